# Optimizing an MI355X kernel written in HIP

```python
import math, functools
import jax, jax.numpy as jnp
from jax import lax
import numpy as np

D_MODEL = 1024
BATCH = 4
SEQ = 4096
DEPTH = 2
DEC_BATCH = 32
DEC_SEQ = 8
PAST_LEN = 8192
PAGE_SIZE = 128

N_META = 16
NORM_EPS = 1e-6
SSM_EXPAND = 2
D_INNER = SSM_EXPAND * D_MODEL
SSM_HEAD_DIM = 64
SSM_HEADS = D_INNER // SSM_HEAD_DIM
SSM_GROUPS = 4
SSM_HPG = SSM_HEADS // SSM_GROUPS
SSM_STATE = 128
CONV_W = 4
CONV_DIM = D_INNER + 2 * SSM_GROUPS * SSM_STATE
SSM_CHUNK = 128
ATT_HEADS = 16
ATT_KV_HEADS = 4
ATT_GROUP = ATT_HEADS // ATT_KV_HEADS
HEAD_DIM = 64
ATT_DIM = ATT_HEADS * HEAD_DIM
KV_DIM = ATT_KV_HEADS * HEAD_DIM
IDX_HEADS = 8
IDX_DIM = 64
TOPK_MAX = 256
Q_BLOCK = 128
D_FF = 4 * D_MODEL

IN_SPLITS = (D_INNER, CONV_DIM, SSM_HEADS,
             ATT_DIM, KV_DIM, KV_DIM,
             IDX_HEADS * IDX_DIM, IDX_DIM, IDX_HEADS,
             D_MODEL, D_MODEL)
IN_DIM = D_INNER + CONV_DIM + SSM_HEADS + ATT_DIM + 2 * KV_DIM + IDX_HEADS * IDX_DIM + IDX_DIM + IDX_HEADS + 2 * D_MODEL

kernel_name = "hybrid_ssd_dsa_gated_decoder_step"

F32 = jnp.float32


def rmsnorm(x, w):
    xf = x.astype(F32)
    y = xf * lax.rsqrt(jnp.mean(xf * xf, axis=-1, keepdims=True) + NORM_EPS)
    return (y * w.astype(F32)).astype(x.dtype)


def split_in(p):
    offs = np.cumsum(IN_SPLITS)[:-1].tolist()
    return jnp.split(p, offs, axis=-1)


def causal_conv(xbc, prefix, w, bias):
    L = xbc.shape[1]
    xp = jnp.concatenate([prefix.astype(xbc.dtype), xbc], axis=1)
    y = bias + xp[:, :L] * w[0]
    for k in range(1, CONV_W):
        y = y + xp[:, k:k + L] * w[k]
    return jax.nn.silu(y), xp[:, L:]


def ssd_scan(x, dt, A, Bm, Cm, h0, chunk):
    b, L = x.shape[:2]
    nc = L // chunk

    def to_chunks(t):
        return jnp.moveaxis(t.reshape((b, nc, chunk) + t.shape[2:]), 1, 0)

    xs = (to_chunks(x.astype(F32).reshape(b, L, SSM_GROUPS, SSM_HPG, SSM_HEAD_DIM)),
          to_chunks(dt.astype(F32).reshape(b, L, SSM_GROUPS, SSM_HPG)),
          to_chunks(Bm.astype(F32)), to_chunks(Cm.astype(F32)))
    a_h = A.astype(F32).reshape(SSM_GROUPS, SSM_HPG)
    causal = jnp.tril(jnp.ones((chunk, chunk), bool))

    def step(h, inp):
        xc, dc, bc, cc = inp
        acum = jnp.cumsum(dc * a_h, axis=1)
        seg = acum[:, :, None] - acum[:, None, :]
        decay = jnp.exp(jnp.where(causal[None, :, :, None, None], seg, -jnp.inf))
        cb = jnp.einsum('bign,bjgn->bijg', cc, bc)
        xdt = xc * dc[..., None]
        y = jnp.einsum('bijg,bijge,bjgep->bigep', cb, decay, xdt)
        y = y + jnp.einsum('bign,bgepn->bigep', cc, h) * jnp.exp(acum)[..., None]
        last = acum[:, -1]
        wj = jnp.exp(last[:, None] - acum)
        h = h * jnp.exp(last)[..., None, None] + jnp.einsum('bjge,bjgep,bjgn->bgepn', wj, xdt, bc)
        return h, y

    h0g = h0.astype(F32).reshape(b, SSM_GROUPS, SSM_HPG, SSM_HEAD_DIM, SSM_STATE)
    hT, ys = lax.scan(step, h0g, xs)
    y = jnp.moveaxis(ys, 0, 1).reshape(b, L, SSM_HEADS, SSM_HEAD_DIM)
    return y, hT.reshape(b, SSM_HEADS, SSM_HEAD_DIM, SSM_STATE)


def ssm_mixer(z, xbc_raw, dt_raw, conv_prefix, h0, segments,
              conv_w, conv_b, dt_bias, a_log, d_skip, ssm_norm_w):
    b, L = z.shape[:2]
    xbc, conv_state = causal_conv(xbc_raw, conv_prefix, conv_w, conv_b)
    xs, Bm, Cm = jnp.split(xbc, [D_INNER, D_INNER + SSM_GROUPS * SSM_STATE], axis=-1)
    xs = xs.reshape(b, L, SSM_HEADS, SSM_HEAD_DIM)
    Bm = Bm.reshape(b, L, SSM_GROUPS, SSM_STATE)
    Cm = Cm.reshape(b, L, SSM_GROUPS, SSM_STATE)
    dt = jax.nn.softplus(dt_raw.astype(F32) + dt_bias.astype(F32))
    A = -jnp.exp(a_log.astype(F32))
    ys, h, start = [], h0, 0
    for length, chunk in segments:
        sl = slice(start, start + length)
        y, h = ssd_scan(xs[:, sl], dt[:, sl], A, Bm[:, sl], Cm[:, sl], h, chunk)
        ys.append(y)
        start += length
    y = jnp.concatenate(ys, axis=1) if len(ys) > 1 else ys[0]
    y = y + xs.astype(F32) * d_skip.astype(F32)[:, None]
    y = y.reshape(b, L, D_INNER) * jax.nn.silu(z.astype(F32))
    yg = y.reshape(b, L, SSM_GROUPS, D_INNER // SSM_GROUPS)
    yg = yg * lax.rsqrt(jnp.mean(yg * yg, axis=-1, keepdims=True) + NORM_EPS)
    y = yg.reshape(b, L, D_INNER) * ssm_norm_w.astype(F32)
    return y.astype(z.dtype), h, conv_state


def indexer_scores(qi, wi, ki):
    s = jax.nn.relu(jnp.einsum('bqhd,bsd->bqhs', qi.astype(F32), ki.astype(F32)) * IDX_DIM ** -0.5)
    return jnp.einsum('bqhs,bqh->bqs', s, wi.astype(F32) * IDX_HEADS ** -0.5)


def select_keys(scores, q_pos, topk):
    s_pos = jnp.arange(scores.shape[-1])
    admissible = s_pos[None, None, :] <= q_pos[None, :, None]
    _, idx = lax.top_k(jnp.where(admissible, scores, -jnp.inf), topk)
    valid = idx <= q_pos[None, :, None]
    return idx, valid


def attend_selected(q, k_sel, v_sel, valid):
    b, nq = q.shape[:2]
    qh = q.reshape(b, nq, ATT_KV_HEADS, ATT_GROUP, HEAD_DIM).astype(F32)
    s = jnp.einsum('bqhgd,bqkhd->bqhgk', qh, k_sel.astype(F32)) * HEAD_DIM ** -0.5
    s = jnp.where(valid[:, :, None, None, :], s, -jnp.inf)
    p = jax.nn.softmax(s, axis=-1)
    o = jnp.einsum('bqhgk,bqkhd->bqhgd', p, v_sel.astype(F32))
    return o.reshape(b, nq, ATT_DIM).astype(q.dtype)


def take_rows(t, i):
    return jax.vmap(lambda tt, ii: tt[ii])(t, i)


def prompt_sparse_attention(q, k, v, qi, wi, ki, topk):
    b, L = q.shape[:2]
    nblk = -(-L // Q_BLOCK)
    pad = nblk * Q_BLOCK - L

    def blocks(t):
        t = jnp.pad(t, [(0, 0), (0, pad)] + [(0, 0)] * (t.ndim - 2))
        return jnp.moveaxis(t.reshape((b, nblk, Q_BLOCK) + t.shape[2:]), 1, 0)

    k_h = k.reshape(b, L, ATT_KV_HEADS, HEAD_DIM)
    v_h = v.reshape(b, L, ATT_KV_HEADS, HEAD_DIM)

    def body(inp):
        qb, qib, wib, start = inp
        q_pos = start + jnp.arange(Q_BLOCK)
        idx, valid = select_keys(indexer_scores(qib, wib, ki), q_pos, topk)
        return attend_selected(qb, take_rows(k_h, idx), take_rows(v_h, idx), valid)

    starts = jnp.arange(nblk) * Q_BLOCK
    out = lax.map(body, (blocks(q), blocks(qi), blocks(wi), starts))
    return jnp.moveaxis(out, 0, 1).reshape(b, nblk * Q_BLOCK, ATT_DIM)[:, :L]


def sample_sparse_attention(q, k, v, qi, wi, ki, pool_k, pool_v, pool_ki, page_table, topk):
    bd, ns = q.shape[:2]
    past = page_table.shape[1] * PAGE_SIZE
    ki_past = pool_ki[page_table].reshape(bd, past, IDX_DIM)
    ki_all = jnp.concatenate([ki_past, ki.astype(ki_past.dtype)], axis=1)
    q_pos = past + jnp.arange(ns)
    idx, valid = select_keys(indexer_scores(qi, wi, ki_all), q_pos, topk)
    in_past = (idx < past)[..., None, None]
    past_idx = jnp.minimum(idx, past - 1)
    phys = take_rows(page_table, past_idx // PAGE_SIZE)
    off = past_idx % PAGE_SIZE
    new_idx = jnp.clip(idx - past, 0, ns - 1)
    k_new = k.reshape(bd, ns, ATT_KV_HEADS, HEAD_DIM)
    v_new = v.reshape(bd, ns, ATT_KV_HEADS, HEAD_DIM)
    k_sel = jnp.where(in_past, pool_k[phys, off], take_rows(k_new, new_idx))
    v_sel = jnp.where(in_past, pool_v[phys, off], take_rows(v_new, new_idx))
    return attend_selected(q, k_sel, v_sel, valid)


def hybrid_layer(h, conv_prefix, h0, segments, attend,
                 norm1_w, w_in, conv_w, conv_b, dt_bias, a_log, d_skip, ssm_norm_w,
                 w_ssm_proj, w_attn_proj, w_out, norm2_w, w_up, w_down):
    b, L = h.shape[:2]
    u = rmsnorm(h, norm1_w)
    z, xbc, dt_raw, q, k, v, qi, ki, wi, g_ssm, g_attn = split_in(u @ w_in)
    y_ssm, ssm_new, conv_new = ssm_mixer(z, xbc, dt_raw, conv_prefix, h0, segments,
                                         conv_w, conv_b, dt_bias, a_log, d_skip, ssm_norm_w)
    qi = qi.reshape(b, L, IDX_HEADS, IDX_DIM)
    y_att = attend(q, k, v, qi, wi, ki)
    merged = jax.nn.sigmoid(g_ssm) * (y_ssm @ w_ssm_proj) + jax.nn.sigmoid(g_attn) * (y_att @ w_attn_proj)
    h = h + merged @ w_out
    u2 = rmsnorm(h, norm2_w)
    h = h + jnp.square(jax.nn.relu(u2 @ w_up)) @ w_down
    rows = (k.reshape(b, L, ATT_KV_HEADS, HEAD_DIM), v.reshape(b, L, ATT_KV_HEADS, HEAD_DIM), ki, ssm_new, conv_new)
    return h, rows


def setup_inputs(seed: int = 0) -> dict:
    key = jax.random.key(seed)
    ks = jax.random.split(key, 32)
    n_pages = PAST_LEN // PAGE_SIZE
    n_pool = (DEC_BATCH * n_pages * 5) // 4

    def nrm(k, shape, scale):
        return jax.random.normal(k, shape, F32) * scale

    dt0 = jnp.exp(jax.random.uniform(ks[13], (DEPTH, SSM_HEADS), F32, math.log(1e-3), math.log(1e-1)))
    page_table = jax.random.permutation(ks[7], n_pool)[:DEC_BATCH * n_pages].reshape(DEC_BATCH, n_pages).astype(jnp.int32)
    return {
        "x_prompt": nrm(ks[0], (BATCH, SEQ, D_MODEL), 1.0),
        "x_sample": nrm(ks[1], (DEC_BATCH, DEC_SEQ, D_MODEL), 1.0),
        "cache_k": nrm(ks[2], (DEPTH, n_pool, PAGE_SIZE, ATT_KV_HEADS, HEAD_DIM), 1.0),
        "cache_v": nrm(ks[3], (DEPTH, n_pool, PAGE_SIZE, ATT_KV_HEADS, HEAD_DIM), 1.0),
        "cache_kidx": nrm(ks[4], (DEPTH, n_pool, PAGE_SIZE, IDX_DIM), 1.0),
        "state_ssm": nrm(ks[5], (DEPTH, DEC_BATCH, SSM_HEADS, SSM_HEAD_DIM, SSM_STATE), 0.3),
        "state_conv": nrm(ks[6], (DEPTH, DEC_BATCH, CONV_W - 1, CONV_DIM), 1.0),
        "page_table": page_table,
        "meta_tokens": nrm(ks[8], (N_META, D_MODEL), 1.0),
        "norm1_w": 1.0 + nrm(ks[9], (DEPTH, D_MODEL), 0.02),
        "w_in": nrm(ks[10], (DEPTH, D_MODEL, IN_DIM), D_MODEL ** -0.5),
        "conv_w": nrm(ks[11], (DEPTH, CONV_W, CONV_DIM), CONV_W ** -0.5),
        "conv_b": nrm(ks[12], (DEPTH, CONV_DIM), 0.02),
        "dt_bias": dt0 + jnp.log(-jnp.expm1(-dt0)),
        "a_log": jnp.log(jax.random.uniform(ks[14], (DEPTH, SSM_HEADS), F32, 1.0, 16.0)),
        "d_skip": 1.0 + nrm(ks[15], (DEPTH, SSM_HEADS), 0.02),
        "ssm_norm_w": 1.0 + nrm(ks[16], (DEPTH, D_INNER), 0.02),
        "w_ssm_proj": nrm(ks[17], (DEPTH, D_INNER, D_MODEL), D_INNER ** -0.5),
        "w_attn_proj": nrm(ks[18], (DEPTH, ATT_DIM, D_MODEL), ATT_DIM ** -0.5),
        "w_out": nrm(ks[19], (DEPTH, D_MODEL, D_MODEL), D_MODEL ** -0.5),
        "norm2_w": 1.0 + nrm(ks[20], (DEPTH, D_MODEL), 0.02),
        "w_up": nrm(ks[21], (DEPTH, D_MODEL, D_FF), D_MODEL ** -0.5),
        "w_down": nrm(ks[22], (DEPTH, D_FF, D_MODEL), D_FF ** -0.5),
        "final_norm_w": 1.0 + nrm(ks[23], (D_MODEL,), 0.02),
    }


def reference(x_prompt, x_sample, cache_k, cache_v, cache_kidx, state_ssm, state_conv, page_table,
              meta_tokens, norm1_w, w_in, conv_w, conv_b, dt_bias, a_log, d_skip, ssm_norm_w,
              w_ssm_proj, w_attn_proj, w_out, norm2_w, w_up, w_down, final_norm_w):
    b, seq = x_prompt.shape[:2]
    bd, ns = x_sample.shape[:2]
    past = page_table.shape[1] * PAGE_SIZE
    hp = jnp.concatenate([jnp.broadcast_to(meta_tokens[None].astype(x_prompt.dtype), (b, N_META, D_MODEL)), x_prompt], axis=1)
    hs = x_sample
    topk_p = min(TOPK_MAX, seq // 4)
    topk_s = min(TOPK_MAX, (past + ns) // 4)
    prompt_segments = ((N_META, N_META), (seq, SSM_CHUNK))
    sample_segments = ((ns, ns),)
    zero_prefix = jnp.zeros((b, CONV_W - 1, CONV_DIM), x_prompt.dtype)
    zero_state = jnp.zeros((b, SSM_HEADS, SSM_HEAD_DIM, SSM_STATE), F32)
    attend_p = functools.partial(prompt_sparse_attention, topk=topk_p)
    p_rows = [[], [], [], [], []]
    s_rows = [[], [], [], [], []]
    for l in range(DEPTH):
        weights = (norm1_w[l], w_in[l], conv_w[l], conv_b[l], dt_bias[l], a_log[l], d_skip[l], ssm_norm_w[l],
                   w_ssm_proj[l], w_attn_proj[l], w_out[l], norm2_w[l], w_up[l], w_down[l])
        hp, rows_p = hybrid_layer(hp, zero_prefix, zero_state, prompt_segments, attend_p, *weights)
        attend_s = functools.partial(sample_sparse_attention, pool_k=cache_k[l], pool_v=cache_v[l],
                                     pool_ki=cache_kidx[l], page_table=page_table, topk=topk_s)
        hs, rows_s = hybrid_layer(hs, state_conv[l], state_ssm[l], sample_segments, attend_s, *weights)
        for acc, r in zip(p_rows, rows_p):
            acc.append(r)
        for acc, r in zip(s_rows, rows_s):
            acc.append(r)
    y_prompt = rmsnorm(hp, final_norm_w)[:, N_META:]
    y_sample = rmsnorm(hs, final_norm_w)
    pk, pv, pki, pssm, pconv = [jnp.stack(r) for r in p_rows]
    sk, sv, ski, sssm, sconv = [jnp.stack(r) for r in s_rows]
    return (y_prompt, y_sample, pk, pv, pki, pssm, pconv, sk, sv, ski, sssm, sconv)
```

```cpp
#include <hip/hip_runtime.h>
#include <cstdio>
#include <cstdint>

constexpr int D = 1024, NB = 4, SEQ = 4096, NMETA = 16, LP = SEQ + NMETA, MP = NB * LP, DB = 32, DS = 8, MS = DB * DS, MR = MP + MS, MPAD = 16896;
constexpr int DIN = 2048, CONVD = 3072, NH = 32, HP = 64, NG = 4, NST = 128;
constexpr int DFF = 4096, IN_DIM = 9320;
constexpr int PAST = 8192, PAGE = 128, NPAGES = 64, NPOOL = 2560;
constexpr int NIN = 9472, LDP1 = 9216;
constexpr int C_Z = 0, C_XBC = 2048, C_Q = 5120, C_K = 6144, C_V = 6400, C_QI = 6656, C_GS = 7168, C_GA = 8192;
constexpr int MC_KI = 0, MC_DT = 64, MC_WI = 96;
static_assert(MP == 16448 && MR == 16704 && MPAD % 256 == 0 && MPAD >= MR, "rows");
namespace pg8 {
#define PG8_LAS __attribute__((address_space(3)))
typedef unsigned short bf16_t;
typedef short bf16x8 __attribute__((ext_vector_type(8)));
typedef float f32x4 __attribute__((ext_vector_type(4)));
typedef unsigned u32x4 __attribute__((ext_vector_type(4)));
constexpr int BM = 256, BK = 64, HALF = 128, HTB = HALF * BK * 2  , STAGE_BYTES = 8 * HTB, NXCD = 8, WGM = 8;

__host__ __device__ __forceinline__ int lds_byte(int r, int c) { const int st = (r >> 4) * 2 + (c >> 5), rr = r & 15, cc = c & 31, ob = rr * 64 + cc * 2; return st * 1024 + (ob ^ (((ob >> 9) & 1) << 5)); }
__host__ __device__ __forceinline__ void stage_rc(int b, int& R, int& C) { const int st = b / 1024, sb = b % 1024, swz = sb ^ (((sb >> 9) & 1) << 5); R = (st >> 1) * 16 + swz / 64; C = (st & 1) * 32 + (swz % 64) / 2; }
__host__ __device__ __forceinline__ int perm32(int rho) { const int n = rho >> 4, i = rho & 15; return 8 * (i >> 2) + 4 * n + (i & 3); }

struct Unit { int pm, pn; };
struct Gemm { const bf16_t* A; const bf16_t* Bt; int M, N, K; };

struct StaticOrder {
    int nM, nN, nwg, G, c;
    __host__ __device__ void init(int M, int N, int G_, int c_) { nM = M / BM; nN = N / BM; nwg = nM * nN; G = G_; c = c_; }
    __host__ __device__ bool next(int i, Unit& u) const {
        const long L = (long)i * G + c; if (L >= nwg) return false;
        int wgid = (int)L; { const int q = nwg / NXCD, r = nwg % NXCD, xcd = wgid % NXCD, off = wgid / NXCD; wgid = (xcd < r ? xcd * (q + 1) : r * (q + 1) + (xcd - r) * q) + off; }
        const int nig = WGM * nN, gid = wgid / nig, fm = gid * WGM, gsz = (nM - fm) < WGM ? (nM - fm) : WGM;
        u.pm = fm + ((wgid % nig) % gsz); u.pn = (wgid % nig) / gsz; return true;
    }
    __device__ __forceinline__ void a_ready(const Unit&) const {}
    __device__ __forceinline__ void done(const Unit&) const {}
};

__device__ __forceinline__ unsigned cvt_pk_bf16(float lo, float hi) { unsigned r; asm volatile("v_cvt_pk_bf16_f32 %0, %1, %2" : "=v"(r) : "v"(lo), "v"(hi)); return r; }

__device__ __forceinline__ void unpack8(const u32x4 w, float (&f)[8]) {
    f[0] = __uint_as_float(w.x << 16); f[1] = __uint_as_float(w.x & 0xffff0000u); f[2] = __uint_as_float(w.y << 16); f[3] = __uint_as_float(w.y & 0xffff0000u);
    f[4] = __uint_as_float(w.z << 16); f[5] = __uint_as_float(w.z & 0xffff0000u); f[6] = __uint_as_float(w.w << 16); f[7] = __uint_as_float(w.w & 0xffff0000u);
}
__device__ __forceinline__ u32x4 pack8(const f32x4 v0, const f32x4 v1) { u32x4 w; w.x = cvt_pk_bf16(v0[0], v0[1]); w.y = cvt_pk_bf16(v0[2], v0[3]); w.z = cvt_pk_bf16(v1[0], v1[1]); w.w = cvt_pk_bf16(v1[2], v1[3]); return w; }
__device__ __forceinline__ float sigm(float x) { return 1.0f / (1.0f + __expf(-x)); }

struct EpiIn {
    static constexpr bool PERM = true, AFTER_DRAIN = false;
    bf16_t* P1; float* misc; bf16_t* kib; float *pk, *pv, *pki, *sk, *sv, *ski;
    __device__ __forceinline__ void operator()(const f32x4 (&acc)[2][2][4][2], const Unit& u, int wr, int wc, int fr, int fq) const {
        const int row0 = u.pm * BM + wr * 64 + fr, lc0 = wc * 32 + 8 * fq;
#pragma unroll
        for (int ai = 0; ai < 2; ++ai)
#pragma unroll
            for (int m = 0; m < 4; ++m) {
                const int row = row0 + ai * HALF + m * 16;
#pragma unroll
                for (int bj = 0; bj < 2; ++bj) {
                    const f32x4 v0 = acc[ai][bj][m][0], v1 = acc[ai][bj][m][1];
                    const int lc = lc0 + bj * HALF;
                    if (u.pn < 36) {
                        *(u32x4*)(P1 + (size_t)row * LDP1 + u.pn * BM + lc) = pack8(v0, v1);
                        if (u.pn == 24) {
                            if (row < MP) { float* dst = pk + (size_t)row * 256 + lc; *(f32x4*)dst = v0; *(f32x4*)(dst + 4) = v1; }
                            else if (row < MR) { float* dst = sk + (size_t)(row - MP) * 256 + lc; *(f32x4*)dst = v0; *(f32x4*)(dst + 4) = v1; }
                        } else if (u.pn == 25) {
                            if (row < MP) { float* dst = pv + (size_t)row * 256 + lc; *(f32x4*)dst = v0; *(f32x4*)(dst + 4) = v1; }
                            else if (row < MR) { float* dst = sv + (size_t)(row - MP) * 256 + lc; *(f32x4*)dst = v0; *(f32x4*)(dst + 4) = v1; }
                        }
                    } else {
                        if (lc < 128) { float* d = misc + (size_t)row * 128 + lc; *(f32x4*)d = v0; *(f32x4*)(d + 4) = v1; }
                        if (lc < 64) {
                            *(u32x4*)(kib + (size_t)row * 64 + lc) = pack8(v0, v1);
                            if (row < MP) { float* dst = pki + (size_t)row * 64 + lc; *(f32x4*)dst = v0; *(f32x4*)(dst + 4) = v1; }
                            else if (row < MR) { float* dst = ski + (size_t)(row - MP) * 64 + lc; *(f32x4*)dst = v0; *(f32x4*)(dst + 4) = v1; }
                        }
                    }
                }
            }
    }
};
struct EpiGate1 {
    static constexpr bool PERM = true, AFTER_DRAIN = false;
    const bf16_t* P1; float* T1;
    __device__ __forceinline__ void operator()(const f32x4 (&acc)[2][2][4][2], const Unit& u, int wr, int wc, int fr, int fq) const {
        const int row0 = u.pm * BM + wr * 64 + fr, col0 = u.pn * BM + wc * 32 + 8 * fq;
#pragma unroll
        for (int ai = 0; ai < 2; ++ai)
#pragma unroll
            for (int m = 0; m < 4; ++m) {
                const int row = row0 + ai * HALF + m * 16;
#pragma unroll
                for (int bj = 0; bj < 2; ++bj) {
                    const int col = col0 + bj * HALF;
                    float g[8]; unpack8(*(const u32x4*)(P1 + (size_t)row * LDP1 + C_GS + col), g);
                    f32x4 v0 = acc[ai][bj][m][0], v1 = acc[ai][bj][m][1];
#pragma unroll
                    for (int e = 0; e < 4; ++e) { v0[e] *= sigm(g[e]); v1[e] *= sigm(g[4 + e]); }
                    float* d = T1 + (size_t)row * 1024 + col; *(f32x4*)d = v0; *(f32x4*)(d + 4) = v1;
                }
            }
    }
};
struct EpiGate2 {
    static constexpr bool PERM = true, AFTER_DRAIN = false;
    const bf16_t* P1; const float* T1; bf16_t* MG;
    __device__ __forceinline__ void operator()(const f32x4 (&acc)[2][2][4][2], const Unit& u, int wr, int wc, int fr, int fq) const {
        const int row0 = u.pm * BM + wr * 64 + fr, col0 = u.pn * BM + wc * 32 + 8 * fq;
#pragma unroll
        for (int ai = 0; ai < 2; ++ai)
#pragma unroll
            for (int m = 0; m < 4; ++m) {
                const int row = row0 + ai * HALF + m * 16;
#pragma unroll
                for (int bj = 0; bj < 2; ++bj) {
                    const int col = col0 + bj * HALF;
                    float g[8]; unpack8(*(const u32x4*)(P1 + (size_t)row * LDP1 + C_GA + col), g);
                    const float* t = T1 + (size_t)row * 1024 + col; const f32x4 t0 = *(const f32x4*)t, t1 = *(const f32x4*)(t + 4);
                    f32x4 v0 = acc[ai][bj][m][0], v1 = acc[ai][bj][m][1];
#pragma unroll
                    for (int e = 0; e < 4; ++e) { v0[e] = t0[e] + v0[e] * sigm(g[e]); v1[e] = t1[e] + v1[e] * sigm(g[4 + e]); }
                    *(u32x4*)(MG + (size_t)row * 1024 + col) = pack8(v0, v1);
                }
            }
    }
};
struct EpiResid {
    static constexpr bool PERM = true, AFTER_DRAIN = false;
    float* H;
    __device__ __forceinline__ void operator()(const f32x4 (&acc)[2][2][4][2], const Unit& u, int wr, int wc, int fr, int fq) const {
        const int row0 = u.pm * BM + wr * 64 + fr, col0 = u.pn * BM + wc * 32 + 8 * fq;
#pragma unroll
        for (int ai = 0; ai < 2; ++ai)
#pragma unroll
            for (int m = 0; m < 4; ++m) {
                const int row = row0 + ai * HALF + m * 16;
#pragma unroll
                for (int bj = 0; bj < 2; ++bj) {
                    float* d = H + (size_t)row * 1024 + col0 + bj * HALF;
                    const f32x4 h0 = *(const f32x4*)d, h1 = *(const f32x4*)(d + 4);
                    *(f32x4*)d = h0 + acc[ai][bj][m][0]; *(f32x4*)(d + 4) = h1 + acc[ai][bj][m][1];
                }
            }
    }
};
struct EpiUp {
    static constexpr bool PERM = true, AFTER_DRAIN = false;
    bf16_t* A2;
    __device__ __forceinline__ void operator()(const f32x4 (&acc)[2][2][4][2], const Unit& u, int wr, int wc, int fr, int fq) const {
        const int row0 = u.pm * BM + wr * 64 + fr, col0 = u.pn * BM + wc * 32 + 8 * fq;
#pragma unroll
        for (int ai = 0; ai < 2; ++ai)
#pragma unroll
            for (int m = 0; m < 4; ++m) {
                const int row = row0 + ai * HALF + m * 16;
#pragma unroll
                for (int bj = 0; bj < 2; ++bj) {
                    f32x4 v0 = acc[ai][bj][m][0], v1 = acc[ai][bj][m][1];
#pragma unroll
                    for (int e = 0; e < 4; ++e) { const float a = fmaxf(v0[e], 0.f), b = fmaxf(v1[e], 0.f); v0[e] = a * a; v1[e] = b * b; }
                    *(u32x4*)(A2 + (size_t)row * DFF + col0 + bj * HALF) = pack8(v0, v1);
                }
            }
    }
};
template <class Epi, class Sched, bool ALIGN_EPI = false, bool SP2 = false>
__device__ __forceinline__ void gemm_phase(PG8_LAS unsigned char* lds, const Gemm g, const Sched& S, const Epi& E) {
    const int tid = threadIdx.x, wid = __builtin_amdgcn_readfirstlane(tid >> 6), lane = tid & 63, wr = wid >> 2, wc = wid & 3, fr = lane & 15, fq = lane >> 4;
    const int K = g.K, nt = K / BK;
    unsigned voffA[2], voffB[2];
#pragma unroll
    for (int i = 0; i < 2; ++i) { int R, C; stage_rc(tid * 16 + i * 8192, R, C); const int Rb = Epi::PERM ? ((R & ~31) + perm32(R & 31)) : R;
        voffA[i] = (unsigned)(R * K + C) * 2u; voffB[i] = (unsigned)(Rb * K + C) * 2u; }
    const size_t kstep = (size_t)(BK * 2);
    const size_t hstep = (size_t)HALF * K * 2;
    const size_t tstep = 2 * hstep;
    const unsigned ldsw = (unsigned)wid * 1024u;
    const int aoff = lds_byte(wr * 64 + fr, fq * 8), boff = lds_byte(wc * 32 + fr, fq * 8);
#define PG8_SA(b, h) (((b) * 2 + (h)) * HTB)
#define PG8_SB(b, h) ((4 + (b) * 2 + (h)) * HTB)
#define PG8_STAGE(bufoff, gbase, voff) do { _Pragma("unroll") for (int _i = 0; _i < 2; ++_i) \
        __builtin_amdgcn_global_load_lds((const unsigned*)((const char*)(gbase) + (voff)[_i]), (PG8_LAS unsigned*)(lds + (bufoff) + ldsw + _i * 8192), 16, 0, 0); } while (0)
#define PG8_LDA(dst, b, h) do { _Pragma("unroll") for (int m = 0; m < 4; ++m) _Pragma("unroll") for (int k = 0; k < 2; ++k) dst[m][k] = *(const PG8_LAS bf16x8*)(lds + PG8_SA(b, h) + aoff + m * 2048 + k * 1024); } while (0)
#define PG8_LDB(dst, b, h) do { _Pragma("unroll") for (int n = 0; n < 2; ++n) _Pragma("unroll") for (int k = 0; k < 2; ++k) dst[n][k] = *(const PG8_LAS bf16x8*)(lds + PG8_SB(b, h) + boff + n * 2048 + k * 1024); } while (0)
#define PG8_MMA(ai, bj, At, Bt) do { __builtin_amdgcn_s_setprio(1); _Pragma("unroll") for (int m = 0; m < 4; ++m) _Pragma("unroll") for (int n = 0; n < 2; ++n) _Pragma("unroll") for (int k = 0; k < 2; ++k) \
        acc[ai][bj][m][n] = __builtin_amdgcn_mfma_f32_16x16x32_bf16(Bt[n][k], At[m][k], acc[ai][bj][m][n], 0, 0, 0); __builtin_amdgcn_s_setprio(0); } while (0)
#define PG8_WAIT_V(n) asm volatile("s_waitcnt vmcnt(" #n ")" ::: "memory")
#define PG8_WAIT_L(n) asm volatile("s_waitcnt lgkmcnt(" #n ")" ::: "memory")
#define PG8_BAR __builtin_amdgcn_s_barrier()
#define PG8_SCHED __builtin_amdgcn_sched_barrier(0)
    Unit cur, nxt; int ui = 0;
    if (!S.next(0, cur)) return;
    f32x4 acc[2][2][4][2];
#pragma unroll
    for (int a = 0; a < 2; ++a)
#pragma unroll
        for (int b = 0; b < 2; ++b)
#pragma unroll
            for (int m = 0; m < 4; ++m)
#pragma unroll
                for (int n = 0; n < 2; ++n) acc[a][b][m][n] = (f32x4){0.f, 0.f, 0.f, 0.f};
    bf16x8 At[4][2], B0[2][2], B1[2][2];
    const char* cA = (const char*)g.A + (size_t)cur.pm * tstep; const char* cB = (const char*)g.Bt + (size_t)cur.pn * tstep;
    S.a_ready(cur);
    if constexpr (SP2) {
        PG8_STAGE(PG8_SB(0, 0), cB, voffB); PG8_STAGE(PG8_SB(0, 1), cB + hstep, voffB); PG8_STAGE(PG8_SA(0, 0), cA, voffA); PG8_STAGE(PG8_SA(0, 1), cA + hstep, voffA);
        if (wr == 1) PG8_BAR;
        PG8_WAIT_V(2); PG8_BAR;
        PG8_STAGE(PG8_SB(1, 0), cB + kstep, voffB); PG8_STAGE(PG8_SA(1, 0), cA + kstep, voffA); PG8_STAGE(PG8_SB(1, 1), cB + hstep + kstep, voffB);
        PG8_WAIT_V(6); PG8_BAR;
    } else {
        PG8_STAGE(PG8_SB(0, 0), cB, voffB); PG8_STAGE(PG8_SA(0, 0), cA, voffA); PG8_STAGE(PG8_SB(0, 1), cB + hstep, voffB); PG8_STAGE(PG8_SA(0, 1), cA + hstep, voffA);
        if (wr == 1) PG8_BAR;
        PG8_WAIT_V(4); PG8_BAR;
        PG8_STAGE(PG8_SB(1, 0), cB + kstep, voffB); PG8_STAGE(PG8_SA(1, 0), cA + kstep, voffA); PG8_STAGE(PG8_SB(1, 1), cB + hstep + kstep, voffB);
        PG8_WAIT_V(6); PG8_BAR;
    }
    for (;;) {
        const bool has_next = S.next(ui + 1, nxt);
        const char* nA = has_next ? (const char*)g.A + (size_t)nxt.pm * tstep : cA; const char* nB = has_next ? (const char*)g.Bt + (size_t)nxt.pn * tstep : cB;
        for (int t = 0; t < nt; t += 2) {
            const bool last = (t == nt - 2);
            const char* a1 = cA + (size_t)(t + 1) * kstep;
            const char* a2 = last ? nA : cA + (size_t)(t + 2) * kstep; const char* b2 = last ? nB : cB + (size_t)(t + 2) * kstep;
            const char* a3 = a2 + kstep; const char* b3 = b2 + kstep;
            if (last && has_next) S.a_ready(nxt);
            if constexpr (SP2) {
            PG8_LDB(B0, 0, 0); PG8_LDB(B1, 0, 1); PG8_SCHED; PG8_LDA(At, 0, 0); PG8_STAGE(PG8_SA(1, 1), a1 + hstep, voffA);
            PG8_WAIT_V(8); PG8_WAIT_L(0); PG8_BAR; PG8_MMA(0, 0, At, B0); PG8_MMA(0, 1, At, B1); PG8_BAR; PG8_SCHED;
            PG8_LDA(At, 0, 1); PG8_STAGE(PG8_SB(0, 0), b2, voffB); PG8_STAGE(PG8_SB(0, 1), b2 + hstep, voffB); PG8_STAGE(PG8_SA(0, 0), a2, voffA);
            PG8_WAIT_V(8); PG8_WAIT_L(0); PG8_BAR; PG8_MMA(1, 0, At, B0); PG8_MMA(1, 1, At, B1); PG8_BAR; PG8_SCHED;
            PG8_LDB(B0, 1, 0); PG8_LDB(B1, 1, 1); PG8_SCHED; PG8_LDA(At, 1, 0); PG8_STAGE(PG8_SA(0, 1), a2 + hstep, voffA);
            PG8_WAIT_V(8); PG8_WAIT_L(0); PG8_BAR; PG8_MMA(0, 0, At, B0); PG8_MMA(0, 1, At, B1); PG8_BAR; PG8_SCHED;
            PG8_LDA(At, 1, 1); PG8_STAGE(PG8_SB(1, 0), b3, voffB); PG8_STAGE(PG8_SB(1, 1), b3 + hstep, voffB); PG8_STAGE(PG8_SA(1, 0), a3, voffA);
            PG8_WAIT_V(8); PG8_WAIT_L(0); PG8_BAR; PG8_MMA(1, 0, At, B0); PG8_MMA(1, 1, At, B1); PG8_BAR; PG8_SCHED;
            } else {
            PG8_LDB(B0, 0, 0); PG8_SCHED; PG8_LDA(At, 0, 0); PG8_STAGE(PG8_SA(1, 1), a1 + hstep, voffA);
            PG8_WAIT_L(8); PG8_BAR; PG8_WAIT_L(0); PG8_MMA(0, 0, At, B0); PG8_BAR; PG8_SCHED;
            PG8_LDB(B1, 0, 1); PG8_STAGE(PG8_SB(0, 0), b2, voffB);
            PG8_BAR; PG8_WAIT_L(0); PG8_MMA(0, 1, At, B1); PG8_BAR;
            PG8_LDA(At, 0, 1); PG8_STAGE(PG8_SA(0, 0), a2, voffA);
            PG8_BAR; PG8_WAIT_L(0); PG8_MMA(1, 0, At, B0); PG8_BAR; PG8_SCHED;
            PG8_STAGE(PG8_SB(0, 1), b2 + hstep, voffB);
            PG8_WAIT_V(6); PG8_BAR; PG8_MMA(1, 1, At, B1); PG8_BAR;
            PG8_LDB(B0, 1, 0); PG8_SCHED; PG8_LDA(At, 1, 0); PG8_STAGE(PG8_SA(0, 1), a2 + hstep, voffA);
            PG8_WAIT_L(8); PG8_BAR; PG8_WAIT_L(0); PG8_MMA(0, 0, At, B0); PG8_BAR; PG8_SCHED;
            PG8_LDB(B1, 1, 1); PG8_STAGE(PG8_SB(1, 0), b3, voffB);
            PG8_BAR; PG8_WAIT_L(0); PG8_MMA(0, 1, At, B1); PG8_BAR;
            PG8_LDA(At, 1, 1); PG8_STAGE(PG8_SA(1, 0), a3, voffA);
            PG8_BAR; PG8_WAIT_L(0); PG8_MMA(1, 0, At, B0); PG8_BAR; PG8_SCHED;
            PG8_STAGE(PG8_SB(1, 1), b3 + hstep, voffB);
            PG8_WAIT_V(6); PG8_BAR; PG8_MMA(1, 1, At, B1); PG8_BAR;
            }
        }
        if constexpr (ALIGN_EPI) { if (wr == 0) PG8_BAR; }
        if constexpr (!Epi::AFTER_DRAIN) { E(acc, cur, wr, wc, fr, fq); S.done(cur); }
        if (!has_next) break;
#pragma unroll
        for (int a = 0; a < 2; ++a)
#pragma unroll
            for (int b = 0; b < 2; ++b)
#pragma unroll
                for (int m = 0; m < 4; ++m)
#pragma unroll
                    for (int n = 0; n < 2; ++n) acc[a][b][m][n] = (f32x4){0.f, 0.f, 0.f, 0.f};
        cur = nxt; cA = nA; cB = nB; ++ui;
        if constexpr (ALIGN_EPI) { if (wr == 1) PG8_BAR; }
    }
    PG8_WAIT_V(0);
    if constexpr (!ALIGN_EPI) { if (wr == 0) PG8_BAR; }
    PG8_BAR;
    if constexpr (Epi::AFTER_DRAIN) { E.fused(acc, cur, wr, wc, fr, fq, lds, wid, lane); S.done(cur); }
#undef PG8_SA
#undef PG8_SB
#undef PG8_STAGE
#undef PG8_LDA
#undef PG8_LDB
#undef PG8_MMA
#undef PG8_WAIT_V
#undef PG8_WAIT_L
#undef PG8_BAR
#undef PG8_SCHED
}
}
#define GAS __attribute__((address_space(1)))
#define LAS __attribute__((address_space(3)))
typedef unsigned short bf16;
typedef unsigned v4u __attribute__((ext_vector_type(4)));
typedef float f32x4 __attribute__((ext_vector_type(4)));
typedef short bf16x8 __attribute__((ext_vector_type(8)));
typedef GAS unsigned gu32;
typedef GAS unsigned long long gu64;
#define RLX_AGENT __ATOMIC_RELAXED, __HIP_MEMORY_SCOPE_AGENT
#define LDS_WAIT() asm volatile("s_waitcnt lgkmcnt(0)" ::: "memory")
#define VM_WAIT() asm volatile("s_waitcnt vmcnt(0)" ::: "memory")
__device__ __forceinline__ unsigned long long rt() { return __builtin_amdgcn_s_memrealtime(); }
__device__ __forceinline__ unsigned f2bf(float f) { unsigned u = __builtin_bit_cast(unsigned, f); return (u + 0x7fffu + ((u >> 16) & 1u)) >> 16; }
__device__ __forceinline__ unsigned pk2(float lo, float hi) { return f2bf(lo) | (f2bf(hi) << 16); }

#define XB_TMO      128
#define XB_XCNT(j)  (256  + 64 * (j))
#define XB_XSUB(j)  (1280 + 64 * (j))
#define XB_XGEN(j)  (2304 + 64 * (j))
#define XB_TOP      3328
#define XB_TOPGEN   3392
#define XCD_BAR_WORDS 3456
#define XB_SPIN_CAP (1u << 18)

__device__ __forceinline__ unsigned xb_ld(unsigned* p)              { return __hip_atomic_load(p, __ATOMIC_RELAXED, __HIP_MEMORY_SCOPE_AGENT); }
__device__ __forceinline__ unsigned xb_add(unsigned* p, unsigned v) { return __hip_atomic_fetch_add(p, v, __ATOMIC_RELAXED, __HIP_MEMORY_SCOPE_AGENT); }
__device__ __forceinline__ unsigned xb_xcc_id() { return (unsigned)__builtin_amdgcn_s_getreg((3 << 11) | 20) & 0xFu; }
#define XB_SPIN(cond, bar) do { unsigned _sp = 0; while (cond) { __builtin_amdgcn_s_sleep(1); \
    if ((++_sp & 255u) == 0u) { if (xb_ld(&(bar)[XB_TMO])) break; if (_sp > XB_SPIN_CAP) { atomicAdd(&(bar)[XB_TMO], 1u); break; } } } } while (0)

struct XcdBarrier {
    unsigned* bar; unsigned x;
    volatile LAS unsigned* st;
};

__device__ __forceinline__ XcdBarrier xcd_barrier_post(unsigned* bar, volatile LAS unsigned* st) {
    XcdBarrier b; b.bar = bar; b.x = xb_xcc_id(); b.st = st;
    if (threadIdx.x == 0) (void)xb_add(&bar[XB_XCNT(b.x)], 1u);
    return b;
}
__device__ __forceinline__ void xcd_barrier_complete(unsigned* bar, unsigned x, unsigned& nloc, unsigned& nx) {
    const unsigned G = gridDim.x * gridDim.y * gridDim.z;
    unsigned sum, cnt, mine, sp = 0u;
    for (;;) {
        sum = 0u; cnt = 0u; mine = 0u;
#pragma unroll
        for (unsigned j = 0; j < 16; ++j) { const unsigned c = xb_ld(&bar[XB_XCNT(j)]); sum += c; cnt += (c > 0u) ? 1u : 0u; mine = (j == x) ? c : mine; }
        if (sum == G) break;
        __builtin_amdgcn_s_sleep(1);
        if ((++sp & 255u) == 0u) { if (xb_ld(&bar[XB_TMO])) break; if (sp > XB_SPIN_CAP) { atomicAdd(&bar[XB_TMO], 1u); break; } }
    }
    nloc = mine > 0u ? mine : 1u; nx = cnt > 0u ? cnt : 1u;
}

__device__ __forceinline__ void xcd_barrier(const XcdBarrier& b) {
    asm volatile("s_waitcnt vmcnt(0)" ::: "memory");
    __syncthreads();
    if (threadIdx.x == 0) {
        unsigned* bar = b.bar;
        __builtin_amdgcn_s_waitcnt(0);
        unsigned nloc = b.st[0], nx = b.st[1];
        if (nloc == 0u) { xcd_barrier_complete(bar, b.x, nloc, nx); b.st[0] = nloc; b.st[1] = nx; }
        const unsigned old = xb_add(&bar[XB_XSUB(b.x)], 1u);
        const unsigned gen = old / nloc;
        if (old + 1u == (gen + 1u) * nloc) {
            __builtin_amdgcn_fence(__ATOMIC_RELEASE, "agent");
            asm volatile("s_waitcnt vmcnt(0)" ::: "memory");
            const unsigned og = xb_add(&bar[XB_TOP], 1u);
            const unsigned tg = og / nx;
            if (og + 1u == (tg + 1u) * nx) xb_add(&bar[XB_TOPGEN], 1u);
            else XB_SPIN(xb_ld(&bar[XB_TOPGEN]) == tg, bar);
            __builtin_amdgcn_fence(__ATOMIC_ACQUIRE, "agent");
            xb_add(&bar[XB_XGEN(b.x)], 1u);
            asm volatile("s_waitcnt vmcnt(0)" ::: "memory");
        } else {
            XB_SPIN(xb_ld(&bar[XB_XGEN(b.x)]) == gen, bar);
            __builtin_amdgcn_fence(__ATOMIC_ACQUIRE, "agent");
            asm volatile("s_waitcnt vmcnt(0)" ::: "memory");
        }
    }
    __syncthreads();
}

constexpr size_t O_YP = 0, O_YS = O_YP + (size_t)NB * SEQ * D, O_PK = O_YS + (size_t)MS * D, O_PV = O_PK + 2ull * MP * 256, O_PKI = O_PV + 2ull * MP * 256,
                 O_PSSM = O_PKI + 2ull * MP * 64, O_PCONV = O_PSSM + 2ull * NB * NH * HP * NST, O_SK = O_PCONV + 2ull * NB * 3 * CONVD, O_SV = O_SK + 2ull * MS * 256,
                 O_SKI = O_SV + 2ull * MS * 256, O_SSSM = O_SKI + 2ull * MS * 64, O_SCONV = O_SSSM + 2ull * DB * NH * HP * NST, O_END = O_SCONV + 2ull * DB * 3 * CONVD;

constexpr size_t MiB = 1u << 20;
constexpr size_t al(size_t x) { return (x + MiB - 1) / MiB * MiB; }
constexpr size_t WS_CTL = 0, CTL_ZERO_BYTES = 1 * MiB;
constexpr size_t SZ_WIN = (size_t)NIN * D * 2, SZ_WSSM = (size_t)D * DIN * 2, SZ_WATT = (size_t)D * D * 2, SZ_WOUT = (size_t)D * D * 2, SZ_WUP = (size_t)DFF * D * 2, SZ_WDN = (size_t)D * DFF * 2;
constexpr size_t WL_WIN = 0, WL_WSSM = al(WL_WIN + SZ_WIN), WL_WATT = al(WL_WSSM + SZ_WSSM), WL_WOUT = al(WL_WATT + SZ_WATT), WL_WUP = al(WL_WOUT + SZ_WOUT), WL_WDN = al(WL_WUP + SZ_WUP), WL_SIZE = al(WL_WDN + SZ_WDN);
constexpr size_t WS_W = 1 * MiB;
constexpr size_t WS_H = al(WS_W + 2 * WL_SIZE);
constexpr size_t WS_U = al(WS_H + (size_t)MPAD * D * 4);
constexpr size_t WS_P1 = al(WS_U + (size_t)MPAD * D * 2);
constexpr size_t WS_MISC = al(WS_P1 + (size_t)MPAD * LDP1 * 2);
constexpr size_t WS_KIB = al(WS_MISC + (size_t)MPAD * 128 * 4);
constexpr size_t WS_XC = al(WS_KIB + (size_t)MPAD * 64 * 2);
constexpr size_t WS_DT = al(WS_XC + (size_t)MPAD * CONVD * 2);
constexpr size_t WS_DA = al(WS_DT + (size_t)MPAD * 32 * 4);
constexpr size_t WS_YS = al(WS_DA + (size_t)MPAD * 32 * 4);
constexpr size_t WS_YSN = al(WS_YS + (size_t)MPAD * DIN * 4);
constexpr size_t WS_YA = al(WS_YSN + (size_t)MPAD * DIN * 2);
constexpr size_t WS_T1 = al(WS_YA + (size_t)MPAD * D * 2);
constexpr size_t WS_MG = al(WS_T1 + (size_t)MPAD * D * 4);
constexpr size_t WS_A2 = al(WS_MG + (size_t)MPAD * D * 2);
constexpr size_t WS_IDXP = al(WS_A2 + (size_t)MPAD * DFF * 2);
constexpr size_t WS_IDXS = al(WS_IDXP + (size_t)MP * 256 * 2);
constexpr int SCS_LD = 8256;
constexpr size_t WS_SCS = al(WS_IDXS + (size_t)MS * 256 * 4);
constexpr size_t WS_END = al(WS_SCS + (size_t)MS * SCS_LD * 4);
constexpr int CW_BAR = 4096;

constexpr int LDS_BYTES = 155648, LDSCTL_OFF = 151552, MISC_OFF = LDSCTL_OFF + 320;
constexpr int NWAVES = 8, NT = 512;
typedef float f32x16 __attribute__((ext_vector_type(16)));
typedef unsigned v2u __attribute__((ext_vector_type(2)));

__device__ __forceinline__ float wave_sum(float v) {
#pragma unroll
    for (int o = 1; o < 64; o <<= 1) v += __shfl_xor(v, o);
    return v;
}
__device__ __forceinline__ float wave_max(float v) {
#pragma unroll
    for (int o = 1; o < 64; o <<= 1) v = fmaxf(v, __shfl_xor(v, o));
    return v;
}
__device__ __forceinline__ void unpack8(const v4u w, float (&f)[8]) {
    f[0] = __uint_as_float(w.x << 16); f[1] = __uint_as_float(w.x & 0xffff0000u); f[2] = __uint_as_float(w.y << 16); f[3] = __uint_as_float(w.y & 0xffff0000u);
    f[4] = __uint_as_float(w.z << 16); f[5] = __uint_as_float(w.z & 0xffff0000u); f[6] = __uint_as_float(w.w << 16); f[7] = __uint_as_float(w.w & 0xffff0000u);
}
__device__ __forceinline__ float sigm(float x) { return 1.0f / (1.0f + __expf(-x)); }

__device__ __forceinline__ int win_src_col(int n) {
    if (n < 5120) return n;
    if (n < 6144) return n - 5120 + 5152;
    if (n < 6400) return n - 6144 + 6176;
    if (n < 6656) return n - 6400 + 6432;
    if (n < 7168) return n - 6656 + 6688;
    if (n < 8192) return n - 7168 + 7272;
    if (n < 9216) return n - 8192 + 8296;
    if (n < 9280) return n - 9216 + 7200;
    if (n < 9312) return n - 9280 + 5120;
    if (n < 9320) return n - 9312 + 7264;
    return -1;
}
__device__ __forceinline__ void tr_item(const float* W, int K, int Nsrc, bf16* WT, int nblk, bool remap, LAS float* scr, int item, int lane) {
    const int kb = item / nblk, nb = item % nblk, k0 = 64 * kb, n0 = 32 * nb;
    const int nd = n0 + (lane & 31), sc = remap ? win_src_col(nd) : nd;
#pragma unroll 8
    for (int i = 0; i < 32; ++i) { const int kk = 2 * i + (lane >> 5); scr[kk * 33 + (lane & 31)] = sc >= 0 ? W[(size_t)(k0 + kk) * Nsrc + sc] : 0.f; }
    LDS_WAIT(); asm volatile("" ::: "memory");
    const int c = lane & 7;
#pragma unroll
    for (int j = 0; j < 4; ++j) { const int n = (lane >> 3) + 8 * j; const LAS float* s = scr + (8 * c) * 33 + n;
        v4u o; o.x = pk2(s[0 * 33], s[1 * 33]); o.y = pk2(s[2 * 33], s[3 * 33]); o.z = pk2(s[4 * 33], s[5 * 33]); o.w = pk2(s[6 * 33], s[7 * 33]);
        *(v4u*)(WT + (size_t)(n0 + n) * K + k0 + 8 * c) = o; }
    LDS_WAIT(); asm volatile("" ::: "memory");
}
__device__ __forceinline__ void rms_row(const float* src, const float* w, float* hdst, bf16* udst, float* fdst, int lane) {
    f32x4 v[4]; float ss = 0.f;
#pragma unroll
    for (int j = 0; j < 4; ++j) { v[j] = src ? ((const f32x4*)src)[lane + 64 * j] : (f32x4){0.f, 0.f, 0.f, 0.f}; ss += (v[j].x * v[j].x + v[j].y * v[j].y) + (v[j].z * v[j].z + v[j].w * v[j].w); }
    ss = wave_sum(ss);
    const float rstd = 1.0f / sqrtf(ss * (1.0f / D) + 1e-6f);
#pragma unroll
    for (int j = 0; j < 4; ++j) {
        if (hdst) ((f32x4*)hdst)[lane + 64 * j] = v[j];
        const f32x4 wv = ((const f32x4*)w)[lane + 64 * j]; const f32x4 o = v[j] * rstd * wv;
        if (udst) ((v2u*)udst)[lane + 64 * j] = (v2u){pk2(o.x, o.y), pk2(o.z, o.w)};
        if (fdst) ((f32x4*)fdst)[lane + 64 * j] = o;
    }
}

__device__ __forceinline__ void ssd_unit(LAS unsigned char* lds, int tid, const bf16* XC, const float* DT, const float* DA, size_t m0, int L, int h, int p0,
                                         const float* hin, float* hout, float* YS, float dskip) {
    LAS float* Bl = (LAS float*)lds;
    LAS float* Cl = Bl + 64 * 128;
    LAS float* Xl = Cl + 64 * 128;
    LAS float* Yl = Xl + 64 * 32;
    LAS float* dtl = Yl + 64 * 32;
    LAS float* dal = dtl + 64;
    const int pl = tid >> 4, nq = tid & 15, n0 = nq * 8, g = h >> 3;
    float s[8];
    if (hin) { const f32x4 a = *(const f32x4*)(hin + (size_t)(p0 + pl) * NST + n0), b = *(const f32x4*)(hin + (size_t)(p0 + pl) * NST + n0 + 4);
        s[0] = a.x; s[1] = a.y; s[2] = a.z; s[3] = a.w; s[4] = b.x; s[5] = b.y; s[6] = b.z; s[7] = b.w; }
    else {
#pragma unroll
        for (int i = 0; i < 8; ++i) s[i] = 0.f; }
    for (int tb = 0; tb < L; tb += 64) {
        const int nb = (L - tb) < 64 ? (L - tb) : 64;
        { const int tk = tid >> 3, part = tid & 7;
            if (tk < nb) { const bf16* xr = XC + (m0 + tb + tk) * CONVD;
                float f[8];
                unpack8(*(const v4u*)(xr + DIN + g * NST + part * 16), f);
                *(LAS f32x4*)(Bl + tk * 128 + part * 16) = (f32x4){f[0], f[1], f[2], f[3]}; *(LAS f32x4*)(Bl + tk * 128 + part * 16 + 4) = (f32x4){f[4], f[5], f[6], f[7]};
                unpack8(*(const v4u*)(xr + DIN + g * NST + part * 16 + 8), f);
                *(LAS f32x4*)(Bl + tk * 128 + part * 16 + 8) = (f32x4){f[0], f[1], f[2], f[3]}; *(LAS f32x4*)(Bl + tk * 128 + part * 16 + 12) = (f32x4){f[4], f[5], f[6], f[7]};
                unpack8(*(const v4u*)(xr + DIN + NG * NST + g * NST + part * 16), f);
                *(LAS f32x4*)(Cl + tk * 128 + part * 16) = (f32x4){f[0], f[1], f[2], f[3]}; *(LAS f32x4*)(Cl + tk * 128 + part * 16 + 4) = (f32x4){f[4], f[5], f[6], f[7]};
                unpack8(*(const v4u*)(xr + DIN + NG * NST + g * NST + part * 16 + 8), f);
                *(LAS f32x4*)(Cl + tk * 128 + part * 16 + 8) = (f32x4){f[0], f[1], f[2], f[3]}; *(LAS f32x4*)(Cl + tk * 128 + part * 16 + 12) = (f32x4){f[4], f[5], f[6], f[7]};
                const v2u xw = *(const v2u*)(xr + h * HP + p0 + part * 4);
                *(LAS f32x4*)(Xl + tk * 32 + part * 4) = (f32x4){__uint_as_float(xw.x << 16), __uint_as_float(xw.x & 0xffff0000u), __uint_as_float(xw.y << 16), __uint_as_float(xw.y & 0xffff0000u)};
            }
            if (tid < nb) { dtl[tid] = DT[(m0 + tb + tid) * 32 + h]; dal[tid] = DA[(m0 + tb + tid) * 32 + h]; }
        }
        __syncthreads();
        for (int t = 0; t < nb; ++t) {
            const float da = dal[t], dtv = dtl[t], xv = Xl[t * 32 + pl], xdt = xv * dtv;
            const f32x4 b0 = *(const LAS f32x4*)(Bl + t * 128 + n0), b1 = *(const LAS f32x4*)(Bl + t * 128 + n0 + 4);
            const f32x4 c0 = *(const LAS f32x4*)(Cl + t * 128 + n0), c1 = *(const LAS f32x4*)(Cl + t * 128 + n0 + 4);
            s[0] = s[0] * da + xdt * b0.x; s[1] = s[1] * da + xdt * b0.y; s[2] = s[2] * da + xdt * b0.z; s[3] = s[3] * da + xdt * b0.w;
            s[4] = s[4] * da + xdt * b1.x; s[5] = s[5] * da + xdt * b1.y; s[6] = s[6] * da + xdt * b1.z; s[7] = s[7] * da + xdt * b1.w;
            float y = (s[0] * c0.x + s[1] * c0.y) + (s[2] * c0.z + s[3] * c0.w) + (s[4] * c1.x + s[5] * c1.y) + (s[6] * c1.z + s[7] * c1.w);
            y += __shfl_xor(y, 1); y += __shfl_xor(y, 2); y += __shfl_xor(y, 4); y += __shfl_xor(y, 8);
            if (nq == 0) Yl[t * 32 + pl] = y + xv * dskip;
        }
        __syncthreads();
        { const int tk = tid >> 3, part = tid & 7;
            if (tk < nb) *(f32x4*)(YS + (m0 + tb + tk) * DIN + h * HP + p0 + part * 4) = *(const LAS f32x4*)(Yl + tk * 32 + part * 4); }
    }
    *(f32x4*)(hout + (size_t)(p0 + pl) * NST + n0) = (f32x4){s[0], s[1], s[2], s[3]};
    *(f32x4*)(hout + (size_t)(p0 + pl) * NST + n0 + 4) = (f32x4){s[4], s[5], s[6], s[7]};
}

__device__ __forceinline__ void idx_load_q(const bf16* P1, const float* MISC, size_t mq0, int lane, bf16x8 (&afr)[2][4], float (&wq)[2][2][8]) {
    const int r = lane & 31, hh = lane >> 5, qs = ((r >> 2) & 1) * 2 + (r >> 4), head = (r & 3) + 4 * ((r >> 3) & 1);
#pragma unroll
    for (int rt = 0; rt < 2; ++rt)
#pragma unroll
        for (int ks = 0; ks < 4; ++ks) afr[rt][ks] = *(const bf16x8*)(P1 + (mq0 + qs + 4 * rt) * LDP1 + C_QI + head * 64 + 16 * ks + 8 * hh);
#pragma unroll
    for (int rt = 0; rt < 2; ++rt)
#pragma unroll
        for (int jq = 0; jq < 2; ++jq) { const float* wp = MISC + (mq0 + 4 * rt + 2 * hh + jq) * 128 + MC_WI; const f32x4 a = *(const f32x4*)wp, b = *(const f32x4*)(wp + 4);
            const float sc = 0.125f * 0.35355339059327373f;
            wq[rt][jq][0] = a.x * sc; wq[rt][jq][1] = a.y * sc; wq[rt][jq][2] = a.z * sc; wq[rt][jq][3] = a.w * sc; wq[rt][jq][4] = b.x * sc; wq[rt][jq][5] = b.y * sc; wq[rt][jq][6] = b.z * sc; wq[rt][jq][7] = b.w * sc; }
}
__device__ __forceinline__ void idx_scores(const bf16x8 (&afr)[2][4], const bf16x8 (&bfr)[4], const float (&wq)[2][2][8], float (&sc)[2][2]) {
#pragma unroll
    for (int rt = 0; rt < 2; ++rt) {
        f32x16 acc = {};
#pragma unroll
        for (int ks = 0; ks < 4; ++ks) acc = __builtin_amdgcn_mfma_f32_32x32x16_bf16(afr[rt][ks], bfr[ks], acc, 0, 0, 0);
#pragma unroll
        for (int jq = 0; jq < 2; ++jq) { float s = 0.f;
#pragma unroll
            for (int i = 0; i < 8; ++i) s += wq[rt][jq][i] * fmaxf(acc[8 * jq + i], 0.f);
            sc[rt][jq] = s; }
    }
}
__device__ __forceinline__ unsigned f2key(float f) { const unsigned u = __float_as_uint(f); return u ^ ((u >> 31) ? 0xffffffffu : 0x80000000u); }
__device__ __forceinline__ unsigned wave_incl_scan(unsigned v, int lane) {
#pragma unroll
    for (int o = 1; o < 64; o <<= 1) { const unsigned t = __shfl_up(v, o); if (lane >= o) v += t; }
    return v;
}
template <class SP, class OT>
__device__ __forceinline__ void topk_select(SP s, int n, LAS unsigned* hist, int lane, OT* out) {
    unsigned prefix = 0u, need = 256u;
    const int nr = (n + 63) & ~63;
#pragma unroll
    for (int pass = 0; pass < 4; ++pass) {
        const int shift = 24 - 8 * pass;
#pragma unroll
        for (int j = 0; j < 4; ++j) hist[lane + 64 * j] = 0u;
        for (int i = lane; i < nr; i += 64) {
            const bool ok = i < n; const unsigned key = ok ? f2key(s[i]) : 0u;
            const bool match = ok && (pass == 0 || (key >> ((shift + 8) & 31)) == prefix);
            if (match) __hip_atomic_fetch_add(hist + ((key >> shift) & 255u), 1u, __ATOMIC_RELAXED, __HIP_MEMORY_SCOPE_WORKGROUP);
        }
        LDS_WAIT(); asm volatile("" ::: "memory");
        const unsigned c0 = hist[255 - 4 * lane], c1 = hist[254 - 4 * lane], c2 = hist[253 - 4 * lane], c3 = hist[252 - 4 * lane];
        const unsigned tot = c0 + c1 + c2 + c3, incl = wave_incl_scan(tot, lane), excl = incl - tot;
        const bool here = (excl < need) && (need <= incl);
        unsigned bin = 0u, above = 0u;
        if (here) { const unsigned r = need - excl;
            if (r <= c0) { bin = 255u - 4u * lane; above = excl; }
            else if (r <= c0 + c1) { bin = 254u - 4u * lane; above = excl + c0; }
            else if (r <= c0 + c1 + c2) { bin = 253u - 4u * lane; above = excl + c0 + c1; }
            else { bin = 252u - 4u * lane; above = excl + c0 + c1 + c2; } }
        const unsigned long long mk = __ballot(here);
        const int src = mk ? (__ffsll((long long)mk) - 1) : 0;
        bin = __shfl(bin, src); above = __shfl(above, src);
        need -= above; prefix = (prefix << 8) | bin;
        LDS_WAIT(); asm volatile("" ::: "memory");
    }
    const unsigned T = prefix;
    const unsigned long long lt = (1ull << lane) - 1ull;
    unsigned running = 0u, eq_taken = 0u;
    for (int i = lane; i < nr; i += 64) {
        const bool ok = i < n; const unsigned key = ok ? f2key(s[i]) : 0u;
        const bool gt = ok && key > T, eq = ok && key == T;
        const unsigned long long em = __ballot(eq);
        const unsigned er = eq_taken + (unsigned)__popcll(em & lt);
        const bool sel = gt || (eq && er < need);
        const unsigned long long sm = __ballot(sel);
        const unsigned pos = running + (unsigned)__popcll(sm & lt);
        if (sel && pos < 256u) out[pos] = (OT)i;
        running += (unsigned)__popcll(sm); eq_taken += (unsigned)__popcll(em);
    }
}

__device__ __forceinline__ void attn_prompt_query(LAS unsigned char* wl, const bf16* P1, const unsigned short* IDXP, bf16* YA, int m, int lane) {
    const int b = m / LP, t = m - b * LP, cnt = (t + 1) < 256 ? (t + 1) : 256, ntile = (cnt + 15) >> 4;
    LAS float* Pl = (LAS float*)wl; LAS unsigned short* idl = (LAS unsigned short*)(wl + 16384); LAS float* linv = (LAS float*)(wl + 16896);
    { const v2u w = *(const v2u*)(IDXP + (size_t)m * 256 + 4 * lane); const int s0 = 4 * lane;
      const unsigned i0 = (s0 + 0 < cnt) ? (w.x & 0xffffu) : 0u, i1 = (s0 + 1 < cnt) ? (w.x >> 16) : 0u, i2 = (s0 + 2 < cnt) ? (w.y & 0xffffu) : 0u, i3 = (s0 + 3 < cnt) ? (w.y >> 16) : 0u;
      *(LAS v2u*)(idl + s0) = (v2u){i0 | (i1 << 16), i2 | (i3 << 16)}; }
    const int n = lane & 15, kg = lane >> 4;
    bf16x8 bq[8];
#pragma unroll
    for (int s = 0; s < 8; ++s) { bq[s] = (bf16x8){0, 0, 0, 0, 0, 0, 0, 0};
        if ((n >> 2) == (s >> 1)) bq[s] = *(const bf16x8*)(P1 + (size_t)m * LDP1 + C_Q + n * 64 + 32 * (s & 1) + 8 * kg); }
    LDS_WAIT(); asm volatile("" ::: "memory");
    const bf16* Kb = P1 + (size_t)b * LP * LDP1 + C_K + 8 * kg;
    f32x4 S[16];
    float mx = -INFINITY;
#pragma unroll
    for (int jt = 0; jt < 16; ++jt) {
        S[jt] = (f32x4){-INFINITY, -INFINITY, -INFINITY, -INFINITY};
        if (jt < ntile) {
            const int row = idl[16 * jt + n];
            const bf16* kr = Kb + (size_t)row * LDP1;
            f32x4 acc = {0.f, 0.f, 0.f, 0.f};
#pragma unroll
            for (int s = 0; s < 8; ++s) acc = __builtin_amdgcn_mfma_f32_16x16x32_bf16(*(const bf16x8*)(kr + 32 * s), bq[s], acc, 0, 0, 0);
#pragma unroll
            for (int i = 0; i < 4; ++i) { const float v = (16 * jt + 4 * kg + i < cnt) ? acc[i] * 0.125f : -INFINITY; S[jt][i] = v; mx = fmaxf(mx, v); }
        }
    }
    mx = fmaxf(mx, __shfl_xor(mx, 16)); mx = fmaxf(mx, __shfl_xor(mx, 32));
    float sum = 0.f;
#pragma unroll
    for (int jt = 0; jt < 16; ++jt)
        if (jt < ntile) {
#pragma unroll
            for (int i = 0; i < 4; ++i) { const float p = __expf(S[jt][i] - mx); sum += p; Pl[(16 * jt + 4 * kg + i) * 16 + n] = p; }
        }
    sum += __shfl_xor(sum, 16); sum += __shfl_xor(sum, 32);
    if (kg == 0) linv[n] = 1.0f / sum;
    LDS_WAIT(); asm volatile("" ::: "memory");
    const int g = lane >> 4;
    float o[4][4];
#pragma unroll
    for (int a = 0; a < 4; ++a)
#pragma unroll
        for (int c = 0; c < 4; ++c) o[a][c] = 0.f;
    const bf16* Vb = P1 + (size_t)b * LP * LDP1 + C_V + 4 * lane;
    const int nk = 16 * ntile;
#pragma unroll 8
    for (int key = 0; key < nk; ++key) {
        const int row = idl[key];
        const v2u w = *(const v2u*)(Vb + (size_t)row * LDP1);
        const f32x4 p = *(const LAS f32x4*)(Pl + key * 16 + 4 * g);
        const float v0 = __uint_as_float(w.x << 16), v1 = __uint_as_float(w.x & 0xffff0000u), v2 = __uint_as_float(w.y << 16), v3 = __uint_as_float(w.y & 0xffff0000u);
#pragma unroll
        for (int a = 0; a < 4; ++a) { o[a][0] += p[a] * v0; o[a][1] += p[a] * v1; o[a][2] += p[a] * v2; o[a][3] += p[a] * v3; }
    }
#pragma unroll
    for (int a = 0; a < 4; ++a) { const float li = linv[4 * g + a];
        *(v2u*)(YA + (size_t)m * D + (4 * g + a) * 64 + 4 * (lane & 15)) = (v2u){pk2(o[a][0] * li, o[a][1] * li), pk2(o[a][2] * li, o[a][3] * li)}; }
    LDS_WAIT(); asm volatile("" ::: "memory");
}

__device__ __forceinline__ void attn_sample_query(LAS unsigned char* lds, int tid, const bf16* P1, const float* ck, const float* cv, const int* ptab, const int* IDXS, bf16* YA, int qi) {
    const int lane = tid & 63, wave = tid >> 6, bd = qi >> 3; const size_t m = (size_t)MP + qi;
    LAS float* Sl = (LAS float*)lds;
    LAS float* Ol = Sl + 16 * 256;
    LAS float* ql = Ol + 8 * 1024;
    LAS float* linv = ql + 1024;
    LAS int* rowsel = (LAS int*)(linv + 16);
    { const unsigned w = *(const unsigned*)(P1 + m * LDP1 + C_Q + 2 * tid); ql[2 * tid] = __uint_as_float(w << 16); ql[2 * tid + 1] = __uint_as_float(w & 0xffff0000u); }
    if (tid < 256) rowsel[tid] = IDXS[qi * 256 + tid];
    __syncthreads();
    const int g = lane >> 4, c = lane & 15;
    float qr[4][4];
#pragma unroll
    for (int a = 0; a < 4; ++a) { const f32x4 t = *(const LAS f32x4*)(ql + (4 * g + a) * 64 + 4 * c); qr[a][0] = t.x; qr[a][1] = t.y; qr[a][2] = t.z; qr[a][3] = t.w; }
#pragma unroll 4
    for (int kk = 0; kk < 32; ++kk) {
        const int key = 32 * wave + kk, idx = rowsel[key];
        f32x4 kv;
        if (idx < PAST) { const int page = ptab[bd * NPAGES + (idx >> 7)]; kv = *(const f32x4*)(ck + ((size_t)page * PAGE + (idx & 127)) * 256 + 4 * lane); }
        else { const v2u w = *(const v2u*)(P1 + (size_t)(MP + bd * DS + (idx - PAST)) * LDP1 + C_K + 4 * lane);
            kv = (f32x4){__uint_as_float(w.x << 16), __uint_as_float(w.x & 0xffff0000u), __uint_as_float(w.y << 16), __uint_as_float(w.y & 0xffff0000u)}; }
        float part[4];
#pragma unroll
        for (int a = 0; a < 4; ++a) { float s = (qr[a][0] * kv.x + qr[a][1] * kv.y) + (qr[a][2] * kv.z + qr[a][3] * kv.w);
            s += __shfl_xor(s, 1); s += __shfl_xor(s, 2); s += __shfl_xor(s, 4); s += __shfl_xor(s, 8); part[a] = s; }
        if (c == 0) {
#pragma unroll
            for (int a = 0; a < 4; ++a) Sl[(4 * g + a) * 256 + key] = part[a] * 0.125f; }
    }
    __syncthreads();
#pragma unroll
    for (int hs = 0; hs < 2; ++hs) { const int head = 2 * wave + hs; float v[4]; float mx = -INFINITY;
#pragma unroll
        for (int j = 0; j < 4; ++j) { v[j] = Sl[head * 256 + lane + 64 * j]; mx = fmaxf(mx, v[j]); }
        mx = wave_max(mx); float sum = 0.f;
#pragma unroll
        for (int j = 0; j < 4; ++j) { v[j] = __expf(v[j] - mx); sum += v[j]; Sl[head * 256 + lane + 64 * j] = v[j]; }
        sum = wave_sum(sum);
        if (lane == 0) linv[head] = 1.0f / sum; }
    __syncthreads();
    float o[4][4];
#pragma unroll
    for (int a = 0; a < 4; ++a)
#pragma unroll
        for (int cc = 0; cc < 4; ++cc) o[a][cc] = 0.f;
#pragma unroll 4
    for (int kk = 0; kk < 32; ++kk) {
        const int key = 32 * wave + kk, idx = rowsel[key];
        f32x4 vv;
        if (idx < PAST) { const int page = ptab[bd * NPAGES + (idx >> 7)]; vv = *(const f32x4*)(cv + ((size_t)page * PAGE + (idx & 127)) * 256 + 4 * lane); }
        else { const v2u w = *(const v2u*)(P1 + (size_t)(MP + bd * DS + (idx - PAST)) * LDP1 + C_V + 4 * lane);
            vv = (f32x4){__uint_as_float(w.x << 16), __uint_as_float(w.x & 0xffff0000u), __uint_as_float(w.y << 16), __uint_as_float(w.y & 0xffff0000u)}; }
#pragma unroll
        for (int a = 0; a < 4; ++a) { const float p = Sl[(4 * g + a) * 256 + key]; o[a][0] += p * vv.x; o[a][1] += p * vv.y; o[a][2] += p * vv.z; o[a][3] += p * vv.w; }
    }
#pragma unroll
    for (int a = 0; a < 4; ++a) *(LAS f32x4*)(Ol + wave * 1024 + (4 * g + a) * 64 + 4 * c) = (f32x4){o[a][0], o[a][1], o[a][2], o[a][3]};
    __syncthreads();
    { float s0 = 0.f, s1 = 0.f;
#pragma unroll
      for (int w = 0; w < 8; ++w) { s0 += Ol[w * 1024 + 2 * tid]; s1 += Ol[w * 1024 + 2 * tid + 1]; }
      const float li = linv[(2 * tid) >> 6];
      *(unsigned*)(YA + m * D + 2 * tid) = pk2(s0 * li, s1 * li); }
    __syncthreads();
}

constexpr int NPH = 11, NPHASES = 1 + 2 * NPH;
struct Args { const void* in[24]; float* out; unsigned char* ws; int l_lo, l_hi; };
static_assert(sizeof(Args) == 24 * 8 + 8 + 8 + 8, "Args has no padding");

template <int KLO, int KHI>
__global__ void __launch_bounds__(NT, 2) fwd_t(Args args) {
    extern __shared__ __attribute__((aligned(16))) unsigned char lds_raw[];
    LAS unsigned char* lds = (LAS unsigned char*)lds_raw;
    volatile LAS unsigned* MISCW = (volatile LAS unsigned*)(lds + MISC_OFF);
    const int tid = threadIdx.x, lane = tid & 63, wave = __builtin_amdgcn_readfirstlane(tid >> 6);
    const int G = gridDim.x, bx = blockIdx.x, gw = bx * NWAVES + wave, NGW = G * NWAVES;
    unsigned char* ws = args.ws;
    unsigned* ctl = (unsigned*)(ws + WS_CTL);
    for (int u = tid; u < (LDS_BYTES - LDSCTL_OFF) / 4; u += NT) ((LAS unsigned*)(lds + LDSCTL_OFF))[u] = 0u;
    __syncthreads();
    XcdBarrier bar = xcd_barrier_post(ctl + CW_BAR, MISCW + 8);
#define IN(k) (KLO <= (k) && (k) < KHI)
#define SEAM(k) do { if (IN(k) && IN((k) + 1)) xcd_barrier(bar); } while (0)

    const float* x_prompt = (const float*)args.in[0]; const float* x_sample = (const float*)args.in[1];
    const float* cache_k = (const float*)args.in[2]; const float* cache_v = (const float*)args.in[3]; const float* cache_ki = (const float*)args.in[4];
    const float* state_ssm = (const float*)args.in[5]; const float* state_conv = (const float*)args.in[6]; const int* page_table = (const int*)args.in[7];
    const float* meta = (const float*)args.in[8]; const float* norm1_w = (const float*)args.in[9]; const float* w_in = (const float*)args.in[10];
    const float* conv_w = (const float*)args.in[11]; const float* conv_b = (const float*)args.in[12]; const float* dt_bias = (const float*)args.in[13];
    const float* a_log = (const float*)args.in[14]; const float* d_skip = (const float*)args.in[15]; const float* ssm_norm_w = (const float*)args.in[16];
    const float* w_ssm = (const float*)args.in[17]; const float* w_att = (const float*)args.in[18]; const float* w_out = (const float*)args.in[19];
    const float* norm2_w = (const float*)args.in[20]; const float* w_up = (const float*)args.in[21]; const float* w_down = (const float*)args.in[22];
    const float* final_w = (const float*)args.in[23];
    float* out = args.out;
    float* H = (float*)(ws + WS_H); bf16* U = (bf16*)(ws + WS_U); bf16* P1 = (bf16*)(ws + WS_P1); float* MISCB = (float*)(ws + WS_MISC); bf16* KIB = (bf16*)(ws + WS_KIB);
    bf16* XC = (bf16*)(ws + WS_XC); float* DT = (float*)(ws + WS_DT); float* DA = (float*)(ws + WS_DA); float* YS = (float*)(ws + WS_YS); bf16* YSN = (bf16*)(ws + WS_YSN);
    bf16* YA = (bf16*)(ws + WS_YA); float* T1 = (float*)(ws + WS_T1); bf16* MG = (bf16*)(ws + WS_MG); bf16* A2 = (bf16*)(ws + WS_A2);
    unsigned short* IDXP = (unsigned short*)(ws + WS_IDXP); int* IDXS = (int*)(ws + WS_IDXS); float* SCS = (float*)(ws + WS_SCS);

    if (IN(0) && args.l_lo == 0) {
        LAS float* scr = (LAS float*)(lds + wave * 16384);
        constexpr int I_IN = (D / 64) * (NIN / 32), I_SSM = (DIN / 64) * (D / 32), I_ATT = (D / 64) * (D / 32), I_OUT = I_ATT, I_UP = (D / 64) * (DFF / 32), I_DN = (DFF / 64) * (D / 32);
        constexpr int I_L = I_IN + I_SSM + I_ATT + I_OUT + I_UP + I_DN;
        for (int it = gw; it < 2 * I_L; it += NGW) {
            const int l = it / I_L; int r = it % I_L; unsigned char* wl = ws + WS_W + (size_t)l * WL_SIZE;
            if (r < I_IN) { tr_item(w_in + (size_t)l * D * IN_DIM, D, IN_DIM, (bf16*)(wl + WL_WIN), NIN / 32, true, scr, r, lane); continue; } r -= I_IN;
            if (r < I_SSM) { tr_item(w_ssm + (size_t)l * DIN * D, DIN, D, (bf16*)(wl + WL_WSSM), D / 32, false, scr, r, lane); continue; } r -= I_SSM;
            if (r < I_ATT) { tr_item(w_att + (size_t)l * D * D, D, D, (bf16*)(wl + WL_WATT), D / 32, false, scr, r, lane); continue; } r -= I_ATT;
            if (r < I_OUT) { tr_item(w_out + (size_t)l * D * D, D, D, (bf16*)(wl + WL_WOUT), D / 32, false, scr, r, lane); continue; } r -= I_OUT;
            if (r < I_UP) { tr_item(w_up + (size_t)l * D * DFF, D, DFF, (bf16*)(wl + WL_WUP), DFF / 32, false, scr, r, lane); continue; } r -= I_UP;
            tr_item(w_down + (size_t)l * DFF * D, DFF, D, (bf16*)(wl + WL_WDN), D / 32, false, scr, r, lane);
        }
        for (int m = gw; m < MPAD; m += NGW) {
            const float* src = nullptr;
            if (m < MP) { const int b = m / LP, t = m - b * LP; src = t < NMETA ? meta + (size_t)t * D : x_prompt + ((size_t)b * SEQ + (t - NMETA)) * D; }
            else if (m < MR) src = x_sample + (size_t)(m - MP) * D;
            rms_row(src, norm1_w, H + (size_t)m * D, U + (size_t)m * D, nullptr, lane);
        }
    }
    SEAM(0);

    for (int l = args.l_lo; l < args.l_hi; ++l) {
        constexpr int pb = 1;
        unsigned char* wl = ws + WS_W + (size_t)l * WL_SIZE;
        const float* ck = cache_k + (size_t)l * NPOOL * PAGE * 256; const float* cv = cache_v + (size_t)l * NPOOL * PAGE * 256; const float* cki = cache_ki + (size_t)l * NPOOL * PAGE * 64;

        if (IN(pb + 0)) {
            pg8::Gemm gm{U, (const bf16*)(wl + WL_WIN), MPAD, NIN, D}; pg8::StaticOrder S; S.init(MPAD, NIN, G, bx);
            pg8::EpiIn E{P1, MISCB, KIB, out + O_PK + (size_t)l * MP * 256, out + O_PV + (size_t)l * MP * 256, out + O_PKI + (size_t)l * MP * 64,
                         out + O_SK + (size_t)l * MS * 256, out + O_SV + (size_t)l * MS * 256, out + O_SKI + (size_t)l * MS * 64};
            pg8::gemm_phase<pg8::EpiIn, pg8::StaticOrder, true, true>(lds, gm, S, E);
        }
        SEAM(pb + 0);

        if (IN(pb + 1)) {
            for (size_t it = (size_t)bx * NT + tid; it < (size_t)MR * 384; it += (size_t)G * NT) {
                const int m = (int)(it / 384), c8 = (int)(it % 384) * 8;
                const bool isS = m >= MP; int tpos, sq;
                if (!isS) { sq = m / LP; tpos = m - sq * LP; } else { sq = (m - MP) >> 3; tpos = (m - MP) & 7; }
                float xv[4][8];
#pragma unroll
                for (int k = 0; k < 4; ++k) { const int dtp = tpos - 3 + k;
                    if (dtp >= 0) unpack8(*(const v4u*)(P1 + (size_t)(m - 3 + k) * LDP1 + C_XBC + c8), xv[k]);
                    else if (isS) { const float* pp = state_conv + ((size_t)(l * DB + sq) * 3 + (3 + dtp)) * CONVD + c8; const f32x4 a = *(const f32x4*)pp, b = *(const f32x4*)(pp + 4);
                        xv[k][0] = a.x; xv[k][1] = a.y; xv[k][2] = a.z; xv[k][3] = a.w; xv[k][4] = b.x; xv[k][5] = b.y; xv[k][6] = b.z; xv[k][7] = b.w; }
                    else {
#pragma unroll
                        for (int j = 0; j < 8; ++j) xv[k][j] = 0.f; } }
                float y[8];
                { const float* bp = conv_b + (size_t)l * CONVD + c8; const f32x4 a = *(const f32x4*)bp, b = *(const f32x4*)(bp + 4);
                  y[0] = a.x; y[1] = a.y; y[2] = a.z; y[3] = a.w; y[4] = b.x; y[5] = b.y; y[6] = b.z; y[7] = b.w; }
#pragma unroll
                for (int k = 0; k < 4; ++k) { const float* wp = conv_w + ((size_t)l * 4 + k) * CONVD + c8; const f32x4 a = *(const f32x4*)wp, b = *(const f32x4*)(wp + 4);
                    y[0] += xv[k][0] * a.x; y[1] += xv[k][1] * a.y; y[2] += xv[k][2] * a.z; y[3] += xv[k][3] * a.w; y[4] += xv[k][4] * b.x; y[5] += xv[k][5] * b.y; y[6] += xv[k][6] * b.z; y[7] += xv[k][7] * b.w; }
#pragma unroll
                for (int j = 0; j < 8; ++j) y[j] = y[j] * sigm(y[j]);
                *(v4u*)(XC + (size_t)m * CONVD + c8) = (v4u){pk2(y[0], y[1]), pk2(y[2], y[3]), pk2(y[4], y[5]), pk2(y[6], y[7])};
                float* cs = nullptr;
                if (!isS && tpos >= LP - 3) cs = out + O_PCONV + ((size_t)(l * NB + sq) * 3 + (tpos - (LP - 3))) * CONVD + c8;
                if (isS && tpos >= DS - 3) cs = out + O_SCONV + ((size_t)(l * DB + sq) * 3 + (tpos - (DS - 3))) * CONVD + c8;
                if (cs) { *(f32x4*)cs = (f32x4){xv[3][0], xv[3][1], xv[3][2], xv[3][3]}; *(f32x4*)(cs + 4) = (f32x4){xv[3][4], xv[3][5], xv[3][6], xv[3][7]}; }
            }
            for (int it = bx * NT + tid; it < MR * NH; it += G * NT) {
                const int m = it >> 5, h = it & 31;
                const float raw = MISCB[(size_t)m * 128 + MC_DT + h] + dt_bias[l * NH + h];
                const float sp = fmaxf(raw, 0.f) + log1pf(__expf(-fabsf(raw)));
                const float A = -__expf(a_log[l * NH + h]);
                DT[it] = sp; DA[it] = __expf(sp * A);
            }
            {
                constexpr int SLD = 4128;
                LAS float* scl = (LAS float*)lds; LAS unsigned* hist = (LAS unsigned*)(lds + 8 * SLD * 4) + wave * 256;
                for (int unit = bx; unit < NB * (LP / 8); unit += G) {
                    const int b = unit / (LP / 8), qb = unit % (LP / 8);
                    const size_t mq0 = (size_t)b * LP + 8 * qb; const int nkeys = 8 * qb + 8, ntl = (nkeys + 31) >> 5;
                    bf16x8 afr[2][4]; float wq[2][2][8];
                    idx_load_q(P1, MISCB, mq0, lane, afr, wq);
                    const int kcol = lane & 31, hh = lane >> 5;
                    for (int kt = wave; kt < ntl; kt += NWAVES) {
                        const int key = 32 * kt + kcol;
                        const bf16* kp = KIB + ((size_t)b * LP + key) * 64 + 8 * hh;
                        bf16x8 bfr[4];
#pragma unroll
                        for (int ks = 0; ks < 4; ++ks) bfr[ks] = *(const bf16x8*)(kp + 16 * ks);
                        float sc[2][2];
                        idx_scores(afr, bfr, wq, sc);
#pragma unroll
                        for (int rt = 0; rt < 2; ++rt)
#pragma unroll
                            for (int jq = 0; jq < 2; ++jq) scl[(4 * rt + 2 * hh + jq) * SLD + key] = sc[rt][jq];
                    }
                    __syncthreads();
                    { const int t = 8 * qb + wave, n = t + 1; unsigned short* op = IDXP + ((size_t)b * LP + t) * 256;
                      if (n <= 256) { for (int i = lane; i < n; i += 64) op[i] = (unsigned short)i; }
                      else topk_select((const LAS float*)(scl + wave * SLD), n, hist, lane, op); }
                    __syncthreads();
                }
            }
            for (int unit = bx; unit < DB * 8; unit += G) {
                const int bd = unit >> 3, ch = unit & 7; const size_t mq0 = (size_t)MP + bd * DS;
                bf16x8 afr[2][4]; float wq[2][2][8];
                idx_load_q(P1, MISCB, mq0, lane, afr, wq);
                const int kcol = lane & 31, hh = lane >> 5;
                const int pg = 8 * ch + wave, phys = page_table[bd * NPAGES + pg];
                const float* kbase = cki + (size_t)phys * PAGE * 64;
#pragma unroll 1
                for (int kt = 0; kt < 4; ++kt) {
                    const int kin = 32 * kt + kcol; const float* kp = kbase + (size_t)kin * 64 + 8 * hh;
                    bf16x8 bfr[4];
#pragma unroll
                    for (int ks = 0; ks < 4; ++ks) { const f32x4 a = *(const f32x4*)(kp + 16 * ks), bq = *(const f32x4*)(kp + 16 * ks + 4);
                        const v4u w = (v4u){pk2(a.x, a.y), pk2(a.z, a.w), pk2(bq.x, bq.y), pk2(bq.z, bq.w)}; bfr[ks] = __builtin_bit_cast(bf16x8, w); }
                    float sc[2][2];
                    idx_scores(afr, bfr, wq, sc);
#pragma unroll
                    for (int rt = 0; rt < 2; ++rt)
#pragma unroll
                        for (int jq = 0; jq < 2; ++jq) SCS[(size_t)(bd * DS + 4 * rt + 2 * hh + jq) * SCS_LD + 128 * pg + kin] = sc[rt][jq];
                }
                if (ch == 7 && wave == 0) {
                    const int j = kcol < DS ? kcol : DS - 1; const bf16* kp = KIB + (mq0 + j) * 64 + 8 * hh;
                    bf16x8 bfr[4];
#pragma unroll
                    for (int ks = 0; ks < 4; ++ks) bfr[ks] = *(const bf16x8*)(kp + 16 * ks);
                    float sc[2][2];
                    idx_scores(afr, bfr, wq, sc);
                    if (kcol < DS) {
#pragma unroll
                        for (int rt = 0; rt < 2; ++rt)
#pragma unroll
                            for (int jq = 0; jq < 2; ++jq) { const int q = 4 * rt + 2 * hh + jq; SCS[(size_t)(bd * DS + q) * SCS_LD + PAST + kcol] = (kcol <= q) ? sc[rt][jq] : -INFINITY; }
                    }
                }
            }
        }
        SEAM(pb + 1);

        if (IN(pb + 2)) {
            for (int qi = bx; qi < MS; qi += G) {
                LAS float* scl = (LAS float*)lds; LAS unsigned* hist = (LAS unsigned*)(lds + 8448 * 4);
                for (int i = tid; i < PAST + DS; i += NT) scl[i] = SCS[(size_t)qi * SCS_LD + i];
                __syncthreads();
                if (wave == 0) topk_select((const LAS float*)scl, PAST + DS, hist, lane, IDXS + qi * 256);
                __syncthreads();
            }
            for (int unit = bx; unit < NB * NH * 2; unit += G) {
                const int b = unit >> 6, h = (unit >> 1) & 31, p0 = (unit & 1) * 32;
                ssd_unit(lds, tid, XC, DT, DA, (size_t)b * LP, LP, h, p0, nullptr, out + O_PSSM + ((size_t)(l * NB + b) * NH + h) * HP * NST, YS, d_skip[l * NH + h]);
                __syncthreads();
            }
            for (int unit = bx; unit < DB * NH * 2; unit += G) {
                const int bd = unit >> 6, h = (unit >> 1) & 31, p0 = (unit & 1) * 32;
                ssd_unit(lds, tid, XC, DT, DA, (size_t)MP + bd * DS, DS, h, p0, state_ssm + ((size_t)(l * DB + bd) * NH + h) * HP * NST,
                         out + O_SSSM + ((size_t)(l * DB + bd) * NH + h) * HP * NST, YS, d_skip[l * NH + h]);
                __syncthreads();
            }
        }
        SEAM(pb + 2);

        if (IN(pb + 3)) {
            for (int it = gw; it < MR * NG; it += NGW) {
                const int m = it >> 2, g = it & 3, c0 = g * 512 + lane * 8;
                const float* yp = YS + (size_t)m * DIN + c0; const f32x4 a = *(const f32x4*)yp, b = *(const f32x4*)(yp + 4);
                float z[8]; unpack8(*(const v4u*)(P1 + (size_t)m * LDP1 + C_Z + c0), z);
                float v[8] = {a.x, a.y, a.z, a.w, b.x, b.y, b.z, b.w}; float ss = 0.f;
#pragma unroll
                for (int j = 0; j < 8; ++j) { v[j] = v[j] * (z[j] * sigm(z[j])); ss += v[j] * v[j]; }
                ss = wave_sum(ss);
                const float rstd = 1.0f / sqrtf(ss * (1.0f / 512.0f) + 1e-6f);
                const float* wp = ssm_norm_w + (size_t)l * DIN + c0; const f32x4 wa = *(const f32x4*)wp, wb = *(const f32x4*)(wp + 4);
                *(v4u*)(YSN + (size_t)m * DIN + c0) = (v4u){pk2(v[0] * rstd * wa.x, v[1] * rstd * wa.y), pk2(v[2] * rstd * wa.z, v[3] * rstd * wa.w), pk2(v[4] * rstd * wb.x, v[5] * rstd * wb.y), pk2(v[6] * rstd * wb.z, v[7] * rstd * wb.w)};
            }
            for (int qi = bx; qi < MS; qi += G) attn_sample_query(lds, tid, P1, ck, cv, page_table, IDXS, YA, qi);
            for (int m = gw; m < MP; m += NGW) attn_prompt_query(lds + wave * 17408, P1, IDXP, YA, m, lane);
        }
        SEAM(pb + 3);

        if (IN(pb + 4)) {
            pg8::Gemm gm{YSN, (const bf16*)(wl + WL_WSSM), MPAD, D, DIN}; pg8::StaticOrder S; S.init(MPAD, D, G, bx);
            pg8::EpiGate1 E{P1, T1};
            pg8::gemm_phase<pg8::EpiGate1, pg8::StaticOrder, true, true>(lds, gm, S, E);
        }
        SEAM(pb + 4);
        if (IN(pb + 5)) {
            pg8::Gemm gm{YA, (const bf16*)(wl + WL_WATT), MPAD, D, D}; pg8::StaticOrder S; S.init(MPAD, D, G, bx);
            pg8::EpiGate2 E{P1, T1, MG};
            pg8::gemm_phase<pg8::EpiGate2, pg8::StaticOrder, true, true>(lds, gm, S, E);
        }
        SEAM(pb + 5);
        if (IN(pb + 6)) {
            pg8::Gemm gm{MG, (const bf16*)(wl + WL_WOUT), MPAD, D, D}; pg8::StaticOrder S; S.init(MPAD, D, G, bx);
            pg8::EpiResid E{H};
            pg8::gemm_phase<pg8::EpiResid, pg8::StaticOrder, true, true>(lds, gm, S, E);
        }
        SEAM(pb + 6);
        if (IN(pb + 7)) {
            for (int m = gw; m < MPAD; m += NGW) rms_row(H + (size_t)m * D, norm2_w + (size_t)l * D, nullptr, U + (size_t)m * D, nullptr, lane);
        }
        SEAM(pb + 7);
        if (IN(pb + 8)) {
            pg8::Gemm gm{U, (const bf16*)(wl + WL_WUP), MPAD, DFF, D}; pg8::StaticOrder S; S.init(MPAD, DFF, G, bx);
            pg8::EpiUp E{A2};
            pg8::gemm_phase<pg8::EpiUp, pg8::StaticOrder, true, true>(lds, gm, S, E);
        }
        SEAM(pb + 8);
        if (IN(pb + 9)) {
            pg8::Gemm gm{A2, (const bf16*)(wl + WL_WDN), MPAD, D, DFF}; pg8::StaticOrder S; S.init(MPAD, D, G, bx);
            pg8::EpiResid E{H};
            pg8::gemm_phase<pg8::EpiResid, pg8::StaticOrder, true, true>(lds, gm, S, E);
        }
        SEAM(pb + 9);
        if (IN(pb + 10)) {
            if (l == 0) { for (int m = gw; m < MPAD; m += NGW) rms_row(H + (size_t)m * D, norm1_w + D, nullptr, U + (size_t)m * D, nullptr, lane); }
            else {
                for (int m = gw; m < MR; m += NGW) {
                    float* dst = nullptr;
                    if (m < MP) { const int b = m / LP, t = m - b * LP; if (t >= NMETA) dst = out + O_YP + ((size_t)b * SEQ + (t - NMETA)) * D; }
                    else dst = out + O_YS + (size_t)(m - MP) * D;
                    if (dst) rms_row(H + (size_t)m * D, final_w, nullptr, nullptr, dst, lane);
                }
            }
        }
        if (IN(pb + 10) && IN(1) && l + 1 < args.l_hi) xcd_barrier(bar);
    }
#undef IN
#undef SEAM
}

#ifndef MK_PER_PHASE
#define MK_PER_PHASE 1
#endif
extern "C" void kernel_launch(void* const* d_in, const int* in_sizes, int n_in, void* d_out, int out_size, void* d_ws, size_t ws_size, hipStream_t stream) {
    static int grid = 0;
    if (grid == 0) {
        if (n_in != 24 || (size_t)out_size != O_END || ws_size < WS_END) { fprintf(stderr, "kernel_launch: unexpected shapes: n_in %d out %d (want %zu) ws %zu (want %zu)\n", n_in, out_size, (size_t)O_END, ws_size, (size_t)WS_END); grid = -1; return; }
        int dev = 0, cus = 0, per_cu = 0;
        if (hipGetDevice(&dev) != hipSuccess || hipDeviceGetAttribute(&cus, hipDeviceAttributeMultiprocessorCount, dev) != hipSuccess) { grid = -1; return; }
        bool ok = true;
#if MK_PER_PHASE
#define SETA(K) ok = ok && hipFuncSetAttribute((const void*)fwd_t<K, K + 1>, hipFuncAttributeMaxDynamicSharedMemorySize, LDS_BYTES) == hipSuccess
        SETA(0); SETA(1); SETA(2); SETA(3); SETA(4); SETA(5); SETA(6); SETA(7); SETA(8); SETA(9); SETA(10); SETA(11);
#else
        ok = hipFuncSetAttribute((const void*)fwd_t<0, NPH + 1>, hipFuncAttributeMaxDynamicSharedMemorySize, LDS_BYTES) == hipSuccess;
        ok = ok && hipOccupancyMaxActiveBlocksPerMultiprocessor(&per_cu, (const void*)fwd_t<0, NPH + 1>, NT, LDS_BYTES) == hipSuccess && per_cu >= 1;
#endif
        if (!ok) { fprintf(stderr, "kernel_launch: hipFuncSetAttribute / occupancy query failed (per_cu %d)\n", per_cu); (void)hipGetLastError(); grid = -1; return; }
        grid = cus;
    }
    if (grid < 0) return;
    (void)hipMemsetAsync((char*)d_ws + WS_CTL, 0, CTL_ZERO_BYTES, stream);
    Args a{};
    for (int i = 0; i < 24; ++i) a.in[i] = d_in[i];
    a.out = (float*)d_out; a.ws = (unsigned char*)d_ws;
#if MK_PER_PHASE
#define LAUNCH_PH(K) hipLaunchKernelGGL((fwd_t<K, K + 1>), dim3(grid), dim3(NT), LDS_BYTES, stream, a)
    a.l_lo = 0; a.l_hi = 1; LAUNCH_PH(0);
    for (int l = 0; l < 2; ++l) { a.l_lo = l; a.l_hi = l + 1;
        LAUNCH_PH(1); LAUNCH_PH(2); LAUNCH_PH(3); LAUNCH_PH(4); LAUNCH_PH(5); LAUNCH_PH(6); LAUNCH_PH(7); LAUNCH_PH(8); LAUNCH_PH(9); LAUNCH_PH(10); LAUNCH_PH(11); }
#else
    a.l_lo = 0; a.l_hi = 2; hipLaunchKernelGGL((fwd_t<0, NPH + 1>), dim3(grid), dim3(NT), LDS_BYTES, stream, a);
#endif
}
```

```cpp
#include <hip/hip_runtime.h>
#include <cstdio>
#include <cstdint>
#define GAS __attribute__((address_space(1)))
#define LAS __attribute__((address_space(3)))

constexpr int D = 1024, NB = 4, SEQ = 4096, NMETA = 16, LP = SEQ + NMETA, MP = NB * LP, DB = 32, DS = 8, MS = DB * DS, MR = MP + MS, MPAD = 16896;
constexpr int DIN = 2048, CONVD = 3072, NH = 32, HP = 64, NG = 4, NST = 128;
constexpr int DFF = 4096, IN_DIM = 9320;
constexpr int PAST = 8192, PAGE = 128, NPAGES = 64, NPOOL = 2560;
constexpr int NIN = 9472, LDP1 = 9216;
constexpr int C_Z = 0, C_XBC = 2048, C_Q = 5120, C_K = 6144, C_V = 6400, C_QI = 6656, C_GS = 7168, C_GA = 8192;
constexpr int MC_KI = 0, MC_DT = 64, MC_WI = 96;
static_assert(MP == 16448 && MR == 16704 && MPAD % 256 == 0 && MPAD >= MR, "rows");
namespace pg8 {
#define PG8_LAS __attribute__((address_space(3)))
typedef unsigned short bf16_t;
typedef short bf16x8 __attribute__((ext_vector_type(8)));
typedef float f32x4 __attribute__((ext_vector_type(4)));
typedef unsigned u32x4 __attribute__((ext_vector_type(4)));
constexpr int BM = 256, BK = 64, HALF = 128, HTB = HALF * BK * 2  , STAGE_BYTES = 8 * HTB, NXCD = 8, WGM = 8;

__host__ __device__ __forceinline__ int lds_byte(int r, int c) { const int st = (r >> 4) * 2 + (c >> 5), rr = r & 15, cc = c & 31, ob = rr * 64 + cc * 2; return st * 1024 + (ob ^ (((ob >> 9) & 1) << 5)); }
__host__ __device__ __forceinline__ void stage_rc(int b, int& R, int& C) { const int st = b / 1024, sb = b % 1024, swz = sb ^ (((sb >> 9) & 1) << 5); R = (st >> 1) * 16 + swz / 64; C = (st & 1) * 32 + (swz % 64) / 2; }
__host__ __device__ __forceinline__ int perm32(int rho) { const int n = rho >> 4, i = rho & 15; return 8 * (i >> 2) + 4 * n + (i & 3); }

struct Unit { int pm, pn; };
struct Gemm { const GAS bf16_t* A; const GAS bf16_t* Bt; int M, N, K; };

struct StaticOrder {
    int nM, nN, nwg, G, c;
    __host__ __device__ void init(int M, int N, int G_, int c_) { nM = M / BM; nN = N / BM; nwg = nM * nN; G = G_; c = c_; }
    __host__ __device__ bool next(int i, Unit& u) const {
        const long L = (long)i * G + c; if (L >= nwg) return false;
        int wgid = (int)L; { const int q = nwg / NXCD, r = nwg % NXCD, xcd = wgid % NXCD, off = wgid / NXCD; wgid = (xcd < r ? xcd * (q + 1) : r * (q + 1) + (xcd - r) * q) + off; }
        const int nig = WGM * nN, gid = wgid / nig, fm = gid * WGM, gsz = (nM - fm) < WGM ? (nM - fm) : WGM;
        u.pm = fm + ((wgid % nig) % gsz); u.pn = (wgid % nig) / gsz; return true;
    }
    __device__ __forceinline__ void a_ready(const Unit&) const {}
    __device__ __forceinline__ void done(const Unit&) const {}
};

__device__ __forceinline__ unsigned cvt_pk_bf16(float lo, float hi) { unsigned r; asm volatile("v_cvt_pk_bf16_f32 %0, %1, %2" : "=v"(r) : "v"(lo), "v"(hi)); return r; }

__device__ __forceinline__ void unpack8(const u32x4 w, float (&f)[8]) {
    f[0] = __uint_as_float(w.x << 16); f[1] = __uint_as_float(w.x & 0xffff0000u); f[2] = __uint_as_float(w.y << 16); f[3] = __uint_as_float(w.y & 0xffff0000u);
    f[4] = __uint_as_float(w.z << 16); f[5] = __uint_as_float(w.z & 0xffff0000u); f[6] = __uint_as_float(w.w << 16); f[7] = __uint_as_float(w.w & 0xffff0000u);
}
__device__ __forceinline__ u32x4 pack8(const f32x4 v0, const f32x4 v1) { u32x4 w; w.x = cvt_pk_bf16(v0[0], v0[1]); w.y = cvt_pk_bf16(v0[2], v0[3]); w.z = cvt_pk_bf16(v1[0], v1[1]); w.w = cvt_pk_bf16(v1[2], v1[3]); return w; }
__device__ __forceinline__ float sigm(float x) { return __builtin_amdgcn_rcpf(1.0f + __expf(-x)); }

struct EpiIn {
    static constexpr bool PERM = true, AFTER_DRAIN = false;
    GAS bf16_t* P1; GAS bf16_t* kvb; GAS float* misc; GAS bf16_t* kib; GAS float *pk, *pv, *pki, *sk, *sv, *ski;
    __device__ __forceinline__ void operator()(const f32x4 (&acc)[2][2][4][2], const Unit& u, int wr, int wc, int fr, int fq) const {
        const int row0 = u.pm * BM + wr * 64 + fr, lc0 = wc * 32 + 8 * fq;
#pragma unroll
        for (int ai = 0; ai < 2; ++ai)
#pragma unroll
            for (int m = 0; m < 4; ++m) {
                const int row = row0 + ai * HALF + m * 16;
#pragma unroll
                for (int bj = 0; bj < 2; ++bj) {
                    const f32x4 v0 = acc[ai][bj][m][0], v1 = acc[ai][bj][m][1];
                    const int lc = lc0 + bj * HALF;
                    if (u.pn < 36) {
                        if (u.pn == 24 || u.pn == 25) *(GAS u32x4*)(kvb + (size_t)row * 512 + (u.pn - 24) * BM + lc) = pack8(v0, v1);
                        else *(GAS u32x4*)(P1 + (size_t)row * LDP1 + u.pn * BM + lc) = pack8(v0, v1);
                        if (u.pn == 24) {
                            if (row < MP) { GAS float* dst = pk + (size_t)row * 256 + lc; *(GAS f32x4*)dst = v0; *(GAS f32x4*)(dst + 4) = v1; }
                            else if (row < MR) { GAS float* dst = sk + (size_t)(row - MP) * 256 + lc; *(GAS f32x4*)dst = v0; *(GAS f32x4*)(dst + 4) = v1; }
                        } else if (u.pn == 25) {
                            if (row < MP) { GAS float* dst = pv + (size_t)row * 256 + lc; *(GAS f32x4*)dst = v0; *(GAS f32x4*)(dst + 4) = v1; }
                            else if (row < MR) { GAS float* dst = sv + (size_t)(row - MP) * 256 + lc; *(GAS f32x4*)dst = v0; *(GAS f32x4*)(dst + 4) = v1; }
                        }
                    } else {
                        if (lc < 128) { GAS float* d = misc + (size_t)row * 128 + lc; *(GAS f32x4*)d = v0; *(GAS f32x4*)(d + 4) = v1; }
                        if (lc < 64) {
                            *(GAS u32x4*)(kib + (size_t)row * 64 + lc) = pack8(v0, v1);
                            if (row < MP) { GAS float* dst = pki + (size_t)row * 64 + lc; *(GAS f32x4*)dst = v0; *(GAS f32x4*)(dst + 4) = v1; }
                            else if (row < MR) { GAS float* dst = ski + (size_t)(row - MP) * 64 + lc; *(GAS f32x4*)dst = v0; *(GAS f32x4*)(dst + 4) = v1; }
                        }
                    }
                }
            }
    }
};
struct EpiGate1 {
    static constexpr bool PERM = true, AFTER_DRAIN = false;
    const GAS bf16_t* P1; GAS bf16_t* T1;
    __device__ __forceinline__ void operator()(const f32x4 (&acc)[2][2][4][2], const Unit& u, int wr, int wc, int fr, int fq) const {
        const int row0 = u.pm * BM + wr * 64 + fr, col0 = u.pn * BM + wc * 32 + 8 * fq;
#pragma unroll
        for (int ai = 0; ai < 2; ++ai)
#pragma unroll
            for (int m = 0; m < 4; ++m) {
                const int row = row0 + ai * HALF + m * 16;
#pragma unroll
                for (int bj = 0; bj < 2; ++bj) {
                    const int col = col0 + bj * HALF;
                    float g[8]; unpack8(*(const GAS u32x4*)(P1 + (size_t)row * LDP1 + C_GS + col), g);
                    f32x4 v0 = acc[ai][bj][m][0], v1 = acc[ai][bj][m][1];
#pragma unroll
                    for (int e = 0; e < 4; ++e) { v0[e] *= sigm(g[e]); v1[e] *= sigm(g[4 + e]); }
                    *(GAS u32x4*)(T1 + (size_t)row * 1024 + col) = pack8(v0, v1);
                }
            }
    }
};
struct EpiGate2 {
    static constexpr bool PERM = true, AFTER_DRAIN = false;
    const GAS bf16_t* P1; const GAS bf16_t* T1; GAS bf16_t* MG;
    __device__ __forceinline__ void operator()(const f32x4 (&acc)[2][2][4][2], const Unit& u, int wr, int wc, int fr, int fq) const {
        const int row0 = u.pm * BM + wr * 64 + fr, col0 = u.pn * BM + wc * 32 + 8 * fq;
#pragma unroll
        for (int ai = 0; ai < 2; ++ai)
#pragma unroll
            for (int m = 0; m < 4; ++m) {
                const int row = row0 + ai * HALF + m * 16;
#pragma unroll
                for (int bj = 0; bj < 2; ++bj) {
                    const int col = col0 + bj * HALF;
                    float g[8]; unpack8(*(const GAS u32x4*)(P1 + (size_t)row * LDP1 + C_GA + col), g);
                    float tt[8]; unpack8(*(const GAS u32x4*)(T1 + (size_t)row * 1024 + col), tt); const f32x4 t0 = (f32x4){tt[0], tt[1], tt[2], tt[3]}, t1 = (f32x4){tt[4], tt[5], tt[6], tt[7]};
                    f32x4 v0 = acc[ai][bj][m][0], v1 = acc[ai][bj][m][1];
#pragma unroll
                    for (int e = 0; e < 4; ++e) { v0[e] = t0[e] + v0[e] * sigm(g[e]); v1[e] = t1[e] + v1[e] * sigm(g[4 + e]); }
                    *(GAS u32x4*)(MG + (size_t)row * 1024 + col) = pack8(v0, v1);
                }
            }
    }
};
struct EpiResid {
    static constexpr bool PERM = true, AFTER_DRAIN = false;
    GAS float* H;
    __device__ __forceinline__ void operator()(const f32x4 (&acc)[2][2][4][2], const Unit& u, int wr, int wc, int fr, int fq) const {
        const int row0 = u.pm * BM + wr * 64 + fr, col0 = u.pn * BM + wc * 32 + 8 * fq;
#pragma unroll
        for (int ai = 0; ai < 2; ++ai)
#pragma unroll
            for (int m = 0; m < 4; ++m) {
                const int row = row0 + ai * HALF + m * 16;
#pragma unroll
                for (int bj = 0; bj < 2; ++bj) {
                    GAS float* d = H + (size_t)row * 1024 + col0 + bj * HALF;
                    const f32x4 h0 = *(const GAS f32x4*)d, h1 = *(const GAS f32x4*)(d + 4);
                    *(GAS f32x4*)d = h0 + acc[ai][bj][m][0]; *(GAS f32x4*)(d + 4) = h1 + acc[ai][bj][m][1];
                }
            }
    }
};
struct EpiUp {
    static constexpr bool PERM = true, AFTER_DRAIN = false;
    GAS bf16_t* A2;
    __device__ __forceinline__ void operator()(const f32x4 (&acc)[2][2][4][2], const Unit& u, int wr, int wc, int fr, int fq) const {
        const int row0 = u.pm * BM + wr * 64 + fr, col0 = u.pn * BM + wc * 32 + 8 * fq;
#pragma unroll
        for (int ai = 0; ai < 2; ++ai)
#pragma unroll
            for (int m = 0; m < 4; ++m) {
                const int row = row0 + ai * HALF + m * 16;
#pragma unroll
                for (int bj = 0; bj < 2; ++bj) {
                    f32x4 v0 = acc[ai][bj][m][0], v1 = acc[ai][bj][m][1];
#pragma unroll
                    for (int e = 0; e < 4; ++e) { const float a = fmaxf(v0[e], 0.f), b = fmaxf(v1[e], 0.f); v0[e] = a * a; v1[e] = b * b; }
                    *(GAS u32x4*)(A2 + (size_t)row * DFF + col0 + bj * HALF) = pack8(v0, v1);
                }
            }
    }
};
template <class Epi, class Sched, bool ALIGN_EPI = false, bool SP2 = false>
__device__ __forceinline__ void gemm_phase(PG8_LAS unsigned char* lds, const Gemm g, const Sched& S, const Epi& E, const int tid) {
    const int wid = __builtin_amdgcn_readfirstlane(tid >> 6), lane = tid & 63, wr = wid >> 2, wc = wid & 3, fr = lane & 15, fq = lane >> 4;
    const int K = g.K, nt = K / BK;
    unsigned voffA[2], voffB[2];
#pragma unroll
    for (int i = 0; i < 2; ++i) { int R, C; stage_rc(tid * 16 + i * 8192, R, C); const int Rb = Epi::PERM ? ((R & ~31) + perm32(R & 31)) : R;
        voffA[i] = (unsigned)(R * K + C) * 2u; voffB[i] = (unsigned)(Rb * K + C) * 2u; }
    const size_t kstep = (size_t)(BK * 2);
    const size_t hstep = (size_t)HALF * K * 2;
    const size_t tstep = 2 * hstep;
    const unsigned ldsw = (unsigned)wid * 1024u;
    const int aoff = lds_byte(wr * 64 + fr, fq * 8), boff = lds_byte(wc * 32 + fr, fq * 8);
#define PG8_SA(b, h) (((b) * 2 + (h)) * HTB)
#define PG8_SB(b, h) ((4 + (b) * 2 + (h)) * HTB)
#define PG8_STAGE(bufoff, gbase, voff) do { _Pragma("unroll") for (int _i = 0; _i < 2; ++_i) \
        __builtin_amdgcn_global_load_lds((const GAS unsigned*)((const GAS char*)(gbase) + (voff)[_i]), (PG8_LAS unsigned*)(lds + (bufoff) + ldsw + _i * 8192), 16, 0, 0); } while (0)
#define PG8_LDA(dst, b, h) do { _Pragma("unroll") for (int m = 0; m < 4; ++m) _Pragma("unroll") for (int k = 0; k < 2; ++k) dst[m][k] = *(const PG8_LAS bf16x8*)(lds + PG8_SA(b, h) + aoff + m * 2048 + k * 1024); } while (0)
#define PG8_LDB(dst, b, h) do { _Pragma("unroll") for (int n = 0; n < 2; ++n) _Pragma("unroll") for (int k = 0; k < 2; ++k) dst[n][k] = *(const PG8_LAS bf16x8*)(lds + PG8_SB(b, h) + boff + n * 2048 + k * 1024); } while (0)
#define PG8_MMA(ai, bj, At, Bt) do { __builtin_amdgcn_s_setprio(1); _Pragma("unroll") for (int m = 0; m < 4; ++m) _Pragma("unroll") for (int n = 0; n < 2; ++n) _Pragma("unroll") for (int k = 0; k < 2; ++k) \
        acc[ai][bj][m][n] = __builtin_amdgcn_mfma_f32_16x16x32_bf16(Bt[n][k], At[m][k], acc[ai][bj][m][n], 0, 0, 0); __builtin_amdgcn_s_setprio(0); } while (0)
#define PG8_WAIT_V(n) asm volatile("s_waitcnt vmcnt(" #n ")" ::: "memory")
#define PG8_WAIT_L(n) asm volatile("s_waitcnt lgkmcnt(" #n ")" ::: "memory")
#define PG8_BAR __builtin_amdgcn_s_barrier()
#define PG8_SCHED __builtin_amdgcn_sched_barrier(0)
    Unit cur, nxt; int ui = 0;
    if (!S.next(0, cur)) return;
    f32x4 acc[2][2][4][2];
#pragma unroll
    for (int a = 0; a < 2; ++a)
#pragma unroll
        for (int b = 0; b < 2; ++b)
#pragma unroll
            for (int m = 0; m < 4; ++m)
#pragma unroll
                for (int n = 0; n < 2; ++n) acc[a][b][m][n] = (f32x4){0.f, 0.f, 0.f, 0.f};
    bf16x8 At[4][2], B0[2][2], B1[2][2];
    const GAS char* cA = (const GAS char*)g.A + (size_t)cur.pm * tstep; const GAS char* cB = (const GAS char*)g.Bt + (size_t)cur.pn * tstep;
    S.a_ready(cur);
    if constexpr (SP2) {
        PG8_STAGE(PG8_SB(0, 0), cB, voffB); PG8_STAGE(PG8_SB(0, 1), cB + hstep, voffB); PG8_STAGE(PG8_SA(0, 0), cA, voffA); PG8_STAGE(PG8_SA(0, 1), cA + hstep, voffA);
        if (wr == 1) PG8_BAR;
        PG8_WAIT_V(2); PG8_BAR;
        PG8_STAGE(PG8_SB(1, 0), cB + kstep, voffB); PG8_STAGE(PG8_SA(1, 0), cA + kstep, voffA); PG8_STAGE(PG8_SB(1, 1), cB + hstep + kstep, voffB);
        PG8_WAIT_V(6); PG8_BAR;
    } else {
        PG8_STAGE(PG8_SB(0, 0), cB, voffB); PG8_STAGE(PG8_SA(0, 0), cA, voffA); PG8_STAGE(PG8_SB(0, 1), cB + hstep, voffB); PG8_STAGE(PG8_SA(0, 1), cA + hstep, voffA);
        if (wr == 1) PG8_BAR;
        PG8_WAIT_V(4); PG8_BAR;
        PG8_STAGE(PG8_SB(1, 0), cB + kstep, voffB); PG8_STAGE(PG8_SA(1, 0), cA + kstep, voffA); PG8_STAGE(PG8_SB(1, 1), cB + hstep + kstep, voffB);
        PG8_WAIT_V(6); PG8_BAR;
    }
    for (;;) {
        const bool has_next = S.next(ui + 1, nxt);
        const GAS char* nA = has_next ? (const GAS char*)g.A + (size_t)nxt.pm * tstep : cA; const GAS char* nB = has_next ? (const GAS char*)g.Bt + (size_t)nxt.pn * tstep : cB;
        for (int t = 0; t < nt; t += 2) {
            const bool last = (t == nt - 2);
            const GAS char* a1 = cA + (size_t)(t + 1) * kstep;
            const GAS char* a2 = last ? nA : cA + (size_t)(t + 2) * kstep; const GAS char* b2 = last ? nB : cB + (size_t)(t + 2) * kstep;
            const GAS char* a3 = a2 + kstep; const GAS char* b3 = b2 + kstep;
            if (last && has_next) S.a_ready(nxt);
            if constexpr (SP2) {
            PG8_LDB(B0, 0, 0); PG8_LDB(B1, 0, 1); PG8_SCHED; PG8_LDA(At, 0, 0); PG8_STAGE(PG8_SA(1, 1), a1 + hstep, voffA);
            PG8_WAIT_V(8); PG8_WAIT_L(0); PG8_BAR; PG8_MMA(0, 0, At, B0); PG8_MMA(0, 1, At, B1); PG8_BAR; PG8_SCHED;
            PG8_LDA(At, 0, 1); PG8_STAGE(PG8_SB(0, 0), b2, voffB); PG8_STAGE(PG8_SB(0, 1), b2 + hstep, voffB); PG8_STAGE(PG8_SA(0, 0), a2, voffA);
            PG8_WAIT_V(8); PG8_WAIT_L(0); PG8_BAR; PG8_MMA(1, 0, At, B0); PG8_MMA(1, 1, At, B1); PG8_BAR; PG8_SCHED;
            PG8_LDB(B0, 1, 0); PG8_LDB(B1, 1, 1); PG8_SCHED; PG8_LDA(At, 1, 0); PG8_STAGE(PG8_SA(0, 1), a2 + hstep, voffA);
            PG8_WAIT_V(8); PG8_WAIT_L(0); PG8_BAR; PG8_MMA(0, 0, At, B0); PG8_MMA(0, 1, At, B1); PG8_BAR; PG8_SCHED;
            PG8_LDA(At, 1, 1); PG8_STAGE(PG8_SB(1, 0), b3, voffB); PG8_STAGE(PG8_SB(1, 1), b3 + hstep, voffB); PG8_STAGE(PG8_SA(1, 0), a3, voffA);
            PG8_WAIT_V(8); PG8_WAIT_L(0); PG8_BAR; PG8_MMA(1, 0, At, B0); PG8_MMA(1, 1, At, B1); PG8_BAR; PG8_SCHED;
            } else {
            PG8_LDB(B0, 0, 0); PG8_SCHED; PG8_LDA(At, 0, 0); PG8_STAGE(PG8_SA(1, 1), a1 + hstep, voffA);
            PG8_WAIT_L(8); PG8_BAR; PG8_WAIT_L(0); PG8_MMA(0, 0, At, B0); PG8_BAR; PG8_SCHED;
            PG8_LDB(B1, 0, 1); PG8_STAGE(PG8_SB(0, 0), b2, voffB);
            PG8_BAR; PG8_WAIT_L(0); PG8_MMA(0, 1, At, B1); PG8_BAR;
            PG8_LDA(At, 0, 1); PG8_STAGE(PG8_SA(0, 0), a2, voffA);
            PG8_BAR; PG8_WAIT_L(0); PG8_MMA(1, 0, At, B0); PG8_BAR; PG8_SCHED;
            PG8_STAGE(PG8_SB(0, 1), b2 + hstep, voffB);
            PG8_WAIT_V(6); PG8_BAR; PG8_MMA(1, 1, At, B1); PG8_BAR;
            PG8_LDB(B0, 1, 0); PG8_SCHED; PG8_LDA(At, 1, 0); PG8_STAGE(PG8_SA(0, 1), a2 + hstep, voffA);
            PG8_WAIT_L(8); PG8_BAR; PG8_WAIT_L(0); PG8_MMA(0, 0, At, B0); PG8_BAR; PG8_SCHED;
            PG8_LDB(B1, 1, 1); PG8_STAGE(PG8_SB(1, 0), b3, voffB);
            PG8_BAR; PG8_WAIT_L(0); PG8_MMA(0, 1, At, B1); PG8_BAR;
            PG8_LDA(At, 1, 1); PG8_STAGE(PG8_SA(1, 0), a3, voffA);
            PG8_BAR; PG8_WAIT_L(0); PG8_MMA(1, 0, At, B0); PG8_BAR; PG8_SCHED;
            PG8_STAGE(PG8_SB(1, 1), b3 + hstep, voffB);
            PG8_WAIT_V(6); PG8_BAR; PG8_MMA(1, 1, At, B1); PG8_BAR;
            }
        }
        if constexpr (ALIGN_EPI) { if (wr == 0) PG8_BAR; }
        if constexpr (!Epi::AFTER_DRAIN) { E(acc, cur, wr, wc, fr, fq); S.done(cur); }
        if (!has_next) break;
#pragma unroll
        for (int a = 0; a < 2; ++a)
#pragma unroll
            for (int b = 0; b < 2; ++b)
#pragma unroll
                for (int m = 0; m < 4; ++m)
#pragma unroll
                    for (int n = 0; n < 2; ++n) acc[a][b][m][n] = (f32x4){0.f, 0.f, 0.f, 0.f};
        cur = nxt; cA = nA; cB = nB; ++ui;
        if constexpr (ALIGN_EPI) { if (wr == 1) PG8_BAR; }
    }
    PG8_WAIT_V(0);
    if constexpr (!ALIGN_EPI) { if (wr == 0) PG8_BAR; }
    PG8_BAR;
    if constexpr (Epi::AFTER_DRAIN) { E.fused(acc, cur, wr, wc, fr, fq, lds, wid, lane); S.done(cur); }
#undef PG8_SA
#undef PG8_SB
#undef PG8_STAGE
#undef PG8_LDA
#undef PG8_LDB
#undef PG8_MMA
#undef PG8_WAIT_V
#undef PG8_WAIT_L
#undef PG8_BAR
#undef PG8_SCHED
}
}

typedef unsigned short bf16;
typedef unsigned v4u __attribute__((ext_vector_type(4)));
typedef float f32x4 __attribute__((ext_vector_type(4)));
typedef short bf16x8 __attribute__((ext_vector_type(8)));
typedef GAS unsigned gu32;
typedef GAS unsigned long long gu64;
#define RLX_AGENT __ATOMIC_RELAXED, __HIP_MEMORY_SCOPE_AGENT
#define LDS_WAIT() asm volatile("s_waitcnt lgkmcnt(0)" ::: "memory")
#define VM_WAIT() asm volatile("s_waitcnt vmcnt(0)" ::: "memory")
__device__ __forceinline__ unsigned long long rt() { return __builtin_amdgcn_s_memrealtime(); }
typedef float f32x2_cv __attribute__((ext_vector_type(2))); typedef __bf16 bf16x2_cv __attribute__((ext_vector_type(2)));
__device__ __forceinline__ unsigned pk2(float lo, float hi) { const f32x2_cv v = {lo, hi}; const bf16x2_cv c = __builtin_convertvector(v, bf16x2_cv); return __builtin_bit_cast(unsigned, c); }
__device__ __forceinline__ unsigned f2bf(float f) { return pk2(f, 0.f) & 0xffffu; }

#define XB_TMO      128
#define XB_XCNT(j)  (256  + 64 * (j))
#define XB_XSUB(j)  (1280 + 64 * (j))
#define XB_XGEN(j)  (2304 + 64 * (j))
#define XB_TOP      3328
#define XB_TOPGEN   3392
#define XCD_BAR_WORDS 3456
#define XB_SPIN_CAP (1u << 18)

__device__ __forceinline__ unsigned xb_ld(unsigned* p)              { return __hip_atomic_load(p, __ATOMIC_RELAXED, __HIP_MEMORY_SCOPE_AGENT); }
__device__ __forceinline__ unsigned xb_add(unsigned* p, unsigned v) { return __hip_atomic_fetch_add(p, v, __ATOMIC_RELAXED, __HIP_MEMORY_SCOPE_AGENT); }
__device__ __forceinline__ unsigned xb_xcc_id() { return (unsigned)__builtin_amdgcn_s_getreg((3 << 11) | 20) & 0xFu; }
#define XB_SPIN(cond, bar) do { unsigned _sp = 0; while (cond) { __builtin_amdgcn_s_sleep(1); \
    if ((++_sp & 255u) == 0u) { if (xb_ld(&(bar)[XB_TMO])) break; if (_sp > XB_SPIN_CAP) { atomicAdd(&(bar)[XB_TMO], 1u); break; } } } } while (0)

struct XcdBarrier {
    unsigned* bar; unsigned x;
    volatile LAS unsigned* st;
};

__device__ __forceinline__ XcdBarrier xcd_barrier_post(unsigned* bar, volatile LAS unsigned* st) {
    XcdBarrier b; b.bar = bar; b.x = xb_xcc_id(); b.st = st;
    if (threadIdx.x == 0) (void)xb_add(&bar[XB_XCNT(b.x)], 1u);
    return b;
}
__device__ __forceinline__ void xcd_barrier_complete(unsigned* bar, unsigned x, unsigned& nloc, unsigned& nx, const unsigned G) {
    unsigned sum, cnt, mine, sp = 0u;
    for (;;) {
        sum = 0u; cnt = 0u; mine = 0u;
#pragma unroll
        for (unsigned j = 0; j < 16; ++j) { const unsigned c = xb_ld(&bar[XB_XCNT(j)]); sum += c; cnt += (c > 0u) ? 1u : 0u; mine = (j == x) ? c : mine; }
        if (sum == G) break;
        __builtin_amdgcn_s_sleep(1);
        if ((++sp & 255u) == 0u) { if (xb_ld(&bar[XB_TMO])) break; if (sp > XB_SPIN_CAP) { atomicAdd(&bar[XB_TMO], 1u); break; } }
    }
    nloc = mine > 0u ? mine : 1u; nx = cnt > 0u ? cnt : 1u;
}

__device__ __forceinline__ void xcd_barrier(const XcdBarrier& b, const int tid_, const unsigned G_) {
    asm volatile("s_waitcnt vmcnt(0)" ::: "memory");
    __syncthreads();
    if (tid_ == 0) {
        unsigned* bar = b.bar;
        __builtin_amdgcn_s_waitcnt(0);
        unsigned nloc = b.st[0], nx = b.st[1];
        if (nloc == 0u) { xcd_barrier_complete(bar, b.x, nloc, nx, G_); b.st[0] = nloc; b.st[1] = nx; }
        const unsigned old = xb_add(&bar[XB_XSUB(b.x)], 1u);
        const unsigned gen = old / nloc;
        if (old + 1u == (gen + 1u) * nloc) {
            __builtin_amdgcn_fence(__ATOMIC_RELEASE, "agent");
            asm volatile("s_waitcnt vmcnt(0)" ::: "memory");
            const unsigned og = xb_add(&bar[XB_TOP], 1u);
            const unsigned tg = og / nx;
            if (og + 1u == (tg + 1u) * nx) xb_add(&bar[XB_TOPGEN], 1u);
            else XB_SPIN(xb_ld(&bar[XB_TOPGEN]) == tg, bar);
            __builtin_amdgcn_fence(__ATOMIC_ACQUIRE, "agent");
            xb_add(&bar[XB_XGEN(b.x)], 1u);
            asm volatile("s_waitcnt vmcnt(0)" ::: "memory");
        } else {
            XB_SPIN(xb_ld(&bar[XB_XGEN(b.x)]) == gen, bar);
            __builtin_amdgcn_fence(__ATOMIC_ACQUIRE, "agent");
            asm volatile("s_waitcnt vmcnt(0)" ::: "memory");
        }
    }
    __syncthreads();
}

constexpr size_t O_YP = 0, O_YS = O_YP + (size_t)NB * SEQ * D, O_PK = O_YS + (size_t)MS * D, O_PV = O_PK + 2ull * MP * 256, O_PKI = O_PV + 2ull * MP * 256,
                 O_PSSM = O_PKI + 2ull * MP * 64, O_PCONV = O_PSSM + 2ull * NB * NH * HP * NST, O_SK = O_PCONV + 2ull * NB * 3 * CONVD, O_SV = O_SK + 2ull * MS * 256,
                 O_SKI = O_SV + 2ull * MS * 256, O_SSSM = O_SKI + 2ull * MS * 64, O_SCONV = O_SSSM + 2ull * DB * NH * HP * NST, O_END = O_SCONV + 2ull * DB * 3 * CONVD;

constexpr size_t MiB = 1u << 20;
constexpr size_t al(size_t x) { return (x + MiB - 1) / MiB * MiB; }
constexpr size_t WS_CTL = 0, CTL_ZERO_BYTES = 1 * MiB;
constexpr size_t SZ_WIN = (size_t)NIN * D * 2, SZ_WSSM = (size_t)D * DIN * 2, SZ_WATT = (size_t)D * D * 2, SZ_WOUT = (size_t)D * D * 2, SZ_WUP = (size_t)DFF * D * 2, SZ_WDN = (size_t)D * DFF * 2;
constexpr size_t WL_WIN = 0, WL_WSSM = al(WL_WIN + SZ_WIN), WL_WATT = al(WL_WSSM + SZ_WSSM), WL_WOUT = al(WL_WATT + SZ_WATT), WL_WUP = al(WL_WOUT + SZ_WOUT), WL_WDN = al(WL_WUP + SZ_WUP), WL_SIZE = al(WL_WDN + SZ_WDN);
constexpr size_t WS_W = 1 * MiB;
constexpr size_t WS_H = al(WS_W + 2 * WL_SIZE);
constexpr size_t WS_U = al(WS_H + (size_t)MPAD * D * 4);
constexpr size_t WS_P1 = al(WS_U + (size_t)MPAD * D * 2);
constexpr size_t WS_MISC = al(WS_P1 + (size_t)MPAD * LDP1 * 2);
constexpr size_t WS_KIB = al(WS_MISC + (size_t)MPAD * 128 * 4);
constexpr size_t WS_XC = al(WS_KIB + (size_t)MPAD * 64 * 2);
constexpr size_t WS_DT = al(WS_XC + (size_t)MPAD * CONVD * 2);
constexpr size_t WS_DA = al(WS_DT + (size_t)MPAD * 32 * 4);
constexpr size_t WS_YS = al(WS_DA + (size_t)MPAD * 32 * 4);
constexpr size_t WS_YSN = al(WS_YS + (size_t)MPAD * DIN * 4);
constexpr size_t WS_YA = al(WS_YSN + (size_t)MPAD * DIN * 2);
constexpr size_t WS_T1 = al(WS_YA + (size_t)MPAD * D * 2);
constexpr size_t WS_MG = al(WS_T1 + (size_t)MPAD * D * 4);
constexpr size_t WS_A2 = al(WS_MG + (size_t)MPAD * D * 2);
constexpr size_t WS_IDXP = al(WS_A2 + (size_t)MPAD * DFF * 2);
constexpr size_t WS_IDXS = al(WS_IDXP + (size_t)MP * 256 * 2);
constexpr int SCS_LD = 8256;
constexpr size_t WS_SCS = al(WS_IDXS + (size_t)MS * 256 * 4);
constexpr size_t WS_SB = al(WS_SCS + (size_t)MS * SCS_LD * 4);
constexpr size_t WS_DEC = al(WS_SB + (size_t)NB * 33 * NH * HP * NST * 4);
constexpr size_t WS_HC = al(WS_DEC + (size_t)NB * 33 * NH * 4);
constexpr size_t WS_KVB = al(WS_HC + (size_t)NB * 33 * NH * HP * NST * 2);
constexpr size_t WS_END = al(WS_KVB + (size_t)MPAD * 512 * 2);
constexpr int CW_BAR = 4096;

constexpr int LDS_BYTES = 155648, LDSCTL_OFF = 151552, MISC_OFF = LDSCTL_OFF + 320;
constexpr int NWAVES = 8, NT = 512;
typedef float f32x16 __attribute__((ext_vector_type(16)));
typedef unsigned v2u __attribute__((ext_vector_type(2)));

__device__ __forceinline__ float dpp_f(float v, const int ctrl_unused) { return v; }
#define DPPF(v, ctrl, rmask, bc) __uint_as_float((unsigned)__builtin_amdgcn_update_dpp(0, (int)__float_as_uint(v), ctrl, rmask, 0xf, bc))
__device__ __forceinline__ float row16_sum(float v) {
    v += DPPF(v, 0xB1, 0xf, true); v += DPPF(v, 0x4E, 0xf, true); v += DPPF(v, 0x141, 0xf, true); v += DPPF(v, 0x140, 0xf, true); return v;
}
__device__ __forceinline__ float wave_sum(float v) {
    v = row16_sum(v);
    v += DPPF(v, 0x142, 0xa, false); v += DPPF(v, 0x143, 0xc, false);
    return __uint_as_float((unsigned)__builtin_amdgcn_readlane((int)__float_as_uint(v), 63));
}
__device__ __forceinline__ float wave_max(float v) {
    v = fmaxf(v, __uint_as_float((unsigned)__builtin_amdgcn_update_dpp((int)__float_as_uint(v), (int)__float_as_uint(v), 0xB1, 0xf, 0xf, false)));
    v = fmaxf(v, __uint_as_float((unsigned)__builtin_amdgcn_update_dpp((int)__float_as_uint(v), (int)__float_as_uint(v), 0x4E, 0xf, 0xf, false)));
    v = fmaxf(v, __uint_as_float((unsigned)__builtin_amdgcn_update_dpp((int)__float_as_uint(v), (int)__float_as_uint(v), 0x141, 0xf, 0xf, false)));
    v = fmaxf(v, __uint_as_float((unsigned)__builtin_amdgcn_update_dpp((int)__float_as_uint(v), (int)__float_as_uint(v), 0x140, 0xf, 0xf, false)));
    v = fmaxf(v, __uint_as_float((unsigned)__builtin_amdgcn_update_dpp((int)__float_as_uint(v), (int)__float_as_uint(v), 0x142, 0xa, 0xf, false)));
    v = fmaxf(v, __uint_as_float((unsigned)__builtin_amdgcn_update_dpp((int)__float_as_uint(v), (int)__float_as_uint(v), 0x143, 0xc, 0xf, false)));
    return __uint_as_float((unsigned)__builtin_amdgcn_readlane((int)__float_as_uint(v), 63));
}
__device__ __forceinline__ void unpack8(const v4u w, float (&f)[8]) {
    f[0] = __uint_as_float(w.x << 16); f[1] = __uint_as_float(w.x & 0xffff0000u); f[2] = __uint_as_float(w.y << 16); f[3] = __uint_as_float(w.y & 0xffff0000u);
    f[4] = __uint_as_float(w.z << 16); f[5] = __uint_as_float(w.z & 0xffff0000u); f[6] = __uint_as_float(w.w << 16); f[7] = __uint_as_float(w.w & 0xffff0000u);
}
__device__ __forceinline__ float sigm(float x) { return __builtin_amdgcn_rcpf(1.0f + __expf(-x)); }

__device__ __forceinline__ int win_src_col(int n) {
    if (n < 5120) return n;
    if (n < 6144) return n - 5120 + 5152;
    if (n < 6400) return n - 6144 + 6176;
    if (n < 6656) return n - 6400 + 6432;
    if (n < 7168) return n - 6656 + 6688;
    if (n < 8192) return n - 7168 + 7272;
    if (n < 9216) return n - 8192 + 8296;
    if (n < 9280) return n - 9216 + 7200;
    if (n < 9312) return n - 9280 + 5120;
    if (n < 9320) return n - 9312 + 7264;
    return -1;
}
__device__ __forceinline__ void tr_item(const GAS float* W, int K, int Nsrc, GAS bf16* WT, int nblk, bool remap, LAS float* scr, int item, int lane) {
    const int kb = item / nblk, nb = item % nblk, k0 = 64 * kb, n0 = 64 * nb;
    const int s0 = remap ? win_src_col(n0) : n0, s63 = remap ? win_src_col(n0 + 63) : n0 + 63;
    if (s0 >= 0 && s63 == s0 + 63 && (s0 & 3) == 0 && (Nsrc & 3) == 0) {
        const int r4 = lane >> 4, c4 = (lane & 15) * 4;
#pragma unroll 4
        for (int i = 0; i < 16; ++i) { const int kk = 4 * i + r4; const f32x4 v = *(const GAS f32x4*)(W + (size_t)(k0 + kk) * Nsrc + s0 + c4);
            scr[kk * 65 + c4] = v.x; scr[kk * 65 + c4 + 1] = v.y; scr[kk * 65 + c4 + 2] = v.z; scr[kk * 65 + c4 + 3] = v.w; }
    } else {
        const int sc = remap ? win_src_col(n0 + lane) : n0 + lane;
#pragma unroll 8
        for (int kk = 0; kk < 64; ++kk) scr[kk * 65 + lane] = sc >= 0 ? W[(size_t)(k0 + kk) * Nsrc + sc] : 0.f;
    }
    LDS_WAIT(); asm volatile("" ::: "memory");
    const int c = lane & 7;
#pragma unroll
    for (int j = 0; j < 8; ++j) { const int n = (lane >> 3) + 8 * j; const LAS float* s = scr + (8 * c) * 65 + n;
        v4u o; o.x = pk2(s[0 * 65], s[1 * 65]); o.y = pk2(s[2 * 65], s[3 * 65]); o.z = pk2(s[4 * 65], s[5 * 65]); o.w = pk2(s[6 * 65], s[7 * 65]);
        *(GAS v4u*)(WT + (size_t)(n0 + n) * K + k0 + 8 * c) = o; }
    LDS_WAIT(); asm volatile("" ::: "memory");
}
__device__ __forceinline__ void rms_row(const GAS float* src, const GAS float* w, GAS float* hdst, GAS bf16* udst, GAS float* fdst, int lane) {
    f32x4 v[4]; float ss = 0.f;
#pragma unroll
    for (int j = 0; j < 4; ++j) { v[j] = src ? ((const GAS f32x4*)src)[lane + 64 * j] : (f32x4){0.f, 0.f, 0.f, 0.f}; ss += (v[j].x * v[j].x + v[j].y * v[j].y) + (v[j].z * v[j].z + v[j].w * v[j].w); }
    ss = wave_sum(ss);
    const float rstd = 1.0f / sqrtf(ss * (1.0f / D) + 1e-6f);
#pragma unroll
    for (int j = 0; j < 4; ++j) {
        if (hdst) ((GAS f32x4*)hdst)[lane + 64 * j] = v[j];
        const f32x4 wv = ((const GAS f32x4*)w)[lane + 64 * j]; const f32x4 o = v[j] * rstd * wv;
        if (udst) ((GAS v2u*)udst)[lane + 64 * j] = (v2u){pk2(o.x, o.y), pk2(o.z, o.w)};
        if (fdst) ((GAS f32x4*)fdst)[lane + 64 * j] = o;
    }
}

__device__ __forceinline__ void ssd_unit(LAS unsigned char* lds, int tid, const GAS bf16* XC, const GAS float* DT, const GAS float* DA, size_t m0, int L, int h, int p0,
                                         const GAS float* hin, GAS float* hout, GAS float* YS, float dskip) {
    LAS float* Bl = (LAS float*)lds;
    LAS float* Cl = Bl + 64 * 128;
    LAS float* Xl = Cl + 64 * 128;
    LAS float* Yl = Xl + 64 * 32;
    LAS float* dtl = Yl + 64 * 32;
    LAS float* dal = dtl + 64;
    const int pl = tid >> 4, nq = tid & 15, n0 = nq * 8, g = h >> 3;
    float s[8];
    if (hin) { const f32x4 a = *(const GAS f32x4*)(hin + (size_t)(p0 + pl) * NST + n0), b = *(const GAS f32x4*)(hin + (size_t)(p0 + pl) * NST + n0 + 4);
        s[0] = a.x; s[1] = a.y; s[2] = a.z; s[3] = a.w; s[4] = b.x; s[5] = b.y; s[6] = b.z; s[7] = b.w; }
    else {
#pragma unroll
        for (int i = 0; i < 8; ++i) s[i] = 0.f; }
    for (int tb = 0; tb < L; tb += 64) {
        const int nb = (L - tb) < 64 ? (L - tb) : 64;
        { const int tk = tid >> 3, part = tid & 7;
            if (tk < nb) { const GAS bf16* xr = XC + (m0 + tb + tk) * CONVD;
                float f[8];
                unpack8(*(const GAS v4u*)(xr + DIN + g * NST + part * 16), f);
                *(LAS f32x4*)(Bl + tk * 128 + part * 16) = (f32x4){f[0], f[1], f[2], f[3]}; *(LAS f32x4*)(Bl + tk * 128 + part * 16 + 4) = (f32x4){f[4], f[5], f[6], f[7]};
                unpack8(*(const GAS v4u*)(xr + DIN + g * NST + part * 16 + 8), f);
                *(LAS f32x4*)(Bl + tk * 128 + part * 16 + 8) = (f32x4){f[0], f[1], f[2], f[3]}; *(LAS f32x4*)(Bl + tk * 128 + part * 16 + 12) = (f32x4){f[4], f[5], f[6], f[7]};
                unpack8(*(const GAS v4u*)(xr + DIN + NG * NST + g * NST + part * 16), f);
                *(LAS f32x4*)(Cl + tk * 128 + part * 16) = (f32x4){f[0], f[1], f[2], f[3]}; *(LAS f32x4*)(Cl + tk * 128 + part * 16 + 4) = (f32x4){f[4], f[5], f[6], f[7]};
                unpack8(*(const GAS v4u*)(xr + DIN + NG * NST + g * NST + part * 16 + 8), f);
                *(LAS f32x4*)(Cl + tk * 128 + part * 16 + 8) = (f32x4){f[0], f[1], f[2], f[3]}; *(LAS f32x4*)(Cl + tk * 128 + part * 16 + 12) = (f32x4){f[4], f[5], f[6], f[7]};
                const v2u xw = *(const GAS v2u*)(xr + h * HP + p0 + part * 4);
                *(LAS f32x4*)(Xl + tk * 32 + part * 4) = (f32x4){__uint_as_float(xw.x << 16), __uint_as_float(xw.x & 0xffff0000u), __uint_as_float(xw.y << 16), __uint_as_float(xw.y & 0xffff0000u)};
            }
            if (tid < nb) { dtl[tid] = DT[(m0 + tb + tid) * 32 + h]; dal[tid] = DA[(m0 + tb + tid) * 32 + h]; }
        }
        __syncthreads();
        for (int t = 0; t < nb; ++t) {
            const float da = dal[t], dtv = dtl[t], xv = Xl[t * 32 + pl], xdt = xv * dtv;
            const f32x4 b0 = *(const LAS f32x4*)(Bl + t * 128 + n0), b1 = *(const LAS f32x4*)(Bl + t * 128 + n0 + 4);
            const f32x4 c0 = *(const LAS f32x4*)(Cl + t * 128 + n0), c1 = *(const LAS f32x4*)(Cl + t * 128 + n0 + 4);
            s[0] = s[0] * da + xdt * b0.x; s[1] = s[1] * da + xdt * b0.y; s[2] = s[2] * da + xdt * b0.z; s[3] = s[3] * da + xdt * b0.w;
            s[4] = s[4] * da + xdt * b1.x; s[5] = s[5] * da + xdt * b1.y; s[6] = s[6] * da + xdt * b1.z; s[7] = s[7] * da + xdt * b1.w;
            float y = (s[0] * c0.x + s[1] * c0.y) + (s[2] * c0.z + s[3] * c0.w) + (s[4] * c1.x + s[5] * c1.y) + (s[6] * c1.z + s[7] * c1.w);
            y += __shfl_xor(y, 1); y += __shfl_xor(y, 2); y += __shfl_xor(y, 4); y += __shfl_xor(y, 8);
            if (nq == 0) Yl[t * 32 + pl] = y + xv * dskip;
        }
        __syncthreads();
        { const int tk = tid >> 3, part = tid & 7;
            if (tk < nb) *(GAS f32x4*)(YS + (m0 + tb + tk) * DIN + h * HP + p0 + part * 4) = *(const LAS f32x4*)(Yl + tk * 32 + part * 4); }
    }
    *(GAS f32x4*)(hout + (size_t)(p0 + pl) * NST + n0) = (f32x4){s[0], s[1], s[2], s[3]};
    *(GAS f32x4*)(hout + (size_t)(p0 + pl) * NST + n0 + 4) = (f32x4){s[4], s[5], s[6], s[7]};
}

__device__ __forceinline__ void idx_load_q(const GAS bf16* P1, const GAS float* MISC, size_t mq0, int lane, bf16x8 (&afr)[2][4], float (&wq)[2][2][8]) {
    const int r = lane & 31, hh = lane >> 5, qs = ((r >> 2) & 1) * 2 + (r >> 4), head = (r & 3) + 4 * ((r >> 3) & 1);
#pragma unroll
    for (int rt = 0; rt < 2; ++rt)
#pragma unroll
        for (int ks = 0; ks < 4; ++ks) afr[rt][ks] = *(const GAS bf16x8*)(P1 + (mq0 + qs + 4 * rt) * LDP1 + C_QI + head * 64 + 16 * ks + 8 * hh);
#pragma unroll
    for (int rt = 0; rt < 2; ++rt)
#pragma unroll
        for (int jq = 0; jq < 2; ++jq) { const GAS float* wp = MISC + (mq0 + 4 * rt + 2 * hh + jq) * 128 + MC_WI; const f32x4 a = *(const GAS f32x4*)wp, b = *(const GAS f32x4*)(wp + 4);
            const float sc = 0.125f * 0.35355339059327373f;
            wq[rt][jq][0] = a.x * sc; wq[rt][jq][1] = a.y * sc; wq[rt][jq][2] = a.z * sc; wq[rt][jq][3] = a.w * sc; wq[rt][jq][4] = b.x * sc; wq[rt][jq][5] = b.y * sc; wq[rt][jq][6] = b.z * sc; wq[rt][jq][7] = b.w * sc; }
}
__device__ __forceinline__ void idx_scores(const bf16x8 (&afr)[2][4], const bf16x8 (&bfr)[4], const float (&wq)[2][2][8], float (&sc)[2][2]) {
#pragma unroll
    for (int rt = 0; rt < 2; ++rt) {
        f32x16 acc = {};
#pragma unroll
        for (int ks = 0; ks < 4; ++ks) acc = __builtin_amdgcn_mfma_f32_32x32x16_bf16(afr[rt][ks], bfr[ks], acc, 0, 0, 0);
#pragma unroll
        for (int jq = 0; jq < 2; ++jq) { float s = 0.f;
#pragma unroll
            for (int i = 0; i < 8; ++i) s += wq[rt][jq][i] * fmaxf(acc[8 * jq + i], 0.f);
            sc[rt][jq] = s; }
    }
}
__device__ __forceinline__ unsigned f2key(float f) { const unsigned u = __float_as_uint(f); return u ^ ((u >> 31) ? 0xffffffffu : 0x80000000u); }
__device__ __forceinline__ unsigned wave_incl_scan(unsigned v, int lane) {
#pragma unroll
    for (int o = 1; o < 64; o <<= 1) { const unsigned t = __shfl_up(v, o); if (lane >= o) v += t; }
    return v;
}
#ifndef REP_TK_PASS
#define REP_TK_PASS 1
#endif
#ifndef REP_TK_COMP
#define REP_TK_COMP 1
#endif
__device__ __forceinline__ int wave_sum_i(int v) {
    v += __builtin_amdgcn_update_dpp(0, v, 0xB1, 0xf, 0xf, true);
    v += __builtin_amdgcn_update_dpp(0, v, 0x4E, 0xf, 0xf, true);
    v += __builtin_amdgcn_update_dpp(0, v, 0x141, 0xf, 0xf, true);
    v += __builtin_amdgcn_update_dpp(0, v, 0x140, 0xf, 0xf, true);
    v += __builtin_amdgcn_update_dpp(0, v, 0x142, 0xa, 0xf, false);
    v += __builtin_amdgcn_update_dpp(0, v, 0x143, 0xc, 0xf, false);
    return __builtin_amdgcn_readlane(v, 63);
}
__device__ __forceinline__ int cnt_ge(const LAS unsigned* s, int nit, unsigned mid, int lane) {
    int cl = 0; int it = 0;
    const LAS v4u* p = (const LAS v4u*)s + lane;
    for (; it + 4 <= nit; it += 4) {
        const v4u k0 = p[64 * it], k1 = p[64 * it + 64], k2 = p[64 * it + 128], k3 = p[64 * it + 192];
        cl += (k0.x >= mid) + (k0.y >= mid) + (k0.z >= mid) + (k0.w >= mid);
        cl += (k1.x >= mid) + (k1.y >= mid) + (k1.z >= mid) + (k1.w >= mid);
        cl += (k2.x >= mid) + (k2.y >= mid) + (k2.z >= mid) + (k2.w >= mid);
        cl += (k3.x >= mid) + (k3.y >= mid) + (k3.z >= mid) + (k3.w >= mid); }
    for (; it < nit; ++it) { const v4u kv = p[64 * it]; cl += (kv.x >= mid) + (kv.y >= mid) + (kv.z >= mid) + (kv.w >= mid); }
    return wave_sum_i(cl);
}
template <class OT>
__device__ __forceinline__ void topk_select(LAS unsigned* s, int n, int lane, OT* out) {
    const int nit = (n + 255) >> 8;
    for (int i = n + lane; i < nit * 256; i += 64) s[i] = 0u;
    LDS_WAIT(); asm volatile("" ::: "memory");
    unsigned T = 0u, need = 0u;
    for (int rq_ = 0; rq_ < REP_TK_PASS; ++rq_) {
    unsigned kmx = 0u;
    for (int it = 0; it < nit; ++it) { const v4u kv = *(const LAS v4u*)(s + 4 * (lane + 64 * it));
        const unsigned a = kv.x > kv.y ? kv.x : kv.y, c = kv.z > kv.w ? kv.z : kv.w, d = a > c ? a : c; kmx = d > kmx ? d : kmx; }
#pragma unroll
    for (int o = 1; o < 64; o <<= 1) { const unsigned a = __shfl_xor(kmx, o); kmx = a > kmx ? a : kmx; }
    kmx = (unsigned)__builtin_amdgcn_readfirstlane((int)kmx);
    unsigned hi = kmx + 1u, lo = 1u; int c_hi = 0, c_lo = n;
    { unsigned step = 1u << 25;
      for (int tr = 0; tr < 7; ++tr) { if (hi <= step + 1u) break; const unsigned cand = hi - step;
          const int c = cnt_ge(s, nit, cand, lane);
          if (c >= 256) { lo = cand; c_lo = c; break; } hi = cand; c_hi = c; step <<= 1; } }
    bool bis = false; unsigned pw = hi - lo;
    for (int pass = 0; pass < 96; ++pass) {
        if (c_lo == 256) { T = lo - 1u; need = 0u; break; }
        if (hi - lo <= 1u) { T = lo; need = (unsigned)(256 - c_hi); break; }
        const unsigned width = hi - lo; unsigned mid;
        if (bis) mid = lo + (width >> 1);
        else { const float f = ((float)(c_lo - 256) + 0.5f) * __builtin_amdgcn_rcpf((float)(c_lo - c_hi)); const float off = (float)width * f;
               mid = lo + (off >= (float)width ? width - 1u : (unsigned)off); }
        if (mid <= lo) mid = lo + 1u; if (mid >= hi) mid = hi - 1u;
        const int c = cnt_ge(s, nit, mid, lane);
        if (c >= 256) { lo = mid; c_lo = c; } else { hi = mid; c_hi = c; }
        const unsigned nw = hi - lo; bis = !bis && (nw > (pw >> 2)); pw = nw;
    }
    }
    const unsigned long long lt = (1ull << lane) - 1ull;
    unsigned running = 0u, eq_taken = 0u;
    for (int rq_ = 0; rq_ < REP_TK_COMP; ++rq_) { running = 0u; eq_taken = 0u;
#pragma unroll 2
    for (int it = 0; it < nit; ++it) {
        const int i0 = 4 * (lane + 64 * it); const v4u kv = *(const LAS v4u*)(s + i0);
        bool sel[4], eq[4]; bool anyeq = false;
#pragma unroll
        for (int e = 0; e < 4; ++e) { sel[e] = kv[e] > T; eq[e] = need != 0u && kv[e] == T && (i0 + e < n); anyeq = anyeq || eq[e]; }
        if (need != 0u && __ballot(anyeq)) {
            unsigned lower = 0u, all = 0u;
#pragma unroll
            for (int e = 0; e < 4; ++e) { const unsigned long long bm = __ballot(eq[e]); lower += (unsigned)__popcll(bm & lt); all += (unsigned)__popcll(bm); }
            unsigned er = eq_taken + lower;
#pragma unroll
            for (int e = 0; e < 4; ++e) { if (eq[e]) { sel[e] = er < need; ++er; } }
            eq_taken += all;
        }
        unsigned lower = 0u, all = 0u;
#pragma unroll
        for (int e = 0; e < 4; ++e) { const unsigned long long sm = __ballot(sel[e]); lower += (unsigned)__popcll(sm & lt); all += (unsigned)__popcll(sm); }
        unsigned pos = running + lower;
#pragma unroll
        for (int e = 0; e < 4; ++e) { if (sel[e]) { if (pos < 256u) out[pos] = (OT)(i0 + e); ++pos; } }
        running += all;
    } }
}

constexpr int NCH = 33;
typedef short s16x4 __attribute__((ext_vector_type(4)));
typedef short v4i16_t __attribute__((ext_vector_type(4)));
__device__ __forceinline__ float wave_incl_scan_f(float v, int lane) {
#pragma unroll
    for (int o = 1; o < 64; o <<= 1) { const float t = __shfl_up(v, o); if (lane >= o) v += t; }
    return v;
}
__device__ __forceinline__ s16x4 ldtr(const LAS unsigned char* p) { return __builtin_bit_cast(s16x4, __builtin_amdgcn_ds_read_tr16_b64_v4i16((LAS v4i16_t*)p)); }
__device__ __forceinline__ bf16x8 frag_tr(const LAS unsigned char* img, int RS, int k0, int c0, int lane) {
    const int hh = lane >> 5, blk = (lane >> 4) & 1, q = (lane & 15) >> 2, pp = lane & 3;
    const LAS unsigned char* a = img + (k0 + 8 * hh + q) * RS + (c0 + 16 * blk + 4 * pp) * 2;
    const s16x4 lo = ldtr(a), hi = ldtr(a + 4 * RS);
    return (bf16x8){lo[0], lo[1], lo[2], lo[3], hi[0], hi[1], hi[2], hi[3]};
}
__device__ __forceinline__ bf16x8 frag_row(const LAS unsigned char* img, int RS, int r0, int k0, int lane) {
    return *(const LAS bf16x8*)(img + (r0 + (lane & 31)) * RS + (k0 + 8 * (lane >> 5)) * 2);
}
constexpr int RS_BC = 272, RS_X = 144, IMG_BC = 128 * RS_BC, IMG_X = 128 * RS_X;
__device__ __forceinline__ void ssd_stage_acum(LAS float* acl, LAS float* dtl, const GAS float* DT, const GAS float* a_log_l, size_t m0, int Lc, int g, int wave, int lane) {
    const int h = 8 * g + wave; const float A = -__expf(a_log_l[h]);
    const float d0 = lane < Lc ? DT[(m0 + lane) * 32 + h] : 0.f, d1 = (64 + lane) < Lc ? DT[(m0 + 64 + lane) * 32 + h] : 0.f;
    const float s0 = wave_incl_scan_f(d0 * A, lane), tot0 = __shfl(s0, 63), s1 = wave_incl_scan_f(d1 * A, lane) + tot0;
    acl[wave * 128 + lane] = s0; acl[wave * 128 + 64 + lane] = s1; dtl[wave * 128 + lane] = d0; dtl[wave * 128 + 64 + lane] = d1;
}
__device__ __forceinline__ void ssd_stage_bc(LAS unsigned char* img, const GAS bf16* src  , int Lc, int tid) {
    const int row = tid >> 2, part = tid & 3;
#pragma unroll
    for (int q4 = 0; q4 < 4; ++q4) { v4u v = (v4u){0u, 0u, 0u, 0u}; if (row < Lc) v = *(const GAS v4u*)(src + (size_t)row * CONVD + part * 32 + q4 * 8);
        *(LAS v4u*)(img + row * RS_BC + (part * 32 + q4 * 8) * 2) = v; }
}
__device__ __forceinline__ void ssd_stage_x(LAS unsigned char* img, const GAS bf16* src  , int Lc, int tid, float sc) {
    const int row = tid >> 2, part = tid & 3;
#pragma unroll
    for (int q2 = 0; q2 < 2; ++q2) { v4u o = (v4u){0u, 0u, 0u, 0u};
        if (row < Lc) { float f[8]; unpack8(*(const GAS v4u*)(src + (size_t)row * CONVD + part * 16 + q2 * 8), f);
            o = (v4u){pk2(f[0] * sc, f[1] * sc), pk2(f[2] * sc, f[3] * sc), pk2(f[4] * sc, f[5] * sc), pk2(f[6] * sc, f[7] * sc)}; }
        *(LAS v4u*)(img + row * RS_X + (part * 16 + q2 * 8) * 2) = o; }
}
__device__ __forceinline__ void ssd1_unit(LAS unsigned char* lds, int tid, const GAS bf16* XC, const GAS float* DT, const GAS float* a_log_l, GAS bf16* SB, GAS float* DEC, int b, int c, int g) {
    const int lane = tid & 63, wave = __builtin_amdgcn_readfirstlane(tid >> 6), hh = lane >> 5, col = lane & 31;
    const int t0 = c == 0 ? 0 : NMETA + 128 * (c - 1), Lc = c == 0 ? NMETA : 128; const size_t m0 = (size_t)b * LP + t0;
    LAS unsigned char* Bimg = lds; LAS unsigned char* Xw0 = lds + IMG_BC;
    LAS float* acl = (LAS float*)(lds + IMG_BC + 2 * IMG_X); LAS float* dtl = acl + 1024;
    ssd_stage_acum(acl, dtl, DT, a_log_l, m0, Lc, g, wave, lane);
    ssd_stage_bc(Bimg, XC + m0 * CONVD + DIN + g * NST, Lc, tid);
    __syncthreads();
    const int pb = wave >> 2, nb = wave & 3;
    for (int hl = 0; hl < 8; ++hl) {
        const int h = 8 * g + hl; LAS unsigned char* Xw = Xw0 + (hl & 1) * IMG_X;
        const float al = acl[hl * 128 + 127];
        { const int row = tid >> 2; ssd_stage_x(Xw, XC + m0 * CONVD + h * HP, Lc, tid, dtl[hl * 128 + row] * __expf(al - acl[hl * 128 + row])); }
        __syncthreads();
        f32x16 acc = {};
        if (Lc == 128) {
#pragma unroll
            for (int ks = 0; ks < 8; ++ks) acc = __builtin_amdgcn_mfma_f32_32x32x16_bf16(frag_tr(Xw, RS_X, 16 * ks, 32 * pb, lane), frag_tr(Bimg, RS_BC, 16 * ks, 32 * nb, lane), acc, 0, 0, 0);
        } else acc = __builtin_amdgcn_mfma_f32_32x32x16_bf16(frag_tr(Xw, RS_X, 0, 32 * pb, lane), frag_tr(Bimg, RS_BC, 0, 32 * nb, lane), acc, 0, 0, 0);
        GAS bf16* Sp = SB + ((size_t)(b * NCH + c) * NH + h) * (HP * NST) + 32 * nb + col;
#pragma unroll
        for (int r = 0; r < 16; ++r) Sp[(32 * pb + (r & 3) + 8 * (r >> 2) + 4 * hh) * NST] = (bf16)f2bf(acc[r]);
        if (tid == 0) DEC[(b * NCH + c) * NH + h] = __expf(al);
    }
    __syncthreads();
}
__device__ __forceinline__ void ssd3_unit(LAS unsigned char* lds, int tid, const GAS bf16* XC, const GAS bf16* P1, const GAS float* DT, const GAS float* a_log_l, const GAS float* dskip_l, const GAS float* normw_l,
                                          const GAS bf16* HC, GAS bf16* YSN, int b, int c, int g) {
    const int lane = tid & 63, wave = __builtin_amdgcn_readfirstlane(tid >> 6), hh = lane >> 5, col = lane & 31;
    const int t0 = c == 0 ? 0 : NMETA + 128 * (c - 1), Lc = c == 0 ? NMETA : 128; const size_t m0 = (size_t)b * LP + t0;
    LAS unsigned char* Bimg = lds; LAS unsigned char* Cimg = lds + IMG_BC; LAS unsigned char* Mimg = lds + 2 * IMG_BC; LAS unsigned char* Ximg = lds + 3 * IMG_BC;
    LAS float* acl = (LAS float*)(lds + 3 * IMG_BC + IMG_X); LAS float* dtl = acl + 1024;
    ssd_stage_acum(acl, dtl, DT, a_log_l, m0, Lc, g, wave, lane);
    ssd_stage_bc(Bimg, XC + m0 * CONVD + DIN + g * NST, Lc, tid);
    ssd_stage_bc(Cimg, XC + m0 * CONVD + DIN + NG * NST + g * NST, Lc, tid);
    __syncthreads();
    const int ib = wave >> 1, pb = wave & 1;
    f32x16 cb[2];
    const bool live = 32 * ib < Lc;
#pragma unroll
    for (int jj = 0; jj < 2; ++jj) { const int jb = 2 * (wave & 1) + jj; cb[jj] = (f32x16){};
        if (jb <= ib && live) {
#pragma unroll
            for (int ks = 0; ks < 8; ++ks) cb[jj] = __builtin_amdgcn_mfma_f32_32x32x16_bf16(frag_row(Cimg, RS_BC, 32 * ib, 16 * ks, lane), frag_row(Bimg, RS_BC, 32 * jb, 16 * ks, lane), cb[jj], 0, 0, 0); } }
    const int xrow = tid >> 2, xpart = tid & 3;
    const GAS bf16* xsrc = XC + (m0 + xrow) * CONVD + (8 * g) * HP + xpart * 16;
    v4u xq0 = (v4u){0u, 0u, 0u, 0u}, xq1 = xq0;
    if (xrow < Lc) { xq0 = *(const GAS v4u*)xsrc; xq1 = *(const GAS v4u*)(xsrc + 8); }
    for (int hl = 0; hl < 8; ++hl) {
        const int h = 8 * g + hl;
        bf16x8 hf[8];
        { const GAS bf16* Hp = HC + ((size_t)(b * NCH + c) * NH + h) * (HP * NST) + (size_t)(32 * pb + col) * NST + 8 * hh;
#pragma unroll
          for (int ks = 0; ks < 8; ++ks) hf[ks] = *(const GAS bf16x8*)(Hp + 16 * ks); }
        v4u xn0 = xq0, xn1 = xq1;
        if (hl < 7 && xrow < Lc) { xn0 = *(const GAS v4u*)(xsrc + (hl + 1) * HP); xn1 = *(const GAS v4u*)(xsrc + (hl + 1) * HP + 8); }
        float ai[16];
#pragma unroll
        for (int r = 0; r < 16; ++r) ai[r] = acl[hl * 128 + 32 * ib + (r & 3) + 8 * (r >> 2) + 4 * hh];
#pragma unroll
        for (int jj = 0; jj < 2; ++jj) { const int jb = 2 * (wave & 1) + jj;
            if (jb <= ib && live) { const int j = 32 * jb + col; const float aj = acl[hl * 128 + j];
                LAS unsigned char* mp = Mimg + (32 * ib + 4 * hh) * RS_BC + j * 2;
#pragma unroll
                for (int r = 0; r < 16; ++r) { const int il = (r & 3) + 8 * (r >> 2);
                    const float v = (j <= 32 * ib + 4 * hh + il) ? cb[jj][r] * __expf(ai[r] - aj) : 0.f;
                    *(LAS unsigned short*)(mp + il * RS_BC) = (unsigned short)f2bf(v); } } }
        { const float sc = dtl[hl * 128 + xrow]; float f[8]; v4u o0, o1;
          unpack8(xq0, f); o0 = (v4u){pk2(f[0] * sc, f[1] * sc), pk2(f[2] * sc, f[3] * sc), pk2(f[4] * sc, f[5] * sc), pk2(f[6] * sc, f[7] * sc)};
          unpack8(xq1, f); o1 = (v4u){pk2(f[0] * sc, f[1] * sc), pk2(f[2] * sc, f[3] * sc), pk2(f[4] * sc, f[5] * sc), pk2(f[6] * sc, f[7] * sc)};
          *(LAS v4u*)(Ximg + xrow * RS_X + (xpart * 16) * 2) = o0; *(LAS v4u*)(Ximg + xrow * RS_X + (xpart * 16 + 8) * 2) = o1; }
        __syncthreads();
        f32x16 a1 = {}, a2 = {};
        if (live) {
        const int nks = Lc == 128 ? 2 * (ib + 1) : 1;
        for (int ks = 0; ks < nks; ++ks) a1 = __builtin_amdgcn_mfma_f32_32x32x16_bf16(frag_row(Mimg, RS_BC, 32 * ib, 16 * ks, lane), frag_tr(Ximg, RS_X, 16 * ks, 32 * pb, lane), a1, 0, 0, 0);
#pragma unroll
        for (int ks = 0; ks < 8; ++ks) a2 = __builtin_amdgcn_mfma_f32_32x32x16_bf16(frag_row(Cimg, RS_BC, 32 * ib, 16 * ks, lane), hf[ks], a2, 0, 0, 0);
        GAS bf16* yo = YSN + (m0 + 32 * ib + 4 * hh) * DIN + h * HP + 32 * pb + col;
#pragma unroll
        for (int r = 0; r < 16; ++r) { const int il = (r & 3) + 8 * (r >> 2);
            if (32 * ib + 4 * hh + il < Lc) yo[(size_t)il * DIN] = (bf16)f2bf(a1[r] + __expf(ai[r]) * a2[r]); }
        }
        __syncthreads();
        xq0 = xn0; xq1 = xn1;
    }
    for (int i0 = wave; i0 < Lc; i0 += 4 * NWAVES) { const int c0 = g * 512 + lane * 8;
        v4u yv[4], xv[4], zv[4];
#pragma unroll
        for (int q = 0; q < 4; ++q) { const int i = i0 + NWAVES * q; const size_t m = m0 + (i < Lc ? i : i0);
            yv[q] = *(const GAS v4u*)(YSN + m * DIN + c0); xv[q] = *(const GAS v4u*)(XC + m * CONVD + c0); zv[q] = *(const GAS v4u*)(P1 + m * LDP1 + C_Z + c0); }
        const float Dh = dskip_l[c0 >> 6];
        const GAS float* wp = normw_l + c0; const f32x4 wa = *(const GAS f32x4*)wp, wb = *(const GAS f32x4*)(wp + 4);
#pragma unroll
        for (int q = 0; q < 4; ++q) { const int i = i0 + NWAVES * q;
            float v[8], x[8], z[8]; unpack8(yv[q], v); unpack8(xv[q], x); unpack8(zv[q], z); float ss = 0.f;
#pragma unroll
            for (int j = 0; j < 8; ++j) { v[j] = (v[j] + Dh * x[j]) * (z[j] * sigm(z[j])); ss += v[j] * v[j]; }
            ss = wave_sum(ss);
            const float rstd = 1.0f / sqrtf(ss * (1.0f / 512.0f) + 1e-6f);
            if (i < Lc) *(GAS v4u*)(YSN + (m0 + i) * DIN + c0) = (v4u){pk2(v[0] * rstd * wa.x, v[1] * rstd * wa.y), pk2(v[2] * rstd * wa.z, v[3] * rstd * wa.w), pk2(v[4] * rstd * wb.x, v[5] * rstd * wb.y), pk2(v[6] * rstd * wb.z, v[7] * rstd * wb.w)}; }
    }
    __syncthreads();
}

constexpr int RS_V = 528;
__device__ __forceinline__ void attn_prompt_query(LAS unsigned char* wl, const GAS bf16* P1, const GAS bf16* KVB, const GAS unsigned short* IDXP, GAS bf16* YA, int m, int lane_in) {
    int lane = lane_in; asm volatile("" : "+v"(lane));
    const int b = m / LP, t = m - b * LP, cnt = (t + 1) < 256 ? (t + 1) : 256, ntile = (cnt + 15) >> 4, nstep = (ntile + 1) >> 1;
    LAS unsigned char* Vst = wl; LAS unsigned short* idl = (LAS unsigned short*)(wl + 32 * RS_V);
    { const v2u w = *(const GAS v2u*)(IDXP + (size_t)m * 256 + 4 * lane); const int s0 = 4 * lane;
      const unsigned i0 = (s0 + 0 < cnt) ? (w.x & 0xffffu) : 0u, i1 = (s0 + 1 < cnt) ? (w.x >> 16) : 0u, i2 = (s0 + 2 < cnt) ? (w.y & 0xffffu) : 0u, i3 = (s0 + 3 < cnt) ? (w.y >> 16) : 0u;
      *(LAS v2u*)(idl + s0) = (v2u){i0 | (i1 << 16), i2 | (i3 << 16)}; }
    const int n = lane & 15, kg = lane >> 4;
    int k4 = 4 * kg; asm volatile("" : "+v"(k4));
    bf16x8 bq[8];
#pragma unroll
    for (int s = 0; s < 8; ++s) { bq[s] = (bf16x8){0, 0, 0, 0, 0, 0, 0, 0};
        if ((n >> 2) == (s >> 1)) bq[s] = *(const GAS bf16x8*)(P1 + (size_t)m * LDP1 + C_Q + n * 64 + 32 * (s & 1) + 8 * kg); }
    LDS_WAIT(); asm volatile("" ::: "memory");
    const GAS char* kvb = (const GAS char*)(KVB + (size_t)b * LP * 512);
    const unsigned koff = 16u * kg, voff = 512u + 16u * (lane & 31);
    LAS unsigned char* Sst = Vst;
    float mx = -INFINITY;
    bf16x8 kc[8], kn[8];
    { const unsigned ko = (unsigned)idl[n] * 1024u + koff;
#pragma unroll
      for (int s = 0; s < 8; ++s) kc[s] = *(const GAS bf16x8*)(kvb + ko + 64 * s); }
#pragma unroll
    for (int s = 0; s < 8; ++s) kn[s] = kc[s];
    if (1 < ntile) { const unsigned ko = (unsigned)idl[16 + n] * 1024u + koff;
#pragma unroll
        for (int s = 0; s < 8; ++s) kn[s] = *(const GAS bf16x8*)(kvb + ko + 64 * s); }
#pragma unroll
    for (int jt = 0; jt < 16; ++jt) {
        if (jt < ntile) {
            bf16x8 k2[8];
#pragma unroll
            for (int s = 0; s < 8; ++s) k2[s] = kn[s];
            if (jt + 2 < ntile) { const unsigned ko = (unsigned)idl[16 * (jt + 2) + n] * 1024u + koff;
#pragma unroll
                for (int s = 0; s < 8; ++s) k2[s] = *(const GAS bf16x8*)(kvb + ko + 64 * s); }
            f32x4 acc = {0.f, 0.f, 0.f, 0.f};
#pragma unroll
            for (int s = 0; s < 8; ++s) acc = __builtin_amdgcn_mfma_f32_16x16x32_bf16(kc[s], bq[s], acc, 0, 0, 0);
            f32x4 sv;
#pragma unroll
            for (int i = 0; i < 4; ++i) { const float v = (k4 + i < cnt - 16 * jt) ? acc[i] * 0.125f : -INFINITY; sv[i] = v; mx = fmaxf(mx, v); }
            *(LAS f32x4*)(Sst + jt * 1024 + lane * 16) = sv;
#pragma unroll
            for (int s = 0; s < 8; ++s) { kc[s] = kn[s]; kn[s] = k2[s]; }
        }
    }
    mx = fmaxf(mx, __shfl_xor(mx, 16)); mx = fmaxf(mx, __shfl_xor(mx, 32));
    float sum = 0.f;
    v4u pa[8];
#pragma unroll
    for (int s = 0; s < 8; ++s) { float p[8];
#pragma unroll
        for (int i = 0; i < 8; ++i) p[i] = 0.f;
        if (2 * s < ntile) { const f32x4 a = *(const LAS f32x4*)(Sst + (2 * s) * 1024 + lane * 16);
#pragma unroll
            for (int i = 0; i < 4; ++i) p[i] = __expf(a[i] - mx); }
        if (2 * s + 1 < ntile) { const f32x4 a = *(const LAS f32x4*)(Sst + (2 * s + 1) * 1024 + lane * 16);
#pragma unroll
            for (int i = 0; i < 4; ++i) p[4 + i] = __expf(a[i] - mx); }
#pragma unroll
        for (int i = 0; i < 8; ++i) sum += p[i];
        pa[s] = (v4u){pk2(p[0], p[1]), pk2(p[2], p[3]), pk2(p[4], p[5]), pk2(p[6], p[7])}; }
    LDS_WAIT(); asm volatile("" ::: "memory");
    sum += __shfl_xor(sum, 16); sum += __shfl_xor(sum, 32);
    const float linv = 1.0f / sum;
    asm volatile("" ::: "memory");
    v4u vr[16];
#pragma unroll
    for (int it = 0; it < 16; ++it) { const int rho = 2 * it + (lane >> 5), slot = 16 * ((rho >> 2) & 1) + 4 * (rho >> 3) + (rho & 3);
        vr[it] = *(const GAS v4u*)(kvb + ((unsigned)idl[slot] * 1024u + voff)); }
    f32x4 o[4];
#pragma unroll
    for (int c = 0; c < 4; ++c) o[c] = (f32x4){0.f, 0.f, 0.f, 0.f};
    const int g16 = lane >> 4, q4 = (lane & 15) >> 2, p4 = lane & 3;
    const LAS unsigned char* trb = Vst + (8 * g16 + q4) * RS_V + 8 * p4;
#pragma unroll
    for (int s = 0; s < 8; ++s) {
        if (s < nstep) {
#pragma unroll
            for (int it = 0; it < 16; ++it) *(LAS v4u*)(Vst + (2 * it + (lane >> 5)) * RS_V + 16 * (lane & 31)) = vr[it];
            LDS_WAIT(); asm volatile("" ::: "memory");
            if (s + 1 < nstep) {
#pragma unroll
                for (int it = 0; it < 16; ++it) { const int rho = 2 * it + (lane >> 5), slot = 32 * (s + 1) + 16 * ((rho >> 2) & 1) + 4 * (rho >> 3) + (rho & 3);
                    vr[it] = *(const GAS v4u*)(kvb + ((unsigned)idl[slot] * 1024u + voff)); } }
#pragma unroll
            for (int g = 0; g < 4; ++g) {
                const v4u pm = ((n >> 2) == g) ? pa[s] : (v4u){0u, 0u, 0u, 0u};
                const bf16x8 pf = __builtin_bit_cast(bf16x8, pm);
#pragma unroll
                for (int c = 0; c < 4; ++c) { const int ct = 4 * g + c;
                    const s16x4 lo = ldtr(trb + 32 * ct), hi = ldtr(trb + 4 * RS_V + 32 * ct);
                    const bf16x8 bv = (bf16x8){lo[0], lo[1], lo[2], lo[3], hi[0], hi[1], hi[2], hi[3]};
                    o[c] = __builtin_amdgcn_mfma_f32_16x16x32_bf16(pf, bv, o[c], 0, 0, 0); }
            }
            LDS_WAIT(); asm volatile("" ::: "memory");
        }
    }
#pragma unroll
    for (int i = 0; i < 4; ++i) { const float li = __shfl(linv, 4 * kg + i);
#pragma unroll
        for (int c = 0; c < 4; ++c) YA[(size_t)m * D + (4 * kg + i) * 64 + 16 * c + n] = (bf16)f2bf(o[c][i] * li); }
}

__device__ __forceinline__ void attn_sample_query(LAS unsigned char* lds, int tid, const GAS bf16* P1, const GAS bf16* KVB, const GAS float* ck, const GAS float* cv, const GAS int* ptab, const GAS int* IDXS, GAS bf16* YA, int qi) {
    const int lane = tid & 63, wave = tid >> 6, bd = qi >> 3; const size_t m = (size_t)MP + qi;
    LAS float* Sl = (LAS float*)lds;
    LAS float* Ol = Sl + 16 * 256;
    LAS float* ql = Ol + 8 * 1024;
    LAS float* linv = ql + 1024;
    LAS int* rowsel = (LAS int*)(linv + 16);
    { const unsigned w = *(const GAS unsigned*)(P1 + m * LDP1 + C_Q + 2 * tid); ql[2 * tid] = __uint_as_float(w << 16); ql[2 * tid + 1] = __uint_as_float(w & 0xffff0000u); }
    if (tid < 256) rowsel[tid] = IDXS[qi * 256 + tid];
    __syncthreads();
    const int g = lane >> 4, c = lane & 15;
    float qr[4][4];
#pragma unroll
    for (int a = 0; a < 4; ++a) { const f32x4 t = *(const LAS f32x4*)(ql + (4 * g + a) * 64 + 4 * c); qr[a][0] = t.x; qr[a][1] = t.y; qr[a][2] = t.z; qr[a][3] = t.w; }
#pragma unroll 4
    for (int kk = 0; kk < 32; ++kk) {
        const int key = 32 * wave + kk, idx = rowsel[key];
        f32x4 kv;
        if (idx < PAST) { const int page = ptab[bd * NPAGES + (idx >> 7)]; kv = *(const GAS f32x4*)(ck + ((size_t)page * PAGE + (idx & 127)) * 256 + 4 * lane); }
        else { const v2u w = *(const GAS v2u*)(KVB + (size_t)(MP + bd * DS + (idx - PAST)) * 512 + 4 * lane);
            kv = (f32x4){__uint_as_float(w.x << 16), __uint_as_float(w.x & 0xffff0000u), __uint_as_float(w.y << 16), __uint_as_float(w.y & 0xffff0000u)}; }
        float part[4];
#pragma unroll
        for (int a = 0; a < 4; ++a) { float s = (qr[a][0] * kv.x + qr[a][1] * kv.y) + (qr[a][2] * kv.z + qr[a][3] * kv.w);
            part[a] = row16_sum(s); }
        if (c == 0) {
#pragma unroll
            for (int a = 0; a < 4; ++a) Sl[(4 * g + a) * 256 + key] = part[a] * 0.125f; }
    }
    __syncthreads();
#pragma unroll
    for (int hs = 0; hs < 2; ++hs) { const int head = 2 * wave + hs; float v[4]; float mx = -INFINITY;
#pragma unroll
        for (int j = 0; j < 4; ++j) { v[j] = Sl[head * 256 + lane + 64 * j]; mx = fmaxf(mx, v[j]); }
        mx = wave_max(mx); float sum = 0.f;
#pragma unroll
        for (int j = 0; j < 4; ++j) { v[j] = __expf(v[j] - mx); sum += v[j]; Sl[head * 256 + lane + 64 * j] = v[j]; }
        sum = wave_sum(sum);
        if (lane == 0) linv[head] = 1.0f / sum; }
    __syncthreads();
    float o[4][4];
#pragma unroll
    for (int a = 0; a < 4; ++a)
#pragma unroll
        for (int cc = 0; cc < 4; ++cc) o[a][cc] = 0.f;
#pragma unroll 4
    for (int kk = 0; kk < 32; ++kk) {
        const int key = 32 * wave + kk, idx = rowsel[key];
        f32x4 vv;
        if (idx < PAST) { const int page = ptab[bd * NPAGES + (idx >> 7)]; vv = *(const GAS f32x4*)(cv + ((size_t)page * PAGE + (idx & 127)) * 256 + 4 * lane); }
        else { const v2u w = *(const GAS v2u*)(KVB + (size_t)(MP + bd * DS + (idx - PAST)) * 512 + 256 + 4 * lane);
            vv = (f32x4){__uint_as_float(w.x << 16), __uint_as_float(w.x & 0xffff0000u), __uint_as_float(w.y << 16), __uint_as_float(w.y & 0xffff0000u)}; }
#pragma unroll
        for (int a = 0; a < 4; ++a) { const float p = Sl[(4 * g + a) * 256 + key]; o[a][0] += p * vv.x; o[a][1] += p * vv.y; o[a][2] += p * vv.z; o[a][3] += p * vv.w; }
    }
#pragma unroll
    for (int a = 0; a < 4; ++a) *(LAS f32x4*)(Ol + wave * 1024 + (4 * g + a) * 64 + 4 * c) = (f32x4){o[a][0], o[a][1], o[a][2], o[a][3]};
    __syncthreads();
    { float s0 = 0.f, s1 = 0.f;
#pragma unroll
      for (int w = 0; w < 8; ++w) { s0 += Ol[w * 1024 + 2 * tid]; s1 += Ol[w * 1024 + 2 * tid + 1]; }
      const float li = linv[(2 * tid) >> 6];
      *(GAS unsigned*)(YA + m * D + 2 * tid) = pk2(s0 * li, s1 * li); }
    __syncthreads();
}

constexpr int TAIL_R0 = 16384, TAIL_NRT = (MR - TAIL_R0) / 64;
static_assert(TAIL_R0 + 64 * TAIL_NRT == MR, "tail rows");
template <int MODE>
__device__ __forceinline__ void tail_gemm(LAS unsigned char* lds, const GAS bf16* A, int K, const GAS bf16* Bt, int N, const GAS bf16* P1, GAS bf16* T1, GAS bf16* MG, GAS float* H, GAS bf16* A2, int bx, int G, int tid) {
    constexpr int KB = 256, RS = (KB + 8) * 2;
    const int lane = tid & 63, wave = __builtin_amdgcn_readfirstlane(tid >> 6), col = lane & 31, hh = lane >> 5;
    const int nunits = TAIL_NRT * (N / 64), lr = tid >> 3, lc = tid & 7, ti = wave & 3, kh = wave >> 2;
    LAS unsigned char* As = lds; LAS unsigned char* Bs = lds + 64 * RS; LAS float* red = (LAS float*)(lds + 2 * 64 * RS);
    for (int u = bx; u < nunits; u += G) {
        const int rt = u % TAIL_NRT, ct = u / TAIL_NRT;
        const GAS bf16* ap = A + (size_t)(TAIL_R0 + 64 * rt + lr) * K + 8 * lc;
        const GAS bf16* bp = Bt + (size_t)(64 * ct + lr) * K + 8 * lc;
        v4u ra[4], rb[4];
#pragma unroll
        for (int j = 0; j < 4; ++j) { ra[j] = *(const GAS v4u*)(ap + 64 * j); rb[j] = *(const GAS v4u*)(bp + 64 * j); }
        f32x16 acc = {};
        for (int k0 = 0; k0 < K; k0 += KB) {
            __syncthreads();
#pragma unroll
            for (int j = 0; j < 4; ++j) { *(LAS v4u*)(As + lr * RS + (lc * 8 + 64 * j) * 2) = ra[j]; *(LAS v4u*)(Bs + lr * RS + (lc * 8 + 64 * j) * 2) = rb[j]; }
            if (k0 + KB < K) {
#pragma unroll
                for (int j = 0; j < 4; ++j) { ra[j] = *(const GAS v4u*)(ap + k0 + KB + 64 * j); rb[j] = *(const GAS v4u*)(bp + k0 + KB + 64 * j); } }
            __syncthreads();
#pragma unroll
            for (int j = 0; j < 8; ++j) { const int ks = 8 * kh + j;
                const bf16x8 av = *(const LAS bf16x8*)(As + (32 * (ti >> 1) + col) * RS + (16 * ks + 8 * hh) * 2), bv = *(const LAS bf16x8*)(Bs + (32 * (ti & 1) + col) * RS + (16 * ks + 8 * hh) * 2);
                acc = __builtin_amdgcn_mfma_f32_32x32x16_bf16(av, bv, acc, 0, 0, 0); }
        }
        __syncthreads();
        if (kh == 1) {
#pragma unroll
            for (int r = 0; r < 16; ++r) red[(ti * 16 + r) * 64 + lane] = acc[r]; }
        __syncthreads();
        if (kh == 0) {
            const int c = 64 * ct + 32 * (ti & 1) + col;
#pragma unroll
            for (int r = 0; r < 16; ++r) { const size_t row = TAIL_R0 + 64 * rt + 32 * (ti >> 1) + (r & 3) + 8 * (r >> 2) + 4 * hh; const float v = acc[r] + red[(ti * 16 + r) * 64 + lane];
                if (MODE == 1) { const float g = __uint_as_float((unsigned)P1[row * LDP1 + C_GS + c] << 16); T1[row * D + c] = (bf16)f2bf(v * sigm(g)); }
                if (MODE == 2) { const float g = __uint_as_float((unsigned)P1[row * LDP1 + C_GA + c] << 16); MG[row * D + c] = (bf16)f2bf(__uint_as_float((unsigned)T1[row * D + c] << 16) + v * sigm(g)); }
                if (MODE == 3) H[row * D + c] += v;
                if (MODE == 4) { const float w = fmaxf(v, 0.f); A2[row * DFF + c] = (bf16)f2bf(w * w); } }
        }
    }
    __syncthreads();
}

#ifndef REP_SEL
#define REP_SEL 1
#endif
#ifndef REP_CONV
#define REP_CONV 1
#endif
#ifndef REP_TOPK
#define REP_TOPK 1
#endif
#ifndef REP_SSC
#define REP_SSC 1
#endif
#ifndef REP_SSEL
#define REP_SSEL 1
#endif
#ifndef REP_SSD1
#define REP_SSD1 1
#endif
#ifndef REP_SREC
#define REP_SREC 1
#endif
#ifndef REP_SCAN
#define REP_SCAN 1
#endif
#ifndef REP_ATTS
#define REP_ATTS 1
#endif
#ifndef REP_ATTP
#define REP_ATTP 1
#endif
#ifndef REP_SSD3
#define REP_SSD3 1
#endif
__device__ __noinline__ void xcd_barrier_ni(unsigned* bar, unsigned x, volatile LAS unsigned* st, int tid, unsigned G) { XcdBarrier b; b.bar = bar; b.x = x; b.st = st; xcd_barrier(b, tid, G); }
__device__ __forceinline__ void assume_global(const void* p) {
#if defined(__HIP_DEVICE_COMPILE__)
    __builtin_assume(!__builtin_amdgcn_is_shared((const __attribute__((address_space(0))) void*)p));
    __builtin_assume(!__builtin_amdgcn_is_private((const __attribute__((address_space(0))) void*)p));
#else
    (void)p;
#endif
}
constexpr int NPH = 12, NPHASES = 1 + 2 * NPH;
struct Args { const void* in[24]; float* out; unsigned char* ws; int l_lo, l_hi; };
static_assert(sizeof(Args) == 24 * 8 + 8 + 8 + 8, "Args has no padding");

template <int KLO, int KHI>
__global__ void __launch_bounds__(NT, 2) fwd_t(Args args) {
    extern __shared__ __attribute__((aligned(16))) unsigned char lds_raw[];
    LAS unsigned char* lds0 = (LAS unsigned char*)lds_raw;
    volatile LAS unsigned* MISCW = (volatile LAS unsigned*)(lds0 + MISC_OFF);
    const int G = gridDim.x, bx = blockIdx.x, NGW = G * NWAVES;
    { const int tid0 = threadIdx.x;
      for (int u = tid0; u < (LDS_BYTES - LDSCTL_OFF) / 4; u += NT) ((LAS unsigned*)(lds0 + LDSCTL_OFF))[u] = 0u; }
    __syncthreads();
    XcdBarrier bar = xcd_barrier_post((unsigned*)(args.ws + WS_CTL) + CW_BAR, MISCW + 8);
#define IN(k) (KLO <= (k) && (k) < KHI)
#define SEAM(k) do { if (IN(k) && IN((k) + 1)) xcd_barrier_ni(bar.bar, bar.x, bar.st, (int)threadIdx.x, (unsigned)G); } while (0)
#define PHASE_REGS \
    int tid = threadIdx.x; asm volatile("" : "+v"(tid)); \
    int bxl = bx, Gl = G; asm volatile("" : "+s"(bxl), "+s"(Gl)); (void)bxl; (void)Gl;     \
    const int lane = tid & 63, wave = __builtin_amdgcn_readfirstlane(tid >> 6), gw = bx * NWAVES + wave; \
    unsigned char* ws_ = args.ws; asm volatile("" : "+s"(ws_)); GAS unsigned char* ws = (GAS unsigned char*)ws_;     \
    float* out_ = args.out; asm volatile("" : "+s"(out_)); GAS float* out = (GAS float*)out_; \
    (void)lane; (void)gw; (void)out; \
    GAS float* H = (GAS float*)(ws + WS_H); GAS bf16* U = (GAS bf16*)(ws + WS_U); GAS bf16* P1 = (GAS bf16*)(ws + WS_P1); GAS float* MISCB = (GAS float*)(ws + WS_MISC); GAS bf16* KIB = (GAS bf16*)(ws + WS_KIB); \
    GAS bf16* XC = (GAS bf16*)(ws + WS_XC); GAS float* DT = (GAS float*)(ws + WS_DT); GAS float* DA = (GAS float*)(ws + WS_DA); GAS float* YS = (GAS float*)(ws + WS_YS); GAS bf16* YSN = (GAS bf16*)(ws + WS_YSN); \
    GAS bf16* YA = (GAS bf16*)(ws + WS_YA); GAS bf16* T1 = (GAS bf16*)(ws + WS_T1); GAS bf16* MG = (GAS bf16*)(ws + WS_MG); GAS bf16* A2 = (GAS bf16*)(ws + WS_A2); \
    GAS unsigned short* IDXP = (GAS unsigned short*)(ws + WS_IDXP); GAS int* IDXS = (GAS int*)(ws + WS_IDXS); GAS float* SCS = (GAS float*)(ws + WS_SCS); \
    GAS bf16* SB = (GAS bf16*)(ws + WS_SB); GAS float* DEC = (GAS float*)(ws + WS_DEC); GAS bf16* HC = (GAS bf16*)(ws + WS_HC); GAS bf16* KVB = (GAS bf16*)(ws + WS_KVB); (void)SB; (void)DEC; (void)HC; (void)KVB; \
    GAS unsigned char* wl = ws + WS_W + (size_t)l * WL_SIZE; \
    (void)H; (void)U; (void)P1; (void)MISCB; (void)KIB; (void)XC; (void)DT; (void)DA; (void)YS; (void)YSN; (void)YA; (void)T1; (void)MG; (void)A2; (void)IDXP; (void)IDXS; (void)SCS; (void)wl;
#define LDS_LOCAL LAS unsigned char* lds = lds0; asm volatile("" : "+s"(lds));
#define INP(T, name, i) const GAS T* name; { const void* p_; asm volatile("s_load_dwordx2 %0, %1, %2\n\ts_waitcnt lgkmcnt(0)" : "=s"(p_) : "s"(__builtin_amdgcn_kernarg_segment_ptr()), "i"((i) * 8)); name = (const GAS T*)p_; }

    if (IN(0) && args.l_lo == 0) {
        const int l = 0; PHASE_REGS
        LDS_LOCAL
        INP(float, w_in, 10) INP(float, w_ssm, 17) INP(float, w_att, 18) INP(float, w_out, 19) INP(float, w_up, 21) INP(float, w_down, 22) INP(float, meta, 8) INP(float, x_prompt, 0) INP(float, x_sample, 1) INP(float, norm1_w, 9)
        LAS float* scr = (LAS float*)(lds + wave * 17408);
        constexpr int I_IN = (D / 64) * (NIN / 64), I_SSM = (DIN / 64) * (D / 64), I_ATT = (D / 64) * (D / 64), I_OUT = I_ATT, I_UP = (D / 64) * (DFF / 64), I_DN = (DFF / 64) * (D / 64);
        constexpr int I_L = I_IN + I_SSM + I_ATT + I_OUT + I_UP + I_DN;
        for (int it = gw; it < 2 * I_L; it += NGW) {
            const int l = it / I_L; int r = it % I_L; GAS unsigned char* wl = ws + WS_W + (size_t)l * WL_SIZE;
            if (r < I_IN) { tr_item(w_in + (size_t)l * D * IN_DIM, D, IN_DIM, (GAS bf16*)(wl + WL_WIN), NIN / 64, true, scr, r, lane); continue; } r -= I_IN;
            if (r < I_SSM) { tr_item(w_ssm + (size_t)l * DIN * D, DIN, D, (GAS bf16*)(wl + WL_WSSM), D / 64, false, scr, r, lane); continue; } r -= I_SSM;
            if (r < I_ATT) { tr_item(w_att + (size_t)l * D * D, D, D, (GAS bf16*)(wl + WL_WATT), D / 64, false, scr, r, lane); continue; } r -= I_ATT;
            if (r < I_OUT) { tr_item(w_out + (size_t)l * D * D, D, D, (GAS bf16*)(wl + WL_WOUT), D / 64, false, scr, r, lane); continue; } r -= I_OUT;
            if (r < I_UP) { tr_item(w_up + (size_t)l * D * DFF, D, DFF, (GAS bf16*)(wl + WL_WUP), DFF / 64, false, scr, r, lane); continue; } r -= I_UP;
            tr_item(w_down + (size_t)l * DFF * D, DFF, D, (GAS bf16*)(wl + WL_WDN), D / 64, false, scr, r, lane);
        }
        for (int m = gw; m < MPAD; m += NGW) {
            const GAS float* src = nullptr;
            if (m < MP) { const int b = m / LP, t = m - b * LP; src = t < NMETA ? meta + (size_t)t * D : x_prompt + ((size_t)b * SEQ + (t - NMETA)) * D; }
            else if (m < MR) src = x_sample + (size_t)(m - MP) * D;
            rms_row(src, norm1_w, H + (size_t)m * D, U + (size_t)m * D, nullptr, lane);
        }
    }
    SEAM(0);

    for (int l = args.l_lo; l < args.l_hi; ++l) {
        constexpr int pb = 1;

        if (IN(pb + 0)) {
            PHASE_REGS
            LAS unsigned char* lds = lds0;
            pg8::Gemm gm{U, (const GAS bf16*)(wl + WL_WIN), MPAD, NIN, D}; pg8::StaticOrder S; S.init(MPAD, NIN, Gl, bxl);
            pg8::EpiIn E{P1, KVB, MISCB, KIB, out + O_PK + (size_t)l * MP * 256, out + O_PV + (size_t)l * MP * 256, out + O_PKI + (size_t)l * MP * 64,
                         out + O_SK + (size_t)l * MS * 256, out + O_SV + (size_t)l * MS * 256, out + O_SKI + (size_t)l * MS * 64};
            pg8::gemm_phase<pg8::EpiIn, pg8::StaticOrder, true, true>(lds, gm, S, E, tid);
        }
        SEAM(pb + 0);

        if (IN(pb + 1)) {
            PHASE_REGS
            LDS_LOCAL
            INP(float, state_conv, 6) INP(float, conv_b, 12) INP(float, conv_w, 11) INP(float, dt_bias, 13) INP(float, a_log, 14) INP(float, cache_ki, 4) INP(int, page_table, 7)
            for (int rp_ = 0; rp_ < REP_CONV; ++rp_) for (int it = bx * NT + tid; it < (MR / 8) * 384; it += G * NT) {
                const int rg = it / 384, c8 = (it % 384) * 8, m0 = 8 * rg;
                const bool isS = m0 >= MP; int tpos, sq;
                if (!isS) { sq = m0 / LP; tpos = m0 - sq * LP; } else { sq = (m0 - MP) >> 3; tpos = (m0 - MP) & 7; }
                float xv[11][8];
#pragma unroll
                for (int k = 0; k < 11; ++k) { const int dtp = tpos - 3 + k;
                    if (dtp >= 0) unpack8(*(const GAS v4u*)(P1 + (size_t)(m0 - 3 + k) * LDP1 + C_XBC + c8), xv[k]);
                    else if (isS) { const GAS float* pp = state_conv + ((size_t)(l * DB + sq) * 3 + (3 + dtp)) * CONVD + c8; const f32x4 a = *(const GAS f32x4*)pp, b = *(const GAS f32x4*)(pp + 4);
                        xv[k][0] = a.x; xv[k][1] = a.y; xv[k][2] = a.z; xv[k][3] = a.w; xv[k][4] = b.x; xv[k][5] = b.y; xv[k][6] = b.z; xv[k][7] = b.w; }
                    else {
#pragma unroll
                        for (int j = 0; j < 8; ++j) xv[k][j] = 0.f; } }
                float wv[4][8], bv[8];
                { const GAS float* bp = conv_b + (size_t)l * CONVD + c8; const f32x4 a = *(const GAS f32x4*)bp, b = *(const GAS f32x4*)(bp + 4);
                  bv[0] = a.x; bv[1] = a.y; bv[2] = a.z; bv[3] = a.w; bv[4] = b.x; bv[5] = b.y; bv[6] = b.z; bv[7] = b.w; }
#pragma unroll
                for (int k = 0; k < 4; ++k) { const GAS float* wp = conv_w + ((size_t)l * 4 + k) * CONVD + c8; const f32x4 a = *(const GAS f32x4*)wp, b = *(const GAS f32x4*)(wp + 4);
                    wv[k][0] = a.x; wv[k][1] = a.y; wv[k][2] = a.z; wv[k][3] = a.w; wv[k][4] = b.x; wv[k][5] = b.y; wv[k][6] = b.z; wv[k][7] = b.w; }
#pragma unroll
                for (int r = 0; r < 8; ++r) {
                    float y[8];
#pragma unroll
                    for (int j = 0; j < 8; ++j) { float s = bv[j];
#pragma unroll
                        for (int k = 0; k < 4; ++k) s += xv[r + k][j] * wv[k][j];
                        y[j] = s * sigm(s); }
                    *(GAS v4u*)(XC + (size_t)(m0 + r) * CONVD + c8) = (v4u){pk2(y[0], y[1]), pk2(y[2], y[3]), pk2(y[4], y[5]), pk2(y[6], y[7])};
                    const int tp = tpos + r; GAS float* cs = nullptr;
                    if (!isS && tp >= LP - 3) cs = out + O_PCONV + ((size_t)(l * NB + sq) * 3 + (tp - (LP - 3))) * CONVD + c8;
                    if (isS && tp >= DS - 3) cs = out + O_SCONV + ((size_t)(l * DB + sq) * 3 + (tp - (DS - 3))) * CONVD + c8;
                    if (cs) { *(GAS f32x4*)cs = (f32x4){xv[r + 3][0], xv[r + 3][1], xv[r + 3][2], xv[r + 3][3]}; *(GAS f32x4*)(cs + 4) = (f32x4){xv[r + 3][4], xv[r + 3][5], xv[r + 3][6], xv[r + 3][7]}; }
                }
            }
            for (int it = bx * NT + tid; it < MR * NH; it += G * NT) {
                const int m = it >> 5, h = it & 31;
                const float raw = MISCB[(size_t)m * 128 + MC_DT + h] + dt_bias[l * NH + h];
                const float sp = fmaxf(raw, 0.f) + log1pf(__expf(-fabsf(raw)));
                const float A = -__expf(a_log[l * NH + h]);
                DT[it] = sp; DA[it] = __expf(sp * A);
            }
            for (int rp_ = 0; rp_ < REP_TOPK; ++rp_) {
                constexpr int SLD = 4352;
                LAS unsigned* scl = (LAS unsigned*)lds;
                for (int j = 0; ; ++j) {
                    const int unit = j * G + ((j & 1) ? (G - 1 - bx) : bx); if (unit >= NB * (LP / 8)) break;
                    const int b = unit & (NB - 1), qb = (LP / 8 - 1) - (unit >> 2);
                    const size_t mq0 = (size_t)b * LP + 8 * qb; const int nkeys = 8 * qb + 8, ntl = (nkeys + 31) >> 5;
                    bf16x8 afr[2][4]; float wq[2][2][8];
                    idx_load_q(P1, MISCB, mq0, lane, afr, wq);
                    const int kcol = lane & 31, hh = lane >> 5;
                    const GAS bf16* kp0 = KIB + ((size_t)b * LP + kcol) * 64 + 8 * hh;
                    bf16x8 bnx[4], bn2[4];
#pragma unroll
                    for (int ks = 0; ks < 4; ++ks) { bnx[ks] = (bf16x8){0, 0, 0, 0, 0, 0, 0, 0}; bn2[ks] = bnx[ks]; }
                    if (wave < ntl) {
#pragma unroll
                        for (int ks = 0; ks < 4; ++ks) bnx[ks] = *(const GAS bf16x8*)(kp0 + (size_t)wave * 32 * 64 + 16 * ks); }
                    if (wave + NWAVES < ntl) {
#pragma unroll
                        for (int ks = 0; ks < 4; ++ks) bn2[ks] = *(const GAS bf16x8*)(kp0 + (size_t)(wave + NWAVES) * 32 * 64 + 16 * ks); }
                    for (int kt = wave; kt < ntl; kt += NWAVES) {
                        bf16x8 bfr[4];
#pragma unroll
                        for (int ks = 0; ks < 4; ++ks) { bfr[ks] = bnx[ks]; bnx[ks] = bn2[ks]; }
                        if (kt + 2 * NWAVES < ntl) {
#pragma unroll
                            for (int ks = 0; ks < 4; ++ks) bn2[ks] = *(const GAS bf16x8*)(kp0 + (size_t)(kt + 2 * NWAVES) * 32 * 64 + 16 * ks); }
                        float sc[2][2];
                        idx_scores(afr, bfr, wq, sc);
                        const int key = 32 * kt + kcol;
#pragma unroll
                        for (int rt = 0; rt < 2; ++rt)
#pragma unroll
                            for (int jq = 0; jq < 2; ++jq) scl[(4 * rt + 2 * hh + jq) * SLD + key] = f2key(sc[rt][jq]);
                    }
                    __syncthreads();
                    for (int r2_ = 0; r2_ < REP_SEL; ++r2_) { const int t = 8 * qb + wave, n = t + 1; GAS unsigned short* op = IDXP + ((size_t)b * LP + t) * 256;
                      if (n <= 256) { for (int i = lane; i < n; i += 64) op[i] = (unsigned short)i; }
                      else topk_select(scl + wave * SLD, n, lane, op); }
                    __syncthreads();
                }
            }
            const GAS float* cki = cache_ki + (size_t)l * NPOOL * PAGE * 64;
            for (int rp_ = 0; rp_ < REP_SSC; ++rp_) for (int unit = bx; unit < DB * 8; unit += G) {
                const int bd = unit >> 3, ch = unit & 7; const size_t mq0 = (size_t)MP + bd * DS;
                bf16x8 afr[2][4]; float wq[2][2][8];
                idx_load_q(P1, MISCB, mq0, lane, afr, wq);
                const int kcol = lane & 31, hh = lane >> 5;
                const int pg = 8 * ch + wave, phys = page_table[bd * NPAGES + pg];
                const GAS float* kbase = cki + (size_t)phys * PAGE * 64;
#pragma unroll 1
                for (int kt = 0; kt < 4; ++kt) {
                    const int kin = 32 * kt + kcol; const GAS float* kp = kbase + (size_t)kin * 64 + 8 * hh;
                    bf16x8 bfr[4];
#pragma unroll
                    for (int ks = 0; ks < 4; ++ks) { const f32x4 a = *(const GAS f32x4*)(kp + 16 * ks), bq = *(const GAS f32x4*)(kp + 16 * ks + 4);
                        const v4u w = (v4u){pk2(a.x, a.y), pk2(a.z, a.w), pk2(bq.x, bq.y), pk2(bq.z, bq.w)}; bfr[ks] = __builtin_bit_cast(bf16x8, w); }
                    float sc[2][2];
                    idx_scores(afr, bfr, wq, sc);
#pragma unroll
                    for (int rt = 0; rt < 2; ++rt)
#pragma unroll
                        for (int jq = 0; jq < 2; ++jq) SCS[(size_t)(bd * DS + 4 * rt + 2 * hh + jq) * SCS_LD + 128 * pg + kin] = sc[rt][jq];
                }
                if (ch == 7 && wave == 0) {
                    const int j = kcol < DS ? kcol : DS - 1; const GAS bf16* kp = KIB + (mq0 + j) * 64 + 8 * hh;
                    bf16x8 bfr[4];
#pragma unroll
                    for (int ks = 0; ks < 4; ++ks) bfr[ks] = *(const GAS bf16x8*)(kp + 16 * ks);
                    float sc[2][2];
                    idx_scores(afr, bfr, wq, sc);
                    if (kcol < DS) {
#pragma unroll
                        for (int rt = 0; rt < 2; ++rt)
#pragma unroll
                            for (int jq = 0; jq < 2; ++jq) { const int q = 4 * rt + 2 * hh + jq; SCS[(size_t)(bd * DS + q) * SCS_LD + PAST + kcol] = (kcol <= q) ? sc[rt][jq] : -INFINITY; }
                    }
                }
            }
        }
        SEAM(pb + 1);

        if (IN(pb + 2)) {
            PHASE_REGS
            LDS_LOCAL
            INP(float, a_log, 14) INP(float, state_ssm, 5) INP(float, d_skip, 15)
            for (int rp_ = 0; rp_ < REP_SSEL; ++rp_) for (int qi = bx; qi < MS; qi += G) {
                LAS unsigned* scl = (LAS unsigned*)lds;
                for (int i = tid; i < PAST + DS; i += NT) scl[i] = f2key(SCS[(size_t)qi * SCS_LD + i]);
                __syncthreads();
                if (wave == 0) { int ns = PAST + DS; asm volatile("" : "+s"(ns)); topk_select(scl, ns, lane, IDXS + qi * 256); }
                __syncthreads();
            }
            for (int rp_ = 0; rp_ < REP_SSD1; ++rp_) for (int unit = bx; unit < NB * NCH * NG; unit += G) {
                int b, c, g; if (unit < NB * 32 * NG) { b = unit >> 7; c = 1 + ((unit & 127) >> 2); g = unit & 3; } else { const int r = unit - NB * 32 * NG; b = r >> 2; c = 0; g = r & 3; }
                ssd1_unit(lds, tid, XC, DT, a_log + l * NH, SB, DEC, b, c, g);
            }
            for (int rp_ = 0; rp_ < REP_SREC; ++rp_) for (int unit = bx; unit < DB * NH * 2; unit += G) {
                const int bd = unit >> 6, h = (unit >> 1) & 31, p0 = (unit & 1) * 32;
                ssd_unit(lds, tid, XC, DT, DA, (size_t)MP + bd * DS, DS, h, p0, state_ssm + ((size_t)(l * DB + bd) * NH + h) * HP * NST,
                         out + O_SSSM + ((size_t)(l * DB + bd) * NH + h) * HP * NST, YS, d_skip[l * NH + h]);
                __syncthreads();
            }
        }
        SEAM(pb + 2);

        if (IN(pb + 3)) {
            PHASE_REGS
            LDS_LOCAL
            INP(float, cache_k, 2) INP(float, cache_v, 3) INP(int, page_table, 7)
            for (int rp_ = 0; rp_ < REP_SCAN; ++rp_) for (int e = bx * NT + tid; e < NB * NH * 2048; e += G * NT) {
                const int b = e / (NH * 2048), h = (e >> 11) & 31, q = e & 2047;
                f32x4 Hr = {0.f, 0.f, 0.f, 0.f};
#pragma unroll 3
                for (int c = 0; c < NCH; ++c) { const size_t idx = (size_t)(b * NCH + c) * NH + h;
                    *(GAS v2u*)(HC + idx * (HP * NST) + q * 4) = (v2u){pk2(Hr.x, Hr.y), pk2(Hr.z, Hr.w)};
                    const float d = DEC[idx]; const v2u sw = *(const GAS v2u*)(SB + idx * (HP * NST) + q * 4);
                    const f32x4 sv = (f32x4){__uint_as_float(sw.x << 16), __uint_as_float(sw.x & 0xffff0000u), __uint_as_float(sw.y << 16), __uint_as_float(sw.y & 0xffff0000u)};
                    Hr = Hr * d + sv; }
                *(GAS f32x4*)(out + O_PSSM + ((size_t)(l * NB + b) * NH + h) * (HP * NST) + q * 4) = Hr;
            }
            const GAS float* ck = cache_k + (size_t)l * NPOOL * PAGE * 256; const GAS float* cv = cache_v + (size_t)l * NPOOL * PAGE * 256;
            for (int rp_ = 0; rp_ < REP_ATTS; ++rp_) for (int qi = bx; qi < MS; qi += G) attn_sample_query(lds, tid, P1, KVB, ck, cv, page_table, IDXS, YA, qi);
        }
        SEAM(pb + 3);

        if (IN(pb + 4)) {
            PHASE_REGS
            LDS_LOCAL
            INP(float, a_log, 14) INP(float, d_skip, 15) INP(float, ssm_norm_w, 16)
            const bool att_first = ((bxl >> 3) & 1) == 0;
            for (int stage_ = 0; stage_ < 2; ++stage_) {
            if ((stage_ == 0) == att_first) {
            for (int rp_ = 0; rp_ < REP_ATTP; ++rp_) {
                    if (Gl == 256) {
                        const int bsel = (bxl & 7) >> 1, widx = ((((bxl >> 3) * NWAVES) + wave) << 1) | (bxl & 1);
                        for (int tr = widx; tr < LP; tr += 512) attn_prompt_query(lds + wave * 17408, P1, KVB, IDXP, YA, bsel * LP + (LP - 1 - tr), lane);
                    } else for (int m = gw; m < MP; m += NGW) attn_prompt_query(lds + wave * 17408, P1, KVB, IDXP, YA, m, lane);
                }
                __syncthreads();
            } else {
            for (int rp_ = 0; rp_ < REP_SSD3; ++rp_) for (int unit = bx; unit < NB * NCH * NG; unit += G) {
                int b, c, g; if (unit < NB * 32 * NG) { b = unit >> 7; c = 1 + ((unit & 127) >> 2); g = unit & 3; } else { const int r = unit - NB * 32 * NG; b = r >> 2; c = 0; g = r & 3; }
                ssd3_unit(lds, tid, XC, P1, DT, a_log + l * NH, d_skip + l * NH, ssm_norm_w + (size_t)l * DIN, HC, YSN, b, c, g);
            }
            for (int it = gw; it < MS * NG; it += NGW) {
                const int m = MP + (it >> 2), g = it & 3, c0 = g * 512 + lane * 8;
                const GAS float* yp = YS + (size_t)m * DIN + c0; const f32x4 a = *(const GAS f32x4*)yp, b = *(const GAS f32x4*)(yp + 4);
                float z[8]; unpack8(*(const GAS v4u*)(P1 + (size_t)m * LDP1 + C_Z + c0), z);
                float v[8] = {a.x, a.y, a.z, a.w, b.x, b.y, b.z, b.w}; float ss = 0.f;
#pragma unroll
                for (int j = 0; j < 8; ++j) { v[j] = v[j] * (z[j] * sigm(z[j])); ss += v[j] * v[j]; }
                ss = wave_sum(ss);
                const float rstd = 1.0f / sqrtf(ss * (1.0f / 512.0f) + 1e-6f);
                const GAS float* wp = ssm_norm_w + (size_t)l * DIN + c0; const f32x4 wa = *(const GAS f32x4*)wp, wb = *(const GAS f32x4*)(wp + 4);
                *(GAS v4u*)(YSN + (size_t)m * DIN + c0) = (v4u){pk2(v[0] * rstd * wa.x, v[1] * rstd * wa.y), pk2(v[2] * rstd * wa.z, v[3] * rstd * wa.w), pk2(v[4] * rstd * wb.x, v[5] * rstd * wb.y), pk2(v[6] * rstd * wb.z, v[7] * rstd * wb.w)};
            }
            } }
        }
        SEAM(pb + 4);

        if (IN(pb + 5)) {
            PHASE_REGS
            LAS unsigned char* lds = lds0;
            pg8::Gemm gm{YSN, (const GAS bf16*)(wl + WL_WSSM), TAIL_R0, D, DIN}; pg8::StaticOrder S; S.init(TAIL_R0, D, Gl, bxl);
            pg8::EpiGate1 E{P1, T1};
            pg8::gemm_phase<pg8::EpiGate1, pg8::StaticOrder, true, true>(lds, gm, S, E, tid);
            tail_gemm<1>(lds, YSN, DIN, (const GAS bf16*)(wl + WL_WSSM), D, P1, T1, MG, H, A2, bxl, Gl, tid);
        }
        if (IN(pb + 6)) {
            PHASE_REGS
            LAS unsigned char* lds = lds0;
            pg8::Gemm gm{YA, (const GAS bf16*)(wl + WL_WATT), TAIL_R0, D, D}; pg8::StaticOrder S; S.init(TAIL_R0, D, Gl, bxl);
            pg8::EpiGate2 E{P1, T1, MG};
            pg8::gemm_phase<pg8::EpiGate2, pg8::StaticOrder, true, true>(lds, gm, S, E, tid);
            tail_gemm<2>(lds, YA, D, (const GAS bf16*)(wl + WL_WATT), D, P1, T1, MG, H, A2, bxl, Gl, tid);
        }
        SEAM(pb + 6);
        if (IN(pb + 7)) {
            PHASE_REGS
            LAS unsigned char* lds = lds0;
            pg8::Gemm gm{MG, (const GAS bf16*)(wl + WL_WOUT), TAIL_R0, D, D}; pg8::StaticOrder S; S.init(TAIL_R0, D, Gl, bxl);
            pg8::EpiResid E{H};
            pg8::gemm_phase<pg8::EpiResid, pg8::StaticOrder, true, true>(lds, gm, S, E, tid);
            tail_gemm<3>(lds, MG, D, (const GAS bf16*)(wl + WL_WOUT), D, P1, T1, MG, H, A2, bxl, Gl, tid);
        }
        SEAM(pb + 7);
        if (IN(pb + 8)) {
            PHASE_REGS
            INP(float, norm2_w, 20)
            for (int m = gw; m < MPAD; m += NGW) rms_row(H + (size_t)m * D, norm2_w + (size_t)l * D, nullptr, U + (size_t)m * D, nullptr, lane);
        }
        SEAM(pb + 8);
        if (IN(pb + 9)) {
            PHASE_REGS
            LAS unsigned char* lds = lds0;
            pg8::Gemm gm{U, (const GAS bf16*)(wl + WL_WUP), TAIL_R0, DFF, D}; pg8::StaticOrder S; S.init(TAIL_R0, DFF, Gl, bxl);
            pg8::EpiUp E{A2};
            pg8::gemm_phase<pg8::EpiUp, pg8::StaticOrder, true, true>(lds, gm, S, E, tid);
            tail_gemm<4>(lds, U, D, (const GAS bf16*)(wl + WL_WUP), DFF, P1, T1, MG, H, A2, bxl, Gl, tid);
        }
        SEAM(pb + 9);
        if (IN(pb + 10)) {
            PHASE_REGS
            LAS unsigned char* lds = lds0;
            pg8::Gemm gm{A2, (const GAS bf16*)(wl + WL_WDN), TAIL_R0, D, DFF}; pg8::StaticOrder S; S.init(TAIL_R0, D, Gl, bxl);
            pg8::EpiResid E{H};
            pg8::gemm_phase<pg8::EpiResid, pg8::StaticOrder, true, true>(lds, gm, S, E, tid);
            tail_gemm<3>(lds, A2, DFF, (const GAS bf16*)(wl + WL_WDN), D, P1, T1, MG, H, A2, bxl, Gl, tid);
        }
        SEAM(pb + 10);
        if (IN(pb + 11)) {
            PHASE_REGS
            INP(float, norm1_w, 9) INP(float, final_w, 23)
            if (l == 0) { for (int m = gw; m < MPAD; m += NGW) rms_row(H + (size_t)m * D, norm1_w + D, nullptr, U + (size_t)m * D, nullptr, lane); }
            else {
                for (int m = gw; m < MR; m += NGW) {
                    GAS float* dst = nullptr;
                    if (m < MP) { const int b = m / LP, t = m - b * LP; if (t >= NMETA) dst = out + O_YP + ((size_t)b * SEQ + (t - NMETA)) * D; }
                    else dst = out + O_YS + (size_t)(m - MP) * D;
                    if (dst) rms_row(H + (size_t)m * D, final_w, nullptr, nullptr, dst, lane);
                }
            }
        }
        if (IN(pb + 11) && IN(1) && l + 1 < args.l_hi) xcd_barrier_ni(bar.bar, bar.x, bar.st, (int)threadIdx.x, (unsigned)G);
    }
#undef IN
#undef SEAM
}

#ifndef MK_PER_PHASE
#define MK_PER_PHASE 0
#endif
extern "C" void kernel_launch(void* const* d_in, const int* in_sizes, int n_in, void* d_out, int out_size, void* d_ws, size_t ws_size, hipStream_t stream) {
    static int grid = 0;
    if (grid == 0) {
        if (n_in != 24 || (size_t)out_size != O_END || ws_size < WS_END) { fprintf(stderr, "kernel_launch: unexpected shapes: n_in %d out %d (want %zu) ws %zu (want %zu)\n", n_in, out_size, (size_t)O_END, ws_size, (size_t)WS_END); grid = -1; return; }
        int dev = 0, cus = 0, per_cu = 0;
        if (hipGetDevice(&dev) != hipSuccess || hipDeviceGetAttribute(&cus, hipDeviceAttributeMultiprocessorCount, dev) != hipSuccess) { grid = -1; return; }
        bool ok = true;
#if MK_PER_PHASE
#define SETA(K) ok = ok && hipFuncSetAttribute((const void*)fwd_t<K, K + 1>, hipFuncAttributeMaxDynamicSharedMemorySize, LDS_BYTES) == hipSuccess
        SETA(0); SETA(1); SETA(2); SETA(3); SETA(4); SETA(5); SETA(6); SETA(7); SETA(8); SETA(9); SETA(10); SETA(11); SETA(12);
#else
        ok = hipFuncSetAttribute((const void*)fwd_t<0, NPH + 1>, hipFuncAttributeMaxDynamicSharedMemorySize, LDS_BYTES) == hipSuccess;
        ok = ok && hipOccupancyMaxActiveBlocksPerMultiprocessor(&per_cu, (const void*)fwd_t<0, NPH + 1>, NT, LDS_BYTES) == hipSuccess && per_cu >= 1;
#endif
        if (!ok) { fprintf(stderr, "kernel_launch: hipFuncSetAttribute / occupancy query failed (per_cu %d)\n", per_cu); (void)hipGetLastError(); grid = -1; return; }
        grid = cus;
    }
    if (grid < 0) return;
    (void)hipMemsetAsync((char*)d_ws + WS_CTL, 0, CTL_ZERO_BYTES, stream);
    Args a{};
    for (int i = 0; i < 24; ++i) a.in[i] = d_in[i];
    a.out = (float*)d_out; a.ws = (unsigned char*)d_ws;
#if MK_PER_PHASE
#define LAUNCH_PH(K) hipLaunchKernelGGL((fwd_t<K, K + 1>), dim3(grid), dim3(NT), LDS_BYTES, stream, a)
    a.l_lo = 0; a.l_hi = 1; LAUNCH_PH(0);
    for (int l = 0; l < 2; ++l) { a.l_lo = l; a.l_hi = l + 1;
        LAUNCH_PH(1); LAUNCH_PH(2); LAUNCH_PH(3); LAUNCH_PH(4); LAUNCH_PH(5); LAUNCH_PH(6); LAUNCH_PH(7); LAUNCH_PH(8); LAUNCH_PH(9); LAUNCH_PH(10); LAUNCH_PH(11); LAUNCH_PH(12); }
#else
    a.l_lo = 0; a.l_hi = 2; hipLaunchKernelGGL((fwd_t<0, NPH + 1>), dim3(grid), dim3(NT), LDS_BYTES, stream, a);
#endif
}
```

```cpp
#include <hip/hip_runtime.h>
#include <cstdio>
#include <cstdint>
#define GAS __attribute__((address_space(1)))
#define LAS __attribute__((address_space(3)))

constexpr int D = 1024, NB = 4, SEQ = 4096, NMETA = 16, LP = SEQ + NMETA, MP = NB * LP, DB = 32, DS = 8, MS = DB * DS, MR = MP + MS, MPAD = 16896;
constexpr int DIN = 2048, CONVD = 3072, NH = 32, HP = 64, NG = 4, NST = 128;
constexpr int DFF = 4096, IN_DIM = 9320;
constexpr int PAST = 8192, PAGE = 128, NPAGES = 64, NPOOL = 2560;
constexpr int NIN = 9472, LDP1 = 9216;
constexpr int C_Z = 0, C_XBC = 2048, C_Q = 5120, C_K = 6144, C_V = 6400, C_QI = 6656, C_GS = 7168, C_GA = 8192;
constexpr int MC_KI = 0, MC_DT = 64, MC_WI = 96;
static_assert(MP == 16448 && MR == 16704 && MPAD % 256 == 0 && MPAD >= MR, "rows");
namespace pg8 {
#define PG8_LAS __attribute__((address_space(3)))
typedef unsigned short bf16_t;
typedef short bf16x8 __attribute__((ext_vector_type(8)));
typedef float f32x4 __attribute__((ext_vector_type(4)));
typedef unsigned u32x4 __attribute__((ext_vector_type(4)));
constexpr int BM = 256, BK = 64, HALF = 128, HTB = HALF * BK * 2  , STAGE_BYTES = 8 * HTB, NXCD = 8, WGM = 8;

__host__ __device__ __forceinline__ int lds_byte(int r, int c) { const int st = (r >> 4) * 2 + (c >> 5), rr = r & 15, cc = c & 31, ob = rr * 64 + cc * 2; return st * 1024 + (ob ^ (((ob >> 9) & 1) << 5)); }
__host__ __device__ __forceinline__ void stage_rc(int b, int& R, int& C) { const int st = b / 1024, sb = b % 1024, swz = sb ^ (((sb >> 9) & 1) << 5); R = (st >> 1) * 16 + swz / 64; C = (st & 1) * 32 + (swz % 64) / 2; }
__host__ __device__ __forceinline__ int perm32(int rho) { const int n = rho >> 4, i = rho & 15; return 8 * (i >> 2) + 4 * n + (i & 3); }

struct Unit { int pm, pn; };
struct Gemm { const GAS bf16_t* A; const GAS bf16_t* Bt; int M, N, K; };

struct StaticOrder {
    int nM, nN, nwg, G, c;
    __host__ __device__ void init(int M, int N, int G_, int c_) { nM = M / BM; nN = N / BM; nwg = nM * nN; G = G_; c = c_; }
    __host__ __device__ bool next(int i, Unit& u) const {
        const long L = (long)i * G + c; if (L >= nwg) return false;
        int wgid = (int)L; { const int q = nwg / NXCD, r = nwg % NXCD, xcd = wgid % NXCD, off = wgid / NXCD; wgid = (xcd < r ? xcd * (q + 1) : r * (q + 1) + (xcd - r) * q) + off; }
        const int nig = WGM * nN, gid = wgid / nig, fm = gid * WGM, gsz = (nM - fm) < WGM ? (nM - fm) : WGM;
        u.pm = fm + ((wgid % nig) % gsz); u.pn = (wgid % nig) / gsz; return true;
    }
    __device__ __forceinline__ void a_ready(const Unit&) const {}
    __device__ __forceinline__ void done(const Unit&) const {}
};

__device__ __forceinline__ unsigned cvt_pk_bf16(float lo, float hi) { unsigned r; asm volatile("v_cvt_pk_bf16_f32 %0, %1, %2" : "=v"(r) : "v"(lo), "v"(hi)); return r; }

__device__ __forceinline__ void unpack8(const u32x4 w, float (&f)[8]) {
    f[0] = __uint_as_float(w.x << 16); f[1] = __uint_as_float(w.x & 0xffff0000u); f[2] = __uint_as_float(w.y << 16); f[3] = __uint_as_float(w.y & 0xffff0000u);
    f[4] = __uint_as_float(w.z << 16); f[5] = __uint_as_float(w.z & 0xffff0000u); f[6] = __uint_as_float(w.w << 16); f[7] = __uint_as_float(w.w & 0xffff0000u);
}
__device__ __forceinline__ u32x4 pack8(const f32x4 v0, const f32x4 v1) { u32x4 w; w.x = cvt_pk_bf16(v0[0], v0[1]); w.y = cvt_pk_bf16(v0[2], v0[3]); w.z = cvt_pk_bf16(v1[0], v1[1]); w.w = cvt_pk_bf16(v1[2], v1[3]); return w; }
__device__ __forceinline__ float sigm(float x) { return __builtin_amdgcn_rcpf(1.0f + __expf(-x)); }

struct EpiIn {
    static constexpr bool PERM = true, AFTER_DRAIN = false;
    GAS bf16_t* P1; GAS bf16_t* kvb; GAS float* misc; GAS bf16_t* kib; GAS float *pk, *pv, *pki, *sk, *sv, *ski;
    __device__ __forceinline__ void operator()(const f32x4 (&acc)[2][2][4][2], const Unit& u, int wr, int wc, int fr, int fq) const {
        const int row0 = u.pm * BM + wr * 64 + fr, lc0 = wc * 32 + 8 * fq;
#pragma unroll
        for (int ai = 0; ai < 2; ++ai)
#pragma unroll
            for (int m = 0; m < 4; ++m) {
                const int row = row0 + ai * HALF + m * 16;
#pragma unroll
                for (int bj = 0; bj < 2; ++bj) {
                    const f32x4 v0 = acc[ai][bj][m][0], v1 = acc[ai][bj][m][1];
                    const int lc = lc0 + bj * HALF;
                    if (u.pn < 36) {
                        if (u.pn == 24 || u.pn == 25) *(GAS u32x4*)(kvb + (size_t)row * 512 + (u.pn - 24) * BM + lc) = pack8(v0, v1);
                        else *(GAS u32x4*)(P1 + (size_t)row * LDP1 + u.pn * BM + lc) = pack8(v0, v1);
                        if (u.pn == 24) {
                            if (row < MP) { GAS float* dst = pk + (size_t)row * 256 + lc; *(GAS f32x4*)dst = v0; *(GAS f32x4*)(dst + 4) = v1; }
                            else if (row < MR) { GAS float* dst = sk + (size_t)(row - MP) * 256 + lc; *(GAS f32x4*)dst = v0; *(GAS f32x4*)(dst + 4) = v1; }
                        } else if (u.pn == 25) {
                            if (row < MP) { GAS float* dst = pv + (size_t)row * 256 + lc; *(GAS f32x4*)dst = v0; *(GAS f32x4*)(dst + 4) = v1; }
                            else if (row < MR) { GAS float* dst = sv + (size_t)(row - MP) * 256 + lc; *(GAS f32x4*)dst = v0; *(GAS f32x4*)(dst + 4) = v1; }
                        }
                    } else {
                        if (lc < 128) { GAS float* d = misc + (size_t)row * 128 + lc; *(GAS f32x4*)d = v0; *(GAS f32x4*)(d + 4) = v1; }
                        if (lc < 64) {
                            *(GAS u32x4*)(kib + (size_t)row * 64 + lc) = pack8(v0, v1);
                            if (row < MP) { GAS float* dst = pki + (size_t)row * 64 + lc; *(GAS f32x4*)dst = v0; *(GAS f32x4*)(dst + 4) = v1; }
                            else if (row < MR) { GAS float* dst = ski + (size_t)(row - MP) * 64 + lc; *(GAS f32x4*)dst = v0; *(GAS f32x4*)(dst + 4) = v1; }
                        }
                    }
                }
            }
    }
};
struct EpiGate1 {
    static constexpr bool PERM = true, AFTER_DRAIN = false;
    const GAS bf16_t* P1; GAS bf16_t* T1;
    __device__ __forceinline__ void operator()(const f32x4 (&acc)[2][2][4][2], const Unit& u, int wr, int wc, int fr, int fq) const {
        const int row0 = u.pm * BM + wr * 64 + fr, col0 = u.pn * BM + wc * 32 + 8 * fq;
#pragma unroll
        for (int ai = 0; ai < 2; ++ai)
#pragma unroll
            for (int m = 0; m < 4; ++m) {
                const int row = row0 + ai * HALF + m * 16;
#pragma unroll
                for (int bj = 0; bj < 2; ++bj) {
                    const int col = col0 + bj * HALF;
                    float g[8]; unpack8(*(const GAS u32x4*)(P1 + (size_t)row * LDP1 + C_GS + col), g);
                    f32x4 v0 = acc[ai][bj][m][0], v1 = acc[ai][bj][m][1];
#pragma unroll
                    for (int e = 0; e < 4; ++e) { v0[e] *= sigm(g[e]); v1[e] *= sigm(g[4 + e]); }
                    *(GAS u32x4*)(T1 + (size_t)row * 1024 + col) = pack8(v0, v1);
                }
            }
    }
};
struct EpiGate2 {
    static constexpr bool PERM = true, AFTER_DRAIN = false;
    const GAS bf16_t* P1; const GAS bf16_t* T1; GAS bf16_t* MG;
    __device__ __forceinline__ void operator()(const f32x4 (&acc)[2][2][4][2], const Unit& u, int wr, int wc, int fr, int fq) const {
        const int row0 = u.pm * BM + wr * 64 + fr, col0 = u.pn * BM + wc * 32 + 8 * fq;
#pragma unroll
        for (int ai = 0; ai < 2; ++ai)
#pragma unroll
            for (int m = 0; m < 4; ++m) {
                const int row = row0 + ai * HALF + m * 16;
#pragma unroll
                for (int bj = 0; bj < 2; ++bj) {
                    const int col = col0 + bj * HALF;
                    float g[8]; unpack8(*(const GAS u32x4*)(P1 + (size_t)row * LDP1 + C_GA + col), g);
                    float tt[8]; unpack8(*(const GAS u32x4*)(T1 + (size_t)row * 1024 + col), tt); const f32x4 t0 = (f32x4){tt[0], tt[1], tt[2], tt[3]}, t1 = (f32x4){tt[4], tt[5], tt[6], tt[7]};
                    f32x4 v0 = acc[ai][bj][m][0], v1 = acc[ai][bj][m][1];
#pragma unroll
                    for (int e = 0; e < 4; ++e) { v0[e] = t0[e] + v0[e] * sigm(g[e]); v1[e] = t1[e] + v1[e] * sigm(g[4 + e]); }
                    *(GAS u32x4*)(MG + (size_t)row * 1024 + col) = pack8(v0, v1);
                }
            }
    }
};
struct EpiResid {
    static constexpr bool PERM = true, AFTER_DRAIN = false;
    GAS float* H;
    __device__ __forceinline__ void operator()(const f32x4 (&acc)[2][2][4][2], const Unit& u, int wr, int wc, int fr, int fq) const {
        const int row0 = u.pm * BM + wr * 64 + fr, col0 = u.pn * BM + wc * 32 + 8 * fq;
#pragma unroll
        for (int ai = 0; ai < 2; ++ai)
#pragma unroll
            for (int m = 0; m < 4; ++m) {
                const int row = row0 + ai * HALF + m * 16;
#pragma unroll
                for (int bj = 0; bj < 2; ++bj) {
                    GAS float* d = H + (size_t)row * 1024 + col0 + bj * HALF;
                    const f32x4 h0 = *(const GAS f32x4*)d, h1 = *(const GAS f32x4*)(d + 4);
                    *(GAS f32x4*)d = h0 + acc[ai][bj][m][0]; *(GAS f32x4*)(d + 4) = h1 + acc[ai][bj][m][1];
                }
            }
    }
};
struct EpiUp {
    static constexpr bool PERM = true, AFTER_DRAIN = false;
    GAS bf16_t* A2;
    __device__ __forceinline__ void operator()(const f32x4 (&acc)[2][2][4][2], const Unit& u, int wr, int wc, int fr, int fq) const {
        const int row0 = u.pm * BM + wr * 64 + fr, col0 = u.pn * BM + wc * 32 + 8 * fq;
#pragma unroll
        for (int ai = 0; ai < 2; ++ai)
#pragma unroll
            for (int m = 0; m < 4; ++m) {
                const int row = row0 + ai * HALF + m * 16;
#pragma unroll
                for (int bj = 0; bj < 2; ++bj) {
                    f32x4 v0 = acc[ai][bj][m][0], v1 = acc[ai][bj][m][1];
#pragma unroll
                    for (int e = 0; e < 4; ++e) { const float a = fmaxf(v0[e], 0.f), b = fmaxf(v1[e], 0.f); v0[e] = a * a; v1[e] = b * b; }
                    *(GAS u32x4*)(A2 + (size_t)row * DFF + col0 + bj * HALF) = pack8(v0, v1);
                }
            }
    }
};
template <class Epi, class Sched, bool ALIGN_EPI = false, bool SP2 = false>
__device__ __forceinline__ void gemm_phase(PG8_LAS unsigned char* lds, const Gemm g, const Sched& S, const Epi& E, const int tid) {
    const int wid = __builtin_amdgcn_readfirstlane(tid >> 6), lane = tid & 63, wr = wid >> 2, wc = wid & 3, fr = lane & 15, fq = lane >> 4;
    const int K = g.K, nt = K / BK;
    unsigned voffA[2], voffB[2];
#pragma unroll
    for (int i = 0; i < 2; ++i) { int R, C; stage_rc(tid * 16 + i * 8192, R, C); const int Rb = Epi::PERM ? ((R & ~31) + perm32(R & 31)) : R;
        voffA[i] = (unsigned)(R * K + C) * 2u; voffB[i] = (unsigned)(Rb * K + C) * 2u; }
    const size_t kstep = (size_t)(BK * 2);
    const size_t hstep = (size_t)HALF * K * 2;
    const size_t tstep = 2 * hstep;
    const unsigned ldsw = (unsigned)wid * 1024u;
    const int aoff = lds_byte(wr * 64 + fr, fq * 8), boff = lds_byte(wc * 32 + fr, fq * 8);
#define PG8_SA(b, h) (((b) * 2 + (h)) * HTB)
#define PG8_SB(b, h) ((4 + (b) * 2 + (h)) * HTB)
#define PG8_STAGE(bufoff, gbase, voff) do { _Pragma("unroll") for (int _i = 0; _i < 2; ++_i) \
        __builtin_amdgcn_global_load_lds((const GAS unsigned*)((const GAS char*)(gbase) + (voff)[_i]), (PG8_LAS unsigned*)(lds + (bufoff) + ldsw + _i * 8192), 16, 0, 0); } while (0)
#define PG8_LDA(dst, b, h) do { _Pragma("unroll") for (int m = 0; m < 4; ++m) _Pragma("unroll") for (int k = 0; k < 2; ++k) dst[m][k] = *(const PG8_LAS bf16x8*)(lds + PG8_SA(b, h) + aoff + m * 2048 + k * 1024); } while (0)
#define PG8_LDB(dst, b, h) do { _Pragma("unroll") for (int n = 0; n < 2; ++n) _Pragma("unroll") for (int k = 0; k < 2; ++k) dst[n][k] = *(const PG8_LAS bf16x8*)(lds + PG8_SB(b, h) + boff + n * 2048 + k * 1024); } while (0)
#define PG8_MMA(ai, bj, At, Bt) do { __builtin_amdgcn_s_setprio(1); _Pragma("unroll") for (int m = 0; m < 4; ++m) _Pragma("unroll") for (int n = 0; n < 2; ++n) _Pragma("unroll") for (int k = 0; k < 2; ++k) \
        acc[ai][bj][m][n] = __builtin_amdgcn_mfma_f32_16x16x32_bf16(Bt[n][k], At[m][k], acc[ai][bj][m][n], 0, 0, 0); __builtin_amdgcn_s_setprio(0); } while (0)
#define PG8_WAIT_V(n) asm volatile("s_waitcnt vmcnt(" #n ")" ::: "memory")
#define PG8_WAIT_L(n) asm volatile("s_waitcnt lgkmcnt(" #n ")" ::: "memory")
#define PG8_BAR __builtin_amdgcn_s_barrier()
#define PG8_SCHED __builtin_amdgcn_sched_barrier(0)
    Unit cur, nxt; int ui = 0;
    if (!S.next(0, cur)) return;
    f32x4 acc[2][2][4][2];
#pragma unroll
    for (int a = 0; a < 2; ++a)
#pragma unroll
        for (int b = 0; b < 2; ++b)
#pragma unroll
            for (int m = 0; m < 4; ++m)
#pragma unroll
                for (int n = 0; n < 2; ++n) acc[a][b][m][n] = (f32x4){0.f, 0.f, 0.f, 0.f};
    bf16x8 At[4][2], B0[2][2], B1[2][2];
    const GAS char* cA = (const GAS char*)g.A + (size_t)cur.pm * tstep; const GAS char* cB = (const GAS char*)g.Bt + (size_t)cur.pn * tstep;
    S.a_ready(cur);
    if constexpr (SP2) {
        PG8_STAGE(PG8_SB(0, 0), cB, voffB); PG8_STAGE(PG8_SB(0, 1), cB + hstep, voffB); PG8_STAGE(PG8_SA(0, 0), cA, voffA); PG8_STAGE(PG8_SA(0, 1), cA + hstep, voffA);
        if (wr == 1) PG8_BAR;
        PG8_WAIT_V(2); PG8_BAR;
        PG8_STAGE(PG8_SB(1, 0), cB + kstep, voffB); PG8_STAGE(PG8_SA(1, 0), cA + kstep, voffA); PG8_STAGE(PG8_SB(1, 1), cB + hstep + kstep, voffB);
        PG8_WAIT_V(6); PG8_BAR;
    } else {
        PG8_STAGE(PG8_SB(0, 0), cB, voffB); PG8_STAGE(PG8_SA(0, 0), cA, voffA); PG8_STAGE(PG8_SB(0, 1), cB + hstep, voffB); PG8_STAGE(PG8_SA(0, 1), cA + hstep, voffA);
        if (wr == 1) PG8_BAR;
        PG8_WAIT_V(4); PG8_BAR;
        PG8_STAGE(PG8_SB(1, 0), cB + kstep, voffB); PG8_STAGE(PG8_SA(1, 0), cA + kstep, voffA); PG8_STAGE(PG8_SB(1, 1), cB + hstep + kstep, voffB);
        PG8_WAIT_V(6); PG8_BAR;
    }
    for (;;) {
        const bool has_next = S.next(ui + 1, nxt);
        const GAS char* nA = has_next ? (const GAS char*)g.A + (size_t)nxt.pm * tstep : cA; const GAS char* nB = has_next ? (const GAS char*)g.Bt + (size_t)nxt.pn * tstep : cB;
        for (int t = 0; t < nt; t += 2) {
            const bool last = (t == nt - 2);
            const GAS char* a1 = cA + (size_t)(t + 1) * kstep;
            const GAS char* a2 = last ? nA : cA + (size_t)(t + 2) * kstep; const GAS char* b2 = last ? nB : cB + (size_t)(t + 2) * kstep;
            const GAS char* a3 = a2 + kstep; const GAS char* b3 = b2 + kstep;
            if (last && has_next) S.a_ready(nxt);
            if constexpr (SP2) {
            PG8_LDB(B0, 0, 0); PG8_LDB(B1, 0, 1); PG8_SCHED; PG8_LDA(At, 0, 0); PG8_STAGE(PG8_SA(1, 1), a1 + hstep, voffA);
            PG8_WAIT_V(8); PG8_WAIT_L(0); PG8_BAR; PG8_MMA(0, 0, At, B0); PG8_MMA(0, 1, At, B1); PG8_BAR; PG8_SCHED;
            PG8_LDA(At, 0, 1); PG8_STAGE(PG8_SB(0, 0), b2, voffB); PG8_STAGE(PG8_SB(0, 1), b2 + hstep, voffB); PG8_STAGE(PG8_SA(0, 0), a2, voffA);
            PG8_WAIT_V(8); PG8_WAIT_L(0); PG8_BAR; PG8_MMA(1, 0, At, B0); PG8_MMA(1, 1, At, B1); PG8_BAR; PG8_SCHED;
            PG8_LDB(B0, 1, 0); PG8_LDB(B1, 1, 1); PG8_SCHED; PG8_LDA(At, 1, 0); PG8_STAGE(PG8_SA(0, 1), a2 + hstep, voffA);
            PG8_WAIT_V(8); PG8_WAIT_L(0); PG8_BAR; PG8_MMA(0, 0, At, B0); PG8_MMA(0, 1, At, B1); PG8_BAR; PG8_SCHED;
            PG8_LDA(At, 1, 1); PG8_STAGE(PG8_SB(1, 0), b3, voffB); PG8_STAGE(PG8_SB(1, 1), b3 + hstep, voffB); PG8_STAGE(PG8_SA(1, 0), a3, voffA);
            PG8_WAIT_V(8); PG8_WAIT_L(0); PG8_BAR; PG8_MMA(1, 0, At, B0); PG8_MMA(1, 1, At, B1); PG8_BAR; PG8_SCHED;
            } else {
            PG8_LDB(B0, 0, 0); PG8_SCHED; PG8_LDA(At, 0, 0); PG8_STAGE(PG8_SA(1, 1), a1 + hstep, voffA);
            PG8_WAIT_L(8); PG8_BAR; PG8_WAIT_L(0); PG8_MMA(0, 0, At, B0); PG8_BAR; PG8_SCHED;
            PG8_LDB(B1, 0, 1); PG8_STAGE(PG8_SB(0, 0), b2, voffB);
            PG8_BAR; PG8_WAIT_L(0); PG8_MMA(0, 1, At, B1); PG8_BAR;
            PG8_LDA(At, 0, 1); PG8_STAGE(PG8_SA(0, 0), a2, voffA);
            PG8_BAR; PG8_WAIT_L(0); PG8_MMA(1, 0, At, B0); PG8_BAR; PG8_SCHED;
            PG8_STAGE(PG8_SB(0, 1), b2 + hstep, voffB);
            PG8_WAIT_V(6); PG8_BAR; PG8_MMA(1, 1, At, B1); PG8_BAR;
            PG8_LDB(B0, 1, 0); PG8_SCHED; PG8_LDA(At, 1, 0); PG8_STAGE(PG8_SA(0, 1), a2 + hstep, voffA);
            PG8_WAIT_L(8); PG8_BAR; PG8_WAIT_L(0); PG8_MMA(0, 0, At, B0); PG8_BAR; PG8_SCHED;
            PG8_LDB(B1, 1, 1); PG8_STAGE(PG8_SB(1, 0), b3, voffB);
            PG8_BAR; PG8_WAIT_L(0); PG8_MMA(0, 1, At, B1); PG8_BAR;
            PG8_LDA(At, 1, 1); PG8_STAGE(PG8_SA(1, 0), a3, voffA);
            PG8_BAR; PG8_WAIT_L(0); PG8_MMA(1, 0, At, B0); PG8_BAR; PG8_SCHED;
            PG8_STAGE(PG8_SB(1, 1), b3 + hstep, voffB);
            PG8_WAIT_V(6); PG8_BAR; PG8_MMA(1, 1, At, B1); PG8_BAR;
            }
        }
        if constexpr (ALIGN_EPI) { if (wr == 0) PG8_BAR; }
        if constexpr (!Epi::AFTER_DRAIN) { E(acc, cur, wr, wc, fr, fq); S.done(cur); }
        if (!has_next) break;
#pragma unroll
        for (int a = 0; a < 2; ++a)
#pragma unroll
            for (int b = 0; b < 2; ++b)
#pragma unroll
                for (int m = 0; m < 4; ++m)
#pragma unroll
                    for (int n = 0; n < 2; ++n) acc[a][b][m][n] = (f32x4){0.f, 0.f, 0.f, 0.f};
        cur = nxt; cA = nA; cB = nB; ++ui;
        if constexpr (ALIGN_EPI) { if (wr == 1) PG8_BAR; }
    }
    PG8_WAIT_V(0);
    if constexpr (!ALIGN_EPI) { if (wr == 0) PG8_BAR; }
    PG8_BAR;
    if constexpr (Epi::AFTER_DRAIN) { E.fused(acc, cur, wr, wc, fr, fq, lds, wid, lane); S.done(cur); }
#undef PG8_SA
#undef PG8_SB
#undef PG8_STAGE
#undef PG8_LDA
#undef PG8_LDB
#undef PG8_MMA
#undef PG8_WAIT_V
#undef PG8_WAIT_L
#undef PG8_BAR
#undef PG8_SCHED
}
}

typedef unsigned short bf16;
typedef unsigned v4u __attribute__((ext_vector_type(4)));
typedef float f32x4 __attribute__((ext_vector_type(4)));
typedef short bf16x8 __attribute__((ext_vector_type(8)));
typedef GAS unsigned gu32;
typedef GAS unsigned long long gu64;
#define RLX_AGENT __ATOMIC_RELAXED, __HIP_MEMORY_SCOPE_AGENT
#define LDS_WAIT() asm volatile("s_waitcnt lgkmcnt(0)" ::: "memory")
#define VM_WAIT() asm volatile("s_waitcnt vmcnt(0)" ::: "memory")
__device__ __forceinline__ unsigned long long rt() { return __builtin_amdgcn_s_memrealtime(); }
typedef float f32x2_cv __attribute__((ext_vector_type(2))); typedef __bf16 bf16x2_cv __attribute__((ext_vector_type(2)));
__device__ __forceinline__ unsigned pk2(float lo, float hi) { const f32x2_cv v = {lo, hi}; const bf16x2_cv c = __builtin_convertvector(v, bf16x2_cv); return __builtin_bit_cast(unsigned, c); }
__device__ __forceinline__ unsigned f2bf(float f) { return pk2(f, 0.f) & 0xffffu; }

#define XB_TMO      128
#define XB_XCNT(j)  (256  + 64 * (j))
#define XB_XSUB(j)  (1280 + 64 * (j))
#define XB_XGEN(j)  (2304 + 64 * (j))
#define XB_TOP      3328
#define XB_TOPGEN   3392
#define XCD_BAR_WORDS 3456
#define XB_SPIN_CAP (1u << 18)

__device__ __forceinline__ unsigned xb_ld(unsigned* p)              { return __hip_atomic_load(p, __ATOMIC_RELAXED, __HIP_MEMORY_SCOPE_AGENT); }
__device__ __forceinline__ unsigned xb_add(unsigned* p, unsigned v) { return __hip_atomic_fetch_add(p, v, __ATOMIC_RELAXED, __HIP_MEMORY_SCOPE_AGENT); }
__device__ __forceinline__ unsigned xb_xcc_id() { return (unsigned)__builtin_amdgcn_s_getreg((3 << 11) | 20) & 0xFu; }
#define XB_SPIN(cond, bar) do { unsigned _sp = 0; while (cond) { __builtin_amdgcn_s_sleep(1); \
    if ((++_sp & 255u) == 0u) { if (xb_ld(&(bar)[XB_TMO])) break; if (_sp > XB_SPIN_CAP) { atomicAdd(&(bar)[XB_TMO], 1u); break; } } } } while (0)

struct XcdBarrier {
    unsigned* bar; unsigned x;
    volatile LAS unsigned* st;
};

__device__ __forceinline__ XcdBarrier xcd_barrier_post(unsigned* bar, volatile LAS unsigned* st) {
    XcdBarrier b; b.bar = bar; b.x = xb_xcc_id(); b.st = st;
    if (threadIdx.x == 0) (void)xb_add(&bar[XB_XCNT(b.x)], 1u);
    return b;
}
__device__ __forceinline__ void xcd_barrier_complete(unsigned* bar, unsigned x, unsigned& nloc, unsigned& nx, const unsigned G) {
    unsigned sum, cnt, mine, sp = 0u;
    for (;;) {
        sum = 0u; cnt = 0u; mine = 0u;
#pragma unroll
        for (unsigned j = 0; j < 16; ++j) { const unsigned c = xb_ld(&bar[XB_XCNT(j)]); sum += c; cnt += (c > 0u) ? 1u : 0u; mine = (j == x) ? c : mine; }
        if (sum == G) break;
        __builtin_amdgcn_s_sleep(1);
        if ((++sp & 255u) == 0u) { if (xb_ld(&bar[XB_TMO])) break; if (sp > XB_SPIN_CAP) { atomicAdd(&bar[XB_TMO], 1u); break; } }
    }
    nloc = mine > 0u ? mine : 1u; nx = cnt > 0u ? cnt : 1u;
}

__device__ __forceinline__ void xcd_barrier(const XcdBarrier& b, const int tid_, const unsigned G_) {
    asm volatile("s_waitcnt vmcnt(0)" ::: "memory");
    __syncthreads();
    if (tid_ == 0) {
        unsigned* bar = b.bar;
        __builtin_amdgcn_s_waitcnt(0);
        unsigned nloc = b.st[0], nx = b.st[1];
        if (nloc == 0u) { xcd_barrier_complete(bar, b.x, nloc, nx, G_); b.st[0] = nloc; b.st[1] = nx; }
        const unsigned old = xb_add(&bar[XB_XSUB(b.x)], 1u);
        const unsigned gen = old / nloc;
        if (old + 1u == (gen + 1u) * nloc) {
            __builtin_amdgcn_fence(__ATOMIC_RELEASE, "agent");
            asm volatile("s_waitcnt vmcnt(0)" ::: "memory");
            const unsigned og = xb_add(&bar[XB_TOP], 1u);
            const unsigned tg = og / nx;
            if (og + 1u == (tg + 1u) * nx) xb_add(&bar[XB_TOPGEN], 1u);
            else XB_SPIN(xb_ld(&bar[XB_TOPGEN]) == tg, bar);
            __builtin_amdgcn_fence(__ATOMIC_ACQUIRE, "agent");
            xb_add(&bar[XB_XGEN(b.x)], 1u);
            asm volatile("s_waitcnt vmcnt(0)" ::: "memory");
        } else {
            XB_SPIN(xb_ld(&bar[XB_XGEN(b.x)]) == gen, bar);
            __builtin_amdgcn_fence(__ATOMIC_ACQUIRE, "agent");
            asm volatile("s_waitcnt vmcnt(0)" ::: "memory");
        }
    }
    __syncthreads();
}

constexpr size_t O_YP = 0, O_YS = O_YP + (size_t)NB * SEQ * D, O_PK = O_YS + (size_t)MS * D, O_PV = O_PK + 2ull * MP * 256, O_PKI = O_PV + 2ull * MP * 256,
                 O_PSSM = O_PKI + 2ull * MP * 64, O_PCONV = O_PSSM + 2ull * NB * NH * HP * NST, O_SK = O_PCONV + 2ull * NB * 3 * CONVD, O_SV = O_SK + 2ull * MS * 256,
                 O_SKI = O_SV + 2ull * MS * 256, O_SSSM = O_SKI + 2ull * MS * 64, O_SCONV = O_SSSM + 2ull * DB * NH * HP * NST, O_END = O_SCONV + 2ull * DB * 3 * CONVD;

constexpr size_t MiB = 1u << 20;
constexpr size_t al(size_t x) { return (x + MiB - 1) / MiB * MiB; }
constexpr size_t WS_CTL = 0, CTL_ZERO_BYTES = 1 * MiB;
constexpr size_t SZ_WIN = (size_t)NIN * D * 2, SZ_WSSM = (size_t)D * DIN * 2, SZ_WATT = (size_t)D * D * 2, SZ_WOUT = (size_t)D * D * 2, SZ_WUP = (size_t)DFF * D * 2, SZ_WDN = (size_t)D * DFF * 2;
constexpr size_t WL_WIN = 0, WL_WSSM = al(WL_WIN + SZ_WIN), WL_WATT = al(WL_WSSM + SZ_WSSM), WL_WOUT = al(WL_WATT + SZ_WATT), WL_WUP = al(WL_WOUT + SZ_WOUT), WL_WDN = al(WL_WUP + SZ_WUP), WL_SIZE = al(WL_WDN + SZ_WDN);
constexpr size_t WS_W = 1 * MiB;
constexpr size_t WS_H = al(WS_W + 2 * WL_SIZE);
constexpr size_t WS_U = al(WS_H + (size_t)MPAD * D * 4);
constexpr size_t WS_P1 = al(WS_U + (size_t)MPAD * D * 2);
constexpr size_t WS_MISC = al(WS_P1 + (size_t)MPAD * LDP1 * 2);
constexpr size_t WS_KIB = al(WS_MISC + (size_t)MPAD * 128 * 4);
constexpr size_t WS_XC = al(WS_KIB + (size_t)MPAD * 64 * 2);
constexpr size_t WS_DT = al(WS_XC + (size_t)MPAD * CONVD * 2);
constexpr size_t WS_DA = al(WS_DT + (size_t)MPAD * 32 * 4);
constexpr size_t WS_YS = al(WS_DA + (size_t)MPAD * 32 * 4);
constexpr size_t WS_YSN = al(WS_YS + (size_t)MPAD * DIN * 4);
constexpr size_t WS_YA = al(WS_YSN + (size_t)MPAD * DIN * 2);
constexpr size_t WS_T1 = al(WS_YA + (size_t)MPAD * D * 2);
constexpr size_t WS_MG = al(WS_T1 + (size_t)MPAD * D * 4);
constexpr size_t WS_A2 = al(WS_MG + (size_t)MPAD * D * 2);
constexpr size_t WS_IDXP = al(WS_A2 + (size_t)MPAD * DFF * 2);
constexpr size_t WS_IDXS = al(WS_IDXP + (size_t)MP * 256 * 2);
constexpr int SCS_LD = 8256;
constexpr size_t WS_SCS = al(WS_IDXS + (size_t)MS * 256 * 4);
constexpr size_t WS_SB = al(WS_SCS + (size_t)MS * SCS_LD * 4);
constexpr size_t WS_DEC = al(WS_SB + (size_t)NB * 33 * NH * HP * NST * 4);
constexpr size_t WS_HC = al(WS_DEC + (size_t)NB * 33 * NH * 4);
constexpr size_t WS_KVB = al(WS_HC + (size_t)NB * 33 * NH * HP * NST * 2);
constexpr size_t WS_END = al(WS_KVB + (size_t)MPAD * 512 * 2);
constexpr int CW_BAR = 4096;

constexpr int LDS_BYTES = 155648, LDSCTL_OFF = 151552, MISC_OFF = LDSCTL_OFF + 320;
constexpr int NWAVES = 8, NT = 512;
typedef float f32x16 __attribute__((ext_vector_type(16)));
typedef unsigned v2u __attribute__((ext_vector_type(2)));

__device__ __forceinline__ float dpp_f(float v, const int ctrl_unused) { return v; }
#define DPPF(v, ctrl, rmask, bc) __uint_as_float((unsigned)__builtin_amdgcn_update_dpp(0, (int)__float_as_uint(v), ctrl, rmask, 0xf, bc))
__device__ __forceinline__ float row16_sum(float v) {
    v += DPPF(v, 0xB1, 0xf, true); v += DPPF(v, 0x4E, 0xf, true); v += DPPF(v, 0x141, 0xf, true); v += DPPF(v, 0x140, 0xf, true); return v;
}
__device__ __forceinline__ float wave_sum(float v) {
    v = row16_sum(v);
    v += DPPF(v, 0x142, 0xa, false); v += DPPF(v, 0x143, 0xc, false);
    return __uint_as_float((unsigned)__builtin_amdgcn_readlane((int)__float_as_uint(v), 63));
}
__device__ __forceinline__ float wave_max(float v) {
    v = fmaxf(v, __uint_as_float((unsigned)__builtin_amdgcn_update_dpp((int)__float_as_uint(v), (int)__float_as_uint(v), 0xB1, 0xf, 0xf, false)));
    v = fmaxf(v, __uint_as_float((unsigned)__builtin_amdgcn_update_dpp((int)__float_as_uint(v), (int)__float_as_uint(v), 0x4E, 0xf, 0xf, false)));
    v = fmaxf(v, __uint_as_float((unsigned)__builtin_amdgcn_update_dpp((int)__float_as_uint(v), (int)__float_as_uint(v), 0x141, 0xf, 0xf, false)));
    v = fmaxf(v, __uint_as_float((unsigned)__builtin_amdgcn_update_dpp((int)__float_as_uint(v), (int)__float_as_uint(v), 0x140, 0xf, 0xf, false)));
    v = fmaxf(v, __uint_as_float((unsigned)__builtin_amdgcn_update_dpp((int)__float_as_uint(v), (int)__float_as_uint(v), 0x142, 0xa, 0xf, false)));
    v = fmaxf(v, __uint_as_float((unsigned)__builtin_amdgcn_update_dpp((int)__float_as_uint(v), (int)__float_as_uint(v), 0x143, 0xc, 0xf, false)));
    return __uint_as_float((unsigned)__builtin_amdgcn_readlane((int)__float_as_uint(v), 63));
}
__device__ __forceinline__ void unpack8(const v4u w, float (&f)[8]) {
    f[0] = __uint_as_float(w.x << 16); f[1] = __uint_as_float(w.x & 0xffff0000u); f[2] = __uint_as_float(w.y << 16); f[3] = __uint_as_float(w.y & 0xffff0000u);
    f[4] = __uint_as_float(w.z << 16); f[5] = __uint_as_float(w.z & 0xffff0000u); f[6] = __uint_as_float(w.w << 16); f[7] = __uint_as_float(w.w & 0xffff0000u);
}
__device__ __forceinline__ float sigm(float x) { return __builtin_amdgcn_rcpf(1.0f + __expf(-x)); }

__device__ __forceinline__ int win_src_col(int n) {
    if (n < 5120) return n;
    if (n < 6144) return n - 5120 + 5152;
    if (n < 6400) return n - 6144 + 6176;
    if (n < 6656) return n - 6400 + 6432;
    if (n < 7168) return n - 6656 + 6688;
    if (n < 8192) return n - 7168 + 7272;
    if (n < 9216) return n - 8192 + 8296;
    if (n < 9280) return n - 9216 + 7200;
    if (n < 9312) return n - 9280 + 5120;
    if (n < 9320) return n - 9312 + 7264;
    return -1;
}
__device__ __forceinline__ void tr_item(const GAS float* W, int K, int Nsrc, GAS bf16* WT, int nblk, bool remap, LAS float* scr, int item, int lane) {
    const int kb = item / nblk, nb = item % nblk, k0 = 64 * kb, n0 = 64 * nb;
    const int s0 = remap ? win_src_col(n0) : n0, s63 = remap ? win_src_col(n0 + 63) : n0 + 63;
    if (s0 >= 0 && s63 == s0 + 63 && (s0 & 3) == 0 && (Nsrc & 3) == 0) {
        const int r4 = lane >> 4, c4 = (lane & 15) * 4;
#pragma unroll 4
        for (int i = 0; i < 16; ++i) { const int kk = 4 * i + r4; const f32x4 v = *(const GAS f32x4*)(W + (size_t)(k0 + kk) * Nsrc + s0 + c4);
            scr[kk * 65 + c4] = v.x; scr[kk * 65 + c4 + 1] = v.y; scr[kk * 65 + c4 + 2] = v.z; scr[kk * 65 + c4 + 3] = v.w; }
    } else {
        const int sc = remap ? win_src_col(n0 + lane) : n0 + lane;
#pragma unroll 8
        for (int kk = 0; kk < 64; ++kk) scr[kk * 65 + lane] = sc >= 0 ? W[(size_t)(k0 + kk) * Nsrc + sc] : 0.f;
    }
    LDS_WAIT(); asm volatile("" ::: "memory");
    const int c = lane & 7;
#pragma unroll
    for (int j = 0; j < 8; ++j) { const int n = (lane >> 3) + 8 * j; const LAS float* s = scr + (8 * c) * 65 + n;
        v4u o; o.x = pk2(s[0 * 65], s[1 * 65]); o.y = pk2(s[2 * 65], s[3 * 65]); o.z = pk2(s[4 * 65], s[5 * 65]); o.w = pk2(s[6 * 65], s[7 * 65]);
        *(GAS v4u*)(WT + (size_t)(n0 + n) * K + k0 + 8 * c) = o; }
    LDS_WAIT(); asm volatile("" ::: "memory");
}
__device__ __forceinline__ void rms_row(const GAS float* src, const GAS float* w, GAS float* hdst, GAS bf16* udst, GAS float* fdst, int lane) {
    f32x4 v[4]; float ss = 0.f;
#pragma unroll
    for (int j = 0; j < 4; ++j) { v[j] = src ? ((const GAS f32x4*)src)[lane + 64 * j] : (f32x4){0.f, 0.f, 0.f, 0.f}; ss += (v[j].x * v[j].x + v[j].y * v[j].y) + (v[j].z * v[j].z + v[j].w * v[j].w); }
    ss = wave_sum(ss);
    const float rstd = 1.0f / sqrtf(ss * (1.0f / D) + 1e-6f);
#pragma unroll
    for (int j = 0; j < 4; ++j) {
        if (hdst) ((GAS f32x4*)hdst)[lane + 64 * j] = v[j];
        const f32x4 wv = ((const GAS f32x4*)w)[lane + 64 * j]; const f32x4 o = v[j] * rstd * wv;
        if (udst) ((GAS v2u*)udst)[lane + 64 * j] = (v2u){pk2(o.x, o.y), pk2(o.z, o.w)};
        if (fdst) ((GAS f32x4*)fdst)[lane + 64 * j] = o;
    }
}

__device__ __forceinline__ void ssd_unit(LAS unsigned char* lds, int tid, const GAS bf16* XC, const GAS float* DT, const GAS float* DA, size_t m0, int L, int h, int p0,
                                         const GAS float* hin, GAS float* hout, GAS float* YS, float dskip) {
    LAS float* Bl = (LAS float*)lds;
    LAS float* Cl = Bl + 64 * 128;
    LAS float* Xl = Cl + 64 * 128;
    LAS float* Yl = Xl + 64 * 32;
    LAS float* dtl = Yl + 64 * 32;
    LAS float* dal = dtl + 64;
    const int pl = tid >> 4, nq = tid & 15, n0 = nq * 8, g = h >> 3;
    float s[8];
    if (hin) { const f32x4 a = *(const GAS f32x4*)(hin + (size_t)(p0 + pl) * NST + n0), b = *(const GAS f32x4*)(hin + (size_t)(p0 + pl) * NST + n0 + 4);
        s[0] = a.x; s[1] = a.y; s[2] = a.z; s[3] = a.w; s[4] = b.x; s[5] = b.y; s[6] = b.z; s[7] = b.w; }
    else {
#pragma unroll
        for (int i = 0; i < 8; ++i) s[i] = 0.f; }
    for (int tb = 0; tb < L; tb += 64) {
        const int nb = (L - tb) < 64 ? (L - tb) : 64;
        { const int tk = tid >> 3, part = tid & 7;
            if (tk < nb) { const GAS bf16* xr = XC + (m0 + tb + tk) * CONVD;
                float f[8];
                unpack8(*(const GAS v4u*)(xr + DIN + g * NST + part * 16), f);
                *(LAS f32x4*)(Bl + tk * 128 + part * 16) = (f32x4){f[0], f[1], f[2], f[3]}; *(LAS f32x4*)(Bl + tk * 128 + part * 16 + 4) = (f32x4){f[4], f[5], f[6], f[7]};
                unpack8(*(const GAS v4u*)(xr + DIN + g * NST + part * 16 + 8), f);
                *(LAS f32x4*)(Bl + tk * 128 + part * 16 + 8) = (f32x4){f[0], f[1], f[2], f[3]}; *(LAS f32x4*)(Bl + tk * 128 + part * 16 + 12) = (f32x4){f[4], f[5], f[6], f[7]};
                unpack8(*(const GAS v4u*)(xr + DIN + NG * NST + g * NST + part * 16), f);
                *(LAS f32x4*)(Cl + tk * 128 + part * 16) = (f32x4){f[0], f[1], f[2], f[3]}; *(LAS f32x4*)(Cl + tk * 128 + part * 16 + 4) = (f32x4){f[4], f[5], f[6], f[7]};
                unpack8(*(const GAS v4u*)(xr + DIN + NG * NST + g * NST + part * 16 + 8), f);
                *(LAS f32x4*)(Cl + tk * 128 + part * 16 + 8) = (f32x4){f[0], f[1], f[2], f[3]}; *(LAS f32x4*)(Cl + tk * 128 + part * 16 + 12) = (f32x4){f[4], f[5], f[6], f[7]};
                const v2u xw = *(const GAS v2u*)(xr + h * HP + p0 + part * 4);
                *(LAS f32x4*)(Xl + tk * 32 + part * 4) = (f32x4){__uint_as_float(xw.x << 16), __uint_as_float(xw.x & 0xffff0000u), __uint_as_float(xw.y << 16), __uint_as_float(xw.y & 0xffff0000u)};
            }
            if (tid < nb) { dtl[tid] = DT[(m0 + tb + tid) * 32 + h]; dal[tid] = DA[(m0 + tb + tid) * 32 + h]; }
        }
        __syncthreads();
        for (int t = 0; t < nb; ++t) {
            const float da = dal[t], dtv = dtl[t], xv = Xl[t * 32 + pl], xdt = xv * dtv;
            const f32x4 b0 = *(const LAS f32x4*)(Bl + t * 128 + n0), b1 = *(const LAS f32x4*)(Bl + t * 128 + n0 + 4);
            const f32x4 c0 = *(const LAS f32x4*)(Cl + t * 128 + n0), c1 = *(const LAS f32x4*)(Cl + t * 128 + n0 + 4);
            s[0] = s[0] * da + xdt * b0.x; s[1] = s[1] * da + xdt * b0.y; s[2] = s[2] * da + xdt * b0.z; s[3] = s[3] * da + xdt * b0.w;
            s[4] = s[4] * da + xdt * b1.x; s[5] = s[5] * da + xdt * b1.y; s[6] = s[6] * da + xdt * b1.z; s[7] = s[7] * da + xdt * b1.w;
            float y = (s[0] * c0.x + s[1] * c0.y) + (s[2] * c0.z + s[3] * c0.w) + (s[4] * c1.x + s[5] * c1.y) + (s[6] * c1.z + s[7] * c1.w);
            y += __shfl_xor(y, 1); y += __shfl_xor(y, 2); y += __shfl_xor(y, 4); y += __shfl_xor(y, 8);
            if (nq == 0) Yl[t * 32 + pl] = y + xv * dskip;
        }
        __syncthreads();
        { const int tk = tid >> 3, part = tid & 7;
            if (tk < nb) *(GAS f32x4*)(YS + (m0 + tb + tk) * DIN + h * HP + p0 + part * 4) = *(const LAS f32x4*)(Yl + tk * 32 + part * 4); }
    }
    *(GAS f32x4*)(hout + (size_t)(p0 + pl) * NST + n0) = (f32x4){s[0], s[1], s[2], s[3]};
    *(GAS f32x4*)(hout + (size_t)(p0 + pl) * NST + n0 + 4) = (f32x4){s[4], s[5], s[6], s[7]};
}

__device__ __forceinline__ void idx_load_q(const GAS bf16* P1, const GAS float* MISC, size_t mq0, int lane, bf16x8 (&afr)[2][4], float (&wq)[2][2][8]) {
    const int r = lane & 31, hh = lane >> 5, qs = ((r >> 2) & 1) * 2 + (r >> 4), head = (r & 3) + 4 * ((r >> 3) & 1);
#pragma unroll
    for (int rt = 0; rt < 2; ++rt)
#pragma unroll
        for (int ks = 0; ks < 4; ++ks) afr[rt][ks] = *(const GAS bf16x8*)(P1 + (mq0 + qs + 4 * rt) * LDP1 + C_QI + head * 64 + 16 * ks + 8 * hh);
#pragma unroll
    for (int rt = 0; rt < 2; ++rt)
#pragma unroll
        for (int jq = 0; jq < 2; ++jq) { const GAS float* wp = MISC + (mq0 + 4 * rt + 2 * hh + jq) * 128 + MC_WI; const f32x4 a = *(const GAS f32x4*)wp, b = *(const GAS f32x4*)(wp + 4);
            const float sc = 0.125f * 0.35355339059327373f;
            wq[rt][jq][0] = a.x * sc; wq[rt][jq][1] = a.y * sc; wq[rt][jq][2] = a.z * sc; wq[rt][jq][3] = a.w * sc; wq[rt][jq][4] = b.x * sc; wq[rt][jq][5] = b.y * sc; wq[rt][jq][6] = b.z * sc; wq[rt][jq][7] = b.w * sc; }
}
__device__ __forceinline__ void idx_scores(const bf16x8 (&afr)[2][4], const bf16x8 (&bfr)[4], const float (&wq)[2][2][8], float (&sc)[2][2]) {
#pragma unroll
    for (int rt = 0; rt < 2; ++rt) {
        f32x16 acc = {};
#pragma unroll
        for (int ks = 0; ks < 4; ++ks) acc = __builtin_amdgcn_mfma_f32_32x32x16_bf16(afr[rt][ks], bfr[ks], acc, 0, 0, 0);
#pragma unroll
        for (int jq = 0; jq < 2; ++jq) { float s = 0.f;
#pragma unroll
            for (int i = 0; i < 8; ++i) s += wq[rt][jq][i] * fmaxf(acc[8 * jq + i], 0.f);
            sc[rt][jq] = s; }
    }
}
__device__ __forceinline__ unsigned f2key(float f) { const unsigned u = __float_as_uint(f); return u ^ ((u >> 31) ? 0xffffffffu : 0x80000000u); }
__device__ __forceinline__ unsigned wave_incl_scan(unsigned v, int lane) {
#pragma unroll
    for (int o = 1; o < 64; o <<= 1) { const unsigned t = __shfl_up(v, o); if (lane >= o) v += t; }
    return v;
}
#ifndef REP_TK_PASS
#define REP_TK_PASS 1
#endif
#ifndef REP_TK_COMP
#define REP_TK_COMP 1
#endif
__device__ __forceinline__ int wave_sum_i(int v) {
    v += __builtin_amdgcn_update_dpp(0, v, 0xB1, 0xf, 0xf, true);
    v += __builtin_amdgcn_update_dpp(0, v, 0x4E, 0xf, 0xf, true);
    v += __builtin_amdgcn_update_dpp(0, v, 0x141, 0xf, 0xf, true);
    v += __builtin_amdgcn_update_dpp(0, v, 0x140, 0xf, 0xf, true);
    v += __builtin_amdgcn_update_dpp(0, v, 0x142, 0xa, 0xf, false);
    v += __builtin_amdgcn_update_dpp(0, v, 0x143, 0xc, 0xf, false);
    return __builtin_amdgcn_readlane(v, 63);
}
__device__ __forceinline__ int cnt_ge(const LAS unsigned* s, int nit, unsigned mid, int lane) {
    int cl = 0; int it = 0;
    const LAS v4u* p = (const LAS v4u*)s + lane;
    for (; it + 4 <= nit; it += 4) {
        const v4u k0 = p[64 * it], k1 = p[64 * it + 64], k2 = p[64 * it + 128], k3 = p[64 * it + 192];
        cl += (k0.x >= mid) + (k0.y >= mid) + (k0.z >= mid) + (k0.w >= mid);
        cl += (k1.x >= mid) + (k1.y >= mid) + (k1.z >= mid) + (k1.w >= mid);
        cl += (k2.x >= mid) + (k2.y >= mid) + (k2.z >= mid) + (k2.w >= mid);
        cl += (k3.x >= mid) + (k3.y >= mid) + (k3.z >= mid) + (k3.w >= mid); }
    for (; it < nit; ++it) { const v4u kv = p[64 * it]; cl += (kv.x >= mid) + (kv.y >= mid) + (kv.z >= mid) + (kv.w >= mid); }
    return wave_sum_i(cl);
}
template <class OT>
__device__ __forceinline__ void topk_select(LAS unsigned* s, int n, int lane, OT* out) {
    const int nit = (n + 255) >> 8;
    for (int i = n + lane; i < nit * 256; i += 64) s[i] = 0u;
    LDS_WAIT(); asm volatile("" ::: "memory");
    unsigned T = 0u, need = 0u;
    for (int rq_ = 0; rq_ < REP_TK_PASS; ++rq_) {
    unsigned kmx = 0u;
    for (int it = 0; it < nit; ++it) { const v4u kv = *(const LAS v4u*)(s + 4 * (lane + 64 * it));
        const unsigned a = kv.x > kv.y ? kv.x : kv.y, c = kv.z > kv.w ? kv.z : kv.w, d = a > c ? a : c; kmx = d > kmx ? d : kmx; }
#pragma unroll
    for (int o = 1; o < 64; o <<= 1) { const unsigned a = __shfl_xor(kmx, o); kmx = a > kmx ? a : kmx; }
    kmx = (unsigned)__builtin_amdgcn_readfirstlane((int)kmx);
    unsigned hi = kmx + 1u, lo = 1u; int c_hi = 0, c_lo = n;
    { unsigned step = 1u << 25;
      for (int tr = 0; tr < 7; ++tr) { if (hi <= step + 1u) break; const unsigned cand = hi - step;
          const int c = cnt_ge(s, nit, cand, lane);
          if (c >= 256) { lo = cand; c_lo = c; break; } hi = cand; c_hi = c; step <<= 1; } }
    bool bis = false; unsigned pw = hi - lo;
    for (int pass = 0; pass < 96; ++pass) {
        if (c_lo == 256) { T = lo - 1u; need = 0u; break; }
        if (hi - lo <= 1u) { T = lo; need = (unsigned)(256 - c_hi); break; }
        const unsigned width = hi - lo; unsigned mid;
        if (bis) mid = lo + (width >> 1);
        else { const float f = ((float)(c_lo - 256) + 0.5f) * __builtin_amdgcn_rcpf((float)(c_lo - c_hi)); const float off = (float)width * f;
               mid = lo + (off >= (float)width ? width - 1u : (unsigned)off); }
        if (mid <= lo) mid = lo + 1u; if (mid >= hi) mid = hi - 1u;
        const int c = cnt_ge(s, nit, mid, lane);
        if (c >= 256) { lo = mid; c_lo = c; } else { hi = mid; c_hi = c; }
        const unsigned nw = hi - lo; bis = !bis && (nw > (pw >> 2)); pw = nw;
    }
    }
    const unsigned long long lt = (1ull << lane) - 1ull;
    unsigned running = 0u, eq_taken = 0u;
    for (int rq_ = 0; rq_ < REP_TK_COMP; ++rq_) { running = 0u; eq_taken = 0u;
#pragma unroll 2
    for (int it = 0; it < nit; ++it) {
        const int i0 = 4 * (lane + 64 * it); const v4u kv = *(const LAS v4u*)(s + i0);
        bool sel[4], eq[4]; bool anyeq = false;
#pragma unroll
        for (int e = 0; e < 4; ++e) { sel[e] = kv[e] > T; eq[e] = need != 0u && kv[e] == T && (i0 + e < n); anyeq = anyeq || eq[e]; }
        if (need != 0u && __ballot(anyeq)) {
            unsigned lower = 0u, all = 0u;
#pragma unroll
            for (int e = 0; e < 4; ++e) { const unsigned long long bm = __ballot(eq[e]); lower += (unsigned)__popcll(bm & lt); all += (unsigned)__popcll(bm); }
            unsigned er = eq_taken + lower;
#pragma unroll
            for (int e = 0; e < 4; ++e) { if (eq[e]) { sel[e] = er < need; ++er; } }
            eq_taken += all;
        }
        unsigned lower = 0u, all = 0u;
#pragma unroll
        for (int e = 0; e < 4; ++e) { const unsigned long long sm = __ballot(sel[e]); lower += (unsigned)__popcll(sm & lt); all += (unsigned)__popcll(sm); }
        unsigned pos = running + lower;
#pragma unroll
        for (int e = 0; e < 4; ++e) { if (sel[e]) { if (pos < 256u) out[pos] = (OT)(i0 + e); ++pos; } }
        running += all;
    } }
}

constexpr int NCH = 33;
typedef short s16x4 __attribute__((ext_vector_type(4)));
typedef short v4i16_t __attribute__((ext_vector_type(4)));
__device__ __forceinline__ float wave_incl_scan_f(float v, int lane) {
#pragma unroll
    for (int o = 1; o < 64; o <<= 1) { const float t = __shfl_up(v, o); if (lane >= o) v += t; }
    return v;
}
__device__ __forceinline__ s16x4 ldtr(const LAS unsigned char* p) { return __builtin_bit_cast(s16x4, __builtin_amdgcn_ds_read_tr16_b64_v4i16((LAS v4i16_t*)p)); }
__device__ __forceinline__ bf16x8 frag_tr(const LAS unsigned char* img, int RS, int k0, int c0, int lane) {
    const int hh = lane >> 5, blk = (lane >> 4) & 1, q = (lane & 15) >> 2, pp = lane & 3;
    const LAS unsigned char* a = img + (k0 + 8 * hh + q) * RS + (c0 + 16 * blk + 4 * pp) * 2;
    const s16x4 lo = ldtr(a), hi = ldtr(a + 4 * RS);
    return (bf16x8){lo[0], lo[1], lo[2], lo[3], hi[0], hi[1], hi[2], hi[3]};
}
__device__ __forceinline__ bf16x8 frag_row(const LAS unsigned char* img, int RS, int r0, int k0, int lane) {
    return *(const LAS bf16x8*)(img + (r0 + (lane & 31)) * RS + (k0 + 8 * (lane >> 5)) * 2);
}
constexpr int RS_BC = 272, RS_X = 144, IMG_BC = 128 * RS_BC, IMG_X = 128 * RS_X;
__device__ __forceinline__ void ssd_stage_acum(LAS float* acl, LAS float* dtl, const GAS float* DT, const GAS float* a_log_l, size_t m0, int Lc, int g, int wave, int lane) {
    const int h = 8 * g + wave; const float A = -__expf(a_log_l[h]);
    const float d0 = lane < Lc ? DT[(m0 + lane) * 32 + h] : 0.f, d1 = (64 + lane) < Lc ? DT[(m0 + 64 + lane) * 32 + h] : 0.f;
    const float s0 = wave_incl_scan_f(d0 * A, lane), tot0 = __shfl(s0, 63), s1 = wave_incl_scan_f(d1 * A, lane) + tot0;
    acl[wave * 128 + lane] = s0; acl[wave * 128 + 64 + lane] = s1; dtl[wave * 128 + lane] = d0; dtl[wave * 128 + 64 + lane] = d1;
}
__device__ __forceinline__ void ssd_stage_bc(LAS unsigned char* img, const GAS bf16* src  , int Lc, int tid) {
    const int row = tid >> 2, part = tid & 3;
#pragma unroll
    for (int q4 = 0; q4 < 4; ++q4) { v4u v = (v4u){0u, 0u, 0u, 0u}; if (row < Lc) v = *(const GAS v4u*)(src + (size_t)row * CONVD + part * 32 + q4 * 8);
        *(LAS v4u*)(img + row * RS_BC + (part * 32 + q4 * 8) * 2) = v; }
}
__device__ __forceinline__ void ssd_stage_x(LAS unsigned char* img, const GAS bf16* src  , int Lc, int tid, float sc) {
    const int row = tid >> 2, part = tid & 3;
#pragma unroll
    for (int q2 = 0; q2 < 2; ++q2) { v4u o = (v4u){0u, 0u, 0u, 0u};
        if (row < Lc) { float f[8]; unpack8(*(const GAS v4u*)(src + (size_t)row * CONVD + part * 16 + q2 * 8), f);
            o = (v4u){pk2(f[0] * sc, f[1] * sc), pk2(f[2] * sc, f[3] * sc), pk2(f[4] * sc, f[5] * sc), pk2(f[6] * sc, f[7] * sc)}; }
        *(LAS v4u*)(img + row * RS_X + (part * 16 + q2 * 8) * 2) = o; }
}
__device__ __forceinline__ void ssd1_unit(LAS unsigned char* lds, int tid, const GAS bf16* XC, const GAS float* DT, const GAS float* a_log_l, GAS bf16* SB, GAS float* DEC, int b, int c, int g) {
    const int lane = tid & 63, wave = __builtin_amdgcn_readfirstlane(tid >> 6), hh = lane >> 5, col = lane & 31;
    const int t0 = c == 0 ? 0 : NMETA + 128 * (c - 1), Lc = c == 0 ? NMETA : 128; const size_t m0 = (size_t)b * LP + t0;
    LAS unsigned char* Bimg = lds; LAS unsigned char* Xw0 = lds + IMG_BC;
    LAS float* acl = (LAS float*)(lds + IMG_BC + 2 * IMG_X); LAS float* dtl = acl + 1024;
    ssd_stage_acum(acl, dtl, DT, a_log_l, m0, Lc, g, wave, lane);
    ssd_stage_bc(Bimg, XC + m0 * CONVD + DIN + g * NST, Lc, tid);
    __syncthreads();
    const int pb = wave >> 2, nb = wave & 3;
    for (int hl = 0; hl < 8; ++hl) {
        const int h = 8 * g + hl; LAS unsigned char* Xw = Xw0 + (hl & 1) * IMG_X;
        const float al = acl[hl * 128 + 127];
        { const int row = tid >> 2; ssd_stage_x(Xw, XC + m0 * CONVD + h * HP, Lc, tid, dtl[hl * 128 + row] * __expf(al - acl[hl * 128 + row])); }
        __syncthreads();
        f32x16 acc = {};
        if (Lc == 128) {
#pragma unroll
            for (int ks = 0; ks < 8; ++ks) acc = __builtin_amdgcn_mfma_f32_32x32x16_bf16(frag_tr(Xw, RS_X, 16 * ks, 32 * pb, lane), frag_tr(Bimg, RS_BC, 16 * ks, 32 * nb, lane), acc, 0, 0, 0);
        } else acc = __builtin_amdgcn_mfma_f32_32x32x16_bf16(frag_tr(Xw, RS_X, 0, 32 * pb, lane), frag_tr(Bimg, RS_BC, 0, 32 * nb, lane), acc, 0, 0, 0);
        GAS bf16* Sp = SB + ((size_t)(b * NCH + c) * NH + h) * (HP * NST) + 32 * nb + col;
#pragma unroll
        for (int r = 0; r < 16; ++r) Sp[(32 * pb + (r & 3) + 8 * (r >> 2) + 4 * hh) * NST] = (bf16)f2bf(acc[r]);
        if (tid == 0) DEC[(b * NCH + c) * NH + h] = __expf(al);
    }
    __syncthreads();
}
__device__ __forceinline__ void ssd3_unit(LAS unsigned char* lds, int tid, const GAS bf16* XC, const GAS bf16* P1, const GAS float* DT, const GAS float* a_log_l, const GAS float* dskip_l, const GAS float* normw_l,
                                          const GAS bf16* HC, GAS bf16* YSN, int b, int c, int g) {
    const int lane = tid & 63, wave = __builtin_amdgcn_readfirstlane(tid >> 6), hh = lane >> 5, col = lane & 31;
    const int t0 = c == 0 ? 0 : NMETA + 128 * (c - 1), Lc = c == 0 ? NMETA : 128; const size_t m0 = (size_t)b * LP + t0;
    LAS unsigned char* Bimg = lds; LAS unsigned char* Cimg = lds + IMG_BC; LAS unsigned char* Mimg = lds + 2 * IMG_BC; LAS unsigned char* Ximg = lds + 3 * IMG_BC;
    LAS float* acl = (LAS float*)(lds + 3 * IMG_BC + IMG_X); LAS float* dtl = acl + 1024;
    ssd_stage_acum(acl, dtl, DT, a_log_l, m0, Lc, g, wave, lane);
    ssd_stage_bc(Bimg, XC + m0 * CONVD + DIN + g * NST, Lc, tid);
    ssd_stage_bc(Cimg, XC + m0 * CONVD + DIN + NG * NST + g * NST, Lc, tid);
    __syncthreads();
    const int ib = wave >> 1, pb = wave & 1;
    f32x16 cb[2];
    const bool live = 32 * ib < Lc;
#pragma unroll
    for (int jj = 0; jj < 2; ++jj) { const int jb = 2 * (wave & 1) + jj; cb[jj] = (f32x16){};
        if (jb <= ib && live) {
#pragma unroll
            for (int ks = 0; ks < 8; ++ks) cb[jj] = __builtin_amdgcn_mfma_f32_32x32x16_bf16(frag_row(Cimg, RS_BC, 32 * ib, 16 * ks, lane), frag_row(Bimg, RS_BC, 32 * jb, 16 * ks, lane), cb[jj], 0, 0, 0); } }
    const int xrow = tid >> 2, xpart = tid & 3;
    const GAS bf16* xsrc = XC + (m0 + xrow) * CONVD + (8 * g) * HP + xpart * 16;
    v4u xq0 = (v4u){0u, 0u, 0u, 0u}, xq1 = xq0;
    if (xrow < Lc) { xq0 = *(const GAS v4u*)xsrc; xq1 = *(const GAS v4u*)(xsrc + 8); }
    for (int hl = 0; hl < 8; ++hl) {
        const int h = 8 * g + hl;
        bf16x8 hf[8];
        { const GAS bf16* Hp = HC + ((size_t)(b * NCH + c) * NH + h) * (HP * NST) + (size_t)(32 * pb + col) * NST + 8 * hh;
#pragma unroll
          for (int ks = 0; ks < 8; ++ks) hf[ks] = *(const GAS bf16x8*)(Hp + 16 * ks); }
        v4u xn0 = xq0, xn1 = xq1;
        if (hl < 7 && xrow < Lc) { xn0 = *(const GAS v4u*)(xsrc + (hl + 1) * HP); xn1 = *(const GAS v4u*)(xsrc + (hl + 1) * HP + 8); }
        float ai[16];
#pragma unroll
        for (int r = 0; r < 16; ++r) ai[r] = acl[hl * 128 + 32 * ib + (r & 3) + 8 * (r >> 2) + 4 * hh];
#pragma unroll
        for (int jj = 0; jj < 2; ++jj) { const int jb = 2 * (wave & 1) + jj;
            if (jb <= ib && live) { const int j = 32 * jb + col; const float aj = acl[hl * 128 + j];
                LAS unsigned char* mp = Mimg + (32 * ib + 4 * hh) * RS_BC + j * 2;
#pragma unroll
                for (int r = 0; r < 16; ++r) { const int il = (r & 3) + 8 * (r >> 2);
                    const float v = (j <= 32 * ib + 4 * hh + il) ? cb[jj][r] * __expf(ai[r] - aj) : 0.f;
                    *(LAS unsigned short*)(mp + il * RS_BC) = (unsigned short)f2bf(v); } } }
        { const float sc = dtl[hl * 128 + xrow]; float f[8]; v4u o0, o1;
          unpack8(xq0, f); o0 = (v4u){pk2(f[0] * sc, f[1] * sc), pk2(f[2] * sc, f[3] * sc), pk2(f[4] * sc, f[5] * sc), pk2(f[6] * sc, f[7] * sc)};
          unpack8(xq1, f); o1 = (v4u){pk2(f[0] * sc, f[1] * sc), pk2(f[2] * sc, f[3] * sc), pk2(f[4] * sc, f[5] * sc), pk2(f[6] * sc, f[7] * sc)};
          *(LAS v4u*)(Ximg + xrow * RS_X + (xpart * 16) * 2) = o0; *(LAS v4u*)(Ximg + xrow * RS_X + (xpart * 16 + 8) * 2) = o1; }
        __syncthreads();
        f32x16 a1 = {}, a2 = {};
        if (live) {
        const int nks = Lc == 128 ? 2 * (ib + 1) : 1;
        for (int ks = 0; ks < nks; ++ks) a1 = __builtin_amdgcn_mfma_f32_32x32x16_bf16(frag_row(Mimg, RS_BC, 32 * ib, 16 * ks, lane), frag_tr(Ximg, RS_X, 16 * ks, 32 * pb, lane), a1, 0, 0, 0);
#pragma unroll
        for (int ks = 0; ks < 8; ++ks) a2 = __builtin_amdgcn_mfma_f32_32x32x16_bf16(frag_row(Cimg, RS_BC, 32 * ib, 16 * ks, lane), hf[ks], a2, 0, 0, 0);
        GAS bf16* yo = YSN + (m0 + 32 * ib + 4 * hh) * DIN + h * HP + 32 * pb + col;
#pragma unroll
        for (int r = 0; r < 16; ++r) { const int il = (r & 3) + 8 * (r >> 2);
            if (32 * ib + 4 * hh + il < Lc) yo[(size_t)il * DIN] = (bf16)f2bf(a1[r] + __expf(ai[r]) * a2[r]); }
        }
        __syncthreads();
        xq0 = xn0; xq1 = xn1;
    }
    for (int i0 = wave; i0 < Lc; i0 += 4 * NWAVES) { const int c0 = g * 512 + lane * 8;
        v4u yv[4], xv[4], zv[4];
#pragma unroll
        for (int q = 0; q < 4; ++q) { const int i = i0 + NWAVES * q; const size_t m = m0 + (i < Lc ? i : i0);
            yv[q] = *(const GAS v4u*)(YSN + m * DIN + c0); xv[q] = *(const GAS v4u*)(XC + m * CONVD + c0); zv[q] = *(const GAS v4u*)(P1 + m * LDP1 + C_Z + c0); }
        const float Dh = dskip_l[c0 >> 6];
        const GAS float* wp = normw_l + c0; const f32x4 wa = *(const GAS f32x4*)wp, wb = *(const GAS f32x4*)(wp + 4);
#pragma unroll
        for (int q = 0; q < 4; ++q) { const int i = i0 + NWAVES * q;
            float v[8], x[8], z[8]; unpack8(yv[q], v); unpack8(xv[q], x); unpack8(zv[q], z); float ss = 0.f;
#pragma unroll
            for (int j = 0; j < 8; ++j) { v[j] = (v[j] + Dh * x[j]) * (z[j] * sigm(z[j])); ss += v[j] * v[j]; }
            ss = wave_sum(ss);
            const float rstd = 1.0f / sqrtf(ss * (1.0f / 512.0f) + 1e-6f);
            if (i < Lc) *(GAS v4u*)(YSN + (m0 + i) * DIN + c0) = (v4u){pk2(v[0] * rstd * wa.x, v[1] * rstd * wa.y), pk2(v[2] * rstd * wa.z, v[3] * rstd * wa.w), pk2(v[4] * rstd * wb.x, v[5] * rstd * wb.y), pk2(v[6] * rstd * wb.z, v[7] * rstd * wb.w)}; }
    }
    __syncthreads();
}

constexpr int RS_V = 528;
__device__ __forceinline__ void attn_prompt_query(LAS unsigned char* wl, const GAS bf16* P1, const GAS bf16* KVB, const GAS unsigned short* IDXP, GAS bf16* YA, int m, int lane_in) {
    int lane = lane_in; asm volatile("" : "+v"(lane));
    const int b = m / LP, t = m - b * LP, cnt = (t + 1) < 256 ? (t + 1) : 256, ntile = (cnt + 15) >> 4, nstep = (ntile + 1) >> 1;
    LAS unsigned char* Vst = wl; LAS unsigned short* idl = (LAS unsigned short*)(wl + 32 * RS_V);
    { const v2u w = *(const GAS v2u*)(IDXP + (size_t)m * 256 + 4 * lane); const int s0 = 4 * lane;
      const unsigned i0 = (s0 + 0 < cnt) ? (w.x & 0xffffu) : 0u, i1 = (s0 + 1 < cnt) ? (w.x >> 16) : 0u, i2 = (s0 + 2 < cnt) ? (w.y & 0xffffu) : 0u, i3 = (s0 + 3 < cnt) ? (w.y >> 16) : 0u;
      *(LAS v2u*)(idl + s0) = (v2u){i0 | (i1 << 16), i2 | (i3 << 16)}; }
    const int n = lane & 15, kg = lane >> 4;
    int k4 = 4 * kg; asm volatile("" : "+v"(k4));
    bf16x8 bq[8];
#pragma unroll
    for (int s = 0; s < 8; ++s) { bq[s] = (bf16x8){0, 0, 0, 0, 0, 0, 0, 0};
        if ((n >> 2) == (s >> 1)) bq[s] = *(const GAS bf16x8*)(P1 + (size_t)m * LDP1 + C_Q + n * 64 + 32 * (s & 1) + 8 * kg); }
    LDS_WAIT(); asm volatile("" ::: "memory");
    const GAS char* kvb = (const GAS char*)(KVB + (size_t)b * LP * 512);
    const unsigned voff = 512u + 16u * (lane & 31);
    f32x4 S[16];
#pragma unroll
    for (int jt = 0; jt < 16; ++jt) S[jt] = (f32x4){-INFINITY, -INFINITY, -INFINITY, -INFINITY};
    float mx = -INFINITY;
    {
        v4u kr[16];
#pragma unroll
        for (int it = 0; it < 16; ++it) kr[it] = *(const GAS v4u*)(kvb + ((unsigned)idl[2 * it + (lane >> 5)] * 1024u + 16u * (lane & 31)));
#pragma unroll
        for (int s = 0; s < 8; ++s) {
            if (s < nstep) {
#pragma unroll
                for (int it = 0; it < 16; ++it) *(LAS v4u*)(Vst + (2 * it + (lane >> 5)) * RS_V + 16 * (lane & 31)) = kr[it];
                LDS_WAIT(); asm volatile("" ::: "memory");
                if (s + 1 < nstep) {
#pragma unroll
                    for (int it = 0; it < 16; ++it) kr[it] = *(const GAS v4u*)(kvb + ((unsigned)idl[32 * (s + 1) + 2 * it + (lane >> 5)] * 1024u + 16u * (lane & 31))); }
#pragma unroll
                for (int tt = 0; tt < 2; ++tt) {
                    if (2 * s + tt < ntile) {
                        f32x4 acc = {0.f, 0.f, 0.f, 0.f};
#pragma unroll
                        for (int s8 = 0; s8 < 8; ++s8) acc = __builtin_amdgcn_mfma_f32_16x16x32_bf16(*(const LAS bf16x8*)(Vst + (16 * tt + n) * RS_V + (32 * s8 + 8 * kg) * 2), bq[s8], acc, 0, 0, 0);
                        f32x4 sv;
#pragma unroll
                        for (int i = 0; i < 4; ++i) { const float v = (k4 + i < cnt - 16 * (2 * s + tt)) ? acc[i] * 0.125f : -INFINITY; sv[i] = v; mx = fmaxf(mx, v); }
                        S[2 * s + tt] = sv;
                    }
                }
                LDS_WAIT(); asm volatile("" ::: "memory");
            }
        }
    }
    mx = fmaxf(mx, __shfl_xor(mx, 16)); mx = fmaxf(mx, __shfl_xor(mx, 32));
    float sum = 0.f;
    v4u pa[8];
#pragma unroll
    for (int s = 0; s < 8; ++s) { float p[8];
#pragma unroll
        for (int i = 0; i < 4; ++i) { p[i] = __expf(S[2 * s][i] - mx); p[4 + i] = __expf(S[2 * s + 1][i] - mx); }
#pragma unroll
        for (int i = 0; i < 8; ++i) sum += p[i];
        pa[s] = (v4u){pk2(p[0], p[1]), pk2(p[2], p[3]), pk2(p[4], p[5]), pk2(p[6], p[7])};
        __builtin_amdgcn_sched_barrier(0); }
    sum += __shfl_xor(sum, 16); sum += __shfl_xor(sum, 32);
    const float linv = 1.0f / sum;
    asm volatile("" ::: "memory");
    v4u vr[16];
#pragma unroll
    for (int it = 0; it < 16; ++it) { const int rho = 2 * it + (lane >> 5), slot = 16 * ((rho >> 2) & 1) + 4 * (rho >> 3) + (rho & 3);
        vr[it] = *(const GAS v4u*)(kvb + ((unsigned)idl[slot] * 1024u + voff)); }
    f32x4 o[4];
#pragma unroll
    for (int c = 0; c < 4; ++c) o[c] = (f32x4){0.f, 0.f, 0.f, 0.f};
    const int g16 = lane >> 4, q4 = (lane & 15) >> 2, p4 = lane & 3;
    const LAS unsigned char* trb = Vst + (8 * g16 + q4) * RS_V + 8 * p4;
#pragma unroll
    for (int s = 0; s < 8; ++s) {
        if (s < nstep) {
#pragma unroll
            for (int it = 0; it < 16; ++it) *(LAS v4u*)(Vst + (2 * it + (lane >> 5)) * RS_V + 16 * (lane & 31)) = vr[it];
            LDS_WAIT(); asm volatile("" ::: "memory");
            if (s + 1 < nstep) {
#pragma unroll
                for (int it = 0; it < 16; ++it) { const int rho = 2 * it + (lane >> 5), slot = 32 * (s + 1) + 16 * ((rho >> 2) & 1) + 4 * (rho >> 3) + (rho & 3);
                    vr[it] = *(const GAS v4u*)(kvb + ((unsigned)idl[slot] * 1024u + voff)); } }
#pragma unroll
            for (int g = 0; g < 4; ++g) {
                const v4u pm = ((n >> 2) == g) ? pa[s] : (v4u){0u, 0u, 0u, 0u};
                const bf16x8 pf = __builtin_bit_cast(bf16x8, pm);
#pragma unroll
                for (int c = 0; c < 4; ++c) { const int ct = 4 * g + c;
                    const s16x4 lo = ldtr(trb + 32 * ct), hi = ldtr(trb + 4 * RS_V + 32 * ct);
                    const bf16x8 bv = (bf16x8){lo[0], lo[1], lo[2], lo[3], hi[0], hi[1], hi[2], hi[3]};
                    o[c] = __builtin_amdgcn_mfma_f32_16x16x32_bf16(pf, bv, o[c], 0, 0, 0); }
            }
            LDS_WAIT(); asm volatile("" ::: "memory");
        }
    }
#pragma unroll
    for (int i = 0; i < 4; ++i) { const float li = __shfl(linv, 4 * kg + i);
#pragma unroll
        for (int c = 0; c < 4; ++c) YA[(size_t)m * D + (4 * kg + i) * 64 + 16 * c + n] = (bf16)f2bf(o[c][i] * li); }
}

__device__ __forceinline__ void attn_sample_query(LAS unsigned char* lds, int tid, const GAS bf16* P1, const GAS bf16* KVB, const GAS float* ck, const GAS float* cv, const GAS int* ptab, const GAS int* IDXS, GAS bf16* YA, int qi) {
    const int lane = tid & 63, wave = tid >> 6, bd = qi >> 3; const size_t m = (size_t)MP + qi;
    LAS float* Sl = (LAS float*)lds;
    LAS float* Ol = Sl + 16 * 256;
    LAS float* ql = Ol + 8 * 1024;
    LAS float* linv = ql + 1024;
    LAS int* rowsel = (LAS int*)(linv + 16);
    { const unsigned w = *(const GAS unsigned*)(P1 + m * LDP1 + C_Q + 2 * tid); ql[2 * tid] = __uint_as_float(w << 16); ql[2 * tid + 1] = __uint_as_float(w & 0xffff0000u); }
    if (tid < 256) rowsel[tid] = IDXS[qi * 256 + tid];
    __syncthreads();
    const int g = lane >> 4, c = lane & 15;
    float qr[4][4];
#pragma unroll
    for (int a = 0; a < 4; ++a) { const f32x4 t = *(const LAS f32x4*)(ql + (4 * g + a) * 64 + 4 * c); qr[a][0] = t.x; qr[a][1] = t.y; qr[a][2] = t.z; qr[a][3] = t.w; }
#pragma unroll 4
    for (int kk = 0; kk < 32; ++kk) {
        const int key = 32 * wave + kk, idx = rowsel[key];
        f32x4 kv;
        if (idx < PAST) { const int page = ptab[bd * NPAGES + (idx >> 7)]; kv = *(const GAS f32x4*)(ck + ((size_t)page * PAGE + (idx & 127)) * 256 + 4 * lane); }
        else { const v2u w = *(const GAS v2u*)(KVB + (size_t)(MP + bd * DS + (idx - PAST)) * 512 + 4 * lane);
            kv = (f32x4){__uint_as_float(w.x << 16), __uint_as_float(w.x & 0xffff0000u), __uint_as_float(w.y << 16), __uint_as_float(w.y & 0xffff0000u)}; }
        float part[4];
#pragma unroll
        for (int a = 0; a < 4; ++a) { float s = (qr[a][0] * kv.x + qr[a][1] * kv.y) + (qr[a][2] * kv.z + qr[a][3] * kv.w);
            part[a] = row16_sum(s); }
        if (c == 0) {
#pragma unroll
            for (int a = 0; a < 4; ++a) Sl[(4 * g + a) * 256 + key] = part[a] * 0.125f; }
    }
    __syncthreads();
#pragma unroll
    for (int hs = 0; hs < 2; ++hs) { const int head = 2 * wave + hs; float v[4]; float mx = -INFINITY;
#pragma unroll
        for (int j = 0; j < 4; ++j) { v[j] = Sl[head * 256 + lane + 64 * j]; mx = fmaxf(mx, v[j]); }
        mx = wave_max(mx); float sum = 0.f;
#pragma unroll
        for (int j = 0; j < 4; ++j) { v[j] = __expf(v[j] - mx); sum += v[j]; Sl[head * 256 + lane + 64 * j] = v[j]; }
        sum = wave_sum(sum);
        if (lane == 0) linv[head] = 1.0f / sum; }
    __syncthreads();
    float o[4][4];
#pragma unroll
    for (int a = 0; a < 4; ++a)
#pragma unroll
        for (int cc = 0; cc < 4; ++cc) o[a][cc] = 0.f;
#pragma unroll 4
    for (int kk = 0; kk < 32; ++kk) {
        const int key = 32 * wave + kk, idx = rowsel[key];
        f32x4 vv;
        if (idx < PAST) { const int page = ptab[bd * NPAGES + (idx >> 7)]; vv = *(const GAS f32x4*)(cv + ((size_t)page * PAGE + (idx & 127)) * 256 + 4 * lane); }
        else { const v2u w = *(const GAS v2u*)(KVB + (size_t)(MP + bd * DS + (idx - PAST)) * 512 + 256 + 4 * lane);
            vv = (f32x4){__uint_as_float(w.x << 16), __uint_as_float(w.x & 0xffff0000u), __uint_as_float(w.y << 16), __uint_as_float(w.y & 0xffff0000u)}; }
#pragma unroll
        for (int a = 0; a < 4; ++a) { const float p = Sl[(4 * g + a) * 256 + key]; o[a][0] += p * vv.x; o[a][1] += p * vv.y; o[a][2] += p * vv.z; o[a][3] += p * vv.w; }
    }
#pragma unroll
    for (int a = 0; a < 4; ++a) *(LAS f32x4*)(Ol + wave * 1024 + (4 * g + a) * 64 + 4 * c) = (f32x4){o[a][0], o[a][1], o[a][2], o[a][3]};
    __syncthreads();
    { float s0 = 0.f, s1 = 0.f;
#pragma unroll
      for (int w = 0; w < 8; ++w) { s0 += Ol[w * 1024 + 2 * tid]; s1 += Ol[w * 1024 + 2 * tid + 1]; }
      const float li = linv[(2 * tid) >> 6];
      *(GAS unsigned*)(YA + m * D + 2 * tid) = pk2(s0 * li, s1 * li); }
    __syncthreads();
}

constexpr int TAIL_R0 = 16384, TAIL_NRT = (MR - TAIL_R0) / 64;
static_assert(TAIL_R0 + 64 * TAIL_NRT == MR, "tail rows");
template <int MODE>
__device__ __forceinline__ void tail_gemm(LAS unsigned char* lds, const GAS bf16* A, int K, const GAS bf16* Bt, int N, const GAS bf16* P1, GAS bf16* T1, GAS bf16* MG, GAS float* H, GAS bf16* A2, int bx, int G, int tid) {
    constexpr int KB = 256, RS = (KB + 8) * 2;
    const int lane = tid & 63, wave = __builtin_amdgcn_readfirstlane(tid >> 6), col = lane & 31, hh = lane >> 5;
    const int nunits = TAIL_NRT * (N / 64), lr = tid >> 3, lc = tid & 7, ti = wave & 3, kh = wave >> 2;
    LAS unsigned char* As = lds; LAS unsigned char* Bs = lds + 64 * RS; LAS float* red = (LAS float*)(lds + 2 * 64 * RS);
    for (int u = bx; u < nunits; u += G) {
        const int rt = u % TAIL_NRT, ct = u / TAIL_NRT;
        const GAS bf16* ap = A + (size_t)(TAIL_R0 + 64 * rt + lr) * K + 8 * lc;
        const GAS bf16* bp = Bt + (size_t)(64 * ct + lr) * K + 8 * lc;
        v4u ra[4], rb[4];
#pragma unroll
        for (int j = 0; j < 4; ++j) { ra[j] = *(const GAS v4u*)(ap + 64 * j); rb[j] = *(const GAS v4u*)(bp + 64 * j); }
        f32x16 acc = {};
        for (int k0 = 0; k0 < K; k0 += KB) {
            __syncthreads();
#pragma unroll
            for (int j = 0; j < 4; ++j) { *(LAS v4u*)(As + lr * RS + (lc * 8 + 64 * j) * 2) = ra[j]; *(LAS v4u*)(Bs + lr * RS + (lc * 8 + 64 * j) * 2) = rb[j]; }
            if (k0 + KB < K) {
#pragma unroll
                for (int j = 0; j < 4; ++j) { ra[j] = *(const GAS v4u*)(ap + k0 + KB + 64 * j); rb[j] = *(const GAS v4u*)(bp + k0 + KB + 64 * j); } }
            __syncthreads();
#pragma unroll
            for (int j = 0; j < 8; ++j) { const int ks = 8 * kh + j;
                const bf16x8 av = *(const LAS bf16x8*)(As + (32 * (ti >> 1) + col) * RS + (16 * ks + 8 * hh) * 2), bv = *(const LAS bf16x8*)(Bs + (32 * (ti & 1) + col) * RS + (16 * ks + 8 * hh) * 2);
                acc = __builtin_amdgcn_mfma_f32_32x32x16_bf16(av, bv, acc, 0, 0, 0); }
        }
        __syncthreads();
        if (kh == 1) {
#pragma unroll
            for (int r = 0; r < 16; ++r) red[(ti * 16 + r) * 64 + lane] = acc[r]; }
        __syncthreads();
        if (kh == 0) {
            const int c = 64 * ct + 32 * (ti & 1) + col;
#pragma unroll
            for (int r = 0; r < 16; ++r) { const size_t row = TAIL_R0 + 64 * rt + 32 * (ti >> 1) + (r & 3) + 8 * (r >> 2) + 4 * hh; const float v = acc[r] + red[(ti * 16 + r) * 64 + lane];
                if (MODE == 1) { const float g = __uint_as_float((unsigned)P1[row * LDP1 + C_GS + c] << 16); T1[row * D + c] = (bf16)f2bf(v * sigm(g)); }
                if (MODE == 2) { const float g = __uint_as_float((unsigned)P1[row * LDP1 + C_GA + c] << 16); MG[row * D + c] = (bf16)f2bf(__uint_as_float((unsigned)T1[row * D + c] << 16) + v * sigm(g)); }
                if (MODE == 3) H[row * D + c] += v;
                if (MODE == 4) { const float w = fmaxf(v, 0.f); A2[row * DFF + c] = (bf16)f2bf(w * w); } }
        }
    }
    __syncthreads();
}

#ifndef REP_SEL
#define REP_SEL 1
#endif
#ifndef REP_CONV
#define REP_CONV 1
#endif
#ifndef REP_TOPK
#define REP_TOPK 1
#endif
#ifndef REP_SSC
#define REP_SSC 1
#endif
#ifndef REP_SSEL
#define REP_SSEL 1
#endif
#ifndef REP_SSD1
#define REP_SSD1 1
#endif
#ifndef REP_SREC
#define REP_SREC 1
#endif
#ifndef REP_SCAN
#define REP_SCAN 1
#endif
#ifndef REP_ATTS
#define REP_ATTS 1
#endif
#ifndef REP_ATTP
#define REP_ATTP 1
#endif
#ifndef REP_SSD3
#define REP_SSD3 1
#endif
__device__ __noinline__ void xcd_barrier_ni(unsigned* bar, unsigned x, volatile LAS unsigned* st, int tid, unsigned G) { XcdBarrier b; b.bar = bar; b.x = x; b.st = st; xcd_barrier(b, tid, G); }
__device__ __forceinline__ void assume_global(const void* p) {
#if defined(__HIP_DEVICE_COMPILE__)
    __builtin_assume(!__builtin_amdgcn_is_shared((const __attribute__((address_space(0))) void*)p));
    __builtin_assume(!__builtin_amdgcn_is_private((const __attribute__((address_space(0))) void*)p));
#else
    (void)p;
#endif
}
constexpr int NPH = 12, NPHASES = 1 + 2 * NPH;
struct Args { const void* in[24]; float* out; unsigned char* ws; int l_lo, l_hi; };
static_assert(sizeof(Args) == 24 * 8 + 8 + 8 + 8, "Args has no padding");

template <int KLO, int KHI>
__global__ void __launch_bounds__(NT, 2) fwd_t(Args args) {
    extern __shared__ __attribute__((aligned(16))) unsigned char lds_raw[];
    LAS unsigned char* lds0 = (LAS unsigned char*)lds_raw;
    volatile LAS unsigned* MISCW = (volatile LAS unsigned*)(lds0 + MISC_OFF);
    const int G = gridDim.x, bx = blockIdx.x, NGW = G * NWAVES;
    { const int tid0 = threadIdx.x;
      for (int u = tid0; u < (LDS_BYTES - LDSCTL_OFF) / 4; u += NT) ((LAS unsigned*)(lds0 + LDSCTL_OFF))[u] = 0u; }
    __syncthreads();
    XcdBarrier bar = xcd_barrier_post((unsigned*)(args.ws + WS_CTL) + CW_BAR, MISCW + 8);
#define IN(k) (KLO <= (k) && (k) < KHI)
#define SEAM(k) do { if (IN(k) && IN((k) + 1)) xcd_barrier_ni(bar.bar, bar.x, bar.st, (int)threadIdx.x, (unsigned)G); } while (0)
#define PHASE_REGS \
    int tid = threadIdx.x; asm volatile("" : "+v"(tid)); \
    int bxl = bx, Gl = G; asm volatile("" : "+s"(bxl), "+s"(Gl)); (void)bxl; (void)Gl;     \
    const int lane = tid & 63, wave = __builtin_amdgcn_readfirstlane(tid >> 6), gw = bx * NWAVES + wave; \
    unsigned char* ws_ = args.ws; asm volatile("" : "+s"(ws_)); GAS unsigned char* ws = (GAS unsigned char*)ws_;     \
    float* out_ = args.out; asm volatile("" : "+s"(out_)); GAS float* out = (GAS float*)out_; \
    (void)lane; (void)gw; (void)out; \
    GAS float* H = (GAS float*)(ws + WS_H); GAS bf16* U = (GAS bf16*)(ws + WS_U); GAS bf16* P1 = (GAS bf16*)(ws + WS_P1); GAS float* MISCB = (GAS float*)(ws + WS_MISC); GAS bf16* KIB = (GAS bf16*)(ws + WS_KIB); \
    GAS bf16* XC = (GAS bf16*)(ws + WS_XC); GAS float* DT = (GAS float*)(ws + WS_DT); GAS float* DA = (GAS float*)(ws + WS_DA); GAS float* YS = (GAS float*)(ws + WS_YS); GAS bf16* YSN = (GAS bf16*)(ws + WS_YSN); \
    GAS bf16* YA = (GAS bf16*)(ws + WS_YA); GAS bf16* T1 = (GAS bf16*)(ws + WS_T1); GAS bf16* MG = (GAS bf16*)(ws + WS_MG); GAS bf16* A2 = (GAS bf16*)(ws + WS_A2); \
    GAS unsigned short* IDXP = (GAS unsigned short*)(ws + WS_IDXP); GAS int* IDXS = (GAS int*)(ws + WS_IDXS); GAS float* SCS = (GAS float*)(ws + WS_SCS); \
    GAS bf16* SB = (GAS bf16*)(ws + WS_SB); GAS float* DEC = (GAS float*)(ws + WS_DEC); GAS bf16* HC = (GAS bf16*)(ws + WS_HC); GAS bf16* KVB = (GAS bf16*)(ws + WS_KVB); (void)SB; (void)DEC; (void)HC; (void)KVB; \
    GAS unsigned char* wl = ws + WS_W + (size_t)l * WL_SIZE; \
    (void)H; (void)U; (void)P1; (void)MISCB; (void)KIB; (void)XC; (void)DT; (void)DA; (void)YS; (void)YSN; (void)YA; (void)T1; (void)MG; (void)A2; (void)IDXP; (void)IDXS; (void)SCS; (void)wl;
#define LDS_LOCAL LAS unsigned char* lds = lds0; asm volatile("" : "+s"(lds));
#define INP(T, name, i) const GAS T* name; { const void* p_; asm volatile("s_load_dwordx2 %0, %1, %2\n\ts_waitcnt lgkmcnt(0)" : "=s"(p_) : "s"(__builtin_amdgcn_kernarg_segment_ptr()), "i"((i) * 8)); name = (const GAS T*)p_; }

    if (IN(0) && args.l_lo == 0) {
        const int l = 0; PHASE_REGS
        LDS_LOCAL
        INP(float, w_in, 10) INP(float, w_ssm, 17) INP(float, w_att, 18) INP(float, w_out, 19) INP(float, w_up, 21) INP(float, w_down, 22) INP(float, meta, 8) INP(float, x_prompt, 0) INP(float, x_sample, 1) INP(float, norm1_w, 9)
        LAS float* scr = (LAS float*)(lds + wave * 17408);
        constexpr int I_IN = (D / 64) * (NIN / 64), I_SSM = (DIN / 64) * (D / 64), I_ATT = (D / 64) * (D / 64), I_OUT = I_ATT, I_UP = (D / 64) * (DFF / 64), I_DN = (DFF / 64) * (D / 64);
        constexpr int I_L = I_IN + I_SSM + I_ATT + I_OUT + I_UP + I_DN;
        for (int it = gw; it < 2 * I_L; it += NGW) {
            const int l = it / I_L; int r = it % I_L; GAS unsigned char* wl = ws + WS_W + (size_t)l * WL_SIZE;
            if (r < I_IN) { tr_item(w_in + (size_t)l * D * IN_DIM, D, IN_DIM, (GAS bf16*)(wl + WL_WIN), NIN / 64, true, scr, r, lane); continue; } r -= I_IN;
            if (r < I_SSM) { tr_item(w_ssm + (size_t)l * DIN * D, DIN, D, (GAS bf16*)(wl + WL_WSSM), D / 64, false, scr, r, lane); continue; } r -= I_SSM;
            if (r < I_ATT) { tr_item(w_att + (size_t)l * D * D, D, D, (GAS bf16*)(wl + WL_WATT), D / 64, false, scr, r, lane); continue; } r -= I_ATT;
            if (r < I_OUT) { tr_item(w_out + (size_t)l * D * D, D, D, (GAS bf16*)(wl + WL_WOUT), D / 64, false, scr, r, lane); continue; } r -= I_OUT;
            if (r < I_UP) { tr_item(w_up + (size_t)l * D * DFF, D, DFF, (GAS bf16*)(wl + WL_WUP), DFF / 64, false, scr, r, lane); continue; } r -= I_UP;
            tr_item(w_down + (size_t)l * DFF * D, DFF, D, (GAS bf16*)(wl + WL_WDN), D / 64, false, scr, r, lane);
        }
        for (int m = gw; m < MPAD; m += NGW) {
            const GAS float* src = nullptr;
            if (m < MP) { const int b = m / LP, t = m - b * LP; src = t < NMETA ? meta + (size_t)t * D : x_prompt + ((size_t)b * SEQ + (t - NMETA)) * D; }
            else if (m < MR) src = x_sample + (size_t)(m - MP) * D;
            rms_row(src, norm1_w, H + (size_t)m * D, U + (size_t)m * D, nullptr, lane);
        }
    }
    SEAM(0);

    for (int l = args.l_lo; l < args.l_hi; ++l) {
        constexpr int pb = 1;

        if (IN(pb + 0)) {
            PHASE_REGS
            LAS unsigned char* lds = lds0;
            pg8::Gemm gm{U, (const GAS bf16*)(wl + WL_WIN), MPAD, NIN, D}; pg8::StaticOrder S; S.init(MPAD, NIN, Gl, bxl);
            pg8::EpiIn E{P1, KVB, MISCB, KIB, out + O_PK + (size_t)l * MP * 256, out + O_PV + (size_t)l * MP * 256, out + O_PKI + (size_t)l * MP * 64,
                         out + O_SK + (size_t)l * MS * 256, out + O_SV + (size_t)l * MS * 256, out + O_SKI + (size_t)l * MS * 64};
            pg8::gemm_phase<pg8::EpiIn, pg8::StaticOrder, true, true>(lds, gm, S, E, tid);
        }
        SEAM(pb + 0);

        if (IN(pb + 1)) {
            PHASE_REGS
            LDS_LOCAL
            INP(float, state_conv, 6) INP(float, conv_b, 12) INP(float, conv_w, 11) INP(float, dt_bias, 13) INP(float, a_log, 14) INP(float, cache_ki, 4) INP(int, page_table, 7)
            for (int rp_ = 0; rp_ < REP_CONV; ++rp_) for (int it = bx * NT + tid; it < (MR / 8) * 384; it += G * NT) {
                const int rg = it / 384, c8 = (it % 384) * 8, m0 = 8 * rg;
                const bool isS = m0 >= MP; int tpos, sq;
                if (!isS) { sq = m0 / LP; tpos = m0 - sq * LP; } else { sq = (m0 - MP) >> 3; tpos = (m0 - MP) & 7; }
                float xv[11][8];
#pragma unroll
                for (int k = 0; k < 11; ++k) { const int dtp = tpos - 3 + k;
                    if (dtp >= 0) unpack8(*(const GAS v4u*)(P1 + (size_t)(m0 - 3 + k) * LDP1 + C_XBC + c8), xv[k]);
                    else if (isS) { const GAS float* pp = state_conv + ((size_t)(l * DB + sq) * 3 + (3 + dtp)) * CONVD + c8; const f32x4 a = *(const GAS f32x4*)pp, b = *(const GAS f32x4*)(pp + 4);
                        xv[k][0] = a.x; xv[k][1] = a.y; xv[k][2] = a.z; xv[k][3] = a.w; xv[k][4] = b.x; xv[k][5] = b.y; xv[k][6] = b.z; xv[k][7] = b.w; }
                    else {
#pragma unroll
                        for (int j = 0; j < 8; ++j) xv[k][j] = 0.f; } }
                float wv[4][8], bv[8];
                { const GAS float* bp = conv_b + (size_t)l * CONVD + c8; const f32x4 a = *(const GAS f32x4*)bp, b = *(const GAS f32x4*)(bp + 4);
                  bv[0] = a.x; bv[1] = a.y; bv[2] = a.z; bv[3] = a.w; bv[4] = b.x; bv[5] = b.y; bv[6] = b.z; bv[7] = b.w; }
#pragma unroll
                for (int k = 0; k < 4; ++k) { const GAS float* wp = conv_w + ((size_t)l * 4 + k) * CONVD + c8; const f32x4 a = *(const GAS f32x4*)wp, b = *(const GAS f32x4*)(wp + 4);
                    wv[k][0] = a.x; wv[k][1] = a.y; wv[k][2] = a.z; wv[k][3] = a.w; wv[k][4] = b.x; wv[k][5] = b.y; wv[k][6] = b.z; wv[k][7] = b.w; }
#pragma unroll
                for (int r = 0; r < 8; ++r) {
                    float y[8];
#pragma unroll
                    for (int j = 0; j < 8; ++j) { float s = bv[j];
#pragma unroll
                        for (int k = 0; k < 4; ++k) s += xv[r + k][j] * wv[k][j];
                        y[j] = s * sigm(s); }
                    *(GAS v4u*)(XC + (size_t)(m0 + r) * CONVD + c8) = (v4u){pk2(y[0], y[1]), pk2(y[2], y[3]), pk2(y[4], y[5]), pk2(y[6], y[7])};
                    const int tp = tpos + r; GAS float* cs = nullptr;
                    if (!isS && tp >= LP - 3) cs = out + O_PCONV + ((size_t)(l * NB + sq) * 3 + (tp - (LP - 3))) * CONVD + c8;
                    if (isS && tp >= DS - 3) cs = out + O_SCONV + ((size_t)(l * DB + sq) * 3 + (tp - (DS - 3))) * CONVD + c8;
                    if (cs) { *(GAS f32x4*)cs = (f32x4){xv[r + 3][0], xv[r + 3][1], xv[r + 3][2], xv[r + 3][3]}; *(GAS f32x4*)(cs + 4) = (f32x4){xv[r + 3][4], xv[r + 3][5], xv[r + 3][6], xv[r + 3][7]}; }
                }
            }
            for (int it = bx * NT + tid; it < MR * NH; it += G * NT) {
                const int m = it >> 5, h = it & 31;
                const float raw = MISCB[(size_t)m * 128 + MC_DT + h] + dt_bias[l * NH + h];
                const float sp = fmaxf(raw, 0.f) + log1pf(__expf(-fabsf(raw)));
                const float A = -__expf(a_log[l * NH + h]);
                DT[it] = sp; DA[it] = __expf(sp * A);
            }
            for (int rp_ = 0; rp_ < REP_TOPK; ++rp_) {
                constexpr int SLD = 4352;
                LAS unsigned* scl = (LAS unsigned*)lds;
                for (int j = 0; ; ++j) {
                    const int unit = j * G + ((j & 1) ? (G - 1 - bx) : bx); if (unit >= NB * (LP / 8)) break;
                    const int b = unit & (NB - 1), qb = (LP / 8 - 1) - (unit >> 2);
                    const size_t mq0 = (size_t)b * LP + 8 * qb; const int nkeys = 8 * qb + 8, ntl = (nkeys + 31) >> 5;
                    bf16x8 afr[2][4]; float wq[2][2][8];
                    idx_load_q(P1, MISCB, mq0, lane, afr, wq);
                    const int kcol = lane & 31, hh = lane >> 5;
                    const GAS bf16* kp0 = KIB + ((size_t)b * LP + kcol) * 64 + 8 * hh;
                    bf16x8 bnx[4], bn2[4];
#pragma unroll
                    for (int ks = 0; ks < 4; ++ks) { bnx[ks] = (bf16x8){0, 0, 0, 0, 0, 0, 0, 0}; bn2[ks] = bnx[ks]; }
                    if (wave < ntl) {
#pragma unroll
                        for (int ks = 0; ks < 4; ++ks) bnx[ks] = *(const GAS bf16x8*)(kp0 + (size_t)wave * 32 * 64 + 16 * ks); }
                    if (wave + NWAVES < ntl) {
#pragma unroll
                        for (int ks = 0; ks < 4; ++ks) bn2[ks] = *(const GAS bf16x8*)(kp0 + (size_t)(wave + NWAVES) * 32 * 64 + 16 * ks); }
                    for (int kt = wave; kt < ntl; kt += NWAVES) {
                        bf16x8 bfr[4];
#pragma unroll
                        for (int ks = 0; ks < 4; ++ks) { bfr[ks] = bnx[ks]; bnx[ks] = bn2[ks]; }
                        if (kt + 2 * NWAVES < ntl) {
#pragma unroll
                            for (int ks = 0; ks < 4; ++ks) bn2[ks] = *(const GAS bf16x8*)(kp0 + (size_t)(kt + 2 * NWAVES) * 32 * 64 + 16 * ks); }
                        float sc[2][2];
                        idx_scores(afr, bfr, wq, sc);
                        const int key = 32 * kt + kcol;
#pragma unroll
                        for (int rt = 0; rt < 2; ++rt)
#pragma unroll
                            for (int jq = 0; jq < 2; ++jq) scl[(4 * rt + 2 * hh + jq) * SLD + key] = f2key(sc[rt][jq]);
                    }
                    __syncthreads();
                    for (int r2_ = 0; r2_ < REP_SEL; ++r2_) { const int t = 8 * qb + wave, n = t + 1; GAS unsigned short* op = IDXP + ((size_t)b * LP + t) * 256;
                      if (n <= 256) { for (int i = lane; i < n; i += 64) op[i] = (unsigned short)i; }
                      else topk_select(scl + wave * SLD, n, lane, op); }
                    __syncthreads();
                }
            }
            const GAS float* cki = cache_ki + (size_t)l * NPOOL * PAGE * 64;
            for (int rp_ = 0; rp_ < REP_SSC; ++rp_) for (int unit = bx; unit < DB * 8; unit += G) {
                const int bd = unit >> 3, ch = unit & 7; const size_t mq0 = (size_t)MP + bd * DS;
                bf16x8 afr[2][4]; float wq[2][2][8];
                idx_load_q(P1, MISCB, mq0, lane, afr, wq);
                const int kcol = lane & 31, hh = lane >> 5;
                const int pg = 8 * ch + wave, phys = page_table[bd * NPAGES + pg];
                const GAS float* kbase = cki + (size_t)phys * PAGE * 64;
#pragma unroll 1
                for (int kt = 0; kt < 4; ++kt) {
                    const int kin = 32 * kt + kcol; const GAS float* kp = kbase + (size_t)kin * 64 + 8 * hh;
                    bf16x8 bfr[4];
#pragma unroll
                    for (int ks = 0; ks < 4; ++ks) { const f32x4 a = *(const GAS f32x4*)(kp + 16 * ks), bq = *(const GAS f32x4*)(kp + 16 * ks + 4);
                        const v4u w = (v4u){pk2(a.x, a.y), pk2(a.z, a.w), pk2(bq.x, bq.y), pk2(bq.z, bq.w)}; bfr[ks] = __builtin_bit_cast(bf16x8, w); }
                    float sc[2][2];
                    idx_scores(afr, bfr, wq, sc);
#pragma unroll
                    for (int rt = 0; rt < 2; ++rt)
#pragma unroll
                        for (int jq = 0; jq < 2; ++jq) SCS[(size_t)(bd * DS + 4 * rt + 2 * hh + jq) * SCS_LD + 128 * pg + kin] = sc[rt][jq];
                }
                if (ch == 7 && wave == 0) {
                    const int j = kcol < DS ? kcol : DS - 1; const GAS bf16* kp = KIB + (mq0 + j) * 64 + 8 * hh;
                    bf16x8 bfr[4];
#pragma unroll
                    for (int ks = 0; ks < 4; ++ks) bfr[ks] = *(const GAS bf16x8*)(kp + 16 * ks);
                    float sc[2][2];
                    idx_scores(afr, bfr, wq, sc);
                    if (kcol < DS) {
#pragma unroll
                        for (int rt = 0; rt < 2; ++rt)
#pragma unroll
                            for (int jq = 0; jq < 2; ++jq) { const int q = 4 * rt + 2 * hh + jq; SCS[(size_t)(bd * DS + q) * SCS_LD + PAST + kcol] = (kcol <= q) ? sc[rt][jq] : -INFINITY; }
                    }
                }
            }
        }
        SEAM(pb + 1);

        if (IN(pb + 2)) {
            PHASE_REGS
            LDS_LOCAL
            INP(float, a_log, 14) INP(float, state_ssm, 5) INP(float, d_skip, 15)
            for (int rp_ = 0; rp_ < REP_SSEL; ++rp_) for (int qi = bx; qi < MS; qi += G) {
                LAS unsigned* scl = (LAS unsigned*)lds;
                for (int i = tid; i < PAST + DS; i += NT) scl[i] = f2key(SCS[(size_t)qi * SCS_LD + i]);
                __syncthreads();
                if (wave == 0) { int ns = PAST + DS; asm volatile("" : "+s"(ns)); topk_select(scl, ns, lane, IDXS + qi * 256); }
                __syncthreads();
            }
            for (int rp_ = 0; rp_ < REP_SSD1; ++rp_) for (int unit = bx; unit < NB * NCH * NG; unit += G) {
                int b, c, g; if (unit < NB * 32 * NG) { b = unit >> 7; c = 1 + ((unit & 127) >> 2); g = unit & 3; } else { const int r = unit - NB * 32 * NG; b = r >> 2; c = 0; g = r & 3; }
                ssd1_unit(lds, tid, XC, DT, a_log + l * NH, SB, DEC, b, c, g);
            }
            for (int rp_ = 0; rp_ < REP_SREC; ++rp_) for (int unit = bx; unit < DB * NH * 2; unit += G) {
                const int bd = unit >> 6, h = (unit >> 1) & 31, p0 = (unit & 1) * 32;
                ssd_unit(lds, tid, XC, DT, DA, (size_t)MP + bd * DS, DS, h, p0, state_ssm + ((size_t)(l * DB + bd) * NH + h) * HP * NST,
                         out + O_SSSM + ((size_t)(l * DB + bd) * NH + h) * HP * NST, YS, d_skip[l * NH + h]);
                __syncthreads();
            }
        }
        SEAM(pb + 2);

        if (IN(pb + 3)) {
            PHASE_REGS
            LDS_LOCAL
            INP(float, cache_k, 2) INP(float, cache_v, 3) INP(int, page_table, 7)
            for (int rp_ = 0; rp_ < REP_SCAN; ++rp_) for (int e = bx * NT + tid; e < NB * NH * 2048; e += G * NT) {
                const int b = e / (NH * 2048), h = (e >> 11) & 31, q = e & 2047;
                f32x4 Hr = {0.f, 0.f, 0.f, 0.f};
#pragma unroll 3
                for (int c = 0; c < NCH; ++c) { const size_t idx = (size_t)(b * NCH + c) * NH + h;
                    *(GAS v2u*)(HC + idx * (HP * NST) + q * 4) = (v2u){pk2(Hr.x, Hr.y), pk2(Hr.z, Hr.w)};
                    const float d = DEC[idx]; const v2u sw = *(const GAS v2u*)(SB + idx * (HP * NST) + q * 4);
                    const f32x4 sv = (f32x4){__uint_as_float(sw.x << 16), __uint_as_float(sw.x & 0xffff0000u), __uint_as_float(sw.y << 16), __uint_as_float(sw.y & 0xffff0000u)};
                    Hr = Hr * d + sv; }
                *(GAS f32x4*)(out + O_PSSM + ((size_t)(l * NB + b) * NH + h) * (HP * NST) + q * 4) = Hr;
            }
            const GAS float* ck = cache_k + (size_t)l * NPOOL * PAGE * 256; const GAS float* cv = cache_v + (size_t)l * NPOOL * PAGE * 256;
            for (int rp_ = 0; rp_ < REP_ATTS; ++rp_) for (int qi = bx; qi < MS; qi += G) attn_sample_query(lds, tid, P1, KVB, ck, cv, page_table, IDXS, YA, qi);
        }
        SEAM(pb + 3);

        if (IN(pb + 4)) {
            PHASE_REGS
            LDS_LOCAL
            INP(float, a_log, 14) INP(float, d_skip, 15) INP(float, ssm_norm_w, 16)
            const bool att_first = ((bxl >> 3) & 1) == 0;
            for (int stage_ = 0; stage_ < 2; ++stage_) {
            if ((stage_ == 0) == att_first) {
            for (int rp_ = 0; rp_ < REP_ATTP; ++rp_) {
                    if (Gl == 256) {
                        const int bsel = (bxl & 7) >> 1, widx = ((((bxl >> 3) * NWAVES) + wave) << 1) | (bxl & 1);
                        for (int tr = widx; tr < LP; tr += 512) attn_prompt_query(lds + wave * 17408, P1, KVB, IDXP, YA, bsel * LP + (LP - 1 - tr), lane);
                    } else for (int m = gw; m < MP; m += NGW) attn_prompt_query(lds + wave * 17408, P1, KVB, IDXP, YA, m, lane);
                }
                __syncthreads();
            } else {
            for (int rp_ = 0; rp_ < REP_SSD3; ++rp_) for (int unit = bx; unit < NB * NCH * NG; unit += G) {
                int b, c, g; if (unit < NB * 32 * NG) { b = unit >> 7; c = 1 + ((unit & 127) >> 2); g = unit & 3; } else { const int r = unit - NB * 32 * NG; b = r >> 2; c = 0; g = r & 3; }
                ssd3_unit(lds, tid, XC, P1, DT, a_log + l * NH, d_skip + l * NH, ssm_norm_w + (size_t)l * DIN, HC, YSN, b, c, g);
            }
            for (int it = gw; it < MS * NG; it += NGW) {
                const int m = MP + (it >> 2), g = it & 3, c0 = g * 512 + lane * 8;
                const GAS float* yp = YS + (size_t)m * DIN + c0; const f32x4 a = *(const GAS f32x4*)yp, b = *(const GAS f32x4*)(yp + 4);
                float z[8]; unpack8(*(const GAS v4u*)(P1 + (size_t)m * LDP1 + C_Z + c0), z);
                float v[8] = {a.x, a.y, a.z, a.w, b.x, b.y, b.z, b.w}; float ss = 0.f;
#pragma unroll
                for (int j = 0; j < 8; ++j) { v[j] = v[j] * (z[j] * sigm(z[j])); ss += v[j] * v[j]; }
                ss = wave_sum(ss);
                const float rstd = 1.0f / sqrtf(ss * (1.0f / 512.0f) + 1e-6f);
                const GAS float* wp = ssm_norm_w + (size_t)l * DIN + c0; const f32x4 wa = *(const GAS f32x4*)wp, wb = *(const GAS f32x4*)(wp + 4);
                *(GAS v4u*)(YSN + (size_t)m * DIN + c0) = (v4u){pk2(v[0] * rstd * wa.x, v[1] * rstd * wa.y), pk2(v[2] * rstd * wa.z, v[3] * rstd * wa.w), pk2(v[4] * rstd * wb.x, v[5] * rstd * wb.y), pk2(v[6] * rstd * wb.z, v[7] * rstd * wb.w)};
            }
            } }
        }
        SEAM(pb + 4);

        if (IN(pb + 5)) {
            PHASE_REGS
            LAS unsigned char* lds = lds0;
            pg8::Gemm gm{YSN, (const GAS bf16*)(wl + WL_WSSM), TAIL_R0, D, DIN}; pg8::StaticOrder S; S.init(TAIL_R0, D, Gl, bxl);
            pg8::EpiGate1 E{P1, T1};
            pg8::gemm_phase<pg8::EpiGate1, pg8::StaticOrder, true, true>(lds, gm, S, E, tid);
            tail_gemm<1>(lds, YSN, DIN, (const GAS bf16*)(wl + WL_WSSM), D, P1, T1, MG, H, A2, bxl, Gl, tid);
        }
        if (IN(pb + 6)) {
            PHASE_REGS
            LAS unsigned char* lds = lds0;
            pg8::Gemm gm{YA, (const GAS bf16*)(wl + WL_WATT), TAIL_R0, D, D}; pg8::StaticOrder S; S.init(TAIL_R0, D, Gl, bxl);
            pg8::EpiGate2 E{P1, T1, MG};
            pg8::gemm_phase<pg8::EpiGate2, pg8::StaticOrder, true, true>(lds, gm, S, E, tid);
            tail_gemm<2>(lds, YA, D, (const GAS bf16*)(wl + WL_WATT), D, P1, T1, MG, H, A2, bxl, Gl, tid);
        }
        SEAM(pb + 6);
        if (IN(pb + 7)) {
            PHASE_REGS
            LAS unsigned char* lds = lds0;
            pg8::Gemm gm{MG, (const GAS bf16*)(wl + WL_WOUT), TAIL_R0, D, D}; pg8::StaticOrder S; S.init(TAIL_R0, D, Gl, bxl);
            pg8::EpiResid E{H};
            pg8::gemm_phase<pg8::EpiResid, pg8::StaticOrder, true, true>(lds, gm, S, E, tid);
            tail_gemm<3>(lds, MG, D, (const GAS bf16*)(wl + WL_WOUT), D, P1, T1, MG, H, A2, bxl, Gl, tid);
        }
        SEAM(pb + 7);
        if (IN(pb + 8)) {
            PHASE_REGS
            INP(float, norm2_w, 20)
            for (int m = gw; m < MPAD; m += NGW) rms_row(H + (size_t)m * D, norm2_w + (size_t)l * D, nullptr, U + (size_t)m * D, nullptr, lane);
        }
        SEAM(pb + 8);
        if (IN(pb + 9)) {
            PHASE_REGS
            LAS unsigned char* lds = lds0;
            pg8::Gemm gm{U, (const GAS bf16*)(wl + WL_WUP), TAIL_R0, DFF, D}; pg8::StaticOrder S; S.init(TAIL_R0, DFF, Gl, bxl);
            pg8::EpiUp E{A2};
            pg8::gemm_phase<pg8::EpiUp, pg8::StaticOrder, true, true>(lds, gm, S, E, tid);
            tail_gemm<4>(lds, U, D, (const GAS bf16*)(wl + WL_WUP), DFF, P1, T1, MG, H, A2, bxl, Gl, tid);
        }
        SEAM(pb + 9);
        if (IN(pb + 10)) {
            PHASE_REGS
            LAS unsigned char* lds = lds0;
            pg8::Gemm gm{A2, (const GAS bf16*)(wl + WL_WDN), TAIL_R0, D, DFF}; pg8::StaticOrder S; S.init(TAIL_R0, D, Gl, bxl);
            pg8::EpiResid E{H};
            pg8::gemm_phase<pg8::EpiResid, pg8::StaticOrder, true, true>(lds, gm, S, E, tid);
            tail_gemm<3>(lds, A2, DFF, (const GAS bf16*)(wl + WL_WDN), D, P1, T1, MG, H, A2, bxl, Gl, tid);
        }
        SEAM(pb + 10);
        if (IN(pb + 11)) {
            PHASE_REGS
            INP(float, norm1_w, 9) INP(float, final_w, 23)
            if (l == 0) { for (int m = gw; m < MPAD; m += NGW) rms_row(H + (size_t)m * D, norm1_w + D, nullptr, U + (size_t)m * D, nullptr, lane); }
            else {
                for (int m = gw; m < MR; m += NGW) {
                    GAS float* dst = nullptr;
                    if (m < MP) { const int b = m / LP, t = m - b * LP; if (t >= NMETA) dst = out + O_YP + ((size_t)b * SEQ + (t - NMETA)) * D; }
                    else dst = out + O_YS + (size_t)(m - MP) * D;
                    if (dst) rms_row(H + (size_t)m * D, final_w, nullptr, nullptr, dst, lane);
                }
            }
        }
        if (IN(pb + 11) && IN(1) && l + 1 < args.l_hi) xcd_barrier_ni(bar.bar, bar.x, bar.st, (int)threadIdx.x, (unsigned)G);
    }
#undef IN
#undef SEAM
}

#ifndef MK_PER_PHASE
#define MK_PER_PHASE 0
#endif
extern "C" void kernel_launch(void* const* d_in, const int* in_sizes, int n_in, void* d_out, int out_size, void* d_ws, size_t ws_size, hipStream_t stream) {
    static int grid = 0;
    if (grid == 0) {
        if (n_in != 24 || (size_t)out_size != O_END || ws_size < WS_END) { fprintf(stderr, "kernel_launch: unexpected shapes: n_in %d out %d (want %zu) ws %zu (want %zu)\n", n_in, out_size, (size_t)O_END, ws_size, (size_t)WS_END); grid = -1; return; }
        int dev = 0, cus = 0, per_cu = 0;
        if (hipGetDevice(&dev) != hipSuccess || hipDeviceGetAttribute(&cus, hipDeviceAttributeMultiprocessorCount, dev) != hipSuccess) { grid = -1; return; }
        bool ok = true;
#if MK_PER_PHASE
#define SETA(K) ok = ok && hipFuncSetAttribute((const void*)fwd_t<K, K + 1>, hipFuncAttributeMaxDynamicSharedMemorySize, LDS_BYTES) == hipSuccess
        SETA(0); SETA(1); SETA(2); SETA(3); SETA(4); SETA(5); SETA(6); SETA(7); SETA(8); SETA(9); SETA(10); SETA(11); SETA(12);
#else
        ok = hipFuncSetAttribute((const void*)fwd_t<0, NPH + 1>, hipFuncAttributeMaxDynamicSharedMemorySize, LDS_BYTES) == hipSuccess;
        ok = ok && hipOccupancyMaxActiveBlocksPerMultiprocessor(&per_cu, (const void*)fwd_t<0, NPH + 1>, NT, LDS_BYTES) == hipSuccess && per_cu >= 1;
#endif
        if (!ok) { fprintf(stderr, "kernel_launch: hipFuncSetAttribute / occupancy query failed (per_cu %d)\n", per_cu); (void)hipGetLastError(); grid = -1; return; }
        grid = cus;
    }
    if (grid < 0) return;
    (void)hipMemsetAsync((char*)d_ws + WS_CTL, 0, CTL_ZERO_BYTES, stream);
    Args a{};
    for (int i = 0; i < 24; ++i) a.in[i] = d_in[i];
    a.out = (float*)d_out; a.ws = (unsigned char*)d_ws;
#if MK_PER_PHASE
#define LAUNCH_PH(K) hipLaunchKernelGGL((fwd_t<K, K + 1>), dim3(grid), dim3(NT), LDS_BYTES, stream, a)
    a.l_lo = 0; a.l_hi = 1; LAUNCH_PH(0);
    for (int l = 0; l < 2; ++l) { a.l_lo = l; a.l_hi = l + 1;
        LAUNCH_PH(1); LAUNCH_PH(2); LAUNCH_PH(3); LAUNCH_PH(4); LAUNCH_PH(5); LAUNCH_PH(6); LAUNCH_PH(7); LAUNCH_PH(8); LAUNCH_PH(9); LAUNCH_PH(10); LAUNCH_PH(11); LAUNCH_PH(12); }
#else
    a.l_lo = 0; a.l_hi = 2; hipLaunchKernelGGL((fwd_t<0, NPH + 1>), dim3(grid), dim3(NT), LDS_BYTES, stream, a);
#endif
}
```

```cpp
#include <hip/hip_runtime.h>
#include <cstdio>
#include <cstdint>
#define GAS __attribute__((address_space(1)))
#define LAS __attribute__((address_space(3)))

constexpr int D = 1024, NB = 4, SEQ = 4096, NMETA = 16, LP = SEQ + NMETA, MP = NB * LP, DB = 32, DS = 8, MS = DB * DS, MR = MP + MS, MPAD = 16896;
constexpr int DIN = 2048, CONVD = 3072, NH = 32, HP = 64, NG = 4, NST = 128;
constexpr int DFF = 4096, IN_DIM = 9320;
constexpr int PAST = 8192, PAGE = 128, NPAGES = 64, NPOOL = 2560;
constexpr int NIN = 9472, LDP1 = 9216;
constexpr int C_Z = 0, C_XBC = 2048, C_Q = 5120, C_K = 6144, C_V = 6400, C_QI = 6656, C_GS = 7168, C_GA = 8192;
constexpr int MC_KI = 0, MC_DT = 64, MC_WI = 96;
constexpr int KT_PER_B = (LP + 31) / 32;
static_assert(MP == 16448 && MR == 16704 && MPAD % 256 == 0 && MPAD >= MR, "rows");
namespace pg8 {
#define PG8_LAS __attribute__((address_space(3)))
typedef unsigned short bf16_t;
typedef short bf16x8 __attribute__((ext_vector_type(8)));
typedef float f32x4 __attribute__((ext_vector_type(4)));
typedef unsigned u32x4 __attribute__((ext_vector_type(4)));
constexpr int BM = 256, BK = 64, HALF = 128, HTB = HALF * BK * 2  , STAGE_BYTES = 8 * HTB, NXCD = 8, WGM = 8;

__host__ __device__ __forceinline__ int lds_byte(int r, int c) { const int st = (r >> 4) * 2 + (c >> 5), rr = r & 15, cc = c & 31, ob = rr * 64 + cc * 2; return st * 1024 + (ob ^ (((ob >> 9) & 1) << 5)); }
__host__ __device__ __forceinline__ void stage_rc(int b, int& R, int& C) { const int st = b / 1024, sb = b % 1024, swz = sb ^ (((sb >> 9) & 1) << 5); R = (st >> 1) * 16 + swz / 64; C = (st & 1) * 32 + (swz % 64) / 2; }
__host__ __device__ __forceinline__ int perm32(int rho) { const int n = rho >> 4, i = rho & 15; return 8 * (i >> 2) + 4 * n + (i & 3); }

struct Unit { int pm, pn; };
struct Gemm { const GAS bf16_t* A; const GAS bf16_t* Bt; int M, N, K; };

struct StaticOrder {
    int nM, nN, nwg, G, c;
    __host__ __device__ void init(int M, int N, int G_, int c_) { nM = M / BM; nN = N / BM; nwg = nM * nN; G = G_; c = c_; }
    __host__ __device__ bool next(int i, Unit& u) const {
        const long L = (long)i * G + c; if (L >= nwg) return false;
        int wgid = (int)L; { const int q = nwg / NXCD, r = nwg % NXCD, xcd = wgid % NXCD, off = wgid / NXCD; wgid = (xcd < r ? xcd * (q + 1) : r * (q + 1) + (xcd - r) * q) + off; }
        const int nig = WGM * nN, gid = wgid / nig, fm = gid * WGM, gsz = (nM - fm) < WGM ? (nM - fm) : WGM;
        u.pm = fm + ((wgid % nig) % gsz); u.pn = (wgid % nig) / gsz; return true;
    }
    __device__ __forceinline__ void a_ready(const Unit&) const {}
    __device__ __forceinline__ void done(const Unit&) const {}
};

__device__ __forceinline__ unsigned cvt_pk_bf16(float lo, float hi) { unsigned r; asm volatile("v_cvt_pk_bf16_f32 %0, %1, %2" : "=v"(r) : "v"(lo), "v"(hi)); return r; }

__device__ __forceinline__ void unpack8(const u32x4 w, float (&f)[8]) {
    f[0] = __uint_as_float(w.x << 16); f[1] = __uint_as_float(w.x & 0xffff0000u); f[2] = __uint_as_float(w.y << 16); f[3] = __uint_as_float(w.y & 0xffff0000u);
    f[4] = __uint_as_float(w.z << 16); f[5] = __uint_as_float(w.z & 0xffff0000u); f[6] = __uint_as_float(w.w << 16); f[7] = __uint_as_float(w.w & 0xffff0000u);
}
__device__ __forceinline__ u32x4 pack8(const f32x4 v0, const f32x4 v1) { u32x4 w; w.x = cvt_pk_bf16(v0[0], v0[1]); w.y = cvt_pk_bf16(v0[2], v0[3]); w.z = cvt_pk_bf16(v1[0], v1[1]); w.w = cvt_pk_bf16(v1[2], v1[3]); return w; }
__device__ __forceinline__ float sigm(float x) { return __builtin_amdgcn_rcpf(1.0f + __expf(-x)); }

struct EpiIn {
    static constexpr bool PERM = true, AFTER_DRAIN = false;
    GAS bf16_t* P1; GAS bf16_t* kvb; GAS float* misc; GAS bf16_t* kib; GAS bf16_t* kib2; GAS float *pk, *pv, *pki, *sk, *sv, *ski;
    __device__ __forceinline__ void operator()(const f32x4 (&acc)[2][2][4][2], const Unit& u, int wr, int wc, int fr, int fq) const {
        const int row0 = u.pm * BM + wr * 64 + fr, lc0 = wc * 32 + 8 * fq;
#pragma unroll
        for (int ai = 0; ai < 2; ++ai)
#pragma unroll
            for (int m = 0; m < 4; ++m) {
                const int row = row0 + ai * HALF + m * 16;
#pragma unroll
                for (int bj = 0; bj < 2; ++bj) {
                    const f32x4 v0 = acc[ai][bj][m][0], v1 = acc[ai][bj][m][1];
                    const int lc = lc0 + bj * HALF;
                    if (u.pn < 36) {
                        if (u.pn == 24 || u.pn == 25) *(GAS u32x4*)(kvb + (size_t)row * 512 + (u.pn - 24) * BM + lc) = pack8(v0, v1);
                        else *(GAS u32x4*)(P1 + (size_t)row * LDP1 + u.pn * BM + lc) = pack8(v0, v1);
                        if (u.pn == 24) {
                            if (row < MP) { GAS float* dst = pk + (size_t)row * 256 + lc; *(GAS f32x4*)dst = v0; *(GAS f32x4*)(dst + 4) = v1; }
                            else if (row < MR) { GAS float* dst = sk + (size_t)(row - MP) * 256 + lc; *(GAS f32x4*)dst = v0; *(GAS f32x4*)(dst + 4) = v1; }
                        } else if (u.pn == 25) {
                            if (row < MP) { GAS float* dst = pv + (size_t)row * 256 + lc; *(GAS f32x4*)dst = v0; *(GAS f32x4*)(dst + 4) = v1; }
                            else if (row < MR) { GAS float* dst = sv + (size_t)(row - MP) * 256 + lc; *(GAS f32x4*)dst = v0; *(GAS f32x4*)(dst + 4) = v1; }
                        }
                    } else {
                        if (lc < 128) { GAS float* d = misc + (size_t)row * 128 + lc; *(GAS f32x4*)d = v0; *(GAS f32x4*)(d + 4) = v1; }
                        if (lc < 64) {
                            *(GAS u32x4*)(kib + (size_t)row * 64 + lc) = pack8(v0, v1);
                            if (row < MP) { const int b = row / LP, t = row - b * LP;
                                *(GAS u32x4*)(kib2 + ((size_t)(b * KT_PER_B + (t >> 5)) * 2048 + (lc >> 4) * 512 + ((lc >> 3) & 1) * 256 + (t & 31) * 8)) = pack8(v0, v1); }
                            if (row < MP) { GAS float* dst = pki + (size_t)row * 64 + lc; *(GAS f32x4*)dst = v0; *(GAS f32x4*)(dst + 4) = v1; }
                            else if (row < MR) { GAS float* dst = ski + (size_t)(row - MP) * 64 + lc; *(GAS f32x4*)dst = v0; *(GAS f32x4*)(dst + 4) = v1; }
                        }
                    }
                }
            }
    }
};
struct EpiGate1 {
    static constexpr bool PERM = true, AFTER_DRAIN = false;
    const GAS bf16_t* P1; GAS bf16_t* T1;
    __device__ __forceinline__ void operator()(const f32x4 (&acc)[2][2][4][2], const Unit& u, int wr, int wc, int fr, int fq) const {
        const int row0 = u.pm * BM + wr * 64 + fr, col0 = u.pn * BM + wc * 32 + 8 * fq;
#pragma unroll
        for (int ai = 0; ai < 2; ++ai)
#pragma unroll
            for (int m = 0; m < 4; ++m) {
                const int row = row0 + ai * HALF + m * 16;
#pragma unroll
                for (int bj = 0; bj < 2; ++bj) {
                    const int col = col0 + bj * HALF;
                    float g[8]; unpack8(*(const GAS u32x4*)(P1 + (size_t)row * LDP1 + C_GS + col), g);
                    f32x4 v0 = acc[ai][bj][m][0], v1 = acc[ai][bj][m][1];
#pragma unroll
                    for (int e = 0; e < 4; ++e) { v0[e] *= sigm(g[e]); v1[e] *= sigm(g[4 + e]); }
                    *(GAS u32x4*)(T1 + (size_t)row * 1024 + col) = pack8(v0, v1);
                }
            }
    }
};
struct EpiGate2 {
    static constexpr bool PERM = true, AFTER_DRAIN = false;
    const GAS bf16_t* P1; const GAS bf16_t* T1; GAS bf16_t* MG;
    __device__ __forceinline__ void operator()(const f32x4 (&acc)[2][2][4][2], const Unit& u, int wr, int wc, int fr, int fq) const {
        const int row0 = u.pm * BM + wr * 64 + fr, col0 = u.pn * BM + wc * 32 + 8 * fq;
#pragma unroll
        for (int ai = 0; ai < 2; ++ai)
#pragma unroll
            for (int m = 0; m < 4; ++m) {
                const int row = row0 + ai * HALF + m * 16;
#pragma unroll
                for (int bj = 0; bj < 2; ++bj) {
                    const int col = col0 + bj * HALF;
                    float g[8]; unpack8(*(const GAS u32x4*)(P1 + (size_t)row * LDP1 + C_GA + col), g);
                    float tt[8]; unpack8(*(const GAS u32x4*)(T1 + (size_t)row * 1024 + col), tt); const f32x4 t0 = (f32x4){tt[0], tt[1], tt[2], tt[3]}, t1 = (f32x4){tt[4], tt[5], tt[6], tt[7]};
                    f32x4 v0 = acc[ai][bj][m][0], v1 = acc[ai][bj][m][1];
#pragma unroll
                    for (int e = 0; e < 4; ++e) { v0[e] = t0[e] + v0[e] * sigm(g[e]); v1[e] = t1[e] + v1[e] * sigm(g[4 + e]); }
                    *(GAS u32x4*)(MG + (size_t)row * 1024 + col) = pack8(v0, v1);
                }
            }
    }
};
struct EpiResid {
    static constexpr bool PERM = true, AFTER_DRAIN = false;
    GAS float* H;
    __device__ __forceinline__ void operator()(const f32x4 (&acc)[2][2][4][2], const Unit& u, int wr, int wc, int fr, int fq) const {
        const int row0 = u.pm * BM + wr * 64 + fr, col0 = u.pn * BM + wc * 32 + 8 * fq;
#pragma unroll
        for (int ai = 0; ai < 2; ++ai)
#pragma unroll
            for (int m = 0; m < 4; ++m) {
                const int row = row0 + ai * HALF + m * 16;
#pragma unroll
                for (int bj = 0; bj < 2; ++bj) {
                    GAS float* d = H + (size_t)row * 1024 + col0 + bj * HALF;
                    const f32x4 h0 = *(const GAS f32x4*)d, h1 = *(const GAS f32x4*)(d + 4);
                    *(GAS f32x4*)d = h0 + acc[ai][bj][m][0]; *(GAS f32x4*)(d + 4) = h1 + acc[ai][bj][m][1];
                }
            }
    }
};
struct EpiUp {
    static constexpr bool PERM = true, AFTER_DRAIN = false;
    GAS bf16_t* A2;
    __device__ __forceinline__ void operator()(const f32x4 (&acc)[2][2][4][2], const Unit& u, int wr, int wc, int fr, int fq) const {
        const int row0 = u.pm * BM + wr * 64 + fr, col0 = u.pn * BM + wc * 32 + 8 * fq;
#pragma unroll
        for (int ai = 0; ai < 2; ++ai)
#pragma unroll
            for (int m = 0; m < 4; ++m) {
                const int row = row0 + ai * HALF + m * 16;
#pragma unroll
                for (int bj = 0; bj < 2; ++bj) {
                    f32x4 v0 = acc[ai][bj][m][0], v1 = acc[ai][bj][m][1];
#pragma unroll
                    for (int e = 0; e < 4; ++e) { const float a = fmaxf(v0[e], 0.f), b = fmaxf(v1[e], 0.f); v0[e] = a * a; v1[e] = b * b; }
                    *(GAS u32x4*)(A2 + (size_t)row * DFF + col0 + bj * HALF) = pack8(v0, v1);
                }
            }
    }
};
template <class Epi, class Sched, bool ALIGN_EPI = false, bool SP2 = false>
__device__ __forceinline__ void gemm_phase(PG8_LAS unsigned char* lds, const Gemm g, const Sched& S, const Epi& E, const int tid) {
    const int wid = __builtin_amdgcn_readfirstlane(tid >> 6), lane = tid & 63, wr = wid >> 2, wc = wid & 3, fr = lane & 15, fq = lane >> 4;
    const int K = g.K, nt = K / BK;
    unsigned voffA[2], voffB[2];
#pragma unroll
    for (int i = 0; i < 2; ++i) { int R, C; stage_rc(tid * 16 + i * 8192, R, C); const int Rb = Epi::PERM ? ((R & ~31) + perm32(R & 31)) : R;
        voffA[i] = (unsigned)(R * K + C) * 2u; voffB[i] = (unsigned)(Rb * K + C) * 2u; }
    const size_t kstep = (size_t)(BK * 2);
    const size_t hstep = (size_t)HALF * K * 2;
    const size_t tstep = 2 * hstep;
    const unsigned ldsw = (unsigned)wid * 1024u;
    const int aoff = lds_byte(wr * 64 + fr, fq * 8), boff = lds_byte(wc * 32 + fr, fq * 8);
#define PG8_SA(b, h) (((b) * 2 + (h)) * HTB)
#define PG8_SB(b, h) ((4 + (b) * 2 + (h)) * HTB)
#define PG8_STAGE(bufoff, gbase, voff) do { _Pragma("unroll") for (int _i = 0; _i < 2; ++_i) \
        __builtin_amdgcn_global_load_lds((const GAS unsigned*)((const GAS char*)(gbase) + (voff)[_i]), (PG8_LAS unsigned*)(lds + (bufoff) + ldsw + _i * 8192), 16, 0, 0); } while (0)
#define PG8_LDA(dst, b, h) do { _Pragma("unroll") for (int m = 0; m < 4; ++m) _Pragma("unroll") for (int k = 0; k < 2; ++k) dst[m][k] = *(const PG8_LAS bf16x8*)(lds + PG8_SA(b, h) + aoff + m * 2048 + k * 1024); } while (0)
#define PG8_LDB(dst, b, h) do { _Pragma("unroll") for (int n = 0; n < 2; ++n) _Pragma("unroll") for (int k = 0; k < 2; ++k) dst[n][k] = *(const PG8_LAS bf16x8*)(lds + PG8_SB(b, h) + boff + n * 2048 + k * 1024); } while (0)
#define PG8_MMA(ai, bj, At, Bt) do { __builtin_amdgcn_s_setprio(1); _Pragma("unroll") for (int m = 0; m < 4; ++m) _Pragma("unroll") for (int n = 0; n < 2; ++n) _Pragma("unroll") for (int k = 0; k < 2; ++k) \
        acc[ai][bj][m][n] = __builtin_amdgcn_mfma_f32_16x16x32_bf16(Bt[n][k], At[m][k], acc[ai][bj][m][n], 0, 0, 0); __builtin_amdgcn_s_setprio(0); } while (0)
#define PG8_WAIT_V(n) asm volatile("s_waitcnt vmcnt(" #n ")" ::: "memory")
#define PG8_WAIT_L(n) asm volatile("s_waitcnt lgkmcnt(" #n ")" ::: "memory")
#define PG8_BAR __builtin_amdgcn_s_barrier()
#define PG8_SCHED __builtin_amdgcn_sched_barrier(0)
    Unit cur, nxt; int ui = 0;
    if (!S.next(0, cur)) return;
    f32x4 acc[2][2][4][2];
#pragma unroll
    for (int a = 0; a < 2; ++a)
#pragma unroll
        for (int b = 0; b < 2; ++b)
#pragma unroll
            for (int m = 0; m < 4; ++m)
#pragma unroll
                for (int n = 0; n < 2; ++n) acc[a][b][m][n] = (f32x4){0.f, 0.f, 0.f, 0.f};
    bf16x8 At[4][2], B0[2][2], B1[2][2];
    const GAS char* cA = (const GAS char*)g.A + (size_t)cur.pm * tstep; const GAS char* cB = (const GAS char*)g.Bt + (size_t)cur.pn * tstep;
    S.a_ready(cur);
    if constexpr (SP2) {
        PG8_STAGE(PG8_SB(0, 0), cB, voffB); PG8_STAGE(PG8_SB(0, 1), cB + hstep, voffB); PG8_STAGE(PG8_SA(0, 0), cA, voffA); PG8_STAGE(PG8_SA(0, 1), cA + hstep, voffA);
        if (wr == 1) PG8_BAR;
        PG8_WAIT_V(2); PG8_BAR;
        PG8_STAGE(PG8_SB(1, 0), cB + kstep, voffB); PG8_STAGE(PG8_SA(1, 0), cA + kstep, voffA); PG8_STAGE(PG8_SB(1, 1), cB + hstep + kstep, voffB);
        PG8_WAIT_V(6); PG8_BAR;
    } else {
        PG8_STAGE(PG8_SB(0, 0), cB, voffB); PG8_STAGE(PG8_SA(0, 0), cA, voffA); PG8_STAGE(PG8_SB(0, 1), cB + hstep, voffB); PG8_STAGE(PG8_SA(0, 1), cA + hstep, voffA);
        if (wr == 1) PG8_BAR;
        PG8_WAIT_V(4); PG8_BAR;
        PG8_STAGE(PG8_SB(1, 0), cB + kstep, voffB); PG8_STAGE(PG8_SA(1, 0), cA + kstep, voffA); PG8_STAGE(PG8_SB(1, 1), cB + hstep + kstep, voffB);
        PG8_WAIT_V(6); PG8_BAR;
    }
    for (;;) {
        const bool has_next = S.next(ui + 1, nxt);
        const GAS char* nA = has_next ? (const GAS char*)g.A + (size_t)nxt.pm * tstep : cA; const GAS char* nB = has_next ? (const GAS char*)g.Bt + (size_t)nxt.pn * tstep : cB;
        for (int t = 0; t < nt; t += 2) {
            const bool last = (t == nt - 2);
            const GAS char* a1 = cA + (size_t)(t + 1) * kstep;
            const GAS char* a2 = last ? nA : cA + (size_t)(t + 2) * kstep; const GAS char* b2 = last ? nB : cB + (size_t)(t + 2) * kstep;
            const GAS char* a3 = a2 + kstep; const GAS char* b3 = b2 + kstep;
            if (last && has_next) S.a_ready(nxt);
            if constexpr (SP2) {
            PG8_LDB(B0, 0, 0); PG8_LDB(B1, 0, 1); PG8_SCHED; PG8_LDA(At, 0, 0); PG8_STAGE(PG8_SA(1, 1), a1 + hstep, voffA);
            PG8_WAIT_V(8); PG8_WAIT_L(0); PG8_BAR; PG8_MMA(0, 0, At, B0); PG8_MMA(0, 1, At, B1); PG8_BAR; PG8_SCHED;
            PG8_LDA(At, 0, 1); PG8_STAGE(PG8_SB(0, 0), b2, voffB); PG8_STAGE(PG8_SB(0, 1), b2 + hstep, voffB); PG8_STAGE(PG8_SA(0, 0), a2, voffA);
            PG8_WAIT_V(8); PG8_WAIT_L(0); PG8_BAR; PG8_MMA(1, 0, At, B0); PG8_MMA(1, 1, At, B1); PG8_BAR; PG8_SCHED;
            PG8_LDB(B0, 1, 0); PG8_LDB(B1, 1, 1); PG8_SCHED; PG8_LDA(At, 1, 0); PG8_STAGE(PG8_SA(0, 1), a2 + hstep, voffA);
            PG8_WAIT_V(8); PG8_WAIT_L(0); PG8_BAR; PG8_MMA(0, 0, At, B0); PG8_MMA(0, 1, At, B1); PG8_BAR; PG8_SCHED;
            PG8_LDA(At, 1, 1); PG8_STAGE(PG8_SB(1, 0), b3, voffB); PG8_STAGE(PG8_SB(1, 1), b3 + hstep, voffB); PG8_STAGE(PG8_SA(1, 0), a3, voffA);
            PG8_WAIT_V(8); PG8_WAIT_L(0); PG8_BAR; PG8_MMA(1, 0, At, B0); PG8_MMA(1, 1, At, B1); PG8_BAR; PG8_SCHED;
            } else {
            PG8_LDB(B0, 0, 0); PG8_SCHED; PG8_LDA(At, 0, 0); PG8_STAGE(PG8_SA(1, 1), a1 + hstep, voffA);
            PG8_WAIT_L(8); PG8_BAR; PG8_WAIT_L(0); PG8_MMA(0, 0, At, B0); PG8_BAR; PG8_SCHED;
            PG8_LDB(B1, 0, 1); PG8_STAGE(PG8_SB(0, 0), b2, voffB);
            PG8_BAR; PG8_WAIT_L(0); PG8_MMA(0, 1, At, B1); PG8_BAR;
            PG8_LDA(At, 0, 1); PG8_STAGE(PG8_SA(0, 0), a2, voffA);
            PG8_BAR; PG8_WAIT_L(0); PG8_MMA(1, 0, At, B0); PG8_BAR; PG8_SCHED;
            PG8_STAGE(PG8_SB(0, 1), b2 + hstep, voffB);
            PG8_WAIT_V(6); PG8_BAR; PG8_MMA(1, 1, At, B1); PG8_BAR;
            PG8_LDB(B0, 1, 0); PG8_SCHED; PG8_LDA(At, 1, 0); PG8_STAGE(PG8_SA(0, 1), a2 + hstep, voffA);
            PG8_WAIT_L(8); PG8_BAR; PG8_WAIT_L(0); PG8_MMA(0, 0, At, B0); PG8_BAR; PG8_SCHED;
            PG8_LDB(B1, 1, 1); PG8_STAGE(PG8_SB(1, 0), b3, voffB);
            PG8_BAR; PG8_WAIT_L(0); PG8_MMA(0, 1, At, B1); PG8_BAR;
            PG8_LDA(At, 1, 1); PG8_STAGE(PG8_SA(1, 0), a3, voffA);
            PG8_BAR; PG8_WAIT_L(0); PG8_MMA(1, 0, At, B0); PG8_BAR; PG8_SCHED;
            PG8_STAGE(PG8_SB(1, 1), b3 + hstep, voffB);
            PG8_WAIT_V(6); PG8_BAR; PG8_MMA(1, 1, At, B1); PG8_BAR;
            }
        }
        if constexpr (ALIGN_EPI) { if (wr == 0) PG8_BAR; }
        if constexpr (!Epi::AFTER_DRAIN) { E(acc, cur, wr, wc, fr, fq); S.done(cur); }
        if (!has_next) break;
#pragma unroll
        for (int a = 0; a < 2; ++a)
#pragma unroll
            for (int b = 0; b < 2; ++b)
#pragma unroll
                for (int m = 0; m < 4; ++m)
#pragma unroll
                    for (int n = 0; n < 2; ++n) acc[a][b][m][n] = (f32x4){0.f, 0.f, 0.f, 0.f};
        cur = nxt; cA = nA; cB = nB; ++ui;
        if constexpr (ALIGN_EPI) { if (wr == 1) PG8_BAR; }
    }
    PG8_WAIT_V(0);
    if constexpr (!ALIGN_EPI) { if (wr == 0) PG8_BAR; }
    PG8_BAR;
    if constexpr (Epi::AFTER_DRAIN) { E.fused(acc, cur, wr, wc, fr, fq, lds, wid, lane); S.done(cur); }
#undef PG8_SA
#undef PG8_SB
#undef PG8_STAGE
#undef PG8_LDA
#undef PG8_LDB
#undef PG8_MMA
#undef PG8_WAIT_V
#undef PG8_WAIT_L
#undef PG8_BAR
#undef PG8_SCHED
}
}

typedef unsigned short bf16;
typedef unsigned v4u __attribute__((ext_vector_type(4)));
typedef float f32x4 __attribute__((ext_vector_type(4)));
typedef short bf16x8 __attribute__((ext_vector_type(8)));
typedef GAS unsigned gu32;
typedef GAS unsigned long long gu64;
#define RLX_AGENT __ATOMIC_RELAXED, __HIP_MEMORY_SCOPE_AGENT
#define LDS_WAIT() asm volatile("s_waitcnt lgkmcnt(0)" ::: "memory")
#define VM_WAIT() asm volatile("s_waitcnt vmcnt(0)" ::: "memory")
__device__ __forceinline__ unsigned long long rt() { return __builtin_amdgcn_s_memrealtime(); }
typedef float f32x2_cv __attribute__((ext_vector_type(2))); typedef __bf16 bf16x2_cv __attribute__((ext_vector_type(2)));
__device__ __forceinline__ unsigned pk2(float lo, float hi) { const f32x2_cv v = {lo, hi}; const bf16x2_cv c = __builtin_convertvector(v, bf16x2_cv); return __builtin_bit_cast(unsigned, c); }
__device__ __forceinline__ unsigned f2bf(float f) { return pk2(f, 0.f) & 0xffffu; }

#define XB_TMO      128
#define XB_XCNT(j)  (256  + 64 * (j))
#define XB_XSUB(j)  (1280 + 64 * (j))
#define XB_XGEN(j)  (2304 + 64 * (j))
#define XB_TOP      3328
#define XB_TOPGEN   3392
#define XCD_BAR_WORDS 3456
#define XB_SPIN_CAP (1u << 18)

__device__ __forceinline__ unsigned xb_ld(unsigned* p)              { return __hip_atomic_load(p, __ATOMIC_RELAXED, __HIP_MEMORY_SCOPE_AGENT); }
__device__ __forceinline__ unsigned xb_add(unsigned* p, unsigned v) { return __hip_atomic_fetch_add(p, v, __ATOMIC_RELAXED, __HIP_MEMORY_SCOPE_AGENT); }
__device__ __forceinline__ unsigned xb_xcc_id() { return (unsigned)__builtin_amdgcn_s_getreg((3 << 11) | 20) & 0xFu; }
#define XB_SPIN(cond, bar) do { unsigned _sp = 0; while (cond) { __builtin_amdgcn_s_sleep(1); \
    if ((++_sp & 255u) == 0u) { if (xb_ld(&(bar)[XB_TMO])) break; if (_sp > XB_SPIN_CAP) { atomicAdd(&(bar)[XB_TMO], 1u); break; } } } } while (0)

struct XcdBarrier {
    unsigned* bar; unsigned x;
    volatile LAS unsigned* st;
};

__device__ __forceinline__ XcdBarrier xcd_barrier_post(unsigned* bar, volatile LAS unsigned* st) {
    XcdBarrier b; b.bar = bar; b.x = xb_xcc_id(); b.st = st;
    if (threadIdx.x == 0) (void)xb_add(&bar[XB_XCNT(b.x)], 1u);
    return b;
}
__device__ __forceinline__ void xcd_barrier_complete(unsigned* bar, unsigned x, unsigned& nloc, unsigned& nx, const unsigned G) {
    unsigned sum, cnt, mine, sp = 0u;
    for (;;) {
        sum = 0u; cnt = 0u; mine = 0u;
#pragma unroll
        for (unsigned j = 0; j < 16; ++j) { const unsigned c = xb_ld(&bar[XB_XCNT(j)]); sum += c; cnt += (c > 0u) ? 1u : 0u; mine = (j == x) ? c : mine; }
        if (sum == G) break;
        __builtin_amdgcn_s_sleep(1);
        if ((++sp & 255u) == 0u) { if (xb_ld(&bar[XB_TMO])) break; if (sp > XB_SPIN_CAP) { atomicAdd(&bar[XB_TMO], 1u); break; } }
    }
    nloc = mine > 0u ? mine : 1u; nx = cnt > 0u ? cnt : 1u;
}

__device__ __forceinline__ void xcd_barrier(const XcdBarrier& b, const int tid_, const unsigned G_) {
    asm volatile("s_waitcnt vmcnt(0)" ::: "memory");
    __syncthreads();
    if (tid_ == 0) {
        unsigned* bar = b.bar;
        __builtin_amdgcn_s_waitcnt(0);
        unsigned nloc = b.st[0], nx = b.st[1];
        if (nloc == 0u) { xcd_barrier_complete(bar, b.x, nloc, nx, G_); b.st[0] = nloc; b.st[1] = nx; }
        const unsigned old = xb_add(&bar[XB_XSUB(b.x)], 1u);
        const unsigned gen = old / nloc;
        if (old + 1u == (gen + 1u) * nloc) {
            __builtin_amdgcn_fence(__ATOMIC_RELEASE, "agent");
            asm volatile("s_waitcnt vmcnt(0)" ::: "memory");
            const unsigned og = xb_add(&bar[XB_TOP], 1u);
            const unsigned tg = og / nx;
            if (og + 1u == (tg + 1u) * nx) xb_add(&bar[XB_TOPGEN], 1u);
            else XB_SPIN(xb_ld(&bar[XB_TOPGEN]) == tg, bar);
            __builtin_amdgcn_fence(__ATOMIC_ACQUIRE, "agent");
            xb_add(&bar[XB_XGEN(b.x)], 1u);
            asm volatile("s_waitcnt vmcnt(0)" ::: "memory");
        } else {
            XB_SPIN(xb_ld(&bar[XB_XGEN(b.x)]) == gen, bar);
            __builtin_amdgcn_fence(__ATOMIC_ACQUIRE, "agent");
            asm volatile("s_waitcnt vmcnt(0)" ::: "memory");
        }
    }
    __syncthreads();
}

constexpr size_t O_YP = 0, O_YS = O_YP + (size_t)NB * SEQ * D, O_PK = O_YS + (size_t)MS * D, O_PV = O_PK + 2ull * MP * 256, O_PKI = O_PV + 2ull * MP * 256,
                 O_PSSM = O_PKI + 2ull * MP * 64, O_PCONV = O_PSSM + 2ull * NB * NH * HP * NST, O_SK = O_PCONV + 2ull * NB * 3 * CONVD, O_SV = O_SK + 2ull * MS * 256,
                 O_SKI = O_SV + 2ull * MS * 256, O_SSSM = O_SKI + 2ull * MS * 64, O_SCONV = O_SSSM + 2ull * DB * NH * HP * NST, O_END = O_SCONV + 2ull * DB * 3 * CONVD;

constexpr size_t MiB = 1u << 20;
constexpr size_t al(size_t x) { return (x + MiB - 1) / MiB * MiB; }
constexpr size_t WS_CTL = 0, CTL_ZERO_BYTES = 1 * MiB;
constexpr size_t SZ_WIN = (size_t)NIN * D * 2, SZ_WSSM = (size_t)D * DIN * 2, SZ_WATT = (size_t)D * D * 2, SZ_WOUT = (size_t)D * D * 2, SZ_WUP = (size_t)DFF * D * 2, SZ_WDN = (size_t)D * DFF * 2;
constexpr size_t WL_WIN = 0, WL_WSSM = al(WL_WIN + SZ_WIN), WL_WATT = al(WL_WSSM + SZ_WSSM), WL_WOUT = al(WL_WATT + SZ_WATT), WL_WUP = al(WL_WOUT + SZ_WOUT), WL_WDN = al(WL_WUP + SZ_WUP), WL_SIZE = al(WL_WDN + SZ_WDN);
constexpr size_t WS_W = 1 * MiB;
constexpr size_t WS_H = al(WS_W + 2 * WL_SIZE);
constexpr size_t WS_U = al(WS_H + (size_t)MPAD * D * 4);
constexpr size_t WS_P1 = al(WS_U + (size_t)MPAD * D * 2);
constexpr size_t WS_MISC = al(WS_P1 + (size_t)MPAD * LDP1 * 2);
constexpr size_t WS_KIB = al(WS_MISC + (size_t)MPAD * 128 * 4);
constexpr size_t WS_XC = al(WS_KIB + (size_t)MPAD * 64 * 2);
constexpr size_t WS_DT = al(WS_XC + (size_t)MPAD * CONVD * 2);
constexpr size_t WS_DA = al(WS_DT + (size_t)MPAD * 32 * 4);
constexpr size_t WS_YS = al(WS_DA + (size_t)MPAD * 32 * 4);
constexpr size_t WS_YSN = al(WS_YS + (size_t)MPAD * DIN * 4);
constexpr size_t WS_YA = al(WS_YSN + (size_t)MPAD * DIN * 2);
constexpr size_t WS_T1 = al(WS_YA + (size_t)MPAD * D * 2);
constexpr size_t WS_MG = al(WS_T1 + (size_t)MPAD * D * 4);
constexpr size_t WS_A2 = al(WS_MG + (size_t)MPAD * D * 2);
constexpr size_t WS_IDXP = al(WS_A2 + (size_t)MPAD * DFF * 2);
constexpr size_t WS_IDXS = al(WS_IDXP + (size_t)MP * 256 * 2);
constexpr int SCS_LD = 8256;
constexpr size_t WS_SCS = al(WS_IDXS + (size_t)MS * 256 * 4);
constexpr size_t WS_SB = al(WS_SCS + (size_t)MS * SCS_LD * 4);
constexpr size_t WS_DEC = al(WS_SB + (size_t)NB * 33 * NH * HP * NST * 4);
constexpr size_t WS_HC = al(WS_DEC + (size_t)NB * 33 * NH * 4);
constexpr size_t WS_KVB = al(WS_HC + (size_t)NB * 33 * NH * HP * NST * 2);
constexpr size_t WS_KIB2 = al(WS_KVB + (size_t)MPAD * 512 * 2);
constexpr size_t WS_END = al(WS_KIB2 + (size_t)NB * KT_PER_B * 2048 * 2);
constexpr int CW_BAR = 4096;

constexpr int LDS_BYTES = 155648, LDSCTL_OFF = 151552, MISC_OFF = LDSCTL_OFF + 320;
constexpr int NWAVES = 8, NT = 512;
typedef float f32x16 __attribute__((ext_vector_type(16)));
typedef unsigned v2u __attribute__((ext_vector_type(2)));

__device__ __forceinline__ float dpp_f(float v, const int ctrl_unused) { return v; }
#define DPPF(v, ctrl, rmask, bc) __uint_as_float((unsigned)__builtin_amdgcn_update_dpp(0, (int)__float_as_uint(v), ctrl, rmask, 0xf, bc))
__device__ __forceinline__ float row16_sum(float v) {
    v += DPPF(v, 0xB1, 0xf, true); v += DPPF(v, 0x4E, 0xf, true); v += DPPF(v, 0x141, 0xf, true); v += DPPF(v, 0x140, 0xf, true); return v;
}
__device__ __forceinline__ float wave_sum(float v) {
    v = row16_sum(v);
    v += DPPF(v, 0x142, 0xa, false); v += DPPF(v, 0x143, 0xc, false);
    return __uint_as_float((unsigned)__builtin_amdgcn_readlane((int)__float_as_uint(v), 63));
}
__device__ __forceinline__ float wave_max(float v) {
    v = fmaxf(v, __uint_as_float((unsigned)__builtin_amdgcn_update_dpp((int)__float_as_uint(v), (int)__float_as_uint(v), 0xB1, 0xf, 0xf, false)));
    v = fmaxf(v, __uint_as_float((unsigned)__builtin_amdgcn_update_dpp((int)__float_as_uint(v), (int)__float_as_uint(v), 0x4E, 0xf, 0xf, false)));
    v = fmaxf(v, __uint_as_float((unsigned)__builtin_amdgcn_update_dpp((int)__float_as_uint(v), (int)__float_as_uint(v), 0x141, 0xf, 0xf, false)));
    v = fmaxf(v, __uint_as_float((unsigned)__builtin_amdgcn_update_dpp((int)__float_as_uint(v), (int)__float_as_uint(v), 0x140, 0xf, 0xf, false)));
    v = fmaxf(v, __uint_as_float((unsigned)__builtin_amdgcn_update_dpp((int)__float_as_uint(v), (int)__float_as_uint(v), 0x142, 0xa, 0xf, false)));
    v = fmaxf(v, __uint_as_float((unsigned)__builtin_amdgcn_update_dpp((int)__float_as_uint(v), (int)__float_as_uint(v), 0x143, 0xc, 0xf, false)));
    return __uint_as_float((unsigned)__builtin_amdgcn_readlane((int)__float_as_uint(v), 63));
}
__device__ __forceinline__ void unpack8(const v4u w, float (&f)[8]) {
    f[0] = __uint_as_float(w.x << 16); f[1] = __uint_as_float(w.x & 0xffff0000u); f[2] = __uint_as_float(w.y << 16); f[3] = __uint_as_float(w.y & 0xffff0000u);
    f[4] = __uint_as_float(w.z << 16); f[5] = __uint_as_float(w.z & 0xffff0000u); f[6] = __uint_as_float(w.w << 16); f[7] = __uint_as_float(w.w & 0xffff0000u);
}
__device__ __forceinline__ float sigm(float x) { return __builtin_amdgcn_rcpf(1.0f + __expf(-x)); }

__device__ __forceinline__ int win_src_col(int n) {
    if (n < 5120) return n;
    if (n < 6144) return n - 5120 + 5152;
    if (n < 6400) return n - 6144 + 6176;
    if (n < 6656) return n - 6400 + 6432;
    if (n < 7168) return n - 6656 + 6688;
    if (n < 8192) return n - 7168 + 7272;
    if (n < 9216) return n - 8192 + 8296;
    if (n < 9280) return n - 9216 + 7200;
    if (n < 9312) return n - 9280 + 5120;
    if (n < 9320) return n - 9312 + 7264;
    return -1;
}
__device__ __forceinline__ void tr_item(const GAS float* W, int K, int Nsrc, GAS bf16* WT, int nblk, bool remap, LAS float* scr, int item, int lane) {
    const int kb = item / nblk, nb = item % nblk, k0 = 64 * kb, n0 = 64 * nb;
    const int s0 = remap ? win_src_col(n0) : n0, s63 = remap ? win_src_col(n0 + 63) : n0 + 63;
    if (s0 >= 0 && s63 == s0 + 63 && (s0 & 3) == 0 && (Nsrc & 3) == 0) {
        const int r4 = lane >> 4, c4 = (lane & 15) * 4;
#pragma unroll 4
        for (int i = 0; i < 16; ++i) { const int kk = 4 * i + r4; const f32x4 v = *(const GAS f32x4*)(W + (size_t)(k0 + kk) * Nsrc + s0 + c4);
            scr[kk * 65 + c4] = v.x; scr[kk * 65 + c4 + 1] = v.y; scr[kk * 65 + c4 + 2] = v.z; scr[kk * 65 + c4 + 3] = v.w; }
    } else {
        const int sc = remap ? win_src_col(n0 + lane) : n0 + lane;
#pragma unroll 8
        for (int kk = 0; kk < 64; ++kk) scr[kk * 65 + lane] = sc >= 0 ? W[(size_t)(k0 + kk) * Nsrc + sc] : 0.f;
    }
    LDS_WAIT(); asm volatile("" ::: "memory");
    const int c = lane & 7;
#pragma unroll
    for (int j = 0; j < 8; ++j) { const int n = (lane >> 3) + 8 * j; const LAS float* s = scr + (8 * c) * 65 + n;
        v4u o; o.x = pk2(s[0 * 65], s[1 * 65]); o.y = pk2(s[2 * 65], s[3 * 65]); o.z = pk2(s[4 * 65], s[5 * 65]); o.w = pk2(s[6 * 65], s[7 * 65]);
        *(GAS v4u*)(WT + (size_t)(n0 + n) * K + k0 + 8 * c) = o; }
    LDS_WAIT(); asm volatile("" ::: "memory");
}
__device__ __forceinline__ void rms_row(const GAS float* src, const GAS float* w, GAS float* hdst, GAS bf16* udst, GAS float* fdst, int lane) {
    f32x4 v[4]; float ss = 0.f;
#pragma unroll
    for (int j = 0; j < 4; ++j) { v[j] = src ? ((const GAS f32x4*)src)[lane + 64 * j] : (f32x4){0.f, 0.f, 0.f, 0.f}; ss += (v[j].x * v[j].x + v[j].y * v[j].y) + (v[j].z * v[j].z + v[j].w * v[j].w); }
    ss = wave_sum(ss);
    const float rstd = 1.0f / sqrtf(ss * (1.0f / D) + 1e-6f);
#pragma unroll
    for (int j = 0; j < 4; ++j) {
        if (hdst) ((GAS f32x4*)hdst)[lane + 64 * j] = v[j];
        const f32x4 wv = ((const GAS f32x4*)w)[lane + 64 * j]; const f32x4 o = v[j] * rstd * wv;
        if (udst) ((GAS v2u*)udst)[lane + 64 * j] = (v2u){pk2(o.x, o.y), pk2(o.z, o.w)};
        if (fdst) ((GAS f32x4*)fdst)[lane + 64 * j] = o;
    }
}

__device__ __forceinline__ void rms_rows4(const GAS float* H, const GAS float* w, GAS bf16* U, int m0, int stride, int mend, int lane) {
    f32x4 v[4][4]; float ss[4];
#pragma unroll
    for (int r = 0; r < 4; ++r) { const int m = m0 + r * stride; const GAS f32x4* src = (const GAS f32x4*)(H + (size_t)(m < mend ? m : m0) * D); ss[r] = 0.f;
#pragma unroll
        for (int j = 0; j < 4; ++j) v[r][j] = src[lane + 64 * j]; }
    f32x4 wv[4];
#pragma unroll
    for (int j = 0; j < 4; ++j) wv[j] = ((const GAS f32x4*)w)[lane + 64 * j];
#pragma unroll
    for (int r = 0; r < 4; ++r) {
#pragma unroll
        for (int j = 0; j < 4; ++j) ss[r] += (v[r][j].x * v[r][j].x + v[r][j].y * v[r][j].y) + (v[r][j].z * v[r][j].z + v[r][j].w * v[r][j].w);
        ss[r] = wave_sum(ss[r]);
        const float rstd = 1.0f / sqrtf(ss[r] * (1.0f / D) + 1e-6f); const int m = m0 + r * stride;
        if (m < mend) {
#pragma unroll
            for (int j = 0; j < 4; ++j) { const f32x4 o = v[r][j] * rstd * wv[j]; ((GAS v2u*)(U + (size_t)m * D))[lane + 64 * j] = (v2u){pk2(o.x, o.y), pk2(o.z, o.w)}; } }
    }
}

__device__ __forceinline__ void rms_rows4g(const GAS float* const (&src)[4], const GAS float* w, GAS float* const (&hdst)[4], GAS bf16* const (&udst)[4], GAS float* const (&fdst)[4], const bool (&live)[4], int lane) {
    f32x4 v[4][4];
#pragma unroll
    for (int r = 0; r < 4; ++r)
#pragma unroll
        for (int j = 0; j < 4; ++j) v[r][j] = (live[r] && src[r]) ? ((const GAS f32x4*)src[r])[lane + 64 * j] : (f32x4){0.f, 0.f, 0.f, 0.f};
    f32x4 wv[4];
#pragma unroll
    for (int j = 0; j < 4; ++j) wv[j] = ((const GAS f32x4*)w)[lane + 64 * j];
#pragma unroll
    for (int r = 0; r < 4; ++r) { float ss = 0.f;
#pragma unroll
        for (int j = 0; j < 4; ++j) ss += (v[r][j].x * v[r][j].x + v[r][j].y * v[r][j].y) + (v[r][j].z * v[r][j].z + v[r][j].w * v[r][j].w);
        ss = wave_sum(ss);
        const float rstd = 1.0f / sqrtf(ss * (1.0f / D) + 1e-6f);
        if (live[r]) {
#pragma unroll
            for (int j = 0; j < 4; ++j) { const f32x4 o = v[r][j] * rstd * wv[j];
                if (hdst[r]) ((GAS f32x4*)hdst[r])[lane + 64 * j] = v[r][j];
                if (udst[r]) ((GAS v2u*)udst[r])[lane + 64 * j] = (v2u){pk2(o.x, o.y), pk2(o.z, o.w)};
                if (fdst[r]) ((GAS f32x4*)fdst[r])[lane + 64 * j] = o; } }
    }
}

__device__ __forceinline__ void ssd_unit(LAS unsigned char* lds, int tid, const GAS bf16* XC, const GAS float* DT, const GAS float* DA, size_t m0, int L, int h, int p0,
                                         const GAS float* hin, GAS float* hout, GAS float* YS, float dskip) {
    LAS float* Bl = (LAS float*)lds;
    LAS float* Cl = Bl + 64 * 128;
    LAS float* Xl = Cl + 64 * 128;
    LAS float* Yl = Xl + 64 * 32;
    LAS float* dtl = Yl + 64 * 32;
    LAS float* dal = dtl + 64;
    const int pl = tid >> 4, nq = tid & 15, n0 = nq * 8, g = h >> 3;
    float s[8];
    if (hin) { const f32x4 a = *(const GAS f32x4*)(hin + (size_t)(p0 + pl) * NST + n0), b = *(const GAS f32x4*)(hin + (size_t)(p0 + pl) * NST + n0 + 4);
        s[0] = a.x; s[1] = a.y; s[2] = a.z; s[3] = a.w; s[4] = b.x; s[5] = b.y; s[6] = b.z; s[7] = b.w; }
    else {
#pragma unroll
        for (int i = 0; i < 8; ++i) s[i] = 0.f; }
    for (int tb = 0; tb < L; tb += 64) {
        const int nb = (L - tb) < 64 ? (L - tb) : 64;
        { const int tk = tid >> 3, part = tid & 7;
            if (tk < nb) { const GAS bf16* xr = XC + (m0 + tb + tk) * CONVD;
                float f[8];
                unpack8(*(const GAS v4u*)(xr + DIN + g * NST + part * 16), f);
                *(LAS f32x4*)(Bl + tk * 128 + part * 16) = (f32x4){f[0], f[1], f[2], f[3]}; *(LAS f32x4*)(Bl + tk * 128 + part * 16 + 4) = (f32x4){f[4], f[5], f[6], f[7]};
                unpack8(*(const GAS v4u*)(xr + DIN + g * NST + part * 16 + 8), f);
                *(LAS f32x4*)(Bl + tk * 128 + part * 16 + 8) = (f32x4){f[0], f[1], f[2], f[3]}; *(LAS f32x4*)(Bl + tk * 128 + part * 16 + 12) = (f32x4){f[4], f[5], f[6], f[7]};
                unpack8(*(const GAS v4u*)(xr + DIN + NG * NST + g * NST + part * 16), f);
                *(LAS f32x4*)(Cl + tk * 128 + part * 16) = (f32x4){f[0], f[1], f[2], f[3]}; *(LAS f32x4*)(Cl + tk * 128 + part * 16 + 4) = (f32x4){f[4], f[5], f[6], f[7]};
                unpack8(*(const GAS v4u*)(xr + DIN + NG * NST + g * NST + part * 16 + 8), f);
                *(LAS f32x4*)(Cl + tk * 128 + part * 16 + 8) = (f32x4){f[0], f[1], f[2], f[3]}; *(LAS f32x4*)(Cl + tk * 128 + part * 16 + 12) = (f32x4){f[4], f[5], f[6], f[7]};
                const v2u xw = *(const GAS v2u*)(xr + h * HP + p0 + part * 4);
                *(LAS f32x4*)(Xl + tk * 32 + part * 4) = (f32x4){__uint_as_float(xw.x << 16), __uint_as_float(xw.x & 0xffff0000u), __uint_as_float(xw.y << 16), __uint_as_float(xw.y & 0xffff0000u)};
            }
            if (tid < nb) { dtl[tid] = DT[(m0 + tb + tid) * 32 + h]; dal[tid] = DA[(m0 + tb + tid) * 32 + h]; }
        }
        __syncthreads();
        for (int t = 0; t < nb; ++t) {
            const float da = dal[t], dtv = dtl[t], xv = Xl[t * 32 + pl], xdt = xv * dtv;
            const f32x4 b0 = *(const LAS f32x4*)(Bl + t * 128 + n0), b1 = *(const LAS f32x4*)(Bl + t * 128 + n0 + 4);
            const f32x4 c0 = *(const LAS f32x4*)(Cl + t * 128 + n0), c1 = *(const LAS f32x4*)(Cl + t * 128 + n0 + 4);
            s[0] = s[0] * da + xdt * b0.x; s[1] = s[1] * da + xdt * b0.y; s[2] = s[2] * da + xdt * b0.z; s[3] = s[3] * da + xdt * b0.w;
            s[4] = s[4] * da + xdt * b1.x; s[5] = s[5] * da + xdt * b1.y; s[6] = s[6] * da + xdt * b1.z; s[7] = s[7] * da + xdt * b1.w;
            float y = (s[0] * c0.x + s[1] * c0.y) + (s[2] * c0.z + s[3] * c0.w) + (s[4] * c1.x + s[5] * c1.y) + (s[6] * c1.z + s[7] * c1.w);
            y += __shfl_xor(y, 1); y += __shfl_xor(y, 2); y += __shfl_xor(y, 4); y += __shfl_xor(y, 8);
            if (nq == 0) Yl[t * 32 + pl] = y + xv * dskip;
        }
        __syncthreads();
        { const int tk = tid >> 3, part = tid & 7;
            if (tk < nb) *(GAS f32x4*)(YS + (m0 + tb + tk) * DIN + h * HP + p0 + part * 4) = *(const LAS f32x4*)(Yl + tk * 32 + part * 4); }
    }
    *(GAS f32x4*)(hout + (size_t)(p0 + pl) * NST + n0) = (f32x4){s[0], s[1], s[2], s[3]};
    *(GAS f32x4*)(hout + (size_t)(p0 + pl) * NST + n0 + 4) = (f32x4){s[4], s[5], s[6], s[7]};
}

__device__ __forceinline__ void idx_load_q(const GAS bf16* P1, const GAS float* MISC, size_t mq0, int lane, bf16x8 (&afr)[2][4], float (&wq)[2][2][8]) {
    const int r = lane & 31, hh = lane >> 5, qs = ((r >> 2) & 1) * 2 + (r >> 4), head = (r & 3) + 4 * ((r >> 3) & 1);
#pragma unroll
    for (int rt = 0; rt < 2; ++rt)
#pragma unroll
        for (int ks = 0; ks < 4; ++ks) afr[rt][ks] = *(const GAS bf16x8*)(P1 + (mq0 + qs + 4 * rt) * LDP1 + C_QI + head * 64 + 16 * ks + 8 * hh);
#pragma unroll
    for (int rt = 0; rt < 2; ++rt)
#pragma unroll
        for (int jq = 0; jq < 2; ++jq) { const GAS float* wp = MISC + (mq0 + 4 * rt + 2 * hh + jq) * 128 + MC_WI; const f32x4 a = *(const GAS f32x4*)wp, b = *(const GAS f32x4*)(wp + 4);
            const float sc = 0.125f * 0.35355339059327373f;
            wq[rt][jq][0] = a.x * sc; wq[rt][jq][1] = a.y * sc; wq[rt][jq][2] = a.z * sc; wq[rt][jq][3] = a.w * sc; wq[rt][jq][4] = b.x * sc; wq[rt][jq][5] = b.y * sc; wq[rt][jq][6] = b.z * sc; wq[rt][jq][7] = b.w * sc; }
}
__device__ __forceinline__ void idx_scores(const bf16x8 (&afr)[2][4], const bf16x8 (&bfr)[4], const float (&wq)[2][2][8], float (&sc)[2][2]) {
#pragma unroll
    for (int rt = 0; rt < 2; ++rt) {
        f32x16 acc = {};
#pragma unroll
        for (int ks = 0; ks < 4; ++ks) acc = __builtin_amdgcn_mfma_f32_32x32x16_bf16(afr[rt][ks], bfr[ks], acc, 0, 0, 0);
#pragma unroll
        for (int jq = 0; jq < 2; ++jq) { float s = 0.f;
#pragma unroll
            for (int i = 0; i < 8; ++i) s += wq[rt][jq][i] * fmaxf(acc[8 * jq + i], 0.f);
            sc[rt][jq] = s; }
    }
}
__device__ __forceinline__ unsigned f2key(float f) { const unsigned u = __float_as_uint(f); return u ^ ((u >> 31) ? 0xffffffffu : 0x80000000u); }
__device__ __forceinline__ unsigned wave_incl_scan(unsigned v, int lane) {
#pragma unroll
    for (int o = 1; o < 64; o <<= 1) { const unsigned t = __shfl_up(v, o); if (lane >= o) v += t; }
    return v;
}
#ifndef REP_TK_PASS
#define REP_TK_PASS 1
#endif
#ifndef REP_TK_COMP
#define REP_TK_COMP 1
#endif
__device__ __forceinline__ int wave_sum_i(int v) {
    v += __builtin_amdgcn_update_dpp(0, v, 0xB1, 0xf, 0xf, true);
    v += __builtin_amdgcn_update_dpp(0, v, 0x4E, 0xf, 0xf, true);
    v += __builtin_amdgcn_update_dpp(0, v, 0x141, 0xf, 0xf, true);
    v += __builtin_amdgcn_update_dpp(0, v, 0x140, 0xf, 0xf, true);
    v += __builtin_amdgcn_update_dpp(0, v, 0x142, 0xa, 0xf, false);
    v += __builtin_amdgcn_update_dpp(0, v, 0x143, 0xc, 0xf, false);
    return __builtin_amdgcn_readlane(v, 63);
}
__device__ __forceinline__ int cnt_ge(const LAS unsigned* s, int nit, unsigned mid, int lane) {
    int cl = 0; int it = 0;
    const LAS v4u* p = (const LAS v4u*)s + lane;
    for (; it + 4 <= nit; it += 4) {
        const v4u k0 = p[64 * it], k1 = p[64 * it + 64], k2 = p[64 * it + 128], k3 = p[64 * it + 192];
        cl += (k0.x >= mid) + (k0.y >= mid) + (k0.z >= mid) + (k0.w >= mid);
        cl += (k1.x >= mid) + (k1.y >= mid) + (k1.z >= mid) + (k1.w >= mid);
        cl += (k2.x >= mid) + (k2.y >= mid) + (k2.z >= mid) + (k2.w >= mid);
        cl += (k3.x >= mid) + (k3.y >= mid) + (k3.z >= mid) + (k3.w >= mid); }
    for (; it < nit; ++it) { const v4u kv = p[64 * it]; cl += (kv.x >= mid) + (kv.y >= mid) + (kv.z >= mid) + (kv.w >= mid); }
    return wave_sum_i(cl);
}
template <class OT>
__device__ __forceinline__ void topk_select(LAS unsigned* s, int n, int lane, OT* out) {
    const int nit = (n + 255) >> 8;
    for (int i = n + lane; i < nit * 256; i += 64) s[i] = 0u;
    LDS_WAIT(); asm volatile("" ::: "memory");
    unsigned T = 0u, need = 0u;
    for (int rq_ = 0; rq_ < REP_TK_PASS; ++rq_) {
    unsigned kmx = 0u;
    for (int it = 0; it < nit; ++it) { const v4u kv = *(const LAS v4u*)(s + 4 * (lane + 64 * it));
        const unsigned a = kv.x > kv.y ? kv.x : kv.y, c = kv.z > kv.w ? kv.z : kv.w, d = a > c ? a : c; kmx = d > kmx ? d : kmx; }
#pragma unroll
    for (int o = 1; o < 64; o <<= 1) { const unsigned a = __shfl_xor(kmx, o); kmx = a > kmx ? a : kmx; }
    kmx = (unsigned)__builtin_amdgcn_readfirstlane((int)kmx);
    unsigned hi = kmx + 1u, lo = 1u; int c_hi = 0, c_lo = n;
    { unsigned step = 1u << 25;
      for (int tr = 0; tr < 7; ++tr) { if (hi <= step + 1u) break; const unsigned cand = hi - step;
          const int c = cnt_ge(s, nit, cand, lane);
          if (c >= 256) { lo = cand; c_lo = c; break; } hi = cand; c_hi = c; step <<= 1; } }
    bool bis = false; unsigned pw = hi - lo;
    for (int pass = 0; pass < 96; ++pass) {
        if (c_lo == 256) { T = lo - 1u; need = 0u; break; }
        if (hi - lo <= 1u) { T = lo; need = (unsigned)(256 - c_hi); break; }
        const unsigned width = hi - lo; unsigned mid;
        if (bis) mid = lo + (width >> 1);
        else { const float f = ((float)(c_lo - 256) + 0.5f) * __builtin_amdgcn_rcpf((float)(c_lo - c_hi)); const float off = (float)width * f;
               mid = lo + (off >= (float)width ? width - 1u : (unsigned)off); }
        if (mid <= lo) mid = lo + 1u; if (mid >= hi) mid = hi - 1u;
        const int c = cnt_ge(s, nit, mid, lane);
        if (c >= 256) { lo = mid; c_lo = c; } else { hi = mid; c_hi = c; }
        const unsigned nw = hi - lo; bis = !bis && (nw > (pw >> 2)); pw = nw;
    }
    }
    const unsigned long long lt = (1ull << lane) - 1ull;
    unsigned running = 0u, eq_taken = 0u;
    for (int rq_ = 0; rq_ < REP_TK_COMP; ++rq_) { running = 0u; eq_taken = 0u;
#pragma unroll 2
    for (int it = 0; it < nit; ++it) {
        const int i0 = 4 * (lane + 64 * it); const v4u kv = *(const LAS v4u*)(s + i0);
        bool sel[4], eq[4]; bool anyeq = false;
#pragma unroll
        for (int e = 0; e < 4; ++e) { sel[e] = kv[e] > T; eq[e] = need != 0u && kv[e] == T && (i0 + e < n); anyeq = anyeq || eq[e]; }
        if (need != 0u && __ballot(anyeq)) {
            unsigned lower = 0u, all = 0u;
#pragma unroll
            for (int e = 0; e < 4; ++e) { const unsigned long long bm = __ballot(eq[e]); lower += (unsigned)__popcll(bm & lt); all += (unsigned)__popcll(bm); }
            unsigned er = eq_taken + lower;
#pragma unroll
            for (int e = 0; e < 4; ++e) { if (eq[e]) { sel[e] = er < need; ++er; } }
            eq_taken += all;
        }
        unsigned lower = 0u, all = 0u;
#pragma unroll
        for (int e = 0; e < 4; ++e) { const unsigned long long sm = __ballot(sel[e]); lower += (unsigned)__popcll(sm & lt); all += (unsigned)__popcll(sm); }
        unsigned pos = running + lower;
#pragma unroll
        for (int e = 0; e < 4; ++e) { if (sel[e]) { if (pos < 256u) out[pos] = (OT)(i0 + e); ++pos; } }
        running += all;
    } }
}

constexpr int NCH = 33;
typedef short s16x4 __attribute__((ext_vector_type(4)));
typedef short v4i16_t __attribute__((ext_vector_type(4)));
__device__ __forceinline__ float wave_incl_scan_f(float v, int lane) {
#pragma unroll
    for (int o = 1; o < 64; o <<= 1) { const float t = __shfl_up(v, o); if (lane >= o) v += t; }
    return v;
}
__device__ __forceinline__ s16x4 ldtr(const LAS unsigned char* p) { return __builtin_bit_cast(s16x4, __builtin_amdgcn_ds_read_tr16_b64_v4i16((LAS v4i16_t*)p)); }
__device__ __forceinline__ bf16x8 frag_tr(const LAS unsigned char* img, int RS, int k0, int c0, int lane) {
    const int hh = lane >> 5, blk = (lane >> 4) & 1, q = (lane & 15) >> 2, pp = lane & 3;
    const LAS unsigned char* a = img + (k0 + 8 * hh + q) * RS + (c0 + 16 * blk + 4 * pp) * 2;
    const s16x4 lo = ldtr(a), hi = ldtr(a + 4 * RS);
    return (bf16x8){lo[0], lo[1], lo[2], lo[3], hi[0], hi[1], hi[2], hi[3]};
}
__device__ __forceinline__ bf16x8 frag_row(const LAS unsigned char* img, int RS, int r0, int k0, int lane) {
    return *(const LAS bf16x8*)(img + (r0 + (lane & 31)) * RS + (k0 + 8 * (lane >> 5)) * 2);
}
constexpr int RS_BC = 272, RS_X = 144, IMG_BC = 128 * RS_BC, IMG_X = 128 * RS_X;
__device__ __forceinline__ void ssd_stage_acum(LAS float* acl, LAS float* dtl, const GAS float* DT, const GAS float* a_log_l, size_t m0, int Lc, int g, int wave, int lane) {
    const int h = 8 * g + wave; const float A = -__expf(a_log_l[h]);
    const float d0 = lane < Lc ? DT[(m0 + lane) * 32 + h] : 0.f, d1 = (64 + lane) < Lc ? DT[(m0 + 64 + lane) * 32 + h] : 0.f;
    const float s0 = wave_incl_scan_f(d0 * A, lane), tot0 = __shfl(s0, 63), s1 = wave_incl_scan_f(d1 * A, lane) + tot0;
    acl[wave * 128 + lane] = s0; acl[wave * 128 + 64 + lane] = s1; dtl[wave * 128 + lane] = d0; dtl[wave * 128 + 64 + lane] = d1;
}
__device__ __forceinline__ void ssd_stage_bc(LAS unsigned char* img, const GAS bf16* src  , int Lc, int tid) {
    const int ch = tid & 15;
#pragma unroll
    for (int q4 = 0; q4 < 4; ++q4) { const int row = (tid >> 4) + 32 * q4; v4u v = (v4u){0u, 0u, 0u, 0u}; if (row < Lc) v = *(const GAS v4u*)(src + (size_t)row * CONVD + ch * 8);
        *(LAS v4u*)(img + row * RS_BC + ch * 16) = v; }
}
__device__ __forceinline__ void ssd_stage_x(LAS unsigned char* img, const GAS bf16* src  , int Lc, int tid, const LAS float* dth, const LAS float* ach, float al, bool decay) {
    const int ch = tid & 7;
#pragma unroll
    for (int q2 = 0; q2 < 2; ++q2) { const int row = (tid >> 3) + 64 * q2; v4u o = (v4u){0u, 0u, 0u, 0u};
        if (row < Lc) { float f[8]; unpack8(*(const GAS v4u*)(src + (size_t)row * CONVD + ch * 8), f);
            const float sc = decay ? dth[row] * __expf(al - ach[row]) : dth[row];
            o = (v4u){pk2(f[0] * sc, f[1] * sc), pk2(f[2] * sc, f[3] * sc), pk2(f[4] * sc, f[5] * sc), pk2(f[6] * sc, f[7] * sc)}; }
        *(LAS v4u*)(img + row * RS_X + ch * 16) = o; }
}
__device__ __forceinline__ void ssd1_unit(LAS unsigned char* lds, int tid, const GAS bf16* XC, const GAS float* DT, const GAS float* a_log_l, GAS bf16* SB, GAS float* DEC, int b, int c, int g) {
    const int lane = tid & 63, wave = __builtin_amdgcn_readfirstlane(tid >> 6), hh = lane >> 5, col = lane & 31;
    const int t0 = c == 0 ? 0 : NMETA + 128 * (c - 1), Lc = c == 0 ? NMETA : 128; const size_t m0 = (size_t)b * LP + t0;
    LAS unsigned char* Bimg = lds; LAS unsigned char* Xw0 = lds + IMG_BC;
    LAS float* acl = (LAS float*)(lds + IMG_BC + 2 * IMG_X); LAS float* dtl = acl + 1024;
    ssd_stage_acum(acl, dtl, DT, a_log_l, m0, Lc, g, wave, lane);
    ssd_stage_bc(Bimg, XC + m0 * CONVD + DIN + g * NST, Lc, tid);
    __syncthreads();
    const int pb = wave >> 2, nb = wave & 3;
    for (int hl = 0; hl < 8; ++hl) {
        const int h = 8 * g + hl; LAS unsigned char* Xw = Xw0 + (hl & 1) * IMG_X;
        const float al = acl[hl * 128 + 127];
        ssd_stage_x(Xw, XC + m0 * CONVD + h * HP, Lc, tid, dtl + hl * 128, acl + hl * 128, al, true);
        __syncthreads();
        f32x16 acc = {};
        if (Lc == 128) {
#pragma unroll
            for (int ks = 0; ks < 8; ++ks) acc = __builtin_amdgcn_mfma_f32_32x32x16_bf16(frag_tr(Xw, RS_X, 16 * ks, 32 * pb, lane), frag_tr(Bimg, RS_BC, 16 * ks, 32 * nb, lane), acc, 0, 0, 0);
        } else acc = __builtin_amdgcn_mfma_f32_32x32x16_bf16(frag_tr(Xw, RS_X, 0, 32 * pb, lane), frag_tr(Bimg, RS_BC, 0, 32 * nb, lane), acc, 0, 0, 0);
        GAS bf16* Sp = SB + ((size_t)(b * NCH + c) * NH + h) * (HP * NST) + 32 * nb + col;
#pragma unroll
        for (int r = 0; r < 16; ++r) Sp[(32 * pb + (r & 3) + 8 * (r >> 2) + 4 * hh) * NST] = (bf16)f2bf(acc[r]);
        if (tid == 0) DEC[(b * NCH + c) * NH + h] = __expf(al);
    }
    __syncthreads();
}
__device__ __forceinline__ void ssd3_unit(LAS unsigned char* lds, int tid, const GAS bf16* XC, const GAS bf16* P1, const GAS float* DT, const GAS float* a_log_l, const GAS float* dskip_l, const GAS float* normw_l,
                                          const GAS bf16* HC, GAS bf16* YSN, int b, int c, int g) {
    const int lane = tid & 63, wave = __builtin_amdgcn_readfirstlane(tid >> 6), hh = lane >> 5, col = lane & 31;
    const int t0 = c == 0 ? 0 : NMETA + 128 * (c - 1), Lc = c == 0 ? NMETA : 128; const size_t m0 = (size_t)b * LP + t0;
    LAS unsigned char* Bimg = lds; LAS unsigned char* Cimg = lds + IMG_BC; LAS unsigned char* Mimg = lds + 2 * IMG_BC; LAS unsigned char* Ximg = lds + 3 * IMG_BC;
    LAS float* acl = (LAS float*)(lds + 3 * IMG_BC + IMG_X); LAS float* dtl = acl + 1024;
    ssd_stage_acum(acl, dtl, DT, a_log_l, m0, Lc, g, wave, lane);
    ssd_stage_bc(Bimg, XC + m0 * CONVD + DIN + g * NST, Lc, tid);
    ssd_stage_bc(Cimg, XC + m0 * CONVD + DIN + NG * NST + g * NST, Lc, tid);
    __syncthreads();
    const int ib = wave >> 1, pb = wave & 1;
    f32x16 cb[2];
    const bool live = 32 * ib < Lc;
#pragma unroll
    for (int jj = 0; jj < 2; ++jj) { const int jb = 2 * (wave & 1) + jj; cb[jj] = (f32x16){};
        if (jb <= ib && live) {
#pragma unroll
            for (int ks = 0; ks < 8; ++ks) cb[jj] = __builtin_amdgcn_mfma_f32_32x32x16_bf16(frag_row(Cimg, RS_BC, 32 * ib, 16 * ks, lane), frag_row(Bimg, RS_BC, 32 * jb, 16 * ks, lane), cb[jj], 0, 0, 0); } }
    const int xrow = tid >> 3, xch = tid & 7;
    const GAS bf16* xsrc = XC + (m0 + xrow) * CONVD + (8 * g) * HP + xch * 8;
    v4u xq0 = (v4u){0u, 0u, 0u, 0u}, xq1 = xq0;
    if (xrow < Lc) xq0 = *(const GAS v4u*)xsrc;
    if (xrow + 64 < Lc) xq1 = *(const GAS v4u*)(xsrc + (size_t)64 * CONVD);
    for (int hl = 0; hl < 8; ++hl) {
        const int h = 8 * g + hl;
        bf16x8 hf[8];
        { const GAS bf16* Hp = HC + ((size_t)(b * NCH + c) * NH + h) * (HP * NST) + pb * 4096 + lane * 8;
#pragma unroll
          for (int ks = 0; ks < 8; ++ks) hf[ks] = *(const GAS bf16x8*)(Hp + 512 * ks); }
        v4u xn0 = xq0, xn1 = xq1;
        if (hl < 7 && xrow < Lc) xn0 = *(const GAS v4u*)(xsrc + (hl + 1) * HP);
        if (hl < 7 && xrow + 64 < Lc) xn1 = *(const GAS v4u*)(xsrc + (size_t)64 * CONVD + (hl + 1) * HP);
        float ai[16];
#pragma unroll
        for (int r = 0; r < 16; ++r) ai[r] = acl[hl * 128 + 32 * ib + (r & 3) + 8 * (r >> 2) + 4 * hh];
#pragma unroll
        for (int jj = 0; jj < 2; ++jj) { const int jb = 2 * (wave & 1) + jj;
            if (jb <= ib && live) { const int j = 32 * jb + col; const float aj = acl[hl * 128 + j];
                LAS unsigned char* mp = Mimg + (32 * ib + 4 * hh) * RS_BC + j * 2;
#pragma unroll
                for (int r = 0; r < 16; ++r) { const int il = (r & 3) + 8 * (r >> 2);
                    const float v = (j <= 32 * ib + 4 * hh + il) ? cb[jj][r] * __expf(ai[r] - aj) : 0.f;
                    *(LAS unsigned short*)(mp + il * RS_BC) = (unsigned short)f2bf(v); } } }
        { const float s0 = dtl[hl * 128 + xrow], s1 = dtl[hl * 128 + 64 + xrow]; float f[8]; v4u o0, o1;
          unpack8(xq0, f); o0 = (v4u){pk2(f[0] * s0, f[1] * s0), pk2(f[2] * s0, f[3] * s0), pk2(f[4] * s0, f[5] * s0), pk2(f[6] * s0, f[7] * s0)};
          unpack8(xq1, f); o1 = (v4u){pk2(f[0] * s1, f[1] * s1), pk2(f[2] * s1, f[3] * s1), pk2(f[4] * s1, f[5] * s1), pk2(f[6] * s1, f[7] * s1)};
          *(LAS v4u*)(Ximg + xrow * RS_X + xch * 16) = o0; *(LAS v4u*)(Ximg + (xrow + 64) * RS_X + xch * 16) = o1; }
        __syncthreads();
        f32x16 a1 = {}, a2 = {};
        if (live) {
        const int nks = Lc == 128 ? 2 * (ib + 1) : 1;
        for (int ks = 0; ks < nks; ++ks) a1 = __builtin_amdgcn_mfma_f32_32x32x16_bf16(frag_row(Mimg, RS_BC, 32 * ib, 16 * ks, lane), frag_tr(Ximg, RS_X, 16 * ks, 32 * pb, lane), a1, 0, 0, 0);
#pragma unroll
        for (int ks = 0; ks < 8; ++ks) a2 = __builtin_amdgcn_mfma_f32_32x32x16_bf16(frag_row(Cimg, RS_BC, 32 * ib, 16 * ks, lane), hf[ks], a2, 0, 0, 0);
        GAS bf16* yo = YSN + (m0 + 32 * ib + 4 * hh) * DIN + h * HP + 32 * pb + col;
#pragma unroll
        for (int r = 0; r < 16; ++r) { const int il = (r & 3) + 8 * (r >> 2);
            if (32 * ib + 4 * hh + il < Lc) yo[(size_t)il * DIN] = (bf16)f2bf(a1[r] + __expf(ai[r]) * a2[r]); }
        }
        __syncthreads();
        xq0 = xn0; xq1 = xn1;
    }
    for (int i0 = wave; i0 < Lc; i0 += 4 * NWAVES) { const int c0 = g * 512 + lane * 8;
        v4u yv[4], xv[4], zv[4];
#pragma unroll
        for (int q = 0; q < 4; ++q) { const int i = i0 + NWAVES * q; const size_t m = m0 + (i < Lc ? i : i0);
            yv[q] = *(const GAS v4u*)(YSN + m * DIN + c0); xv[q] = *(const GAS v4u*)(XC + m * CONVD + c0); zv[q] = *(const GAS v4u*)(P1 + m * LDP1 + C_Z + c0); }
        const float Dh = dskip_l[c0 >> 6];
        const GAS float* wp = normw_l + c0; const f32x4 wa = *(const GAS f32x4*)wp, wb = *(const GAS f32x4*)(wp + 4);
#pragma unroll
        for (int q = 0; q < 4; ++q) { const int i = i0 + NWAVES * q;
            float v[8], x[8], z[8]; unpack8(yv[q], v); unpack8(xv[q], x); unpack8(zv[q], z); float ss = 0.f;
#pragma unroll
            for (int j = 0; j < 8; ++j) { v[j] = (v[j] + Dh * x[j]) * (z[j] * sigm(z[j])); ss += v[j] * v[j]; }
            ss = wave_sum(ss);
            const float rstd = 1.0f / sqrtf(ss * (1.0f / 512.0f) + 1e-6f);
            if (i < Lc) *(GAS v4u*)(YSN + (m0 + i) * DIN + c0) = (v4u){pk2(v[0] * rstd * wa.x, v[1] * rstd * wa.y), pk2(v[2] * rstd * wa.z, v[3] * rstd * wa.w), pk2(v[4] * rstd * wb.x, v[5] * rstd * wb.y), pk2(v[6] * rstd * wb.z, v[7] * rstd * wb.w)}; }
    }
    __syncthreads();
}

constexpr int RS_V = 528;
__device__ __forceinline__ void attn_prompt_query(LAS unsigned char* wl, const GAS bf16* P1, const GAS bf16* KVB, const GAS unsigned short* IDXP, GAS bf16* YA, int m, int lane_in) {
    int lane = lane_in; asm volatile("" : "+v"(lane));
    const int b = m / LP, t = m - b * LP, cnt = (t + 1) < 256 ? (t + 1) : 256, ntile = (cnt + 15) >> 4, nstep = (ntile + 1) >> 1;
    LAS unsigned char* Vst = wl; LAS unsigned short* idl = (LAS unsigned short*)(wl + 32 * RS_V);
    { const v2u w = *(const GAS v2u*)(IDXP + (size_t)m * 256 + 4 * lane); const int s0 = 4 * lane;
      const unsigned i0 = (s0 + 0 < cnt) ? (w.x & 0xffffu) : 0u, i1 = (s0 + 1 < cnt) ? (w.x >> 16) : 0u, i2 = (s0 + 2 < cnt) ? (w.y & 0xffffu) : 0u, i3 = (s0 + 3 < cnt) ? (w.y >> 16) : 0u;
      *(LAS v2u*)(idl + s0) = (v2u){i0 | (i1 << 16), i2 | (i3 << 16)}; }
    const int n = lane & 15, kg = lane >> 4;
    int k4 = 4 * kg; asm volatile("" : "+v"(k4));
    bf16x8 bq[8];
#pragma unroll
    for (int s = 0; s < 8; ++s) { bq[s] = (bf16x8){0, 0, 0, 0, 0, 0, 0, 0};
        if ((n >> 2) == (s >> 1)) bq[s] = *(const GAS bf16x8*)(P1 + (size_t)m * LDP1 + C_Q + n * 64 + 32 * (s & 1) + 8 * kg); }
    LDS_WAIT(); asm volatile("" ::: "memory");
    const GAS char* kvb = (const GAS char*)(KVB + (size_t)b * LP * 512);
    const unsigned voff = 512u + 16u * (lane & 31);
    f32x4 S[16];
#pragma unroll
    for (int jt = 0; jt < 16; ++jt) S[jt] = (f32x4){-INFINITY, -INFINITY, -INFINITY, -INFINITY};
    float mx = -INFINITY;
    {
        v4u kst[3][8];
#define KLOAD(dst, tile) do { _Pragma("unroll") for (int it = 0; it < 8; ++it) dst[it] = *(const GAS v4u*)(kvb + ((unsigned)idl[16 * (tile) + 2 * it + (lane >> 5)] * 1024u + 16u * (lane & 31))); } while (0)
        KLOAD(kst[0], 0);
#pragma unroll
        for (int it = 0; it < 8; ++it) { kst[1][it] = kst[0][it]; kst[2][it] = kst[0][it]; }
        if (1 < ntile) KLOAD(kst[1], 1);
        if (2 < ntile) KLOAD(kst[2], 2);
#pragma unroll
        for (int jt = 0; jt < 16; ++jt) {
            if (jt < ntile) {
                LAS unsigned char* half = Vst + 16 * (jt & 1) * RS_V;
#pragma unroll
                for (int it = 0; it < 8; ++it) *(LAS v4u*)(half + (2 * it + (lane >> 5)) * RS_V + 16 * (lane & 31)) = kst[jt % 3][it];
                LDS_WAIT(); asm volatile("" ::: "memory");
                if (jt + 3 < ntile) KLOAD(kst[jt % 3], jt + 3);
                f32x4 acc = {0.f, 0.f, 0.f, 0.f};
#pragma unroll
                for (int s8 = 0; s8 < 8; ++s8) acc = __builtin_amdgcn_mfma_f32_16x16x32_bf16(*(const LAS bf16x8*)(half + n * RS_V + (32 * s8 + 8 * kg) * 2), bq[s8], acc, 0, 0, 0);
                f32x4 sv;
#pragma unroll
                for (int i = 0; i < 4; ++i) { const float v = (k4 + i < cnt - 16 * jt) ? acc[i] * 0.125f : -INFINITY; sv[i] = v; mx = fmaxf(mx, v); }
                S[jt] = sv;
                LDS_WAIT(); asm volatile("" ::: "memory");
            }
        }
#undef KLOAD
    }
    mx = fmaxf(mx, __shfl_xor(mx, 16)); mx = fmaxf(mx, __shfl_xor(mx, 32));
    float sum = 0.f;
    v4u pa[8];
#pragma unroll
    for (int s = 0; s < 8; ++s) { float p[8];
#pragma unroll
        for (int i = 0; i < 4; ++i) { p[i] = __expf(S[2 * s][i] - mx); p[4 + i] = __expf(S[2 * s + 1][i] - mx); }
#pragma unroll
        for (int i = 0; i < 8; ++i) sum += p[i];
        pa[s] = (v4u){pk2(p[0], p[1]), pk2(p[2], p[3]), pk2(p[4], p[5]), pk2(p[6], p[7])};
        __builtin_amdgcn_sched_barrier(0); }
    sum += __shfl_xor(sum, 16); sum += __shfl_xor(sum, 32);
    const float linv = 1.0f / sum;
    asm volatile("" ::: "memory");
    v4u vst[3][8];
#define VLOAD(dst, tile) do { _Pragma("unroll") for (int it = 0; it < 8; ++it) dst[it] = *(const GAS v4u*)(kvb + ((unsigned)idl[16 * (tile) + 2 * it + (lane >> 5)] * 1024u + voff)); } while (0)
#define VSTORE(src, tt) do { _Pragma("unroll") for (int it = 0; it < 8; ++it) { const int u = 2 * it + (lane >> 5); *(LAS v4u*)(Vst + (8 * (u >> 2) + 4 * (tt) + (u & 3)) * RS_V + 16 * (lane & 31)) = src[it]; } } while (0)
    VLOAD(vst[0], 0);
#pragma unroll
    for (int it = 0; it < 8; ++it) { vst[1][it] = vst[0][it]; vst[2][it] = vst[0][it]; }
    if (1 < ntile) VLOAD(vst[1], 1);
    if (2 < ntile) VLOAD(vst[2], 2);
    f32x4 o[4];
#pragma unroll
    for (int c = 0; c < 4; ++c) o[c] = (f32x4){0.f, 0.f, 0.f, 0.f};
    const int g16 = lane >> 4, q4 = (lane & 15) >> 2, p4 = lane & 3;
    const LAS unsigned char* trb = Vst + (8 * g16 + q4) * RS_V + 8 * p4;
#pragma unroll
    for (int s = 0; s < 8; ++s) {
        if (s < nstep) {
            VSTORE(vst[(2 * s) % 3], 0);
            VSTORE(vst[(2 * s + 1) % 3], 1);
            LDS_WAIT(); asm volatile("" ::: "memory");
            if (2 * s + 3 < ntile) VLOAD(vst[(2 * s) % 3], 2 * s + 3);
            if (2 * s + 4 < ntile) VLOAD(vst[(2 * s + 1) % 3], 2 * s + 4);
#pragma unroll
            for (int g = 0; g < 4; ++g) {
                const v4u pm = ((n >> 2) == g) ? pa[s] : (v4u){0u, 0u, 0u, 0u};
                const bf16x8 pf = __builtin_bit_cast(bf16x8, pm);
#pragma unroll
                for (int c = 0; c < 4; ++c) { const int ct = 4 * g + c;
                    const s16x4 lo = ldtr(trb + 32 * ct), hi = ldtr(trb + 4 * RS_V + 32 * ct);
                    const bf16x8 bv = (bf16x8){lo[0], lo[1], lo[2], lo[3], hi[0], hi[1], hi[2], hi[3]};
                    o[c] = __builtin_amdgcn_mfma_f32_16x16x32_bf16(pf, bv, o[c], 0, 0, 0); }
            }
            LDS_WAIT(); asm volatile("" ::: "memory");
        }
    }
#undef VLOAD
#undef VSTORE
#pragma unroll
    for (int i = 0; i < 4; ++i) { const float li = __shfl(linv, 4 * kg + i);
#pragma unroll
        for (int c = 0; c < 4; ++c) YA[(size_t)m * D + (4 * kg + i) * 64 + 16 * c + n] = (bf16)f2bf(o[c][i] * li); }
}

__device__ __forceinline__ void attn_sample_query(LAS unsigned char* lds, int tid, const GAS bf16* P1, const GAS bf16* KVB, const GAS float* ck, const GAS float* cv, const GAS int* ptab, const GAS int* IDXS, GAS bf16* YA, int qi) {
    const int lane = tid & 63, wave = tid >> 6, bd = qi >> 3; const size_t m = (size_t)MP + qi;
    LAS float* Sl = (LAS float*)lds;
    LAS float* Ol = Sl + 16 * 256;
    LAS float* ql = Ol + 8 * 1024;
    LAS float* linv = ql + 1024;
    LAS int* rowsel = (LAS int*)(linv + 16);
    { const unsigned w = *(const GAS unsigned*)(P1 + m * LDP1 + C_Q + 2 * tid); ql[2 * tid] = __uint_as_float(w << 16); ql[2 * tid + 1] = __uint_as_float(w & 0xffff0000u); }
    if (tid < 256) rowsel[tid] = IDXS[qi * 256 + tid];
    __syncthreads();
    const int g = lane >> 4, c = lane & 15;
    float qr[4][4];
#pragma unroll
    for (int a = 0; a < 4; ++a) { const f32x4 t = *(const LAS f32x4*)(ql + (4 * g + a) * 64 + 4 * c); qr[a][0] = t.x; qr[a][1] = t.y; qr[a][2] = t.z; qr[a][3] = t.w; }
#pragma unroll 4
    for (int kk = 0; kk < 32; ++kk) {
        const int key = 32 * wave + kk, idx = rowsel[key];
        f32x4 kv;
        if (idx < PAST) { const int page = ptab[bd * NPAGES + (idx >> 7)]; kv = *(const GAS f32x4*)(ck + ((size_t)page * PAGE + (idx & 127)) * 256 + 4 * lane); }
        else { const v2u w = *(const GAS v2u*)(KVB + (size_t)(MP + bd * DS + (idx - PAST)) * 512 + 4 * lane);
            kv = (f32x4){__uint_as_float(w.x << 16), __uint_as_float(w.x & 0xffff0000u), __uint_as_float(w.y << 16), __uint_as_float(w.y & 0xffff0000u)}; }
        float part[4];
#pragma unroll
        for (int a = 0; a < 4; ++a) { float s = (qr[a][0] * kv.x + qr[a][1] * kv.y) + (qr[a][2] * kv.z + qr[a][3] * kv.w);
            part[a] = row16_sum(s); }
        if (c == 0) {
#pragma unroll
            for (int a = 0; a < 4; ++a) Sl[(4 * g + a) * 256 + key] = part[a] * 0.125f; }
    }
    __syncthreads();
#pragma unroll
    for (int hs = 0; hs < 2; ++hs) { const int head = 2 * wave + hs; float v[4]; float mx = -INFINITY;
#pragma unroll
        for (int j = 0; j < 4; ++j) { v[j] = Sl[head * 256 + lane + 64 * j]; mx = fmaxf(mx, v[j]); }
        mx = wave_max(mx); float sum = 0.f;
#pragma unroll
        for (int j = 0; j < 4; ++j) { v[j] = __expf(v[j] - mx); sum += v[j]; Sl[head * 256 + lane + 64 * j] = v[j]; }
        sum = wave_sum(sum);
        if (lane == 0) linv[head] = 1.0f / sum; }
    __syncthreads();
    float o[4][4];
#pragma unroll
    for (int a = 0; a < 4; ++a)
#pragma unroll
        for (int cc = 0; cc < 4; ++cc) o[a][cc] = 0.f;
#pragma unroll 4
    for (int kk = 0; kk < 32; ++kk) {
        const int key = 32 * wave + kk, idx = rowsel[key];
        f32x4 vv;
        if (idx < PAST) { const int page = ptab[bd * NPAGES + (idx >> 7)]; vv = *(const GAS f32x4*)(cv + ((size_t)page * PAGE + (idx & 127)) * 256 + 4 * lane); }
        else { const v2u w = *(const GAS v2u*)(KVB + (size_t)(MP + bd * DS + (idx - PAST)) * 512 + 256 + 4 * lane);
            vv = (f32x4){__uint_as_float(w.x << 16), __uint_as_float(w.x & 0xffff0000u), __uint_as_float(w.y << 16), __uint_as_float(w.y & 0xffff0000u)}; }
#pragma unroll
        for (int a = 0; a < 4; ++a) { const float p = Sl[(4 * g + a) * 256 + key]; o[a][0] += p * vv.x; o[a][1] += p * vv.y; o[a][2] += p * vv.z; o[a][3] += p * vv.w; }
    }
#pragma unroll
    for (int a = 0; a < 4; ++a) *(LAS f32x4*)(Ol + wave * 1024 + (4 * g + a) * 64 + 4 * c) = (f32x4){o[a][0], o[a][1], o[a][2], o[a][3]};
    __syncthreads();
    { float s0 = 0.f, s1 = 0.f;
#pragma unroll
      for (int w = 0; w < 8; ++w) { s0 += Ol[w * 1024 + 2 * tid]; s1 += Ol[w * 1024 + 2 * tid + 1]; }
      const float li = linv[(2 * tid) >> 6];
      *(GAS unsigned*)(YA + m * D + 2 * tid) = pk2(s0 * li, s1 * li); }
    __syncthreads();
}

constexpr int TAIL_R0 = 16384, TAIL_NRT = (MR - TAIL_R0) / 64;
static_assert(TAIL_R0 + 64 * TAIL_NRT == MR, "tail rows");
template <int MODE>
__device__ __forceinline__ void tail_gemm(LAS unsigned char* lds, const GAS bf16* A, int K, const GAS bf16* Bt, int N, const GAS bf16* P1, GAS bf16* T1, GAS bf16* MG, GAS float* H, GAS bf16* A2, int bx, int G, int tid) {
    constexpr int KB = 256, RS = (KB + 8) * 2;
    const int lane = tid & 63, wave = __builtin_amdgcn_readfirstlane(tid >> 6), col = lane & 31, hh = lane >> 5;
    const int nunits = TAIL_NRT * (N / 64), lr = tid >> 3, lc = tid & 7, ti = wave & 3, kh = wave >> 2;
    LAS unsigned char* As = lds; LAS unsigned char* Bs = lds + 64 * RS; LAS float* red = (LAS float*)(lds + 2 * 64 * RS);
    for (int u = bx; u < nunits; u += G) {
        const int rt = u % TAIL_NRT, ct = u / TAIL_NRT;
        const GAS bf16* ap = A + (size_t)(TAIL_R0 + 64 * rt + lr) * K + 8 * lc;
        const GAS bf16* bp = Bt + (size_t)(64 * ct + lr) * K + 8 * lc;
        v4u ra[4], rb[4];
#pragma unroll
        for (int j = 0; j < 4; ++j) { ra[j] = *(const GAS v4u*)(ap + 64 * j); rb[j] = *(const GAS v4u*)(bp + 64 * j); }
        f32x16 acc = {};
        for (int k0 = 0; k0 < K; k0 += KB) {
            __syncthreads();
#pragma unroll
            for (int j = 0; j < 4; ++j) { *(LAS v4u*)(As + lr * RS + (lc * 8 + 64 * j) * 2) = ra[j]; *(LAS v4u*)(Bs + lr * RS + (lc * 8 + 64 * j) * 2) = rb[j]; }
            if (k0 + KB < K) {
#pragma unroll
                for (int j = 0; j < 4; ++j) { ra[j] = *(const GAS v4u*)(ap + k0 + KB + 64 * j); rb[j] = *(const GAS v4u*)(bp + k0 + KB + 64 * j); } }
            __syncthreads();
#pragma unroll
            for (int j = 0; j < 8; ++j) { const int ks = 8 * kh + j;
                const bf16x8 av = *(const LAS bf16x8*)(As + (32 * (ti >> 1) + col) * RS + (16 * ks + 8 * hh) * 2), bv = *(const LAS bf16x8*)(Bs + (32 * (ti & 1) + col) * RS + (16 * ks + 8 * hh) * 2);
                acc = __builtin_amdgcn_mfma_f32_32x32x16_bf16(av, bv, acc, 0, 0, 0); }
        }
        __syncthreads();
        if (kh == 1) {
#pragma unroll
            for (int r = 0; r < 16; ++r) red[(ti * 16 + r) * 64 + lane] = acc[r]; }
        __syncthreads();
        if (kh == 0) {
            const int c = 64 * ct + 32 * (ti & 1) + col;
#pragma unroll
            for (int r = 0; r < 16; ++r) { const size_t row = TAIL_R0 + 64 * rt + 32 * (ti >> 1) + (r & 3) + 8 * (r >> 2) + 4 * hh; const float v = acc[r] + red[(ti * 16 + r) * 64 + lane];
                if (MODE == 1) { const float g = __uint_as_float((unsigned)P1[row * LDP1 + C_GS + c] << 16); T1[row * D + c] = (bf16)f2bf(v * sigm(g)); }
                if (MODE == 2) { const float g = __uint_as_float((unsigned)P1[row * LDP1 + C_GA + c] << 16); MG[row * D + c] = (bf16)f2bf(__uint_as_float((unsigned)T1[row * D + c] << 16) + v * sigm(g)); }
                if (MODE == 3) H[row * D + c] += v;
                if (MODE == 4) { const float w = fmaxf(v, 0.f); A2[row * DFF + c] = (bf16)f2bf(w * w); } }
        }
    }
    __syncthreads();
}

#ifndef REP_SEL
#define REP_SEL 1
#endif
#ifndef REP_CONV
#define REP_CONV 1
#endif
#ifndef REP_TOPK
#define REP_TOPK 1
#endif
#ifndef REP_SSC
#define REP_SSC 1
#endif
#ifndef REP_SSEL
#define REP_SSEL 1
#endif
#ifndef REP_SSD1
#define REP_SSD1 1
#endif
#ifndef REP_SREC
#define REP_SREC 1
#endif
#ifndef REP_SCAN
#define REP_SCAN 1
#endif
#ifndef REP_ATTS
#define REP_ATTS 1
#endif
#ifndef REP_ATTP
#define REP_ATTP 1
#endif
#ifndef REP_SSD3
#define REP_SSD3 1
#endif
__device__ __noinline__ void xcd_barrier_ni(unsigned* bar, unsigned x, volatile LAS unsigned* st, int tid, unsigned G) { XcdBarrier b; b.bar = bar; b.x = x; b.st = st; xcd_barrier(b, tid, G); }
__device__ __forceinline__ void assume_global(const void* p) {
#if defined(__HIP_DEVICE_COMPILE__)
    __builtin_assume(!__builtin_amdgcn_is_shared((const __attribute__((address_space(0))) void*)p));
    __builtin_assume(!__builtin_amdgcn_is_private((const __attribute__((address_space(0))) void*)p));
#else
    (void)p;
#endif
}
constexpr int NPH = 12, NPHASES = 1 + 2 * NPH;
struct Args { const void* in[24]; float* out; unsigned char* ws; int l_lo, l_hi; };
static_assert(sizeof(Args) == 24 * 8 + 8 + 8 + 8, "Args has no padding");

template <int KLO, int KHI>
__global__ void __launch_bounds__(NT, 2) fwd_t(Args args) {
    extern __shared__ __attribute__((aligned(16))) unsigned char lds_raw[];
    LAS unsigned char* lds0 = (LAS unsigned char*)lds_raw;
    volatile LAS unsigned* MISCW = (volatile LAS unsigned*)(lds0 + MISC_OFF);
    const int G = gridDim.x, bx = blockIdx.x, NGW = G * NWAVES;
    const int wave0 = __builtin_amdgcn_readfirstlane((int)threadIdx.x >> 6);
#define TID_NOW() ((wave0 << 6) | (int)__builtin_amdgcn_mbcnt_hi(~0u, __builtin_amdgcn_mbcnt_lo(~0u, 0u)))
    { const int tid0 = threadIdx.x;
      for (int u = tid0; u < (LDS_BYTES - LDSCTL_OFF) / 4; u += NT) ((LAS unsigned*)(lds0 + LDSCTL_OFF))[u] = 0u; }
    __syncthreads();
    XcdBarrier bar = xcd_barrier_post((unsigned*)(args.ws + WS_CTL) + CW_BAR, MISCW + 8);
#define IN(k) (KLO <= (k) && (k) < KHI)
#define SEAM(k) do { if (IN(k) && IN((k) + 1)) xcd_barrier_ni(bar.bar, bar.x, bar.st, TID_NOW(), (unsigned)G); } while (0)
#define PHASE_REGS \
    int tid = TID_NOW(); asm volatile("" : "+v"(tid)); \
    int bxl = bx, Gl = G; asm volatile("" : "+s"(bxl), "+s"(Gl)); (void)bxl; (void)Gl;     \
    const int lane = tid & 63, wave = __builtin_amdgcn_readfirstlane(tid >> 6), gw = bx * NWAVES + wave; \
    unsigned char* ws_ = args.ws; asm volatile("" : "+s"(ws_)); GAS unsigned char* ws = (GAS unsigned char*)ws_;     \
    float* out_ = args.out; asm volatile("" : "+s"(out_)); GAS float* out = (GAS float*)out_; \
    (void)lane; (void)gw; (void)out; \
    GAS float* H = (GAS float*)(ws + WS_H); GAS bf16* U = (GAS bf16*)(ws + WS_U); GAS bf16* P1 = (GAS bf16*)(ws + WS_P1); GAS float* MISCB = (GAS float*)(ws + WS_MISC); GAS bf16* KIB = (GAS bf16*)(ws + WS_KIB); \
    GAS bf16* XC = (GAS bf16*)(ws + WS_XC); GAS float* DT = (GAS float*)(ws + WS_DT); GAS float* DA = (GAS float*)(ws + WS_DA); GAS float* YS = (GAS float*)(ws + WS_YS); GAS bf16* YSN = (GAS bf16*)(ws + WS_YSN); \
    GAS bf16* YA = (GAS bf16*)(ws + WS_YA); GAS bf16* T1 = (GAS bf16*)(ws + WS_T1); GAS bf16* MG = (GAS bf16*)(ws + WS_MG); GAS bf16* A2 = (GAS bf16*)(ws + WS_A2); \
    GAS unsigned short* IDXP = (GAS unsigned short*)(ws + WS_IDXP); GAS int* IDXS = (GAS int*)(ws + WS_IDXS); GAS float* SCS = (GAS float*)(ws + WS_SCS); \
    GAS bf16* SB = (GAS bf16*)(ws + WS_SB); GAS float* DEC = (GAS float*)(ws + WS_DEC); GAS bf16* HC = (GAS bf16*)(ws + WS_HC); GAS bf16* KVB = (GAS bf16*)(ws + WS_KVB); GAS bf16* KIB2 = (GAS bf16*)(ws + WS_KIB2); (void)KIB2; (void)SB; (void)DEC; (void)HC; (void)KVB; \
    GAS unsigned char* wl = ws + WS_W + (size_t)l * WL_SIZE; \
    (void)H; (void)U; (void)P1; (void)MISCB; (void)KIB; (void)XC; (void)DT; (void)DA; (void)YS; (void)YSN; (void)YA; (void)T1; (void)MG; (void)A2; (void)IDXP; (void)IDXS; (void)SCS; (void)wl;
#define LDS_LOCAL LAS unsigned char* lds = lds0; asm volatile("" : "+s"(lds));
#define INP(T, name, i) const GAS T* name; { const void* p_; asm volatile("s_load_dwordx2 %0, %1, %2\n\ts_waitcnt lgkmcnt(0)" : "=s"(p_) : "s"(__builtin_amdgcn_kernarg_segment_ptr()), "i"((i) * 8)); name = (const GAS T*)p_; }

    if (IN(0) && args.l_lo == 0) {
        const int l = 0; PHASE_REGS
        LDS_LOCAL
        INP(float, w_in, 10) INP(float, w_ssm, 17) INP(float, w_att, 18) INP(float, w_out, 19) INP(float, w_up, 21) INP(float, w_down, 22) INP(float, meta, 8) INP(float, x_prompt, 0) INP(float, x_sample, 1) INP(float, norm1_w, 9)
        LAS float* scr = (LAS float*)(lds + wave * 17408);
        constexpr int I_IN = (D / 64) * (NIN / 64), I_SSM = (DIN / 64) * (D / 64), I_ATT = (D / 64) * (D / 64), I_OUT = I_ATT, I_UP = (D / 64) * (DFF / 64), I_DN = (DFF / 64) * (D / 64);
        constexpr int I_L = I_IN + I_SSM + I_ATT + I_OUT + I_UP + I_DN;
        for (int it = gw; it < 2 * I_L; it += NGW) {
            const int l = it / I_L; int r = it % I_L; GAS unsigned char* wl = ws + WS_W + (size_t)l * WL_SIZE;
            if (r < I_IN) { tr_item(w_in + (size_t)l * D * IN_DIM, D, IN_DIM, (GAS bf16*)(wl + WL_WIN), NIN / 64, true, scr, r, lane); continue; } r -= I_IN;
            if (r < I_SSM) { tr_item(w_ssm + (size_t)l * DIN * D, DIN, D, (GAS bf16*)(wl + WL_WSSM), D / 64, false, scr, r, lane); continue; } r -= I_SSM;
            if (r < I_ATT) { tr_item(w_att + (size_t)l * D * D, D, D, (GAS bf16*)(wl + WL_WATT), D / 64, false, scr, r, lane); continue; } r -= I_ATT;
            if (r < I_OUT) { tr_item(w_out + (size_t)l * D * D, D, D, (GAS bf16*)(wl + WL_WOUT), D / 64, false, scr, r, lane); continue; } r -= I_OUT;
            if (r < I_UP) { tr_item(w_up + (size_t)l * D * DFF, D, DFF, (GAS bf16*)(wl + WL_WUP), DFF / 64, false, scr, r, lane); continue; } r -= I_UP;
            tr_item(w_down + (size_t)l * DFF * D, DFF, D, (GAS bf16*)(wl + WL_WDN), D / 64, false, scr, r, lane);
        }
        for (int m0 = gw; m0 < MPAD; m0 += 4 * NGW) {
            const GAS float* src[4]; GAS float* hd[4]; GAS bf16* ud[4]; GAS float* fd[4]; bool live[4];
#pragma unroll
            for (int r = 0; r < 4; ++r) { const int m = m0 + r * NGW; live[r] = m < MPAD; src[r] = nullptr; fd[r] = nullptr; hd[r] = H + (size_t)m * D; ud[r] = U + (size_t)m * D;
                if (m < MP) { const int b = m / LP, t = m - b * LP; src[r] = t < NMETA ? meta + (size_t)t * D : x_prompt + ((size_t)b * SEQ + (t - NMETA)) * D; }
                else if (m < MR) src[r] = x_sample + (size_t)(m - MP) * D; }
            rms_rows4g(src, norm1_w, hd, ud, fd, live, lane);
        }
    }
    SEAM(0);

    for (int l = args.l_lo; l < args.l_hi; ++l) {
        constexpr int pb = 1;

        if (IN(pb + 0)) {
            PHASE_REGS
            LAS unsigned char* lds = lds0;
            pg8::Gemm gm{U, (const GAS bf16*)(wl + WL_WIN), MPAD, NIN, D}; pg8::StaticOrder S; S.init(MPAD, NIN, Gl, bxl);
            pg8::EpiIn E{P1, KVB, MISCB, KIB, KIB2, out + O_PK + (size_t)l * MP * 256, out + O_PV + (size_t)l * MP * 256, out + O_PKI + (size_t)l * MP * 64,
                         out + O_SK + (size_t)l * MS * 256, out + O_SV + (size_t)l * MS * 256, out + O_SKI + (size_t)l * MS * 64};
            pg8::gemm_phase<pg8::EpiIn, pg8::StaticOrder, true, true>(lds, gm, S, E, tid);
        }
        SEAM(pb + 0);

        if (IN(pb + 1)) {
            PHASE_REGS
            LDS_LOCAL
            INP(float, state_conv, 6) INP(float, conv_b, 12) INP(float, conv_w, 11) INP(float, dt_bias, 13) INP(float, a_log, 14) INP(float, cache_ki, 4) INP(int, page_table, 7)
            for (int rp_ = 0; rp_ < REP_CONV; ++rp_) for (int it = bx * NT + tid; it < (MR / 8) * 384; it += G * NT) {
                const int rg = it / 384, c8 = (it % 384) * 8, m0 = 8 * rg;
                const bool isS = m0 >= MP; int tpos, sq;
                if (!isS) { sq = m0 / LP; tpos = m0 - sq * LP; } else { sq = (m0 - MP) >> 3; tpos = (m0 - MP) & 7; }
                float xv[11][8];
#pragma unroll
                for (int k = 0; k < 11; ++k) { const int dtp = tpos - 3 + k;
                    if (dtp >= 0) unpack8(*(const GAS v4u*)(P1 + (size_t)(m0 - 3 + k) * LDP1 + C_XBC + c8), xv[k]);
                    else if (isS) { const GAS float* pp = state_conv + ((size_t)(l * DB + sq) * 3 + (3 + dtp)) * CONVD + c8; const f32x4 a = *(const GAS f32x4*)pp, b = *(const GAS f32x4*)(pp + 4);
                        xv[k][0] = a.x; xv[k][1] = a.y; xv[k][2] = a.z; xv[k][3] = a.w; xv[k][4] = b.x; xv[k][5] = b.y; xv[k][6] = b.z; xv[k][7] = b.w; }
                    else {
#pragma unroll
                        for (int j = 0; j < 8; ++j) xv[k][j] = 0.f; } }
                float wv[4][8], bv[8];
                { const GAS float* bp = conv_b + (size_t)l * CONVD + c8; const f32x4 a = *(const GAS f32x4*)bp, b = *(const GAS f32x4*)(bp + 4);
                  bv[0] = a.x; bv[1] = a.y; bv[2] = a.z; bv[3] = a.w; bv[4] = b.x; bv[5] = b.y; bv[6] = b.z; bv[7] = b.w; }
#pragma unroll
                for (int k = 0; k < 4; ++k) { const GAS float* wp = conv_w + ((size_t)l * 4 + k) * CONVD + c8; const f32x4 a = *(const GAS f32x4*)wp, b = *(const GAS f32x4*)(wp + 4);
                    wv[k][0] = a.x; wv[k][1] = a.y; wv[k][2] = a.z; wv[k][3] = a.w; wv[k][4] = b.x; wv[k][5] = b.y; wv[k][6] = b.z; wv[k][7] = b.w; }
#pragma unroll
                for (int r = 0; r < 8; ++r) {
                    float y[8];
#pragma unroll
                    for (int j = 0; j < 8; ++j) { float s = bv[j];
#pragma unroll
                        for (int k = 0; k < 4; ++k) s += xv[r + k][j] * wv[k][j];
                        y[j] = s * sigm(s); }
                    *(GAS v4u*)(XC + (size_t)(m0 + r) * CONVD + c8) = (v4u){pk2(y[0], y[1]), pk2(y[2], y[3]), pk2(y[4], y[5]), pk2(y[6], y[7])};
                    const int tp = tpos + r; GAS float* cs = nullptr;
                    if (!isS && tp >= LP - 3) cs = out + O_PCONV + ((size_t)(l * NB + sq) * 3 + (tp - (LP - 3))) * CONVD + c8;
                    if (isS && tp >= DS - 3) cs = out + O_SCONV + ((size_t)(l * DB + sq) * 3 + (tp - (DS - 3))) * CONVD + c8;
                    if (cs) { *(GAS f32x4*)cs = (f32x4){xv[r + 3][0], xv[r + 3][1], xv[r + 3][2], xv[r + 3][3]}; *(GAS f32x4*)(cs + 4) = (f32x4){xv[r + 3][4], xv[r + 3][5], xv[r + 3][6], xv[r + 3][7]}; }
                }
            }
            for (int it = bx * NT + tid; it < MR * NH; it += G * NT) {
                const int m = it >> 5, h = it & 31;
                const float raw = MISCB[(size_t)m * 128 + MC_DT + h] + dt_bias[l * NH + h];
                const float sp = fmaxf(raw, 0.f) + log1pf(__expf(-fabsf(raw)));
                const float A = -__expf(a_log[l * NH + h]);
                DT[it] = sp; DA[it] = __expf(sp * A);
            }
            for (int rp_ = 0; rp_ < REP_TOPK; ++rp_) {
                constexpr int SLD = 4352;
                LAS unsigned* scl = (LAS unsigned*)lds;
                for (int j = 0; ; ++j) {
                    const int unit = j * G + ((j & 1) ? (G - 1 - bx) : bx); if (unit >= NB * (LP / 8)) break;
                    const int b = unit & (NB - 1), qb = (LP / 8 - 1) - (unit >> 2);
                    const size_t mq0 = (size_t)b * LP + 8 * qb; const int nkeys = 8 * qb + 8, ntl = (nkeys + 31) >> 5;
                    bf16x8 afr[2][4]; float wq[2][2][8];
                    idx_load_q(P1, MISCB, mq0, lane, afr, wq);
                    const int kcol = lane & 31, hh = lane >> 5;
                    const GAS bf16* kp0 = KIB2 + (size_t)b * KT_PER_B * 2048 + lane * 8;
                    bf16x8 bnx[4], bn2[4];
#pragma unroll
                    for (int ks = 0; ks < 4; ++ks) { bnx[ks] = (bf16x8){0, 0, 0, 0, 0, 0, 0, 0}; bn2[ks] = bnx[ks]; }
                    if (wave < ntl) {
#pragma unroll
                        for (int ks = 0; ks < 4; ++ks) bnx[ks] = *(const GAS bf16x8*)(kp0 + (size_t)wave * 2048 + 512 * ks); }
                    if (wave + NWAVES < ntl) {
#pragma unroll
                        for (int ks = 0; ks < 4; ++ks) bn2[ks] = *(const GAS bf16x8*)(kp0 + (size_t)(wave + NWAVES) * 2048 + 512 * ks); }
                    for (int kt = wave; kt < ntl; kt += NWAVES) {
                        bf16x8 bfr[4];
#pragma unroll
                        for (int ks = 0; ks < 4; ++ks) { bfr[ks] = bnx[ks]; bnx[ks] = bn2[ks]; }
                        if (kt + 2 * NWAVES < ntl) {
#pragma unroll
                            for (int ks = 0; ks < 4; ++ks) bn2[ks] = *(const GAS bf16x8*)(kp0 + (size_t)(kt + 2 * NWAVES) * 2048 + 512 * ks); }
                        float sc[2][2];
                        idx_scores(afr, bfr, wq, sc);
                        const int key = 32 * kt + kcol;
#pragma unroll
                        for (int rt = 0; rt < 2; ++rt)
#pragma unroll
                            for (int jq = 0; jq < 2; ++jq) scl[(4 * rt + 2 * hh + jq) * SLD + key] = f2key(sc[rt][jq]);
                    }
                    __syncthreads();
                    for (int r2_ = 0; r2_ < REP_SEL; ++r2_) { const int t = 8 * qb + wave, n = t + 1; GAS unsigned short* op = IDXP + ((size_t)b * LP + t) * 256;
                      if (n <= 256) { for (int i = lane; i < n; i += 64) op[i] = (unsigned short)i; }
                      else topk_select(scl + wave * SLD, n, lane, op); }
                    __syncthreads();
                }
            }
            const GAS float* cki = cache_ki + (size_t)l * NPOOL * PAGE * 64;
            for (int rp_ = 0; rp_ < REP_SSC; ++rp_) for (int unit = bx; unit < DB * 8; unit += G) {
                const int bd = unit >> 3, ch = unit & 7; const size_t mq0 = (size_t)MP + bd * DS;
                bf16x8 afr[2][4]; float wq[2][2][8];
                idx_load_q(P1, MISCB, mq0, lane, afr, wq);
                const int kcol = lane & 31, hh = lane >> 5;
                const int pg = 8 * ch + wave, phys = page_table[bd * NPAGES + pg];
                const GAS float* kbase = cki + (size_t)phys * PAGE * 64;
#pragma unroll 1
                for (int kt = 0; kt < 4; ++kt) {
                    const int kin = 32 * kt + kcol; const GAS float* kp = kbase + (size_t)kin * 64 + 8 * hh;
                    bf16x8 bfr[4];
#pragma unroll
                    for (int ks = 0; ks < 4; ++ks) { const f32x4 a = *(const GAS f32x4*)(kp + 16 * ks), bq = *(const GAS f32x4*)(kp + 16 * ks + 4);
                        const v4u w = (v4u){pk2(a.x, a.y), pk2(a.z, a.w), pk2(bq.x, bq.y), pk2(bq.z, bq.w)}; bfr[ks] = __builtin_bit_cast(bf16x8, w); }
                    float sc[2][2];
                    idx_scores(afr, bfr, wq, sc);
#pragma unroll
                    for (int rt = 0; rt < 2; ++rt)
#pragma unroll
                        for (int jq = 0; jq < 2; ++jq) SCS[(size_t)(bd * DS + 4 * rt + 2 * hh + jq) * SCS_LD + 128 * pg + kin] = sc[rt][jq];
                }
                if (ch == 7 && wave == 0) {
                    const int j = kcol < DS ? kcol : DS - 1; const GAS bf16* kp = KIB + (mq0 + j) * 64 + 8 * hh;
                    bf16x8 bfr[4];
#pragma unroll
                    for (int ks = 0; ks < 4; ++ks) bfr[ks] = *(const GAS bf16x8*)(kp + 16 * ks);
                    float sc[2][2];
                    idx_scores(afr, bfr, wq, sc);
                    if (kcol < DS) {
#pragma unroll
                        for (int rt = 0; rt < 2; ++rt)
#pragma unroll
                            for (int jq = 0; jq < 2; ++jq) { const int q = 4 * rt + 2 * hh + jq; SCS[(size_t)(bd * DS + q) * SCS_LD + PAST + kcol] = (kcol <= q) ? sc[rt][jq] : -INFINITY; }
                    }
                }
            }
        }
        SEAM(pb + 1);

        if (IN(pb + 2)) {
            PHASE_REGS
            LDS_LOCAL
            INP(float, a_log, 14) INP(float, state_ssm, 5) INP(float, d_skip, 15)
            for (int rp_ = 0; rp_ < REP_SSEL; ++rp_) for (int qi = bx; qi < MS; qi += G) {
                LAS unsigned* scl = (LAS unsigned*)lds;
                for (int i = tid; i < PAST + DS; i += NT) scl[i] = f2key(SCS[(size_t)qi * SCS_LD + i]);
                __syncthreads();
                if (wave == 0) { int ns = PAST + DS; asm volatile("" : "+s"(ns)); topk_select(scl, ns, lane, IDXS + qi * 256); }
                __syncthreads();
            }
            for (int rp_ = 0; rp_ < REP_SSD1; ++rp_) for (int unit = bx; unit < NB * NCH * NG; unit += G) {
                int b, c, g; if (unit < NB * 32 * NG) { b = unit >> 7; c = 1 + ((unit & 127) >> 2); g = unit & 3; } else { const int r = unit - NB * 32 * NG; b = r >> 2; c = 0; g = r & 3; }
                ssd1_unit(lds, tid, XC, DT, a_log + l * NH, SB, DEC, b, c, g);
            }
            for (int rp_ = 0; rp_ < REP_SREC; ++rp_) for (int unit = bx; unit < DB * NH * 2; unit += G) {
                const int bd = unit >> 6, h = (unit >> 1) & 31, p0 = (unit & 1) * 32;
                ssd_unit(lds, tid, XC, DT, DA, (size_t)MP + bd * DS, DS, h, p0, state_ssm + ((size_t)(l * DB + bd) * NH + h) * HP * NST,
                         out + O_SSSM + ((size_t)(l * DB + bd) * NH + h) * HP * NST, YS, d_skip[l * NH + h]);
                __syncthreads();
            }
        }
        SEAM(pb + 2);

        if (IN(pb + 3)) {
            PHASE_REGS
            LDS_LOCAL
            INP(float, cache_k, 2) INP(float, cache_v, 3) INP(int, page_table, 7)
            for (int rp_ = 0; rp_ < REP_SCAN; ++rp_) for (int e = bx * NT + tid; e < NB * NH * 2048; e += G * NT) {
                const int b = e / (NH * 2048), h = (e >> 11) & 31, q = e & 2047;
                f32x4 Hr = {0.f, 0.f, 0.f, 0.f};
#pragma unroll 3
                for (int c = 0; c < NCH; ++c) { const size_t idx = (size_t)(b * NCH + c) * NH + h;
                    { const int p = q >> 5, n = (q & 31) * 4;
                      *(GAS v2u*)(HC + idx * (HP * NST) + ((((p >> 5) * 8 + (n >> 4)) * 2 + ((n >> 3) & 1)) * 32 + (p & 31)) * 8 + (n & 7)) = (v2u){pk2(Hr.x, Hr.y), pk2(Hr.z, Hr.w)}; }
                    const float d = DEC[idx]; const v2u sw = *(const GAS v2u*)(SB + idx * (HP * NST) + q * 4);
                    const f32x4 sv = (f32x4){__uint_as_float(sw.x << 16), __uint_as_float(sw.x & 0xffff0000u), __uint_as_float(sw.y << 16), __uint_as_float(sw.y & 0xffff0000u)};
                    Hr = Hr * d + sv; }
                *(GAS f32x4*)(out + O_PSSM + ((size_t)(l * NB + b) * NH + h) * (HP * NST) + q * 4) = Hr;
            }
            const GAS float* ck = cache_k + (size_t)l * NPOOL * PAGE * 256; const GAS float* cv = cache_v + (size_t)l * NPOOL * PAGE * 256;
            for (int rp_ = 0; rp_ < REP_ATTS; ++rp_) for (int qi = bx; qi < MS; qi += G) attn_sample_query(lds, tid, P1, KVB, ck, cv, page_table, IDXS, YA, qi);
            for (int rp_ = 0; rp_ < REP_ATTP; ++rp_) {
                if (Gl == 256) {
                    const int bsel = (bxl & 7) >> 1, widx = ((((bxl >> 3) * NWAVES) + wave) << 1) | (bxl & 1);
                    for (int tr = widx; tr < LP; tr += 512) attn_prompt_query(lds + wave * 17408, P1, KVB, IDXP, YA, bsel * LP + (LP - 1 - tr), lane);
                } else for (int m = gw; m < MP; m += NGW) attn_prompt_query(lds + wave * 17408, P1, KVB, IDXP, YA, m, lane);
            }
        }
        SEAM(pb + 3);

        if (IN(pb + 4)) {
            PHASE_REGS
            LDS_LOCAL
            INP(float, a_log, 14) INP(float, d_skip, 15) INP(float, ssm_norm_w, 16)
            for (int rp_ = 0; rp_ < REP_SSD3; ++rp_) for (int unit = bx; unit < NB * NCH * NG; unit += G) {
                int b, c, g; if (unit < NB * 32 * NG) { b = unit >> 7; c = 1 + ((unit & 127) >> 2); g = unit & 3; } else { const int r = unit - NB * 32 * NG; b = r >> 2; c = 0; g = r & 3; }
                ssd3_unit(lds, tid, XC, P1, DT, a_log + l * NH, d_skip + l * NH, ssm_norm_w + (size_t)l * DIN, HC, YSN, b, c, g);
            }
            for (int it = gw; it < MS * NG; it += NGW) {
                const int m = MP + (it >> 2), g = it & 3, c0 = g * 512 + lane * 8;
                const GAS float* yp = YS + (size_t)m * DIN + c0; const f32x4 a = *(const GAS f32x4*)yp, b = *(const GAS f32x4*)(yp + 4);
                float z[8]; unpack8(*(const GAS v4u*)(P1 + (size_t)m * LDP1 + C_Z + c0), z);
                float v[8] = {a.x, a.y, a.z, a.w, b.x, b.y, b.z, b.w}; float ss = 0.f;
#pragma unroll
                for (int j = 0; j < 8; ++j) { v[j] = v[j] * (z[j] * sigm(z[j])); ss += v[j] * v[j]; }
                ss = wave_sum(ss);
                const float rstd = 1.0f / sqrtf(ss * (1.0f / 512.0f) + 1e-6f);
                const GAS float* wp = ssm_norm_w + (size_t)l * DIN + c0; const f32x4 wa = *(const GAS f32x4*)wp, wb = *(const GAS f32x4*)(wp + 4);
                *(GAS v4u*)(YSN + (size_t)m * DIN + c0) = (v4u){pk2(v[0] * rstd * wa.x, v[1] * rstd * wa.y), pk2(v[2] * rstd * wa.z, v[3] * rstd * wa.w), pk2(v[4] * rstd * wb.x, v[5] * rstd * wb.y), pk2(v[6] * rstd * wb.z, v[7] * rstd * wb.w)};
            }
        }
        SEAM(pb + 4);

        if (IN(pb + 5)) {
            PHASE_REGS
            LAS unsigned char* lds = lds0;
            pg8::Gemm gm{YSN, (const GAS bf16*)(wl + WL_WSSM), TAIL_R0, D, DIN}; pg8::StaticOrder S; S.init(TAIL_R0, D, Gl, bxl);
            pg8::EpiGate1 E{P1, T1};
            pg8::gemm_phase<pg8::EpiGate1, pg8::StaticOrder, true, true>(lds, gm, S, E, tid);
            tail_gemm<1>(lds, YSN, DIN, (const GAS bf16*)(wl + WL_WSSM), D, P1, T1, MG, H, A2, bxl, Gl, tid);
        }
        if (IN(pb + 6)) {
            PHASE_REGS
            LAS unsigned char* lds = lds0;
            pg8::Gemm gm{YA, (const GAS bf16*)(wl + WL_WATT), TAIL_R0, D, D}; pg8::StaticOrder S; S.init(TAIL_R0, D, Gl, bxl);
            pg8::EpiGate2 E{P1, T1, MG};
            pg8::gemm_phase<pg8::EpiGate2, pg8::StaticOrder, true, true>(lds, gm, S, E, tid);
            tail_gemm<2>(lds, YA, D, (const GAS bf16*)(wl + WL_WATT), D, P1, T1, MG, H, A2, bxl, Gl, tid);
        }
        SEAM(pb + 6);
        if (IN(pb + 7)) {
            PHASE_REGS
            LAS unsigned char* lds = lds0;
            pg8::Gemm gm{MG, (const GAS bf16*)(wl + WL_WOUT), TAIL_R0, D, D}; pg8::StaticOrder S; S.init(TAIL_R0, D, Gl, bxl);
            pg8::EpiResid E{H};
            pg8::gemm_phase<pg8::EpiResid, pg8::StaticOrder, true, true>(lds, gm, S, E, tid);
            tail_gemm<3>(lds, MG, D, (const GAS bf16*)(wl + WL_WOUT), D, P1, T1, MG, H, A2, bxl, Gl, tid);
        }
        SEAM(pb + 7);
        if (IN(pb + 8)) {
            PHASE_REGS
            INP(float, norm2_w, 20)
            for (int m = gw; m < MPAD; m += 4 * NGW) rms_rows4(H, norm2_w + (size_t)l * D, U, m, NGW, MPAD, lane);
        }
        SEAM(pb + 8);
        if (IN(pb + 9)) {
            PHASE_REGS
            LAS unsigned char* lds = lds0;
            pg8::Gemm gm{U, (const GAS bf16*)(wl + WL_WUP), TAIL_R0, DFF, D}; pg8::StaticOrder S; S.init(TAIL_R0, DFF, Gl, bxl);
            pg8::EpiUp E{A2};
            pg8::gemm_phase<pg8::EpiUp, pg8::StaticOrder, true, true>(lds, gm, S, E, tid);
            tail_gemm<4>(lds, U, D, (const GAS bf16*)(wl + WL_WUP), DFF, P1, T1, MG, H, A2, bxl, Gl, tid);
        }
        SEAM(pb + 9);
        if (IN(pb + 10)) {
            PHASE_REGS
            LAS unsigned char* lds = lds0;
            pg8::Gemm gm{A2, (const GAS bf16*)(wl + WL_WDN), TAIL_R0, D, DFF}; pg8::StaticOrder S; S.init(TAIL_R0, D, Gl, bxl);
            pg8::EpiResid E{H};
            pg8::gemm_phase<pg8::EpiResid, pg8::StaticOrder, true, true>(lds, gm, S, E, tid);
            tail_gemm<3>(lds, A2, DFF, (const GAS bf16*)(wl + WL_WDN), D, P1, T1, MG, H, A2, bxl, Gl, tid);
        }
        SEAM(pb + 10);
        if (IN(pb + 11)) {
            PHASE_REGS
            INP(float, norm1_w, 9) INP(float, final_w, 23)
            if (l == 0) { for (int m = gw; m < MPAD; m += 4 * NGW) rms_rows4(H, norm1_w + D, U, m, NGW, MPAD, lane); }
            else {
                for (int m0 = gw; m0 < MR; m0 += 4 * NGW) {
                    const GAS float* src[4]; GAS float* hd[4]; GAS bf16* ud[4]; GAS float* fd[4]; bool live[4];
#pragma unroll
                    for (int r = 0; r < 4; ++r) { const int m = m0 + r * NGW; hd[r] = nullptr; ud[r] = nullptr; fd[r] = nullptr; src[r] = H + (size_t)(m < MR ? m : m0) * D;
                        if (m < MP) { const int b = m / LP, t = m - b * LP; if (t >= NMETA) fd[r] = out + O_YP + ((size_t)b * SEQ + (t - NMETA)) * D; }
                        else if (m < MR) fd[r] = out + O_YS + (size_t)(m - MP) * D;
                        live[r] = fd[r] != nullptr; }
                    rms_rows4g(src, final_w, hd, ud, fd, live, lane);
                }
            }
        }
        if (IN(pb + 11) && IN(1) && l + 1 < args.l_hi) xcd_barrier_ni(bar.bar, bar.x, bar.st, TID_NOW(), (unsigned)G);
    }
#undef IN
#undef SEAM
}

#ifndef MK_PER_PHASE
#define MK_PER_PHASE 0
#endif
extern "C" void kernel_launch(void* const* d_in, const int* in_sizes, int n_in, void* d_out, int out_size, void* d_ws, size_t ws_size, hipStream_t stream) {
    static int grid = 0;
    if (grid == 0) {
        if (n_in != 24 || (size_t)out_size != O_END || ws_size < WS_END) { fprintf(stderr, "kernel_launch: unexpected shapes: n_in %d out %d (want %zu) ws %zu (want %zu)\n", n_in, out_size, (size_t)O_END, ws_size, (size_t)WS_END); grid = -1; return; }
        int dev = 0, cus = 0, per_cu = 0;
        if (hipGetDevice(&dev) != hipSuccess || hipDeviceGetAttribute(&cus, hipDeviceAttributeMultiprocessorCount, dev) != hipSuccess) { grid = -1; return; }
        bool ok = true;
#if MK_PER_PHASE
#define SETA(K) ok = ok && hipFuncSetAttribute((const void*)fwd_t<K, K + 1>, hipFuncAttributeMaxDynamicSharedMemorySize, LDS_BYTES) == hipSuccess
        SETA(0); SETA(1); SETA(2); SETA(3); SETA(4); SETA(5); SETA(6); SETA(7); SETA(8); SETA(9); SETA(10); SETA(11); SETA(12);
#else
        ok = hipFuncSetAttribute((const void*)fwd_t<0, NPH + 1>, hipFuncAttributeMaxDynamicSharedMemorySize, LDS_BYTES) == hipSuccess;
        ok = ok && hipOccupancyMaxActiveBlocksPerMultiprocessor(&per_cu, (const void*)fwd_t<0, NPH + 1>, NT, LDS_BYTES) == hipSuccess && per_cu >= 1;
#endif
        if (!ok) { fprintf(stderr, "kernel_launch: hipFuncSetAttribute / occupancy query failed (per_cu %d)\n", per_cu); (void)hipGetLastError(); grid = -1; return; }
        grid = cus;
    }
    if (grid < 0) return;
    (void)hipMemsetAsync((char*)d_ws + WS_CTL, 0, CTL_ZERO_BYTES, stream);
    Args a{};
    for (int i = 0; i < 24; ++i) a.in[i] = d_in[i];
    a.out = (float*)d_out; a.ws = (unsigned char*)d_ws;
#if MK_PER_PHASE
#define LAUNCH_PH(K) hipLaunchKernelGGL((fwd_t<K, K + 1>), dim3(grid), dim3(NT), LDS_BYTES, stream, a)
    a.l_lo = 0; a.l_hi = 1; LAUNCH_PH(0);
    for (int l = 0; l < 2; ++l) { a.l_lo = l; a.l_hi = l + 1;
        LAUNCH_PH(1); LAUNCH_PH(2); LAUNCH_PH(3); LAUNCH_PH(4); LAUNCH_PH(5); LAUNCH_PH(6); LAUNCH_PH(7); LAUNCH_PH(8); LAUNCH_PH(9); LAUNCH_PH(10); LAUNCH_PH(11); LAUNCH_PH(12); }
#else
    a.l_lo = 0; a.l_hi = 2; hipLaunchKernelGGL((fwd_t<0, NPH + 1>), dim3(grid), dim3(NT), LDS_BYTES, stream, a);
#endif
}
```

```cpp
#include <hip/hip_runtime.h>
#include <cstdio>
#include <cstdint>
#define GAS __attribute__((address_space(1)))
#define LAS __attribute__((address_space(3)))

constexpr int D = 1024, NB = 4, SEQ = 4096, NMETA = 16, LP = SEQ + NMETA, MP = NB * LP, DB = 32, DS = 8, MS = DB * DS, MR = MP + MS, MPAD = 16896;
constexpr int DIN = 2048, CONVD = 3072, NH = 32, HP = 64, NG = 4, NST = 128;
constexpr int DFF = 4096, IN_DIM = 9320;
constexpr int PAST = 8192, PAGE = 128, NPAGES = 64, NPOOL = 2560;
constexpr int NIN = 9472, LDP1 = 9216;
constexpr int C_Z = 0, C_XBC = 2048, C_Q = 5120, C_K = 6144, C_V = 6400, C_QI = 6656, C_GS = 7168, C_GA = 8192;
constexpr int MC_KI = 0, MC_DT = 64, MC_WI = 96;
constexpr int KT_PER_B = (LP + 31) / 32;
static_assert(MP == 16448 && MR == 16704 && MPAD % 256 == 0 && MPAD >= MR, "rows");
namespace pg8 {
#define PG8_LAS __attribute__((address_space(3)))
typedef unsigned short bf16_t;
typedef short bf16x8 __attribute__((ext_vector_type(8)));
typedef float f32x4 __attribute__((ext_vector_type(4)));
typedef unsigned u32x4 __attribute__((ext_vector_type(4)));
constexpr int BM = 256, BK = 64, HALF = 128, HTB = HALF * BK * 2  , STAGE_BYTES = 8 * HTB, NXCD = 8, WGM = 8;

__host__ __device__ __forceinline__ int lds_byte(int r, int c) { const int st = (r >> 4) * 2 + (c >> 5), rr = r & 15, cc = c & 31, ob = rr * 64 + cc * 2; return st * 1024 + (ob ^ (((ob >> 9) & 1) << 5)); }
__host__ __device__ __forceinline__ void stage_rc(int b, int& R, int& C) { const int st = b / 1024, sb = b % 1024, swz = sb ^ (((sb >> 9) & 1) << 5); R = (st >> 1) * 16 + swz / 64; C = (st & 1) * 32 + (swz % 64) / 2; }
__host__ __device__ __forceinline__ int perm32(int rho) { const int n = rho >> 4, i = rho & 15; return 8 * (i >> 2) + 4 * n + (i & 3); }

struct Unit { int pm, pn; };
struct Gemm { const GAS bf16_t* A; const GAS bf16_t* Bt; int M, N, K; };

struct StaticOrder {
    int nM, nN, nwg, G, c;
    __host__ __device__ void init(int M, int N, int G_, int c_) { nM = M / BM; nN = N / BM; nwg = nM * nN; G = G_; c = c_; }
    __host__ __device__ bool next(int i, Unit& u) const {
        const long L = (long)i * G + c; if (L >= nwg) return false;
        int wgid = (int)L; { const int q = nwg / NXCD, r = nwg % NXCD, xcd = wgid % NXCD, off = wgid / NXCD; wgid = (xcd < r ? xcd * (q + 1) : r * (q + 1) + (xcd - r) * q) + off; }
        const int nig = WGM * nN, gid = wgid / nig, fm = gid * WGM, gsz = (nM - fm) < WGM ? (nM - fm) : WGM;
        u.pm = fm + ((wgid % nig) % gsz); u.pn = (wgid % nig) / gsz; return true;
    }
    __device__ __forceinline__ void a_ready(const Unit&) const {}
    __device__ __forceinline__ void done(const Unit&) const {}
};

__device__ __forceinline__ unsigned cvt_pk_bf16(float lo, float hi) { unsigned r; asm volatile("v_cvt_pk_bf16_f32 %0, %1, %2" : "=v"(r) : "v"(lo), "v"(hi)); return r; }

__device__ __forceinline__ void unpack8(const u32x4 w, float (&f)[8]) {
    f[0] = __uint_as_float(w.x << 16); f[1] = __uint_as_float(w.x & 0xffff0000u); f[2] = __uint_as_float(w.y << 16); f[3] = __uint_as_float(w.y & 0xffff0000u);
    f[4] = __uint_as_float(w.z << 16); f[5] = __uint_as_float(w.z & 0xffff0000u); f[6] = __uint_as_float(w.w << 16); f[7] = __uint_as_float(w.w & 0xffff0000u);
}
__device__ __forceinline__ u32x4 pack8(const f32x4 v0, const f32x4 v1) { u32x4 w; w.x = cvt_pk_bf16(v0[0], v0[1]); w.y = cvt_pk_bf16(v0[2], v0[3]); w.z = cvt_pk_bf16(v1[0], v1[1]); w.w = cvt_pk_bf16(v1[2], v1[3]); return w; }
__device__ __forceinline__ float sigm(float x) { return __builtin_amdgcn_rcpf(1.0f + __expf(-x)); }

struct EpiIn {
    static constexpr bool PERM = true, AFTER_DRAIN = false;
    GAS bf16_t* P1; GAS bf16_t* kvb; GAS float* misc; GAS bf16_t* kib; GAS bf16_t* kib2; GAS float *pk, *pv, *pki, *sk, *sv, *ski;
    __device__ __forceinline__ void operator()(const f32x4 (&acc)[2][2][4][2], const Unit& u, int wr, int wc, int fr, int fq) const {
        const int row0 = u.pm * BM + wr * 64 + fr, lc0 = wc * 32 + 8 * fq;
#pragma unroll
        for (int ai = 0; ai < 2; ++ai)
#pragma unroll
            for (int m = 0; m < 4; ++m) {
                const int row = row0 + ai * HALF + m * 16;
#pragma unroll
                for (int bj = 0; bj < 2; ++bj) {
                    const f32x4 v0 = acc[ai][bj][m][0], v1 = acc[ai][bj][m][1];
                    const int lc = lc0 + bj * HALF;
                    if (u.pn < 36) {
                        if (u.pn == 24 || u.pn == 25) *(GAS u32x4*)(kvb + (size_t)row * 512 + (u.pn - 24) * BM + lc) = pack8(v0, v1);
                        else *(GAS u32x4*)(P1 + (size_t)row * LDP1 + u.pn * BM + lc) = pack8(v0, v1);
                        if (u.pn == 24) {
                            if (row < MP) { GAS float* dst = pk + (size_t)row * 256 + lc; *(GAS f32x4*)dst = v0; *(GAS f32x4*)(dst + 4) = v1; }
                            else if (row < MR) { GAS float* dst = sk + (size_t)(row - MP) * 256 + lc; *(GAS f32x4*)dst = v0; *(GAS f32x4*)(dst + 4) = v1; }
                        } else if (u.pn == 25) {
                            if (row < MP) { GAS float* dst = pv + (size_t)row * 256 + lc; *(GAS f32x4*)dst = v0; *(GAS f32x4*)(dst + 4) = v1; }
                            else if (row < MR) { GAS float* dst = sv + (size_t)(row - MP) * 256 + lc; *(GAS f32x4*)dst = v0; *(GAS f32x4*)(dst + 4) = v1; }
                        }
                    } else {
                        if (lc < 128) { GAS float* d = misc + (size_t)row * 128 + lc; *(GAS f32x4*)d = v0; *(GAS f32x4*)(d + 4) = v1; }
                        if (lc < 64) {
                            *(GAS u32x4*)(kib + (size_t)row * 64 + lc) = pack8(v0, v1);
                            if (row < MP) { const int b = row / LP, t = row - b * LP;
                                *(GAS u32x4*)(kib2 + ((size_t)(b * KT_PER_B + (t >> 5)) * 2048 + (lc >> 4) * 512 + ((lc >> 3) & 1) * 256 + (t & 31) * 8)) = pack8(v0, v1); }
                            if (row < MP) { GAS float* dst = pki + (size_t)row * 64 + lc; *(GAS f32x4*)dst = v0; *(GAS f32x4*)(dst + 4) = v1; }
                            else if (row < MR) { GAS float* dst = ski + (size_t)(row - MP) * 64 + lc; *(GAS f32x4*)dst = v0; *(GAS f32x4*)(dst + 4) = v1; }
                        }
                    }
                }
            }
    }
};
struct EpiGate1 {
    static constexpr bool PERM = true, AFTER_DRAIN = false;
    const GAS bf16_t* P1; GAS bf16_t* T1;
    __device__ __forceinline__ void operator()(const f32x4 (&acc)[2][2][4][2], const Unit& u, int wr, int wc, int fr, int fq) const {
        const int row0 = u.pm * BM + wr * 64 + fr, col0 = u.pn * BM + wc * 32 + 8 * fq;
#pragma unroll
        for (int ai = 0; ai < 2; ++ai)
#pragma unroll
            for (int m = 0; m < 4; ++m) {
                const int row = row0 + ai * HALF + m * 16;
#pragma unroll
                for (int bj = 0; bj < 2; ++bj) {
                    const int col = col0 + bj * HALF;
                    float g[8]; unpack8(*(const GAS u32x4*)(P1 + (size_t)row * LDP1 + C_GS + col), g);
                    f32x4 v0 = acc[ai][bj][m][0], v1 = acc[ai][bj][m][1];
#pragma unroll
                    for (int e = 0; e < 4; ++e) { v0[e] *= sigm(g[e]); v1[e] *= sigm(g[4 + e]); }
                    *(GAS u32x4*)(T1 + (size_t)row * 1024 + col) = pack8(v0, v1);
                }
            }
    }
};
struct EpiGate2 {
    static constexpr bool PERM = true, AFTER_DRAIN = false;
    const GAS bf16_t* P1; const GAS bf16_t* T1; GAS bf16_t* MG;
    __device__ __forceinline__ void operator()(const f32x4 (&acc)[2][2][4][2], const Unit& u, int wr, int wc, int fr, int fq) const {
        const int row0 = u.pm * BM + wr * 64 + fr, col0 = u.pn * BM + wc * 32 + 8 * fq;
#pragma unroll
        for (int ai = 0; ai < 2; ++ai)
#pragma unroll
            for (int m = 0; m < 4; ++m) {
                const int row = row0 + ai * HALF + m * 16;
#pragma unroll
                for (int bj = 0; bj < 2; ++bj) {
                    const int col = col0 + bj * HALF;
                    float g[8]; unpack8(*(const GAS u32x4*)(P1 + (size_t)row * LDP1 + C_GA + col), g);
                    float tt[8]; unpack8(*(const GAS u32x4*)(T1 + (size_t)row * 1024 + col), tt); const f32x4 t0 = (f32x4){tt[0], tt[1], tt[2], tt[3]}, t1 = (f32x4){tt[4], tt[5], tt[6], tt[7]};
                    f32x4 v0 = acc[ai][bj][m][0], v1 = acc[ai][bj][m][1];
#pragma unroll
                    for (int e = 0; e < 4; ++e) { v0[e] = t0[e] + v0[e] * sigm(g[e]); v1[e] = t1[e] + v1[e] * sigm(g[4 + e]); }
                    *(GAS u32x4*)(MG + (size_t)row * 1024 + col) = pack8(v0, v1);
                }
            }
    }
};
struct EpiResid {
    static constexpr bool PERM = true, AFTER_DRAIN = false;
    GAS float* H;
    __device__ __forceinline__ void operator()(const f32x4 (&acc)[2][2][4][2], const Unit& u, int wr, int wc, int fr, int fq) const {
        const int row0 = u.pm * BM + wr * 64 + fr, col0 = u.pn * BM + wc * 32 + 8 * fq;
#pragma unroll
        for (int ai = 0; ai < 2; ++ai)
#pragma unroll
            for (int m = 0; m < 4; ++m) {
                const int row = row0 + ai * HALF + m * 16;
#pragma unroll
                for (int bj = 0; bj < 2; ++bj) {
                    GAS float* d = H + (size_t)row * 1024 + col0 + bj * HALF;
                    const f32x4 h0 = *(const GAS f32x4*)d, h1 = *(const GAS f32x4*)(d + 4);
                    *(GAS f32x4*)d = h0 + acc[ai][bj][m][0]; *(GAS f32x4*)(d + 4) = h1 + acc[ai][bj][m][1];
                }
            }
    }
};
struct EpiUp {
    static constexpr bool PERM = true, AFTER_DRAIN = false;
    GAS bf16_t* A2;
    __device__ __forceinline__ void operator()(const f32x4 (&acc)[2][2][4][2], const Unit& u, int wr, int wc, int fr, int fq) const {
        const int row0 = u.pm * BM + wr * 64 + fr, col0 = u.pn * BM + wc * 32 + 8 * fq;
#pragma unroll
        for (int ai = 0; ai < 2; ++ai)
#pragma unroll
            for (int m = 0; m < 4; ++m) {
                const int row = row0 + ai * HALF + m * 16;
#pragma unroll
                for (int bj = 0; bj < 2; ++bj) {
                    f32x4 v0 = acc[ai][bj][m][0], v1 = acc[ai][bj][m][1];
#pragma unroll
                    for (int e = 0; e < 4; ++e) { const float a = fmaxf(v0[e], 0.f), b = fmaxf(v1[e], 0.f); v0[e] = a * a; v1[e] = b * b; }
                    *(GAS u32x4*)(A2 + (size_t)row * DFF + col0 + bj * HALF) = pack8(v0, v1);
                }
            }
    }
};
template <class Epi, class Sched, bool ALIGN_EPI = false, bool SP2 = false>
__device__ __forceinline__ void gemm_phase(PG8_LAS unsigned char* lds, const Gemm g, const Sched& S, const Epi& E, const int tid) {
    const int wid = __builtin_amdgcn_readfirstlane(tid >> 6), lane = tid & 63, wr = wid >> 2, wc = wid & 3, fr = lane & 15, fq = lane >> 4;
    const int K = g.K, nt = K / BK;
    unsigned voffA[2], voffB[2];
#pragma unroll
    for (int i = 0; i < 2; ++i) { int R, C; stage_rc(tid * 16 + i * 8192, R, C); const int Rb = Epi::PERM ? ((R & ~31) + perm32(R & 31)) : R;
        voffA[i] = (unsigned)(R * K + C) * 2u; voffB[i] = (unsigned)(Rb * K + C) * 2u; }
    const size_t kstep = (size_t)(BK * 2);
    const size_t hstep = (size_t)HALF * K * 2;
    const size_t tstep = 2 * hstep;
    const unsigned ldsw = (unsigned)wid * 1024u;
    const int aoff = lds_byte(wr * 64 + fr, fq * 8), boff = lds_byte(wc * 32 + fr, fq * 8);
#define PG8_SA(b, h) (((b) * 2 + (h)) * HTB)
#define PG8_SB(b, h) ((4 + (b) * 2 + (h)) * HTB)
#define PG8_STAGE(bufoff, gbase, voff) do { _Pragma("unroll") for (int _i = 0; _i < 2; ++_i) \
        __builtin_amdgcn_global_load_lds((const GAS unsigned*)((const GAS char*)(gbase) + (voff)[_i]), (PG8_LAS unsigned*)(lds + (bufoff) + ldsw + _i * 8192), 16, 0, 0); } while (0)
#define PG8_LDA(dst, b, h) do { _Pragma("unroll") for (int m = 0; m < 4; ++m) _Pragma("unroll") for (int k = 0; k < 2; ++k) dst[m][k] = *(const PG8_LAS bf16x8*)(lds + PG8_SA(b, h) + aoff + m * 2048 + k * 1024); } while (0)
#define PG8_LDB(dst, b, h) do { _Pragma("unroll") for (int n = 0; n < 2; ++n) _Pragma("unroll") for (int k = 0; k < 2; ++k) dst[n][k] = *(const PG8_LAS bf16x8*)(lds + PG8_SB(b, h) + boff + n * 2048 + k * 1024); } while (0)
#define PG8_MMA(ai, bj, At, Bt) do { __builtin_amdgcn_s_setprio(1); _Pragma("unroll") for (int m = 0; m < 4; ++m) _Pragma("unroll") for (int n = 0; n < 2; ++n) _Pragma("unroll") for (int k = 0; k < 2; ++k) \
        acc[ai][bj][m][n] = __builtin_amdgcn_mfma_f32_16x16x32_bf16(Bt[n][k], At[m][k], acc[ai][bj][m][n], 0, 0, 0); __builtin_amdgcn_s_setprio(0); } while (0)
#define PG8_WAIT_V(n) asm volatile("s_waitcnt vmcnt(" #n ")" ::: "memory")
#define PG8_WAIT_L(n) asm volatile("s_waitcnt lgkmcnt(" #n ")" ::: "memory")
#define PG8_BAR __builtin_amdgcn_s_barrier()
#define PG8_SCHED __builtin_amdgcn_sched_barrier(0)
    Unit cur, nxt; int ui = 0;
    if (!S.next(0, cur)) return;
    f32x4 acc[2][2][4][2];
#pragma unroll
    for (int a = 0; a < 2; ++a)
#pragma unroll
        for (int b = 0; b < 2; ++b)
#pragma unroll
            for (int m = 0; m < 4; ++m)
#pragma unroll
                for (int n = 0; n < 2; ++n) acc[a][b][m][n] = (f32x4){0.f, 0.f, 0.f, 0.f};
    bf16x8 At[4][2], B0[2][2], B1[2][2];
    const GAS char* cA = (const GAS char*)g.A + (size_t)cur.pm * tstep; const GAS char* cB = (const GAS char*)g.Bt + (size_t)cur.pn * tstep;
    S.a_ready(cur);
    if constexpr (SP2) {
        PG8_STAGE(PG8_SB(0, 0), cB, voffB); PG8_STAGE(PG8_SB(0, 1), cB + hstep, voffB); PG8_STAGE(PG8_SA(0, 0), cA, voffA); PG8_STAGE(PG8_SA(0, 1), cA + hstep, voffA);
        if (wr == 1) PG8_BAR;
        PG8_WAIT_V(2); PG8_BAR;
        PG8_STAGE(PG8_SB(1, 0), cB + kstep, voffB); PG8_STAGE(PG8_SA(1, 0), cA + kstep, voffA); PG8_STAGE(PG8_SB(1, 1), cB + hstep + kstep, voffB);
        PG8_WAIT_V(6); PG8_BAR;
    } else {
        PG8_STAGE(PG8_SB(0, 0), cB, voffB); PG8_STAGE(PG8_SA(0, 0), cA, voffA); PG8_STAGE(PG8_SB(0, 1), cB + hstep, voffB); PG8_STAGE(PG8_SA(0, 1), cA + hstep, voffA);
        if (wr == 1) PG8_BAR;
        PG8_WAIT_V(4); PG8_BAR;
        PG8_STAGE(PG8_SB(1, 0), cB + kstep, voffB); PG8_STAGE(PG8_SA(1, 0), cA + kstep, voffA); PG8_STAGE(PG8_SB(1, 1), cB + hstep + kstep, voffB);
        PG8_WAIT_V(6); PG8_BAR;
    }
    for (;;) {
        const bool has_next = S.next(ui + 1, nxt);
        const GAS char* nA = has_next ? (const GAS char*)g.A + (size_t)nxt.pm * tstep : cA; const GAS char* nB = has_next ? (const GAS char*)g.Bt + (size_t)nxt.pn * tstep : cB;
        for (int t = 0; t < nt; t += 2) {
            const bool last = (t == nt - 2);
            const GAS char* a1 = cA + (size_t)(t + 1) * kstep;
            const GAS char* a2 = last ? nA : cA + (size_t)(t + 2) * kstep; const GAS char* b2 = last ? nB : cB + (size_t)(t + 2) * kstep;
            const GAS char* a3 = a2 + kstep; const GAS char* b3 = b2 + kstep;
            if (last && has_next) S.a_ready(nxt);
            if constexpr (SP2) {
            PG8_LDB(B0, 0, 0); PG8_LDB(B1, 0, 1); PG8_SCHED; PG8_LDA(At, 0, 0); PG8_STAGE(PG8_SA(1, 1), a1 + hstep, voffA);
            PG8_WAIT_V(8); PG8_WAIT_L(0); PG8_BAR; PG8_MMA(0, 0, At, B0); PG8_MMA(0, 1, At, B1); PG8_BAR; PG8_SCHED;
            PG8_LDA(At, 0, 1); PG8_STAGE(PG8_SB(0, 0), b2, voffB); PG8_STAGE(PG8_SB(0, 1), b2 + hstep, voffB); PG8_STAGE(PG8_SA(0, 0), a2, voffA);
            PG8_WAIT_V(8); PG8_WAIT_L(0); PG8_BAR; PG8_MMA(1, 0, At, B0); PG8_MMA(1, 1, At, B1); PG8_BAR; PG8_SCHED;
            PG8_LDB(B0, 1, 0); PG8_LDB(B1, 1, 1); PG8_SCHED; PG8_LDA(At, 1, 0); PG8_STAGE(PG8_SA(0, 1), a2 + hstep, voffA);
            PG8_WAIT_V(8); PG8_WAIT_L(0); PG8_BAR; PG8_MMA(0, 0, At, B0); PG8_MMA(0, 1, At, B1); PG8_BAR; PG8_SCHED;
            PG8_LDA(At, 1, 1); PG8_STAGE(PG8_SB(1, 0), b3, voffB); PG8_STAGE(PG8_SB(1, 1), b3 + hstep, voffB); PG8_STAGE(PG8_SA(1, 0), a3, voffA);
            PG8_WAIT_V(8); PG8_WAIT_L(0); PG8_BAR; PG8_MMA(1, 0, At, B0); PG8_MMA(1, 1, At, B1); PG8_BAR; PG8_SCHED;
            } else {
            PG8_LDB(B0, 0, 0); PG8_SCHED; PG8_LDA(At, 0, 0); PG8_STAGE(PG8_SA(1, 1), a1 + hstep, voffA);
            PG8_WAIT_L(8); PG8_BAR; PG8_WAIT_L(0); PG8_MMA(0, 0, At, B0); PG8_BAR; PG8_SCHED;
            PG8_LDB(B1, 0, 1); PG8_STAGE(PG8_SB(0, 0), b2, voffB);
            PG8_BAR; PG8_WAIT_L(0); PG8_MMA(0, 1, At, B1); PG8_BAR;
            PG8_LDA(At, 0, 1); PG8_STAGE(PG8_SA(0, 0), a2, voffA);
            PG8_BAR; PG8_WAIT_L(0); PG8_MMA(1, 0, At, B0); PG8_BAR; PG8_SCHED;
            PG8_STAGE(PG8_SB(0, 1), b2 + hstep, voffB);
            PG8_WAIT_V(6); PG8_BAR; PG8_MMA(1, 1, At, B1); PG8_BAR;
            PG8_LDB(B0, 1, 0); PG8_SCHED; PG8_LDA(At, 1, 0); PG8_STAGE(PG8_SA(0, 1), a2 + hstep, voffA);
            PG8_WAIT_L(8); PG8_BAR; PG8_WAIT_L(0); PG8_MMA(0, 0, At, B0); PG8_BAR; PG8_SCHED;
            PG8_LDB(B1, 1, 1); PG8_STAGE(PG8_SB(1, 0), b3, voffB);
            PG8_BAR; PG8_WAIT_L(0); PG8_MMA(0, 1, At, B1); PG8_BAR;
            PG8_LDA(At, 1, 1); PG8_STAGE(PG8_SA(1, 0), a3, voffA);
            PG8_BAR; PG8_WAIT_L(0); PG8_MMA(1, 0, At, B0); PG8_BAR; PG8_SCHED;
            PG8_STAGE(PG8_SB(1, 1), b3 + hstep, voffB);
            PG8_WAIT_V(6); PG8_BAR; PG8_MMA(1, 1, At, B1); PG8_BAR;
            }
        }
        if constexpr (ALIGN_EPI) { if (wr == 0) PG8_BAR; }
        if constexpr (!Epi::AFTER_DRAIN) { E(acc, cur, wr, wc, fr, fq); S.done(cur); }
        if (!has_next) break;
#pragma unroll
        for (int a = 0; a < 2; ++a)
#pragma unroll
            for (int b = 0; b < 2; ++b)
#pragma unroll
                for (int m = 0; m < 4; ++m)
#pragma unroll
                    for (int n = 0; n < 2; ++n) acc[a][b][m][n] = (f32x4){0.f, 0.f, 0.f, 0.f};
        cur = nxt; cA = nA; cB = nB; ++ui;
        if constexpr (ALIGN_EPI) { if (wr == 1) PG8_BAR; }
    }
    PG8_WAIT_V(0);
    if constexpr (!ALIGN_EPI) { if (wr == 0) PG8_BAR; }
    PG8_BAR;
    if constexpr (Epi::AFTER_DRAIN) { E.fused(acc, cur, wr, wc, fr, fq, lds, wid, lane); S.done(cur); }
#undef PG8_SA
#undef PG8_SB
#undef PG8_STAGE
#undef PG8_LDA
#undef PG8_LDB
#undef PG8_MMA
#undef PG8_WAIT_V
#undef PG8_WAIT_L
#undef PG8_BAR
#undef PG8_SCHED
}
}

typedef unsigned short bf16;
typedef unsigned v4u __attribute__((ext_vector_type(4)));
typedef float f32x4 __attribute__((ext_vector_type(4)));
typedef short bf16x8 __attribute__((ext_vector_type(8)));
typedef GAS unsigned gu32;
typedef GAS unsigned long long gu64;
#define RLX_AGENT __ATOMIC_RELAXED, __HIP_MEMORY_SCOPE_AGENT
#define LDS_WAIT() asm volatile("s_waitcnt lgkmcnt(0)" ::: "memory")
#define VM_WAIT() asm volatile("s_waitcnt vmcnt(0)" ::: "memory")
__device__ __forceinline__ unsigned long long rt() { return __builtin_amdgcn_s_memrealtime(); }
typedef float f32x2_cv __attribute__((ext_vector_type(2))); typedef __bf16 bf16x2_cv __attribute__((ext_vector_type(2)));
__device__ __forceinline__ unsigned pk2(float lo, float hi) { const f32x2_cv v = {lo, hi}; const bf16x2_cv c = __builtin_convertvector(v, bf16x2_cv); return __builtin_bit_cast(unsigned, c); }
__device__ __forceinline__ unsigned f2bf(float f) { return pk2(f, 0.f) & 0xffffu; }

#define XB_TMO      128
#define XB_XCNT(j)  (256  + 64 * (j))
#define XB_XSUB(j)  (1280 + 64 * (j))
#define XB_XGEN(j)  (2304 + 64 * (j))
#define XB_TOP      3328
#define XB_TOPGEN   3392
#define XCD_BAR_WORDS 3456
#define XB_SPIN_CAP (1u << 18)

__device__ __forceinline__ unsigned xb_ld(unsigned* p)              { return __hip_atomic_load(p, __ATOMIC_RELAXED, __HIP_MEMORY_SCOPE_AGENT); }
__device__ __forceinline__ unsigned xb_add(unsigned* p, unsigned v) { return __hip_atomic_fetch_add(p, v, __ATOMIC_RELAXED, __HIP_MEMORY_SCOPE_AGENT); }
__device__ __forceinline__ unsigned xb_xcc_id() { return (unsigned)__builtin_amdgcn_s_getreg((3 << 11) | 20) & 0xFu; }
#define XB_SPIN(cond, bar) do { unsigned _sp = 0; while (cond) { __builtin_amdgcn_s_sleep(1); \
    if ((++_sp & 255u) == 0u) { if (xb_ld(&(bar)[XB_TMO])) break; if (_sp > XB_SPIN_CAP) { atomicAdd(&(bar)[XB_TMO], 1u); break; } } } } while (0)

struct XcdBarrier {
    unsigned* bar; unsigned x;
    volatile LAS unsigned* st;
};

__device__ __forceinline__ XcdBarrier xcd_barrier_post(unsigned* bar, volatile LAS unsigned* st) {
    XcdBarrier b; b.bar = bar; b.x = xb_xcc_id(); b.st = st;
    if (threadIdx.x == 0) (void)xb_add(&bar[XB_XCNT(b.x)], 1u);
    return b;
}
__device__ __forceinline__ void xcd_barrier_complete(unsigned* bar, unsigned x, unsigned& nloc, unsigned& nx, const unsigned G) {
    unsigned sum, cnt, mine, sp = 0u;
    for (;;) {
        sum = 0u; cnt = 0u; mine = 0u;
#pragma unroll 1
        for (unsigned j = 0; j < 16; ++j) { const unsigned c = xb_ld(&bar[XB_XCNT(j)]); sum += c; cnt += (c > 0u) ? 1u : 0u; mine = (j == x) ? c : mine; }
        if (sum == G) break;
        __builtin_amdgcn_s_sleep(1);
        if ((++sp & 255u) == 0u) { if (xb_ld(&bar[XB_TMO])) break; if (sp > XB_SPIN_CAP) { atomicAdd(&bar[XB_TMO], 1u); break; } }
    }
    nloc = mine > 0u ? mine : 1u; nx = cnt > 0u ? cnt : 1u;
}

__device__ __forceinline__ void xcd_barrier(const XcdBarrier& b, const int tid_, const unsigned G_) {
    asm volatile("s_waitcnt vmcnt(0)" ::: "memory");
    __syncthreads();
    if (tid_ == 0) {
        unsigned* bar = b.bar;
        __builtin_amdgcn_s_waitcnt(0);
        unsigned nloc = b.st[0], nx = b.st[1];
        if (nloc == 0u) { xcd_barrier_complete(bar, b.x, nloc, nx, G_); b.st[0] = nloc; b.st[1] = nx; }
        const unsigned old = xb_add(&bar[XB_XSUB(b.x)], 1u);
        const unsigned gen = old / nloc;
        if (old + 1u == (gen + 1u) * nloc) {
            __builtin_amdgcn_fence(__ATOMIC_RELEASE, "agent");
            asm volatile("s_waitcnt vmcnt(0)" ::: "memory");
            const unsigned og = xb_add(&bar[XB_TOP], 1u);
            const unsigned tg = og / nx;
            if (og + 1u == (tg + 1u) * nx) xb_add(&bar[XB_TOPGEN], 1u);
            else XB_SPIN(xb_ld(&bar[XB_TOPGEN]) == tg, bar);
            __builtin_amdgcn_fence(__ATOMIC_ACQUIRE, "agent");
            xb_add(&bar[XB_XGEN(b.x)], 1u);
            asm volatile("s_waitcnt vmcnt(0)" ::: "memory");
        } else {
            XB_SPIN(xb_ld(&bar[XB_XGEN(b.x)]) == gen, bar);
            __builtin_amdgcn_fence(__ATOMIC_ACQUIRE, "agent");
            asm volatile("s_waitcnt vmcnt(0)" ::: "memory");
        }
    }
    __syncthreads();
}

constexpr size_t O_YP = 0, O_YS = O_YP + (size_t)NB * SEQ * D, O_PK = O_YS + (size_t)MS * D, O_PV = O_PK + 2ull * MP * 256, O_PKI = O_PV + 2ull * MP * 256,
                 O_PSSM = O_PKI + 2ull * MP * 64, O_PCONV = O_PSSM + 2ull * NB * NH * HP * NST, O_SK = O_PCONV + 2ull * NB * 3 * CONVD, O_SV = O_SK + 2ull * MS * 256,
                 O_SKI = O_SV + 2ull * MS * 256, O_SSSM = O_SKI + 2ull * MS * 64, O_SCONV = O_SSSM + 2ull * DB * NH * HP * NST, O_END = O_SCONV + 2ull * DB * 3 * CONVD;

constexpr size_t MiB = 1u << 20;
constexpr size_t al(size_t x) { return (x + MiB - 1) / MiB * MiB; }
constexpr size_t WS_CTL = 0, CTL_ZERO_BYTES = 1 * MiB;
constexpr size_t SZ_WIN = (size_t)NIN * D * 2, SZ_WSSM = (size_t)D * DIN * 2, SZ_WATT = (size_t)D * D * 2, SZ_WOUT = (size_t)D * D * 2, SZ_WUP = (size_t)DFF * D * 2, SZ_WDN = (size_t)D * DFF * 2;
constexpr size_t WL_WIN = 0, WL_WSSM = al(WL_WIN + SZ_WIN), WL_WATT = al(WL_WSSM + SZ_WSSM), WL_WOUT = al(WL_WATT + SZ_WATT), WL_WUP = al(WL_WOUT + SZ_WOUT), WL_WDN = al(WL_WUP + SZ_WUP), WL_SIZE = al(WL_WDN + SZ_WDN);
constexpr size_t WS_W = 1 * MiB;
constexpr size_t WS_H = al(WS_W + 2 * WL_SIZE);
constexpr size_t WS_U = al(WS_H + (size_t)MPAD * D * 4);
constexpr size_t WS_P1 = al(WS_U + (size_t)MPAD * D * 2);
constexpr size_t WS_MISC = al(WS_P1 + (size_t)MPAD * LDP1 * 2);
constexpr size_t WS_KIB = al(WS_MISC + (size_t)MPAD * 128 * 4);
constexpr size_t WS_XC = al(WS_KIB + (size_t)MPAD * 64 * 2);
constexpr size_t WS_DT = al(WS_XC + (size_t)MPAD * CONVD * 2);
constexpr size_t WS_DA = al(WS_DT + (size_t)MPAD * 32 * 4);
constexpr size_t WS_YS = al(WS_DA + (size_t)MPAD * 32 * 4);
constexpr size_t WS_YSN = al(WS_YS + (size_t)MPAD * DIN * 4);
constexpr size_t WS_YA = al(WS_YSN + (size_t)MPAD * DIN * 2);
constexpr size_t WS_T1 = al(WS_YA + (size_t)MPAD * D * 2);
constexpr size_t WS_MG = al(WS_T1 + (size_t)MPAD * D * 4);
constexpr size_t WS_A2 = al(WS_MG + (size_t)MPAD * D * 2);
constexpr size_t WS_IDXP = al(WS_A2 + (size_t)MPAD * DFF * 2);
constexpr size_t WS_IDXS = al(WS_IDXP + (size_t)MP * 256 * 2);
constexpr int SCS_LD = 8256;
constexpr size_t WS_SCS = al(WS_IDXS + (size_t)MS * 256 * 4);
constexpr size_t WS_SB = al(WS_SCS + (size_t)MS * SCS_LD * 4);
constexpr size_t WS_DEC = al(WS_SB + (size_t)NB * 33 * NH * HP * NST * 4);
constexpr size_t WS_HC = al(WS_DEC + (size_t)NB * 33 * NH * 4);
constexpr size_t WS_KVB = al(WS_HC + (size_t)NB * 33 * NH * HP * NST * 2);
constexpr size_t WS_KIB2 = al(WS_KVB + (size_t)MPAD * 512 * 2);
constexpr size_t WS_END = al(WS_KIB2 + (size_t)NB * KT_PER_B * 2048 * 2);
constexpr int CW_BAR = 4096;

constexpr int LDS_BYTES = 159744, LDSCTL_OFF = 155648, MISC_OFF = LDSCTL_OFF + 320;
constexpr int NWAVES = 8, NT = 512;
typedef float f32x16 __attribute__((ext_vector_type(16)));
typedef unsigned v2u __attribute__((ext_vector_type(2)));

__device__ __forceinline__ float dpp_f(float v, const int ctrl_unused) { return v; }
#define DPPF(v, ctrl, rmask, bc) __uint_as_float((unsigned)__builtin_amdgcn_update_dpp(0, (int)__float_as_uint(v), ctrl, rmask, 0xf, bc))
__device__ __forceinline__ float row16_sum(float v) {
    v += DPPF(v, 0xB1, 0xf, true); v += DPPF(v, 0x4E, 0xf, true); v += DPPF(v, 0x141, 0xf, true); v += DPPF(v, 0x140, 0xf, true); return v;
}
__device__ __forceinline__ float wave_sum(float v) {
    v = row16_sum(v);
    v += DPPF(v, 0x142, 0xa, false); v += DPPF(v, 0x143, 0xc, false);
    return __uint_as_float((unsigned)__builtin_amdgcn_readlane((int)__float_as_uint(v), 63));
}
__device__ __forceinline__ float wave_max(float v) {
    v = fmaxf(v, __uint_as_float((unsigned)__builtin_amdgcn_update_dpp((int)__float_as_uint(v), (int)__float_as_uint(v), 0xB1, 0xf, 0xf, false)));
    v = fmaxf(v, __uint_as_float((unsigned)__builtin_amdgcn_update_dpp((int)__float_as_uint(v), (int)__float_as_uint(v), 0x4E, 0xf, 0xf, false)));
    v = fmaxf(v, __uint_as_float((unsigned)__builtin_amdgcn_update_dpp((int)__float_as_uint(v), (int)__float_as_uint(v), 0x141, 0xf, 0xf, false)));
    v = fmaxf(v, __uint_as_float((unsigned)__builtin_amdgcn_update_dpp((int)__float_as_uint(v), (int)__float_as_uint(v), 0x140, 0xf, 0xf, false)));
    v = fmaxf(v, __uint_as_float((unsigned)__builtin_amdgcn_update_dpp((int)__float_as_uint(v), (int)__float_as_uint(v), 0x142, 0xa, 0xf, false)));
    v = fmaxf(v, __uint_as_float((unsigned)__builtin_amdgcn_update_dpp((int)__float_as_uint(v), (int)__float_as_uint(v), 0x143, 0xc, 0xf, false)));
    return __uint_as_float((unsigned)__builtin_amdgcn_readlane((int)__float_as_uint(v), 63));
}
__device__ __forceinline__ void unpack8(const v4u w, float (&f)[8]) {
    f[0] = __uint_as_float(w.x << 16); f[1] = __uint_as_float(w.x & 0xffff0000u); f[2] = __uint_as_float(w.y << 16); f[3] = __uint_as_float(w.y & 0xffff0000u);
    f[4] = __uint_as_float(w.z << 16); f[5] = __uint_as_float(w.z & 0xffff0000u); f[6] = __uint_as_float(w.w << 16); f[7] = __uint_as_float(w.w & 0xffff0000u);
}
__device__ __forceinline__ float sigm(float x) { return __builtin_amdgcn_rcpf(1.0f + __expf(-x)); }

__device__ __forceinline__ int win_src_col(int n) {
    if (n < 5120) return n;
    if (n < 6144) return n - 5120 + 5152;
    if (n < 6400) return n - 6144 + 6176;
    if (n < 6656) return n - 6400 + 6432;
    if (n < 7168) return n - 6656 + 6688;
    if (n < 8192) return n - 7168 + 7272;
    if (n < 9216) return n - 8192 + 8296;
    if (n < 9280) return n - 9216 + 7200;
    if (n < 9312) return n - 9280 + 5120;
    if (n < 9320) return n - 9312 + 7264;
    return -1;
}
__device__ __forceinline__ void tr_item(const GAS float* W, int K, int Nsrc, GAS bf16* WT, int nblk, bool remap, LAS float* scr, int item, int lane) {
    const int kb = item / nblk, nb = item % nblk, k0 = 64 * kb, n0 = 64 * nb;
    const int s0 = remap ? win_src_col(n0) : n0, s63 = remap ? win_src_col(n0 + 63) : n0 + 63;
    if (s0 >= 0 && s63 == s0 + 63 && (s0 & 3) == 0 && (Nsrc & 3) == 0) {
        const int r4 = lane >> 4, c4 = (lane & 15) * 4;
#pragma unroll 4
        for (int i = 0; i < 16; ++i) { const int kk = 4 * i + r4; const f32x4 v = *(const GAS f32x4*)(W + (size_t)(k0 + kk) * Nsrc + s0 + c4);
            scr[kk * 65 + c4] = v.x; scr[kk * 65 + c4 + 1] = v.y; scr[kk * 65 + c4 + 2] = v.z; scr[kk * 65 + c4 + 3] = v.w; }
    } else {
        const int sc = remap ? win_src_col(n0 + lane) : n0 + lane;
#pragma unroll 8
        for (int kk = 0; kk < 64; ++kk) scr[kk * 65 + lane] = sc >= 0 ? W[(size_t)(k0 + kk) * Nsrc + sc] : 0.f;
    }
    LDS_WAIT(); asm volatile("" ::: "memory");
    const int c = lane & 7;
#pragma unroll
    for (int j = 0; j < 8; ++j) { const int n = (lane >> 3) + 8 * j; const LAS float* s = scr + (8 * c) * 65 + n;
        v4u o; o.x = pk2(s[0 * 65], s[1 * 65]); o.y = pk2(s[2 * 65], s[3 * 65]); o.z = pk2(s[4 * 65], s[5 * 65]); o.w = pk2(s[6 * 65], s[7 * 65]);
        *(GAS v4u*)(WT + (size_t)(n0 + n) * K + k0 + 8 * c) = o; }
    LDS_WAIT(); asm volatile("" ::: "memory");
}
__device__ __forceinline__ void rms_row(const GAS float* src, const GAS float* w, GAS float* hdst, GAS bf16* udst, GAS float* fdst, int lane) {
    f32x4 v[4]; float ss = 0.f;
#pragma unroll
    for (int j = 0; j < 4; ++j) { v[j] = src ? ((const GAS f32x4*)src)[lane + 64 * j] : (f32x4){0.f, 0.f, 0.f, 0.f}; ss += (v[j].x * v[j].x + v[j].y * v[j].y) + (v[j].z * v[j].z + v[j].w * v[j].w); }
    ss = wave_sum(ss);
    const float rstd = 1.0f / sqrtf(ss * (1.0f / D) + 1e-6f);
#pragma unroll
    for (int j = 0; j < 4; ++j) {
        if (hdst) ((GAS f32x4*)hdst)[lane + 64 * j] = v[j];
        const f32x4 wv = ((const GAS f32x4*)w)[lane + 64 * j]; const f32x4 o = v[j] * rstd * wv;
        if (udst) ((GAS v2u*)udst)[lane + 64 * j] = (v2u){pk2(o.x, o.y), pk2(o.z, o.w)};
        if (fdst) ((GAS f32x4*)fdst)[lane + 64 * j] = o;
    }
}

__device__ __forceinline__ void rms_rows4(const GAS float* H, const GAS float* w, GAS bf16* U, int m0, int stride, int mend, int lane) {
    f32x4 v[4][4]; float ss[4];
#pragma unroll
    for (int r = 0; r < 4; ++r) { const int m = m0 + r * stride; const GAS f32x4* src = (const GAS f32x4*)(H + (size_t)(m < mend ? m : m0) * D); ss[r] = 0.f;
#pragma unroll
        for (int j = 0; j < 4; ++j) v[r][j] = src[lane + 64 * j]; }
    f32x4 wv[4];
#pragma unroll
    for (int j = 0; j < 4; ++j) wv[j] = ((const GAS f32x4*)w)[lane + 64 * j];
#pragma unroll
    for (int r = 0; r < 4; ++r) {
#pragma unroll
        for (int j = 0; j < 4; ++j) ss[r] += (v[r][j].x * v[r][j].x + v[r][j].y * v[r][j].y) + (v[r][j].z * v[r][j].z + v[r][j].w * v[r][j].w);
        ss[r] = wave_sum(ss[r]);
        const float rstd = 1.0f / sqrtf(ss[r] * (1.0f / D) + 1e-6f); const int m = m0 + r * stride;
        if (m < mend) {
#pragma unroll
            for (int j = 0; j < 4; ++j) { const f32x4 o = v[r][j] * rstd * wv[j]; ((GAS v2u*)(U + (size_t)m * D))[lane + 64 * j] = (v2u){pk2(o.x, o.y), pk2(o.z, o.w)}; } }
    }
}

__device__ __forceinline__ void rms_rows4g(const GAS float* const (&src)[4], const GAS float* w, GAS float* const (&hdst)[4], GAS bf16* const (&udst)[4], GAS float* const (&fdst)[4], const bool (&live)[4], int lane) {
    f32x4 v[4][4];
#pragma unroll
    for (int r = 0; r < 4; ++r)
#pragma unroll
        for (int j = 0; j < 4; ++j) v[r][j] = (live[r] && src[r]) ? ((const GAS f32x4*)src[r])[lane + 64 * j] : (f32x4){0.f, 0.f, 0.f, 0.f};
    f32x4 wv[4];
#pragma unroll
    for (int j = 0; j < 4; ++j) wv[j] = ((const GAS f32x4*)w)[lane + 64 * j];
#pragma unroll
    for (int r = 0; r < 4; ++r) { float ss = 0.f;
#pragma unroll
        for (int j = 0; j < 4; ++j) ss += (v[r][j].x * v[r][j].x + v[r][j].y * v[r][j].y) + (v[r][j].z * v[r][j].z + v[r][j].w * v[r][j].w);
        ss = wave_sum(ss);
        const float rstd = 1.0f / sqrtf(ss * (1.0f / D) + 1e-6f);
        if (live[r]) {
#pragma unroll
            for (int j = 0; j < 4; ++j) { const f32x4 o = v[r][j] * rstd * wv[j];
                if (hdst[r]) ((GAS f32x4*)hdst[r])[lane + 64 * j] = v[r][j];
                if (udst[r]) ((GAS v2u*)udst[r])[lane + 64 * j] = (v2u){pk2(o.x, o.y), pk2(o.z, o.w)};
                if (fdst[r]) ((GAS f32x4*)fdst[r])[lane + 64 * j] = o; } }
    }
}

__device__ __forceinline__ void ssd_unit(LAS unsigned char* lds, int tid, const GAS bf16* XC, const GAS float* DT, const GAS float* DA, size_t m0, int L, int h, int p0,
                                         const GAS float* hin, GAS float* hout, GAS float* YS, float dskip) {
    LAS float* Bl = (LAS float*)lds;
    LAS float* Cl = Bl + 64 * 128;
    LAS float* Xl = Cl + 64 * 128;
    LAS float* Yl = Xl + 64 * 32;
    LAS float* dtl = Yl + 64 * 32;
    LAS float* dal = dtl + 64;
    const int pl = tid >> 4, nq = tid & 15, n0 = nq * 8, g = h >> 3;
    float s[8];
    if (hin) { const f32x4 a = *(const GAS f32x4*)(hin + (size_t)(p0 + pl) * NST + n0), b = *(const GAS f32x4*)(hin + (size_t)(p0 + pl) * NST + n0 + 4);
        s[0] = a.x; s[1] = a.y; s[2] = a.z; s[3] = a.w; s[4] = b.x; s[5] = b.y; s[6] = b.z; s[7] = b.w; }
    else {
#pragma unroll
        for (int i = 0; i < 8; ++i) s[i] = 0.f; }
    for (int tb = 0; tb < L; tb += 64) {
        const int nb = (L - tb) < 64 ? (L - tb) : 64;
        { const int tk = tid >> 3, part = tid & 7;
            if (tk < nb) { const GAS bf16* xr = XC + (m0 + tb + tk) * CONVD;
                float f[8];
                unpack8(*(const GAS v4u*)(xr + DIN + g * NST + part * 16), f);
                *(LAS f32x4*)(Bl + tk * 128 + part * 16) = (f32x4){f[0], f[1], f[2], f[3]}; *(LAS f32x4*)(Bl + tk * 128 + part * 16 + 4) = (f32x4){f[4], f[5], f[6], f[7]};
                unpack8(*(const GAS v4u*)(xr + DIN + g * NST + part * 16 + 8), f);
                *(LAS f32x4*)(Bl + tk * 128 + part * 16 + 8) = (f32x4){f[0], f[1], f[2], f[3]}; *(LAS f32x4*)(Bl + tk * 128 + part * 16 + 12) = (f32x4){f[4], f[5], f[6], f[7]};
                unpack8(*(const GAS v4u*)(xr + DIN + NG * NST + g * NST + part * 16), f);
                *(LAS f32x4*)(Cl + tk * 128 + part * 16) = (f32x4){f[0], f[1], f[2], f[3]}; *(LAS f32x4*)(Cl + tk * 128 + part * 16 + 4) = (f32x4){f[4], f[5], f[6], f[7]};
                unpack8(*(const GAS v4u*)(xr + DIN + NG * NST + g * NST + part * 16 + 8), f);
                *(LAS f32x4*)(Cl + tk * 128 + part * 16 + 8) = (f32x4){f[0], f[1], f[2], f[3]}; *(LAS f32x4*)(Cl + tk * 128 + part * 16 + 12) = (f32x4){f[4], f[5], f[6], f[7]};
                const v2u xw = *(const GAS v2u*)(xr + h * HP + p0 + part * 4);
                *(LAS f32x4*)(Xl + tk * 32 + part * 4) = (f32x4){__uint_as_float(xw.x << 16), __uint_as_float(xw.x & 0xffff0000u), __uint_as_float(xw.y << 16), __uint_as_float(xw.y & 0xffff0000u)};
            }
            if (tid < nb) { dtl[tid] = DT[(m0 + tb + tid) * 32 + h]; dal[tid] = DA[(m0 + tb + tid) * 32 + h]; }
        }
        __syncthreads();
        for (int t = 0; t < nb; ++t) {
            const float da = dal[t], dtv = dtl[t], xv = Xl[t * 32 + pl], xdt = xv * dtv;
            const f32x4 b0 = *(const LAS f32x4*)(Bl + t * 128 + n0), b1 = *(const LAS f32x4*)(Bl + t * 128 + n0 + 4);
            const f32x4 c0 = *(const LAS f32x4*)(Cl + t * 128 + n0), c1 = *(const LAS f32x4*)(Cl + t * 128 + n0 + 4);
            s[0] = s[0] * da + xdt * b0.x; s[1] = s[1] * da + xdt * b0.y; s[2] = s[2] * da + xdt * b0.z; s[3] = s[3] * da + xdt * b0.w;
            s[4] = s[4] * da + xdt * b1.x; s[5] = s[5] * da + xdt * b1.y; s[6] = s[6] * da + xdt * b1.z; s[7] = s[7] * da + xdt * b1.w;
            float y = (s[0] * c0.x + s[1] * c0.y) + (s[2] * c0.z + s[3] * c0.w) + (s[4] * c1.x + s[5] * c1.y) + (s[6] * c1.z + s[7] * c1.w);
            y += __shfl_xor(y, 1); y += __shfl_xor(y, 2); y += __shfl_xor(y, 4); y += __shfl_xor(y, 8);
            if (nq == 0) Yl[t * 32 + pl] = y + xv * dskip;
        }
        __syncthreads();
        { const int tk = tid >> 3, part = tid & 7;
            if (tk < nb) *(GAS f32x4*)(YS + (m0 + tb + tk) * DIN + h * HP + p0 + part * 4) = *(const LAS f32x4*)(Yl + tk * 32 + part * 4); }
    }
    *(GAS f32x4*)(hout + (size_t)(p0 + pl) * NST + n0) = (f32x4){s[0], s[1], s[2], s[3]};
    *(GAS f32x4*)(hout + (size_t)(p0 + pl) * NST + n0 + 4) = (f32x4){s[4], s[5], s[6], s[7]};
}

__device__ __forceinline__ void idx_load_q(const GAS bf16* P1, const GAS float* MISC, size_t mq0, int lane, bf16x8 (&afr)[2][4], float (&wq)[2][2][8]) {
    const int r = lane & 31, hh = lane >> 5, qs = ((r >> 2) & 1) * 2 + (r >> 4), head = (r & 3) + 4 * ((r >> 3) & 1);
#pragma unroll
    for (int rt = 0; rt < 2; ++rt)
#pragma unroll
        for (int ks = 0; ks < 4; ++ks) afr[rt][ks] = *(const GAS bf16x8*)(P1 + (mq0 + qs + 4 * rt) * LDP1 + C_QI + head * 64 + 16 * ks + 8 * hh);
#pragma unroll
    for (int rt = 0; rt < 2; ++rt)
#pragma unroll
        for (int jq = 0; jq < 2; ++jq) { const GAS float* wp = MISC + (mq0 + 4 * rt + 2 * hh + jq) * 128 + MC_WI; const f32x4 a = *(const GAS f32x4*)wp, b = *(const GAS f32x4*)(wp + 4);
            const float sc = 0.125f * 0.35355339059327373f;
            wq[rt][jq][0] = a.x * sc; wq[rt][jq][1] = a.y * sc; wq[rt][jq][2] = a.z * sc; wq[rt][jq][3] = a.w * sc; wq[rt][jq][4] = b.x * sc; wq[rt][jq][5] = b.y * sc; wq[rt][jq][6] = b.z * sc; wq[rt][jq][7] = b.w * sc; }
}
__device__ __forceinline__ void idx_scores(const bf16x8 (&afr)[2][4], const bf16x8 (&bfr)[4], const float (&wq)[2][2][8], float (&sc)[2][2]) {
#pragma unroll
    for (int rt = 0; rt < 2; ++rt) {
        f32x16 acc = {};
#pragma unroll
        for (int ks = 0; ks < 4; ++ks) acc = __builtin_amdgcn_mfma_f32_32x32x16_bf16(afr[rt][ks], bfr[ks], acc, 0, 0, 0);
#pragma unroll
        for (int jq = 0; jq < 2; ++jq) { float s = 0.f;
#pragma unroll
            for (int i = 0; i < 8; ++i) s += wq[rt][jq][i] * fmaxf(acc[8 * jq + i], 0.f);
            sc[rt][jq] = s; }
    }
}
__device__ __forceinline__ unsigned f2key(float f) { const unsigned u = __float_as_uint(f); return u ^ ((u >> 31) ? 0xffffffffu : 0x80000000u); }
__device__ __forceinline__ unsigned wave_incl_scan(unsigned v, int lane) {
#pragma unroll
    for (int o = 1; o < 64; o <<= 1) { const unsigned t = __shfl_up(v, o); if (lane >= o) v += t; }
    return v;
}
#ifndef REP_TK_PASS
#define REP_TK_PASS 1
#endif
#ifndef REP_TK_COMP
#define REP_TK_COMP 1
#endif
__device__ __forceinline__ int wave_sum_i(int v) {
    v += __builtin_amdgcn_update_dpp(0, v, 0xB1, 0xf, 0xf, true);
    v += __builtin_amdgcn_update_dpp(0, v, 0x4E, 0xf, 0xf, true);
    v += __builtin_amdgcn_update_dpp(0, v, 0x141, 0xf, 0xf, true);
    v += __builtin_amdgcn_update_dpp(0, v, 0x140, 0xf, 0xf, true);
    v += __builtin_amdgcn_update_dpp(0, v, 0x142, 0xa, 0xf, false);
    v += __builtin_amdgcn_update_dpp(0, v, 0x143, 0xc, 0xf, false);
    return __builtin_amdgcn_readlane(v, 63);
}
__device__ __forceinline__ int cnt_ge(const LAS unsigned* s, int nit, unsigned mid, int lane) {
    int cl = 0; int it = 0;
    const LAS v4u* p = (const LAS v4u*)s + lane;
    for (; it + 4 <= nit; it += 4) {
        const v4u k0 = p[64 * it], k1 = p[64 * it + 64], k2 = p[64 * it + 128], k3 = p[64 * it + 192];
        cl += (k0.x >= mid) + (k0.y >= mid) + (k0.z >= mid) + (k0.w >= mid);
        cl += (k1.x >= mid) + (k1.y >= mid) + (k1.z >= mid) + (k1.w >= mid);
        cl += (k2.x >= mid) + (k2.y >= mid) + (k2.z >= mid) + (k2.w >= mid);
        cl += (k3.x >= mid) + (k3.y >= mid) + (k3.z >= mid) + (k3.w >= mid); }
    for (; it < nit; ++it) { const v4u kv = p[64 * it]; cl += (kv.x >= mid) + (kv.y >= mid) + (kv.z >= mid) + (kv.w >= mid); }
    return wave_sum_i(cl);
}
constexpr int HB = 512;
__device__ __forceinline__ unsigned hist_bound_key(int b) {
    return b <= 0 ? 1u : (b >= HB ? 0xff800001u : (b == 256 ? 0x7fffffffu : f2key((float)(b - 256) * (1.0f / 64.0f))));
}
template <class OT>
__device__ __forceinline__ void topk_select(LAS unsigned* s, int n, int lane, OT* out, const LAS unsigned* hist = nullptr) {
    const int nit = (n + 255) >> 8;
    for (int i = n + lane; i < nit * 256; i += 64) s[i] = 0u;
    LDS_WAIT(); asm volatile("" ::: "memory");
    unsigned T = 0u, need = 0u;
    for (int rq_ = 0; rq_ < REP_TK_PASS; ++rq_) {
    unsigned hi, lo; int c_hi, c_lo;
    if (hist) {
        unsigned c[8], tot = 0u;
#pragma unroll
        for (int j = 0; j < 8; ++j) { c[j] = hist[HB - 1 - 8 * lane - j]; tot += c[j]; }
        const unsigned incl = wave_incl_scan(tot, lane), excl = incl - tot;
        const bool here = (excl < 256u) && (256u <= incl);
        int bin = 0; unsigned above = 0u, inb = 0u;
        if (here) { unsigned run = excl;
#pragma unroll
            for (int j = 0; j < 8; ++j) { if (run < 256u && 256u <= run + c[j]) { bin = HB - 1 - 8 * lane - j; above = run; inb = c[j]; } run += c[j]; } }
        const unsigned long long mk = __ballot(here); const int src = mk ? (__ffsll((long long)mk) - 1) : 0;
        bin = __builtin_amdgcn_readlane(bin, src); above = (unsigned)__builtin_amdgcn_readlane((int)above, src); inb = (unsigned)__builtin_amdgcn_readlane((int)inb, src);
        lo = hist_bound_key(bin); hi = hist_bound_key(bin + 1); c_hi = (int)above; c_lo = (int)(above + inb);
    } else {
    unsigned kmx = 0u;
    for (int it = 0; it < nit; ++it) { const v4u kv = *(const LAS v4u*)(s + 4 * (lane + 64 * it));
        const unsigned a = kv.x > kv.y ? kv.x : kv.y, c = kv.z > kv.w ? kv.z : kv.w, d = a > c ? a : c; kmx = d > kmx ? d : kmx; }
#pragma unroll
    for (int o = 1; o < 64; o <<= 1) { const unsigned a = __shfl_xor(kmx, o); kmx = a > kmx ? a : kmx; }
    kmx = (unsigned)__builtin_amdgcn_readfirstlane((int)kmx);
    hi = kmx + 1u; lo = 1u; c_hi = 0; c_lo = n;
    { unsigned step = 1u << 25;
      for (int tr = 0; tr < 7; ++tr) { if (hi <= step + 1u) break; const unsigned cand = hi - step;
          const int c = cnt_ge(s, nit, cand, lane);
          if (c >= 256) { lo = cand; c_lo = c; break; } hi = cand; c_hi = c; step <<= 1; } }
    }
    bool bis = false; unsigned pw = hi - lo;
    for (int pass = 0; pass < 96; ++pass) {
        if (c_lo == 256) { T = lo - 1u; need = 0u; break; }
        if (hi - lo <= 1u) { T = lo; need = (unsigned)(256 - c_hi); break; }
        const unsigned width = hi - lo; unsigned mid;
        if (bis) mid = lo + (width >> 1);
        else { const float f = ((float)(c_lo - 256) + 0.5f) * __builtin_amdgcn_rcpf((float)(c_lo - c_hi)); const float off = (float)width * f;
               mid = lo + (off >= (float)width ? width - 1u : (unsigned)off); }
        if (mid <= lo) mid = lo + 1u; if (mid >= hi) mid = hi - 1u;
        const int c = cnt_ge(s, nit, mid, lane);
        if (c >= 256) { lo = mid; c_lo = c; } else { hi = mid; c_hi = c; }
        const unsigned nw = hi - lo; bis = !bis && (nw > (pw >> 2)); pw = nw;
    }
    }
    const unsigned long long lt = (1ull << lane) - 1ull;
    unsigned running = 0u, eq_taken = 0u;
    for (int rq_ = 0; rq_ < REP_TK_COMP; ++rq_) { running = 0u; eq_taken = 0u;
#pragma unroll 2
    for (int it = 0; it < nit; ++it) {
        const int i0 = 4 * (lane + 64 * it); const v4u kv = *(const LAS v4u*)(s + i0);
        bool sel[4], eq[4]; bool anyeq = false;
#pragma unroll
        for (int e = 0; e < 4; ++e) { sel[e] = kv[e] > T; eq[e] = need != 0u && kv[e] == T && (i0 + e < n); anyeq = anyeq || eq[e]; }
        if (need != 0u && __ballot(anyeq)) {
            unsigned lower = 0u, all = 0u;
#pragma unroll
            for (int e = 0; e < 4; ++e) { const unsigned long long bm = __ballot(eq[e]); lower += (unsigned)__popcll(bm & lt); all += (unsigned)__popcll(bm); }
            unsigned er = eq_taken + lower;
#pragma unroll
            for (int e = 0; e < 4; ++e) { if (eq[e]) { sel[e] = er < need; ++er; } }
            eq_taken += all;
        }
        unsigned lower = 0u, all = 0u;
#pragma unroll
        for (int e = 0; e < 4; ++e) { const unsigned long long sm = __ballot(sel[e]); lower += (unsigned)__popcll(sm & lt); all += (unsigned)__popcll(sm); }
        unsigned pos = running + lower;
#pragma unroll
        for (int e = 0; e < 4; ++e) { if (sel[e]) { if (pos < 256u) out[pos] = (OT)(i0 + e); ++pos; } }
        running += all;
    } }
}

constexpr int NCH = 33;
typedef short s16x4 __attribute__((ext_vector_type(4)));
typedef short v4i16_t __attribute__((ext_vector_type(4)));
__device__ __forceinline__ float wave_incl_scan_f(float v, int lane) {
#pragma unroll
    for (int o = 1; o < 64; o <<= 1) { const float t = __shfl_up(v, o); if (lane >= o) v += t; }
    return v;
}
__device__ __forceinline__ s16x4 ldtr(const LAS unsigned char* p) { return __builtin_bit_cast(s16x4, __builtin_amdgcn_ds_read_tr16_b64_v4i16((LAS v4i16_t*)p)); }
__device__ __forceinline__ bf16x8 frag_tr(const LAS unsigned char* img, int RS, int k0, int c0, int lane) {
    const int hh = lane >> 5, blk = (lane >> 4) & 1, q = (lane & 15) >> 2, pp = lane & 3;
    const LAS unsigned char* a = img + (k0 + 8 * hh + q) * RS + (c0 + 16 * blk + 4 * pp) * 2;
    const s16x4 lo = ldtr(a), hi = ldtr(a + 4 * RS);
    return (bf16x8){lo[0], lo[1], lo[2], lo[3], hi[0], hi[1], hi[2], hi[3]};
}
__device__ __forceinline__ bf16x8 frag_row(const LAS unsigned char* img, int RS, int r0, int k0, int lane) {
    return *(const LAS bf16x8*)(img + (r0 + (lane & 31)) * RS + (k0 + 8 * (lane >> 5)) * 2);
}
constexpr int RS_BC = 272, RS_X = 144, IMG_BC = 128 * RS_BC, IMG_X = 128 * RS_X;
__device__ __forceinline__ void ssd_stage_acum(LAS float* acl, LAS float* dtl, const GAS float* DT, const GAS float* a_log_l, size_t m0, int Lc, int g, int wave, int lane) {
    const int h = 8 * g + wave; const float A = -__expf(a_log_l[h]);
    const float d0 = lane < Lc ? DT[(m0 + lane) * 32 + h] : 0.f, d1 = (64 + lane) < Lc ? DT[(m0 + 64 + lane) * 32 + h] : 0.f;
    const float s0 = wave_incl_scan_f(d0 * A, lane), tot0 = __shfl(s0, 63), s1 = wave_incl_scan_f(d1 * A, lane) + tot0;
    acl[wave * 128 + lane] = s0; acl[wave * 128 + 64 + lane] = s1; dtl[wave * 128 + lane] = d0; dtl[wave * 128 + 64 + lane] = d1;
}
__device__ __forceinline__ void ssd_stage_bc(LAS unsigned char* img, const GAS bf16* src  , int Lc, int tid) {
    const int ch = tid & 15;
#pragma unroll
    for (int q4 = 0; q4 < 4; ++q4) { const int row = (tid >> 4) + 32 * q4; v4u v = (v4u){0u, 0u, 0u, 0u}; if (row < Lc) v = *(const GAS v4u*)(src + (size_t)row * CONVD + ch * 8);
        *(LAS v4u*)(img + row * RS_BC + ch * 16) = v; }
}
__device__ __forceinline__ void ssd_stage_x(LAS unsigned char* img, const GAS bf16* src  , int Lc, int tid, const LAS float* dth, const LAS float* ach, float al, bool decay) {
    const int ch = tid & 7;
#pragma unroll
    for (int q2 = 0; q2 < 2; ++q2) { const int row = (tid >> 3) + 64 * q2; v4u o = (v4u){0u, 0u, 0u, 0u};
        if (row < Lc) { float f[8]; unpack8(*(const GAS v4u*)(src + (size_t)row * CONVD + ch * 8), f);
            const float sc = decay ? dth[row] * __expf(al - ach[row]) : dth[row];
            o = (v4u){pk2(f[0] * sc, f[1] * sc), pk2(f[2] * sc, f[3] * sc), pk2(f[4] * sc, f[5] * sc), pk2(f[6] * sc, f[7] * sc)}; }
        *(LAS v4u*)(img + row * RS_X + ch * 16) = o; }
}
__device__ __forceinline__ void ssd1_unit(LAS unsigned char* lds, int tid, const GAS bf16* XC, const GAS float* DT, const GAS float* a_log_l, GAS bf16* SB, GAS float* DEC, int b, int c, int g) {
    const int lane = tid & 63, wave = __builtin_amdgcn_readfirstlane(tid >> 6), hh = lane >> 5, col = lane & 31;
    const int t0 = c == 0 ? 0 : NMETA + 128 * (c - 1), Lc = c == 0 ? NMETA : 128; const size_t m0 = (size_t)b * LP + t0;
    LAS unsigned char* Bimg = lds; LAS unsigned char* Xw0 = lds + IMG_BC;
    LAS float* acl = (LAS float*)(lds + IMG_BC + 2 * IMG_X); LAS float* dtl = acl + 1024;
    ssd_stage_acum(acl, dtl, DT, a_log_l, m0, Lc, g, wave, lane);
    ssd_stage_bc(Bimg, XC + m0 * CONVD + DIN + g * NST, Lc, tid);
    __syncthreads();
    const int pb = wave >> 2, nb = wave & 3;
    for (int hl = 0; hl < 8; ++hl) {
        const int h = 8 * g + hl; LAS unsigned char* Xw = Xw0 + (hl & 1) * IMG_X;
        const float al = acl[hl * 128 + 127];
        ssd_stage_x(Xw, XC + m0 * CONVD + h * HP, Lc, tid, dtl + hl * 128, acl + hl * 128, al, true);
        __syncthreads();
        f32x16 acc = {};
        if (Lc == 128) {
#pragma unroll
            for (int ks = 0; ks < 8; ++ks) acc = __builtin_amdgcn_mfma_f32_32x32x16_bf16(frag_tr(Xw, RS_X, 16 * ks, 32 * pb, lane), frag_tr(Bimg, RS_BC, 16 * ks, 32 * nb, lane), acc, 0, 0, 0);
        } else acc = __builtin_amdgcn_mfma_f32_32x32x16_bf16(frag_tr(Xw, RS_X, 0, 32 * pb, lane), frag_tr(Bimg, RS_BC, 0, 32 * nb, lane), acc, 0, 0, 0);
        GAS bf16* Sp = SB + ((size_t)(b * NCH + c) * NH + h) * (HP * NST) + 32 * nb + col;
#pragma unroll
        for (int r = 0; r < 16; ++r) Sp[(32 * pb + (r & 3) + 8 * (r >> 2) + 4 * hh) * NST] = (bf16)f2bf(acc[r]);
        if (tid == 0) DEC[(b * NCH + c) * NH + h] = __expf(al);
    }
    __syncthreads();
}
__device__ __forceinline__ void ssd3_unit(LAS unsigned char* lds, int tid, const GAS bf16* XC, const GAS bf16* P1, const GAS float* DT, const GAS float* a_log_l, const GAS float* dskip_l, const GAS float* normw_l,
                                          const GAS bf16* HC, GAS bf16* YSN, int b, int c, int g) {
    const int lane = tid & 63, wave = __builtin_amdgcn_readfirstlane(tid >> 6), hh = lane >> 5, col = lane & 31;
    const int t0 = c == 0 ? 0 : NMETA + 128 * (c - 1), Lc = c == 0 ? NMETA : 128; const size_t m0 = (size_t)b * LP + t0;
    LAS unsigned char* Bimg = lds; LAS unsigned char* Cimg = lds + IMG_BC; LAS unsigned char* Mimg = lds + 2 * IMG_BC; LAS unsigned char* Ximg = lds + 3 * IMG_BC;
    LAS float* acl = (LAS float*)(lds + 3 * IMG_BC + IMG_X); LAS float* dtl = acl + 1024;
    ssd_stage_acum(acl, dtl, DT, a_log_l, m0, Lc, g, wave, lane);
    ssd_stage_bc(Bimg, XC + m0 * CONVD + DIN + g * NST, Lc, tid);
    ssd_stage_bc(Cimg, XC + m0 * CONVD + DIN + NG * NST + g * NST, Lc, tid);
    __syncthreads();
    const int ib = wave >> 1, pb = wave & 1;
    f32x16 cb[2];
    const bool live = 32 * ib < Lc;
#pragma unroll
    for (int jj = 0; jj < 2; ++jj) { const int jb = 2 * (wave & 1) + jj; cb[jj] = (f32x16){};
        if (jb <= ib && live) {
#pragma unroll
            for (int ks = 0; ks < 8; ++ks) cb[jj] = __builtin_amdgcn_mfma_f32_32x32x16_bf16(frag_row(Cimg, RS_BC, 32 * ib, 16 * ks, lane), frag_row(Bimg, RS_BC, 32 * jb, 16 * ks, lane), cb[jj], 0, 0, 0); } }
    const int xrow = tid >> 3, xch = tid & 7;
    const GAS bf16* xsrc = XC + (m0 + xrow) * CONVD + (8 * g) * HP + xch * 8;
    v4u xq0 = (v4u){0u, 0u, 0u, 0u}, xq1 = xq0;
    if (xrow < Lc) xq0 = *(const GAS v4u*)xsrc;
    if (xrow + 64 < Lc) xq1 = *(const GAS v4u*)(xsrc + (size_t)64 * CONVD);
    for (int hl = 0; hl < 8; ++hl) {
        const int h = 8 * g + hl;
        bf16x8 hf[8];
        { const GAS bf16* Hp = HC + ((size_t)(b * NCH + c) * NH + h) * (HP * NST) + pb * 4096 + lane * 8;
#pragma unroll
          for (int ks = 0; ks < 8; ++ks) hf[ks] = *(const GAS bf16x8*)(Hp + 512 * ks); }
        v4u xn0 = xq0, xn1 = xq1;
        if (hl < 7 && xrow < Lc) xn0 = *(const GAS v4u*)(xsrc + (hl + 1) * HP);
        if (hl < 7 && xrow + 64 < Lc) xn1 = *(const GAS v4u*)(xsrc + (size_t)64 * CONVD + (hl + 1) * HP);
        float ai[16];
#pragma unroll
        for (int r = 0; r < 16; ++r) ai[r] = acl[hl * 128 + 32 * ib + (r & 3) + 8 * (r >> 2) + 4 * hh];
#pragma unroll
        for (int jj = 0; jj < 2; ++jj) { const int jb = 2 * (wave & 1) + jj;
            if (jb <= ib && live) { const int j = 32 * jb + col; const float aj = acl[hl * 128 + j];
                LAS unsigned char* mp = Mimg + (32 * ib + 4 * hh) * RS_BC + j * 2;
#pragma unroll
                for (int r = 0; r < 16; ++r) { const int il = (r & 3) + 8 * (r >> 2);
                    const float v = (j <= 32 * ib + 4 * hh + il) ? cb[jj][r] * __expf(ai[r] - aj) : 0.f;
                    *(LAS unsigned short*)(mp + il * RS_BC) = (unsigned short)f2bf(v); } } }
        { const float s0 = dtl[hl * 128 + xrow], s1 = dtl[hl * 128 + 64 + xrow]; float f[8]; v4u o0, o1;
          unpack8(xq0, f); o0 = (v4u){pk2(f[0] * s0, f[1] * s0), pk2(f[2] * s0, f[3] * s0), pk2(f[4] * s0, f[5] * s0), pk2(f[6] * s0, f[7] * s0)};
          unpack8(xq1, f); o1 = (v4u){pk2(f[0] * s1, f[1] * s1), pk2(f[2] * s1, f[3] * s1), pk2(f[4] * s1, f[5] * s1), pk2(f[6] * s1, f[7] * s1)};
          *(LAS v4u*)(Ximg + xrow * RS_X + xch * 16) = o0; *(LAS v4u*)(Ximg + (xrow + 64) * RS_X + xch * 16) = o1; }
        __syncthreads();
        f32x16 a1 = {}, a2 = {};
        if (live) {
        const int nks = Lc == 128 ? 2 * (ib + 1) : 1;
        for (int ks = 0; ks < nks; ++ks) a1 = __builtin_amdgcn_mfma_f32_32x32x16_bf16(frag_row(Mimg, RS_BC, 32 * ib, 16 * ks, lane), frag_tr(Ximg, RS_X, 16 * ks, 32 * pb, lane), a1, 0, 0, 0);
#pragma unroll
        for (int ks = 0; ks < 8; ++ks) a2 = __builtin_amdgcn_mfma_f32_32x32x16_bf16(frag_row(Cimg, RS_BC, 32 * ib, 16 * ks, lane), hf[ks], a2, 0, 0, 0);
        GAS bf16* yo = YSN + (m0 + 32 * ib + 4 * hh) * DIN + h * HP + 32 * pb + col;
#pragma unroll
        for (int r = 0; r < 16; ++r) { const int il = (r & 3) + 8 * (r >> 2);
            if (32 * ib + 4 * hh + il < Lc) yo[(size_t)il * DIN] = (bf16)f2bf(a1[r] + __expf(ai[r]) * a2[r]); }
        }
        __syncthreads();
        xq0 = xn0; xq1 = xn1;
    }
    for (int i0 = wave; i0 < Lc; i0 += 4 * NWAVES) { const int c0 = g * 512 + lane * 8;
        v4u yv[4], xv[4], zv[4];
#pragma unroll
        for (int q = 0; q < 4; ++q) { const int i = i0 + NWAVES * q; const size_t m = m0 + (i < Lc ? i : i0);
            yv[q] = *(const GAS v4u*)(YSN + m * DIN + c0); xv[q] = *(const GAS v4u*)(XC + m * CONVD + c0); zv[q] = *(const GAS v4u*)(P1 + m * LDP1 + C_Z + c0); }
        const float Dh = dskip_l[c0 >> 6];
        const GAS float* wp = normw_l + c0; const f32x4 wa = *(const GAS f32x4*)wp, wb = *(const GAS f32x4*)(wp + 4);
#pragma unroll
        for (int q = 0; q < 4; ++q) { const int i = i0 + NWAVES * q;
            float v[8], x[8], z[8]; unpack8(yv[q], v); unpack8(xv[q], x); unpack8(zv[q], z); float ss = 0.f;
#pragma unroll
            for (int j = 0; j < 8; ++j) { v[j] = (v[j] + Dh * x[j]) * (z[j] * sigm(z[j])); ss += v[j] * v[j]; }
            ss = wave_sum(ss);
            const float rstd = 1.0f / sqrtf(ss * (1.0f / 512.0f) + 1e-6f);
            if (i < Lc) *(GAS v4u*)(YSN + (m0 + i) * DIN + c0) = (v4u){pk2(v[0] * rstd * wa.x, v[1] * rstd * wa.y), pk2(v[2] * rstd * wa.z, v[3] * rstd * wa.w), pk2(v[4] * rstd * wb.x, v[5] * rstd * wb.y), pk2(v[6] * rstd * wb.z, v[7] * rstd * wb.w)}; }
    }
    __syncthreads();
}

constexpr int RS_V = 528;
__device__ __forceinline__ void attn_prompt_query(LAS unsigned char* wl, const GAS bf16* P1, const GAS bf16* KVB, const GAS unsigned short* IDXP, GAS bf16* YA, int m, int lane_in) {
    int lane = lane_in; asm volatile("" : "+v"(lane));
    const int b = m / LP, t = m - b * LP, cnt = (t + 1) < 256 ? (t + 1) : 256, ntile = (cnt + 15) >> 4, nstep = (ntile + 1) >> 1;
    LAS unsigned char* Vst = wl; LAS unsigned short* idl = (LAS unsigned short*)(wl + 32 * RS_V);
    { const v2u w = *(const GAS v2u*)(IDXP + (size_t)m * 256 + 4 * lane); const int s0 = 4 * lane;
      const unsigned i0 = (s0 + 0 < cnt) ? (w.x & 0xffffu) : 0u, i1 = (s0 + 1 < cnt) ? (w.x >> 16) : 0u, i2 = (s0 + 2 < cnt) ? (w.y & 0xffffu) : 0u, i3 = (s0 + 3 < cnt) ? (w.y >> 16) : 0u;
      *(LAS v2u*)(idl + s0) = (v2u){i0 | (i1 << 16), i2 | (i3 << 16)}; }
    const int n = lane & 15, kg = lane >> 4;
    int k4 = 4 * kg; asm volatile("" : "+v"(k4));
    bf16x8 bq[8];
#pragma unroll
    for (int s = 0; s < 8; ++s) { bq[s] = (bf16x8){0, 0, 0, 0, 0, 0, 0, 0};
        if ((n >> 2) == (s >> 1)) bq[s] = *(const GAS bf16x8*)(P1 + (size_t)m * LDP1 + C_Q + n * 64 + 32 * (s & 1) + 8 * kg); }
    LDS_WAIT(); asm volatile("" ::: "memory");
    const GAS char* kvb = (const GAS char*)(KVB + (size_t)b * LP * 512);
    const unsigned voff = 512u + 16u * (lane & 31);
    f32x4 S[16];
#pragma unroll
    for (int jt = 0; jt < 16; ++jt) S[jt] = (f32x4){-INFINITY, -INFINITY, -INFINITY, -INFINITY};
    float mx = -INFINITY;
    {
        v4u kst[3][8];
#define KLOAD(dst, tile) do { _Pragma("unroll") for (int it = 0; it < 8; ++it) dst[it] = *(const GAS v4u*)(kvb + ((unsigned)idl[16 * (tile) + 2 * it + (lane >> 5)] * 1024u + 16u * (lane & 31))); } while (0)
        KLOAD(kst[0], 0);
#pragma unroll
        for (int it = 0; it < 8; ++it) { kst[1][it] = kst[0][it]; kst[2][it] = kst[0][it]; }
        if (1 < ntile) KLOAD(kst[1], 1);
        if (2 < ntile) KLOAD(kst[2], 2);
#pragma unroll
        for (int jt = 0; jt < 16; ++jt) {
            if (jt < ntile) {
                LAS unsigned char* half = Vst + 16 * (jt & 1) * RS_V;
#pragma unroll
                for (int it = 0; it < 8; ++it) *(LAS v4u*)(half + (2 * it + (lane >> 5)) * RS_V + 16 * (lane & 31)) = kst[jt % 3][it];
                LDS_WAIT(); asm volatile("" ::: "memory");
                if (jt + 3 < ntile) KLOAD(kst[jt % 3], jt + 3);
                f32x4 acc = {0.f, 0.f, 0.f, 0.f};
#pragma unroll
                for (int s8 = 0; s8 < 8; ++s8) acc = __builtin_amdgcn_mfma_f32_16x16x32_bf16(*(const LAS bf16x8*)(half + n * RS_V + (32 * s8 + 8 * kg) * 2), bq[s8], acc, 0, 0, 0);
                f32x4 sv;
#pragma unroll
                for (int i = 0; i < 4; ++i) { const float v = (k4 + i < cnt - 16 * jt) ? acc[i] * 0.125f : -INFINITY; sv[i] = v; mx = fmaxf(mx, v); }
                S[jt] = sv;
                LDS_WAIT(); asm volatile("" ::: "memory");
            }
        }
#undef KLOAD
    }
    mx = fmaxf(mx, __shfl_xor(mx, 16)); mx = fmaxf(mx, __shfl_xor(mx, 32));
    float sum = 0.f;
    v4u pa[8];
#pragma unroll
    for (int s = 0; s < 8; ++s) { float p[8];
#pragma unroll
        for (int i = 0; i < 4; ++i) { p[i] = __expf(S[2 * s][i] - mx); p[4 + i] = __expf(S[2 * s + 1][i] - mx); }
#pragma unroll
        for (int i = 0; i < 8; ++i) sum += p[i];
        pa[s] = (v4u){pk2(p[0], p[1]), pk2(p[2], p[3]), pk2(p[4], p[5]), pk2(p[6], p[7])};
        __builtin_amdgcn_sched_barrier(0); }
    sum += __shfl_xor(sum, 16); sum += __shfl_xor(sum, 32);
    const float linv = 1.0f / sum;
    asm volatile("" ::: "memory");
    v4u vst[3][8];
#define VLOAD(dst, tile) do { _Pragma("unroll") for (int it = 0; it < 8; ++it) dst[it] = *(const GAS v4u*)(kvb + ((unsigned)idl[16 * (tile) + 2 * it + (lane >> 5)] * 1024u + voff)); } while (0)
#define VSTORE(src, tt) do { _Pragma("unroll") for (int it = 0; it < 8; ++it) { const int u = 2 * it + (lane >> 5); *(LAS v4u*)(Vst + (8 * (u >> 2) + 4 * (tt) + (u & 3)) * RS_V + 16 * (lane & 31)) = src[it]; } } while (0)
    VLOAD(vst[0], 0);
#pragma unroll
    for (int it = 0; it < 8; ++it) { vst[1][it] = vst[0][it]; vst[2][it] = vst[0][it]; }
    if (1 < ntile) VLOAD(vst[1], 1);
    if (2 < ntile) VLOAD(vst[2], 2);
    f32x4 o[4];
#pragma unroll
    for (int c = 0; c < 4; ++c) o[c] = (f32x4){0.f, 0.f, 0.f, 0.f};
    const int g16 = lane >> 4, q4 = (lane & 15) >> 2, p4 = lane & 3;
    const LAS unsigned char* trb = Vst + (8 * g16 + q4) * RS_V + 8 * p4;
#pragma unroll
    for (int s = 0; s < 8; ++s) {
        if (s < nstep) {
            VSTORE(vst[(2 * s) % 3], 0);
            VSTORE(vst[(2 * s + 1) % 3], 1);
            LDS_WAIT(); asm volatile("" ::: "memory");
            if (2 * s + 3 < ntile) VLOAD(vst[(2 * s) % 3], 2 * s + 3);
            if (2 * s + 4 < ntile) VLOAD(vst[(2 * s + 1) % 3], 2 * s + 4);
#pragma unroll
            for (int g = 0; g < 4; ++g) {
                const v4u pm = ((n >> 2) == g) ? pa[s] : (v4u){0u, 0u, 0u, 0u};
                const bf16x8 pf = __builtin_bit_cast(bf16x8, pm);
#pragma unroll
                for (int c = 0; c < 4; ++c) { const int ct = 4 * g + c;
                    const s16x4 lo = ldtr(trb + 32 * ct), hi = ldtr(trb + 4 * RS_V + 32 * ct);
                    const bf16x8 bv = (bf16x8){lo[0], lo[1], lo[2], lo[3], hi[0], hi[1], hi[2], hi[3]};
                    o[c] = __builtin_amdgcn_mfma_f32_16x16x32_bf16(pf, bv, o[c], 0, 0, 0); }
            }
            LDS_WAIT(); asm volatile("" ::: "memory");
        }
    }
#undef VLOAD
#undef VSTORE
#pragma unroll
    for (int i = 0; i < 4; ++i) { const float li = __shfl(linv, 4 * kg + i);
#pragma unroll
        for (int c = 0; c < 4; ++c) YA[(size_t)m * D + (4 * kg + i) * 64 + 16 * c + n] = (bf16)f2bf(o[c][i] * li); }
}

__device__ __forceinline__ void attn_sample_query(LAS unsigned char* lds, int tid, const GAS bf16* P1, const GAS bf16* KVB, const GAS float* ck, const GAS float* cv, const GAS int* ptab, const GAS int* IDXS, GAS bf16* YA, int qi) {
    const int lane = tid & 63, wave = tid >> 6, bd = qi >> 3; const size_t m = (size_t)MP + qi;
    LAS float* Sl = (LAS float*)lds;
    LAS float* Ol = Sl + 16 * 256;
    LAS float* ql = Ol + 8 * 1024;
    LAS float* linv = ql + 1024;
    LAS int* rowsel = (LAS int*)(linv + 16);
    { const unsigned w = *(const GAS unsigned*)(P1 + m * LDP1 + C_Q + 2 * tid); ql[2 * tid] = __uint_as_float(w << 16); ql[2 * tid + 1] = __uint_as_float(w & 0xffff0000u); }
    if (tid < 256) rowsel[tid] = IDXS[qi * 256 + tid];
    __syncthreads();
    const int g = lane >> 4, c = lane & 15;
    float qr[4][4];
#pragma unroll
    for (int a = 0; a < 4; ++a) { const f32x4 t = *(const LAS f32x4*)(ql + (4 * g + a) * 64 + 4 * c); qr[a][0] = t.x; qr[a][1] = t.y; qr[a][2] = t.z; qr[a][3] = t.w; }
#pragma unroll 4
    for (int kk = 0; kk < 32; ++kk) {
        const int key = 32 * wave + kk, idx = rowsel[key];
        f32x4 kv;
        if (idx < PAST) { const int page = ptab[bd * NPAGES + (idx >> 7)]; kv = *(const GAS f32x4*)(ck + ((size_t)page * PAGE + (idx & 127)) * 256 + 4 * lane); }
        else { const v2u w = *(const GAS v2u*)(KVB + (size_t)(MP + bd * DS + (idx - PAST)) * 512 + 4 * lane);
            kv = (f32x4){__uint_as_float(w.x << 16), __uint_as_float(w.x & 0xffff0000u), __uint_as_float(w.y << 16), __uint_as_float(w.y & 0xffff0000u)}; }
        float part[4];
#pragma unroll
        for (int a = 0; a < 4; ++a) { float s = (qr[a][0] * kv.x + qr[a][1] * kv.y) + (qr[a][2] * kv.z + qr[a][3] * kv.w);
            part[a] = row16_sum(s); }
        if (c == 0) {
#pragma unroll
            for (int a = 0; a < 4; ++a) Sl[(4 * g + a) * 256 + key] = part[a] * 0.125f; }
    }
    __syncthreads();
#pragma unroll
    for (int hs = 0; hs < 2; ++hs) { const int head = 2 * wave + hs; float v[4]; float mx = -INFINITY;
#pragma unroll
        for (int j = 0; j < 4; ++j) { v[j] = Sl[head * 256 + lane + 64 * j]; mx = fmaxf(mx, v[j]); }
        mx = wave_max(mx); float sum = 0.f;
#pragma unroll
        for (int j = 0; j < 4; ++j) { v[j] = __expf(v[j] - mx); sum += v[j]; Sl[head * 256 + lane + 64 * j] = v[j]; }
        sum = wave_sum(sum);
        if (lane == 0) linv[head] = 1.0f / sum; }
    __syncthreads();
    float o[4][4];
#pragma unroll
    for (int a = 0; a < 4; ++a)
#pragma unroll
        for (int cc = 0; cc < 4; ++cc) o[a][cc] = 0.f;
#pragma unroll 4
    for (int kk = 0; kk < 32; ++kk) {
        const int key = 32 * wave + kk, idx = rowsel[key];
        f32x4 vv;
        if (idx < PAST) { const int page = ptab[bd * NPAGES + (idx >> 7)]; vv = *(const GAS f32x4*)(cv + ((size_t)page * PAGE + (idx & 127)) * 256 + 4 * lane); }
        else { const v2u w = *(const GAS v2u*)(KVB + (size_t)(MP + bd * DS + (idx - PAST)) * 512 + 256 + 4 * lane);
            vv = (f32x4){__uint_as_float(w.x << 16), __uint_as_float(w.x & 0xffff0000u), __uint_as_float(w.y << 16), __uint_as_float(w.y & 0xffff0000u)}; }
#pragma unroll
        for (int a = 0; a < 4; ++a) { const float p = Sl[(4 * g + a) * 256 + key]; o[a][0] += p * vv.x; o[a][1] += p * vv.y; o[a][2] += p * vv.z; o[a][3] += p * vv.w; }
    }
#pragma unroll
    for (int a = 0; a < 4; ++a) *(LAS f32x4*)(Ol + wave * 1024 + (4 * g + a) * 64 + 4 * c) = (f32x4){o[a][0], o[a][1], o[a][2], o[a][3]};
    __syncthreads();
    { float s0 = 0.f, s1 = 0.f;
#pragma unroll
      for (int w = 0; w < 8; ++w) { s0 += Ol[w * 1024 + 2 * tid]; s1 += Ol[w * 1024 + 2 * tid + 1]; }
      const float li = linv[(2 * tid) >> 6];
      *(GAS unsigned*)(YA + m * D + 2 * tid) = pk2(s0 * li, s1 * li); }
    __syncthreads();
}

constexpr int TAIL_R0 = 16384, TAIL_NRT = (MR - TAIL_R0) / 64;
static_assert(TAIL_R0 + 64 * TAIL_NRT == MR, "tail rows");
template <int MODE>
__device__ __forceinline__ void tail_gemm(LAS unsigned char* lds, const GAS bf16* A, int K, const GAS bf16* Bt, int N, const GAS bf16* P1, GAS bf16* T1, GAS bf16* MG, GAS float* H, GAS bf16* A2, int bx, int G, int tid) {
    constexpr int KB = 256, RS = (KB + 8) * 2;
    const int lane = tid & 63, wave = __builtin_amdgcn_readfirstlane(tid >> 6), col = lane & 31, hh = lane >> 5;
    const int nunits = TAIL_NRT * (N / 64), lr = tid >> 3, lc = tid & 7, ti = wave & 3, kh = wave >> 2;
    LAS unsigned char* As = lds; LAS unsigned char* Bs = lds + 64 * RS; LAS float* red = (LAS float*)(lds + 2 * 64 * RS);
    for (int u = bx; u < nunits; u += G) {
        const int rt = u % TAIL_NRT, ct = u / TAIL_NRT;
        const GAS bf16* ap = A + (size_t)(TAIL_R0 + 64 * rt + lr) * K + 8 * lc;
        const GAS bf16* bp = Bt + (size_t)(64 * ct + lr) * K + 8 * lc;
        v4u ra[4], rb[4];
#pragma unroll
        for (int j = 0; j < 4; ++j) { ra[j] = *(const GAS v4u*)(ap + 64 * j); rb[j] = *(const GAS v4u*)(bp + 64 * j); }
        f32x16 acc = {};
        for (int k0 = 0; k0 < K; k0 += KB) {
            __syncthreads();
#pragma unroll
            for (int j = 0; j < 4; ++j) { *(LAS v4u*)(As + lr * RS + (lc * 8 + 64 * j) * 2) = ra[j]; *(LAS v4u*)(Bs + lr * RS + (lc * 8 + 64 * j) * 2) = rb[j]; }
            if (k0 + KB < K) {
#pragma unroll
                for (int j = 0; j < 4; ++j) { ra[j] = *(const GAS v4u*)(ap + k0 + KB + 64 * j); rb[j] = *(const GAS v4u*)(bp + k0 + KB + 64 * j); } }
            __syncthreads();
#pragma unroll
            for (int j = 0; j < 8; ++j) { const int ks = 8 * kh + j;
                const bf16x8 av = *(const LAS bf16x8*)(As + (32 * (ti >> 1) + col) * RS + (16 * ks + 8 * hh) * 2), bv = *(const LAS bf16x8*)(Bs + (32 * (ti & 1) + col) * RS + (16 * ks + 8 * hh) * 2);
                acc = __builtin_amdgcn_mfma_f32_32x32x16_bf16(av, bv, acc, 0, 0, 0); }
        }
        __syncthreads();
        if (kh == 1) {
#pragma unroll
            for (int r = 0; r < 16; ++r) red[(ti * 16 + r) * 64 + lane] = acc[r]; }
        __syncthreads();
        if (kh == 0) {
            const int c = 64 * ct + 32 * (ti & 1) + col;
#pragma unroll
            for (int r = 0; r < 16; ++r) { const size_t row = TAIL_R0 + 64 * rt + 32 * (ti >> 1) + (r & 3) + 8 * (r >> 2) + 4 * hh; const float v = acc[r] + red[(ti * 16 + r) * 64 + lane];
                if (MODE == 1) { const float g = __uint_as_float((unsigned)P1[row * LDP1 + C_GS + c] << 16); T1[row * D + c] = (bf16)f2bf(v * sigm(g)); }
                if (MODE == 2) { const float g = __uint_as_float((unsigned)P1[row * LDP1 + C_GA + c] << 16); MG[row * D + c] = (bf16)f2bf(__uint_as_float((unsigned)T1[row * D + c] << 16) + v * sigm(g)); }
                if (MODE == 3) H[row * D + c] += v;
                if (MODE == 4) { const float w = fmaxf(v, 0.f); A2[row * DFF + c] = (bf16)f2bf(w * w); } }
        }
    }
    __syncthreads();
}

#ifndef REP_SEL
#define REP_SEL 1
#endif
#ifndef REP_CONV
#define REP_CONV 1
#endif
#ifndef REP_TOPK
#define REP_TOPK 1
#endif
#ifndef REP_SSC
#define REP_SSC 1
#endif
#ifndef REP_SSEL
#define REP_SSEL 1
#endif
#ifndef REP_SSD1
#define REP_SSD1 1
#endif
#ifndef REP_SREC
#define REP_SREC 1
#endif
#ifndef REP_SCAN
#define REP_SCAN 1
#endif
#ifndef REP_ATTS
#define REP_ATTS 1
#endif
#ifndef REP_ATTP
#define REP_ATTP 1
#endif
#ifndef REP_SSD3
#define REP_SSD3 1
#endif
__device__ __forceinline__ void xcd_barrier_ni(unsigned* bar, unsigned x, volatile LAS unsigned* st, int tid, unsigned G) { XcdBarrier b; b.bar = bar; b.x = x; b.st = st; xcd_barrier(b, tid, G); }
__device__ __forceinline__ void assume_global(const void* p) {
#if defined(__HIP_DEVICE_COMPILE__)
    __builtin_assume(!__builtin_amdgcn_is_shared((const __attribute__((address_space(0))) void*)p));
    __builtin_assume(!__builtin_amdgcn_is_private((const __attribute__((address_space(0))) void*)p));
#else
    (void)p;
#endif
}
__device__ __forceinline__ int tid_now(int wave0) { unsigned ones = ~0u; asm volatile("" : "+s"(ones)); return (wave0 << 6) | (int)__builtin_amdgcn_mbcnt_hi(ones, __builtin_amdgcn_mbcnt_lo(ones, 0u)); }
constexpr int NPH = 12, NPHASES = 1 + 2 * NPH;
struct Args { const void* in[24]; float* out; unsigned char* ws; int l_lo, l_hi; };
static_assert(sizeof(Args) == 24 * 8 + 8 + 8 + 8, "Args has no padding");

template <int KLO, int KHI>
__global__ void __launch_bounds__(NT, 2) fwd_t(Args args) {
    extern __shared__ __attribute__((aligned(16))) unsigned char lds_raw[];
    LAS unsigned char* lds0 = (LAS unsigned char*)lds_raw;
    volatile LAS unsigned* MISCW = (volatile LAS unsigned*)(lds0 + MISC_OFF);
    const int G = gridDim.x, bx = blockIdx.x, NGW = G * NWAVES;
    const int wave0 = __builtin_amdgcn_readfirstlane((int)threadIdx.x >> 6);
#define TID_NOW() tid_now(wave0)
    { const int tid0 = threadIdx.x;
      for (int u = tid0; u < (LDS_BYTES - LDSCTL_OFF) / 4; u += NT) ((LAS unsigned*)(lds0 + LDSCTL_OFF))[u] = 0u; }
    __syncthreads();
    XcdBarrier bar = xcd_barrier_post((unsigned*)(args.ws + WS_CTL) + CW_BAR, MISCW + 8);
#define IN(k) (KLO <= (k) && (k) < KHI)
#define SEAM(k) do { if (IN(k) && IN((k) + 1)) xcd_barrier_ni(bar.bar, bar.x, bar.st, TID_NOW(), (unsigned)G); } while (0)
#define PHASE_REGS \
    int tid = TID_NOW(); asm volatile("" : "+v"(tid)); \
    int bxl = bx, Gl = G; asm volatile("" : "+s"(bxl), "+s"(Gl)); (void)bxl; (void)Gl;     \
    const int lane = tid & 63, wave = __builtin_amdgcn_readfirstlane(tid >> 6), gw = bx * NWAVES + wave; \
    unsigned char* ws_ = args.ws; asm volatile("" : "+s"(ws_)); GAS unsigned char* ws = (GAS unsigned char*)ws_;     \
    float* out_ = args.out; asm volatile("" : "+s"(out_)); GAS float* out = (GAS float*)out_; \
    (void)lane; (void)gw; (void)out; \
    GAS float* H = (GAS float*)(ws + WS_H); GAS bf16* U = (GAS bf16*)(ws + WS_U); GAS bf16* P1 = (GAS bf16*)(ws + WS_P1); GAS float* MISCB = (GAS float*)(ws + WS_MISC); GAS bf16* KIB = (GAS bf16*)(ws + WS_KIB); \
    GAS bf16* XC = (GAS bf16*)(ws + WS_XC); GAS float* DT = (GAS float*)(ws + WS_DT); GAS float* DA = (GAS float*)(ws + WS_DA); GAS float* YS = (GAS float*)(ws + WS_YS); GAS bf16* YSN = (GAS bf16*)(ws + WS_YSN); \
    GAS bf16* YA = (GAS bf16*)(ws + WS_YA); GAS bf16* T1 = (GAS bf16*)(ws + WS_T1); GAS bf16* MG = (GAS bf16*)(ws + WS_MG); GAS bf16* A2 = (GAS bf16*)(ws + WS_A2); \
    GAS unsigned short* IDXP = (GAS unsigned short*)(ws + WS_IDXP); GAS int* IDXS = (GAS int*)(ws + WS_IDXS); GAS float* SCS = (GAS float*)(ws + WS_SCS); \
    GAS bf16* SB = (GAS bf16*)(ws + WS_SB); GAS float* DEC = (GAS float*)(ws + WS_DEC); GAS bf16* HC = (GAS bf16*)(ws + WS_HC); GAS bf16* KVB = (GAS bf16*)(ws + WS_KVB); GAS bf16* KIB2 = (GAS bf16*)(ws + WS_KIB2); (void)KIB2; (void)SB; (void)DEC; (void)HC; (void)KVB; \
    GAS unsigned char* wl = ws + WS_W + (size_t)l * WL_SIZE; \
    (void)H; (void)U; (void)P1; (void)MISCB; (void)KIB; (void)XC; (void)DT; (void)DA; (void)YS; (void)YSN; (void)YA; (void)T1; (void)MG; (void)A2; (void)IDXP; (void)IDXS; (void)SCS; (void)wl;
#define LDS_LOCAL LAS unsigned char* lds = lds0; asm volatile("" : "+s"(lds));
#define INP(T, name, i) const GAS T* name; { const void* p_; asm volatile("s_load_dwordx2 %0, %1, %2\n\ts_waitcnt lgkmcnt(0)" : "=s"(p_) : "s"(__builtin_amdgcn_kernarg_segment_ptr()), "i"((i) * 8)); name = (const GAS T*)p_; }

    if (IN(0) && args.l_lo == 0) {
        const int l = 0; PHASE_REGS
        LDS_LOCAL
        INP(float, w_in, 10) INP(float, w_ssm, 17) INP(float, w_att, 18) INP(float, w_out, 19) INP(float, w_up, 21) INP(float, w_down, 22) INP(float, meta, 8) INP(float, x_prompt, 0) INP(float, x_sample, 1) INP(float, norm1_w, 9)
        LAS float* scr = (LAS float*)(lds + wave * 17408);
        constexpr int I_IN = (D / 64) * (NIN / 64), I_SSM = (DIN / 64) * (D / 64), I_ATT = (D / 64) * (D / 64), I_OUT = I_ATT, I_UP = (D / 64) * (DFF / 64), I_DN = (DFF / 64) * (D / 64);
        constexpr int I_L = I_IN + I_SSM + I_ATT + I_OUT + I_UP + I_DN;
        for (int it = gw; it < 2 * I_L; it += NGW) {
            const int l = it / I_L; int r = it % I_L; GAS unsigned char* wl = ws + WS_W + (size_t)l * WL_SIZE;
            if (r < I_IN) { tr_item(w_in + (size_t)l * D * IN_DIM, D, IN_DIM, (GAS bf16*)(wl + WL_WIN), NIN / 64, true, scr, r, lane); continue; } r -= I_IN;
            if (r < I_SSM) { tr_item(w_ssm + (size_t)l * DIN * D, DIN, D, (GAS bf16*)(wl + WL_WSSM), D / 64, false, scr, r, lane); continue; } r -= I_SSM;
            if (r < I_ATT) { tr_item(w_att + (size_t)l * D * D, D, D, (GAS bf16*)(wl + WL_WATT), D / 64, false, scr, r, lane); continue; } r -= I_ATT;
            if (r < I_OUT) { tr_item(w_out + (size_t)l * D * D, D, D, (GAS bf16*)(wl + WL_WOUT), D / 64, false, scr, r, lane); continue; } r -= I_OUT;
            if (r < I_UP) { tr_item(w_up + (size_t)l * D * DFF, D, DFF, (GAS bf16*)(wl + WL_WUP), DFF / 64, false, scr, r, lane); continue; } r -= I_UP;
            tr_item(w_down + (size_t)l * DFF * D, DFF, D, (GAS bf16*)(wl + WL_WDN), D / 64, false, scr, r, lane);
        }
        for (int m0 = gw; m0 < MPAD; m0 += 4 * NGW) {
            const GAS float* src[4]; GAS float* hd[4]; GAS bf16* ud[4]; GAS float* fd[4]; bool live[4];
#pragma unroll
            for (int r = 0; r < 4; ++r) { const int m = m0 + r * NGW; live[r] = m < MPAD; src[r] = nullptr; fd[r] = nullptr; hd[r] = H + (size_t)m * D; ud[r] = U + (size_t)m * D;
                if (m < MP) { const int b = m / LP, t = m - b * LP; src[r] = t < NMETA ? meta + (size_t)t * D : x_prompt + ((size_t)b * SEQ + (t - NMETA)) * D; }
                else if (m < MR) src[r] = x_sample + (size_t)(m - MP) * D; }
            rms_rows4g(src, norm1_w, hd, ud, fd, live, lane);
        }
    }
    SEAM(0);

    for (int l = args.l_lo; l < args.l_hi; ++l) {
        constexpr int pb = 1;

        if (IN(pb + 0)) {
            PHASE_REGS
            LAS unsigned char* lds = lds0;
            pg8::Gemm gm{U, (const GAS bf16*)(wl + WL_WIN), MPAD, NIN, D}; pg8::StaticOrder S; S.init(MPAD, NIN, Gl, bxl);
            pg8::EpiIn E{P1, KVB, MISCB, KIB, KIB2, out + O_PK + (size_t)l * MP * 256, out + O_PV + (size_t)l * MP * 256, out + O_PKI + (size_t)l * MP * 64,
                         out + O_SK + (size_t)l * MS * 256, out + O_SV + (size_t)l * MS * 256, out + O_SKI + (size_t)l * MS * 64};
            pg8::gemm_phase<pg8::EpiIn, pg8::StaticOrder, true, true>(lds, gm, S, E, tid);
        }
        SEAM(pb + 0);

        if (IN(pb + 1)) {
            PHASE_REGS
            LDS_LOCAL
            INP(float, state_conv, 6) INP(float, conv_b, 12) INP(float, conv_w, 11) INP(float, dt_bias, 13) INP(float, a_log, 14) INP(float, cache_ki, 4) INP(int, page_table, 7)
            for (int rp_ = 0; rp_ < REP_CONV; ++rp_) for (int it = bx * NT + tid; it < (MR / 8) * 384; it += G * NT) {
                const int rg = it / 384, c8 = (it % 384) * 8, m0 = 8 * rg;
                const bool isS = m0 >= MP; int tpos, sq;
                if (!isS) { sq = m0 / LP; tpos = m0 - sq * LP; } else { sq = (m0 - MP) >> 3; tpos = (m0 - MP) & 7; }
                float xv[11][8];
#pragma unroll
                for (int k = 0; k < 11; ++k) { const int dtp = tpos - 3 + k;
                    if (dtp >= 0) unpack8(*(const GAS v4u*)(P1 + (size_t)(m0 - 3 + k) * LDP1 + C_XBC + c8), xv[k]);
                    else if (isS) { const GAS float* pp = state_conv + ((size_t)(l * DB + sq) * 3 + (3 + dtp)) * CONVD + c8; const f32x4 a = *(const GAS f32x4*)pp, b = *(const GAS f32x4*)(pp + 4);
                        xv[k][0] = a.x; xv[k][1] = a.y; xv[k][2] = a.z; xv[k][3] = a.w; xv[k][4] = b.x; xv[k][5] = b.y; xv[k][6] = b.z; xv[k][7] = b.w; }
                    else {
#pragma unroll
                        for (int j = 0; j < 8; ++j) xv[k][j] = 0.f; } }
                float wv[4][8], bv[8];
                { const GAS float* bp = conv_b + (size_t)l * CONVD + c8; const f32x4 a = *(const GAS f32x4*)bp, b = *(const GAS f32x4*)(bp + 4);
                  bv[0] = a.x; bv[1] = a.y; bv[2] = a.z; bv[3] = a.w; bv[4] = b.x; bv[5] = b.y; bv[6] = b.z; bv[7] = b.w; }
#pragma unroll
                for (int k = 0; k < 4; ++k) { const GAS float* wp = conv_w + ((size_t)l * 4 + k) * CONVD + c8; const f32x4 a = *(const GAS f32x4*)wp, b = *(const GAS f32x4*)(wp + 4);
                    wv[k][0] = a.x; wv[k][1] = a.y; wv[k][2] = a.z; wv[k][3] = a.w; wv[k][4] = b.x; wv[k][5] = b.y; wv[k][6] = b.z; wv[k][7] = b.w; }
#pragma unroll
                for (int r = 0; r < 8; ++r) {
                    float y[8];
#pragma unroll
                    for (int j = 0; j < 8; ++j) { float s = bv[j];
#pragma unroll
                        for (int k = 0; k < 4; ++k) s += xv[r + k][j] * wv[k][j];
                        y[j] = s * sigm(s); }
                    *(GAS v4u*)(XC + (size_t)(m0 + r) * CONVD + c8) = (v4u){pk2(y[0], y[1]), pk2(y[2], y[3]), pk2(y[4], y[5]), pk2(y[6], y[7])};
                    const int tp = tpos + r; GAS float* cs = nullptr;
                    if (!isS && tp >= LP - 3) cs = out + O_PCONV + ((size_t)(l * NB + sq) * 3 + (tp - (LP - 3))) * CONVD + c8;
                    if (isS && tp >= DS - 3) cs = out + O_SCONV + ((size_t)(l * DB + sq) * 3 + (tp - (DS - 3))) * CONVD + c8;
                    if (cs) { *(GAS f32x4*)cs = (f32x4){xv[r + 3][0], xv[r + 3][1], xv[r + 3][2], xv[r + 3][3]}; *(GAS f32x4*)(cs + 4) = (f32x4){xv[r + 3][4], xv[r + 3][5], xv[r + 3][6], xv[r + 3][7]}; }
                }
            }
            for (int it = bx * NT + tid; it < MR * NH; it += G * NT) {
                const int m = it >> 5, h = it & 31;
                const float raw = MISCB[(size_t)m * 128 + MC_DT + h] + dt_bias[l * NH + h];
                const float sp = fmaxf(raw, 0.f) + log1pf(__expf(-fabsf(raw)));
                const float A = -__expf(a_log[l * NH + h]);
                DT[it] = sp; DA[it] = __expf(sp * A);
            }
            for (int rp_ = 0; rp_ < REP_TOPK; ++rp_) {
                constexpr int SLD = 4352;
                LAS unsigned* scl = (LAS unsigned*)lds; LAS unsigned* histq = (LAS unsigned*)(lds + 8 * SLD * 4);
                for (int j = 0; ; ++j) {
                    const int unit = j * G + ((j & 1) ? (G - 1 - bx) : bx); if (unit >= NB * (LP / 8)) break;
                    const int b = unit & (NB - 1), qb = (LP / 8 - 1) - (unit >> 2);
                    const size_t mq0 = (size_t)b * LP + 8 * qb; const int nkeys = 8 * qb + 8, ntl = (nkeys + 31) >> 5;
                    bf16x8 afr[2][4]; float wq[2][2][8];
                    idx_load_q(P1, MISCB, mq0, lane, afr, wq);
                    for (int i = tid; i < 8 * HB; i += NT) histq[i] = 0u;
                    __syncthreads();
                    const int kcol = lane & 31, hh = lane >> 5;
                    const GAS bf16* kp0 = KIB2 + (size_t)b * KT_PER_B * 2048 + lane * 8;
                    bf16x8 bnx[4], bn2[4];
#pragma unroll
                    for (int ks = 0; ks < 4; ++ks) { bnx[ks] = (bf16x8){0, 0, 0, 0, 0, 0, 0, 0}; bn2[ks] = bnx[ks]; }
                    if (wave < ntl) {
#pragma unroll
                        for (int ks = 0; ks < 4; ++ks) bnx[ks] = *(const GAS bf16x8*)(kp0 + (size_t)wave * 2048 + 512 * ks); }
                    if (wave + NWAVES < ntl) {
#pragma unroll
                        for (int ks = 0; ks < 4; ++ks) bn2[ks] = *(const GAS bf16x8*)(kp0 + (size_t)(wave + NWAVES) * 2048 + 512 * ks); }
                    for (int kt = wave; kt < ntl; kt += NWAVES) {
                        bf16x8 bfr[4];
#pragma unroll
                        for (int ks = 0; ks < 4; ++ks) { bfr[ks] = bnx[ks]; bnx[ks] = bn2[ks]; }
                        if (kt + 2 * NWAVES < ntl) {
#pragma unroll
                            for (int ks = 0; ks < 4; ++ks) bn2[ks] = *(const GAS bf16x8*)(kp0 + (size_t)(kt + 2 * NWAVES) * 2048 + 512 * ks); }
                        float sc[2][2];
                        idx_scores(afr, bfr, wq, sc);
                        const int key = 32 * kt + kcol;
#pragma unroll
                        for (int rt = 0; rt < 2; ++rt)
#pragma unroll
                            for (int jq = 0; jq < 2; ++jq) { const int q = 4 * rt + 2 * hh + jq; scl[q * SLD + key] = f2key(sc[rt][jq]);
                                if (key <= 8 * qb + q) { int bn = __float2int_rd(sc[rt][jq] * 64.0f) + 256; bn = bn < 0 ? 0 : (bn > HB - 1 ? HB - 1 : bn);
                                    __hip_atomic_fetch_add(histq + q * HB + bn, 1u, __ATOMIC_RELAXED, __HIP_MEMORY_SCOPE_WORKGROUP); } }
                    }
                    __syncthreads();
                    for (int r2_ = 0; r2_ < REP_SEL; ++r2_) { const int t = 8 * qb + wave, n = t + 1; GAS unsigned short* op = IDXP + ((size_t)b * LP + t) * 256;
                      if (n <= 256) { for (int i = lane; i < n; i += 64) op[i] = (unsigned short)i; }
                      else topk_select(scl + wave * SLD, n, lane, op, histq + wave * HB); }
                    __syncthreads();
                }
            }
            const GAS float* cki = cache_ki + (size_t)l * NPOOL * PAGE * 64;
            for (int rp_ = 0; rp_ < REP_SSC; ++rp_) for (int unit = bx; unit < DB * 8; unit += G) {
                const int bd = unit >> 3, ch = unit & 7; const size_t mq0 = (size_t)MP + bd * DS;
                bf16x8 afr[2][4]; float wq[2][2][8];
                idx_load_q(P1, MISCB, mq0, lane, afr, wq);
                const int kcol = lane & 31, hh = lane >> 5;
                const int pg = 8 * ch + wave, phys = page_table[bd * NPAGES + pg];
                const GAS float* kbase = cki + (size_t)phys * PAGE * 64;
#pragma unroll 1
                for (int kt = 0; kt < 4; ++kt) {
                    const int kin = 32 * kt + kcol; const GAS float* kp = kbase + (size_t)kin * 64 + 8 * hh;
                    bf16x8 bfr[4];
#pragma unroll
                    for (int ks = 0; ks < 4; ++ks) { const f32x4 a = *(const GAS f32x4*)(kp + 16 * ks), bq = *(const GAS f32x4*)(kp + 16 * ks + 4);
                        const v4u w = (v4u){pk2(a.x, a.y), pk2(a.z, a.w), pk2(bq.x, bq.y), pk2(bq.z, bq.w)}; bfr[ks] = __builtin_bit_cast(bf16x8, w); }
                    float sc[2][2];
                    idx_scores(afr, bfr, wq, sc);
#pragma unroll
                    for (int rt = 0; rt < 2; ++rt)
#pragma unroll
                        for (int jq = 0; jq < 2; ++jq) SCS[(size_t)(bd * DS + 4 * rt + 2 * hh + jq) * SCS_LD + 128 * pg + kin] = sc[rt][jq];
                }
                if (ch == 7 && wave == 0) {
                    const int j = kcol < DS ? kcol : DS - 1; const GAS bf16* kp = KIB + (mq0 + j) * 64 + 8 * hh;
                    bf16x8 bfr[4];
#pragma unroll
                    for (int ks = 0; ks < 4; ++ks) bfr[ks] = *(const GAS bf16x8*)(kp + 16 * ks);
                    float sc[2][2];
                    idx_scores(afr, bfr, wq, sc);
                    if (kcol < DS) {
#pragma unroll
                        for (int rt = 0; rt < 2; ++rt)
#pragma unroll
                            for (int jq = 0; jq < 2; ++jq) { const int q = 4 * rt + 2 * hh + jq; SCS[(size_t)(bd * DS + q) * SCS_LD + PAST + kcol] = (kcol <= q) ? sc[rt][jq] : -INFINITY; }
                    }
                }
            }
        }
        SEAM(pb + 1);

        if (IN(pb + 2)) {
            PHASE_REGS
            LDS_LOCAL
            INP(float, a_log, 14) INP(float, state_ssm, 5) INP(float, d_skip, 15)
            for (int rp_ = 0; rp_ < REP_SSEL; ++rp_) for (int qi = bx; qi < MS; qi += G) {
                LAS unsigned* scl = (LAS unsigned*)lds; LAS unsigned* hs = (LAS unsigned*)(lds + 8448 * 4);
                hs[tid] = 0u;
                __syncthreads();
                for (int i = tid; i < PAST + DS; i += NT) { const float sc = SCS[(size_t)qi * SCS_LD + i]; scl[i] = f2key(sc);
                    int bn = __float2int_rd(fmaxf(sc, -8.0f) * 64.0f) + 256; bn = bn < 0 ? 0 : (bn > HB - 1 ? HB - 1 : bn);
                    __hip_atomic_fetch_add(hs + bn, 1u, __ATOMIC_RELAXED, __HIP_MEMORY_SCOPE_WORKGROUP); }
                __syncthreads();
                if (wave == 0) { int ns = PAST + DS; asm volatile("" : "+s"(ns)); topk_select(scl, ns, lane, IDXS + qi * 256, hs); }
                __syncthreads();
            }
            for (int rp_ = 0; rp_ < REP_SSD1; ++rp_) for (int unit = bx; unit < NB * NCH * NG; unit += G) {
                int b, c, g; if (unit < NB * 32 * NG) { b = unit >> 7; c = 1 + ((unit & 127) >> 2); g = unit & 3; } else { const int r = unit - NB * 32 * NG; b = r >> 2; c = 0; g = r & 3; }
                ssd1_unit(lds, tid, XC, DT, a_log + l * NH, SB, DEC, b, c, g);
            }
            for (int rp_ = 0; rp_ < REP_SREC; ++rp_) for (int unit = bx; unit < DB * NH * 2; unit += G) {
                const int bd = unit >> 6, h = (unit >> 1) & 31, p0 = (unit & 1) * 32;
                ssd_unit(lds, tid, XC, DT, DA, (size_t)MP + bd * DS, DS, h, p0, state_ssm + ((size_t)(l * DB + bd) * NH + h) * HP * NST,
                         out + O_SSSM + ((size_t)(l * DB + bd) * NH + h) * HP * NST, YS, d_skip[l * NH + h]);
                __syncthreads();
            }
        }
        SEAM(pb + 2);

        if (IN(pb + 3)) {
            PHASE_REGS
            LDS_LOCAL
            INP(float, cache_k, 2) INP(float, cache_v, 3) INP(int, page_table, 7)
            for (int rp_ = 0; rp_ < REP_SCAN; ++rp_) for (int e = bx * NT + tid; e < NB * NH * 2048; e += G * NT) {
                const int b = e / (NH * 2048), h = (e >> 11) & 31, q = e & 2047;
                f32x4 Hr = {0.f, 0.f, 0.f, 0.f};
#pragma unroll 3
                for (int c = 0; c < NCH; ++c) { const size_t idx = (size_t)(b * NCH + c) * NH + h;
                    { const int p = q >> 5, n = (q & 31) * 4;
                      *(GAS v2u*)(HC + idx * (HP * NST) + ((((p >> 5) * 8 + (n >> 4)) * 2 + ((n >> 3) & 1)) * 32 + (p & 31)) * 8 + (n & 7)) = (v2u){pk2(Hr.x, Hr.y), pk2(Hr.z, Hr.w)}; }
                    const float d = DEC[idx]; const v2u sw = *(const GAS v2u*)(SB + idx * (HP * NST) + q * 4);
                    const f32x4 sv = (f32x4){__uint_as_float(sw.x << 16), __uint_as_float(sw.x & 0xffff0000u), __uint_as_float(sw.y << 16), __uint_as_float(sw.y & 0xffff0000u)};
                    Hr = Hr * d + sv; }
                *(GAS f32x4*)(out + O_PSSM + ((size_t)(l * NB + b) * NH + h) * (HP * NST) + q * 4) = Hr;
            }
            const GAS float* ck = cache_k + (size_t)l * NPOOL * PAGE * 256; const GAS float* cv = cache_v + (size_t)l * NPOOL * PAGE * 256;
            for (int rp_ = 0; rp_ < REP_ATTS; ++rp_) for (int qi = bx; qi < MS; qi += G) attn_sample_query(lds, tid, P1, KVB, ck, cv, page_table, IDXS, YA, qi);
            for (int rp_ = 0; rp_ < REP_ATTP; ++rp_) {
                if (Gl == 256) {
                    const int bsel = (bxl & 7) >> 1, widx = ((((bxl >> 3) * NWAVES) + wave) << 1) | (bxl & 1);
                    for (int tr = widx; tr < LP; tr += 512) attn_prompt_query(lds + wave * 17408, P1, KVB, IDXP, YA, bsel * LP + (LP - 1 - tr), lane);
                } else for (int m = gw; m < MP; m += NGW) attn_prompt_query(lds + wave * 17408, P1, KVB, IDXP, YA, m, lane);
            }
        }
        SEAM(pb + 3);

        if (IN(pb + 4)) {
            PHASE_REGS
            LDS_LOCAL
            INP(float, a_log, 14) INP(float, d_skip, 15) INP(float, ssm_norm_w, 16)
            for (int rp_ = 0; rp_ < REP_SSD3; ++rp_) for (int unit = bx; unit < NB * NCH * NG; unit += G) {
                int b, c, g; if (unit < NB * 32 * NG) { b = unit >> 7; c = 1 + ((unit & 127) >> 2); g = unit & 3; } else { const int r = unit - NB * 32 * NG; b = r >> 2; c = 0; g = r & 3; }
                ssd3_unit(lds, tid, XC, P1, DT, a_log + l * NH, d_skip + l * NH, ssm_norm_w + (size_t)l * DIN, HC, YSN, b, c, g);
            }
            for (int it = gw; it < MS * NG; it += NGW) {
                const int m = MP + (it >> 2), g = it & 3, c0 = g * 512 + lane * 8;
                const GAS float* yp = YS + (size_t)m * DIN + c0; const f32x4 a = *(const GAS f32x4*)yp, b = *(const GAS f32x4*)(yp + 4);
                float z[8]; unpack8(*(const GAS v4u*)(P1 + (size_t)m * LDP1 + C_Z + c0), z);
                float v[8] = {a.x, a.y, a.z, a.w, b.x, b.y, b.z, b.w}; float ss = 0.f;
#pragma unroll
                for (int j = 0; j < 8; ++j) { v[j] = v[j] * (z[j] * sigm(z[j])); ss += v[j] * v[j]; }
                ss = wave_sum(ss);
                const float rstd = 1.0f / sqrtf(ss * (1.0f / 512.0f) + 1e-6f);
                const GAS float* wp = ssm_norm_w + (size_t)l * DIN + c0; const f32x4 wa = *(const GAS f32x4*)wp, wb = *(const GAS f32x4*)(wp + 4);
                *(GAS v4u*)(YSN + (size_t)m * DIN + c0) = (v4u){pk2(v[0] * rstd * wa.x, v[1] * rstd * wa.y), pk2(v[2] * rstd * wa.z, v[3] * rstd * wa.w), pk2(v[4] * rstd * wb.x, v[5] * rstd * wb.y), pk2(v[6] * rstd * wb.z, v[7] * rstd * wb.w)};
            }
        }
        SEAM(pb + 4);

        if (IN(pb + 5)) {
            PHASE_REGS
            LAS unsigned char* lds = lds0;
            pg8::Gemm gm{YSN, (const GAS bf16*)(wl + WL_WSSM), TAIL_R0, D, DIN}; pg8::StaticOrder S; S.init(TAIL_R0, D, Gl, bxl);
            pg8::EpiGate1 E{P1, T1};
            pg8::gemm_phase<pg8::EpiGate1, pg8::StaticOrder, true, true>(lds, gm, S, E, tid);
            tail_gemm<1>(lds, YSN, DIN, (const GAS bf16*)(wl + WL_WSSM), D, P1, T1, MG, H, A2, bxl, Gl, tid);
        }
        if (IN(pb + 6)) {
            PHASE_REGS
            LAS unsigned char* lds = lds0;
            pg8::Gemm gm{YA, (const GAS bf16*)(wl + WL_WATT), TAIL_R0, D, D}; pg8::StaticOrder S; S.init(TAIL_R0, D, Gl, bxl);
            pg8::EpiGate2 E{P1, T1, MG};
            pg8::gemm_phase<pg8::EpiGate2, pg8::StaticOrder, true, true>(lds, gm, S, E, tid);
            tail_gemm<2>(lds, YA, D, (const GAS bf16*)(wl + WL_WATT), D, P1, T1, MG, H, A2, bxl, Gl, tid);
        }
        SEAM(pb + 6);
        if (IN(pb + 7)) {
            PHASE_REGS
            LAS unsigned char* lds = lds0;
            pg8::Gemm gm{MG, (const GAS bf16*)(wl + WL_WOUT), TAIL_R0, D, D}; pg8::StaticOrder S; S.init(TAIL_R0, D, Gl, bxl);
            pg8::EpiResid E{H};
            pg8::gemm_phase<pg8::EpiResid, pg8::StaticOrder, true, true>(lds, gm, S, E, tid);
            tail_gemm<3>(lds, MG, D, (const GAS bf16*)(wl + WL_WOUT), D, P1, T1, MG, H, A2, bxl, Gl, tid);
        }
        SEAM(pb + 7);
        if (IN(pb + 8)) {
            PHASE_REGS
            INP(float, norm2_w, 20)
            for (int m = gw; m < MPAD; m += 4 * NGW) rms_rows4(H, norm2_w + (size_t)l * D, U, m, NGW, MPAD, lane);
        }
        SEAM(pb + 8);
        if (IN(pb + 9)) {
            PHASE_REGS
            LAS unsigned char* lds = lds0;
            pg8::Gemm gm{U, (const GAS bf16*)(wl + WL_WUP), TAIL_R0, DFF, D}; pg8::StaticOrder S; S.init(TAIL_R0, DFF, Gl, bxl);
            pg8::EpiUp E{A2};
            pg8::gemm_phase<pg8::EpiUp, pg8::StaticOrder, true, true>(lds, gm, S, E, tid);
            tail_gemm<4>(lds, U, D, (const GAS bf16*)(wl + WL_WUP), DFF, P1, T1, MG, H, A2, bxl, Gl, tid);
        }
        SEAM(pb + 9);
        if (IN(pb + 10)) {
            PHASE_REGS
            LAS unsigned char* lds = lds0;
            pg8::Gemm gm{A2, (const GAS bf16*)(wl + WL_WDN), TAIL_R0, D, DFF}; pg8::StaticOrder S; S.init(TAIL_R0, D, Gl, bxl);
            pg8::EpiResid E{H};
            pg8::gemm_phase<pg8::EpiResid, pg8::StaticOrder, true, true>(lds, gm, S, E, tid);
            tail_gemm<3>(lds, A2, DFF, (const GAS bf16*)(wl + WL_WDN), D, P1, T1, MG, H, A2, bxl, Gl, tid);
        }
        SEAM(pb + 10);
        if (IN(pb + 11)) {
            PHASE_REGS
            INP(float, norm1_w, 9) INP(float, final_w, 23)
            if (l == 0) { for (int m = gw; m < MPAD; m += 4 * NGW) rms_rows4(H, norm1_w + D, U, m, NGW, MPAD, lane); }
            else {
                for (int m0 = gw; m0 < MR; m0 += 4 * NGW) {
                    const GAS float* src[4]; GAS float* hd[4]; GAS bf16* ud[4]; GAS float* fd[4]; bool live[4];
#pragma unroll
                    for (int r = 0; r < 4; ++r) { const int m = m0 + r * NGW; hd[r] = nullptr; ud[r] = nullptr; fd[r] = nullptr; src[r] = H + (size_t)(m < MR ? m : m0) * D;
                        if (m < MP) { const int b = m / LP, t = m - b * LP; if (t >= NMETA) fd[r] = out + O_YP + ((size_t)b * SEQ + (t - NMETA)) * D; }
                        else if (m < MR) fd[r] = out + O_YS + (size_t)(m - MP) * D;
                        live[r] = fd[r] != nullptr; }
                    rms_rows4g(src, final_w, hd, ud, fd, live, lane);
                }
            }
        }
        if (IN(pb + 11) && IN(1) && l + 1 < args.l_hi) xcd_barrier_ni(bar.bar, bar.x, bar.st, TID_NOW(), (unsigned)G);
    }
#undef IN
#undef SEAM
}

#ifndef MK_PER_PHASE
#define MK_PER_PHASE 0
#endif
extern "C" void kernel_launch(void* const* d_in, const int* in_sizes, int n_in, void* d_out, int out_size, void* d_ws, size_t ws_size, hipStream_t stream) {
    static int grid = 0;
    if (grid == 0) {
        if (n_in != 24 || (size_t)out_size != O_END || ws_size < WS_END) { fprintf(stderr, "kernel_launch: unexpected shapes: n_in %d out %d (want %zu) ws %zu (want %zu)\n", n_in, out_size, (size_t)O_END, ws_size, (size_t)WS_END); grid = -1; return; }
        int dev = 0, cus = 0, per_cu = 0;
        if (hipGetDevice(&dev) != hipSuccess || hipDeviceGetAttribute(&cus, hipDeviceAttributeMultiprocessorCount, dev) != hipSuccess) { grid = -1; return; }
        bool ok = true;
#if MK_PER_PHASE
#define SETA(K) ok = ok && hipFuncSetAttribute((const void*)fwd_t<K, K + 1>, hipFuncAttributeMaxDynamicSharedMemorySize, LDS_BYTES) == hipSuccess
        SETA(0); SETA(1); SETA(2); SETA(3); SETA(4); SETA(5); SETA(6); SETA(7); SETA(8); SETA(9); SETA(10); SETA(11); SETA(12);
#else
        ok = hipFuncSetAttribute((const void*)fwd_t<0, NPH + 1>, hipFuncAttributeMaxDynamicSharedMemorySize, LDS_BYTES) == hipSuccess;
        ok = ok && hipOccupancyMaxActiveBlocksPerMultiprocessor(&per_cu, (const void*)fwd_t<0, NPH + 1>, NT, LDS_BYTES) == hipSuccess && per_cu >= 1;
#endif
        if (!ok) { fprintf(stderr, "kernel_launch: hipFuncSetAttribute / occupancy query failed (per_cu %d)\n", per_cu); (void)hipGetLastError(); grid = -1; return; }
        grid = cus;
    }
    if (grid < 0) return;
    (void)hipMemsetAsync((char*)d_ws + WS_CTL, 0, CTL_ZERO_BYTES, stream);
    Args a{};
    for (int i = 0; i < 24; ++i) a.in[i] = d_in[i];
    a.out = (float*)d_out; a.ws = (unsigned char*)d_ws;
#if MK_PER_PHASE
#define LAUNCH_PH(K) hipLaunchKernelGGL((fwd_t<K, K + 1>), dim3(grid), dim3(NT), LDS_BYTES, stream, a)
    a.l_lo = 0; a.l_hi = 1; LAUNCH_PH(0);
    for (int l = 0; l < 2; ++l) { a.l_lo = l; a.l_hi = l + 1;
        LAUNCH_PH(1); LAUNCH_PH(2); LAUNCH_PH(3); LAUNCH_PH(4); LAUNCH_PH(5); LAUNCH_PH(6); LAUNCH_PH(7); LAUNCH_PH(8); LAUNCH_PH(9); LAUNCH_PH(10); LAUNCH_PH(11); LAUNCH_PH(12); }
#else
    a.l_lo = 0; a.l_hi = 2; hipLaunchKernelGGL((fwd_t<0, NPH + 1>), dim3(grid), dim3(NT), LDS_BYTES, stream, a);
#endif
}
```

```cpp
#include <hip/hip_runtime.h>
#include <cstdio>
#include <cstdint>
#define GAS __attribute__((address_space(1)))
#define LAS __attribute__((address_space(3)))

constexpr int D = 1024, NB = 4, SEQ = 4096, NMETA = 16, LP = SEQ + NMETA, MP = NB * LP, DB = 32, DS = 8, MS = DB * DS, MR = MP + MS, MPAD = 16896;
constexpr int DIN = 2048, CONVD = 3072, NH = 32, HP = 64, NG = 4, NST = 128;
constexpr int DFF = 4096, IN_DIM = 9320;
constexpr int PAST = 8192, PAGE = 128, NPAGES = 64, NPOOL = 2560;
constexpr int NIN = 9472, LDP1 = 9216;
constexpr int C_Z = 0, C_XBC = 2048, C_Q = 5120, C_K = 6144, C_V = 6400, C_QI = 6656, C_GS = 7168, C_GA = 8192;
constexpr int MC_KI = 0, MC_DT = 64, MC_WI = 96;
constexpr int KT_PER_B = (LP + 31) / 32;
static_assert(MP == 16448 && MR == 16704 && MPAD % 256 == 0 && MPAD >= MR, "rows");
namespace pg8 {
#define PG8_LAS __attribute__((address_space(3)))
typedef unsigned short bf16_t;
typedef short bf16x8 __attribute__((ext_vector_type(8)));
typedef float f32x4 __attribute__((ext_vector_type(4)));
typedef unsigned u32x4 __attribute__((ext_vector_type(4)));
constexpr int BM = 256, BK = 64, HALF = 128, HTB = HALF * BK * 2  , STAGE_BYTES = 8 * HTB, NXCD = 8, WGM = 8;

__host__ __device__ __forceinline__ int lds_byte(int r, int c) { const int st = (r >> 4) * 2 + (c >> 5), rr = r & 15, cc = c & 31, ob = rr * 64 + cc * 2; return st * 1024 + (ob ^ (((ob >> 9) & 1) << 5)); }
__host__ __device__ __forceinline__ void stage_rc(int b, int& R, int& C) { const int st = b / 1024, sb = b % 1024, swz = sb ^ (((sb >> 9) & 1) << 5); R = (st >> 1) * 16 + swz / 64; C = (st & 1) * 32 + (swz % 64) / 2; }
__host__ __device__ __forceinline__ int perm32(int rho) { const int n = rho >> 4, i = rho & 15; return 8 * (i >> 2) + 4 * n + (i & 3); }

struct Unit { int pm, pn; };
struct Gemm { const GAS bf16_t* A; const GAS bf16_t* Bt; int M, N, K; };

struct StaticOrder {
    int nM, nN, nwg, G, c;
    __host__ __device__ void init(int M, int N, int G_, int c_) { nM = M / BM; nN = N / BM; nwg = nM * nN; G = G_; c = c_; }
    __host__ __device__ bool next(int i, Unit& u) const {
        const long L = (long)i * G + c; if (L >= nwg) return false;
        int wgid = (int)L; { const int q = nwg / NXCD, r = nwg % NXCD, xcd = wgid % NXCD, off = wgid / NXCD; wgid = (xcd < r ? xcd * (q + 1) : r * (q + 1) + (xcd - r) * q) + off; }
        const int nig = WGM * nN, gid = wgid / nig, fm = gid * WGM, gsz = (nM - fm) < WGM ? (nM - fm) : WGM;
        u.pm = fm + ((wgid % nig) % gsz); u.pn = (wgid % nig) / gsz; return true;
    }
    __device__ __forceinline__ void a_ready(const Unit&) const {}
    __device__ __forceinline__ void done(const Unit&) const {}
};

__device__ __forceinline__ unsigned cvt_pk_bf16(float lo, float hi) { unsigned r; asm volatile("v_cvt_pk_bf16_f32 %0, %1, %2" : "=v"(r) : "v"(lo), "v"(hi)); return r; }

__device__ __forceinline__ void unpack8(const u32x4 w, float (&f)[8]) {
    f[0] = __uint_as_float(w.x << 16); f[1] = __uint_as_float(w.x & 0xffff0000u); f[2] = __uint_as_float(w.y << 16); f[3] = __uint_as_float(w.y & 0xffff0000u);
    f[4] = __uint_as_float(w.z << 16); f[5] = __uint_as_float(w.z & 0xffff0000u); f[6] = __uint_as_float(w.w << 16); f[7] = __uint_as_float(w.w & 0xffff0000u);
}
__device__ __forceinline__ u32x4 pack8(const f32x4 v0, const f32x4 v1) { u32x4 w; w.x = cvt_pk_bf16(v0[0], v0[1]); w.y = cvt_pk_bf16(v0[2], v0[3]); w.z = cvt_pk_bf16(v1[0], v1[1]); w.w = cvt_pk_bf16(v1[2], v1[3]); return w; }
__device__ __forceinline__ float sigm(float x) { return __builtin_amdgcn_rcpf(1.0f + __expf(-x)); }

struct EpiIn {
    static constexpr bool PERM = true, AFTER_DRAIN = false;
    GAS bf16_t* P1; GAS bf16_t* kvb; GAS float* misc; GAS bf16_t* kib; GAS bf16_t* kib2; GAS float *pk, *pv, *pki, *sk, *sv, *ski;
    __device__ __forceinline__ void operator()(const f32x4 (&acc)[2][2][4][2], const Unit& u, int wr, int wc, int fr, int fq) const {
        const int row0 = u.pm * BM + wr * 64 + fr, lc0 = wc * 32 + 8 * fq;
#pragma unroll
        for (int ai = 0; ai < 2; ++ai)
#pragma unroll
            for (int m = 0; m < 4; ++m) {
                const int row = row0 + ai * HALF + m * 16;
#pragma unroll
                for (int bj = 0; bj < 2; ++bj) {
                    const f32x4 v0 = acc[ai][bj][m][0], v1 = acc[ai][bj][m][1];
                    const int lc = lc0 + bj * HALF;
                    if (u.pn < 36) {
                        if (u.pn == 24 || u.pn == 25) *(GAS u32x4*)(kvb + (size_t)row * 512 + (u.pn - 24) * BM + lc) = pack8(v0, v1);
                        else *(GAS u32x4*)(P1 + (size_t)row * LDP1 + u.pn * BM + lc) = pack8(v0, v1);
                        if (u.pn == 24) {
                            if (row < MP) { GAS float* dst = pk + (size_t)row * 256 + lc; *(GAS f32x4*)dst = v0; *(GAS f32x4*)(dst + 4) = v1; }
                            else if (row < MR) { GAS float* dst = sk + (size_t)(row - MP) * 256 + lc; *(GAS f32x4*)dst = v0; *(GAS f32x4*)(dst + 4) = v1; }
                        } else if (u.pn == 25) {
                            if (row < MP) { GAS float* dst = pv + (size_t)row * 256 + lc; *(GAS f32x4*)dst = v0; *(GAS f32x4*)(dst + 4) = v1; }
                            else if (row < MR) { GAS float* dst = sv + (size_t)(row - MP) * 256 + lc; *(GAS f32x4*)dst = v0; *(GAS f32x4*)(dst + 4) = v1; }
                        }
                    } else {
                        if (lc < 128) { GAS float* d = misc + (size_t)row * 128 + lc; *(GAS f32x4*)d = v0; *(GAS f32x4*)(d + 4) = v1; }
                        if (lc < 64) {
                            *(GAS u32x4*)(kib + (size_t)row * 64 + lc) = pack8(v0, v1);
                            if (row < MP) { const int b = row / LP, t = row - b * LP;
                                *(GAS u32x4*)(kib2 + ((size_t)(b * KT_PER_B + (t >> 5)) * 2048 + (lc >> 4) * 512 + ((lc >> 3) & 1) * 256 + (t & 31) * 8)) = pack8(v0, v1); }
                            if (row < MP) { GAS float* dst = pki + (size_t)row * 64 + lc; *(GAS f32x4*)dst = v0; *(GAS f32x4*)(dst + 4) = v1; }
                            else if (row < MR) { GAS float* dst = ski + (size_t)(row - MP) * 64 + lc; *(GAS f32x4*)dst = v0; *(GAS f32x4*)(dst + 4) = v1; }
                        }
                    }
                }
            }
    }
};
struct EpiGate1 {
    static constexpr bool PERM = true, AFTER_DRAIN = false;
    const GAS bf16_t* P1; GAS bf16_t* T1;
    __device__ __forceinline__ void operator()(const f32x4 (&acc)[2][2][4][2], const Unit& u, int wr, int wc, int fr, int fq) const {
        const int row0 = u.pm * BM + wr * 64 + fr, col0 = u.pn * BM + wc * 32 + 8 * fq;
#pragma unroll
        for (int ai = 0; ai < 2; ++ai)
#pragma unroll
            for (int m = 0; m < 4; ++m) {
                const int row = row0 + ai * HALF + m * 16;
#pragma unroll
                for (int bj = 0; bj < 2; ++bj) {
                    const int col = col0 + bj * HALF;
                    float g[8]; unpack8(*(const GAS u32x4*)(P1 + (size_t)row * LDP1 + C_GS + col), g);
                    f32x4 v0 = acc[ai][bj][m][0], v1 = acc[ai][bj][m][1];
#pragma unroll
                    for (int e = 0; e < 4; ++e) { v0[e] *= sigm(g[e]); v1[e] *= sigm(g[4 + e]); }
                    *(GAS u32x4*)(T1 + (size_t)row * 1024 + col) = pack8(v0, v1);
                }
            }
    }
};
struct EpiGate2 {
    static constexpr bool PERM = true, AFTER_DRAIN = false;
    const GAS bf16_t* P1; const GAS bf16_t* T1; GAS bf16_t* MG;
    __device__ __forceinline__ void operator()(const f32x4 (&acc)[2][2][4][2], const Unit& u, int wr, int wc, int fr, int fq) const {
        const int row0 = u.pm * BM + wr * 64 + fr, col0 = u.pn * BM + wc * 32 + 8 * fq;
#pragma unroll
        for (int ai = 0; ai < 2; ++ai)
#pragma unroll
            for (int m = 0; m < 4; ++m) {
                const int row = row0 + ai * HALF + m * 16;
#pragma unroll
                for (int bj = 0; bj < 2; ++bj) {
                    const int col = col0 + bj * HALF;
                    float g[8]; unpack8(*(const GAS u32x4*)(P1 + (size_t)row * LDP1 + C_GA + col), g);
                    float tt[8]; unpack8(*(const GAS u32x4*)(T1 + (size_t)row * 1024 + col), tt); const f32x4 t0 = (f32x4){tt[0], tt[1], tt[2], tt[3]}, t1 = (f32x4){tt[4], tt[5], tt[6], tt[7]};
                    f32x4 v0 = acc[ai][bj][m][0], v1 = acc[ai][bj][m][1];
#pragma unroll
                    for (int e = 0; e < 4; ++e) { v0[e] = t0[e] + v0[e] * sigm(g[e]); v1[e] = t1[e] + v1[e] * sigm(g[4 + e]); }
                    *(GAS u32x4*)(MG + (size_t)row * 1024 + col) = pack8(v0, v1);
                }
            }
    }
};
struct EpiResid {
    static constexpr bool PERM = true, AFTER_DRAIN = false;
    GAS float* H;
    __device__ __forceinline__ void operator()(const f32x4 (&acc)[2][2][4][2], const Unit& u, int wr, int wc, int fr, int fq) const {
        const int row0 = u.pm * BM + wr * 64 + fr, col0 = u.pn * BM + wc * 32 + 8 * fq;
#pragma unroll
        for (int ai = 0; ai < 2; ++ai)
#pragma unroll
            for (int m = 0; m < 4; ++m) {
                const int row = row0 + ai * HALF + m * 16;
#pragma unroll
                for (int bj = 0; bj < 2; ++bj) {
                    GAS float* d = H + (size_t)row * 1024 + col0 + bj * HALF;
                    const f32x4 h0 = *(const GAS f32x4*)d, h1 = *(const GAS f32x4*)(d + 4);
                    *(GAS f32x4*)d = h0 + acc[ai][bj][m][0]; *(GAS f32x4*)(d + 4) = h1 + acc[ai][bj][m][1];
                }
            }
    }
};
struct EpiUp {
    static constexpr bool PERM = true, AFTER_DRAIN = false;
    GAS bf16_t* A2;
    __device__ __forceinline__ void operator()(const f32x4 (&acc)[2][2][4][2], const Unit& u, int wr, int wc, int fr, int fq) const {
        const int row0 = u.pm * BM + wr * 64 + fr, col0 = u.pn * BM + wc * 32 + 8 * fq;
#pragma unroll
        for (int ai = 0; ai < 2; ++ai)
#pragma unroll
            for (int m = 0; m < 4; ++m) {
                const int row = row0 + ai * HALF + m * 16;
#pragma unroll
                for (int bj = 0; bj < 2; ++bj) {
                    f32x4 v0 = acc[ai][bj][m][0], v1 = acc[ai][bj][m][1];
#pragma unroll
                    for (int e = 0; e < 4; ++e) { const float a = fmaxf(v0[e], 0.f), b = fmaxf(v1[e], 0.f); v0[e] = a * a; v1[e] = b * b; }
                    *(GAS u32x4*)(A2 + (size_t)row * DFF + col0 + bj * HALF) = pack8(v0, v1);
                }
            }
    }
};
template <class Epi, class Sched, bool ALIGN_EPI = false, bool SP2 = false>
__device__ __forceinline__ void gemm_phase(PG8_LAS unsigned char* lds, const Gemm g, const Sched& S, const Epi& E, const int tid) {
    const int wid = __builtin_amdgcn_readfirstlane(tid >> 6), lane = tid & 63, wr = wid >> 2, wc = wid & 3, fr = lane & 15, fq = lane >> 4;
    const int K = g.K, nt = K / BK;
    unsigned voffA[2], voffB[2];
#pragma unroll
    for (int i = 0; i < 2; ++i) { int R, C; stage_rc(tid * 16 + i * 8192, R, C); const int Rb = Epi::PERM ? ((R & ~31) + perm32(R & 31)) : R;
        voffA[i] = (unsigned)(R * K + C) * 2u; voffB[i] = (unsigned)(Rb * K + C) * 2u; }
    const size_t kstep = (size_t)(BK * 2);
    const size_t hstep = (size_t)HALF * K * 2;
    const size_t tstep = 2 * hstep;
    const unsigned ldsw = (unsigned)wid * 1024u;
    const int aoff = lds_byte(wr * 64 + fr, fq * 8), boff = lds_byte(wc * 32 + fr, fq * 8);
#define PG8_SA(b, h) (((b) * 2 + (h)) * HTB)
#define PG8_SB(b, h) ((4 + (b) * 2 + (h)) * HTB)
#define PG8_STAGE(bufoff, gbase, voff) do { _Pragma("unroll") for (int _i = 0; _i < 2; ++_i) \
        __builtin_amdgcn_global_load_lds((const GAS unsigned*)((const GAS char*)(gbase) + (voff)[_i]), (PG8_LAS unsigned*)(lds + (bufoff) + ldsw + _i * 8192), 16, 0, 0); } while (0)
#define PG8_LDA(dst, b, h) do { _Pragma("unroll") for (int m = 0; m < 4; ++m) _Pragma("unroll") for (int k = 0; k < 2; ++k) dst[m][k] = *(const PG8_LAS bf16x8*)(lds + PG8_SA(b, h) + aoff + m * 2048 + k * 1024); } while (0)
#define PG8_LDB(dst, b, h) do { _Pragma("unroll") for (int n = 0; n < 2; ++n) _Pragma("unroll") for (int k = 0; k < 2; ++k) dst[n][k] = *(const PG8_LAS bf16x8*)(lds + PG8_SB(b, h) + boff + n * 2048 + k * 1024); } while (0)
#define PG8_MMA(ai, bj, At, Bt) do { __builtin_amdgcn_s_setprio(1); _Pragma("unroll") for (int m = 0; m < 4; ++m) _Pragma("unroll") for (int n = 0; n < 2; ++n) _Pragma("unroll") for (int k = 0; k < 2; ++k) \
        acc[ai][bj][m][n] = __builtin_amdgcn_mfma_f32_16x16x32_bf16(Bt[n][k], At[m][k], acc[ai][bj][m][n], 0, 0, 0); __builtin_amdgcn_s_setprio(0); } while (0)
#define PG8_WAIT_V(n) asm volatile("s_waitcnt vmcnt(" #n ")" ::: "memory")
#define PG8_WAIT_L(n) asm volatile("s_waitcnt lgkmcnt(" #n ")" ::: "memory")
#define PG8_BAR __builtin_amdgcn_s_barrier()
#define PG8_SCHED __builtin_amdgcn_sched_barrier(0)
    Unit cur, nxt; int ui = 0;
    if (!S.next(0, cur)) return;
    f32x4 acc[2][2][4][2];
#pragma unroll
    for (int a = 0; a < 2; ++a)
#pragma unroll
        for (int b = 0; b < 2; ++b)
#pragma unroll
            for (int m = 0; m < 4; ++m)
#pragma unroll
                for (int n = 0; n < 2; ++n) acc[a][b][m][n] = (f32x4){0.f, 0.f, 0.f, 0.f};
    bf16x8 At[4][2], B0[2][2], B1[2][2];
    const GAS char* cA = (const GAS char*)g.A + (size_t)cur.pm * tstep; const GAS char* cB = (const GAS char*)g.Bt + (size_t)cur.pn * tstep;
    S.a_ready(cur);
    if constexpr (SP2) {
        PG8_STAGE(PG8_SB(0, 0), cB, voffB); PG8_STAGE(PG8_SB(0, 1), cB + hstep, voffB); PG8_STAGE(PG8_SA(0, 0), cA, voffA); PG8_STAGE(PG8_SA(0, 1), cA + hstep, voffA);
        if (wr == 1) PG8_BAR;
        PG8_WAIT_V(2); PG8_BAR;
        PG8_STAGE(PG8_SB(1, 0), cB + kstep, voffB); PG8_STAGE(PG8_SA(1, 0), cA + kstep, voffA); PG8_STAGE(PG8_SB(1, 1), cB + hstep + kstep, voffB);
        PG8_WAIT_V(6); PG8_BAR;
    } else {
        PG8_STAGE(PG8_SB(0, 0), cB, voffB); PG8_STAGE(PG8_SA(0, 0), cA, voffA); PG8_STAGE(PG8_SB(0, 1), cB + hstep, voffB); PG8_STAGE(PG8_SA(0, 1), cA + hstep, voffA);
        if (wr == 1) PG8_BAR;
        PG8_WAIT_V(4); PG8_BAR;
        PG8_STAGE(PG8_SB(1, 0), cB + kstep, voffB); PG8_STAGE(PG8_SA(1, 0), cA + kstep, voffA); PG8_STAGE(PG8_SB(1, 1), cB + hstep + kstep, voffB);
        PG8_WAIT_V(6); PG8_BAR;
    }
    for (;;) {
        const bool has_next = S.next(ui + 1, nxt);
        const GAS char* nA = has_next ? (const GAS char*)g.A + (size_t)nxt.pm * tstep : cA; const GAS char* nB = has_next ? (const GAS char*)g.Bt + (size_t)nxt.pn * tstep : cB;
        for (int t = 0; t < nt; t += 2) {
            const bool last = (t == nt - 2);
            const GAS char* a1 = cA + (size_t)(t + 1) * kstep;
            const GAS char* a2 = last ? nA : cA + (size_t)(t + 2) * kstep; const GAS char* b2 = last ? nB : cB + (size_t)(t + 2) * kstep;
            const GAS char* a3 = a2 + kstep; const GAS char* b3 = b2 + kstep;
            if (last && has_next) S.a_ready(nxt);
            if constexpr (SP2) {
            PG8_LDB(B0, 0, 0); PG8_LDB(B1, 0, 1); PG8_SCHED; PG8_LDA(At, 0, 0); PG8_STAGE(PG8_SA(1, 1), a1 + hstep, voffA);
            PG8_WAIT_V(8); PG8_WAIT_L(0); PG8_BAR; PG8_MMA(0, 0, At, B0); PG8_MMA(0, 1, At, B1); PG8_BAR; PG8_SCHED;
            PG8_LDA(At, 0, 1); PG8_STAGE(PG8_SB(0, 0), b2, voffB); PG8_STAGE(PG8_SB(0, 1), b2 + hstep, voffB); PG8_STAGE(PG8_SA(0, 0), a2, voffA);
            PG8_WAIT_V(8); PG8_WAIT_L(0); PG8_BAR; PG8_MMA(1, 0, At, B0); PG8_MMA(1, 1, At, B1); PG8_BAR; PG8_SCHED;
            PG8_LDB(B0, 1, 0); PG8_LDB(B1, 1, 1); PG8_SCHED; PG8_LDA(At, 1, 0); PG8_STAGE(PG8_SA(0, 1), a2 + hstep, voffA);
            PG8_WAIT_V(8); PG8_WAIT_L(0); PG8_BAR; PG8_MMA(0, 0, At, B0); PG8_MMA(0, 1, At, B1); PG8_BAR; PG8_SCHED;
            PG8_LDA(At, 1, 1); PG8_STAGE(PG8_SB(1, 0), b3, voffB); PG8_STAGE(PG8_SB(1, 1), b3 + hstep, voffB); PG8_STAGE(PG8_SA(1, 0), a3, voffA);
            PG8_WAIT_V(8); PG8_WAIT_L(0); PG8_BAR; PG8_MMA(1, 0, At, B0); PG8_MMA(1, 1, At, B1); PG8_BAR; PG8_SCHED;
            } else {
            PG8_LDB(B0, 0, 0); PG8_SCHED; PG8_LDA(At, 0, 0); PG8_STAGE(PG8_SA(1, 1), a1 + hstep, voffA);
            PG8_WAIT_L(8); PG8_BAR; PG8_WAIT_L(0); PG8_MMA(0, 0, At, B0); PG8_BAR; PG8_SCHED;
            PG8_LDB(B1, 0, 1); PG8_STAGE(PG8_SB(0, 0), b2, voffB);
            PG8_BAR; PG8_WAIT_L(0); PG8_MMA(0, 1, At, B1); PG8_BAR;
            PG8_LDA(At, 0, 1); PG8_STAGE(PG8_SA(0, 0), a2, voffA);
            PG8_BAR; PG8_WAIT_L(0); PG8_MMA(1, 0, At, B0); PG8_BAR; PG8_SCHED;
            PG8_STAGE(PG8_SB(0, 1), b2 + hstep, voffB);
            PG8_WAIT_V(6); PG8_BAR; PG8_MMA(1, 1, At, B1); PG8_BAR;
            PG8_LDB(B0, 1, 0); PG8_SCHED; PG8_LDA(At, 1, 0); PG8_STAGE(PG8_SA(0, 1), a2 + hstep, voffA);
            PG8_WAIT_L(8); PG8_BAR; PG8_WAIT_L(0); PG8_MMA(0, 0, At, B0); PG8_BAR; PG8_SCHED;
            PG8_LDB(B1, 1, 1); PG8_STAGE(PG8_SB(1, 0), b3, voffB);
            PG8_BAR; PG8_WAIT_L(0); PG8_MMA(0, 1, At, B1); PG8_BAR;
            PG8_LDA(At, 1, 1); PG8_STAGE(PG8_SA(1, 0), a3, voffA);
            PG8_BAR; PG8_WAIT_L(0); PG8_MMA(1, 0, At, B0); PG8_BAR; PG8_SCHED;
            PG8_STAGE(PG8_SB(1, 1), b3 + hstep, voffB);
            PG8_WAIT_V(6); PG8_BAR; PG8_MMA(1, 1, At, B1); PG8_BAR;
            }
        }
        if constexpr (ALIGN_EPI) { if (wr == 0) PG8_BAR; }
        if constexpr (!Epi::AFTER_DRAIN) { E(acc, cur, wr, wc, fr, fq); S.done(cur); }
        if (!has_next) break;
#pragma unroll
        for (int a = 0; a < 2; ++a)
#pragma unroll
            for (int b = 0; b < 2; ++b)
#pragma unroll
                for (int m = 0; m < 4; ++m)
#pragma unroll
                    for (int n = 0; n < 2; ++n) acc[a][b][m][n] = (f32x4){0.f, 0.f, 0.f, 0.f};
        cur = nxt; cA = nA; cB = nB; ++ui;
        if constexpr (ALIGN_EPI) { if (wr == 1) PG8_BAR; }
    }
    PG8_WAIT_V(0);
    if constexpr (!ALIGN_EPI) { if (wr == 0) PG8_BAR; }
    PG8_BAR;
    if constexpr (Epi::AFTER_DRAIN) { E.fused(acc, cur, wr, wc, fr, fq, lds, wid, lane); S.done(cur); }
#undef PG8_SA
#undef PG8_SB
#undef PG8_STAGE
#undef PG8_LDA
#undef PG8_LDB
#undef PG8_MMA
#undef PG8_WAIT_V
#undef PG8_WAIT_L
#undef PG8_BAR
#undef PG8_SCHED
}
}

typedef unsigned short bf16;
typedef unsigned v4u __attribute__((ext_vector_type(4)));
typedef float f32x4 __attribute__((ext_vector_type(4)));
typedef short bf16x8 __attribute__((ext_vector_type(8)));
typedef GAS unsigned gu32;
typedef GAS unsigned long long gu64;
#define RLX_AGENT __ATOMIC_RELAXED, __HIP_MEMORY_SCOPE_AGENT
#define LDS_WAIT() asm volatile("s_waitcnt lgkmcnt(0)" ::: "memory")
#define VM_WAIT() asm volatile("s_waitcnt vmcnt(0)" ::: "memory")
__device__ __forceinline__ unsigned long long rt() { return __builtin_amdgcn_s_memrealtime(); }
typedef float f32x2_cv __attribute__((ext_vector_type(2))); typedef __bf16 bf16x2_cv __attribute__((ext_vector_type(2)));
__device__ __forceinline__ unsigned pk2(float lo, float hi) { const f32x2_cv v = {lo, hi}; const bf16x2_cv c = __builtin_convertvector(v, bf16x2_cv); return __builtin_bit_cast(unsigned, c); }
__device__ __forceinline__ unsigned f2bf(float f) { return pk2(f, 0.f) & 0xffffu; }

#define XB_TMO      128
#define XB_XCNT(j)  (256  + 64 * (j))
#define XB_XSUB(j)  (1280 + 64 * (j))
#define XB_XGEN(j)  (2304 + 64 * (j))
#define XB_TOP      3328
#define XB_TOPGEN   3392
#define XCD_BAR_WORDS 3456
#define XB_SPIN_CAP (1u << 18)

__device__ __forceinline__ unsigned xb_ld(unsigned* p)              { return __hip_atomic_load(p, __ATOMIC_RELAXED, __HIP_MEMORY_SCOPE_AGENT); }
__device__ __forceinline__ unsigned xb_add(unsigned* p, unsigned v) { return __hip_atomic_fetch_add(p, v, __ATOMIC_RELAXED, __HIP_MEMORY_SCOPE_AGENT); }
__device__ __forceinline__ unsigned xb_xcc_id() { return (unsigned)__builtin_amdgcn_s_getreg((3 << 11) | 20) & 0xFu; }
#define XB_SPIN(cond, bar) do { unsigned _sp = 0; while (cond) { __builtin_amdgcn_s_sleep(1); \
    if ((++_sp & 255u) == 0u) { if (xb_ld(&(bar)[XB_TMO])) break; if (_sp > XB_SPIN_CAP) { atomicAdd(&(bar)[XB_TMO], 1u); break; } } } } while (0)

struct XcdBarrier {
    unsigned* bar; unsigned x;
    volatile LAS unsigned* st;
};

__device__ __forceinline__ XcdBarrier xcd_barrier_post(unsigned* bar, volatile LAS unsigned* st) {
    XcdBarrier b; b.bar = bar; b.x = xb_xcc_id(); b.st = st;
    if (threadIdx.x == 0) (void)xb_add(&bar[XB_XCNT(b.x)], 1u);
    return b;
}
__device__ __forceinline__ void xcd_barrier_complete(unsigned* bar, unsigned x, unsigned& nloc, unsigned& nx, const unsigned G) {
    unsigned sum, cnt, mine, sp = 0u;
    for (;;) {
        sum = 0u; cnt = 0u; mine = 0u;
#pragma unroll 1
        for (unsigned j = 0; j < 16; ++j) { const unsigned c = xb_ld(&bar[XB_XCNT(j)]); sum += c; cnt += (c > 0u) ? 1u : 0u; mine = (j == x) ? c : mine; }
        if (sum == G) break;
        __builtin_amdgcn_s_sleep(1);
        if ((++sp & 255u) == 0u) { if (xb_ld(&bar[XB_TMO])) break; if (sp > XB_SPIN_CAP) { atomicAdd(&bar[XB_TMO], 1u); break; } }
    }
    nloc = mine > 0u ? mine : 1u; nx = cnt > 0u ? cnt : 1u;
}

__device__ __forceinline__ void xcd_barrier(const XcdBarrier& b, const int tid_, const unsigned G_) {
    asm volatile("s_waitcnt vmcnt(0)" ::: "memory");
    __syncthreads();
    if (tid_ == 0) {
        unsigned* bar = b.bar;
        __builtin_amdgcn_s_waitcnt(0);
        unsigned nloc = b.st[0], nx = b.st[1];
        if (nloc == 0u) { xcd_barrier_complete(bar, b.x, nloc, nx, G_); b.st[0] = nloc; b.st[1] = nx; }
        const unsigned old = xb_add(&bar[XB_XSUB(b.x)], 1u);
        const unsigned gen = old / nloc;
        if (old + 1u == (gen + 1u) * nloc) {
            __builtin_amdgcn_fence(__ATOMIC_RELEASE, "agent");
            asm volatile("s_waitcnt vmcnt(0)" ::: "memory");
            const unsigned og = xb_add(&bar[XB_TOP], 1u);
            const unsigned tg = og / nx;
            if (og + 1u == (tg + 1u) * nx) xb_add(&bar[XB_TOPGEN], 1u);
            else XB_SPIN(xb_ld(&bar[XB_TOPGEN]) == tg, bar);
            __builtin_amdgcn_fence(__ATOMIC_ACQUIRE, "agent");
            xb_add(&bar[XB_XGEN(b.x)], 1u);
            asm volatile("s_waitcnt vmcnt(0)" ::: "memory");
        } else {
            XB_SPIN(xb_ld(&bar[XB_XGEN(b.x)]) == gen, bar);
            __builtin_amdgcn_fence(__ATOMIC_ACQUIRE, "agent");
            asm volatile("s_waitcnt vmcnt(0)" ::: "memory");
        }
    }
    __syncthreads();
}

constexpr size_t O_YP = 0, O_YS = O_YP + (size_t)NB * SEQ * D, O_PK = O_YS + (size_t)MS * D, O_PV = O_PK + 2ull * MP * 256, O_PKI = O_PV + 2ull * MP * 256,
                 O_PSSM = O_PKI + 2ull * MP * 64, O_PCONV = O_PSSM + 2ull * NB * NH * HP * NST, O_SK = O_PCONV + 2ull * NB * 3 * CONVD, O_SV = O_SK + 2ull * MS * 256,
                 O_SKI = O_SV + 2ull * MS * 256, O_SSSM = O_SKI + 2ull * MS * 64, O_SCONV = O_SSSM + 2ull * DB * NH * HP * NST, O_END = O_SCONV + 2ull * DB * 3 * CONVD;

constexpr size_t MiB = 1u << 20;
constexpr size_t al(size_t x) { return (x + MiB - 1) / MiB * MiB; }
constexpr size_t WS_CTL = 0, CTL_ZERO_BYTES = 1 * MiB;
constexpr size_t SZ_WIN = (size_t)NIN * D * 2, SZ_WSSM = (size_t)D * DIN * 2, SZ_WATT = (size_t)D * D * 2, SZ_WOUT = (size_t)D * D * 2, SZ_WUP = (size_t)DFF * D * 2, SZ_WDN = (size_t)D * DFF * 2;
constexpr size_t WL_WIN = 0, WL_WSSM = al(WL_WIN + SZ_WIN), WL_WATT = al(WL_WSSM + SZ_WSSM), WL_WOUT = al(WL_WATT + SZ_WATT), WL_WUP = al(WL_WOUT + SZ_WOUT), WL_WDN = al(WL_WUP + SZ_WUP), WL_SIZE = al(WL_WDN + SZ_WDN);
constexpr size_t WS_W = 1 * MiB;
constexpr size_t WS_H = al(WS_W + 2 * WL_SIZE);
constexpr size_t WS_U = al(WS_H + (size_t)MPAD * D * 4);
constexpr size_t WS_P1 = al(WS_U + (size_t)MPAD * D * 2);
constexpr size_t WS_MISC = al(WS_P1 + (size_t)MPAD * LDP1 * 2);
constexpr size_t WS_KIB = al(WS_MISC + (size_t)MPAD * 128 * 4);
constexpr size_t WS_XC = al(WS_KIB + (size_t)MPAD * 64 * 2);
constexpr size_t WS_DT = al(WS_XC + (size_t)MPAD * CONVD * 2);
constexpr size_t WS_DA = al(WS_DT + (size_t)MPAD * 32 * 4);
constexpr size_t WS_YS = al(WS_DA + (size_t)MPAD * 32 * 4);
constexpr size_t WS_YSN = al(WS_YS + (size_t)MPAD * DIN * 4);
constexpr size_t WS_YA = al(WS_YSN + (size_t)MPAD * DIN * 2);
constexpr size_t WS_T1 = al(WS_YA + (size_t)MPAD * D * 2);
constexpr size_t WS_MG = al(WS_T1 + (size_t)MPAD * D * 4);
constexpr size_t WS_A2 = al(WS_MG + (size_t)MPAD * D * 2);
constexpr size_t WS_IDXP = al(WS_A2 + (size_t)MPAD * DFF * 2);
constexpr size_t WS_IDXS = al(WS_IDXP + (size_t)MP * 256 * 2);
constexpr int SCS_LD = 8256;
constexpr size_t WS_SCS = al(WS_IDXS + (size_t)MS * 256 * 4);
constexpr size_t WS_SB = al(WS_SCS + (size_t)MS * SCS_LD * 4);
constexpr size_t WS_DEC = al(WS_SB + (size_t)NB * 33 * NH * HP * NST * 4);
constexpr size_t WS_HC = al(WS_DEC + (size_t)NB * 33 * NH * 4);
constexpr size_t WS_KVB = al(WS_HC + (size_t)NB * 33 * NH * HP * NST * 2);
constexpr size_t WS_KIB2 = al(WS_KVB + (size_t)MPAD * 512 * 2);
constexpr size_t WS_END = al(WS_KIB2 + (size_t)NB * KT_PER_B * 2048 * 2);
constexpr int CW_BAR = 4096;

constexpr int LDS_BYTES = 159744, LDSCTL_OFF = 155648, MISC_OFF = LDSCTL_OFF + 320;
constexpr int NWAVES = 8, NT = 512;
typedef float f32x16 __attribute__((ext_vector_type(16)));
typedef unsigned v2u __attribute__((ext_vector_type(2)));

__device__ __forceinline__ float dpp_f(float v, const int ctrl_unused) { return v; }
#define DPPF(v, ctrl, rmask, bc) __uint_as_float((unsigned)__builtin_amdgcn_update_dpp(0, (int)__float_as_uint(v), ctrl, rmask, 0xf, bc))
__device__ __forceinline__ float row16_sum(float v) {
    v += DPPF(v, 0xB1, 0xf, true); v += DPPF(v, 0x4E, 0xf, true); v += DPPF(v, 0x141, 0xf, true); v += DPPF(v, 0x140, 0xf, true); return v;
}
__device__ __forceinline__ float wave_sum(float v) {
    v = row16_sum(v);
    v += DPPF(v, 0x142, 0xa, false); v += DPPF(v, 0x143, 0xc, false);
    return __uint_as_float((unsigned)__builtin_amdgcn_readlane((int)__float_as_uint(v), 63));
}
__device__ __forceinline__ float wave_max(float v) {
    v = fmaxf(v, __uint_as_float((unsigned)__builtin_amdgcn_update_dpp((int)__float_as_uint(v), (int)__float_as_uint(v), 0xB1, 0xf, 0xf, false)));
    v = fmaxf(v, __uint_as_float((unsigned)__builtin_amdgcn_update_dpp((int)__float_as_uint(v), (int)__float_as_uint(v), 0x4E, 0xf, 0xf, false)));
    v = fmaxf(v, __uint_as_float((unsigned)__builtin_amdgcn_update_dpp((int)__float_as_uint(v), (int)__float_as_uint(v), 0x141, 0xf, 0xf, false)));
    v = fmaxf(v, __uint_as_float((unsigned)__builtin_amdgcn_update_dpp((int)__float_as_uint(v), (int)__float_as_uint(v), 0x140, 0xf, 0xf, false)));
    v = fmaxf(v, __uint_as_float((unsigned)__builtin_amdgcn_update_dpp((int)__float_as_uint(v), (int)__float_as_uint(v), 0x142, 0xa, 0xf, false)));
    v = fmaxf(v, __uint_as_float((unsigned)__builtin_amdgcn_update_dpp((int)__float_as_uint(v), (int)__float_as_uint(v), 0x143, 0xc, 0xf, false)));
    return __uint_as_float((unsigned)__builtin_amdgcn_readlane((int)__float_as_uint(v), 63));
}
__device__ __forceinline__ void unpack8(const v4u w, float (&f)[8]) {
    f[0] = __uint_as_float(w.x << 16); f[1] = __uint_as_float(w.x & 0xffff0000u); f[2] = __uint_as_float(w.y << 16); f[3] = __uint_as_float(w.y & 0xffff0000u);
    f[4] = __uint_as_float(w.z << 16); f[5] = __uint_as_float(w.z & 0xffff0000u); f[6] = __uint_as_float(w.w << 16); f[7] = __uint_as_float(w.w & 0xffff0000u);
}
__device__ __forceinline__ float sigm(float x) { return __builtin_amdgcn_rcpf(1.0f + __expf(-x)); }

__device__ __forceinline__ int win_src_col(int n) {
    if (n < 5120) return n;
    if (n < 6144) return n - 5120 + 5152;
    if (n < 6400) return n - 6144 + 6176;
    if (n < 6656) return n - 6400 + 6432;
    if (n < 7168) return n - 6656 + 6688;
    if (n < 8192) return n - 7168 + 7272;
    if (n < 9216) return n - 8192 + 8296;
    if (n < 9280) return n - 9216 + 7200;
    if (n < 9312) return n - 9280 + 5120;
    if (n < 9320) return n - 9312 + 7264;
    return -1;
}
__device__ __forceinline__ void tr_item(const GAS float* W, int K, int Nsrc, GAS bf16* WT, int nblk, bool remap, LAS float* scr, int item, int lane) {
    const int kb = item / nblk, nb = item % nblk, k0 = 64 * kb, n0 = 64 * nb;
    const int s0 = remap ? win_src_col(n0) : n0, s63 = remap ? win_src_col(n0 + 63) : n0 + 63;
    if (s0 >= 0 && s63 == s0 + 63 && (s0 & 3) == 0 && (Nsrc & 3) == 0) {
        const int r4 = lane >> 4, c4 = (lane & 15) * 4;
#pragma unroll 4
        for (int i = 0; i < 16; ++i) { const int kk = 4 * i + r4; const f32x4 v = *(const GAS f32x4*)(W + (size_t)(k0 + kk) * Nsrc + s0 + c4);
            scr[kk * 65 + c4] = v.x; scr[kk * 65 + c4 + 1] = v.y; scr[kk * 65 + c4 + 2] = v.z; scr[kk * 65 + c4 + 3] = v.w; }
    } else {
        const int sc = remap ? win_src_col(n0 + lane) : n0 + lane;
#pragma unroll 8
        for (int kk = 0; kk < 64; ++kk) scr[kk * 65 + lane] = sc >= 0 ? W[(size_t)(k0 + kk) * Nsrc + sc] : 0.f;
    }
    LDS_WAIT(); asm volatile("" ::: "memory");
    const int c = lane & 7;
#pragma unroll
    for (int j = 0; j < 8; ++j) { const int n = (lane >> 3) + 8 * j; const LAS float* s = scr + (8 * c) * 65 + n;
        v4u o; o.x = pk2(s[0 * 65], s[1 * 65]); o.y = pk2(s[2 * 65], s[3 * 65]); o.z = pk2(s[4 * 65], s[5 * 65]); o.w = pk2(s[6 * 65], s[7 * 65]);
        *(GAS v4u*)(WT + (size_t)(n0 + n) * K + k0 + 8 * c) = o; }
    LDS_WAIT(); asm volatile("" ::: "memory");
}
__device__ __forceinline__ void rms_row(const GAS float* src, const GAS float* w, GAS float* hdst, GAS bf16* udst, GAS float* fdst, int lane) {
    f32x4 v[4]; float ss = 0.f;
#pragma unroll
    for (int j = 0; j < 4; ++j) { v[j] = src ? ((const GAS f32x4*)src)[lane + 64 * j] : (f32x4){0.f, 0.f, 0.f, 0.f}; ss += (v[j].x * v[j].x + v[j].y * v[j].y) + (v[j].z * v[j].z + v[j].w * v[j].w); }
    ss = wave_sum(ss);
    const float rstd = 1.0f / sqrtf(ss * (1.0f / D) + 1e-6f);
#pragma unroll
    for (int j = 0; j < 4; ++j) {
        if (hdst) ((GAS f32x4*)hdst)[lane + 64 * j] = v[j];
        const f32x4 wv = ((const GAS f32x4*)w)[lane + 64 * j]; const f32x4 o = v[j] * rstd * wv;
        if (udst) ((GAS v2u*)udst)[lane + 64 * j] = (v2u){pk2(o.x, o.y), pk2(o.z, o.w)};
        if (fdst) ((GAS f32x4*)fdst)[lane + 64 * j] = o;
    }
}

__device__ __forceinline__ void rms_rows4(const GAS float* H, const GAS float* w, GAS bf16* U, int m0, int stride, int mend, int lane) {
    f32x4 v[4][4]; float ss[4];
#pragma unroll
    for (int r = 0; r < 4; ++r) { const int m = m0 + r * stride; const GAS f32x4* src = (const GAS f32x4*)(H + (size_t)(m < mend ? m : m0) * D); ss[r] = 0.f;
#pragma unroll
        for (int j = 0; j < 4; ++j) v[r][j] = src[lane + 64 * j]; }
    f32x4 wv[4];
#pragma unroll
    for (int j = 0; j < 4; ++j) wv[j] = ((const GAS f32x4*)w)[lane + 64 * j];
#pragma unroll
    for (int r = 0; r < 4; ++r) {
#pragma unroll
        for (int j = 0; j < 4; ++j) ss[r] += (v[r][j].x * v[r][j].x + v[r][j].y * v[r][j].y) + (v[r][j].z * v[r][j].z + v[r][j].w * v[r][j].w);
        ss[r] = wave_sum(ss[r]);
        const float rstd = 1.0f / sqrtf(ss[r] * (1.0f / D) + 1e-6f); const int m = m0 + r * stride;
        if (m < mend) {
#pragma unroll
            for (int j = 0; j < 4; ++j) { const f32x4 o = v[r][j] * rstd * wv[j]; ((GAS v2u*)(U + (size_t)m * D))[lane + 64 * j] = (v2u){pk2(o.x, o.y), pk2(o.z, o.w)}; } }
    }
}

__device__ __forceinline__ void rms_rows4g(const GAS float* const (&src)[4], const GAS float* w, GAS float* const (&hdst)[4], GAS bf16* const (&udst)[4], GAS float* const (&fdst)[4], const bool (&live)[4], int lane) {
    f32x4 v[4][4];
#pragma unroll
    for (int r = 0; r < 4; ++r)
#pragma unroll
        for (int j = 0; j < 4; ++j) v[r][j] = (live[r] && src[r]) ? ((const GAS f32x4*)src[r])[lane + 64 * j] : (f32x4){0.f, 0.f, 0.f, 0.f};
    f32x4 wv[4];
#pragma unroll
    for (int j = 0; j < 4; ++j) wv[j] = ((const GAS f32x4*)w)[lane + 64 * j];
#pragma unroll
    for (int r = 0; r < 4; ++r) { float ss = 0.f;
#pragma unroll
        for (int j = 0; j < 4; ++j) ss += (v[r][j].x * v[r][j].x + v[r][j].y * v[r][j].y) + (v[r][j].z * v[r][j].z + v[r][j].w * v[r][j].w);
        ss = wave_sum(ss);
        const float rstd = 1.0f / sqrtf(ss * (1.0f / D) + 1e-6f);
        if (live[r]) {
#pragma unroll
            for (int j = 0; j < 4; ++j) { const f32x4 o = v[r][j] * rstd * wv[j];
                if (hdst[r]) ((GAS f32x4*)hdst[r])[lane + 64 * j] = v[r][j];
                if (udst[r]) ((GAS v2u*)udst[r])[lane + 64 * j] = (v2u){pk2(o.x, o.y), pk2(o.z, o.w)};
                if (fdst[r]) ((GAS f32x4*)fdst[r])[lane + 64 * j] = o; } }
    }
}

__device__ __forceinline__ void ssd_unit(LAS unsigned char* lds, int tid, const GAS bf16* XC, const GAS float* DT, const GAS float* DA, size_t m0, int L, int h, int p0,
                                         const GAS float* hin, GAS float* hout, GAS float* YS, float dskip) {
    LAS float* Bl = (LAS float*)lds;
    LAS float* Cl = Bl + 64 * 128;
    LAS float* Xl = Cl + 64 * 128;
    LAS float* Yl = Xl + 64 * 32;
    LAS float* dtl = Yl + 64 * 32;
    LAS float* dal = dtl + 64;
    const int pl = tid >> 4, nq = tid & 15, n0 = nq * 8, g = h >> 3;
    float s[8];
    if (hin) { const f32x4 a = *(const GAS f32x4*)(hin + (size_t)(p0 + pl) * NST + n0), b = *(const GAS f32x4*)(hin + (size_t)(p0 + pl) * NST + n0 + 4);
        s[0] = a.x; s[1] = a.y; s[2] = a.z; s[3] = a.w; s[4] = b.x; s[5] = b.y; s[6] = b.z; s[7] = b.w; }
    else {
#pragma unroll
        for (int i = 0; i < 8; ++i) s[i] = 0.f; }
    for (int tb = 0; tb < L; tb += 64) {
        const int nb = (L - tb) < 64 ? (L - tb) : 64;
        { const int tk = tid >> 3, part = tid & 7;
            if (tk < nb) { const GAS bf16* xr = XC + (m0 + tb + tk) * CONVD;
                float f[8];
                unpack8(*(const GAS v4u*)(xr + DIN + g * NST + part * 16), f);
                *(LAS f32x4*)(Bl + tk * 128 + part * 16) = (f32x4){f[0], f[1], f[2], f[3]}; *(LAS f32x4*)(Bl + tk * 128 + part * 16 + 4) = (f32x4){f[4], f[5], f[6], f[7]};
                unpack8(*(const GAS v4u*)(xr + DIN + g * NST + part * 16 + 8), f);
                *(LAS f32x4*)(Bl + tk * 128 + part * 16 + 8) = (f32x4){f[0], f[1], f[2], f[3]}; *(LAS f32x4*)(Bl + tk * 128 + part * 16 + 12) = (f32x4){f[4], f[5], f[6], f[7]};
                unpack8(*(const GAS v4u*)(xr + DIN + NG * NST + g * NST + part * 16), f);
                *(LAS f32x4*)(Cl + tk * 128 + part * 16) = (f32x4){f[0], f[1], f[2], f[3]}; *(LAS f32x4*)(Cl + tk * 128 + part * 16 + 4) = (f32x4){f[4], f[5], f[6], f[7]};
                unpack8(*(const GAS v4u*)(xr + DIN + NG * NST + g * NST + part * 16 + 8), f);
                *(LAS f32x4*)(Cl + tk * 128 + part * 16 + 8) = (f32x4){f[0], f[1], f[2], f[3]}; *(LAS f32x4*)(Cl + tk * 128 + part * 16 + 12) = (f32x4){f[4], f[5], f[6], f[7]};
                const v2u xw = *(const GAS v2u*)(xr + h * HP + p0 + part * 4);
                *(LAS f32x4*)(Xl + tk * 32 + part * 4) = (f32x4){__uint_as_float(xw.x << 16), __uint_as_float(xw.x & 0xffff0000u), __uint_as_float(xw.y << 16), __uint_as_float(xw.y & 0xffff0000u)};
            }
            if (tid < nb) { dtl[tid] = DT[(m0 + tb + tid) * 32 + h]; dal[tid] = DA[(m0 + tb + tid) * 32 + h]; }
        }
        __syncthreads();
        for (int t = 0; t < nb; ++t) {
            const float da = dal[t], dtv = dtl[t], xv = Xl[t * 32 + pl], xdt = xv * dtv;
            const f32x4 b0 = *(const LAS f32x4*)(Bl + t * 128 + n0), b1 = *(const LAS f32x4*)(Bl + t * 128 + n0 + 4);
            const f32x4 c0 = *(const LAS f32x4*)(Cl + t * 128 + n0), c1 = *(const LAS f32x4*)(Cl + t * 128 + n0 + 4);
            s[0] = s[0] * da + xdt * b0.x; s[1] = s[1] * da + xdt * b0.y; s[2] = s[2] * da + xdt * b0.z; s[3] = s[3] * da + xdt * b0.w;
            s[4] = s[4] * da + xdt * b1.x; s[5] = s[5] * da + xdt * b1.y; s[6] = s[6] * da + xdt * b1.z; s[7] = s[7] * da + xdt * b1.w;
            float y = (s[0] * c0.x + s[1] * c0.y) + (s[2] * c0.z + s[3] * c0.w) + (s[4] * c1.x + s[5] * c1.y) + (s[6] * c1.z + s[7] * c1.w);
            y += __shfl_xor(y, 1); y += __shfl_xor(y, 2); y += __shfl_xor(y, 4); y += __shfl_xor(y, 8);
            if (nq == 0) Yl[t * 32 + pl] = y + xv * dskip;
        }
        __syncthreads();
        { const int tk = tid >> 3, part = tid & 7;
            if (tk < nb) *(GAS f32x4*)(YS + (m0 + tb + tk) * DIN + h * HP + p0 + part * 4) = *(const LAS f32x4*)(Yl + tk * 32 + part * 4); }
    }
    *(GAS f32x4*)(hout + (size_t)(p0 + pl) * NST + n0) = (f32x4){s[0], s[1], s[2], s[3]};
    *(GAS f32x4*)(hout + (size_t)(p0 + pl) * NST + n0 + 4) = (f32x4){s[4], s[5], s[6], s[7]};
}

__device__ __forceinline__ void idx_load_q(const GAS bf16* P1, const GAS float* MISC, size_t mq0, int lane, bf16x8 (&afr)[2][4], float (&wq)[2][2][8]) {
    const int r = lane & 31, hh = lane >> 5, qs = ((r >> 2) & 1) * 2 + (r >> 4), head = (r & 3) + 4 * ((r >> 3) & 1);
#pragma unroll
    for (int rt = 0; rt < 2; ++rt)
#pragma unroll
        for (int ks = 0; ks < 4; ++ks) afr[rt][ks] = *(const GAS bf16x8*)(P1 + (mq0 + qs + 4 * rt) * LDP1 + C_QI + head * 64 + 16 * ks + 8 * hh);
#pragma unroll
    for (int rt = 0; rt < 2; ++rt)
#pragma unroll
        for (int jq = 0; jq < 2; ++jq) { const GAS float* wp = MISC + (mq0 + 4 * rt + 2 * hh + jq) * 128 + MC_WI; const f32x4 a = *(const GAS f32x4*)wp, b = *(const GAS f32x4*)(wp + 4);
            const float sc = 0.125f * 0.35355339059327373f;
            wq[rt][jq][0] = a.x * sc; wq[rt][jq][1] = a.y * sc; wq[rt][jq][2] = a.z * sc; wq[rt][jq][3] = a.w * sc; wq[rt][jq][4] = b.x * sc; wq[rt][jq][5] = b.y * sc; wq[rt][jq][6] = b.z * sc; wq[rt][jq][7] = b.w * sc; }
}
__device__ __forceinline__ void idx_scores(const bf16x8 (&afr)[2][4], const bf16x8 (&bfr)[4], const float (&wq)[2][2][8], float (&sc)[2][2]) {
#pragma unroll
    for (int rt = 0; rt < 2; ++rt) {
        f32x16 acc = {};
#pragma unroll
        for (int ks = 0; ks < 4; ++ks) acc = __builtin_amdgcn_mfma_f32_32x32x16_bf16(afr[rt][ks], bfr[ks], acc, 0, 0, 0);
#pragma unroll
        for (int jq = 0; jq < 2; ++jq) { float s = 0.f;
#pragma unroll
            for (int i = 0; i < 8; ++i) s += wq[rt][jq][i] * fmaxf(acc[8 * jq + i], 0.f);
            sc[rt][jq] = s; }
    }
}
__device__ __forceinline__ unsigned f2key(float f) { const unsigned u = __float_as_uint(f); return u ^ ((u >> 31) ? 0xffffffffu : 0x80000000u); }
__device__ __forceinline__ unsigned wave_incl_scan(unsigned v, int lane) {
#pragma unroll
    for (int o = 1; o < 64; o <<= 1) { const unsigned t = __shfl_up(v, o); if (lane >= o) v += t; }
    return v;
}
#ifndef REP_TK_PASS
#define REP_TK_PASS 1
#endif
#ifndef REP_TK_COMP
#define REP_TK_COMP 1
#endif
__device__ __forceinline__ int wave_sum_i(int v) {
    v += __builtin_amdgcn_update_dpp(0, v, 0xB1, 0xf, 0xf, true);
    v += __builtin_amdgcn_update_dpp(0, v, 0x4E, 0xf, 0xf, true);
    v += __builtin_amdgcn_update_dpp(0, v, 0x141, 0xf, 0xf, true);
    v += __builtin_amdgcn_update_dpp(0, v, 0x140, 0xf, 0xf, true);
    v += __builtin_amdgcn_update_dpp(0, v, 0x142, 0xa, 0xf, false);
    v += __builtin_amdgcn_update_dpp(0, v, 0x143, 0xc, 0xf, false);
    return __builtin_amdgcn_readlane(v, 63);
}
__device__ __forceinline__ int cnt_ge(const LAS unsigned* s, int nit, unsigned mid, int lane) {
    int cl = 0; int it = 0;
    const LAS v4u* p = (const LAS v4u*)s + lane;
    for (; it + 4 <= nit; it += 4) {
        const v4u k0 = p[64 * it], k1 = p[64 * it + 64], k2 = p[64 * it + 128], k3 = p[64 * it + 192];
        cl += (k0.x >= mid) + (k0.y >= mid) + (k0.z >= mid) + (k0.w >= mid);
        cl += (k1.x >= mid) + (k1.y >= mid) + (k1.z >= mid) + (k1.w >= mid);
        cl += (k2.x >= mid) + (k2.y >= mid) + (k2.z >= mid) + (k2.w >= mid);
        cl += (k3.x >= mid) + (k3.y >= mid) + (k3.z >= mid) + (k3.w >= mid); }
    for (; it < nit; ++it) { const v4u kv = p[64 * it]; cl += (kv.x >= mid) + (kv.y >= mid) + (kv.z >= mid) + (kv.w >= mid); }
    return wave_sum_i(cl);
}
constexpr int HB = 512;
__device__ __forceinline__ unsigned hist_bound_key(int b) {
    return b <= 0 ? 1u : (b >= HB ? 0xff800001u : (b == 256 ? 0x7fffffffu : f2key((float)(b - 256) * (1.0f / 64.0f))));
}
template <class OT>
__device__ __forceinline__ void topk_select(LAS unsigned* s, int n, int lane, OT* out, const LAS unsigned* hist = nullptr) {
    const int nit = (n + 255) >> 8;
    for (int i = n + lane; i < nit * 256; i += 64) s[i] = 0u;
    LDS_WAIT(); asm volatile("" ::: "memory");
    unsigned T = 0u, need = 0u;
    for (int rq_ = 0; rq_ < REP_TK_PASS; ++rq_) {
    unsigned hi, lo; int c_hi, c_lo;
    if (hist) {
        unsigned c[8], tot = 0u;
#pragma unroll
        for (int j = 0; j < 8; ++j) { c[j] = hist[HB - 1 - 8 * lane - j]; tot += c[j]; }
        const unsigned incl = wave_incl_scan(tot, lane), excl = incl - tot;
        const bool here = (excl < 256u) && (256u <= incl);
        int bin = 0; unsigned above = 0u, inb = 0u;
        if (here) { unsigned run = excl;
#pragma unroll
            for (int j = 0; j < 8; ++j) { if (run < 256u && 256u <= run + c[j]) { bin = HB - 1 - 8 * lane - j; above = run; inb = c[j]; } run += c[j]; } }
        const unsigned long long mk = __ballot(here); const int src = mk ? (__ffsll((long long)mk) - 1) : 0;
        bin = __builtin_amdgcn_readlane(bin, src); above = (unsigned)__builtin_amdgcn_readlane((int)above, src); inb = (unsigned)__builtin_amdgcn_readlane((int)inb, src);
        lo = hist_bound_key(bin); hi = hist_bound_key(bin + 1); c_hi = (int)above; c_lo = (int)(above + inb);
    } else {
    unsigned kmx = 0u;
    for (int it = 0; it < nit; ++it) { const v4u kv = *(const LAS v4u*)(s + 4 * (lane + 64 * it));
        const unsigned a = kv.x > kv.y ? kv.x : kv.y, c = kv.z > kv.w ? kv.z : kv.w, d = a > c ? a : c; kmx = d > kmx ? d : kmx; }
#pragma unroll
    for (int o = 1; o < 64; o <<= 1) { const unsigned a = __shfl_xor(kmx, o); kmx = a > kmx ? a : kmx; }
    kmx = (unsigned)__builtin_amdgcn_readfirstlane((int)kmx);
    hi = kmx + 1u; lo = 1u; c_hi = 0; c_lo = n;
    { unsigned step = 1u << 25;
      for (int tr = 0; tr < 7; ++tr) { if (hi <= step + 1u) break; const unsigned cand = hi - step;
          const int c = cnt_ge(s, nit, cand, lane);
          if (c >= 256) { lo = cand; c_lo = c; break; } hi = cand; c_hi = c; step <<= 1; } }
    }
    bool bis = false; unsigned pw = hi - lo;
    for (int pass = 0; pass < 96; ++pass) {
        if (c_lo == 256) { T = lo - 1u; need = 0u; break; }
        if (hi - lo <= 1u) { T = lo; need = (unsigned)(256 - c_hi); break; }
        const unsigned width = hi - lo; unsigned mid;
        if (bis) mid = lo + (width >> 1);
        else { const float f = ((float)(c_lo - 256) + 0.5f) * __builtin_amdgcn_rcpf((float)(c_lo - c_hi)); const float off = (float)width * f;
               mid = lo + (off >= (float)width ? width - 1u : (unsigned)off); }
        if (mid <= lo) mid = lo + 1u; if (mid >= hi) mid = hi - 1u;
        const int c = cnt_ge(s, nit, mid, lane);
        if (c >= 256) { lo = mid; c_lo = c; } else { hi = mid; c_hi = c; }
        const unsigned nw = hi - lo; bis = !bis && (nw > (pw >> 2)); pw = nw;
    }
    }
    const unsigned long long lt = (1ull << lane) - 1ull;
    unsigned running = 0u, eq_taken = 0u;
    for (int rq_ = 0; rq_ < REP_TK_COMP; ++rq_) { running = 0u; eq_taken = 0u;
#pragma unroll 2
    for (int it = 0; it < nit; ++it) {
        const int i0 = 4 * (lane + 64 * it); const v4u kv = *(const LAS v4u*)(s + i0);
        bool sel[4], eq[4]; bool anyeq = false;
#pragma unroll
        for (int e = 0; e < 4; ++e) { sel[e] = kv[e] > T; eq[e] = need != 0u && kv[e] == T && (i0 + e < n); anyeq = anyeq || eq[e]; }
        if (need != 0u && __ballot(anyeq)) {
            unsigned lower = 0u, all = 0u;
#pragma unroll
            for (int e = 0; e < 4; ++e) { const unsigned long long bm = __ballot(eq[e]); lower += (unsigned)__popcll(bm & lt); all += (unsigned)__popcll(bm); }
            unsigned er = eq_taken + lower;
#pragma unroll
            for (int e = 0; e < 4; ++e) { if (eq[e]) { sel[e] = er < need; ++er; } }
            eq_taken += all;
        }
        unsigned lower = 0u, all = 0u;
#pragma unroll
        for (int e = 0; e < 4; ++e) { const unsigned long long sm = __ballot(sel[e]); lower += (unsigned)__popcll(sm & lt); all += (unsigned)__popcll(sm); }
        unsigned pos = running + lower;
#pragma unroll
        for (int e = 0; e < 4; ++e) { if (sel[e]) { if (pos < 256u) out[pos] = (OT)(i0 + e); ++pos; } }
        running += all;
    } }
}

constexpr int NCH = 33;
typedef short s16x4 __attribute__((ext_vector_type(4)));
typedef short v4i16_t __attribute__((ext_vector_type(4)));
__device__ __forceinline__ float wave_incl_scan_f(float v, int lane) {
#pragma unroll
    for (int o = 1; o < 64; o <<= 1) { const float t = __shfl_up(v, o); if (lane >= o) v += t; }
    return v;
}
__device__ __forceinline__ s16x4 ldtr(const LAS unsigned char* p) { return __builtin_bit_cast(s16x4, __builtin_amdgcn_ds_read_tr16_b64_v4i16((LAS v4i16_t*)p)); }
__device__ __forceinline__ bf16x8 frag_tr(const LAS unsigned char* img, int RS, int k0, int c0, int lane) {
    const int hh = lane >> 5, blk = (lane >> 4) & 1, q = (lane & 15) >> 2, pp = lane & 3;
    const LAS unsigned char* a = img + (k0 + 8 * hh + q) * RS + (c0 + 16 * blk + 4 * pp) * 2;
    const s16x4 lo = ldtr(a), hi = ldtr(a + 4 * RS);
    return (bf16x8){lo[0], lo[1], lo[2], lo[3], hi[0], hi[1], hi[2], hi[3]};
}
__device__ __forceinline__ bf16x8 frag_row(const LAS unsigned char* img, int RS, int r0, int k0, int lane) {
    return *(const LAS bf16x8*)(img + (r0 + (lane & 31)) * RS + (k0 + 8 * (lane >> 5)) * 2);
}
constexpr int RS_BC = 272, RS_X = 144, IMG_BC = 128 * RS_BC, IMG_X = 128 * RS_X;
__device__ __forceinline__ void ssd_stage_acum(LAS float* acl, LAS float* dtl, const GAS float* DT, const GAS float* a_log_l, size_t m0, int Lc, int g, int wave, int lane) {
    const int h = 8 * g + wave; const float A = -__expf(a_log_l[h]);
    const float d0 = lane < Lc ? DT[(m0 + lane) * 32 + h] : 0.f, d1 = (64 + lane) < Lc ? DT[(m0 + 64 + lane) * 32 + h] : 0.f;
    const float s0 = wave_incl_scan_f(d0 * A, lane), tot0 = __shfl(s0, 63), s1 = wave_incl_scan_f(d1 * A, lane) + tot0;
    acl[wave * 128 + lane] = s0; acl[wave * 128 + 64 + lane] = s1; dtl[wave * 128 + lane] = d0; dtl[wave * 128 + 64 + lane] = d1;
}
__device__ __forceinline__ void ssd_stage_bc(LAS unsigned char* img, const GAS bf16* src  , int Lc, int tid) {
    const int ch = tid & 15;
#pragma unroll
    for (int q4 = 0; q4 < 4; ++q4) { const int row = (tid >> 4) + 32 * q4; v4u v = (v4u){0u, 0u, 0u, 0u}; if (row < Lc) v = *(const GAS v4u*)(src + (size_t)row * CONVD + ch * 8);
        *(LAS v4u*)(img + row * RS_BC + ch * 16) = v; }
}
__device__ __forceinline__ void ssd_stage_x(LAS unsigned char* img, const GAS bf16* src  , int Lc, int tid, const LAS float* dth, const LAS float* ach, float al, bool decay) {
    const int ch = tid & 7;
#pragma unroll
    for (int q2 = 0; q2 < 2; ++q2) { const int row = (tid >> 3) + 64 * q2; v4u o = (v4u){0u, 0u, 0u, 0u};
        if (row < Lc) { float f[8]; unpack8(*(const GAS v4u*)(src + (size_t)row * CONVD + ch * 8), f);
            const float sc = decay ? dth[row] * __expf(al - ach[row]) : dth[row];
            o = (v4u){pk2(f[0] * sc, f[1] * sc), pk2(f[2] * sc, f[3] * sc), pk2(f[4] * sc, f[5] * sc), pk2(f[6] * sc, f[7] * sc)}; }
        *(LAS v4u*)(img + row * RS_X + ch * 16) = o; }
}
__device__ __forceinline__ void ssd1_unit(LAS unsigned char* lds, int tid, const GAS bf16* XC, const GAS float* DT, const GAS float* a_log_l, GAS bf16* SB, GAS float* DEC, int b, int c, int g) {
    const int lane = tid & 63, wave = __builtin_amdgcn_readfirstlane(tid >> 6), hh = lane >> 5, col = lane & 31;
    const int t0 = c == 0 ? 0 : NMETA + 128 * (c - 1), Lc = c == 0 ? NMETA : 128; const size_t m0 = (size_t)b * LP + t0;
    LAS unsigned char* Bimg = lds; LAS unsigned char* Xw0 = lds + IMG_BC;
    LAS float* acl = (LAS float*)(lds + IMG_BC + 2 * IMG_X); LAS float* dtl = acl + 1024;
    ssd_stage_acum(acl, dtl, DT, a_log_l, m0, Lc, g, wave, lane);
    ssd_stage_bc(Bimg, XC + m0 * CONVD + DIN + g * NST, Lc, tid);
    __syncthreads();
    const int pb = wave >> 2, nb = wave & 3;
    for (int hl = 0; hl < 8; ++hl) {
        const int h = 8 * g + hl; LAS unsigned char* Xw = Xw0 + (hl & 1) * IMG_X;
        const float al = acl[hl * 128 + 127];
        ssd_stage_x(Xw, XC + m0 * CONVD + h * HP, Lc, tid, dtl + hl * 128, acl + hl * 128, al, true);
        __syncthreads();
        f32x16 acc = {};
        if (Lc == 128) {
#pragma unroll
            for (int ks = 0; ks < 8; ++ks) acc = __builtin_amdgcn_mfma_f32_32x32x16_bf16(frag_tr(Xw, RS_X, 16 * ks, 32 * pb, lane), frag_tr(Bimg, RS_BC, 16 * ks, 32 * nb, lane), acc, 0, 0, 0);
        } else acc = __builtin_amdgcn_mfma_f32_32x32x16_bf16(frag_tr(Xw, RS_X, 0, 32 * pb, lane), frag_tr(Bimg, RS_BC, 0, 32 * nb, lane), acc, 0, 0, 0);
        GAS bf16* Sp = SB + ((size_t)(b * NCH + c) * NH + h) * (HP * NST) + 32 * nb + col;
#pragma unroll
        for (int r = 0; r < 16; ++r) Sp[(32 * pb + (r & 3) + 8 * (r >> 2) + 4 * hh) * NST] = (bf16)f2bf(acc[r]);
        if (tid == 0) DEC[(b * NCH + c) * NH + h] = __expf(al);
    }
    __syncthreads();
}
__device__ __forceinline__ void ssd3_unit(LAS unsigned char* lds, int tid, const GAS bf16* XC, const GAS bf16* P1, const GAS float* DT, const GAS float* a_log_l, const GAS float* dskip_l, const GAS float* normw_l,
                                          const GAS bf16* HC, GAS bf16* YSN, int b, int c, int g) {
    const int lane = tid & 63, wave = __builtin_amdgcn_readfirstlane(tid >> 6), hh = lane >> 5, col = lane & 31;
    const int t0 = c == 0 ? 0 : NMETA + 128 * (c - 1), Lc = c == 0 ? NMETA : 128; const size_t m0 = (size_t)b * LP + t0;
    LAS unsigned char* Bimg = lds; LAS unsigned char* Cimg = lds + IMG_BC; LAS unsigned char* Mimg0 = lds + 2 * IMG_BC; LAS unsigned char* Ximg0 = lds + 3 * IMG_BC;
    LAS float* acl = (LAS float*)(lds + 3 * IMG_BC + 2 * IMG_X); LAS float* dtl = acl + 1024;
    LAS unsigned char* Mimg1 = Bimg; LAS unsigned char* Ximg1 = Ximg0 + IMG_X;
    ssd_stage_acum(acl, dtl, DT, a_log_l, m0, Lc, g, wave, lane);
    ssd_stage_bc(Bimg, XC + m0 * CONVD + DIN + g * NST, Lc, tid);
    ssd_stage_bc(Cimg, XC + m0 * CONVD + DIN + NG * NST + g * NST, Lc, tid);
    __syncthreads();
    const int ib = wave >> 1, pb = wave & 1;
    f32x16 cb[2];
    const bool live = 32 * ib < Lc;
#pragma unroll
    for (int jj = 0; jj < 2; ++jj) { const int jb = 2 * (wave & 1) + jj; cb[jj] = (f32x16){};
        if (jb <= ib && live) {
#pragma unroll
            for (int ks = 0; ks < 8; ++ks) cb[jj] = __builtin_amdgcn_mfma_f32_32x32x16_bf16(frag_row(Cimg, RS_BC, 32 * ib, 16 * ks, lane), frag_row(Bimg, RS_BC, 32 * jb, 16 * ks, lane), cb[jj], 0, 0, 0); } }
    bf16x8 cf[8];
#pragma unroll
    for (int ks = 0; ks < 8; ++ks) cf[ks] = frag_row(Cimg, RS_BC, 32 * ib, 16 * ks, lane);
    __syncthreads();
    const int xrow = tid >> 3, xch = tid & 7;
    const GAS bf16* xsrc = XC + (m0 + xrow) * CONVD + (8 * g) * HP + xch * 8;
    v4u xq0 = (v4u){0u, 0u, 0u, 0u}, xq1 = xq0;
    if (xrow < Lc) xq0 = *(const GAS v4u*)xsrc;
    if (xrow + 64 < Lc) xq1 = *(const GAS v4u*)(xsrc + (size_t)64 * CONVD);
    for (int hl = 0; hl < 8; ++hl) {
        const int h = 8 * g + hl;
        LAS unsigned char* Mimg = (hl & 1) ? Mimg1 : Mimg0; LAS unsigned char* Ximg = (hl & 1) ? Ximg1 : Ximg0;
        bf16x8 hf[8];
        { const GAS bf16* Hp = HC + ((size_t)(b * NCH + c) * NH + h) * (HP * NST) + pb * 4096 + lane * 8;
#pragma unroll
          for (int ks = 0; ks < 8; ++ks) hf[ks] = *(const GAS bf16x8*)(Hp + 512 * ks); }
        v4u xn0 = xq0, xn1 = xq1;
        if (hl < 7 && xrow < Lc) xn0 = *(const GAS v4u*)(xsrc + (hl + 1) * HP);
        if (hl < 7 && xrow + 64 < Lc) xn1 = *(const GAS v4u*)(xsrc + (size_t)64 * CONVD + (hl + 1) * HP);
        float ai[16];
#pragma unroll
        for (int r = 0; r < 16; ++r) ai[r] = acl[hl * 128 + 32 * ib + (r & 3) + 8 * (r >> 2) + 4 * hh];
#pragma unroll
        for (int jj = 0; jj < 2; ++jj) { const int jb = 2 * (wave & 1) + jj;
            if (jb <= ib && live) { const int j = 32 * jb + col; const float aj = acl[hl * 128 + j];
                LAS unsigned char* mp = Mimg + (32 * ib + 4 * hh) * RS_BC + j * 2;
#pragma unroll
                for (int r = 0; r < 16; ++r) { const int il = (r & 3) + 8 * (r >> 2);
                    const float v = (j <= 32 * ib + 4 * hh + il) ? cb[jj][r] * __expf(ai[r] - aj) : 0.f;
                    *(LAS unsigned short*)(mp + il * RS_BC) = (unsigned short)f2bf(v); } } }
        { const float s0 = dtl[hl * 128 + xrow], s1 = dtl[hl * 128 + 64 + xrow]; float f[8]; v4u o0, o1;
          unpack8(xq0, f); o0 = (v4u){pk2(f[0] * s0, f[1] * s0), pk2(f[2] * s0, f[3] * s0), pk2(f[4] * s0, f[5] * s0), pk2(f[6] * s0, f[7] * s0)};
          unpack8(xq1, f); o1 = (v4u){pk2(f[0] * s1, f[1] * s1), pk2(f[2] * s1, f[3] * s1), pk2(f[4] * s1, f[5] * s1), pk2(f[6] * s1, f[7] * s1)};
          *(LAS v4u*)(Ximg + xrow * RS_X + xch * 16) = o0; *(LAS v4u*)(Ximg + (xrow + 64) * RS_X + xch * 16) = o1; }
        __syncthreads();
        f32x16 a1 = {}, a2 = {};
        if (live) {
        const int nks = Lc == 128 ? 2 * (ib + 1) : 1;
        for (int ks = 0; ks < nks; ++ks) a1 = __builtin_amdgcn_mfma_f32_32x32x16_bf16(frag_row(Mimg, RS_BC, 32 * ib, 16 * ks, lane), frag_tr(Ximg, RS_X, 16 * ks, 32 * pb, lane), a1, 0, 0, 0);
#pragma unroll
        for (int ks = 0; ks < 8; ++ks) a2 = __builtin_amdgcn_mfma_f32_32x32x16_bf16(cf[ks], hf[ks], a2, 0, 0, 0);
        GAS bf16* yo = YSN + (m0 + 32 * ib + 4 * hh) * DIN + h * HP + 32 * pb + col;
#pragma unroll
        for (int r = 0; r < 16; ++r) { const int il = (r & 3) + 8 * (r >> 2);
            if (32 * ib + 4 * hh + il < Lc) yo[(size_t)il * DIN] = (bf16)f2bf(a1[r] + __expf(ai[r]) * a2[r]); }
        }
        xq0 = xn0; xq1 = xn1;
    }
    __syncthreads();
    for (int i0 = wave; i0 < Lc; i0 += 4 * NWAVES) { const int c0 = g * 512 + lane * 8;
        v4u yv[4], xv[4], zv[4];
#pragma unroll
        for (int q = 0; q < 4; ++q) { const int i = i0 + NWAVES * q; const size_t m = m0 + (i < Lc ? i : i0);
            yv[q] = *(const GAS v4u*)(YSN + m * DIN + c0); xv[q] = *(const GAS v4u*)(XC + m * CONVD + c0); zv[q] = *(const GAS v4u*)(P1 + m * LDP1 + C_Z + c0); }
        const float Dh = dskip_l[c0 >> 6];
        const GAS float* wp = normw_l + c0; const f32x4 wa = *(const GAS f32x4*)wp, wb = *(const GAS f32x4*)(wp + 4);
#pragma unroll
        for (int q = 0; q < 4; ++q) { const int i = i0 + NWAVES * q;
            float v[8], x[8], z[8]; unpack8(yv[q], v); unpack8(xv[q], x); unpack8(zv[q], z); float ss = 0.f;
#pragma unroll
            for (int j = 0; j < 8; ++j) { v[j] = (v[j] + Dh * x[j]) * (z[j] * sigm(z[j])); ss += v[j] * v[j]; }
            ss = wave_sum(ss);
            const float rstd = 1.0f / sqrtf(ss * (1.0f / 512.0f) + 1e-6f);
            if (i < Lc) *(GAS v4u*)(YSN + (m0 + i) * DIN + c0) = (v4u){pk2(v[0] * rstd * wa.x, v[1] * rstd * wa.y), pk2(v[2] * rstd * wa.z, v[3] * rstd * wa.w), pk2(v[4] * rstd * wb.x, v[5] * rstd * wb.y), pk2(v[6] * rstd * wb.z, v[7] * rstd * wb.w)}; }
    }
    __syncthreads();
}

constexpr int RS_V = 528;
__device__ __forceinline__ void attn_prompt_query(LAS unsigned char* wl, const GAS bf16* P1, const GAS bf16* KVB, const GAS unsigned short* IDXP, GAS bf16* YA, int m, int lane_in) {
    int lane = lane_in; asm volatile("" : "+v"(lane));
    const int b = m / LP, t = m - b * LP, cnt = (t + 1) < 256 ? (t + 1) : 256, ntile = (cnt + 15) >> 4, nstep = (ntile + 1) >> 1;
    LAS unsigned char* Vst = wl; LAS unsigned short* idl = (LAS unsigned short*)(wl + 32 * RS_V);
    { const v2u w = *(const GAS v2u*)(IDXP + (size_t)m * 256 + 4 * lane); const int s0 = 4 * lane;
      const unsigned i0 = (s0 + 0 < cnt) ? (w.x & 0xffffu) : 0u, i1 = (s0 + 1 < cnt) ? (w.x >> 16) : 0u, i2 = (s0 + 2 < cnt) ? (w.y & 0xffffu) : 0u, i3 = (s0 + 3 < cnt) ? (w.y >> 16) : 0u;
      *(LAS v2u*)(idl + s0) = (v2u){i0 | (i1 << 16), i2 | (i3 << 16)}; }
    const int n = lane & 15, kg = lane >> 4;
    int k4 = 4 * kg; asm volatile("" : "+v"(k4));
    bf16x8 bq[8];
#pragma unroll
    for (int s = 0; s < 8; ++s) { bq[s] = (bf16x8){0, 0, 0, 0, 0, 0, 0, 0};
        if ((n >> 2) == (s >> 1)) bq[s] = *(const GAS bf16x8*)(P1 + (size_t)m * LDP1 + C_Q + n * 64 + 32 * (s & 1) + 8 * kg); }
    LDS_WAIT(); asm volatile("" ::: "memory");
    const GAS char* kvb = (const GAS char*)(KVB + (size_t)b * LP * 512);
    const unsigned voff = 512u + 16u * (lane & 31);
    f32x4 S[16];
#pragma unroll
    for (int jt = 0; jt < 16; ++jt) S[jt] = (f32x4){-INFINITY, -INFINITY, -INFINITY, -INFINITY};
    float mx = -INFINITY;
    {
        v4u kst[3][8];
#define KLOAD(dst, tile) do { _Pragma("unroll") for (int it = 0; it < 8; ++it) dst[it] = *(const GAS v4u*)(kvb + ((unsigned)idl[16 * (tile) + 2 * it + (lane >> 5)] * 1024u + 16u * (lane & 31))); } while (0)
        KLOAD(kst[0], 0);
#pragma unroll
        for (int it = 0; it < 8; ++it) { kst[1][it] = kst[0][it]; kst[2][it] = kst[0][it]; }
        if (1 < ntile) KLOAD(kst[1], 1);
        if (2 < ntile) KLOAD(kst[2], 2);
#pragma unroll
        for (int jt = 0; jt < 16; ++jt) {
            if (jt < ntile) {
                LAS unsigned char* half = Vst + 16 * (jt & 1) * RS_V;
#pragma unroll
                for (int it = 0; it < 8; ++it) *(LAS v4u*)(half + (2 * it + (lane >> 5)) * RS_V + 16 * (lane & 31)) = kst[jt % 3][it];
                LDS_WAIT(); asm volatile("" ::: "memory");
                if (jt + 3 < ntile) KLOAD(kst[jt % 3], jt + 3);
                f32x4 acc = {0.f, 0.f, 0.f, 0.f};
#pragma unroll
                for (int s8 = 0; s8 < 8; ++s8) acc = __builtin_amdgcn_mfma_f32_16x16x32_bf16(*(const LAS bf16x8*)(half + n * RS_V + (32 * s8 + 8 * kg) * 2), bq[s8], acc, 0, 0, 0);
                f32x4 sv;
#pragma unroll
                for (int i = 0; i < 4; ++i) { const float v = (k4 + i < cnt - 16 * jt) ? acc[i] * 0.125f : -INFINITY; sv[i] = v; mx = fmaxf(mx, v); }
                S[jt] = sv;
                LDS_WAIT(); asm volatile("" ::: "memory");
            }
        }
#undef KLOAD
    }
    mx = fmaxf(mx, __shfl_xor(mx, 16)); mx = fmaxf(mx, __shfl_xor(mx, 32));
    float sum = 0.f;
    v4u pa[8];
#pragma unroll
    for (int s = 0; s < 8; ++s) { float p[8];
#pragma unroll
        for (int i = 0; i < 4; ++i) { p[i] = __expf(S[2 * s][i] - mx); p[4 + i] = __expf(S[2 * s + 1][i] - mx); }
#pragma unroll
        for (int i = 0; i < 8; ++i) sum += p[i];
        pa[s] = (v4u){pk2(p[0], p[1]), pk2(p[2], p[3]), pk2(p[4], p[5]), pk2(p[6], p[7])};
        __builtin_amdgcn_sched_barrier(0); }
    sum += __shfl_xor(sum, 16); sum += __shfl_xor(sum, 32);
    const float linv = 1.0f / sum;
    asm volatile("" ::: "memory");
    v4u vst[3][8];
#define VLOAD(dst, tile) do { _Pragma("unroll") for (int it = 0; it < 8; ++it) dst[it] = *(const GAS v4u*)(kvb + ((unsigned)idl[16 * (tile) + 2 * it + (lane >> 5)] * 1024u + voff)); } while (0)
#define VSTORE(src, tt) do { _Pragma("unroll") for (int it = 0; it < 8; ++it) { const int u = 2 * it + (lane >> 5); *(LAS v4u*)(Vst + (8 * (u >> 2) + 4 * (tt) + (u & 3)) * RS_V + 16 * (lane & 31)) = src[it]; } } while (0)
    VLOAD(vst[0], 0);
#pragma unroll
    for (int it = 0; it < 8; ++it) { vst[1][it] = vst[0][it]; vst[2][it] = vst[0][it]; }
    if (1 < ntile) VLOAD(vst[1], 1);
    if (2 < ntile) VLOAD(vst[2], 2);
    f32x4 o[4];
#pragma unroll
    for (int c = 0; c < 4; ++c) o[c] = (f32x4){0.f, 0.f, 0.f, 0.f};
    const int g16 = lane >> 4, q4 = (lane & 15) >> 2, p4 = lane & 3;
    const LAS unsigned char* trb = Vst + (8 * g16 + q4) * RS_V + 8 * p4;
#pragma unroll
    for (int s = 0; s < 8; ++s) {
        if (s < nstep) {
            VSTORE(vst[(2 * s) % 3], 0);
            VSTORE(vst[(2 * s + 1) % 3], 1);
            LDS_WAIT(); asm volatile("" ::: "memory");
            if (2 * s + 3 < ntile) VLOAD(vst[(2 * s) % 3], 2 * s + 3);
            if (2 * s + 4 < ntile) VLOAD(vst[(2 * s + 1) % 3], 2 * s + 4);
#pragma unroll
            for (int g = 0; g < 4; ++g) {
                const v4u pm = ((n >> 2) == g) ? pa[s] : (v4u){0u, 0u, 0u, 0u};
                const bf16x8 pf = __builtin_bit_cast(bf16x8, pm);
#pragma unroll
                for (int c = 0; c < 4; ++c) { const int ct = 4 * g + c;
                    const s16x4 lo = ldtr(trb + 32 * ct), hi = ldtr(trb + 4 * RS_V + 32 * ct);
                    const bf16x8 bv = (bf16x8){lo[0], lo[1], lo[2], lo[3], hi[0], hi[1], hi[2], hi[3]};
                    o[c] = __builtin_amdgcn_mfma_f32_16x16x32_bf16(pf, bv, o[c], 0, 0, 0); }
            }
            LDS_WAIT(); asm volatile("" ::: "memory");
        }
    }
#undef VLOAD
#undef VSTORE
#pragma unroll
    for (int i = 0; i < 4; ++i) { const float li = __shfl(linv, 4 * kg + i);
#pragma unroll
        for (int c = 0; c < 4; ++c) YA[(size_t)m * D + (4 * kg + i) * 64 + 16 * c + n] = (bf16)f2bf(o[c][i] * li); }
}

__device__ __forceinline__ void attn_sample_query(LAS unsigned char* lds, int tid, const GAS bf16* P1, const GAS bf16* KVB, const GAS float* ck, const GAS float* cv, const GAS int* ptab, const GAS int* IDXS, GAS bf16* YA, int qi) {
    const int lane = tid & 63, wave = tid >> 6, bd = qi >> 3; const size_t m = (size_t)MP + qi;
    LAS float* Sl = (LAS float*)lds;
    LAS float* Ol = Sl + 16 * 256;
    LAS float* ql = Ol + 8 * 1024;
    LAS float* linv = ql + 1024;
    LAS int* rowsel = (LAS int*)(linv + 16);
    { const unsigned w = *(const GAS unsigned*)(P1 + m * LDP1 + C_Q + 2 * tid); ql[2 * tid] = __uint_as_float(w << 16); ql[2 * tid + 1] = __uint_as_float(w & 0xffff0000u); }
    if (tid < 256) rowsel[tid] = IDXS[qi * 256 + tid];
    __syncthreads();
    const int g = lane >> 4, c = lane & 15;
    float qr[4][4];
#pragma unroll
    for (int a = 0; a < 4; ++a) { const f32x4 t = *(const LAS f32x4*)(ql + (4 * g + a) * 64 + 4 * c); qr[a][0] = t.x; qr[a][1] = t.y; qr[a][2] = t.z; qr[a][3] = t.w; }
#pragma unroll 4
    for (int kk = 0; kk < 32; ++kk) {
        const int key = 32 * wave + kk, idx = rowsel[key];
        f32x4 kv;
        if (idx < PAST) { const int page = ptab[bd * NPAGES + (idx >> 7)]; kv = *(const GAS f32x4*)(ck + ((size_t)page * PAGE + (idx & 127)) * 256 + 4 * lane); }
        else { const v2u w = *(const GAS v2u*)(KVB + (size_t)(MP + bd * DS + (idx - PAST)) * 512 + 4 * lane);
            kv = (f32x4){__uint_as_float(w.x << 16), __uint_as_float(w.x & 0xffff0000u), __uint_as_float(w.y << 16), __uint_as_float(w.y & 0xffff0000u)}; }
        float part[4];
#pragma unroll
        for (int a = 0; a < 4; ++a) { float s = (qr[a][0] * kv.x + qr[a][1] * kv.y) + (qr[a][2] * kv.z + qr[a][3] * kv.w);
            part[a] = row16_sum(s); }
        if (c == 0) {
#pragma unroll
            for (int a = 0; a < 4; ++a) Sl[(4 * g + a) * 256 + key] = part[a] * 0.125f; }
    }
    __syncthreads();
#pragma unroll
    for (int hs = 0; hs < 2; ++hs) { const int head = 2 * wave + hs; float v[4]; float mx = -INFINITY;
#pragma unroll
        for (int j = 0; j < 4; ++j) { v[j] = Sl[head * 256 + lane + 64 * j]; mx = fmaxf(mx, v[j]); }
        mx = wave_max(mx); float sum = 0.f;
#pragma unroll
        for (int j = 0; j < 4; ++j) { v[j] = __expf(v[j] - mx); sum += v[j]; Sl[head * 256 + lane + 64 * j] = v[j]; }
        sum = wave_sum(sum);
        if (lane == 0) linv[head] = 1.0f / sum; }
    __syncthreads();
    float o[4][4];
#pragma unroll
    for (int a = 0; a < 4; ++a)
#pragma unroll
        for (int cc = 0; cc < 4; ++cc) o[a][cc] = 0.f;
#pragma unroll 4
    for (int kk = 0; kk < 32; ++kk) {
        const int key = 32 * wave + kk, idx = rowsel[key];
        f32x4 vv;
        if (idx < PAST) { const int page = ptab[bd * NPAGES + (idx >> 7)]; vv = *(const GAS f32x4*)(cv + ((size_t)page * PAGE + (idx & 127)) * 256 + 4 * lane); }
        else { const v2u w = *(const GAS v2u*)(KVB + (size_t)(MP + bd * DS + (idx - PAST)) * 512 + 256 + 4 * lane);
            vv = (f32x4){__uint_as_float(w.x << 16), __uint_as_float(w.x & 0xffff0000u), __uint_as_float(w.y << 16), __uint_as_float(w.y & 0xffff0000u)}; }
#pragma unroll
        for (int a = 0; a < 4; ++a) { const float p = Sl[(4 * g + a) * 256 + key]; o[a][0] += p * vv.x; o[a][1] += p * vv.y; o[a][2] += p * vv.z; o[a][3] += p * vv.w; }
    }
#pragma unroll
    for (int a = 0; a < 4; ++a) *(LAS f32x4*)(Ol + wave * 1024 + (4 * g + a) * 64 + 4 * c) = (f32x4){o[a][0], o[a][1], o[a][2], o[a][3]};
    __syncthreads();
    { float s0 = 0.f, s1 = 0.f;
#pragma unroll
      for (int w = 0; w < 8; ++w) { s0 += Ol[w * 1024 + 2 * tid]; s1 += Ol[w * 1024 + 2 * tid + 1]; }
      const float li = linv[(2 * tid) >> 6];
      *(GAS unsigned*)(YA + m * D + 2 * tid) = pk2(s0 * li, s1 * li); }
    __syncthreads();
}

constexpr int TAIL_R0 = 16384, TAIL_NRT = (MR - TAIL_R0) / 64;
static_assert(TAIL_R0 + 64 * TAIL_NRT == MR, "tail rows");
template <int MODE>
__device__ __forceinline__ void tail_gemm(LAS unsigned char* lds, const GAS bf16* A, int K, const GAS bf16* Bt, int N, const GAS bf16* P1, GAS bf16* T1, GAS bf16* MG, GAS float* H, GAS bf16* A2, int bx, int G, int tid) {
    constexpr int KB = 256, RS = (KB + 8) * 2;
    const int lane = tid & 63, wave = __builtin_amdgcn_readfirstlane(tid >> 6), col = lane & 31, hh = lane >> 5;
    const int nunits = TAIL_NRT * (N / 64), lr = tid >> 3, lc = tid & 7, ti = wave & 3, kh = wave >> 2;
    LAS unsigned char* As = lds; LAS unsigned char* Bs = lds + 64 * RS; LAS float* red = (LAS float*)(lds + 2 * 64 * RS);
    for (int u = bx; u < nunits; u += G) {
        const int rt = u % TAIL_NRT, ct = u / TAIL_NRT;
        const GAS bf16* ap = A + (size_t)(TAIL_R0 + 64 * rt + lr) * K + 8 * lc;
        const GAS bf16* bp = Bt + (size_t)(64 * ct + lr) * K + 8 * lc;
        v4u ra[4], rb[4];
#pragma unroll
        for (int j = 0; j < 4; ++j) { ra[j] = *(const GAS v4u*)(ap + 64 * j); rb[j] = *(const GAS v4u*)(bp + 64 * j); }
        f32x16 acc = {};
        for (int k0 = 0; k0 < K; k0 += KB) {
            __syncthreads();
#pragma unroll
            for (int j = 0; j < 4; ++j) { *(LAS v4u*)(As + lr * RS + (lc * 8 + 64 * j) * 2) = ra[j]; *(LAS v4u*)(Bs + lr * RS + (lc * 8 + 64 * j) * 2) = rb[j]; }
            if (k0 + KB < K) {
#pragma unroll
                for (int j = 0; j < 4; ++j) { ra[j] = *(const GAS v4u*)(ap + k0 + KB + 64 * j); rb[j] = *(const GAS v4u*)(bp + k0 + KB + 64 * j); } }
            __syncthreads();
#pragma unroll
            for (int j = 0; j < 8; ++j) { const int ks = 8 * kh + j;
                const bf16x8 av = *(const LAS bf16x8*)(As + (32 * (ti >> 1) + col) * RS + (16 * ks + 8 * hh) * 2), bv = *(const LAS bf16x8*)(Bs + (32 * (ti & 1) + col) * RS + (16 * ks + 8 * hh) * 2);
                acc = __builtin_amdgcn_mfma_f32_32x32x16_bf16(av, bv, acc, 0, 0, 0); }
        }
        __syncthreads();
        if (kh == 1) {
#pragma unroll
            for (int r = 0; r < 16; ++r) red[(ti * 16 + r) * 64 + lane] = acc[r]; }
        __syncthreads();
        if (kh == 0) {
            const int c = 64 * ct + 32 * (ti & 1) + col;
#pragma unroll
            for (int r = 0; r < 16; ++r) { const size_t row = TAIL_R0 + 64 * rt + 32 * (ti >> 1) + (r & 3) + 8 * (r >> 2) + 4 * hh; const float v = acc[r] + red[(ti * 16 + r) * 64 + lane];
                if (MODE == 1) { const float g = __uint_as_float((unsigned)P1[row * LDP1 + C_GS + c] << 16); T1[row * D + c] = (bf16)f2bf(v * sigm(g)); }
                if (MODE == 2) { const float g = __uint_as_float((unsigned)P1[row * LDP1 + C_GA + c] << 16); MG[row * D + c] = (bf16)f2bf(__uint_as_float((unsigned)T1[row * D + c] << 16) + v * sigm(g)); }
                if (MODE == 3) H[row * D + c] += v;
                if (MODE == 4) { const float w = fmaxf(v, 0.f); A2[row * DFF + c] = (bf16)f2bf(w * w); } }
        }
    }
    __syncthreads();
}

#ifndef REP_SEL
#define REP_SEL 1
#endif
#ifndef REP_CONV
#define REP_CONV 1
#endif
#ifndef REP_TOPK
#define REP_TOPK 1
#endif
#ifndef REP_SSC
#define REP_SSC 1
#endif
#ifndef REP_SSEL
#define REP_SSEL 1
#endif
#ifndef REP_SSD1
#define REP_SSD1 1
#endif
#ifndef REP_SREC
#define REP_SREC 1
#endif
#ifndef REP_SCAN
#define REP_SCAN 1
#endif
#ifndef REP_ATTS
#define REP_ATTS 1
#endif
#ifndef REP_ATTP
#define REP_ATTP 1
#endif
#ifndef REP_SSD3
#define REP_SSD3 1
#endif
__device__ __forceinline__ void xcd_barrier_ni(unsigned* bar, unsigned x, volatile LAS unsigned* st, int tid, unsigned G) { XcdBarrier b; b.bar = bar; b.x = x; b.st = st; xcd_barrier(b, tid, G); }
__device__ __forceinline__ void assume_global(const void* p) {
#if defined(__HIP_DEVICE_COMPILE__)
    __builtin_assume(!__builtin_amdgcn_is_shared((const __attribute__((address_space(0))) void*)p));
    __builtin_assume(!__builtin_amdgcn_is_private((const __attribute__((address_space(0))) void*)p));
#else
    (void)p;
#endif
}
__device__ __forceinline__ int tid_now(int wave0) { unsigned ones = ~0u; asm volatile("" : "+s"(ones)); return (wave0 << 6) | (int)__builtin_amdgcn_mbcnt_hi(ones, __builtin_amdgcn_mbcnt_lo(ones, 0u)); }
constexpr int NPH = 12, NPHASES = 1 + 2 * NPH;
struct Args { const void* in[24]; float* out; unsigned char* ws; int l_lo, l_hi; };
static_assert(sizeof(Args) == 24 * 8 + 8 + 8 + 8, "Args has no padding");

template <int KLO, int KHI>
__global__ void __launch_bounds__(NT, 2) fwd_t(Args args) {
    extern __shared__ __attribute__((aligned(16))) unsigned char lds_raw[];
    LAS unsigned char* lds0 = (LAS unsigned char*)lds_raw;
    volatile LAS unsigned* MISCW = (volatile LAS unsigned*)(lds0 + MISC_OFF);
    const int G = gridDim.x, bx = blockIdx.x, NGW = G * NWAVES;
    const int wave0 = __builtin_amdgcn_readfirstlane((int)threadIdx.x >> 6);
#define TID_NOW() tid_now(wave0)
    { const int tid0 = threadIdx.x;
      for (int u = tid0; u < (LDS_BYTES - LDSCTL_OFF) / 4; u += NT) ((LAS unsigned*)(lds0 + LDSCTL_OFF))[u] = 0u; }
    __syncthreads();
    XcdBarrier bar = xcd_barrier_post((unsigned*)(args.ws + WS_CTL) + CW_BAR, MISCW + 8);
#define IN(k) (KLO <= (k) && (k) < KHI)
#define SEAM(k) do { if (IN(k) && IN((k) + 1)) xcd_barrier_ni(bar.bar, bar.x, bar.st, TID_NOW(), (unsigned)G); } while (0)
#define PHASE_REGS \
    int tid = TID_NOW(); asm volatile("" : "+v"(tid)); \
    int bxl = bx, Gl = G; asm volatile("" : "+s"(bxl), "+s"(Gl)); (void)bxl; (void)Gl;     \
    const int lane = tid & 63, wave = __builtin_amdgcn_readfirstlane(tid >> 6), gw = bx * NWAVES + wave; \
    unsigned char* ws_ = args.ws; asm volatile("" : "+s"(ws_)); GAS unsigned char* ws = (GAS unsigned char*)ws_;     \
    float* out_ = args.out; asm volatile("" : "+s"(out_)); GAS float* out = (GAS float*)out_; \
    (void)lane; (void)gw; (void)out; \
    GAS float* H = (GAS float*)(ws + WS_H); GAS bf16* U = (GAS bf16*)(ws + WS_U); GAS bf16* P1 = (GAS bf16*)(ws + WS_P1); GAS float* MISCB = (GAS float*)(ws + WS_MISC); GAS bf16* KIB = (GAS bf16*)(ws + WS_KIB); \
    GAS bf16* XC = (GAS bf16*)(ws + WS_XC); GAS float* DT = (GAS float*)(ws + WS_DT); GAS float* DA = (GAS float*)(ws + WS_DA); GAS float* YS = (GAS float*)(ws + WS_YS); GAS bf16* YSN = (GAS bf16*)(ws + WS_YSN); \
    GAS bf16* YA = (GAS bf16*)(ws + WS_YA); GAS bf16* T1 = (GAS bf16*)(ws + WS_T1); GAS bf16* MG = (GAS bf16*)(ws + WS_MG); GAS bf16* A2 = (GAS bf16*)(ws + WS_A2); \
    GAS unsigned short* IDXP = (GAS unsigned short*)(ws + WS_IDXP); GAS int* IDXS = (GAS int*)(ws + WS_IDXS); GAS float* SCS = (GAS float*)(ws + WS_SCS); \
    GAS bf16* SB = (GAS bf16*)(ws + WS_SB); GAS float* DEC = (GAS float*)(ws + WS_DEC); GAS bf16* HC = (GAS bf16*)(ws + WS_HC); GAS bf16* KVB = (GAS bf16*)(ws + WS_KVB); GAS bf16* KIB2 = (GAS bf16*)(ws + WS_KIB2); (void)KIB2; (void)SB; (void)DEC; (void)HC; (void)KVB; \
    GAS unsigned char* wl = ws + WS_W + (size_t)l * WL_SIZE; \
    (void)H; (void)U; (void)P1; (void)MISCB; (void)KIB; (void)XC; (void)DT; (void)DA; (void)YS; (void)YSN; (void)YA; (void)T1; (void)MG; (void)A2; (void)IDXP; (void)IDXS; (void)SCS; (void)wl;
#define LDS_LOCAL LAS unsigned char* lds = lds0; asm volatile("" : "+s"(lds));
#define INP(T, name, i) const GAS T* name; { const void* p_; asm volatile("s_load_dwordx2 %0, %1, %2\n\ts_waitcnt lgkmcnt(0)" : "=s"(p_) : "s"(__builtin_amdgcn_kernarg_segment_ptr()), "i"((i) * 8)); name = (const GAS T*)p_; }

    if (IN(0) && args.l_lo == 0) {
        const int l = 0; PHASE_REGS
        LDS_LOCAL
        INP(float, w_in, 10) INP(float, w_ssm, 17) INP(float, w_att, 18) INP(float, w_out, 19) INP(float, w_up, 21) INP(float, w_down, 22) INP(float, meta, 8) INP(float, x_prompt, 0) INP(float, x_sample, 1) INP(float, norm1_w, 9)
        LAS float* scr = (LAS float*)(lds + wave * 17408);
        constexpr int I_IN = (D / 64) * (NIN / 64), I_SSM = (DIN / 64) * (D / 64), I_ATT = (D / 64) * (D / 64), I_OUT = I_ATT, I_UP = (D / 64) * (DFF / 64), I_DN = (DFF / 64) * (D / 64);
        constexpr int I_L = I_IN + I_SSM + I_ATT + I_OUT + I_UP + I_DN;
        for (int it = gw; it < 2 * I_L; it += NGW) {
            const int l = it / I_L; int r = it % I_L; GAS unsigned char* wl = ws + WS_W + (size_t)l * WL_SIZE;
            if (r < I_IN) { tr_item(w_in + (size_t)l * D * IN_DIM, D, IN_DIM, (GAS bf16*)(wl + WL_WIN), NIN / 64, true, scr, r, lane); continue; } r -= I_IN;
            if (r < I_SSM) { tr_item(w_ssm + (size_t)l * DIN * D, DIN, D, (GAS bf16*)(wl + WL_WSSM), D / 64, false, scr, r, lane); continue; } r -= I_SSM;
            if (r < I_ATT) { tr_item(w_att + (size_t)l * D * D, D, D, (GAS bf16*)(wl + WL_WATT), D / 64, false, scr, r, lane); continue; } r -= I_ATT;
            if (r < I_OUT) { tr_item(w_out + (size_t)l * D * D, D, D, (GAS bf16*)(wl + WL_WOUT), D / 64, false, scr, r, lane); continue; } r -= I_OUT;
            if (r < I_UP) { tr_item(w_up + (size_t)l * D * DFF, D, DFF, (GAS bf16*)(wl + WL_WUP), DFF / 64, false, scr, r, lane); continue; } r -= I_UP;
            tr_item(w_down + (size_t)l * DFF * D, DFF, D, (GAS bf16*)(wl + WL_WDN), D / 64, false, scr, r, lane);
        }
        for (int m0 = gw; m0 < MPAD; m0 += 4 * NGW) {
            const GAS float* src[4]; GAS float* hd[4]; GAS bf16* ud[4]; GAS float* fd[4]; bool live[4];
#pragma unroll
            for (int r = 0; r < 4; ++r) { const int m = m0 + r * NGW; live[r] = m < MPAD; src[r] = nullptr; fd[r] = nullptr; hd[r] = H + (size_t)m * D; ud[r] = U + (size_t)m * D;
                if (m < MP) { const int b = m / LP, t = m - b * LP; src[r] = t < NMETA ? meta + (size_t)t * D : x_prompt + ((size_t)b * SEQ + (t - NMETA)) * D; }
                else if (m < MR) src[r] = x_sample + (size_t)(m - MP) * D; }
            rms_rows4g(src, norm1_w, hd, ud, fd, live, lane);
        }
    }
    SEAM(0);

    for (int l = args.l_lo; l < args.l_hi; ++l) {
        constexpr int pb = 1;

        if (IN(pb + 0)) {
            PHASE_REGS
            LAS unsigned char* lds = lds0;
            pg8::Gemm gm{U, (const GAS bf16*)(wl + WL_WIN), MPAD, NIN, D}; pg8::StaticOrder S; S.init(MPAD, NIN, Gl, bxl);
            pg8::EpiIn E{P1, KVB, MISCB, KIB, KIB2, out + O_PK + (size_t)l * MP * 256, out + O_PV + (size_t)l * MP * 256, out + O_PKI + (size_t)l * MP * 64,
                         out + O_SK + (size_t)l * MS * 256, out + O_SV + (size_t)l * MS * 256, out + O_SKI + (size_t)l * MS * 64};
            pg8::gemm_phase<pg8::EpiIn, pg8::StaticOrder, true, true>(lds, gm, S, E, tid);
        }
        SEAM(pb + 0);

        if (IN(pb + 1)) {
            PHASE_REGS
            LDS_LOCAL
            INP(float, state_conv, 6) INP(float, conv_b, 12) INP(float, conv_w, 11) INP(float, dt_bias, 13) INP(float, a_log, 14) INP(float, cache_ki, 4) INP(int, page_table, 7)
            for (int rp_ = 0; rp_ < REP_CONV; ++rp_) for (int it = bx * NT + tid; it < (MR / 8) * 384; it += G * NT) {
                const int rg = it / 384, c8 = (it % 384) * 8, m0 = 8 * rg;
                const bool isS = m0 >= MP; int tpos, sq;
                if (!isS) { sq = m0 / LP; tpos = m0 - sq * LP; } else { sq = (m0 - MP) >> 3; tpos = (m0 - MP) & 7; }
                float xv[11][8];
#pragma unroll
                for (int k = 0; k < 11; ++k) { const int dtp = tpos - 3 + k;
                    if (dtp >= 0) unpack8(*(const GAS v4u*)(P1 + (size_t)(m0 - 3 + k) * LDP1 + C_XBC + c8), xv[k]);
                    else if (isS) { const GAS float* pp = state_conv + ((size_t)(l * DB + sq) * 3 + (3 + dtp)) * CONVD + c8; const f32x4 a = *(const GAS f32x4*)pp, b = *(const GAS f32x4*)(pp + 4);
                        xv[k][0] = a.x; xv[k][1] = a.y; xv[k][2] = a.z; xv[k][3] = a.w; xv[k][4] = b.x; xv[k][5] = b.y; xv[k][6] = b.z; xv[k][7] = b.w; }
                    else {
#pragma unroll
                        for (int j = 0; j < 8; ++j) xv[k][j] = 0.f; } }
                float wv[4][8], bv[8];
                { const GAS float* bp = conv_b + (size_t)l * CONVD + c8; const f32x4 a = *(const GAS f32x4*)bp, b = *(const GAS f32x4*)(bp + 4);
                  bv[0] = a.x; bv[1] = a.y; bv[2] = a.z; bv[3] = a.w; bv[4] = b.x; bv[5] = b.y; bv[6] = b.z; bv[7] = b.w; }
#pragma unroll
                for (int k = 0; k < 4; ++k) { const GAS float* wp = conv_w + ((size_t)l * 4 + k) * CONVD + c8; const f32x4 a = *(const GAS f32x4*)wp, b = *(const GAS f32x4*)(wp + 4);
                    wv[k][0] = a.x; wv[k][1] = a.y; wv[k][2] = a.z; wv[k][3] = a.w; wv[k][4] = b.x; wv[k][5] = b.y; wv[k][6] = b.z; wv[k][7] = b.w; }
#pragma unroll
                for (int r = 0; r < 8; ++r) {
                    float y[8];
#pragma unroll
                    for (int j = 0; j < 8; ++j) { float s = bv[j];
#pragma unroll
                        for (int k = 0; k < 4; ++k) s += xv[r + k][j] * wv[k][j];
                        y[j] = s * sigm(s); }
                    *(GAS v4u*)(XC + (size_t)(m0 + r) * CONVD + c8) = (v4u){pk2(y[0], y[1]), pk2(y[2], y[3]), pk2(y[4], y[5]), pk2(y[6], y[7])};
                    const int tp = tpos + r; GAS float* cs = nullptr;
                    if (!isS && tp >= LP - 3) cs = out + O_PCONV + ((size_t)(l * NB + sq) * 3 + (tp - (LP - 3))) * CONVD + c8;
                    if (isS && tp >= DS - 3) cs = out + O_SCONV + ((size_t)(l * DB + sq) * 3 + (tp - (DS - 3))) * CONVD + c8;
                    if (cs) { *(GAS f32x4*)cs = (f32x4){xv[r + 3][0], xv[r + 3][1], xv[r + 3][2], xv[r + 3][3]}; *(GAS f32x4*)(cs + 4) = (f32x4){xv[r + 3][4], xv[r + 3][5], xv[r + 3][6], xv[r + 3][7]}; }
                }
            }
            for (int it = bx * NT + tid; it < MR * NH; it += G * NT) {
                const int m = it >> 5, h = it & 31;
                const float raw = MISCB[(size_t)m * 128 + MC_DT + h] + dt_bias[l * NH + h];
                const float sp = fmaxf(raw, 0.f) + log1pf(__expf(-fabsf(raw)));
                const float A = -__expf(a_log[l * NH + h]);
                DT[it] = sp; DA[it] = __expf(sp * A);
            }
            for (int rp_ = 0; rp_ < REP_TOPK; ++rp_) {
                constexpr int SLD = 4352;
                LAS unsigned* scl = (LAS unsigned*)lds; LAS unsigned* histq = (LAS unsigned*)(lds + 8 * SLD * 4);
                for (int j = 0; ; ++j) {
                    const int unit = j * G + ((j & 1) ? (G - 1 - bx) : bx); if (unit >= NB * (LP / 8)) break;
                    const int b = unit & (NB - 1), qb = (LP / 8 - 1) - (unit >> 2);
                    const size_t mq0 = (size_t)b * LP + 8 * qb; const int nkeys = 8 * qb + 8, ntl = (nkeys + 31) >> 5;
                    bf16x8 afr[2][4]; float wq[2][2][8];
                    idx_load_q(P1, MISCB, mq0, lane, afr, wq);
                    for (int i = tid; i < 8 * HB; i += NT) histq[i] = 0u;
                    __syncthreads();
                    const int kcol = lane & 31, hh = lane >> 5;
                    const GAS bf16* kp0 = KIB2 + (size_t)b * KT_PER_B * 2048 + lane * 8;
                    bf16x8 bnx[4], bn2[4];
#pragma unroll
                    for (int ks = 0; ks < 4; ++ks) { bnx[ks] = (bf16x8){0, 0, 0, 0, 0, 0, 0, 0}; bn2[ks] = bnx[ks]; }
                    if (wave < ntl) {
#pragma unroll
                        for (int ks = 0; ks < 4; ++ks) bnx[ks] = *(const GAS bf16x8*)(kp0 + (size_t)wave * 2048 + 512 * ks); }
                    if (wave + NWAVES < ntl) {
#pragma unroll
                        for (int ks = 0; ks < 4; ++ks) bn2[ks] = *(const GAS bf16x8*)(kp0 + (size_t)(wave + NWAVES) * 2048 + 512 * ks); }
                    for (int kt = wave; kt < ntl; kt += NWAVES) {
                        bf16x8 bfr[4];
#pragma unroll
                        for (int ks = 0; ks < 4; ++ks) { bfr[ks] = bnx[ks]; bnx[ks] = bn2[ks]; }
                        if (kt + 2 * NWAVES < ntl) {
#pragma unroll
                            for (int ks = 0; ks < 4; ++ks) bn2[ks] = *(const GAS bf16x8*)(kp0 + (size_t)(kt + 2 * NWAVES) * 2048 + 512 * ks); }
                        float sc[2][2];
                        idx_scores(afr, bfr, wq, sc);
                        const int key = 32 * kt + kcol;
#pragma unroll
                        for (int rt = 0; rt < 2; ++rt)
#pragma unroll
                            for (int jq = 0; jq < 2; ++jq) { const int q = 4 * rt + 2 * hh + jq; scl[q * SLD + key] = f2key(sc[rt][jq]);
                                if (key <= 8 * qb + q) { int bn = __float2int_rd(sc[rt][jq] * 64.0f) + 256; bn = bn < 0 ? 0 : (bn > HB - 1 ? HB - 1 : bn);
                                    __hip_atomic_fetch_add(histq + q * HB + bn, 1u, __ATOMIC_RELAXED, __HIP_MEMORY_SCOPE_WORKGROUP); } }
                    }
                    __syncthreads();
                    for (int r2_ = 0; r2_ < REP_SEL; ++r2_) { const int t = 8 * qb + wave, n = t + 1; GAS unsigned short* op = IDXP + ((size_t)b * LP + t) * 256;
                      if (n <= 256) { for (int i = lane; i < n; i += 64) op[i] = (unsigned short)i; }
                      else topk_select(scl + wave * SLD, n, lane, op, histq + wave * HB); }
                    __syncthreads();
                }
            }
            const GAS float* cki = cache_ki + (size_t)l * NPOOL * PAGE * 64;
            for (int rp_ = 0; rp_ < REP_SSC; ++rp_) for (int unit = bx; unit < DB * 8; unit += G) {
                const int bd = unit >> 3, ch = unit & 7; const size_t mq0 = (size_t)MP + bd * DS;
                bf16x8 afr[2][4]; float wq[2][2][8];
                idx_load_q(P1, MISCB, mq0, lane, afr, wq);
                const int kcol = lane & 31, hh = lane >> 5;
                const int pg = 8 * ch + wave, phys = page_table[bd * NPAGES + pg];
                const GAS float* kbase = cki + (size_t)phys * PAGE * 64;
#pragma unroll 1
                for (int kt = 0; kt < 4; ++kt) {
                    const int kin = 32 * kt + kcol; const GAS float* kp = kbase + (size_t)kin * 64 + 8 * hh;
                    bf16x8 bfr[4];
#pragma unroll
                    for (int ks = 0; ks < 4; ++ks) { const f32x4 a = *(const GAS f32x4*)(kp + 16 * ks), bq = *(const GAS f32x4*)(kp + 16 * ks + 4);
                        const v4u w = (v4u){pk2(a.x, a.y), pk2(a.z, a.w), pk2(bq.x, bq.y), pk2(bq.z, bq.w)}; bfr[ks] = __builtin_bit_cast(bf16x8, w); }
                    float sc[2][2];
                    idx_scores(afr, bfr, wq, sc);
#pragma unroll
                    for (int rt = 0; rt < 2; ++rt)
#pragma unroll
                        for (int jq = 0; jq < 2; ++jq) SCS[(size_t)(bd * DS + 4 * rt + 2 * hh + jq) * SCS_LD + 128 * pg + kin] = sc[rt][jq];
                }
                if (ch == 7 && wave == 0) {
                    const int j = kcol < DS ? kcol : DS - 1; const GAS bf16* kp = KIB + (mq0 + j) * 64 + 8 * hh;
                    bf16x8 bfr[4];
#pragma unroll
                    for (int ks = 0; ks < 4; ++ks) bfr[ks] = *(const GAS bf16x8*)(kp + 16 * ks);
                    float sc[2][2];
                    idx_scores(afr, bfr, wq, sc);
                    if (kcol < DS) {
#pragma unroll
                        for (int rt = 0; rt < 2; ++rt)
#pragma unroll
                            for (int jq = 0; jq < 2; ++jq) { const int q = 4 * rt + 2 * hh + jq; SCS[(size_t)(bd * DS + q) * SCS_LD + PAST + kcol] = (kcol <= q) ? sc[rt][jq] : -INFINITY; }
                    }
                }
            }
        }
        SEAM(pb + 1);

        if (IN(pb + 2)) {
            PHASE_REGS
            LDS_LOCAL
            INP(float, a_log, 14) INP(float, state_ssm, 5) INP(float, d_skip, 15)
            for (int rp_ = 0; rp_ < REP_SSEL; ++rp_) for (int qi = bx; qi < MS; qi += G) {
                LAS unsigned* scl = (LAS unsigned*)lds; LAS unsigned* hs = (LAS unsigned*)(lds + 8448 * 4);
                hs[tid] = 0u;
                __syncthreads();
                for (int i = tid; i < PAST + DS; i += NT) { const float sc = SCS[(size_t)qi * SCS_LD + i]; scl[i] = f2key(sc);
                    int bn = __float2int_rd(fmaxf(sc, -8.0f) * 64.0f) + 256; bn = bn < 0 ? 0 : (bn > HB - 1 ? HB - 1 : bn);
                    __hip_atomic_fetch_add(hs + bn, 1u, __ATOMIC_RELAXED, __HIP_MEMORY_SCOPE_WORKGROUP); }
                __syncthreads();
                if (wave == 0) { int ns = PAST + DS; asm volatile("" : "+s"(ns)); topk_select(scl, ns, lane, IDXS + qi * 256, hs); }
                __syncthreads();
            }
            for (int rp_ = 0; rp_ < REP_SSD1; ++rp_) for (int unit = bx; unit < NB * NCH * NG; unit += G) {
                int b, c, g; if (unit < NB * 32 * NG) { b = unit >> 7; c = 1 + ((unit & 127) >> 2); g = unit & 3; } else { const int r = unit - NB * 32 * NG; b = r >> 2; c = 0; g = r & 3; }
                ssd1_unit(lds, tid, XC, DT, a_log + l * NH, SB, DEC, b, c, g);
            }
            for (int rp_ = 0; rp_ < REP_SREC; ++rp_) for (int unit = bx; unit < DB * NH * 2; unit += G) {
                const int bd = unit >> 6, h = (unit >> 1) & 31, p0 = (unit & 1) * 32;
                ssd_unit(lds, tid, XC, DT, DA, (size_t)MP + bd * DS, DS, h, p0, state_ssm + ((size_t)(l * DB + bd) * NH + h) * HP * NST,
                         out + O_SSSM + ((size_t)(l * DB + bd) * NH + h) * HP * NST, YS, d_skip[l * NH + h]);
                __syncthreads();
            }
        }
        SEAM(pb + 2);

        if (IN(pb + 3)) {
            PHASE_REGS
            LDS_LOCAL
            INP(float, cache_k, 2) INP(float, cache_v, 3) INP(int, page_table, 7)
            for (int rp_ = 0; rp_ < REP_SCAN; ++rp_) for (int e = bx * NT + tid; e < NB * NH * 2048; e += G * NT) {
                const int b = e / (NH * 2048), h = (e >> 11) & 31, q = e & 2047;
                f32x4 Hr = {0.f, 0.f, 0.f, 0.f};
#pragma unroll 3
                for (int c = 0; c < NCH; ++c) { const size_t idx = (size_t)(b * NCH + c) * NH + h;
                    { const int p = q >> 5, n = (q & 31) * 4;
                      *(GAS v2u*)(HC + idx * (HP * NST) + ((((p >> 5) * 8 + (n >> 4)) * 2 + ((n >> 3) & 1)) * 32 + (p & 31)) * 8 + (n & 7)) = (v2u){pk2(Hr.x, Hr.y), pk2(Hr.z, Hr.w)}; }
                    const float d = DEC[idx]; const v2u sw = *(const GAS v2u*)(SB + idx * (HP * NST) + q * 4);
                    const f32x4 sv = (f32x4){__uint_as_float(sw.x << 16), __uint_as_float(sw.x & 0xffff0000u), __uint_as_float(sw.y << 16), __uint_as_float(sw.y & 0xffff0000u)};
                    Hr = Hr * d + sv; }
                *(GAS f32x4*)(out + O_PSSM + ((size_t)(l * NB + b) * NH + h) * (HP * NST) + q * 4) = Hr;
            }
            const GAS float* ck = cache_k + (size_t)l * NPOOL * PAGE * 256; const GAS float* cv = cache_v + (size_t)l * NPOOL * PAGE * 256;
            for (int rp_ = 0; rp_ < REP_ATTS; ++rp_) for (int qi = bx; qi < MS; qi += G) attn_sample_query(lds, tid, P1, KVB, ck, cv, page_table, IDXS, YA, qi);
            for (int rp_ = 0; rp_ < REP_ATTP; ++rp_) {
                if (Gl == 256) {
                    const int bsel = (bxl & 7) >> 1, widx = ((((bxl >> 3) * NWAVES) + wave) << 1) | (bxl & 1);
                    for (int tr = widx; tr < LP; tr += 512) attn_prompt_query(lds + wave * 17408, P1, KVB, IDXP, YA, bsel * LP + (LP - 1 - tr), lane);
                } else for (int m = gw; m < MP; m += NGW) attn_prompt_query(lds + wave * 17408, P1, KVB, IDXP, YA, m, lane);
            }
        }
        SEAM(pb + 3);

        if (IN(pb + 4)) {
            PHASE_REGS
            LDS_LOCAL
            INP(float, a_log, 14) INP(float, d_skip, 15) INP(float, ssm_norm_w, 16)
            for (int rp_ = 0; rp_ < REP_SSD3; ++rp_) for (int unit = bx; unit < NB * NCH * NG; unit += G) {
                int b, c, g; if (unit < NB * 32 * NG) { b = unit >> 7; c = 1 + ((unit & 127) >> 2); g = unit & 3; } else { const int r = unit - NB * 32 * NG; b = r >> 2; c = 0; g = r & 3; }
                ssd3_unit(lds, tid, XC, P1, DT, a_log + l * NH, d_skip + l * NH, ssm_norm_w + (size_t)l * DIN, HC, YSN, b, c, g);
            }
            for (int it = gw; it < MS * NG; it += NGW) {
                const int m = MP + (it >> 2), g = it & 3, c0 = g * 512 + lane * 8;
                const GAS float* yp = YS + (size_t)m * DIN + c0; const f32x4 a = *(const GAS f32x4*)yp, b = *(const GAS f32x4*)(yp + 4);
                float z[8]; unpack8(*(const GAS v4u*)(P1 + (size_t)m * LDP1 + C_Z + c0), z);
                float v[8] = {a.x, a.y, a.z, a.w, b.x, b.y, b.z, b.w}; float ss = 0.f;
#pragma unroll
                for (int j = 0; j < 8; ++j) { v[j] = v[j] * (z[j] * sigm(z[j])); ss += v[j] * v[j]; }
                ss = wave_sum(ss);
                const float rstd = 1.0f / sqrtf(ss * (1.0f / 512.0f) + 1e-6f);
                const GAS float* wp = ssm_norm_w + (size_t)l * DIN + c0; const f32x4 wa = *(const GAS f32x4*)wp, wb = *(const GAS f32x4*)(wp + 4);
                *(GAS v4u*)(YSN + (size_t)m * DIN + c0) = (v4u){pk2(v[0] * rstd * wa.x, v[1] * rstd * wa.y), pk2(v[2] * rstd * wa.z, v[3] * rstd * wa.w), pk2(v[4] * rstd * wb.x, v[5] * rstd * wb.y), pk2(v[6] * rstd * wb.z, v[7] * rstd * wb.w)};
            }
        }
        SEAM(pb + 4);

        if (IN(pb + 5)) {
            PHASE_REGS
            LAS unsigned char* lds = lds0;
            pg8::Gemm gm{YSN, (const GAS bf16*)(wl + WL_WSSM), TAIL_R0, D, DIN}; pg8::StaticOrder S; S.init(TAIL_R0, D, Gl, bxl);
            pg8::EpiGate1 E{P1, T1};
            pg8::gemm_phase<pg8::EpiGate1, pg8::StaticOrder, true, true>(lds, gm, S, E, tid);
            tail_gemm<1>(lds, YSN, DIN, (const GAS bf16*)(wl + WL_WSSM), D, P1, T1, MG, H, A2, bxl, Gl, tid);
        }
        if (IN(pb + 6)) {
            PHASE_REGS
            LAS unsigned char* lds = lds0;
            pg8::Gemm gm{YA, (const GAS bf16*)(wl + WL_WATT), TAIL_R0, D, D}; pg8::StaticOrder S; S.init(TAIL_R0, D, Gl, bxl);
            pg8::EpiGate2 E{P1, T1, MG};
            pg8::gemm_phase<pg8::EpiGate2, pg8::StaticOrder, true, true>(lds, gm, S, E, tid);
            tail_gemm<2>(lds, YA, D, (const GAS bf16*)(wl + WL_WATT), D, P1, T1, MG, H, A2, bxl, Gl, tid);
        }
        SEAM(pb + 6);
        if (IN(pb + 7)) {
            PHASE_REGS
            LAS unsigned char* lds = lds0;
            pg8::Gemm gm{MG, (const GAS bf16*)(wl + WL_WOUT), TAIL_R0, D, D}; pg8::StaticOrder S; S.init(TAIL_R0, D, Gl, bxl);
            pg8::EpiResid E{H};
            pg8::gemm_phase<pg8::EpiResid, pg8::StaticOrder, true, true>(lds, gm, S, E, tid);
            tail_gemm<3>(lds, MG, D, (const GAS bf16*)(wl + WL_WOUT), D, P1, T1, MG, H, A2, bxl, Gl, tid);
        }
        SEAM(pb + 7);
        if (IN(pb + 8)) {
            PHASE_REGS
            INP(float, norm2_w, 20)
            for (int m = gw; m < MPAD; m += 4 * NGW) rms_rows4(H, norm2_w + (size_t)l * D, U, m, NGW, MPAD, lane);
        }
        SEAM(pb + 8);
        if (IN(pb + 9)) {
            PHASE_REGS
            LAS unsigned char* lds = lds0;
            pg8::Gemm gm{U, (const GAS bf16*)(wl + WL_WUP), TAIL_R0, DFF, D}; pg8::StaticOrder S; S.init(TAIL_R0, DFF, Gl, bxl);
            pg8::EpiUp E{A2};
            pg8::gemm_phase<pg8::EpiUp, pg8::StaticOrder, true, true>(lds, gm, S, E, tid);
            tail_gemm<4>(lds, U, D, (const GAS bf16*)(wl + WL_WUP), DFF, P1, T1, MG, H, A2, bxl, Gl, tid);
        }
        SEAM(pb + 9);
        if (IN(pb + 10)) {
            PHASE_REGS
            LAS unsigned char* lds = lds0;
            pg8::Gemm gm{A2, (const GAS bf16*)(wl + WL_WDN), TAIL_R0, D, DFF}; pg8::StaticOrder S; S.init(TAIL_R0, D, Gl, bxl);
            pg8::EpiResid E{H};
            pg8::gemm_phase<pg8::EpiResid, pg8::StaticOrder, true, true>(lds, gm, S, E, tid);
            tail_gemm<3>(lds, A2, DFF, (const GAS bf16*)(wl + WL_WDN), D, P1, T1, MG, H, A2, bxl, Gl, tid);
        }
        SEAM(pb + 10);
        if (IN(pb + 11)) {
            PHASE_REGS
            INP(float, norm1_w, 9) INP(float, final_w, 23)
            if (l == 0) { for (int m = gw; m < MPAD; m += 4 * NGW) rms_rows4(H, norm1_w + D, U, m, NGW, MPAD, lane); }
            else {
                for (int m0 = gw; m0 < MR; m0 += 4 * NGW) {
                    const GAS float* src[4]; GAS float* hd[4]; GAS bf16* ud[4]; GAS float* fd[4]; bool live[4];
#pragma unroll
                    for (int r = 0; r < 4; ++r) { const int m = m0 + r * NGW; hd[r] = nullptr; ud[r] = nullptr; fd[r] = nullptr; src[r] = H + (size_t)(m < MR ? m : m0) * D;
                        if (m < MP) { const int b = m / LP, t = m - b * LP; if (t >= NMETA) fd[r] = out + O_YP + ((size_t)b * SEQ + (t - NMETA)) * D; }
                        else if (m < MR) fd[r] = out + O_YS + (size_t)(m - MP) * D;
                        live[r] = fd[r] != nullptr; }
                    rms_rows4g(src, final_w, hd, ud, fd, live, lane);
                }
            }
        }
        if (IN(pb + 11) && IN(1) && l + 1 < args.l_hi) xcd_barrier_ni(bar.bar, bar.x, bar.st, TID_NOW(), (unsigned)G);
    }
#undef IN
#undef SEAM
}

#ifndef MK_PER_PHASE
#define MK_PER_PHASE 0
#endif
extern "C" void kernel_launch(void* const* d_in, const int* in_sizes, int n_in, void* d_out, int out_size, void* d_ws, size_t ws_size, hipStream_t stream) {
    static int grid = 0;
    if (grid == 0) {
        if (n_in != 24 || (size_t)out_size != O_END || ws_size < WS_END) { fprintf(stderr, "kernel_launch: unexpected shapes: n_in %d out %d (want %zu) ws %zu (want %zu)\n", n_in, out_size, (size_t)O_END, ws_size, (size_t)WS_END); grid = -1; return; }
        int dev = 0, cus = 0, per_cu = 0;
        if (hipGetDevice(&dev) != hipSuccess || hipDeviceGetAttribute(&cus, hipDeviceAttributeMultiprocessorCount, dev) != hipSuccess) { grid = -1; return; }
        bool ok = true;
#if MK_PER_PHASE
#define SETA(K) ok = ok && hipFuncSetAttribute((const void*)fwd_t<K, K + 1>, hipFuncAttributeMaxDynamicSharedMemorySize, LDS_BYTES) == hipSuccess
        SETA(0); SETA(1); SETA(2); SETA(3); SETA(4); SETA(5); SETA(6); SETA(7); SETA(8); SETA(9); SETA(10); SETA(11); SETA(12);
#else
        ok = hipFuncSetAttribute((const void*)fwd_t<0, NPH + 1>, hipFuncAttributeMaxDynamicSharedMemorySize, LDS_BYTES) == hipSuccess;
        ok = ok && hipOccupancyMaxActiveBlocksPerMultiprocessor(&per_cu, (const void*)fwd_t<0, NPH + 1>, NT, LDS_BYTES) == hipSuccess && per_cu >= 1;
#endif
        if (!ok) { fprintf(stderr, "kernel_launch: hipFuncSetAttribute / occupancy query failed (per_cu %d)\n", per_cu); (void)hipGetLastError(); grid = -1; return; }
        grid = cus;
    }
    if (grid < 0) return;
    (void)hipMemsetAsync((char*)d_ws + WS_CTL, 0, CTL_ZERO_BYTES, stream);
    Args a{};
    for (int i = 0; i < 24; ++i) a.in[i] = d_in[i];
    a.out = (float*)d_out; a.ws = (unsigned char*)d_ws;
#if MK_PER_PHASE
#define LAUNCH_PH(K) hipLaunchKernelGGL((fwd_t<K, K + 1>), dim3(grid), dim3(NT), LDS_BYTES, stream, a)
    a.l_lo = 0; a.l_hi = 1; LAUNCH_PH(0);
    for (int l = 0; l < 2; ++l) { a.l_lo = l; a.l_hi = l + 1;
        LAUNCH_PH(1); LAUNCH_PH(2); LAUNCH_PH(3); LAUNCH_PH(4); LAUNCH_PH(5); LAUNCH_PH(6); LAUNCH_PH(7); LAUNCH_PH(8); LAUNCH_PH(9); LAUNCH_PH(10); LAUNCH_PH(11); LAUNCH_PH(12); }
#else
    a.l_lo = 0; a.l_hi = 2; hipLaunchKernelGGL((fwd_t<0, NPH + 1>), dim3(grid), dim3(NT), LDS_BYTES, stream, a);
#endif
}
```

```cpp
#include <hip/hip_runtime.h>
#include <cstdio>
#include <cstdint>
#define GAS __attribute__((address_space(1)))
#define LAS __attribute__((address_space(3)))

constexpr int D = 1024, NB = 4, SEQ = 4096, NMETA = 16, LP = SEQ + NMETA, MP = NB * LP, DB = 32, DS = 8, MS = DB * DS, MR = MP + MS, MPAD = 16896;
constexpr int DIN = 2048, CONVD = 3072, NH = 32, HP = 64, NG = 4, NST = 128;
constexpr int DFF = 4096, IN_DIM = 9320;
constexpr int PAST = 8192, PAGE = 128, NPAGES = 64, NPOOL = 2560;
constexpr int NIN = 9472, LDP1 = 9216;
constexpr int C_Z = 0, C_XBC = 2048, C_Q = 5120, C_K = 6144, C_V = 6400, C_QI = 6656, C_GS = 7168, C_GA = 8192;
constexpr int MC_KI = 0, MC_DT = 64, MC_WI = 96;
constexpr int KT_PER_B = (LP + 31) / 32;
static_assert(MP == 16448 && MR == 16704 && MPAD % 256 == 0 && MPAD >= MR, "rows");
namespace pg8 {
#define PG8_LAS __attribute__((address_space(3)))
typedef unsigned short bf16_t;
typedef short bf16x8 __attribute__((ext_vector_type(8)));
typedef float f32x4 __attribute__((ext_vector_type(4)));
typedef unsigned u32x4 __attribute__((ext_vector_type(4)));
constexpr int BM = 256, BK = 64, HALF = 128, HTB = HALF * BK * 2  , STAGE_BYTES = 8 * HTB, NXCD = 8, WGM = 8;

__host__ __device__ __forceinline__ int lds_byte(int r, int c) { const int st = (r >> 4) * 2 + (c >> 5), rr = r & 15, cc = c & 31, ob = rr * 64 + cc * 2; return st * 1024 + (ob ^ (((ob >> 9) & 1) << 5)); }
__host__ __device__ __forceinline__ void stage_rc(int b, int& R, int& C) { const int st = b / 1024, sb = b % 1024, swz = sb ^ (((sb >> 9) & 1) << 5); R = (st >> 1) * 16 + swz / 64; C = (st & 1) * 32 + (swz % 64) / 2; }
__host__ __device__ __forceinline__ int perm32(int rho) { const int n = rho >> 4, i = rho & 15; return 8 * (i >> 2) + 4 * n + (i & 3); }

struct Unit { int pm, pn; };
struct Gemm { const GAS bf16_t* A; const GAS bf16_t* Bt; int M, N, K; };

struct StaticOrder {
    int nM, nN, nwg, G, c;
    __host__ __device__ void init(int M, int N, int G_, int c_) { nM = M / BM; nN = N / BM; nwg = nM * nN; G = G_; c = c_; }
    __host__ __device__ bool next(int i, Unit& u) const {
        const long L = (long)i * G + c; if (L >= nwg) return false;
        int wgid = (int)L; { const int q = nwg / NXCD, r = nwg % NXCD, xcd = wgid % NXCD, off = wgid / NXCD; wgid = (xcd < r ? xcd * (q + 1) : r * (q + 1) + (xcd - r) * q) + off; }
        const int nig = WGM * nN, gid = wgid / nig, fm = gid * WGM, gsz = (nM - fm) < WGM ? (nM - fm) : WGM;
        u.pm = fm + ((wgid % nig) % gsz); u.pn = (wgid % nig) / gsz; return true;
    }
    __device__ __forceinline__ void a_ready(const Unit&) const {}
    __device__ __forceinline__ void done(const Unit&) const {}
};

__device__ __forceinline__ unsigned cvt_pk_bf16(float lo, float hi) { unsigned r; asm volatile("v_cvt_pk_bf16_f32 %0, %1, %2" : "=v"(r) : "v"(lo), "v"(hi)); return r; }

__device__ __forceinline__ void unpack8(const u32x4 w, float (&f)[8]) {
    f[0] = __uint_as_float(w.x << 16); f[1] = __uint_as_float(w.x & 0xffff0000u); f[2] = __uint_as_float(w.y << 16); f[3] = __uint_as_float(w.y & 0xffff0000u);
    f[4] = __uint_as_float(w.z << 16); f[5] = __uint_as_float(w.z & 0xffff0000u); f[6] = __uint_as_float(w.w << 16); f[7] = __uint_as_float(w.w & 0xffff0000u);
}
__device__ __forceinline__ u32x4 pack8(const f32x4 v0, const f32x4 v1) { u32x4 w; w.x = cvt_pk_bf16(v0[0], v0[1]); w.y = cvt_pk_bf16(v0[2], v0[3]); w.z = cvt_pk_bf16(v1[0], v1[1]); w.w = cvt_pk_bf16(v1[2], v1[3]); return w; }
__device__ __forceinline__ float sigm(float x) { return __builtin_amdgcn_rcpf(1.0f + __expf(-x)); }

struct EpiIn {
    static constexpr bool PERM = true, AFTER_DRAIN = false;
    GAS bf16_t* P1; GAS bf16_t* kvb; GAS float* misc; GAS bf16_t* kib; GAS bf16_t* kib2; GAS float *pk, *pv, *pki, *sk, *sv, *ski;
    __device__ __forceinline__ void operator()(const f32x4 (&acc)[2][2][4][2], const Unit& u, int wr, int wc, int fr, int fq) const {
        const int row0 = u.pm * BM + wr * 64 + fr, lc0 = wc * 32 + 8 * fq;
#pragma unroll
        for (int ai = 0; ai < 2; ++ai)
#pragma unroll
            for (int m = 0; m < 4; ++m) {
                const int row = row0 + ai * HALF + m * 16;
#pragma unroll
                for (int bj = 0; bj < 2; ++bj) {
                    const f32x4 v0 = acc[ai][bj][m][0], v1 = acc[ai][bj][m][1];
                    const int lc = lc0 + bj * HALF;
                    if (u.pn < 36) {
                        if (u.pn == 24 || u.pn == 25) *(GAS u32x4*)(kvb + (size_t)row * 512 + (u.pn - 24) * BM + lc) = pack8(v0, v1);
                        else *(GAS u32x4*)(P1 + (size_t)row * LDP1 + u.pn * BM + lc) = pack8(v0, v1);
                        if (u.pn == 24) {
                            if (row < MP) { GAS float* dst = pk + (size_t)row * 256 + lc; *(GAS f32x4*)dst = v0; *(GAS f32x4*)(dst + 4) = v1; }
                            else if (row < MR) { GAS float* dst = sk + (size_t)(row - MP) * 256 + lc; *(GAS f32x4*)dst = v0; *(GAS f32x4*)(dst + 4) = v1; }
                        } else if (u.pn == 25) {
                            if (row < MP) { GAS float* dst = pv + (size_t)row * 256 + lc; *(GAS f32x4*)dst = v0; *(GAS f32x4*)(dst + 4) = v1; }
                            else if (row < MR) { GAS float* dst = sv + (size_t)(row - MP) * 256 + lc; *(GAS f32x4*)dst = v0; *(GAS f32x4*)(dst + 4) = v1; }
                        }
                    } else {
                        if (lc < 128) { GAS float* d = misc + (size_t)row * 128 + lc; *(GAS f32x4*)d = v0; *(GAS f32x4*)(d + 4) = v1; }
                        if (lc < 64) {
                            *(GAS u32x4*)(kib + (size_t)row * 64 + lc) = pack8(v0, v1);
                            if (row < MP) { const int b = row / LP, t = row - b * LP;
                                *(GAS u32x4*)(kib2 + ((size_t)(b * KT_PER_B + (t >> 5)) * 2048 + (lc >> 4) * 512 + ((lc >> 3) & 1) * 256 + (t & 31) * 8)) = pack8(v0, v1); }
                            if (row < MP) { GAS float* dst = pki + (size_t)row * 64 + lc; *(GAS f32x4*)dst = v0; *(GAS f32x4*)(dst + 4) = v1; }
                            else if (row < MR) { GAS float* dst = ski + (size_t)(row - MP) * 64 + lc; *(GAS f32x4*)dst = v0; *(GAS f32x4*)(dst + 4) = v1; }
                        }
                    }
                }
            }
    }
};
struct EpiGate1 {
    static constexpr bool PERM = true, AFTER_DRAIN = false;
    const GAS bf16_t* P1; GAS bf16_t* T1;
    __device__ __forceinline__ void operator()(const f32x4 (&acc)[2][2][4][2], const Unit& u, int wr, int wc, int fr, int fq) const {
        const int row0 = u.pm * BM + wr * 64 + fr, col0 = u.pn * BM + wc * 32 + 8 * fq;
#pragma unroll
        for (int ai = 0; ai < 2; ++ai)
#pragma unroll
            for (int m = 0; m < 4; ++m) {
                const int row = row0 + ai * HALF + m * 16;
#pragma unroll
                for (int bj = 0; bj < 2; ++bj) {
                    const int col = col0 + bj * HALF;
                    float g[8]; unpack8(*(const GAS u32x4*)(P1 + (size_t)row * LDP1 + C_GS + col), g);
                    f32x4 v0 = acc[ai][bj][m][0], v1 = acc[ai][bj][m][1];
#pragma unroll
                    for (int e = 0; e < 4; ++e) { v0[e] *= sigm(g[e]); v1[e] *= sigm(g[4 + e]); }
                    *(GAS u32x4*)(T1 + (size_t)row * 1024 + col) = pack8(v0, v1);
                }
            }
    }
};
struct EpiGate2 {
    static constexpr bool PERM = true, AFTER_DRAIN = false;
    const GAS bf16_t* P1; const GAS bf16_t* T1; GAS bf16_t* MG;
    __device__ __forceinline__ void operator()(const f32x4 (&acc)[2][2][4][2], const Unit& u, int wr, int wc, int fr, int fq) const {
        const int row0 = u.pm * BM + wr * 64 + fr, col0 = u.pn * BM + wc * 32 + 8 * fq;
#pragma unroll
        for (int ai = 0; ai < 2; ++ai)
#pragma unroll
            for (int m = 0; m < 4; ++m) {
                const int row = row0 + ai * HALF + m * 16;
#pragma unroll
                for (int bj = 0; bj < 2; ++bj) {
                    const int col = col0 + bj * HALF;
                    float g[8]; unpack8(*(const GAS u32x4*)(P1 + (size_t)row * LDP1 + C_GA + col), g);
                    float tt[8]; unpack8(*(const GAS u32x4*)(T1 + (size_t)row * 1024 + col), tt); const f32x4 t0 = (f32x4){tt[0], tt[1], tt[2], tt[3]}, t1 = (f32x4){tt[4], tt[5], tt[6], tt[7]};
                    f32x4 v0 = acc[ai][bj][m][0], v1 = acc[ai][bj][m][1];
#pragma unroll
                    for (int e = 0; e < 4; ++e) { v0[e] = t0[e] + v0[e] * sigm(g[e]); v1[e] = t1[e] + v1[e] * sigm(g[4 + e]); }
                    *(GAS u32x4*)(MG + (size_t)row * 1024 + col) = pack8(v0, v1);
                }
            }
    }
};
struct EpiResid {
    static constexpr bool PERM = true, AFTER_DRAIN = false;
    GAS float* H;
    __device__ __forceinline__ void operator()(const f32x4 (&acc)[2][2][4][2], const Unit& u, int wr, int wc, int fr, int fq) const {
        const int row0 = u.pm * BM + wr * 64 + fr, col0 = u.pn * BM + wc * 32 + 8 * fq;
#pragma unroll
        for (int ai = 0; ai < 2; ++ai)
#pragma unroll
            for (int m = 0; m < 4; ++m) {
                const int row = row0 + ai * HALF + m * 16;
#pragma unroll
                for (int bj = 0; bj < 2; ++bj) {
                    GAS float* d = H + (size_t)row * 1024 + col0 + bj * HALF;
                    const f32x4 h0 = *(const GAS f32x4*)d, h1 = *(const GAS f32x4*)(d + 4);
                    *(GAS f32x4*)d = h0 + acc[ai][bj][m][0]; *(GAS f32x4*)(d + 4) = h1 + acc[ai][bj][m][1];
                }
            }
    }
};
struct EpiUp {
    static constexpr bool PERM = true, AFTER_DRAIN = false;
    GAS bf16_t* A2;
    __device__ __forceinline__ void operator()(const f32x4 (&acc)[2][2][4][2], const Unit& u, int wr, int wc, int fr, int fq) const {
        const int row0 = u.pm * BM + wr * 64 + fr, col0 = u.pn * BM + wc * 32 + 8 * fq;
#pragma unroll
        for (int ai = 0; ai < 2; ++ai)
#pragma unroll
            for (int m = 0; m < 4; ++m) {
                const int row = row0 + ai * HALF + m * 16;
#pragma unroll
                for (int bj = 0; bj < 2; ++bj) {
                    f32x4 v0 = acc[ai][bj][m][0], v1 = acc[ai][bj][m][1];
#pragma unroll
                    for (int e = 0; e < 4; ++e) { const float a = fmaxf(v0[e], 0.f), b = fmaxf(v1[e], 0.f); v0[e] = a * a; v1[e] = b * b; }
                    *(GAS u32x4*)(A2 + (size_t)row * DFF + col0 + bj * HALF) = pack8(v0, v1);
                }
            }
    }
};
template <class Epi, class Sched, bool ALIGN_EPI = false, bool SP2 = false>
__device__ __forceinline__ void gemm_phase(PG8_LAS unsigned char* lds, const Gemm g, const Sched& S, const Epi& E, const int tid) {
    const int wid = __builtin_amdgcn_readfirstlane(tid >> 6), lane = tid & 63, wr = wid >> 2, wc = wid & 3, fr = lane & 15, fq = lane >> 4;
    const int K = g.K, nt = K / BK;
    unsigned voffA[2], voffB[2];
#pragma unroll
    for (int i = 0; i < 2; ++i) { int R, C; stage_rc(tid * 16 + i * 8192, R, C); const int Rb = Epi::PERM ? ((R & ~31) + perm32(R & 31)) : R;
        voffA[i] = (unsigned)(R * K + C) * 2u; voffB[i] = (unsigned)(Rb * K + C) * 2u; }
    const size_t kstep = (size_t)(BK * 2);
    const size_t hstep = (size_t)HALF * K * 2;
    const size_t tstep = 2 * hstep;
    const unsigned ldsw = (unsigned)wid * 1024u;
    const int aoff = lds_byte(wr * 64 + fr, fq * 8), boff = lds_byte(wc * 32 + fr, fq * 8);
#define PG8_SA(b, h) (((b) * 2 + (h)) * HTB)
#define PG8_SB(b, h) ((4 + (b) * 2 + (h)) * HTB)
#define PG8_STAGE(bufoff, gbase, voff) do { _Pragma("unroll") for (int _i = 0; _i < 2; ++_i) \
        __builtin_amdgcn_global_load_lds((const GAS unsigned*)((const GAS char*)(gbase) + (voff)[_i]), (PG8_LAS unsigned*)(lds + (bufoff) + ldsw + _i * 8192), 16, 0, 0); } while (0)
#define PG8_LDA(dst, b, h) do { _Pragma("unroll") for (int m = 0; m < 4; ++m) _Pragma("unroll") for (int k = 0; k < 2; ++k) dst[m][k] = *(const PG8_LAS bf16x8*)(lds + PG8_SA(b, h) + aoff + m * 2048 + k * 1024); } while (0)
#define PG8_LDB(dst, b, h) do { _Pragma("unroll") for (int n = 0; n < 2; ++n) _Pragma("unroll") for (int k = 0; k < 2; ++k) dst[n][k] = *(const PG8_LAS bf16x8*)(lds + PG8_SB(b, h) + boff + n * 2048 + k * 1024); } while (0)
#define PG8_MMA(ai, bj, At, Bt) do { __builtin_amdgcn_s_setprio(1); _Pragma("unroll") for (int m = 0; m < 4; ++m) _Pragma("unroll") for (int n = 0; n < 2; ++n) _Pragma("unroll") for (int k = 0; k < 2; ++k) \
        acc[ai][bj][m][n] = __builtin_amdgcn_mfma_f32_16x16x32_bf16(Bt[n][k], At[m][k], acc[ai][bj][m][n], 0, 0, 0); __builtin_amdgcn_s_setprio(0); } while (0)
#define PG8_WAIT_V(n) asm volatile("s_waitcnt vmcnt(" #n ")" ::: "memory")
#define PG8_WAIT_L(n) asm volatile("s_waitcnt lgkmcnt(" #n ")" ::: "memory")
#define PG8_BAR __builtin_amdgcn_s_barrier()
#define PG8_SCHED __builtin_amdgcn_sched_barrier(0)
    Unit cur, nxt; int ui = 0;
    if (!S.next(0, cur)) return;
    f32x4 acc[2][2][4][2];
#pragma unroll
    for (int a = 0; a < 2; ++a)
#pragma unroll
        for (int b = 0; b < 2; ++b)
#pragma unroll
            for (int m = 0; m < 4; ++m)
#pragma unroll
                for (int n = 0; n < 2; ++n) acc[a][b][m][n] = (f32x4){0.f, 0.f, 0.f, 0.f};
    bf16x8 At[4][2], B0[2][2], B1[2][2];
    const GAS char* cA = (const GAS char*)g.A + (size_t)cur.pm * tstep; const GAS char* cB = (const GAS char*)g.Bt + (size_t)cur.pn * tstep;
    S.a_ready(cur);
    if constexpr (SP2) {
        PG8_STAGE(PG8_SB(0, 0), cB, voffB); PG8_STAGE(PG8_SB(0, 1), cB + hstep, voffB); PG8_STAGE(PG8_SA(0, 0), cA, voffA); PG8_STAGE(PG8_SA(0, 1), cA + hstep, voffA);
        if (wr == 1) PG8_BAR;
        PG8_WAIT_V(2); PG8_BAR;
        PG8_STAGE(PG8_SB(1, 0), cB + kstep, voffB); PG8_STAGE(PG8_SA(1, 0), cA + kstep, voffA); PG8_STAGE(PG8_SB(1, 1), cB + hstep + kstep, voffB);
        PG8_WAIT_V(6); PG8_BAR;
    } else {
        PG8_STAGE(PG8_SB(0, 0), cB, voffB); PG8_STAGE(PG8_SA(0, 0), cA, voffA); PG8_STAGE(PG8_SB(0, 1), cB + hstep, voffB); PG8_STAGE(PG8_SA(0, 1), cA + hstep, voffA);
        if (wr == 1) PG8_BAR;
        PG8_WAIT_V(4); PG8_BAR;
        PG8_STAGE(PG8_SB(1, 0), cB + kstep, voffB); PG8_STAGE(PG8_SA(1, 0), cA + kstep, voffA); PG8_STAGE(PG8_SB(1, 1), cB + hstep + kstep, voffB);
        PG8_WAIT_V(6); PG8_BAR;
    }
    for (;;) {
        const bool has_next = S.next(ui + 1, nxt);
        const GAS char* nA = has_next ? (const GAS char*)g.A + (size_t)nxt.pm * tstep : cA; const GAS char* nB = has_next ? (const GAS char*)g.Bt + (size_t)nxt.pn * tstep : cB;
        for (int t = 0; t < nt; t += 2) {
            const bool last = (t == nt - 2);
            const GAS char* a1 = cA + (size_t)(t + 1) * kstep;
            const GAS char* a2 = last ? nA : cA + (size_t)(t + 2) * kstep; const GAS char* b2 = last ? nB : cB + (size_t)(t + 2) * kstep;
            const GAS char* a3 = a2 + kstep; const GAS char* b3 = b2 + kstep;
            if (last && has_next) S.a_ready(nxt);
            if constexpr (SP2) {
            PG8_LDB(B0, 0, 0); PG8_LDB(B1, 0, 1); PG8_SCHED; PG8_LDA(At, 0, 0); PG8_STAGE(PG8_SA(1, 1), a1 + hstep, voffA);
            PG8_WAIT_V(8); PG8_WAIT_L(0); PG8_BAR; PG8_MMA(0, 0, At, B0); PG8_MMA(0, 1, At, B1); PG8_BAR; PG8_SCHED;
            PG8_LDA(At, 0, 1); PG8_STAGE(PG8_SB(0, 0), b2, voffB); PG8_STAGE(PG8_SB(0, 1), b2 + hstep, voffB); PG8_STAGE(PG8_SA(0, 0), a2, voffA);
            PG8_WAIT_V(8); PG8_WAIT_L(0); PG8_BAR; PG8_MMA(1, 0, At, B0); PG8_MMA(1, 1, At, B1); PG8_BAR; PG8_SCHED;
            PG8_LDB(B0, 1, 0); PG8_LDB(B1, 1, 1); PG8_SCHED; PG8_LDA(At, 1, 0); PG8_STAGE(PG8_SA(0, 1), a2 + hstep, voffA);
            PG8_WAIT_V(8); PG8_WAIT_L(0); PG8_BAR; PG8_MMA(0, 0, At, B0); PG8_MMA(0, 1, At, B1); PG8_BAR; PG8_SCHED;
            PG8_LDA(At, 1, 1); PG8_STAGE(PG8_SB(1, 0), b3, voffB); PG8_STAGE(PG8_SB(1, 1), b3 + hstep, voffB); PG8_STAGE(PG8_SA(1, 0), a3, voffA);
            PG8_WAIT_V(8); PG8_WAIT_L(0); PG8_BAR; PG8_MMA(1, 0, At, B0); PG8_MMA(1, 1, At, B1); PG8_BAR; PG8_SCHED;
            } else {
            PG8_LDB(B0, 0, 0); PG8_SCHED; PG8_LDA(At, 0, 0); PG8_STAGE(PG8_SA(1, 1), a1 + hstep, voffA);
            PG8_WAIT_L(8); PG8_BAR; PG8_WAIT_L(0); PG8_MMA(0, 0, At, B0); PG8_BAR; PG8_SCHED;
            PG8_LDB(B1, 0, 1); PG8_STAGE(PG8_SB(0, 0), b2, voffB);
            PG8_BAR; PG8_WAIT_L(0); PG8_MMA(0, 1, At, B1); PG8_BAR;
            PG8_LDA(At, 0, 1); PG8_STAGE(PG8_SA(0, 0), a2, voffA);
            PG8_BAR; PG8_WAIT_L(0); PG8_MMA(1, 0, At, B0); PG8_BAR; PG8_SCHED;
            PG8_STAGE(PG8_SB(0, 1), b2 + hstep, voffB);
            PG8_WAIT_V(6); PG8_BAR; PG8_MMA(1, 1, At, B1); PG8_BAR;
            PG8_LDB(B0, 1, 0); PG8_SCHED; PG8_LDA(At, 1, 0); PG8_STAGE(PG8_SA(0, 1), a2 + hstep, voffA);
            PG8_WAIT_L(8); PG8_BAR; PG8_WAIT_L(0); PG8_MMA(0, 0, At, B0); PG8_BAR; PG8_SCHED;
            PG8_LDB(B1, 1, 1); PG8_STAGE(PG8_SB(1, 0), b3, voffB);
            PG8_BAR; PG8_WAIT_L(0); PG8_MMA(0, 1, At, B1); PG8_BAR;
            PG8_LDA(At, 1, 1); PG8_STAGE(PG8_SA(1, 0), a3, voffA);
            PG8_BAR; PG8_WAIT_L(0); PG8_MMA(1, 0, At, B0); PG8_BAR; PG8_SCHED;
            PG8_STAGE(PG8_SB(1, 1), b3 + hstep, voffB);
            PG8_WAIT_V(6); PG8_BAR; PG8_MMA(1, 1, At, B1); PG8_BAR;
            }
        }
        if constexpr (ALIGN_EPI) { if (wr == 0) PG8_BAR; }
        if constexpr (!Epi::AFTER_DRAIN) { E(acc, cur, wr, wc, fr, fq); S.done(cur); }
        if (!has_next) break;
#pragma unroll
        for (int a = 0; a < 2; ++a)
#pragma unroll
            for (int b = 0; b < 2; ++b)
#pragma unroll
                for (int m = 0; m < 4; ++m)
#pragma unroll
                    for (int n = 0; n < 2; ++n) acc[a][b][m][n] = (f32x4){0.f, 0.f, 0.f, 0.f};
        cur = nxt; cA = nA; cB = nB; ++ui;
        if constexpr (ALIGN_EPI) { if (wr == 1) PG8_BAR; }
    }
    PG8_WAIT_V(0);
    if constexpr (!ALIGN_EPI) { if (wr == 0) PG8_BAR; }
    PG8_BAR;
    if constexpr (Epi::AFTER_DRAIN) { E.fused(acc, cur, wr, wc, fr, fq, lds, wid, lane); S.done(cur); }
#undef PG8_SA
#undef PG8_SB
#undef PG8_STAGE
#undef PG8_LDA
#undef PG8_LDB
#undef PG8_MMA
#undef PG8_WAIT_V
#undef PG8_WAIT_L
#undef PG8_BAR
#undef PG8_SCHED
}
}

typedef unsigned short bf16;
typedef unsigned v4u __attribute__((ext_vector_type(4)));
typedef float f32x4 __attribute__((ext_vector_type(4)));
typedef short bf16x8 __attribute__((ext_vector_type(8)));
typedef GAS unsigned gu32;
typedef GAS unsigned long long gu64;
#define RLX_AGENT __ATOMIC_RELAXED, __HIP_MEMORY_SCOPE_AGENT
#define LDS_WAIT() asm volatile("s_waitcnt lgkmcnt(0)" ::: "memory")
#define VM_WAIT() asm volatile("s_waitcnt vmcnt(0)" ::: "memory")
__device__ __forceinline__ unsigned long long rt() { return __builtin_amdgcn_s_memrealtime(); }
typedef float f32x2_cv __attribute__((ext_vector_type(2))); typedef __bf16 bf16x2_cv __attribute__((ext_vector_type(2)));
__device__ __forceinline__ unsigned pk2(float lo, float hi) { const f32x2_cv v = {lo, hi}; const bf16x2_cv c = __builtin_convertvector(v, bf16x2_cv); return __builtin_bit_cast(unsigned, c); }
__device__ __forceinline__ unsigned f2bf(float f) { return pk2(f, 0.f) & 0xffffu; }

#define XB_TMO      128
#define XB_XCNT(j)  (256  + 64 * (j))
#define XB_XSUB(j)  (1280 + 64 * (j))
#define XB_XGEN(j)  (2304 + 64 * (j))
#define XB_TOP      3328
#define XB_TOPGEN   3392
#define XCD_BAR_WORDS 3456
#define XB_SPIN_CAP (1u << 18)

__device__ __forceinline__ unsigned xb_ld(unsigned* p)              { return __hip_atomic_load(p, __ATOMIC_RELAXED, __HIP_MEMORY_SCOPE_AGENT); }
__device__ __forceinline__ unsigned xb_add(unsigned* p, unsigned v) { return __hip_atomic_fetch_add(p, v, __ATOMIC_RELAXED, __HIP_MEMORY_SCOPE_AGENT); }
__device__ __forceinline__ unsigned xb_xcc_id() { return (unsigned)__builtin_amdgcn_s_getreg((3 << 11) | 20) & 0xFu; }
#define XB_SPIN(cond, bar) do { unsigned _sp = 0; while (cond) { __builtin_amdgcn_s_sleep(1); \
    if ((++_sp & 255u) == 0u) { if (xb_ld(&(bar)[XB_TMO])) break; if (_sp > XB_SPIN_CAP) { atomicAdd(&(bar)[XB_TMO], 1u); break; } } } } while (0)

struct XcdBarrier {
    unsigned* bar; unsigned x;
    volatile LAS unsigned* st;
};

__device__ __forceinline__ XcdBarrier xcd_barrier_post(unsigned* bar, volatile LAS unsigned* st) {
    XcdBarrier b; b.bar = bar; b.x = xb_xcc_id(); b.st = st;
    if (threadIdx.x == 0) (void)xb_add(&bar[XB_XCNT(b.x)], 1u);
    return b;
}
__device__ __forceinline__ void xcd_barrier_complete(unsigned* bar, unsigned x, unsigned& nloc, unsigned& nx, const unsigned G) {
    unsigned sum, cnt, mine, sp = 0u;
    for (;;) {
        sum = 0u; cnt = 0u; mine = 0u;
#pragma unroll 1
        for (unsigned j = 0; j < 16; ++j) { const unsigned c = xb_ld(&bar[XB_XCNT(j)]); sum += c; cnt += (c > 0u) ? 1u : 0u; mine = (j == x) ? c : mine; }
        if (sum == G) break;
        __builtin_amdgcn_s_sleep(1);
        if ((++sp & 255u) == 0u) { if (xb_ld(&bar[XB_TMO])) break; if (sp > XB_SPIN_CAP) { atomicAdd(&bar[XB_TMO], 1u); break; } }
    }
    nloc = mine > 0u ? mine : 1u; nx = cnt > 0u ? cnt : 1u;
}

__device__ __forceinline__ void xcd_barrier(const XcdBarrier& b, const int tid_, const unsigned G_) {
    asm volatile("s_waitcnt vmcnt(0)" ::: "memory");
    __syncthreads();
    if (tid_ == 0) {
        unsigned* bar = b.bar;
        __builtin_amdgcn_s_waitcnt(0);
        unsigned nloc = b.st[0], nx = b.st[1];
        if (nloc == 0u) { xcd_barrier_complete(bar, b.x, nloc, nx, G_); b.st[0] = nloc; b.st[1] = nx; }
        const unsigned old = xb_add(&bar[XB_XSUB(b.x)], 1u);
        const unsigned gen = old / nloc;
        if (old + 1u == (gen + 1u) * nloc) {
            __builtin_amdgcn_fence(__ATOMIC_RELEASE, "agent");
            asm volatile("s_waitcnt vmcnt(0)" ::: "memory");
            const unsigned og = xb_add(&bar[XB_TOP], 1u);
            const unsigned tg = og / nx;
            if (og + 1u == (tg + 1u) * nx) xb_add(&bar[XB_TOPGEN], 1u);
            else XB_SPIN(xb_ld(&bar[XB_TOPGEN]) == tg, bar);
            __builtin_amdgcn_fence(__ATOMIC_ACQUIRE, "agent");
            xb_add(&bar[XB_XGEN(b.x)], 1u);
            asm volatile("s_waitcnt vmcnt(0)" ::: "memory");
        } else {
            XB_SPIN(xb_ld(&bar[XB_XGEN(b.x)]) == gen, bar);
            __builtin_amdgcn_fence(__ATOMIC_ACQUIRE, "agent");
            asm volatile("s_waitcnt vmcnt(0)" ::: "memory");
        }
    }
    __syncthreads();
}

constexpr size_t O_YP = 0, O_YS = O_YP + (size_t)NB * SEQ * D, O_PK = O_YS + (size_t)MS * D, O_PV = O_PK + 2ull * MP * 256, O_PKI = O_PV + 2ull * MP * 256,
                 O_PSSM = O_PKI + 2ull * MP * 64, O_PCONV = O_PSSM + 2ull * NB * NH * HP * NST, O_SK = O_PCONV + 2ull * NB * 3 * CONVD, O_SV = O_SK + 2ull * MS * 256,
                 O_SKI = O_SV + 2ull * MS * 256, O_SSSM = O_SKI + 2ull * MS * 64, O_SCONV = O_SSSM + 2ull * DB * NH * HP * NST, O_END = O_SCONV + 2ull * DB * 3 * CONVD;

constexpr size_t MiB = 1u << 20;
constexpr size_t al(size_t x) { return (x + MiB - 1) / MiB * MiB; }
constexpr size_t WS_CTL = 0, CTL_ZERO_BYTES = 1 * MiB;
constexpr size_t SZ_WIN = (size_t)NIN * D * 2, SZ_WSSM = (size_t)D * DIN * 2, SZ_WATT = (size_t)D * D * 2, SZ_WOUT = (size_t)D * D * 2, SZ_WUP = (size_t)DFF * D * 2, SZ_WDN = (size_t)D * DFF * 2;
constexpr size_t WL_WIN = 0, WL_WSSM = al(WL_WIN + SZ_WIN), WL_WATT = al(WL_WSSM + SZ_WSSM), WL_WOUT = al(WL_WATT + SZ_WATT), WL_WUP = al(WL_WOUT + SZ_WOUT), WL_WDN = al(WL_WUP + SZ_WUP), WL_SIZE = al(WL_WDN + SZ_WDN);
constexpr size_t WS_W = 1 * MiB;
constexpr size_t WS_H = al(WS_W + 2 * WL_SIZE);
constexpr size_t WS_U = al(WS_H + (size_t)MPAD * D * 4);
constexpr size_t WS_P1 = al(WS_U + (size_t)MPAD * D * 2);
constexpr size_t WS_MISC = al(WS_P1 + (size_t)MPAD * LDP1 * 2);
constexpr size_t WS_KIB = al(WS_MISC + (size_t)MPAD * 128 * 4);
constexpr size_t WS_XC = al(WS_KIB + (size_t)MPAD * 64 * 2);
constexpr size_t WS_DT = al(WS_XC + (size_t)MPAD * CONVD * 2);
constexpr size_t WS_DA = al(WS_DT + (size_t)MPAD * 32 * 4);
constexpr size_t WS_YS = al(WS_DA + (size_t)MPAD * 32 * 4);
constexpr size_t WS_YSN = al(WS_YS + (size_t)MPAD * DIN * 4);
constexpr size_t WS_YA = al(WS_YSN + (size_t)MPAD * DIN * 2);
constexpr size_t WS_T1 = al(WS_YA + (size_t)MPAD * D * 2);
constexpr size_t WS_MG = al(WS_T1 + (size_t)MPAD * D * 4);
constexpr size_t WS_A2 = al(WS_MG + (size_t)MPAD * D * 2);
constexpr size_t WS_IDXP = al(WS_A2 + (size_t)MPAD * DFF * 2);
constexpr size_t WS_IDXS = al(WS_IDXP + (size_t)MP * 256 * 2);
constexpr int SCS_LD = 8256;
constexpr size_t WS_SCS = al(WS_IDXS + (size_t)MS * 256 * 4);
constexpr size_t WS_SB = al(WS_SCS + (size_t)MS * SCS_LD * 4);
constexpr size_t WS_DEC = al(WS_SB + (size_t)NB * 33 * NH * HP * NST * 4);
constexpr size_t WS_HC = al(WS_DEC + (size_t)NB * 33 * NH * 4);
constexpr size_t WS_KVB = al(WS_HC + (size_t)NB * 33 * NH * HP * NST * 2);
constexpr size_t WS_KIB2 = al(WS_KVB + (size_t)MPAD * 512 * 2);
constexpr size_t WS_END = al(WS_KIB2 + (size_t)NB * KT_PER_B * 2048 * 2);
constexpr int CW_BAR = 4096;

constexpr int LDS_BYTES = 159744, LDSCTL_OFF = 155648, MISC_OFF = LDSCTL_OFF + 320;
constexpr int NWAVES = 8, NT = 512;
typedef float f32x16 __attribute__((ext_vector_type(16)));
typedef unsigned v2u __attribute__((ext_vector_type(2)));

__device__ __forceinline__ float dpp_f(float v, const int ctrl_unused) { return v; }
#define DPPF(v, ctrl, rmask, bc) __uint_as_float((unsigned)__builtin_amdgcn_update_dpp(0, (int)__float_as_uint(v), ctrl, rmask, 0xf, bc))
__device__ __forceinline__ float row16_sum(float v) {
    v += DPPF(v, 0xB1, 0xf, true); v += DPPF(v, 0x4E, 0xf, true); v += DPPF(v, 0x141, 0xf, true); v += DPPF(v, 0x140, 0xf, true); return v;
}
__device__ __forceinline__ float wave_sum(float v) {
    v = row16_sum(v);
    v += DPPF(v, 0x142, 0xa, false); v += DPPF(v, 0x143, 0xc, false);
    return __uint_as_float((unsigned)__builtin_amdgcn_readlane((int)__float_as_uint(v), 63));
}
__device__ __forceinline__ float wave_max(float v) {
    v = fmaxf(v, __uint_as_float((unsigned)__builtin_amdgcn_update_dpp((int)__float_as_uint(v), (int)__float_as_uint(v), 0xB1, 0xf, 0xf, false)));
    v = fmaxf(v, __uint_as_float((unsigned)__builtin_amdgcn_update_dpp((int)__float_as_uint(v), (int)__float_as_uint(v), 0x4E, 0xf, 0xf, false)));
    v = fmaxf(v, __uint_as_float((unsigned)__builtin_amdgcn_update_dpp((int)__float_as_uint(v), (int)__float_as_uint(v), 0x141, 0xf, 0xf, false)));
    v = fmaxf(v, __uint_as_float((unsigned)__builtin_amdgcn_update_dpp((int)__float_as_uint(v), (int)__float_as_uint(v), 0x140, 0xf, 0xf, false)));
    v = fmaxf(v, __uint_as_float((unsigned)__builtin_amdgcn_update_dpp((int)__float_as_uint(v), (int)__float_as_uint(v), 0x142, 0xa, 0xf, false)));
    v = fmaxf(v, __uint_as_float((unsigned)__builtin_amdgcn_update_dpp((int)__float_as_uint(v), (int)__float_as_uint(v), 0x143, 0xc, 0xf, false)));
    return __uint_as_float((unsigned)__builtin_amdgcn_readlane((int)__float_as_uint(v), 63));
}
__device__ __forceinline__ void unpack8(const v4u w, float (&f)[8]) {
    f[0] = __uint_as_float(w.x << 16); f[1] = __uint_as_float(w.x & 0xffff0000u); f[2] = __uint_as_float(w.y << 16); f[3] = __uint_as_float(w.y & 0xffff0000u);
    f[4] = __uint_as_float(w.z << 16); f[5] = __uint_as_float(w.z & 0xffff0000u); f[6] = __uint_as_float(w.w << 16); f[7] = __uint_as_float(w.w & 0xffff0000u);
}
__device__ __forceinline__ float sigm(float x) { return __builtin_amdgcn_rcpf(1.0f + __expf(-x)); }

__device__ __forceinline__ int win_src_col(int n) {
    if (n < 5120) return n;
    if (n < 6144) return n - 5120 + 5152;
    if (n < 6400) return n - 6144 + 6176;
    if (n < 6656) return n - 6400 + 6432;
    if (n < 7168) return n - 6656 + 6688;
    if (n < 8192) return n - 7168 + 7272;
    if (n < 9216) return n - 8192 + 8296;
    if (n < 9280) return n - 9216 + 7200;
    if (n < 9312) return n - 9280 + 5120;
    if (n < 9320) return n - 9312 + 7264;
    return -1;
}
__device__ __forceinline__ void tr_item(const GAS float* W, int K, int Nsrc, GAS bf16* WT, int nblk, bool remap, LAS float* scr, int item, int lane) {
    const int kb = item / nblk, nb = item % nblk, k0 = 64 * kb, n0 = 64 * nb;
    const int s0 = remap ? win_src_col(n0) : n0, s63 = remap ? win_src_col(n0 + 63) : n0 + 63;
    if (s0 >= 0 && s63 == s0 + 63 && (s0 & 3) == 0 && (Nsrc & 3) == 0) {
        const int r4 = lane >> 4, c4 = (lane & 15) * 4;
#pragma unroll 4
        for (int i = 0; i < 16; ++i) { const int kk = 4 * i + r4; const f32x4 v = *(const GAS f32x4*)(W + (size_t)(k0 + kk) * Nsrc + s0 + c4);
            scr[kk * 65 + c4] = v.x; scr[kk * 65 + c4 + 1] = v.y; scr[kk * 65 + c4 + 2] = v.z; scr[kk * 65 + c4 + 3] = v.w; }
    } else {
        const int sc = remap ? win_src_col(n0 + lane) : n0 + lane;
#pragma unroll 8
        for (int kk = 0; kk < 64; ++kk) scr[kk * 65 + lane] = sc >= 0 ? W[(size_t)(k0 + kk) * Nsrc + sc] : 0.f;
    }
    LDS_WAIT(); asm volatile("" ::: "memory");
    const int c = lane & 7;
#pragma unroll
    for (int j = 0; j < 8; ++j) { const int n = (lane >> 3) + 8 * j; const LAS float* s = scr + (8 * c) * 65 + n;
        v4u o; o.x = pk2(s[0 * 65], s[1 * 65]); o.y = pk2(s[2 * 65], s[3 * 65]); o.z = pk2(s[4 * 65], s[5 * 65]); o.w = pk2(s[6 * 65], s[7 * 65]);
        *(GAS v4u*)(WT + (size_t)(n0 + n) * K + k0 + 8 * c) = o; }
    LDS_WAIT(); asm volatile("" ::: "memory");
}
__device__ __forceinline__ void rms_row(const GAS float* src, const GAS float* w, GAS float* hdst, GAS bf16* udst, GAS float* fdst, int lane) {
    f32x4 v[4]; float ss = 0.f;
#pragma unroll
    for (int j = 0; j < 4; ++j) { v[j] = src ? ((const GAS f32x4*)src)[lane + 64 * j] : (f32x4){0.f, 0.f, 0.f, 0.f}; ss += (v[j].x * v[j].x + v[j].y * v[j].y) + (v[j].z * v[j].z + v[j].w * v[j].w); }
    ss = wave_sum(ss);
    const float rstd = 1.0f / sqrtf(ss * (1.0f / D) + 1e-6f);
#pragma unroll
    for (int j = 0; j < 4; ++j) {
        if (hdst) ((GAS f32x4*)hdst)[lane + 64 * j] = v[j];
        const f32x4 wv = ((const GAS f32x4*)w)[lane + 64 * j]; const f32x4 o = v[j] * rstd * wv;
        if (udst) ((GAS v2u*)udst)[lane + 64 * j] = (v2u){pk2(o.x, o.y), pk2(o.z, o.w)};
        if (fdst) ((GAS f32x4*)fdst)[lane + 64 * j] = o;
    }
}

__device__ __forceinline__ void rms_rows4(const GAS float* H, const GAS float* w, GAS bf16* U, int m0, int stride, int mend, int lane) {
    f32x4 v[4][4]; float ss[4];
#pragma unroll
    for (int r = 0; r < 4; ++r) { const int m = m0 + r * stride; const GAS f32x4* src = (const GAS f32x4*)(H + (size_t)(m < mend ? m : m0) * D); ss[r] = 0.f;
#pragma unroll
        for (int j = 0; j < 4; ++j) v[r][j] = src[lane + 64 * j]; }
    f32x4 wv[4];
#pragma unroll
    for (int j = 0; j < 4; ++j) wv[j] = ((const GAS f32x4*)w)[lane + 64 * j];
#pragma unroll
    for (int r = 0; r < 4; ++r) {
#pragma unroll
        for (int j = 0; j < 4; ++j) ss[r] += (v[r][j].x * v[r][j].x + v[r][j].y * v[r][j].y) + (v[r][j].z * v[r][j].z + v[r][j].w * v[r][j].w);
        ss[r] = wave_sum(ss[r]);
        const float rstd = 1.0f / sqrtf(ss[r] * (1.0f / D) + 1e-6f); const int m = m0 + r * stride;
        if (m < mend) {
#pragma unroll
            for (int j = 0; j < 4; ++j) { const f32x4 o = v[r][j] * rstd * wv[j]; ((GAS v2u*)(U + (size_t)m * D))[lane + 64 * j] = (v2u){pk2(o.x, o.y), pk2(o.z, o.w)}; } }
    }
}

__device__ __forceinline__ void rms_rows4g(const GAS float* const (&src)[4], const GAS float* w, GAS float* const (&hdst)[4], GAS bf16* const (&udst)[4], GAS float* const (&fdst)[4], const bool (&live)[4], int lane) {
    f32x4 v[4][4];
#pragma unroll
    for (int r = 0; r < 4; ++r)
#pragma unroll
        for (int j = 0; j < 4; ++j) v[r][j] = (live[r] && src[r]) ? ((const GAS f32x4*)src[r])[lane + 64 * j] : (f32x4){0.f, 0.f, 0.f, 0.f};
    f32x4 wv[4];
#pragma unroll
    for (int j = 0; j < 4; ++j) wv[j] = ((const GAS f32x4*)w)[lane + 64 * j];
#pragma unroll
    for (int r = 0; r < 4; ++r) { float ss = 0.f;
#pragma unroll
        for (int j = 0; j < 4; ++j) ss += (v[r][j].x * v[r][j].x + v[r][j].y * v[r][j].y) + (v[r][j].z * v[r][j].z + v[r][j].w * v[r][j].w);
        ss = wave_sum(ss);
        const float rstd = 1.0f / sqrtf(ss * (1.0f / D) + 1e-6f);
        if (live[r]) {
#pragma unroll
            for (int j = 0; j < 4; ++j) { const f32x4 o = v[r][j] * rstd * wv[j];
                if (hdst[r]) ((GAS f32x4*)hdst[r])[lane + 64 * j] = v[r][j];
                if (udst[r]) ((GAS v2u*)udst[r])[lane + 64 * j] = (v2u){pk2(o.x, o.y), pk2(o.z, o.w)};
                if (fdst[r]) ((GAS f32x4*)fdst[r])[lane + 64 * j] = o; } }
    }
}

__device__ __forceinline__ void ssd_unit(LAS unsigned char* lds, int tid, const GAS bf16* XC, const GAS float* DT, const GAS float* DA, size_t m0, int L, int h, int p0,
                                         const GAS float* hin, GAS float* hout, GAS float* YS, float dskip) {
    LAS float* Bl = (LAS float*)lds;
    LAS float* Cl = Bl + 64 * 128;
    LAS float* Xl = Cl + 64 * 128;
    LAS float* Yl = Xl + 64 * 32;
    LAS float* dtl = Yl + 64 * 32;
    LAS float* dal = dtl + 64;
    const int pl = tid >> 4, nq = tid & 15, n0 = nq * 8, g = h >> 3;
    float s[8];
    if (hin) { const f32x4 a = *(const GAS f32x4*)(hin + (size_t)(p0 + pl) * NST + n0), b = *(const GAS f32x4*)(hin + (size_t)(p0 + pl) * NST + n0 + 4);
        s[0] = a.x; s[1] = a.y; s[2] = a.z; s[3] = a.w; s[4] = b.x; s[5] = b.y; s[6] = b.z; s[7] = b.w; }
    else {
#pragma unroll
        for (int i = 0; i < 8; ++i) s[i] = 0.f; }
    for (int tb = 0; tb < L; tb += 64) {
        const int nb = (L - tb) < 64 ? (L - tb) : 64;
        { const int tk = tid >> 3, part = tid & 7;
            if (tk < nb) { const GAS bf16* xr = XC + (m0 + tb + tk) * CONVD;
                float f[8];
                unpack8(*(const GAS v4u*)(xr + DIN + g * NST + part * 16), f);
                *(LAS f32x4*)(Bl + tk * 128 + part * 16) = (f32x4){f[0], f[1], f[2], f[3]}; *(LAS f32x4*)(Bl + tk * 128 + part * 16 + 4) = (f32x4){f[4], f[5], f[6], f[7]};
                unpack8(*(const GAS v4u*)(xr + DIN + g * NST + part * 16 + 8), f);
                *(LAS f32x4*)(Bl + tk * 128 + part * 16 + 8) = (f32x4){f[0], f[1], f[2], f[3]}; *(LAS f32x4*)(Bl + tk * 128 + part * 16 + 12) = (f32x4){f[4], f[5], f[6], f[7]};
                unpack8(*(const GAS v4u*)(xr + DIN + NG * NST + g * NST + part * 16), f);
                *(LAS f32x4*)(Cl + tk * 128 + part * 16) = (f32x4){f[0], f[1], f[2], f[3]}; *(LAS f32x4*)(Cl + tk * 128 + part * 16 + 4) = (f32x4){f[4], f[5], f[6], f[7]};
                unpack8(*(const GAS v4u*)(xr + DIN + NG * NST + g * NST + part * 16 + 8), f);
                *(LAS f32x4*)(Cl + tk * 128 + part * 16 + 8) = (f32x4){f[0], f[1], f[2], f[3]}; *(LAS f32x4*)(Cl + tk * 128 + part * 16 + 12) = (f32x4){f[4], f[5], f[6], f[7]};
                const v2u xw = *(const GAS v2u*)(xr + h * HP + p0 + part * 4);
                *(LAS f32x4*)(Xl + tk * 32 + part * 4) = (f32x4){__uint_as_float(xw.x << 16), __uint_as_float(xw.x & 0xffff0000u), __uint_as_float(xw.y << 16), __uint_as_float(xw.y & 0xffff0000u)};
            }
            if (tid < nb) { dtl[tid] = DT[(m0 + tb + tid) * 32 + h]; dal[tid] = DA[(m0 + tb + tid) * 32 + h]; }
        }
        __syncthreads();
        for (int t = 0; t < nb; ++t) {
            const float da = dal[t], dtv = dtl[t], xv = Xl[t * 32 + pl], xdt = xv * dtv;
            const f32x4 b0 = *(const LAS f32x4*)(Bl + t * 128 + n0), b1 = *(const LAS f32x4*)(Bl + t * 128 + n0 + 4);
            const f32x4 c0 = *(const LAS f32x4*)(Cl + t * 128 + n0), c1 = *(const LAS f32x4*)(Cl + t * 128 + n0 + 4);
            s[0] = s[0] * da + xdt * b0.x; s[1] = s[1] * da + xdt * b0.y; s[2] = s[2] * da + xdt * b0.z; s[3] = s[3] * da + xdt * b0.w;
            s[4] = s[4] * da + xdt * b1.x; s[5] = s[5] * da + xdt * b1.y; s[6] = s[6] * da + xdt * b1.z; s[7] = s[7] * da + xdt * b1.w;
            float y = (s[0] * c0.x + s[1] * c0.y) + (s[2] * c0.z + s[3] * c0.w) + (s[4] * c1.x + s[5] * c1.y) + (s[6] * c1.z + s[7] * c1.w);
            y += __shfl_xor(y, 1); y += __shfl_xor(y, 2); y += __shfl_xor(y, 4); y += __shfl_xor(y, 8);
            if (nq == 0) Yl[t * 32 + pl] = y + xv * dskip;
        }
        __syncthreads();
        { const int tk = tid >> 3, part = tid & 7;
            if (tk < nb) *(GAS f32x4*)(YS + (m0 + tb + tk) * DIN + h * HP + p0 + part * 4) = *(const LAS f32x4*)(Yl + tk * 32 + part * 4); }
    }
    *(GAS f32x4*)(hout + (size_t)(p0 + pl) * NST + n0) = (f32x4){s[0], s[1], s[2], s[3]};
    *(GAS f32x4*)(hout + (size_t)(p0 + pl) * NST + n0 + 4) = (f32x4){s[4], s[5], s[6], s[7]};
}

__device__ __forceinline__ void idx_load_q(const GAS bf16* P1, const GAS float* MISC, size_t mq0, int lane, bf16x8 (&afr)[2][4], float (&wq)[2][2][8]) {
    const int r = lane & 31, hh = lane >> 5, qs = ((r >> 2) & 1) * 2 + (r >> 4), head = (r & 3) + 4 * ((r >> 3) & 1);
#pragma unroll
    for (int rt = 0; rt < 2; ++rt)
#pragma unroll
        for (int ks = 0; ks < 4; ++ks) afr[rt][ks] = *(const GAS bf16x8*)(P1 + (mq0 + qs + 4 * rt) * LDP1 + C_QI + head * 64 + 16 * ks + 8 * hh);
#pragma unroll
    for (int rt = 0; rt < 2; ++rt)
#pragma unroll
        for (int jq = 0; jq < 2; ++jq) { const GAS float* wp = MISC + (mq0 + 4 * rt + 2 * hh + jq) * 128 + MC_WI; const f32x4 a = *(const GAS f32x4*)wp, b = *(const GAS f32x4*)(wp + 4);
            const float sc = 0.125f * 0.35355339059327373f;
            wq[rt][jq][0] = a.x * sc; wq[rt][jq][1] = a.y * sc; wq[rt][jq][2] = a.z * sc; wq[rt][jq][3] = a.w * sc; wq[rt][jq][4] = b.x * sc; wq[rt][jq][5] = b.y * sc; wq[rt][jq][6] = b.z * sc; wq[rt][jq][7] = b.w * sc; }
}
typedef float f32x2 __attribute__((ext_vector_type(2)));
__device__ __forceinline__ float relu_bits(float x) { return __int_as_float(max(__float_as_int(x), 0)); }
__device__ __forceinline__ float idx_reduce(const f32x16& acc, const int o, const float (&w)[8]) {
    f32x2 s2 = (f32x2){w[0], w[1]} * (f32x2){relu_bits(acc[o]), relu_bits(acc[o + 1])};
#pragma unroll
    for (int i = 2; i < 8; i += 2) s2 = __builtin_elementwise_fma((f32x2){w[i], w[i + 1]}, (f32x2){relu_bits(acc[o + i]), relu_bits(acc[o + i + 1])}, s2);
    return s2.x + s2.y;
}
__device__ __forceinline__ void idx_scores(const bf16x8 (&afr)[2][4], const bf16x8 (&bfr)[4], const float (&wq)[2][2][8], float (&sc)[2][2]) {
#pragma unroll
    for (int rt = 0; rt < 2; ++rt) {
        f32x16 acc = {};
#pragma unroll
        for (int ks = 0; ks < 4; ++ks) acc = __builtin_amdgcn_mfma_f32_32x32x16_bf16(afr[rt][ks], bfr[ks], acc, 0, 0, 0);
#pragma unroll
        for (int jq = 0; jq < 2; ++jq) sc[rt][jq] = idx_reduce(acc, 8 * jq, wq[rt][jq]);
    }
}
__device__ __forceinline__ unsigned f2key(float f) { const unsigned u = __float_as_uint(f); return u ^ ((u >> 31) ? 0xffffffffu : 0x80000000u); }
__device__ __forceinline__ unsigned wave_incl_scan(unsigned v, int lane) {
#pragma unroll
    for (int o = 1; o < 64; o <<= 1) { const unsigned t = __shfl_up(v, o); if (lane >= o) v += t; }
    return v;
}
#ifndef REP_TK_PASS
#define REP_TK_PASS 1
#endif
#ifndef REP_TK_COMP
#define REP_TK_COMP 1
#endif
__device__ __forceinline__ int wave_sum_i(int v) {
    v += __builtin_amdgcn_update_dpp(0, v, 0xB1, 0xf, 0xf, true);
    v += __builtin_amdgcn_update_dpp(0, v, 0x4E, 0xf, 0xf, true);
    v += __builtin_amdgcn_update_dpp(0, v, 0x141, 0xf, 0xf, true);
    v += __builtin_amdgcn_update_dpp(0, v, 0x140, 0xf, 0xf, true);
    v += __builtin_amdgcn_update_dpp(0, v, 0x142, 0xa, 0xf, false);
    v += __builtin_amdgcn_update_dpp(0, v, 0x143, 0xc, 0xf, false);
    return __builtin_amdgcn_readlane(v, 63);
}
__device__ __forceinline__ int cnt_ge(const LAS unsigned* s, int nit, unsigned mid, int lane) {
    int cl = 0; int it = 0;
    const LAS v4u* p = (const LAS v4u*)s + lane;
    for (; it + 4 <= nit; it += 4) {
        const v4u k0 = p[64 * it], k1 = p[64 * it + 64], k2 = p[64 * it + 128], k3 = p[64 * it + 192];
        cl += (k0.x >= mid) + (k0.y >= mid) + (k0.z >= mid) + (k0.w >= mid);
        cl += (k1.x >= mid) + (k1.y >= mid) + (k1.z >= mid) + (k1.w >= mid);
        cl += (k2.x >= mid) + (k2.y >= mid) + (k2.z >= mid) + (k2.w >= mid);
        cl += (k3.x >= mid) + (k3.y >= mid) + (k3.z >= mid) + (k3.w >= mid); }
    for (; it < nit; ++it) { const v4u kv = p[64 * it]; cl += (kv.x >= mid) + (kv.y >= mid) + (kv.z >= mid) + (kv.w >= mid); }
    return wave_sum_i(cl);
}
constexpr int HB = 512;
__device__ __forceinline__ unsigned hist_bound_key(int b) {
    return b <= 0 ? 1u : (b >= HB ? 0xff800001u : (b == 256 ? 0x7fffffffu : f2key((float)(b - 256) * (1.0f / 64.0f))));
}
template <class OT>
__device__ __forceinline__ void topk_select(LAS unsigned* s, int n, int lane, OT* out, const LAS unsigned* hist = nullptr) {
    const int nit = (n + 255) >> 8;
    for (int i = n + lane; i < nit * 256; i += 64) s[i] = 0u;
    LDS_WAIT(); asm volatile("" ::: "memory");
    unsigned T = 0u, need = 0u;
    for (int rq_ = 0; rq_ < REP_TK_PASS; ++rq_) {
    unsigned hi, lo; int c_hi, c_lo;
    if (hist) {
        unsigned c[8], tot = 0u;
#pragma unroll
        for (int j = 0; j < 8; ++j) { c[j] = hist[HB - 1 - 8 * lane - j]; tot += c[j]; }
        const unsigned incl = wave_incl_scan(tot, lane), excl = incl - tot;
        const bool here = (excl < 256u) && (256u <= incl);
        int bin = 0; unsigned above = 0u, inb = 0u;
        if (here) { unsigned run = excl;
#pragma unroll
            for (int j = 0; j < 8; ++j) { if (run < 256u && 256u <= run + c[j]) { bin = HB - 1 - 8 * lane - j; above = run; inb = c[j]; } run += c[j]; } }
        const unsigned long long mk = __ballot(here); const int src = mk ? (__ffsll((long long)mk) - 1) : 0;
        bin = __builtin_amdgcn_readlane(bin, src); above = (unsigned)__builtin_amdgcn_readlane((int)above, src); inb = (unsigned)__builtin_amdgcn_readlane((int)inb, src);
        lo = hist_bound_key(bin); hi = hist_bound_key(bin + 1); c_hi = (int)above; c_lo = (int)(above + inb);
    } else {
    unsigned kmx = 0u;
    for (int it = 0; it < nit; ++it) { const v4u kv = *(const LAS v4u*)(s + 4 * (lane + 64 * it));
        const unsigned a = kv.x > kv.y ? kv.x : kv.y, c = kv.z > kv.w ? kv.z : kv.w, d = a > c ? a : c; kmx = d > kmx ? d : kmx; }
#pragma unroll
    for (int o = 1; o < 64; o <<= 1) { const unsigned a = __shfl_xor(kmx, o); kmx = a > kmx ? a : kmx; }
    kmx = (unsigned)__builtin_amdgcn_readfirstlane((int)kmx);
    hi = kmx + 1u; lo = 1u; c_hi = 0; c_lo = n;
    { unsigned step = 1u << 25;
      for (int tr = 0; tr < 7; ++tr) { if (hi <= step + 1u) break; const unsigned cand = hi - step;
          const int c = cnt_ge(s, nit, cand, lane);
          if (c >= 256) { lo = cand; c_lo = c; break; } hi = cand; c_hi = c; step <<= 1; } }
    }
    bool bis = false; unsigned pw = hi - lo;
    for (int pass = 0; pass < 96; ++pass) {
        if (c_lo == 256) { T = lo - 1u; need = 0u; break; }
        if (hi - lo <= 1u) { T = lo; need = (unsigned)(256 - c_hi); break; }
        const unsigned width = hi - lo; unsigned mid;
        if (bis) mid = lo + (width >> 1);
        else { const float f = ((float)(c_lo - 256) + 0.5f) * __builtin_amdgcn_rcpf((float)(c_lo - c_hi)); const float off = (float)width * f;
               mid = lo + (off >= (float)width ? width - 1u : (unsigned)off); }
        if (mid <= lo) mid = lo + 1u; if (mid >= hi) mid = hi - 1u;
        const int c = cnt_ge(s, nit, mid, lane);
        if (c >= 256) { lo = mid; c_lo = c; } else { hi = mid; c_hi = c; }
        const unsigned nw = hi - lo; bis = !bis && (nw > (pw >> 2)); pw = nw;
    }
    }
    const unsigned long long lt = (1ull << lane) - 1ull;
    unsigned running = 0u, eq_taken = 0u;
    for (int rq_ = 0; rq_ < REP_TK_COMP; ++rq_) { running = 0u; eq_taken = 0u;
#pragma unroll 2
    for (int it = 0; it < nit; ++it) {
        const int i0 = 4 * (lane + 64 * it); const v4u kv = *(const LAS v4u*)(s + i0);
        bool sel[4], eq[4]; bool anyeq = false;
#pragma unroll
        for (int e = 0; e < 4; ++e) { sel[e] = kv[e] > T; eq[e] = need != 0u && kv[e] == T && (i0 + e < n); anyeq = anyeq || eq[e]; }
        if (need != 0u && __ballot(anyeq)) {
            unsigned lower = 0u, all = 0u;
#pragma unroll
            for (int e = 0; e < 4; ++e) { const unsigned long long bm = __ballot(eq[e]); lower += (unsigned)__popcll(bm & lt); all += (unsigned)__popcll(bm); }
            unsigned er = eq_taken + lower;
#pragma unroll
            for (int e = 0; e < 4; ++e) { if (eq[e]) { sel[e] = er < need; ++er; } }
            eq_taken += all;
        }
        unsigned lower = 0u, all = 0u;
#pragma unroll
        for (int e = 0; e < 4; ++e) { const unsigned long long sm = __ballot(sel[e]); lower += (unsigned)__popcll(sm & lt); all += (unsigned)__popcll(sm); }
        unsigned pos = running + lower;
#pragma unroll
        for (int e = 0; e < 4; ++e) { if (sel[e]) { if (pos < 256u) out[pos] = (OT)(i0 + e); ++pos; } }
        running += all;
    } }
}

constexpr int NCH = 33;
typedef short s16x4 __attribute__((ext_vector_type(4)));
typedef short v4i16_t __attribute__((ext_vector_type(4)));
__device__ __forceinline__ float wave_incl_scan_f(float v, int lane) {
#pragma unroll
    for (int o = 1; o < 64; o <<= 1) { const float t = __shfl_up(v, o); if (lane >= o) v += t; }
    return v;
}
__device__ __forceinline__ s16x4 ldtr(const LAS unsigned char* p) { return __builtin_bit_cast(s16x4, __builtin_amdgcn_ds_read_tr16_b64_v4i16((LAS v4i16_t*)p)); }
__device__ __forceinline__ bf16x8 frag_tr(const LAS unsigned char* img, int RS, int k0, int c0, int lane) {
    const int hh = lane >> 5, blk = (lane >> 4) & 1, q = (lane & 15) >> 2, pp = lane & 3;
    const LAS unsigned char* a = img + (k0 + 8 * hh + q) * RS + (c0 + 16 * blk + 4 * pp) * 2;
    const s16x4 lo = ldtr(a), hi = ldtr(a + 4 * RS);
    return (bf16x8){lo[0], lo[1], lo[2], lo[3], hi[0], hi[1], hi[2], hi[3]};
}
__device__ __forceinline__ bf16x8 frag_row(const LAS unsigned char* img, int RS, int r0, int k0, int lane) {
    return *(const LAS bf16x8*)(img + (r0 + (lane & 31)) * RS + (k0 + 8 * (lane >> 5)) * 2);
}
constexpr int RS_BC = 272, RS_X = 144, IMG_BC = 128 * RS_BC, IMG_X = 128 * RS_X;
__device__ __forceinline__ void ssd_stage_acum(LAS float* acl, LAS float* dtl, const GAS float* DT, const GAS float* a_log_l, size_t m0, int Lc, int g, int wave, int lane) {
    const int h = 8 * g + wave; const float A = -__expf(a_log_l[h]);
    const float d0 = lane < Lc ? DT[(m0 + lane) * 32 + h] : 0.f, d1 = (64 + lane) < Lc ? DT[(m0 + 64 + lane) * 32 + h] : 0.f;
    const float s0 = wave_incl_scan_f(d0 * A, lane), tot0 = __shfl(s0, 63), s1 = wave_incl_scan_f(d1 * A, lane) + tot0;
    acl[wave * 128 + lane] = s0; acl[wave * 128 + 64 + lane] = s1; dtl[wave * 128 + lane] = d0; dtl[wave * 128 + 64 + lane] = d1;
}
__device__ __forceinline__ void ssd_stage_bc(LAS unsigned char* img, const GAS bf16* src  , int Lc, int tid) {
    const int ch = tid & 15;
#pragma unroll
    for (int q4 = 0; q4 < 4; ++q4) { const int row = (tid >> 4) + 32 * q4; v4u v = (v4u){0u, 0u, 0u, 0u}; if (row < Lc) v = *(const GAS v4u*)(src + (size_t)row * CONVD + ch * 8);
        *(LAS v4u*)(img + row * RS_BC + ch * 16) = v; }
}
__device__ __forceinline__ void ssd_stage_x(LAS unsigned char* img, const GAS bf16* src  , int Lc, int tid, const LAS float* dth, const LAS float* ach, float al, bool decay) {
    const int ch = tid & 7;
#pragma unroll
    for (int q2 = 0; q2 < 2; ++q2) { const int row = (tid >> 3) + 64 * q2; v4u o = (v4u){0u, 0u, 0u, 0u};
        if (row < Lc) { float f[8]; unpack8(*(const GAS v4u*)(src + (size_t)row * CONVD + ch * 8), f);
            const float sc = decay ? dth[row] * __expf(al - ach[row]) : dth[row];
            o = (v4u){pk2(f[0] * sc, f[1] * sc), pk2(f[2] * sc, f[3] * sc), pk2(f[4] * sc, f[5] * sc), pk2(f[6] * sc, f[7] * sc)}; }
        *(LAS v4u*)(img + row * RS_X + ch * 16) = o; }
}
__device__ __forceinline__ void ssd1_unit(LAS unsigned char* lds, int tid, const GAS bf16* XC, const GAS float* DT, const GAS float* a_log_l, GAS bf16* SB, GAS float* DEC, int b, int c, int g) {
    const int lane = tid & 63, wave = __builtin_amdgcn_readfirstlane(tid >> 6), hh = lane >> 5, col = lane & 31;
    const int t0 = c == 0 ? 0 : NMETA + 128 * (c - 1), Lc = c == 0 ? NMETA : 128; const size_t m0 = (size_t)b * LP + t0;
    LAS unsigned char* Bimg = lds; LAS unsigned char* Xw0 = lds + IMG_BC;
    LAS float* acl = (LAS float*)(lds + IMG_BC + 2 * IMG_X); LAS float* dtl = acl + 1024;
    ssd_stage_acum(acl, dtl, DT, a_log_l, m0, Lc, g, wave, lane);
    ssd_stage_bc(Bimg, XC + m0 * CONVD + DIN + g * NST, Lc, tid);
    __syncthreads();
    const int pb = wave >> 2, nb = wave & 3;
    for (int hl = 0; hl < 8; ++hl) {
        const int h = 8 * g + hl; LAS unsigned char* Xw = Xw0 + (hl & 1) * IMG_X;
        const float al = acl[hl * 128 + 127];
        ssd_stage_x(Xw, XC + m0 * CONVD + h * HP, Lc, tid, dtl + hl * 128, acl + hl * 128, al, true);
        __syncthreads();
        f32x16 acc = {};
        if (Lc == 128) {
#pragma unroll
            for (int ks = 0; ks < 8; ++ks) acc = __builtin_amdgcn_mfma_f32_32x32x16_bf16(frag_tr(Xw, RS_X, 16 * ks, 32 * pb, lane), frag_tr(Bimg, RS_BC, 16 * ks, 32 * nb, lane), acc, 0, 0, 0);
        } else acc = __builtin_amdgcn_mfma_f32_32x32x16_bf16(frag_tr(Xw, RS_X, 0, 32 * pb, lane), frag_tr(Bimg, RS_BC, 0, 32 * nb, lane), acc, 0, 0, 0);
        GAS bf16* Sp = SB + ((size_t)(b * NCH + c) * NH + h) * (HP * NST) + 32 * nb + col;
#pragma unroll
        for (int r = 0; r < 16; ++r) Sp[(32 * pb + (r & 3) + 8 * (r >> 2) + 4 * hh) * NST] = (bf16)f2bf(acc[r]);
        if (tid == 0) DEC[(b * NCH + c) * NH + h] = __expf(al);
    }
    __syncthreads();
}
#ifndef REP_SSD3_WR
#define REP_SSD3_WR 1
#endif
#ifndef REP_SSD3_MM
#define REP_SSD3_MM 1
#endif
#ifndef REP_SSD3_HEADS
#define REP_SSD3_HEADS 1
#endif
__device__ __forceinline__ void ssd3_unit(LAS unsigned char* lds, int tid, const GAS bf16* XC, const GAS bf16* P1, const GAS float* DT, const GAS float* a_log_l, const GAS float* dskip_l, const GAS float* normw_l,
                                          const GAS bf16* HC, GAS bf16* YSN, int b, int c, int g) {
    const int lane = tid & 63, wave = __builtin_amdgcn_readfirstlane(tid >> 6), hh = lane >> 5, col = lane & 31;
    const int t0 = c == 0 ? 0 : NMETA + 128 * (c - 1), Lc = c == 0 ? NMETA : 128; const size_t m0 = (size_t)b * LP + t0;
    LAS unsigned char* Bimg = lds; LAS unsigned char* Cimg = lds + IMG_BC; LAS unsigned char* Mimg0 = lds + 2 * IMG_BC; LAS unsigned char* Ximg0 = lds + 3 * IMG_BC;
    LAS float* acl = (LAS float*)(lds + 3 * IMG_BC + 2 * IMG_X); LAS float* dtl = acl + 1024;
    LAS unsigned char* Mimg1 = Bimg; LAS unsigned char* Ximg1 = Ximg0 + IMG_X;
    ssd_stage_acum(acl, dtl, DT, a_log_l, m0, Lc, g, wave, lane);
    ssd_stage_bc(Bimg, XC + m0 * CONVD + DIN + g * NST, Lc, tid);
    ssd_stage_bc(Cimg, XC + m0 * CONVD + DIN + NG * NST + g * NST, Lc, tid);
    __syncthreads();
    const int ib = wave >> 1, pb = wave & 1;
    f32x16 cb[2];
    const bool live = 32 * ib < Lc;
#pragma unroll
    for (int jj = 0; jj < 2; ++jj) { const int jb = 2 * (wave & 1) + jj; cb[jj] = (f32x16){};
        if (jb <= ib && live) {
#pragma unroll
            for (int ks = 0; ks < 8; ++ks) cb[jj] = __builtin_amdgcn_mfma_f32_32x32x16_bf16(frag_row(Bimg, RS_BC, 32 * jb, 16 * ks, lane), frag_row(Cimg, RS_BC, 32 * ib, 16 * ks, lane), cb[jj], 0, 0, 0); } }
    const int irow = 32 * ib + col;
    bf16x8 cf[8];
#pragma unroll
    for (int ks = 0; ks < 8; ++ks) cf[ks] = frag_row(Cimg, RS_BC, 32 * ib, 16 * ks, lane);
    __syncthreads();
    const int xrow = tid >> 3, xch = tid & 7;
    const GAS bf16* xsrc = XC + (m0 + xrow) * CONVD + (8 * g) * HP + xch * 8;
    v4u xq0 = (v4u){0u, 0u, 0u, 0u}, xq1 = xq0;
    for (int rh_ = 0; rh_ < REP_SSD3_HEADS; ++rh_) {
    if (rh_ > 0) __syncthreads();
    if (xrow < Lc) xq0 = *(const GAS v4u*)xsrc;
    if (xrow + 64 < Lc) xq1 = *(const GAS v4u*)(xsrc + (size_t)64 * CONVD);
    const GAS bf16* Hp0 = HC + ((size_t)(b * NCH + c) * NH + 8 * g) * (HP * NST) + pb * 4096 + lane * 8;
    bf16x8 hq[8];
#pragma unroll
    for (int ks = 0; ks < 8; ++ks) hq[ks] = *(const GAS bf16x8*)(Hp0 + 512 * ks);
    for (int hl = 0; hl < 8; ++hl) {
        const int h = 8 * g + hl;
        LAS unsigned char* Mimg = (hl & 1) ? Mimg1 : Mimg0; LAS unsigned char* Ximg = (hl & 1) ? Ximg1 : Ximg0;
        bf16x8 hf[8], hn[8];
#pragma unroll
        for (int ks = 0; ks < 8; ++ks) { hf[ks] = hq[ks]; hn[ks] = hq[ks]; }
        if (hl < 7) {
#pragma unroll
            for (int ks = 0; ks < 8; ++ks) hn[ks] = *(const GAS bf16x8*)(Hp0 + (size_t)(hl + 1) * (HP * NST) + 512 * ks); }
        v4u xn0 = xq0, xn1 = xq1;
        if (hl < 7 && xrow < Lc) xn0 = *(const GAS v4u*)(xsrc + (hl + 1) * HP);
        if (hl < 7 && xrow + 64 < Lc) xn1 = *(const GAS v4u*)(xsrc + (size_t)64 * CONVD + (hl + 1) * HP);
        const float ai = acl[hl * 128 + irow];
        for (int rw_ = 0; rw_ < REP_SSD3_WR; ++rw_) {
#pragma unroll
        for (int jj = 0; jj < 2; ++jj) { const int jb = 2 * (wave & 1) + jj;
            if (jb <= ib && live) {
                LAS unsigned char* mp = Mimg + irow * RS_BC + (32 * jb + 4 * hh) * 2;
#pragma unroll
                for (int q = 0; q < 4; ++q) { const int j0 = 32 * jb + 8 * q + 4 * hh; const f32x4 aj = *(const LAS f32x4*)(acl + hl * 128 + j0);
                    float v[4];
#pragma unroll
                    for (int e = 0; e < 4; ++e) v[e] = (j0 + e <= irow) ? cb[jj][4 * q + e] * __expf(ai - aj[e]) : 0.f;
                    *(LAS v2u*)(mp + 16 * q) = (v2u){pk2(v[0], v[1]), pk2(v[2], v[3])}; } } }
        { const float s0 = dtl[hl * 128 + xrow], s1 = dtl[hl * 128 + 64 + xrow]; float f[8]; v4u o0, o1;
          unpack8(xq0, f); o0 = (v4u){pk2(f[0] * s0, f[1] * s0), pk2(f[2] * s0, f[3] * s0), pk2(f[4] * s0, f[5] * s0), pk2(f[6] * s0, f[7] * s0)};
          unpack8(xq1, f); o1 = (v4u){pk2(f[0] * s1, f[1] * s1), pk2(f[2] * s1, f[3] * s1), pk2(f[4] * s1, f[5] * s1), pk2(f[6] * s1, f[7] * s1)};
          *(LAS v4u*)(Ximg + xrow * RS_X + xch * 16) = o0; *(LAS v4u*)(Ximg + (xrow + 64) * RS_X + xch * 16) = o1; }
        }
        __syncthreads();
        f32x16 a1 = {}, a2 = {};
        if (live) {
        const int nks = Lc == 128 ? 2 * (ib + 1) : 1;
        for (int rm_ = 0; rm_ < REP_SSD3_MM; ++rm_) { a1 = (f32x16){}; a2 = (f32x16){};
        for (int ks = 0; ks < nks; ++ks) a1 = __builtin_amdgcn_mfma_f32_32x32x16_bf16(frag_tr(Ximg, RS_X, 16 * ks, 32 * pb, lane), frag_row(Mimg, RS_BC, 32 * ib, 16 * ks, lane), a1, 0, 0, 0);
#pragma unroll
        for (int ks = 0; ks < 8; ++ks) a2 = __builtin_amdgcn_mfma_f32_32x32x16_bf16(hf[ks], cf[ks], a2, 0, 0, 0);
        }
        const float ei = __expf(ai);
        v2u wq[4];
#pragma unroll
        for (int q = 0; q < 4; ++q) wq[q] = (v2u){pk2(a1[4 * q] + ei * a2[4 * q], a1[4 * q + 1] + ei * a2[4 * q + 1]), pk2(a1[4 * q + 2] + ei * a2[4 * q + 2], a1[4 * q + 3] + ei * a2[4 * q + 3])};
        GAS bf16* yo = YSN + (m0 + irow) * DIN + h * HP + 32 * pb + 8 * hh;
#pragma unroll
        for (int k = 0; k < 4; k += 2) {
            const auto rx = __builtin_amdgcn_permlane32_swap(wq[k].x, wq[k + 1].x, false, false), ry = __builtin_amdgcn_permlane32_swap(wq[k].y, wq[k + 1].y, false, false);
            if (irow < Lc) *(GAS v4u*)(yo + 8 * k) = (v4u){rx[0], ry[0], rx[1], ry[1]}; }
        }
#pragma unroll
        for (int ks = 0; ks < 8; ++ks) hq[ks] = hn[ks];
        xq0 = xn0; xq1 = xn1;
    }
    }
    __syncthreads();
    for (int i0 = wave; i0 < Lc; i0 += 4 * NWAVES) { const int c0 = g * 512 + lane * 8;
        v4u yv[4], xv[4], zv[4];
#pragma unroll
        for (int q = 0; q < 4; ++q) { const int i = i0 + NWAVES * q; const size_t m = m0 + (i < Lc ? i : i0);
            yv[q] = *(const GAS v4u*)(YSN + m * DIN + c0); xv[q] = *(const GAS v4u*)(XC + m * CONVD + c0); zv[q] = *(const GAS v4u*)(P1 + m * LDP1 + C_Z + c0); }
        const float Dh = dskip_l[c0 >> 6];
        const GAS float* wp = normw_l + c0; const f32x4 wa = *(const GAS f32x4*)wp, wb = *(const GAS f32x4*)(wp + 4);
#pragma unroll
        for (int q = 0; q < 4; ++q) { const int i = i0 + NWAVES * q;
            float v[8], x[8], z[8]; unpack8(yv[q], v); unpack8(xv[q], x); unpack8(zv[q], z); float ss = 0.f;
#pragma unroll
            for (int j = 0; j < 8; ++j) { v[j] = (v[j] + Dh * x[j]) * (z[j] * sigm(z[j])); ss += v[j] * v[j]; }
            ss = wave_sum(ss);
            const float rstd = 1.0f / sqrtf(ss * (1.0f / 512.0f) + 1e-6f);
            if (i < Lc) *(GAS v4u*)(YSN + (m0 + i) * DIN + c0) = (v4u){pk2(v[0] * rstd * wa.x, v[1] * rstd * wa.y), pk2(v[2] * rstd * wa.z, v[3] * rstd * wa.w), pk2(v[4] * rstd * wb.x, v[5] * rstd * wb.y), pk2(v[6] * rstd * wb.z, v[7] * rstd * wb.w)}; }
    }
    __syncthreads();
}

constexpr int RS_V = 528;
__device__ __forceinline__ void attn_prompt_query(LAS unsigned char* wl, const GAS bf16* P1, const GAS bf16* KVB, const GAS unsigned short* IDXP, GAS bf16* YA, int m, int lane_in) {
    int lane = lane_in; asm volatile("" : "+v"(lane));
    const int b = m / LP, t = m - b * LP, cnt = (t + 1) < 256 ? (t + 1) : 256, ntile = (cnt + 15) >> 4, nstep = (ntile + 1) >> 1;
    LAS unsigned char* Vst = wl; LAS unsigned short* idl = (LAS unsigned short*)(wl + 32 * RS_V);
    { const v2u w = *(const GAS v2u*)(IDXP + (size_t)m * 256 + 4 * lane); const int s0 = 4 * lane;
      const unsigned i0 = (s0 + 0 < cnt) ? (w.x & 0xffffu) : 0u, i1 = (s0 + 1 < cnt) ? (w.x >> 16) : 0u, i2 = (s0 + 2 < cnt) ? (w.y & 0xffffu) : 0u, i3 = (s0 + 3 < cnt) ? (w.y >> 16) : 0u;
      *(LAS v2u*)(idl + s0) = (v2u){i0 | (i1 << 16), i2 | (i3 << 16)}; }
    const int n = lane & 15, kg = lane >> 4;
    int k4 = 4 * kg; asm volatile("" : "+v"(k4));
    bf16x8 bq[8];
#pragma unroll
    for (int s = 0; s < 8; ++s) { bq[s] = (bf16x8){0, 0, 0, 0, 0, 0, 0, 0};
        if ((n >> 2) == (s >> 1)) bq[s] = *(const GAS bf16x8*)(P1 + (size_t)m * LDP1 + C_Q + n * 64 + 32 * (s & 1) + 8 * kg); }
    LDS_WAIT(); asm volatile("" ::: "memory");
    const GAS char* kvb = (const GAS char*)(KVB + (size_t)b * LP * 512);
    const unsigned voff = 512u + 16u * (lane & 31);
    f32x4 S[16];
#pragma unroll
    for (int jt = 0; jt < 16; ++jt) S[jt] = (f32x4){-INFINITY, -INFINITY, -INFINITY, -INFINITY};
    float mx = -INFINITY;
    {
        v4u kst[3][8];
#define KLOAD(dst, tile) do { _Pragma("unroll") for (int it = 0; it < 8; ++it) dst[it] = *(const GAS v4u*)(kvb + ((unsigned)idl[16 * (tile) + 2 * it + (lane >> 5)] * 1024u + 16u * (lane & 31))); } while (0)
        KLOAD(kst[0], 0);
#pragma unroll
        for (int it = 0; it < 8; ++it) { kst[1][it] = kst[0][it]; kst[2][it] = kst[0][it]; }
        if (1 < ntile) KLOAD(kst[1], 1);
        if (2 < ntile) KLOAD(kst[2], 2);
#pragma unroll
        for (int jt = 0; jt < 16; ++jt) {
            if (jt < ntile) {
                LAS unsigned char* half = Vst + 16 * (jt & 1) * RS_V;
#pragma unroll
                for (int it = 0; it < 8; ++it) *(LAS v4u*)(half + (2 * it + (lane >> 5)) * RS_V + 16 * (lane & 31)) = kst[jt % 3][it];
                LDS_WAIT(); asm volatile("" ::: "memory");
                if (jt + 3 < ntile) KLOAD(kst[jt % 3], jt + 3);
                f32x4 acc = {0.f, 0.f, 0.f, 0.f};
#pragma unroll
                for (int s8 = 0; s8 < 8; ++s8) acc = __builtin_amdgcn_mfma_f32_16x16x32_bf16(*(const LAS bf16x8*)(half + n * RS_V + (32 * s8 + 8 * kg) * 2), bq[s8], acc, 0, 0, 0);
                f32x4 sv;
#pragma unroll
                for (int i = 0; i < 4; ++i) { const float v = (k4 + i < cnt - 16 * jt) ? acc[i] * 0.125f : -INFINITY; sv[i] = v; mx = fmaxf(mx, v); }
                S[jt] = sv;
                LDS_WAIT(); asm volatile("" ::: "memory");
            }
        }
#undef KLOAD
    }
    mx = fmaxf(mx, __shfl_xor(mx, 16)); mx = fmaxf(mx, __shfl_xor(mx, 32));
    float sum = 0.f;
    v4u pa[8];
#pragma unroll
    for (int s = 0; s < 8; ++s) { float p[8];
#pragma unroll
        for (int i = 0; i < 4; ++i) { p[i] = __expf(S[2 * s][i] - mx); p[4 + i] = __expf(S[2 * s + 1][i] - mx); }
#pragma unroll
        for (int i = 0; i < 8; ++i) sum += p[i];
        pa[s] = (v4u){pk2(p[0], p[1]), pk2(p[2], p[3]), pk2(p[4], p[5]), pk2(p[6], p[7])};
        __builtin_amdgcn_sched_barrier(0); }
    sum += __shfl_xor(sum, 16); sum += __shfl_xor(sum, 32);
    const float linv = 1.0f / sum;
    asm volatile("" ::: "memory");
    v4u vst[3][8];
#define VLOAD(dst, tile) do { _Pragma("unroll") for (int it = 0; it < 8; ++it) dst[it] = *(const GAS v4u*)(kvb + ((unsigned)idl[16 * (tile) + 2 * it + (lane >> 5)] * 1024u + voff)); } while (0)
#define VSTORE(src, tt) do { _Pragma("unroll") for (int it = 0; it < 8; ++it) { const int u = 2 * it + (lane >> 5); *(LAS v4u*)(Vst + (8 * (u >> 2) + 4 * (tt) + (u & 3)) * RS_V + 16 * (lane & 31)) = src[it]; } } while (0)
    VLOAD(vst[0], 0);
#pragma unroll
    for (int it = 0; it < 8; ++it) { vst[1][it] = vst[0][it]; vst[2][it] = vst[0][it]; }
    if (1 < ntile) VLOAD(vst[1], 1);
    if (2 < ntile) VLOAD(vst[2], 2);
    f32x4 o[4];
#pragma unroll
    for (int c = 0; c < 4; ++c) o[c] = (f32x4){0.f, 0.f, 0.f, 0.f};
    const int g16 = lane >> 4, q4 = (lane & 15) >> 2, p4 = lane & 3;
    const LAS unsigned char* trb = Vst + (8 * g16 + q4) * RS_V + 8 * p4;
#pragma unroll
    for (int s = 0; s < 8; ++s) {
        if (s < nstep) {
            VSTORE(vst[(2 * s) % 3], 0);
            VSTORE(vst[(2 * s + 1) % 3], 1);
            LDS_WAIT(); asm volatile("" ::: "memory");
            if (2 * s + 3 < ntile) VLOAD(vst[(2 * s) % 3], 2 * s + 3);
            if (2 * s + 4 < ntile) VLOAD(vst[(2 * s + 1) % 3], 2 * s + 4);
#pragma unroll
            for (int g = 0; g < 4; ++g) {
                const v4u pm = ((n >> 2) == g) ? pa[s] : (v4u){0u, 0u, 0u, 0u};
                const bf16x8 pf = __builtin_bit_cast(bf16x8, pm);
#pragma unroll
                for (int c = 0; c < 4; ++c) { const int ct = 4 * g + c;
                    const s16x4 lo = ldtr(trb + 32 * ct), hi = ldtr(trb + 4 * RS_V + 32 * ct);
                    const bf16x8 bv = (bf16x8){lo[0], lo[1], lo[2], lo[3], hi[0], hi[1], hi[2], hi[3]};
                    o[c] = __builtin_amdgcn_mfma_f32_16x16x32_bf16(pf, bv, o[c], 0, 0, 0); }
            }
            LDS_WAIT(); asm volatile("" ::: "memory");
        }
    }
#undef VLOAD
#undef VSTORE
#pragma unroll
    for (int i = 0; i < 4; ++i) { const float li = __shfl(linv, 4 * kg + i);
#pragma unroll
        for (int c = 0; c < 4; ++c) YA[(size_t)m * D + (4 * kg + i) * 64 + 16 * c + n] = (bf16)f2bf(o[c][i] * li); }
}

__device__ __forceinline__ void attn_sample_query(LAS unsigned char* lds, int tid, const GAS bf16* P1, const GAS bf16* KVB, const GAS float* ck, const GAS float* cv, const GAS int* ptab, const GAS int* IDXS, GAS bf16* YA, int qi) {
    const int lane = tid & 63, wave = tid >> 6, bd = qi >> 3; const size_t m = (size_t)MP + qi;
    LAS float* Sl = (LAS float*)lds;
    LAS float* Ol = Sl + 16 * 256;
    LAS float* ql = Ol + 8 * 1024;
    LAS float* linv = ql + 1024;
    LAS int* rowsel = (LAS int*)(linv + 16);
    { const unsigned w = *(const GAS unsigned*)(P1 + m * LDP1 + C_Q + 2 * tid); ql[2 * tid] = __uint_as_float(w << 16); ql[2 * tid + 1] = __uint_as_float(w & 0xffff0000u); }
    if (tid < 256) rowsel[tid] = IDXS[qi * 256 + tid];
    __syncthreads();
    const int g = lane >> 4, c = lane & 15;
    float qr[4][4];
#pragma unroll
    for (int a = 0; a < 4; ++a) { const f32x4 t = *(const LAS f32x4*)(ql + (4 * g + a) * 64 + 4 * c); qr[a][0] = t.x; qr[a][1] = t.y; qr[a][2] = t.z; qr[a][3] = t.w; }
#pragma unroll 4
    for (int kk = 0; kk < 32; ++kk) {
        const int key = 32 * wave + kk, idx = rowsel[key];
        f32x4 kv;
        if (idx < PAST) { const int page = ptab[bd * NPAGES + (idx >> 7)]; kv = *(const GAS f32x4*)(ck + ((size_t)page * PAGE + (idx & 127)) * 256 + 4 * lane); }
        else { const v2u w = *(const GAS v2u*)(KVB + (size_t)(MP + bd * DS + (idx - PAST)) * 512 + 4 * lane);
            kv = (f32x4){__uint_as_float(w.x << 16), __uint_as_float(w.x & 0xffff0000u), __uint_as_float(w.y << 16), __uint_as_float(w.y & 0xffff0000u)}; }
        float part[4];
#pragma unroll
        for (int a = 0; a < 4; ++a) { float s = (qr[a][0] * kv.x + qr[a][1] * kv.y) + (qr[a][2] * kv.z + qr[a][3] * kv.w);
            part[a] = row16_sum(s); }
        if (c == 0) {
#pragma unroll
            for (int a = 0; a < 4; ++a) Sl[(4 * g + a) * 256 + key] = part[a] * 0.125f; }
    }
    __syncthreads();
#pragma unroll
    for (int hs = 0; hs < 2; ++hs) { const int head = 2 * wave + hs; float v[4]; float mx = -INFINITY;
#pragma unroll
        for (int j = 0; j < 4; ++j) { v[j] = Sl[head * 256 + lane + 64 * j]; mx = fmaxf(mx, v[j]); }
        mx = wave_max(mx); float sum = 0.f;
#pragma unroll
        for (int j = 0; j < 4; ++j) { v[j] = __expf(v[j] - mx); sum += v[j]; Sl[head * 256 + lane + 64 * j] = v[j]; }
        sum = wave_sum(sum);
        if (lane == 0) linv[head] = 1.0f / sum; }
    __syncthreads();
    float o[4][4];
#pragma unroll
    for (int a = 0; a < 4; ++a)
#pragma unroll
        for (int cc = 0; cc < 4; ++cc) o[a][cc] = 0.f;
#pragma unroll 4
    for (int kk = 0; kk < 32; ++kk) {
        const int key = 32 * wave + kk, idx = rowsel[key];
        f32x4 vv;
        if (idx < PAST) { const int page = ptab[bd * NPAGES + (idx >> 7)]; vv = *(const GAS f32x4*)(cv + ((size_t)page * PAGE + (idx & 127)) * 256 + 4 * lane); }
        else { const v2u w = *(const GAS v2u*)(KVB + (size_t)(MP + bd * DS + (idx - PAST)) * 512 + 256 + 4 * lane);
            vv = (f32x4){__uint_as_float(w.x << 16), __uint_as_float(w.x & 0xffff0000u), __uint_as_float(w.y << 16), __uint_as_float(w.y & 0xffff0000u)}; }
#pragma unroll
        for (int a = 0; a < 4; ++a) { const float p = Sl[(4 * g + a) * 256 + key]; o[a][0] += p * vv.x; o[a][1] += p * vv.y; o[a][2] += p * vv.z; o[a][3] += p * vv.w; }
    }
#pragma unroll
    for (int a = 0; a < 4; ++a) *(LAS f32x4*)(Ol + wave * 1024 + (4 * g + a) * 64 + 4 * c) = (f32x4){o[a][0], o[a][1], o[a][2], o[a][3]};
    __syncthreads();
    { float s0 = 0.f, s1 = 0.f;
#pragma unroll
      for (int w = 0; w < 8; ++w) { s0 += Ol[w * 1024 + 2 * tid]; s1 += Ol[w * 1024 + 2 * tid + 1]; }
      const float li = linv[(2 * tid) >> 6];
      *(GAS unsigned*)(YA + m * D + 2 * tid) = pk2(s0 * li, s1 * li); }
    __syncthreads();
}

constexpr int TAIL_R0 = 16384, TAIL_NRT = (MR - TAIL_R0) / 64;
static_assert(TAIL_R0 + 64 * TAIL_NRT == MR, "tail rows");
template <int MODE>
__device__ __forceinline__ void tail_gemm(LAS unsigned char* lds, const GAS bf16* A, int K, const GAS bf16* Bt, int N, const GAS bf16* P1, GAS bf16* T1, GAS bf16* MG, GAS float* H, GAS bf16* A2, int bx, int G, int tid) {
    constexpr int KB = 256, RS = (KB + 8) * 2;
    const int lane = tid & 63, wave = __builtin_amdgcn_readfirstlane(tid >> 6), col = lane & 31, hh = lane >> 5;
    const int nunits = TAIL_NRT * (N / 64), lr = tid >> 3, lc = tid & 7, ti = wave & 3, kh = wave >> 2;
    LAS unsigned char* As = lds; LAS unsigned char* Bs = lds + 64 * RS; LAS float* red = (LAS float*)(lds + 2 * 64 * RS);
    for (int u = bx; u < nunits; u += G) {
        const int rt = u % TAIL_NRT, ct = u / TAIL_NRT;
        const GAS bf16* ap = A + (size_t)(TAIL_R0 + 64 * rt + lr) * K + 8 * lc;
        const GAS bf16* bp = Bt + (size_t)(64 * ct + lr) * K + 8 * lc;
        v4u ra[4], rb[4];
#pragma unroll
        for (int j = 0; j < 4; ++j) { ra[j] = *(const GAS v4u*)(ap + 64 * j); rb[j] = *(const GAS v4u*)(bp + 64 * j); }
        f32x16 acc = {};
        for (int k0 = 0; k0 < K; k0 += KB) {
            __syncthreads();
#pragma unroll
            for (int j = 0; j < 4; ++j) { *(LAS v4u*)(As + lr * RS + (lc * 8 + 64 * j) * 2) = ra[j]; *(LAS v4u*)(Bs + lr * RS + (lc * 8 + 64 * j) * 2) = rb[j]; }
            if (k0 + KB < K) {
#pragma unroll
                for (int j = 0; j < 4; ++j) { ra[j] = *(const GAS v4u*)(ap + k0 + KB + 64 * j); rb[j] = *(const GAS v4u*)(bp + k0 + KB + 64 * j); } }
            __syncthreads();
#pragma unroll
            for (int j = 0; j < 8; ++j) { const int ks = 8 * kh + j;
                const bf16x8 av = *(const LAS bf16x8*)(As + (32 * (ti >> 1) + col) * RS + (16 * ks + 8 * hh) * 2), bv = *(const LAS bf16x8*)(Bs + (32 * (ti & 1) + col) * RS + (16 * ks + 8 * hh) * 2);
                acc = __builtin_amdgcn_mfma_f32_32x32x16_bf16(av, bv, acc, 0, 0, 0); }
        }
        __syncthreads();
        if (kh == 1) {
#pragma unroll
            for (int r = 0; r < 16; ++r) red[(ti * 16 + r) * 64 + lane] = acc[r]; }
        __syncthreads();
        if (kh == 0) {
            const int c = 64 * ct + 32 * (ti & 1) + col;
#pragma unroll
            for (int r = 0; r < 16; ++r) { const size_t row = TAIL_R0 + 64 * rt + 32 * (ti >> 1) + (r & 3) + 8 * (r >> 2) + 4 * hh; const float v = acc[r] + red[(ti * 16 + r) * 64 + lane];
                if (MODE == 1) { const float g = __uint_as_float((unsigned)P1[row * LDP1 + C_GS + c] << 16); T1[row * D + c] = (bf16)f2bf(v * sigm(g)); }
                if (MODE == 2) { const float g = __uint_as_float((unsigned)P1[row * LDP1 + C_GA + c] << 16); MG[row * D + c] = (bf16)f2bf(__uint_as_float((unsigned)T1[row * D + c] << 16) + v * sigm(g)); }
                if (MODE == 3) H[row * D + c] += v;
                if (MODE == 4) { const float w = fmaxf(v, 0.f); A2[row * DFF + c] = (bf16)f2bf(w * w); } }
        }
    }
    __syncthreads();
}

#ifndef REP_SCORE
#define REP_SCORE 1
#endif
#ifndef REP_SCORE_AT
#define REP_SCORE_AT 1
#endif
#ifndef REP_SEL
#define REP_SEL 1
#endif
#ifndef REP_CONV
#define REP_CONV 1
#endif
#ifndef REP_TOPK
#define REP_TOPK 1
#endif
#ifndef REP_SSC
#define REP_SSC 1
#endif
#ifndef REP_SSEL
#define REP_SSEL 1
#endif
#ifndef REP_SSD1
#define REP_SSD1 1
#endif
#ifndef REP_SREC
#define REP_SREC 1
#endif
#ifndef REP_SCAN
#define REP_SCAN 1
#endif
#ifndef REP_ATTS
#define REP_ATTS 1
#endif
#ifndef REP_ATTP
#define REP_ATTP 1
#endif
#ifndef REP_SSD3
#define REP_SSD3 1
#endif
__device__ __forceinline__ void xcd_barrier_ni(unsigned* bar, unsigned x, volatile LAS unsigned* st, int tid, unsigned G) { XcdBarrier b; b.bar = bar; b.x = x; b.st = st; xcd_barrier(b, tid, G); }
__device__ __forceinline__ void assume_global(const void* p) {
#if defined(__HIP_DEVICE_COMPILE__)
    __builtin_assume(!__builtin_amdgcn_is_shared((const __attribute__((address_space(0))) void*)p));
    __builtin_assume(!__builtin_amdgcn_is_private((const __attribute__((address_space(0))) void*)p));
#else
    (void)p;
#endif
}
__device__ __forceinline__ int tid_now(int wave0) { unsigned ones = ~0u; asm volatile("" : "+s"(ones)); return (wave0 << 6) | (int)__builtin_amdgcn_mbcnt_hi(ones, __builtin_amdgcn_mbcnt_lo(ones, 0u)); }
constexpr int NPH = 12, NPHASES = 1 + 2 * NPH;
struct Args { const void* in[24]; float* out; unsigned char* ws; int l_lo, l_hi; };
static_assert(sizeof(Args) == 24 * 8 + 8 + 8 + 8, "Args has no padding");

template <int KLO, int KHI>
__global__ void __launch_bounds__(NT, 2) fwd_t(Args args) {
    extern __shared__ __attribute__((aligned(16))) unsigned char lds_raw[];
    LAS unsigned char* lds0 = (LAS unsigned char*)lds_raw;
    volatile LAS unsigned* MISCW = (volatile LAS unsigned*)(lds0 + MISC_OFF);
    const int G = gridDim.x, bx = blockIdx.x, NGW = G * NWAVES;
    const int wave0 = __builtin_amdgcn_readfirstlane((int)threadIdx.x >> 6);
#define TID_NOW() tid_now(wave0)
    { const int tid0 = threadIdx.x;
      for (int u = tid0; u < (LDS_BYTES - LDSCTL_OFF) / 4; u += NT) ((LAS unsigned*)(lds0 + LDSCTL_OFF))[u] = 0u; }
    __syncthreads();
    XcdBarrier bar = xcd_barrier_post((unsigned*)(args.ws + WS_CTL) + CW_BAR, MISCW + 8);
#define IN(k) (KLO <= (k) && (k) < KHI)
#define SEAM(k) do { if (IN(k) && IN((k) + 1)) xcd_barrier_ni(bar.bar, bar.x, bar.st, TID_NOW(), (unsigned)G); } while (0)
#define PHASE_REGS \
    int tid = TID_NOW(); asm volatile("" : "+v"(tid)); \
    int bxl = bx, Gl = G; asm volatile("" : "+s"(bxl), "+s"(Gl)); (void)bxl; (void)Gl;     \
    const int lane = tid & 63, wave = __builtin_amdgcn_readfirstlane(tid >> 6), gw = bx * NWAVES + wave; \
    unsigned char* ws_ = args.ws; asm volatile("" : "+s"(ws_)); GAS unsigned char* ws = (GAS unsigned char*)ws_;     \
    float* out_ = args.out; asm volatile("" : "+s"(out_)); GAS float* out = (GAS float*)out_; \
    (void)lane; (void)gw; (void)out; \
    GAS float* H = (GAS float*)(ws + WS_H); GAS bf16* U = (GAS bf16*)(ws + WS_U); GAS bf16* P1 = (GAS bf16*)(ws + WS_P1); GAS float* MISCB = (GAS float*)(ws + WS_MISC); GAS bf16* KIB = (GAS bf16*)(ws + WS_KIB); \
    GAS bf16* XC = (GAS bf16*)(ws + WS_XC); GAS float* DT = (GAS float*)(ws + WS_DT); GAS float* DA = (GAS float*)(ws + WS_DA); GAS float* YS = (GAS float*)(ws + WS_YS); GAS bf16* YSN = (GAS bf16*)(ws + WS_YSN); \
    GAS bf16* YA = (GAS bf16*)(ws + WS_YA); GAS bf16* T1 = (GAS bf16*)(ws + WS_T1); GAS bf16* MG = (GAS bf16*)(ws + WS_MG); GAS bf16* A2 = (GAS bf16*)(ws + WS_A2); \
    GAS unsigned short* IDXP = (GAS unsigned short*)(ws + WS_IDXP); GAS int* IDXS = (GAS int*)(ws + WS_IDXS); GAS float* SCS = (GAS float*)(ws + WS_SCS); \
    GAS bf16* SB = (GAS bf16*)(ws + WS_SB); GAS float* DEC = (GAS float*)(ws + WS_DEC); GAS bf16* HC = (GAS bf16*)(ws + WS_HC); GAS bf16* KVB = (GAS bf16*)(ws + WS_KVB); GAS bf16* KIB2 = (GAS bf16*)(ws + WS_KIB2); (void)KIB2; (void)SB; (void)DEC; (void)HC; (void)KVB; \
    GAS unsigned char* wl = ws + WS_W + (size_t)l * WL_SIZE; \
    (void)H; (void)U; (void)P1; (void)MISCB; (void)KIB; (void)XC; (void)DT; (void)DA; (void)YS; (void)YSN; (void)YA; (void)T1; (void)MG; (void)A2; (void)IDXP; (void)IDXS; (void)SCS; (void)wl;
#define LDS_LOCAL LAS unsigned char* lds = lds0; asm volatile("" : "+s"(lds));
#define INP(T, name, i) const GAS T* name; { const void* p_; asm volatile("s_load_dwordx2 %0, %1, %2\n\ts_waitcnt lgkmcnt(0)" : "=s"(p_) : "s"(__builtin_amdgcn_kernarg_segment_ptr()), "i"((i) * 8)); name = (const GAS T*)p_; }

    if (IN(0) && args.l_lo == 0) {
        const int l = 0; PHASE_REGS
        LDS_LOCAL
        INP(float, w_in, 10) INP(float, w_ssm, 17) INP(float, w_att, 18) INP(float, w_out, 19) INP(float, w_up, 21) INP(float, w_down, 22) INP(float, meta, 8) INP(float, x_prompt, 0) INP(float, x_sample, 1) INP(float, norm1_w, 9)
        LAS float* scr = (LAS float*)(lds + wave * 17408);
        constexpr int I_IN = (D / 64) * (NIN / 64), I_SSM = (DIN / 64) * (D / 64), I_ATT = (D / 64) * (D / 64), I_OUT = I_ATT, I_UP = (D / 64) * (DFF / 64), I_DN = (DFF / 64) * (D / 64);
        constexpr int I_L = I_IN + I_SSM + I_ATT + I_OUT + I_UP + I_DN;
        for (int it = gw; it < 2 * I_L; it += NGW) {
            const int l = it / I_L; int r = it % I_L; GAS unsigned char* wl = ws + WS_W + (size_t)l * WL_SIZE;
            if (r < I_IN) { tr_item(w_in + (size_t)l * D * IN_DIM, D, IN_DIM, (GAS bf16*)(wl + WL_WIN), NIN / 64, true, scr, r, lane); continue; } r -= I_IN;
            if (r < I_SSM) { tr_item(w_ssm + (size_t)l * DIN * D, DIN, D, (GAS bf16*)(wl + WL_WSSM), D / 64, false, scr, r, lane); continue; } r -= I_SSM;
            if (r < I_ATT) { tr_item(w_att + (size_t)l * D * D, D, D, (GAS bf16*)(wl + WL_WATT), D / 64, false, scr, r, lane); continue; } r -= I_ATT;
            if (r < I_OUT) { tr_item(w_out + (size_t)l * D * D, D, D, (GAS bf16*)(wl + WL_WOUT), D / 64, false, scr, r, lane); continue; } r -= I_OUT;
            if (r < I_UP) { tr_item(w_up + (size_t)l * D * DFF, D, DFF, (GAS bf16*)(wl + WL_WUP), DFF / 64, false, scr, r, lane); continue; } r -= I_UP;
            tr_item(w_down + (size_t)l * DFF * D, DFF, D, (GAS bf16*)(wl + WL_WDN), D / 64, false, scr, r, lane);
        }
        for (int m0 = gw; m0 < MPAD; m0 += 4 * NGW) {
            const GAS float* src[4]; GAS float* hd[4]; GAS bf16* ud[4]; GAS float* fd[4]; bool live[4];
#pragma unroll
            for (int r = 0; r < 4; ++r) { const int m = m0 + r * NGW; live[r] = m < MPAD; src[r] = nullptr; fd[r] = nullptr; hd[r] = H + (size_t)m * D; ud[r] = U + (size_t)m * D;
                if (m < MP) { const int b = m / LP, t = m - b * LP; src[r] = t < NMETA ? meta + (size_t)t * D : x_prompt + ((size_t)b * SEQ + (t - NMETA)) * D; }
                else if (m < MR) src[r] = x_sample + (size_t)(m - MP) * D; }
            rms_rows4g(src, norm1_w, hd, ud, fd, live, lane);
        }
    }
    SEAM(0);

    for (int l = args.l_lo; l < args.l_hi; ++l) {
        constexpr int pb = 1;

        if (IN(pb + 0)) {
            PHASE_REGS
            LAS unsigned char* lds = lds0;
            pg8::Gemm gm{U, (const GAS bf16*)(wl + WL_WIN), MPAD, NIN, D}; pg8::StaticOrder S; S.init(MPAD, NIN, Gl, bxl);
            pg8::EpiIn E{P1, KVB, MISCB, KIB, KIB2, out + O_PK + (size_t)l * MP * 256, out + O_PV + (size_t)l * MP * 256, out + O_PKI + (size_t)l * MP * 64,
                         out + O_SK + (size_t)l * MS * 256, out + O_SV + (size_t)l * MS * 256, out + O_SKI + (size_t)l * MS * 64};
            pg8::gemm_phase<pg8::EpiIn, pg8::StaticOrder, true, true>(lds, gm, S, E, tid);
        }
        SEAM(pb + 0);

        if (IN(pb + 1)) {
            PHASE_REGS
            LDS_LOCAL
            INP(float, state_conv, 6) INP(float, conv_b, 12) INP(float, conv_w, 11) INP(float, dt_bias, 13) INP(float, a_log, 14) INP(float, cache_ki, 4) INP(int, page_table, 7)
            for (int rp_ = 0; rp_ < REP_CONV; ++rp_) for (int it = bx * NT + tid; it < (MR / 8) * 384; it += G * NT) {
                const int rg = it / 384, c8 = (it % 384) * 8, m0 = 8 * rg;
                const bool isS = m0 >= MP; int tpos, sq;
                if (!isS) { sq = m0 / LP; tpos = m0 - sq * LP; } else { sq = (m0 - MP) >> 3; tpos = (m0 - MP) & 7; }
                float xv[11][8];
#pragma unroll
                for (int k = 0; k < 11; ++k) { const int dtp = tpos - 3 + k;
                    if (dtp >= 0) unpack8(*(const GAS v4u*)(P1 + (size_t)(m0 - 3 + k) * LDP1 + C_XBC + c8), xv[k]);
                    else if (isS) { const GAS float* pp = state_conv + ((size_t)(l * DB + sq) * 3 + (3 + dtp)) * CONVD + c8; const f32x4 a = *(const GAS f32x4*)pp, b = *(const GAS f32x4*)(pp + 4);
                        xv[k][0] = a.x; xv[k][1] = a.y; xv[k][2] = a.z; xv[k][3] = a.w; xv[k][4] = b.x; xv[k][5] = b.y; xv[k][6] = b.z; xv[k][7] = b.w; }
                    else {
#pragma unroll
                        for (int j = 0; j < 8; ++j) xv[k][j] = 0.f; } }
                float wv[4][8], bv[8];
                { const GAS float* bp = conv_b + (size_t)l * CONVD + c8; const f32x4 a = *(const GAS f32x4*)bp, b = *(const GAS f32x4*)(bp + 4);
                  bv[0] = a.x; bv[1] = a.y; bv[2] = a.z; bv[3] = a.w; bv[4] = b.x; bv[5] = b.y; bv[6] = b.z; bv[7] = b.w; }
#pragma unroll
                for (int k = 0; k < 4; ++k) { const GAS float* wp = conv_w + ((size_t)l * 4 + k) * CONVD + c8; const f32x4 a = *(const GAS f32x4*)wp, b = *(const GAS f32x4*)(wp + 4);
                    wv[k][0] = a.x; wv[k][1] = a.y; wv[k][2] = a.z; wv[k][3] = a.w; wv[k][4] = b.x; wv[k][5] = b.y; wv[k][6] = b.z; wv[k][7] = b.w; }
#pragma unroll
                for (int r = 0; r < 8; ++r) {
                    float y[8];
#pragma unroll
                    for (int j = 0; j < 8; ++j) { float s = bv[j];
#pragma unroll
                        for (int k = 0; k < 4; ++k) s += xv[r + k][j] * wv[k][j];
                        y[j] = s * sigm(s); }
                    *(GAS v4u*)(XC + (size_t)(m0 + r) * CONVD + c8) = (v4u){pk2(y[0], y[1]), pk2(y[2], y[3]), pk2(y[4], y[5]), pk2(y[6], y[7])};
                    const int tp = tpos + r; GAS float* cs = nullptr;
                    if (!isS && tp >= LP - 3) cs = out + O_PCONV + ((size_t)(l * NB + sq) * 3 + (tp - (LP - 3))) * CONVD + c8;
                    if (isS && tp >= DS - 3) cs = out + O_SCONV + ((size_t)(l * DB + sq) * 3 + (tp - (DS - 3))) * CONVD + c8;
                    if (cs) { *(GAS f32x4*)cs = (f32x4){xv[r + 3][0], xv[r + 3][1], xv[r + 3][2], xv[r + 3][3]}; *(GAS f32x4*)(cs + 4) = (f32x4){xv[r + 3][4], xv[r + 3][5], xv[r + 3][6], xv[r + 3][7]}; }
                }
            }
            for (int it = bx * NT + tid; it < MR * NH; it += G * NT) {
                const int m = it >> 5, h = it & 31;
                const float raw = MISCB[(size_t)m * 128 + MC_DT + h] + dt_bias[l * NH + h];
                const float sp = fmaxf(raw, 0.f) + log1pf(__expf(-fabsf(raw)));
                const float A = -__expf(a_log[l * NH + h]);
                DT[it] = sp; DA[it] = __expf(sp * A);
            }
            for (int rp_ = 0; rp_ < REP_TOPK; ++rp_) {
                constexpr int SLD = 4352;
                LAS unsigned* scl = (LAS unsigned*)lds; LAS unsigned* histq = (LAS unsigned*)(lds + 8 * SLD * 4);
                for (int j = 0; ; ++j) {
                    const int unit = j * G + ((j & 1) ? (G - 1 - bx) : bx); if (unit >= NB * (LP / 8)) break;
                    const int b = unit & (NB - 1), qb = (LP / 8 - 1) - (unit >> 2);
                    const size_t mq0 = (size_t)b * LP + 8 * qb; const int nkeys = 8 * qb + 8, ntl = (nkeys + 31) >> 5;
                    bf16x8 afr[2][4]; float wq[2][2][8];
                    idx_load_q(P1, MISCB, mq0, lane, afr, wq);
                    const int kcol = lane & 31, hh = lane >> 5;
                    for (int rs_ = 0; rs_ < REP_SCORE; ++rs_) {
                    if (rs_) __syncthreads();
                    for (int i = tid; i < 8 * HB; i += NT) histq[i] = 0u;
                    __syncthreads();
                    const GAS bf16* kp0 = KIB2 + (size_t)b * KT_PER_B * 2048 + lane * 8;
                    bf16x8 ks0[4], ks1[4], ks2[4];
#pragma unroll
                    for (int ks = 0; ks < 4; ++ks) { ks0[ks] = (bf16x8){0, 0, 0, 0, 0, 0, 0, 0}; ks1[ks] = ks0[ks]; ks2[ks] = ks0[ks]; }
#define SC_LOAD(S, T) { _Pragma("unroll") for (int ks = 0; ks < 4; ++ks) S[ks] = *(const GAS bf16x8*)(kp0 + (size_t)(T) * 2048 + 512 * ks); }
#define SC_TILE(S, KT, LOADC) { \
                        f32x16 a0 = {}, a1 = {}; \
                        _Pragma("unroll") for (int ks = 0; ks < 4; ++ks) { a0 = __builtin_amdgcn_mfma_f32_32x32x16_bf16(afr[0][ks], S[ks], a0, 0, 0, 0); a1 = __builtin_amdgcn_mfma_f32_32x32x16_bf16(afr[1][ks], S[ks], a1, 0, 0, 0); } \
                        asm volatile("" : "+v"(a0), "+v"(a1) :: "memory");        \
                        if (LOADC) SC_LOAD(S, (KT) + 3 * NWAVES) \
                        const int key = 32 * (KT) + kcol; \
                        _Pragma("unroll") for (int rt = 0; rt < 2; ++rt) \
                        _Pragma("unroll") for (int jq = 0; jq < 2; ++jq) { const int q = 4 * rt + 2 * hh + jq; const float sv = idx_reduce(rt ? a1 : a0, 8 * jq, wq[rt][jq]); \
                            scl[q * SLD + key] = f2key(sv); \
                            int bn; asm("v_cvt_flr_i32_f32 %0, %1" : "=v"(bn) : "v"(sv * 64.0f)); bn = min(max(bn + 256, 0), HB - 1); \
                            if (SC_ATOM) __hip_atomic_fetch_add(histq + q * HB + bn, key <= 8 * qb + q ? 1u : 0u, __ATOMIC_RELAXED, __HIP_MEMORY_SCOPE_WORKGROUP); } }
                    const bool SC_ATOM = REP_SCORE_AT || rs_ == REP_SCORE - 1;
                    int kt = wave;
                    if (kt + 5 * NWAVES < ntl) {
                        SC_LOAD(ks0, wave) SC_LOAD(ks1, wave + NWAVES) SC_LOAD(ks2, wave + 2 * NWAVES)
                        do { SC_TILE(ks0, kt, true) SC_TILE(ks1, kt + NWAVES, true) SC_TILE(ks2, kt + 2 * NWAVES, true) kt += 3 * NWAVES; } while (kt + 5 * NWAVES < ntl);
                    } else {
                        if (wave < ntl) SC_LOAD(ks0, wave)
                        if (wave + NWAVES < ntl) SC_LOAD(ks1, wave + NWAVES)
                        if (wave + 2 * NWAVES < ntl) SC_LOAD(ks2, wave + 2 * NWAVES)
                    }
                    for (; kt < ntl; kt += 3 * NWAVES) {
                        SC_TILE(ks0, kt, kt + 3 * NWAVES < ntl)
                        if (kt + NWAVES < ntl) SC_TILE(ks1, kt + NWAVES, kt + 4 * NWAVES < ntl)
                        if (kt + 2 * NWAVES < ntl) SC_TILE(ks2, kt + 2 * NWAVES, kt + 5 * NWAVES < ntl)
                    }
#undef SC_TILE
#undef SC_LOAD
                    }
                    __syncthreads();
                    for (int r2_ = 0; r2_ < REP_SEL; ++r2_) { const int t = 8 * qb + wave, n = t + 1; GAS unsigned short* op = IDXP + ((size_t)b * LP + t) * 256;
                      if (n <= 256) { for (int i = lane; i < n; i += 64) op[i] = (unsigned short)i; }
                      else topk_select(scl + wave * SLD, n, lane, op, histq + wave * HB); }
                    __syncthreads();
                }
            }
            const GAS float* cki = cache_ki + (size_t)l * NPOOL * PAGE * 64;
            for (int rp_ = 0; rp_ < REP_SSC; ++rp_) for (int unit = bx; unit < DB * 8; unit += G) {
                const int bd = unit >> 3, ch = unit & 7; const size_t mq0 = (size_t)MP + bd * DS;
                bf16x8 afr[2][4]; float wq[2][2][8];
                idx_load_q(P1, MISCB, mq0, lane, afr, wq);
                const int kcol = lane & 31, hh = lane >> 5;
                const int pg = 8 * ch + wave, phys = page_table[bd * NPAGES + pg];
                const GAS float* kbase = cki + (size_t)phys * PAGE * 64;
#pragma unroll 1
                for (int kt = 0; kt < 4; ++kt) {
                    const int kin = 32 * kt + kcol; const GAS float* kp = kbase + (size_t)kin * 64 + 8 * hh;
                    bf16x8 bfr[4];
#pragma unroll
                    for (int ks = 0; ks < 4; ++ks) { const f32x4 a = *(const GAS f32x4*)(kp + 16 * ks), bq = *(const GAS f32x4*)(kp + 16 * ks + 4);
                        const v4u w = (v4u){pk2(a.x, a.y), pk2(a.z, a.w), pk2(bq.x, bq.y), pk2(bq.z, bq.w)}; bfr[ks] = __builtin_bit_cast(bf16x8, w); }
                    float sc[2][2];
                    idx_scores(afr, bfr, wq, sc);
#pragma unroll
                    for (int rt = 0; rt < 2; ++rt)
#pragma unroll
                        for (int jq = 0; jq < 2; ++jq) SCS[(size_t)(bd * DS + 4 * rt + 2 * hh + jq) * SCS_LD + 128 * pg + kin] = sc[rt][jq];
                }
                if (ch == 7 && wave == 0) {
                    const int j = kcol < DS ? kcol : DS - 1; const GAS bf16* kp = KIB + (mq0 + j) * 64 + 8 * hh;
                    bf16x8 bfr[4];
#pragma unroll
                    for (int ks = 0; ks < 4; ++ks) bfr[ks] = *(const GAS bf16x8*)(kp + 16 * ks);
                    float sc[2][2];
                    idx_scores(afr, bfr, wq, sc);
                    if (kcol < DS) {
#pragma unroll
                        for (int rt = 0; rt < 2; ++rt)
#pragma unroll
                            for (int jq = 0; jq < 2; ++jq) { const int q = 4 * rt + 2 * hh + jq; SCS[(size_t)(bd * DS + q) * SCS_LD + PAST + kcol] = (kcol <= q) ? sc[rt][jq] : -INFINITY; }
                    }
                }
            }
        }
        SEAM(pb + 1);

        if (IN(pb + 2)) {
            PHASE_REGS
            LDS_LOCAL
            INP(float, a_log, 14) INP(float, state_ssm, 5) INP(float, d_skip, 15)
            for (int rp_ = 0; rp_ < REP_SSEL; ++rp_) for (int qi = bx; qi < MS; qi += G) {
                LAS unsigned* scl = (LAS unsigned*)lds; LAS unsigned* hs = (LAS unsigned*)(lds + 8448 * 4);
                hs[tid] = 0u;
                __syncthreads();
                for (int i = tid; i < PAST + DS; i += NT) { const float sc = SCS[(size_t)qi * SCS_LD + i]; scl[i] = f2key(sc);
                    int bn = __float2int_rd(fmaxf(sc, -8.0f) * 64.0f) + 256; bn = bn < 0 ? 0 : (bn > HB - 1 ? HB - 1 : bn);
                    __hip_atomic_fetch_add(hs + bn, 1u, __ATOMIC_RELAXED, __HIP_MEMORY_SCOPE_WORKGROUP); }
                __syncthreads();
                if (wave == 0) { int ns = PAST + DS; asm volatile("" : "+s"(ns)); topk_select(scl, ns, lane, IDXS + qi * 256, hs); }
                __syncthreads();
            }
            for (int rp_ = 0; rp_ < REP_SSD1; ++rp_) for (int unit = bx; unit < NB * NCH * NG; unit += G) {
                int b, c, g; if (unit < NB * 32 * NG) { b = unit >> 7; c = 1 + ((unit & 127) >> 2); g = unit & 3; } else { const int r = unit - NB * 32 * NG; b = r >> 2; c = 0; g = r & 3; }
                ssd1_unit(lds, tid, XC, DT, a_log + l * NH, SB, DEC, b, c, g);
            }
            for (int rp_ = 0; rp_ < REP_SREC; ++rp_) for (int unit = bx; unit < DB * NH * 2; unit += G) {
                const int bd = unit >> 6, h = (unit >> 1) & 31, p0 = (unit & 1) * 32;
                ssd_unit(lds, tid, XC, DT, DA, (size_t)MP + bd * DS, DS, h, p0, state_ssm + ((size_t)(l * DB + bd) * NH + h) * HP * NST,
                         out + O_SSSM + ((size_t)(l * DB + bd) * NH + h) * HP * NST, YS, d_skip[l * NH + h]);
                __syncthreads();
            }
        }
        SEAM(pb + 2);

        if (IN(pb + 3)) {
            PHASE_REGS
            LDS_LOCAL
            INP(float, cache_k, 2) INP(float, cache_v, 3) INP(int, page_table, 7)
            for (int rp_ = 0; rp_ < REP_SCAN; ++rp_) for (int e = bx * NT + tid; e < NB * NH * 2048; e += G * NT) {
                const int b = e / (NH * 2048), h = (e >> 11) & 31, q = e & 2047;
                f32x4 Hr = {0.f, 0.f, 0.f, 0.f};
#pragma unroll 3
                for (int c = 0; c < NCH; ++c) { const size_t idx = (size_t)(b * NCH + c) * NH + h;
                    { const int p = q >> 5, n = (q & 31) * 4;
                      *(GAS v2u*)(HC + idx * (HP * NST) + ((((p >> 5) * 8 + (n >> 4)) * 2 + ((n >> 3) & 1)) * 32 + (p & 31)) * 8 + (n & 7)) = (v2u){pk2(Hr.x, Hr.y), pk2(Hr.z, Hr.w)}; }
                    const float d = DEC[idx]; const v2u sw = *(const GAS v2u*)(SB + idx * (HP * NST) + q * 4);
                    const f32x4 sv = (f32x4){__uint_as_float(sw.x << 16), __uint_as_float(sw.x & 0xffff0000u), __uint_as_float(sw.y << 16), __uint_as_float(sw.y & 0xffff0000u)};
                    Hr = Hr * d + sv; }
                *(GAS f32x4*)(out + O_PSSM + ((size_t)(l * NB + b) * NH + h) * (HP * NST) + q * 4) = Hr;
            }
            const GAS float* ck = cache_k + (size_t)l * NPOOL * PAGE * 256; const GAS float* cv = cache_v + (size_t)l * NPOOL * PAGE * 256;
            for (int rp_ = 0; rp_ < REP_ATTS; ++rp_) for (int qi = bx; qi < MS; qi += G) attn_sample_query(lds, tid, P1, KVB, ck, cv, page_table, IDXS, YA, qi);
            for (int rp_ = 0; rp_ < REP_ATTP; ++rp_) {
                if (Gl == 256) {
                    const int bsel = (bxl & 7) >> 1, widx = ((((bxl >> 3) * NWAVES) + wave) << 1) | (bxl & 1);
                    for (int tr = widx; tr < LP; tr += 512) attn_prompt_query(lds + wave * 17408, P1, KVB, IDXP, YA, bsel * LP + (LP - 1 - tr), lane);
                } else for (int m = gw; m < MP; m += NGW) attn_prompt_query(lds + wave * 17408, P1, KVB, IDXP, YA, m, lane);
            }
        }
        SEAM(pb + 3);

        if (IN(pb + 4)) {
            PHASE_REGS
            LDS_LOCAL
            INP(float, a_log, 14) INP(float, d_skip, 15) INP(float, ssm_norm_w, 16)
            for (int rp_ = 0; rp_ < REP_SSD3; ++rp_) for (int unit = bx; unit < NB * NCH * NG; unit += G) {
                int b, c, g; if (unit < NB * 32 * NG) { b = unit >> 7; c = 1 + ((unit & 127) >> 2); g = unit & 3; } else { const int r = unit - NB * 32 * NG; b = r >> 2; c = 0; g = r & 3; }
                ssd3_unit(lds, tid, XC, P1, DT, a_log + l * NH, d_skip + l * NH, ssm_norm_w + (size_t)l * DIN, HC, YSN, b, c, g);
            }
            for (int it = gw; it < MS * NG; it += NGW) {
                const int m = MP + (it >> 2), g = it & 3, c0 = g * 512 + lane * 8;
                const GAS float* yp = YS + (size_t)m * DIN + c0; const f32x4 a = *(const GAS f32x4*)yp, b = *(const GAS f32x4*)(yp + 4);
                float z[8]; unpack8(*(const GAS v4u*)(P1 + (size_t)m * LDP1 + C_Z + c0), z);
                float v[8] = {a.x, a.y, a.z, a.w, b.x, b.y, b.z, b.w}; float ss = 0.f;
#pragma unroll
                for (int j = 0; j < 8; ++j) { v[j] = v[j] * (z[j] * sigm(z[j])); ss += v[j] * v[j]; }
                ss = wave_sum(ss);
                const float rstd = 1.0f / sqrtf(ss * (1.0f / 512.0f) + 1e-6f);
                const GAS float* wp = ssm_norm_w + (size_t)l * DIN + c0; const f32x4 wa = *(const GAS f32x4*)wp, wb = *(const GAS f32x4*)(wp + 4);
                *(GAS v4u*)(YSN + (size_t)m * DIN + c0) = (v4u){pk2(v[0] * rstd * wa.x, v[1] * rstd * wa.y), pk2(v[2] * rstd * wa.z, v[3] * rstd * wa.w), pk2(v[4] * rstd * wb.x, v[5] * rstd * wb.y), pk2(v[6] * rstd * wb.z, v[7] * rstd * wb.w)};
            }
        }
        SEAM(pb + 4);

        if (IN(pb + 5)) {
            PHASE_REGS
            LAS unsigned char* lds = lds0;
            pg8::Gemm gm{YSN, (const GAS bf16*)(wl + WL_WSSM), TAIL_R0, D, DIN}; pg8::StaticOrder S; S.init(TAIL_R0, D, Gl, bxl);
            pg8::EpiGate1 E{P1, T1};
            pg8::gemm_phase<pg8::EpiGate1, pg8::StaticOrder, true, true>(lds, gm, S, E, tid);
            tail_gemm<1>(lds, YSN, DIN, (const GAS bf16*)(wl + WL_WSSM), D, P1, T1, MG, H, A2, bxl, Gl, tid);
        }
        if (IN(pb + 6)) {
            PHASE_REGS
            LAS unsigned char* lds = lds0;
            pg8::Gemm gm{YA, (const GAS bf16*)(wl + WL_WATT), TAIL_R0, D, D}; pg8::StaticOrder S; S.init(TAIL_R0, D, Gl, bxl);
            pg8::EpiGate2 E{P1, T1, MG};
            pg8::gemm_phase<pg8::EpiGate2, pg8::StaticOrder, true, true>(lds, gm, S, E, tid);
            tail_gemm<2>(lds, YA, D, (const GAS bf16*)(wl + WL_WATT), D, P1, T1, MG, H, A2, bxl, Gl, tid);
        }
        SEAM(pb + 6);
        if (IN(pb + 7)) {
            PHASE_REGS
            LAS unsigned char* lds = lds0;
            pg8::Gemm gm{MG, (const GAS bf16*)(wl + WL_WOUT), TAIL_R0, D, D}; pg8::StaticOrder S; S.init(TAIL_R0, D, Gl, bxl);
            pg8::EpiResid E{H};
            pg8::gemm_phase<pg8::EpiResid, pg8::StaticOrder, true, true>(lds, gm, S, E, tid);
            tail_gemm<3>(lds, MG, D, (const GAS bf16*)(wl + WL_WOUT), D, P1, T1, MG, H, A2, bxl, Gl, tid);
        }
        SEAM(pb + 7);
        if (IN(pb + 8)) {
            PHASE_REGS
            INP(float, norm2_w, 20)
            for (int m = gw; m < MPAD; m += 4 * NGW) rms_rows4(H, norm2_w + (size_t)l * D, U, m, NGW, MPAD, lane);
        }
        SEAM(pb + 8);
        if (IN(pb + 9)) {
            PHASE_REGS
            LAS unsigned char* lds = lds0;
            pg8::Gemm gm{U, (const GAS bf16*)(wl + WL_WUP), TAIL_R0, DFF, D}; pg8::StaticOrder S; S.init(TAIL_R0, DFF, Gl, bxl);
            pg8::EpiUp E{A2};
            pg8::gemm_phase<pg8::EpiUp, pg8::StaticOrder, true, true>(lds, gm, S, E, tid);
            tail_gemm<4>(lds, U, D, (const GAS bf16*)(wl + WL_WUP), DFF, P1, T1, MG, H, A2, bxl, Gl, tid);
        }
        SEAM(pb + 9);
        if (IN(pb + 10)) {
            PHASE_REGS
            LAS unsigned char* lds = lds0;
            pg8::Gemm gm{A2, (const GAS bf16*)(wl + WL_WDN), TAIL_R0, D, DFF}; pg8::StaticOrder S; S.init(TAIL_R0, D, Gl, bxl);
            pg8::EpiResid E{H};
            pg8::gemm_phase<pg8::EpiResid, pg8::StaticOrder, true, true>(lds, gm, S, E, tid);
            tail_gemm<3>(lds, A2, DFF, (const GAS bf16*)(wl + WL_WDN), D, P1, T1, MG, H, A2, bxl, Gl, tid);
        }
        SEAM(pb + 10);
        if (IN(pb + 11)) {
            PHASE_REGS
            INP(float, norm1_w, 9) INP(float, final_w, 23)
            if (l == 0) { for (int m = gw; m < MPAD; m += 4 * NGW) rms_rows4(H, norm1_w + D, U, m, NGW, MPAD, lane); }
            else {
                for (int m0 = gw; m0 < MR; m0 += 4 * NGW) {
                    const GAS float* src[4]; GAS float* hd[4]; GAS bf16* ud[4]; GAS float* fd[4]; bool live[4];
#pragma unroll
                    for (int r = 0; r < 4; ++r) { const int m = m0 + r * NGW; hd[r] = nullptr; ud[r] = nullptr; fd[r] = nullptr; src[r] = H + (size_t)(m < MR ? m : m0) * D;
                        if (m < MP) { const int b = m / LP, t = m - b * LP; if (t >= NMETA) fd[r] = out + O_YP + ((size_t)b * SEQ + (t - NMETA)) * D; }
                        else if (m < MR) fd[r] = out + O_YS + (size_t)(m - MP) * D;
                        live[r] = fd[r] != nullptr; }
                    rms_rows4g(src, final_w, hd, ud, fd, live, lane);
                }
            }
        }
        if (IN(pb + 11) && IN(1) && l + 1 < args.l_hi) xcd_barrier_ni(bar.bar, bar.x, bar.st, TID_NOW(), (unsigned)G);
    }
#undef IN
#undef SEAM
}

#ifndef MK_PER_PHASE
#define MK_PER_PHASE 0
#endif
extern "C" void kernel_launch(void* const* d_in, const int* in_sizes, int n_in, void* d_out, int out_size, void* d_ws, size_t ws_size, hipStream_t stream) {
    static int grid = 0;
    if (grid == 0) {
        if (n_in != 24 || (size_t)out_size != O_END || ws_size < WS_END) { fprintf(stderr, "kernel_launch: unexpected shapes: n_in %d out %d (want %zu) ws %zu (want %zu)\n", n_in, out_size, (size_t)O_END, ws_size, (size_t)WS_END); grid = -1; return; }
        int dev = 0, cus = 0, per_cu = 0;
        if (hipGetDevice(&dev) != hipSuccess || hipDeviceGetAttribute(&cus, hipDeviceAttributeMultiprocessorCount, dev) != hipSuccess) { grid = -1; return; }
        bool ok = true;
#if MK_PER_PHASE
#define SETA(K) ok = ok && hipFuncSetAttribute((const void*)fwd_t<K, K + 1>, hipFuncAttributeMaxDynamicSharedMemorySize, LDS_BYTES) == hipSuccess
        SETA(0); SETA(1); SETA(2); SETA(3); SETA(4); SETA(5); SETA(6); SETA(7); SETA(8); SETA(9); SETA(10); SETA(11); SETA(12);
#else
        ok = hipFuncSetAttribute((const void*)fwd_t<0, NPH + 1>, hipFuncAttributeMaxDynamicSharedMemorySize, LDS_BYTES) == hipSuccess;
        ok = ok && hipOccupancyMaxActiveBlocksPerMultiprocessor(&per_cu, (const void*)fwd_t<0, NPH + 1>, NT, LDS_BYTES) == hipSuccess && per_cu >= 1;
#endif
        if (!ok) { fprintf(stderr, "kernel_launch: hipFuncSetAttribute / occupancy query failed (per_cu %d)\n", per_cu); (void)hipGetLastError(); grid = -1; return; }
        grid = cus;
    }
    if (grid < 0) return;
    (void)hipMemsetAsync((char*)d_ws + WS_CTL, 0, CTL_ZERO_BYTES, stream);
    Args a{};
    for (int i = 0; i < 24; ++i) a.in[i] = d_in[i];
    a.out = (float*)d_out; a.ws = (unsigned char*)d_ws;
#if MK_PER_PHASE
#define LAUNCH_PH(K) hipLaunchKernelGGL((fwd_t<K, K + 1>), dim3(grid), dim3(NT), LDS_BYTES, stream, a)
    a.l_lo = 0; a.l_hi = 1; LAUNCH_PH(0);
    for (int l = 0; l < 2; ++l) { a.l_lo = l; a.l_hi = l + 1;
        LAUNCH_PH(1); LAUNCH_PH(2); LAUNCH_PH(3); LAUNCH_PH(4); LAUNCH_PH(5); LAUNCH_PH(6); LAUNCH_PH(7); LAUNCH_PH(8); LAUNCH_PH(9); LAUNCH_PH(10); LAUNCH_PH(11); LAUNCH_PH(12); }
#else
    a.l_lo = 0; a.l_hi = 2; hipLaunchKernelGGL((fwd_t<0, NPH + 1>), dim3(grid), dim3(NT), LDS_BYTES, stream, a);
#endif
}
```

```cpp
#include <hip/hip_runtime.h>
#include <cstdio>
#include <cstdint>
#define GAS __attribute__((address_space(1)))
#define LAS __attribute__((address_space(3)))

constexpr int D = 1024, NB = 4, SEQ = 4096, NMETA = 16, LP = SEQ + NMETA, MP = NB * LP, DB = 32, DS = 8, MS = DB * DS, MR = MP + MS, MPAD = 16896;
constexpr int DIN = 2048, CONVD = 3072, NH = 32, HP = 64, NG = 4, NST = 128;
constexpr int DFF = 4096, IN_DIM = 9320;
constexpr int PAST = 8192, PAGE = 128, NPAGES = 64, NPOOL = 2560;
constexpr int NIN = 9472, LDP1 = 9216;
constexpr int C_Z = 0, C_XBC = 2048, C_Q = 5120, C_K = 6144, C_V = 6400, C_QI = 6656, C_GS = 7168, C_GA = 8192;
constexpr int MC_KI = 0, MC_DT = 64, MC_WI = 96;
constexpr int KT_PER_B = (LP + 31) / 32;
static_assert(MP == 16448 && MR == 16704 && MPAD % 256 == 0 && MPAD >= MR, "rows");
namespace pg8 {
#define PG8_LAS __attribute__((address_space(3)))
typedef unsigned short bf16_t;
typedef short bf16x8 __attribute__((ext_vector_type(8)));
typedef float f32x4 __attribute__((ext_vector_type(4)));
typedef unsigned u32x4 __attribute__((ext_vector_type(4)));
constexpr int BM = 256, BK = 64, HALF = 128, HTB = HALF * BK * 2  , STAGE_BYTES = 8 * HTB, NXCD = 8, WGM = 8;

__host__ __device__ __forceinline__ int lds_byte(int r, int c) { const int st = (r >> 4) * 2 + (c >> 5), rr = r & 15, cc = c & 31, ob = rr * 64 + cc * 2; return st * 1024 + (ob ^ (((ob >> 9) & 1) << 5)); }
__host__ __device__ __forceinline__ void stage_rc(int b, int& R, int& C) { const int st = b / 1024, sb = b % 1024, swz = sb ^ (((sb >> 9) & 1) << 5); R = (st >> 1) * 16 + swz / 64; C = (st & 1) * 32 + (swz % 64) / 2; }
__host__ __device__ __forceinline__ int perm32(int rho) { const int n = rho >> 4, i = rho & 15; return 8 * (i >> 2) + 4 * n + (i & 3); }

struct Unit { int pm, pn; };
struct Gemm { const GAS bf16_t* A; const GAS bf16_t* Bt; int M, N, K; };

struct StaticOrder {
    int nM, nN, nwg, G, c;
    __host__ __device__ void init(int M, int N, int G_, int c_) { nM = M / BM; nN = N / BM; nwg = nM * nN; G = G_; c = c_; }
    __host__ __device__ bool next(int i, Unit& u) const {
        const long L = (long)i * G + c; if (L >= nwg) return false;
        int wgid = (int)L; { const int q = nwg / NXCD, r = nwg % NXCD, xcd = wgid % NXCD, off = wgid / NXCD; wgid = (xcd < r ? xcd * (q + 1) : r * (q + 1) + (xcd - r) * q) + off; }
        const int nig = WGM * nN, gid = wgid / nig, fm = gid * WGM, gsz = (nM - fm) < WGM ? (nM - fm) : WGM;
        u.pm = fm + ((wgid % nig) % gsz); u.pn = (wgid % nig) / gsz; return true;
    }
    __device__ __forceinline__ void a_ready(const Unit&) const {}
    __device__ __forceinline__ void done(const Unit&) const {}
};

__device__ __forceinline__ unsigned cvt_pk_bf16(float lo, float hi) { unsigned r; asm volatile("v_cvt_pk_bf16_f32 %0, %1, %2" : "=v"(r) : "v"(lo), "v"(hi)); return r; }

__device__ __forceinline__ void unpack8(const u32x4 w, float (&f)[8]) {
    f[0] = __uint_as_float(w.x << 16); f[1] = __uint_as_float(w.x & 0xffff0000u); f[2] = __uint_as_float(w.y << 16); f[3] = __uint_as_float(w.y & 0xffff0000u);
    f[4] = __uint_as_float(w.z << 16); f[5] = __uint_as_float(w.z & 0xffff0000u); f[6] = __uint_as_float(w.w << 16); f[7] = __uint_as_float(w.w & 0xffff0000u);
}
__device__ __forceinline__ u32x4 pack8(const f32x4 v0, const f32x4 v1) { u32x4 w; w.x = cvt_pk_bf16(v0[0], v0[1]); w.y = cvt_pk_bf16(v0[2], v0[3]); w.z = cvt_pk_bf16(v1[0], v1[1]); w.w = cvt_pk_bf16(v1[2], v1[3]); return w; }
__device__ __forceinline__ float sigm(float x) { return __builtin_amdgcn_rcpf(1.0f + __expf(-x)); }

struct EpiIn {
    static constexpr bool PERM = true, AFTER_DRAIN = false;
    GAS bf16_t* P1; GAS bf16_t* kvb; GAS float* misc; GAS bf16_t* kib; GAS bf16_t* kib2; GAS float *pk, *pv, *pki, *sk, *sv, *ski;
    __device__ __forceinline__ void operator()(const f32x4 (&acc)[2][2][4][2], const Unit& u, int wr, int wc, int fr, int fq) const {
        const int row0 = u.pm * BM + wr * 64 + fr, lc0 = wc * 32 + 8 * fq;
#pragma unroll
        for (int ai = 0; ai < 2; ++ai)
#pragma unroll
            for (int m = 0; m < 4; ++m) {
                const int row = row0 + ai * HALF + m * 16;
#pragma unroll
                for (int bj = 0; bj < 2; ++bj) {
                    const f32x4 v0 = acc[ai][bj][m][0], v1 = acc[ai][bj][m][1];
                    const int lc = lc0 + bj * HALF;
                    if (u.pn < 36) {
                        if (u.pn == 24 || u.pn == 25) *(GAS u32x4*)(kvb + (size_t)row * 512 + (u.pn - 24) * BM + lc) = pack8(v0, v1);
                        else *(GAS u32x4*)(P1 + (size_t)row * LDP1 + u.pn * BM + lc) = pack8(v0, v1);
                        if (u.pn == 24) {
                            if (row < MP) { GAS float* dst = pk + (size_t)row * 256 + lc; *(GAS f32x4*)dst = v0; *(GAS f32x4*)(dst + 4) = v1; }
                            else if (row < MR) { GAS float* dst = sk + (size_t)(row - MP) * 256 + lc; *(GAS f32x4*)dst = v0; *(GAS f32x4*)(dst + 4) = v1; }
                        } else if (u.pn == 25) {
                            if (row < MP) { GAS float* dst = pv + (size_t)row * 256 + lc; *(GAS f32x4*)dst = v0; *(GAS f32x4*)(dst + 4) = v1; }
                            else if (row < MR) { GAS float* dst = sv + (size_t)(row - MP) * 256 + lc; *(GAS f32x4*)dst = v0; *(GAS f32x4*)(dst + 4) = v1; }
                        }
                    } else {
                        if (lc < 128) { GAS float* d = misc + (size_t)row * 128 + lc; *(GAS f32x4*)d = v0; *(GAS f32x4*)(d + 4) = v1; }
                        if (lc < 64) {
                            *(GAS u32x4*)(kib + (size_t)row * 64 + lc) = pack8(v0, v1);
                            if (row < MP) { const int b = row / LP, t = row - b * LP;
                                *(GAS u32x4*)(kib2 + ((size_t)(b * KT_PER_B + (t >> 5)) * 2048 + (lc >> 4) * 512 + ((lc >> 3) & 1) * 256 + (t & 31) * 8)) = pack8(v0, v1); }
                            if (row < MP) { GAS float* dst = pki + (size_t)row * 64 + lc; *(GAS f32x4*)dst = v0; *(GAS f32x4*)(dst + 4) = v1; }
                            else if (row < MR) { GAS float* dst = ski + (size_t)(row - MP) * 64 + lc; *(GAS f32x4*)dst = v0; *(GAS f32x4*)(dst + 4) = v1; }
                        }
                    }
                }
            }
    }
};
struct EpiGate1 {
    static constexpr bool PERM = true, AFTER_DRAIN = false;
    const GAS bf16_t* P1; GAS bf16_t* T1;
    __device__ __forceinline__ void operator()(const f32x4 (&acc)[2][2][4][2], const Unit& u, int wr, int wc, int fr, int fq) const {
        const int row0 = u.pm * BM + wr * 64 + fr, col0 = u.pn * BM + wc * 32 + 8 * fq;
#pragma unroll
        for (int ai = 0; ai < 2; ++ai)
#pragma unroll
            for (int m = 0; m < 4; ++m) {
                const int row = row0 + ai * HALF + m * 16;
#pragma unroll
                for (int bj = 0; bj < 2; ++bj) {
                    const int col = col0 + bj * HALF;
                    float g[8]; unpack8(*(const GAS u32x4*)(P1 + (size_t)row * LDP1 + C_GS + col), g);
                    f32x4 v0 = acc[ai][bj][m][0], v1 = acc[ai][bj][m][1];
#pragma unroll
                    for (int e = 0; e < 4; ++e) { v0[e] *= sigm(g[e]); v1[e] *= sigm(g[4 + e]); }
                    *(GAS u32x4*)(T1 + (size_t)row * 1024 + col) = pack8(v0, v1);
                }
            }
    }
};
struct EpiGate2 {
    static constexpr bool PERM = true, AFTER_DRAIN = false;
    const GAS bf16_t* P1; const GAS bf16_t* T1; GAS bf16_t* MG;
    __device__ __forceinline__ void operator()(const f32x4 (&acc)[2][2][4][2], const Unit& u, int wr, int wc, int fr, int fq) const {
        const int row0 = u.pm * BM + wr * 64 + fr, col0 = u.pn * BM + wc * 32 + 8 * fq;
#pragma unroll
        for (int ai = 0; ai < 2; ++ai)
#pragma unroll
            for (int m = 0; m < 4; ++m) {
                const int row = row0 + ai * HALF + m * 16;
#pragma unroll
                for (int bj = 0; bj < 2; ++bj) {
                    const int col = col0 + bj * HALF;
                    float g[8]; unpack8(*(const GAS u32x4*)(P1 + (size_t)row * LDP1 + C_GA + col), g);
                    float tt[8]; unpack8(*(const GAS u32x4*)(T1 + (size_t)row * 1024 + col), tt); const f32x4 t0 = (f32x4){tt[0], tt[1], tt[2], tt[3]}, t1 = (f32x4){tt[4], tt[5], tt[6], tt[7]};
                    f32x4 v0 = acc[ai][bj][m][0], v1 = acc[ai][bj][m][1];
#pragma unroll
                    for (int e = 0; e < 4; ++e) { v0[e] = t0[e] + v0[e] * sigm(g[e]); v1[e] = t1[e] + v1[e] * sigm(g[4 + e]); }
                    *(GAS u32x4*)(MG + (size_t)row * 1024 + col) = pack8(v0, v1);
                }
            }
    }
};
struct EpiResid {
    static constexpr bool PERM = true, AFTER_DRAIN = false;
    GAS float* H;
    __device__ __forceinline__ void operator()(const f32x4 (&acc)[2][2][4][2], const Unit& u, int wr, int wc, int fr, int fq) const {
        const int row0 = u.pm * BM + wr * 64 + fr, col0 = u.pn * BM + wc * 32 + 8 * fq;
#pragma unroll
        for (int ai = 0; ai < 2; ++ai)
#pragma unroll
            for (int m = 0; m < 4; ++m) {
                const int row = row0 + ai * HALF + m * 16;
#pragma unroll
                for (int bj = 0; bj < 2; ++bj) {
                    GAS float* d = H + (size_t)row * 1024 + col0 + bj * HALF;
                    const f32x4 h0 = *(const GAS f32x4*)d, h1 = *(const GAS f32x4*)(d + 4);
                    *(GAS f32x4*)d = h0 + acc[ai][bj][m][0]; *(GAS f32x4*)(d + 4) = h1 + acc[ai][bj][m][1];
                }
            }
    }
};
struct EpiUp {
    static constexpr bool PERM = true, AFTER_DRAIN = false;
    GAS bf16_t* A2;
    __device__ __forceinline__ void operator()(const f32x4 (&acc)[2][2][4][2], const Unit& u, int wr, int wc, int fr, int fq) const {
        const int row0 = u.pm * BM + wr * 64 + fr, col0 = u.pn * BM + wc * 32 + 8 * fq;
#pragma unroll
        for (int ai = 0; ai < 2; ++ai)
#pragma unroll
            for (int m = 0; m < 4; ++m) {
                const int row = row0 + ai * HALF + m * 16;
#pragma unroll
                for (int bj = 0; bj < 2; ++bj) {
                    f32x4 v0 = acc[ai][bj][m][0], v1 = acc[ai][bj][m][1];
#pragma unroll
                    for (int e = 0; e < 4; ++e) { const float a = fmaxf(v0[e], 0.f), b = fmaxf(v1[e], 0.f); v0[e] = a * a; v1[e] = b * b; }
                    *(GAS u32x4*)(A2 + (size_t)row * DFF + col0 + bj * HALF) = pack8(v0, v1);
                }
            }
    }
};
template <class Epi, class Sched, bool ALIGN_EPI = false, bool SP2 = false>
__device__ __forceinline__ void gemm_phase(PG8_LAS unsigned char* lds, const Gemm g, const Sched& S, const Epi& E, const int tid) {
    const int wid = __builtin_amdgcn_readfirstlane(tid >> 6), lane = tid & 63, wr = wid >> 2, wc = wid & 3, fr = lane & 15, fq = lane >> 4;
    const int K = g.K, nt = K / BK;
    unsigned voffA[2], voffB[2];
#pragma unroll
    for (int i = 0; i < 2; ++i) { int R, C; stage_rc(tid * 16 + i * 8192, R, C); const int Rb = Epi::PERM ? ((R & ~31) + perm32(R & 31)) : R;
        voffA[i] = (unsigned)(R * K + C) * 2u; voffB[i] = (unsigned)(Rb * K + C) * 2u; }
    const size_t kstep = (size_t)(BK * 2);
    const size_t hstep = (size_t)HALF * K * 2;
    const size_t tstep = 2 * hstep;
    const unsigned ldsw = (unsigned)wid * 1024u;
    const int aoff = lds_byte(wr * 64 + fr, fq * 8), boff = lds_byte(wc * 32 + fr, fq * 8);
#define PG8_SA(b, h) (((b) * 2 + (h)) * HTB)
#define PG8_SB(b, h) ((4 + (b) * 2 + (h)) * HTB)
#define PG8_STAGE(bufoff, gbase, voff) do { _Pragma("unroll") for (int _i = 0; _i < 2; ++_i) \
        __builtin_amdgcn_global_load_lds((const GAS unsigned*)((const GAS char*)(gbase) + (voff)[_i]), (PG8_LAS unsigned*)(lds + (bufoff) + ldsw + _i * 8192), 16, 0, 0); } while (0)
#define PG8_LDA(dst, b, h) do { _Pragma("unroll") for (int m = 0; m < 4; ++m) _Pragma("unroll") for (int k = 0; k < 2; ++k) dst[m][k] = *(const PG8_LAS bf16x8*)(lds + PG8_SA(b, h) + aoff + m * 2048 + k * 1024); } while (0)
#define PG8_LDB(dst, b, h) do { _Pragma("unroll") for (int n = 0; n < 2; ++n) _Pragma("unroll") for (int k = 0; k < 2; ++k) dst[n][k] = *(const PG8_LAS bf16x8*)(lds + PG8_SB(b, h) + boff + n * 2048 + k * 1024); } while (0)
#define PG8_MMA(ai, bj, At, Bt) do { __builtin_amdgcn_s_setprio(1); _Pragma("unroll") for (int m = 0; m < 4; ++m) _Pragma("unroll") for (int n = 0; n < 2; ++n) _Pragma("unroll") for (int k = 0; k < 2; ++k) \
        acc[ai][bj][m][n] = __builtin_amdgcn_mfma_f32_16x16x32_bf16(Bt[n][k], At[m][k], acc[ai][bj][m][n], 0, 0, 0); __builtin_amdgcn_s_setprio(0); } while (0)
#define PG8_WAIT_V(n) asm volatile("s_waitcnt vmcnt(" #n ")" ::: "memory")
#define PG8_WAIT_L(n) asm volatile("s_waitcnt lgkmcnt(" #n ")" ::: "memory")
#define PG8_BAR __builtin_amdgcn_s_barrier()
#define PG8_SCHED __builtin_amdgcn_sched_barrier(0)
    Unit cur, nxt; int ui = 0;
    if (!S.next(0, cur)) return;
    f32x4 acc[2][2][4][2];
#pragma unroll
    for (int a = 0; a < 2; ++a)
#pragma unroll
        for (int b = 0; b < 2; ++b)
#pragma unroll
            for (int m = 0; m < 4; ++m)
#pragma unroll
                for (int n = 0; n < 2; ++n) acc[a][b][m][n] = (f32x4){0.f, 0.f, 0.f, 0.f};
    bf16x8 At[4][2], B0[2][2], B1[2][2];
    const GAS char* cA = (const GAS char*)g.A + (size_t)cur.pm * tstep; const GAS char* cB = (const GAS char*)g.Bt + (size_t)cur.pn * tstep;
    S.a_ready(cur);
    if constexpr (SP2) {
        PG8_STAGE(PG8_SB(0, 0), cB, voffB); PG8_STAGE(PG8_SB(0, 1), cB + hstep, voffB); PG8_STAGE(PG8_SA(0, 0), cA, voffA); PG8_STAGE(PG8_SA(0, 1), cA + hstep, voffA);
        if (wr == 1) PG8_BAR;
        PG8_WAIT_V(2); PG8_BAR;
        PG8_STAGE(PG8_SB(1, 0), cB + kstep, voffB); PG8_STAGE(PG8_SA(1, 0), cA + kstep, voffA); PG8_STAGE(PG8_SB(1, 1), cB + hstep + kstep, voffB);
        PG8_WAIT_V(6); PG8_BAR;
    } else {
        PG8_STAGE(PG8_SB(0, 0), cB, voffB); PG8_STAGE(PG8_SA(0, 0), cA, voffA); PG8_STAGE(PG8_SB(0, 1), cB + hstep, voffB); PG8_STAGE(PG8_SA(0, 1), cA + hstep, voffA);
        if (wr == 1) PG8_BAR;
        PG8_WAIT_V(4); PG8_BAR;
        PG8_STAGE(PG8_SB(1, 0), cB + kstep, voffB); PG8_STAGE(PG8_SA(1, 0), cA + kstep, voffA); PG8_STAGE(PG8_SB(1, 1), cB + hstep + kstep, voffB);
        PG8_WAIT_V(6); PG8_BAR;
    }
    for (;;) {
        const bool has_next = S.next(ui + 1, nxt);
        const GAS char* nA = has_next ? (const GAS char*)g.A + (size_t)nxt.pm * tstep : cA; const GAS char* nB = has_next ? (const GAS char*)g.Bt + (size_t)nxt.pn * tstep : cB;
        for (int t = 0; t < nt; t += 2) {
            const bool last = (t == nt - 2);
            const GAS char* a1 = cA + (size_t)(t + 1) * kstep;
            const GAS char* a2 = last ? nA : cA + (size_t)(t + 2) * kstep; const GAS char* b2 = last ? nB : cB + (size_t)(t + 2) * kstep;
            const GAS char* a3 = a2 + kstep; const GAS char* b3 = b2 + kstep;
            if (last && has_next) S.a_ready(nxt);
            if constexpr (SP2) {
            PG8_LDB(B0, 0, 0); PG8_LDB(B1, 0, 1); PG8_SCHED; PG8_LDA(At, 0, 0); PG8_STAGE(PG8_SA(1, 1), a1 + hstep, voffA);
            PG8_WAIT_V(8); PG8_WAIT_L(0); PG8_BAR; PG8_MMA(0, 0, At, B0); PG8_MMA(0, 1, At, B1); PG8_BAR; PG8_SCHED;
            PG8_LDA(At, 0, 1); PG8_STAGE(PG8_SB(0, 0), b2, voffB); PG8_STAGE(PG8_SB(0, 1), b2 + hstep, voffB); PG8_STAGE(PG8_SA(0, 0), a2, voffA);
            PG8_WAIT_V(8); PG8_WAIT_L(0); PG8_BAR; PG8_MMA(1, 0, At, B0); PG8_MMA(1, 1, At, B1); PG8_BAR; PG8_SCHED;
            PG8_LDB(B0, 1, 0); PG8_LDB(B1, 1, 1); PG8_SCHED; PG8_LDA(At, 1, 0); PG8_STAGE(PG8_SA(0, 1), a2 + hstep, voffA);
            PG8_WAIT_V(8); PG8_WAIT_L(0); PG8_BAR; PG8_MMA(0, 0, At, B0); PG8_MMA(0, 1, At, B1); PG8_BAR; PG8_SCHED;
            PG8_LDA(At, 1, 1); PG8_STAGE(PG8_SB(1, 0), b3, voffB); PG8_STAGE(PG8_SB(1, 1), b3 + hstep, voffB); PG8_STAGE(PG8_SA(1, 0), a3, voffA);
            PG8_WAIT_V(8); PG8_WAIT_L(0); PG8_BAR; PG8_MMA(1, 0, At, B0); PG8_MMA(1, 1, At, B1); PG8_BAR; PG8_SCHED;
            } else {
            PG8_LDB(B0, 0, 0); PG8_SCHED; PG8_LDA(At, 0, 0); PG8_STAGE(PG8_SA(1, 1), a1 + hstep, voffA);
            PG8_WAIT_L(8); PG8_BAR; PG8_WAIT_L(0); PG8_MMA(0, 0, At, B0); PG8_BAR; PG8_SCHED;
            PG8_LDB(B1, 0, 1); PG8_STAGE(PG8_SB(0, 0), b2, voffB);
            PG8_BAR; PG8_WAIT_L(0); PG8_MMA(0, 1, At, B1); PG8_BAR;
            PG8_LDA(At, 0, 1); PG8_STAGE(PG8_SA(0, 0), a2, voffA);
            PG8_BAR; PG8_WAIT_L(0); PG8_MMA(1, 0, At, B0); PG8_BAR; PG8_SCHED;
            PG8_STAGE(PG8_SB(0, 1), b2 + hstep, voffB);
            PG8_WAIT_V(6); PG8_BAR; PG8_MMA(1, 1, At, B1); PG8_BAR;
            PG8_LDB(B0, 1, 0); PG8_SCHED; PG8_LDA(At, 1, 0); PG8_STAGE(PG8_SA(0, 1), a2 + hstep, voffA);
            PG8_WAIT_L(8); PG8_BAR; PG8_WAIT_L(0); PG8_MMA(0, 0, At, B0); PG8_BAR; PG8_SCHED;
            PG8_LDB(B1, 1, 1); PG8_STAGE(PG8_SB(1, 0), b3, voffB);
            PG8_BAR; PG8_WAIT_L(0); PG8_MMA(0, 1, At, B1); PG8_BAR;
            PG8_LDA(At, 1, 1); PG8_STAGE(PG8_SA(1, 0), a3, voffA);
            PG8_BAR; PG8_WAIT_L(0); PG8_MMA(1, 0, At, B0); PG8_BAR; PG8_SCHED;
            PG8_STAGE(PG8_SB(1, 1), b3 + hstep, voffB);
            PG8_WAIT_V(6); PG8_BAR; PG8_MMA(1, 1, At, B1); PG8_BAR;
            }
        }
        if constexpr (ALIGN_EPI) { if (wr == 0) PG8_BAR; }
        if constexpr (!Epi::AFTER_DRAIN) { E(acc, cur, wr, wc, fr, fq); S.done(cur); }
        if (!has_next) break;
#pragma unroll
        for (int a = 0; a < 2; ++a)
#pragma unroll
            for (int b = 0; b < 2; ++b)
#pragma unroll
                for (int m = 0; m < 4; ++m)
#pragma unroll
                    for (int n = 0; n < 2; ++n) acc[a][b][m][n] = (f32x4){0.f, 0.f, 0.f, 0.f};
        cur = nxt; cA = nA; cB = nB; ++ui;
        if constexpr (ALIGN_EPI) { if (wr == 1) PG8_BAR; }
    }
    PG8_WAIT_V(0);
    if constexpr (!ALIGN_EPI) { if (wr == 0) PG8_BAR; }
    PG8_BAR;
    if constexpr (Epi::AFTER_DRAIN) { E.fused(acc, cur, wr, wc, fr, fq, lds, wid, lane); S.done(cur); }
#undef PG8_SA
#undef PG8_SB
#undef PG8_STAGE
#undef PG8_LDA
#undef PG8_LDB
#undef PG8_MMA
#undef PG8_WAIT_V
#undef PG8_WAIT_L
#undef PG8_BAR
#undef PG8_SCHED
}
}

typedef unsigned short bf16;
typedef unsigned v4u __attribute__((ext_vector_type(4)));
typedef float f32x4 __attribute__((ext_vector_type(4)));
typedef short bf16x8 __attribute__((ext_vector_type(8)));
typedef GAS unsigned gu32;
typedef GAS unsigned long long gu64;
#define RLX_AGENT __ATOMIC_RELAXED, __HIP_MEMORY_SCOPE_AGENT
#define LDS_WAIT() asm volatile("s_waitcnt lgkmcnt(0)" ::: "memory")
#define VM_WAIT() asm volatile("s_waitcnt vmcnt(0)" ::: "memory")
__device__ __forceinline__ unsigned long long rt() { return __builtin_amdgcn_s_memrealtime(); }
typedef float f32x2_cv __attribute__((ext_vector_type(2))); typedef __bf16 bf16x2_cv __attribute__((ext_vector_type(2)));
__device__ __forceinline__ unsigned pk2(float lo, float hi) { const f32x2_cv v = {lo, hi}; const bf16x2_cv c = __builtin_convertvector(v, bf16x2_cv); return __builtin_bit_cast(unsigned, c); }
__device__ __forceinline__ unsigned f2bf(float f) { return pk2(f, 0.f) & 0xffffu; }

#define XB_TMO      128
#define XB_XCNT(j)  (256  + 64 * (j))
#define XB_XSUB(j)  (1280 + 64 * (j))
#define XB_XGEN(j)  (2304 + 64 * (j))
#define XB_TOP      3328
#define XB_TOPGEN   3392
#define XCD_BAR_WORDS 3456
#define XB_SPIN_CAP (1u << 18)

__device__ __forceinline__ unsigned xb_ld(unsigned* p)              { return __hip_atomic_load(p, __ATOMIC_RELAXED, __HIP_MEMORY_SCOPE_AGENT); }
__device__ __forceinline__ unsigned xb_add(unsigned* p, unsigned v) { return __hip_atomic_fetch_add(p, v, __ATOMIC_RELAXED, __HIP_MEMORY_SCOPE_AGENT); }
__device__ __forceinline__ unsigned xb_xcc_id() { return (unsigned)__builtin_amdgcn_s_getreg((3 << 11) | 20) & 0xFu; }
#define XB_SPIN(cond, bar) do { unsigned _sp = 0; while (cond) { __builtin_amdgcn_s_sleep(1); \
    if ((++_sp & 255u) == 0u) { if (xb_ld(&(bar)[XB_TMO])) break; if (_sp > XB_SPIN_CAP) { atomicAdd(&(bar)[XB_TMO], 1u); break; } } } } while (0)

struct XcdBarrier {
    unsigned* bar; unsigned x;
    volatile LAS unsigned* st;
};

__device__ __forceinline__ XcdBarrier xcd_barrier_post(unsigned* bar, volatile LAS unsigned* st) {
    XcdBarrier b; b.bar = bar; b.x = xb_xcc_id(); b.st = st;
    if (threadIdx.x == 0) (void)xb_add(&bar[XB_XCNT(b.x)], 1u);
    return b;
}
__device__ __forceinline__ void xcd_barrier_complete(unsigned* bar, unsigned x, unsigned& nloc, unsigned& nx, const unsigned G) {
    unsigned sum, cnt, mine, sp = 0u;
    for (;;) {
        sum = 0u; cnt = 0u; mine = 0u;
#pragma unroll 1
        for (unsigned j = 0; j < 16; ++j) { const unsigned c = xb_ld(&bar[XB_XCNT(j)]); sum += c; cnt += (c > 0u) ? 1u : 0u; mine = (j == x) ? c : mine; }
        if (sum == G) break;
        __builtin_amdgcn_s_sleep(1);
        if ((++sp & 255u) == 0u) { if (xb_ld(&bar[XB_TMO])) break; if (sp > XB_SPIN_CAP) { atomicAdd(&bar[XB_TMO], 1u); break; } }
    }
    nloc = mine > 0u ? mine : 1u; nx = cnt > 0u ? cnt : 1u;
}

__device__ __forceinline__ void xcd_barrier(const XcdBarrier& b, const int tid_, const unsigned G_) {
    asm volatile("s_waitcnt vmcnt(0)" ::: "memory");
    __syncthreads();
    if (tid_ == 0) {
        unsigned* bar = b.bar;
        __builtin_amdgcn_s_waitcnt(0);
        unsigned nloc = b.st[0], nx = b.st[1];
        if (nloc == 0u) { xcd_barrier_complete(bar, b.x, nloc, nx, G_); b.st[0] = nloc; b.st[1] = nx; }
        const unsigned old = xb_add(&bar[XB_XSUB(b.x)], 1u);
        const unsigned gen = old / nloc;
        if (old + 1u == (gen + 1u) * nloc) {
            __builtin_amdgcn_fence(__ATOMIC_RELEASE, "agent");
            asm volatile("s_waitcnt vmcnt(0)" ::: "memory");
            const unsigned og = xb_add(&bar[XB_TOP], 1u);
            const unsigned tg = og / nx;
            if (og + 1u == (tg + 1u) * nx) xb_add(&bar[XB_TOPGEN], 1u);
            else XB_SPIN(xb_ld(&bar[XB_TOPGEN]) == tg, bar);
            __builtin_amdgcn_fence(__ATOMIC_ACQUIRE, "agent");
            xb_add(&bar[XB_XGEN(b.x)], 1u);
            asm volatile("s_waitcnt vmcnt(0)" ::: "memory");
        } else {
            XB_SPIN(xb_ld(&bar[XB_XGEN(b.x)]) == gen, bar);
            __builtin_amdgcn_fence(__ATOMIC_ACQUIRE, "agent");
            asm volatile("s_waitcnt vmcnt(0)" ::: "memory");
        }
    }
    __syncthreads();
}

constexpr size_t O_YP = 0, O_YS = O_YP + (size_t)NB * SEQ * D, O_PK = O_YS + (size_t)MS * D, O_PV = O_PK + 2ull * MP * 256, O_PKI = O_PV + 2ull * MP * 256,
                 O_PSSM = O_PKI + 2ull * MP * 64, O_PCONV = O_PSSM + 2ull * NB * NH * HP * NST, O_SK = O_PCONV + 2ull * NB * 3 * CONVD, O_SV = O_SK + 2ull * MS * 256,
                 O_SKI = O_SV + 2ull * MS * 256, O_SSSM = O_SKI + 2ull * MS * 64, O_SCONV = O_SSSM + 2ull * DB * NH * HP * NST, O_END = O_SCONV + 2ull * DB * 3 * CONVD;

constexpr size_t MiB = 1u << 20;
constexpr size_t al(size_t x) { return (x + MiB - 1) / MiB * MiB; }
constexpr size_t WS_CTL = 0, CTL_ZERO_BYTES = 1 * MiB;
constexpr size_t SZ_WIN = (size_t)NIN * D * 2, SZ_WSSM = (size_t)D * DIN * 2, SZ_WATT = (size_t)D * D * 2, SZ_WOUT = (size_t)D * D * 2, SZ_WUP = (size_t)DFF * D * 2, SZ_WDN = (size_t)D * DFF * 2;
constexpr size_t WL_WIN = 0, WL_WSSM = al(WL_WIN + SZ_WIN), WL_WATT = al(WL_WSSM + SZ_WSSM), WL_WOUT = al(WL_WATT + SZ_WATT), WL_WUP = al(WL_WOUT + SZ_WOUT), WL_WDN = al(WL_WUP + SZ_WUP), WL_SIZE = al(WL_WDN + SZ_WDN);
constexpr size_t WS_W = 1 * MiB;
constexpr size_t WS_H = al(WS_W + 2 * WL_SIZE);
constexpr size_t WS_U = al(WS_H + (size_t)MPAD * D * 4);
constexpr size_t WS_P1 = al(WS_U + (size_t)MPAD * D * 2);
constexpr size_t WS_MISC = al(WS_P1 + (size_t)MPAD * LDP1 * 2);
constexpr size_t WS_KIB = al(WS_MISC + (size_t)MPAD * 128 * 4);
constexpr size_t WS_XC = al(WS_KIB + (size_t)MPAD * 64 * 2);
constexpr size_t WS_DT = al(WS_XC + (size_t)MPAD * CONVD * 2);
constexpr size_t WS_DA = al(WS_DT + (size_t)MPAD * 32 * 4);
constexpr size_t WS_YS = al(WS_DA + (size_t)MPAD * 32 * 4);
constexpr size_t WS_YSN = al(WS_YS + (size_t)MPAD * DIN * 4);
constexpr size_t WS_YA = al(WS_YSN + (size_t)MPAD * DIN * 2);
constexpr size_t WS_T1 = al(WS_YA + (size_t)MPAD * D * 2);
constexpr size_t WS_MG = al(WS_T1 + (size_t)MPAD * D * 4);
constexpr size_t WS_A2 = al(WS_MG + (size_t)MPAD * D * 2);
constexpr size_t WS_IDXP = al(WS_A2 + (size_t)MPAD * DFF * 2);
constexpr size_t WS_IDXS = al(WS_IDXP + (size_t)MP * 256 * 2);
constexpr int SCS_LD = 8256;
constexpr size_t WS_SCS = al(WS_IDXS + (size_t)MS * 256 * 4);
constexpr size_t WS_SB = al(WS_SCS + (size_t)MS * SCS_LD * 4);
constexpr size_t WS_DEC = al(WS_SB + (size_t)NB * 33 * NH * HP * NST * 4);
constexpr size_t WS_HC = al(WS_DEC + (size_t)NB * 33 * NH * 4);
constexpr size_t WS_KVB = al(WS_HC + (size_t)NB * 33 * NH * HP * NST * 2);
constexpr size_t WS_KIB2 = al(WS_KVB + (size_t)MPAD * 512 * 2);
constexpr size_t WS_END = al(WS_KIB2 + (size_t)NB * KT_PER_B * 2048 * 2);
constexpr int CW_BAR = 4096;

constexpr int LDS_BYTES = 159744, LDSCTL_OFF = 155648, MISC_OFF = LDSCTL_OFF + 320;
constexpr int NWAVES = 8, NT = 512;
typedef float f32x16 __attribute__((ext_vector_type(16)));
typedef unsigned v2u __attribute__((ext_vector_type(2)));

__device__ __forceinline__ float dpp_f(float v, const int ctrl_unused) { return v; }
#define DPPF(v, ctrl, rmask, bc) __uint_as_float((unsigned)__builtin_amdgcn_update_dpp(0, (int)__float_as_uint(v), ctrl, rmask, 0xf, bc))
__device__ __forceinline__ float row16_sum(float v) {
    v += DPPF(v, 0xB1, 0xf, true); v += DPPF(v, 0x4E, 0xf, true); v += DPPF(v, 0x141, 0xf, true); v += DPPF(v, 0x140, 0xf, true); return v;
}
__device__ __forceinline__ float wave_sum(float v) {
    v = row16_sum(v);
    v += DPPF(v, 0x142, 0xa, false); v += DPPF(v, 0x143, 0xc, false);
    return __uint_as_float((unsigned)__builtin_amdgcn_readlane((int)__float_as_uint(v), 63));
}
__device__ __forceinline__ float wave_max(float v) {
    v = fmaxf(v, __uint_as_float((unsigned)__builtin_amdgcn_update_dpp((int)__float_as_uint(v), (int)__float_as_uint(v), 0xB1, 0xf, 0xf, false)));
    v = fmaxf(v, __uint_as_float((unsigned)__builtin_amdgcn_update_dpp((int)__float_as_uint(v), (int)__float_as_uint(v), 0x4E, 0xf, 0xf, false)));
    v = fmaxf(v, __uint_as_float((unsigned)__builtin_amdgcn_update_dpp((int)__float_as_uint(v), (int)__float_as_uint(v), 0x141, 0xf, 0xf, false)));
    v = fmaxf(v, __uint_as_float((unsigned)__builtin_amdgcn_update_dpp((int)__float_as_uint(v), (int)__float_as_uint(v), 0x140, 0xf, 0xf, false)));
    v = fmaxf(v, __uint_as_float((unsigned)__builtin_amdgcn_update_dpp((int)__float_as_uint(v), (int)__float_as_uint(v), 0x142, 0xa, 0xf, false)));
    v = fmaxf(v, __uint_as_float((unsigned)__builtin_amdgcn_update_dpp((int)__float_as_uint(v), (int)__float_as_uint(v), 0x143, 0xc, 0xf, false)));
    return __uint_as_float((unsigned)__builtin_amdgcn_readlane((int)__float_as_uint(v), 63));
}
__device__ __forceinline__ void unpack8(const v4u w, float (&f)[8]) {
    f[0] = __uint_as_float(w.x << 16); f[1] = __uint_as_float(w.x & 0xffff0000u); f[2] = __uint_as_float(w.y << 16); f[3] = __uint_as_float(w.y & 0xffff0000u);
    f[4] = __uint_as_float(w.z << 16); f[5] = __uint_as_float(w.z & 0xffff0000u); f[6] = __uint_as_float(w.w << 16); f[7] = __uint_as_float(w.w & 0xffff0000u);
}
__device__ __forceinline__ float sigm(float x) { return __builtin_amdgcn_rcpf(1.0f + __expf(-x)); }

__device__ __forceinline__ int win_src_col(int n) {
    if (n < 5120) return n;
    if (n < 6144) return n - 5120 + 5152;
    if (n < 6400) return n - 6144 + 6176;
    if (n < 6656) return n - 6400 + 6432;
    if (n < 7168) return n - 6656 + 6688;
    if (n < 8192) return n - 7168 + 7272;
    if (n < 9216) return n - 8192 + 8296;
    if (n < 9280) return n - 9216 + 7200;
    if (n < 9312) return n - 9280 + 5120;
    if (n < 9320) return n - 9312 + 7264;
    return -1;
}
__device__ __forceinline__ void tr_item(const GAS float* W, int K, int Nsrc, GAS bf16* WT, int nblk, bool remap, LAS float* scr, int item, int lane) {
    const int kb = item / nblk, nb = item % nblk, k0 = 64 * kb, n0 = 64 * nb;
    const int s0 = remap ? win_src_col(n0) : n0, s63 = remap ? win_src_col(n0 + 63) : n0 + 63;
    if (s0 >= 0 && s63 == s0 + 63 && (s0 & 3) == 0 && (Nsrc & 3) == 0) {
        const int r4 = lane >> 4, c4 = (lane & 15) * 4;
#pragma unroll 4
        for (int i = 0; i < 16; ++i) { const int kk = 4 * i + r4; const f32x4 v = *(const GAS f32x4*)(W + (size_t)(k0 + kk) * Nsrc + s0 + c4);
            scr[kk * 65 + c4] = v.x; scr[kk * 65 + c4 + 1] = v.y; scr[kk * 65 + c4 + 2] = v.z; scr[kk * 65 + c4 + 3] = v.w; }
    } else {
        const int sc = remap ? win_src_col(n0 + lane) : n0 + lane;
#pragma unroll 8
        for (int kk = 0; kk < 64; ++kk) scr[kk * 65 + lane] = sc >= 0 ? W[(size_t)(k0 + kk) * Nsrc + sc] : 0.f;
    }
    LDS_WAIT(); asm volatile("" ::: "memory");
    const int c = lane & 7;
#pragma unroll
    for (int j = 0; j < 8; ++j) { const int n = (lane >> 3) + 8 * j; const LAS float* s = scr + (8 * c) * 65 + n;
        v4u o; o.x = pk2(s[0 * 65], s[1 * 65]); o.y = pk2(s[2 * 65], s[3 * 65]); o.z = pk2(s[4 * 65], s[5 * 65]); o.w = pk2(s[6 * 65], s[7 * 65]);
        *(GAS v4u*)(WT + (size_t)(n0 + n) * K + k0 + 8 * c) = o; }
    LDS_WAIT(); asm volatile("" ::: "memory");
}
__device__ __forceinline__ void rms_row(const GAS float* src, const GAS float* w, GAS float* hdst, GAS bf16* udst, GAS float* fdst, int lane) {
    f32x4 v[4]; float ss = 0.f;
#pragma unroll
    for (int j = 0; j < 4; ++j) { v[j] = src ? ((const GAS f32x4*)src)[lane + 64 * j] : (f32x4){0.f, 0.f, 0.f, 0.f}; ss += (v[j].x * v[j].x + v[j].y * v[j].y) + (v[j].z * v[j].z + v[j].w * v[j].w); }
    ss = wave_sum(ss);
    const float rstd = 1.0f / sqrtf(ss * (1.0f / D) + 1e-6f);
#pragma unroll
    for (int j = 0; j < 4; ++j) {
        if (hdst) ((GAS f32x4*)hdst)[lane + 64 * j] = v[j];
        const f32x4 wv = ((const GAS f32x4*)w)[lane + 64 * j]; const f32x4 o = v[j] * rstd * wv;
        if (udst) ((GAS v2u*)udst)[lane + 64 * j] = (v2u){pk2(o.x, o.y), pk2(o.z, o.w)};
        if (fdst) ((GAS f32x4*)fdst)[lane + 64 * j] = o;
    }
}

__device__ __forceinline__ void rms_rows4(const GAS float* H, const GAS float* w, GAS bf16* U, int m0, int stride, int mend, int lane) {
    f32x4 v[4][4]; float ss[4];
#pragma unroll
    for (int r = 0; r < 4; ++r) { const int m = m0 + r * stride; const GAS f32x4* src = (const GAS f32x4*)(H + (size_t)(m < mend ? m : m0) * D); ss[r] = 0.f;
#pragma unroll
        for (int j = 0; j < 4; ++j) v[r][j] = src[lane + 64 * j]; }
    f32x4 wv[4];
#pragma unroll
    for (int j = 0; j < 4; ++j) wv[j] = ((const GAS f32x4*)w)[lane + 64 * j];
#pragma unroll
    for (int r = 0; r < 4; ++r) {
#pragma unroll
        for (int j = 0; j < 4; ++j) ss[r] += (v[r][j].x * v[r][j].x + v[r][j].y * v[r][j].y) + (v[r][j].z * v[r][j].z + v[r][j].w * v[r][j].w);
        ss[r] = wave_sum(ss[r]);
        const float rstd = 1.0f / sqrtf(ss[r] * (1.0f / D) + 1e-6f); const int m = m0 + r * stride;
        if (m < mend) {
#pragma unroll
            for (int j = 0; j < 4; ++j) { const f32x4 o = v[r][j] * rstd * wv[j]; ((GAS v2u*)(U + (size_t)m * D))[lane + 64 * j] = (v2u){pk2(o.x, o.y), pk2(o.z, o.w)}; } }
    }
}

__device__ __forceinline__ void rms_rows4g(const GAS float* const (&src)[4], const GAS float* w, GAS float* const (&hdst)[4], GAS bf16* const (&udst)[4], GAS float* const (&fdst)[4], const bool (&live)[4], int lane) {
    f32x4 v[4][4];
#pragma unroll
    for (int r = 0; r < 4; ++r)
#pragma unroll
        for (int j = 0; j < 4; ++j) v[r][j] = (live[r] && src[r]) ? ((const GAS f32x4*)src[r])[lane + 64 * j] : (f32x4){0.f, 0.f, 0.f, 0.f};
    f32x4 wv[4];
#pragma unroll
    for (int j = 0; j < 4; ++j) wv[j] = ((const GAS f32x4*)w)[lane + 64 * j];
#pragma unroll
    for (int r = 0; r < 4; ++r) { float ss = 0.f;
#pragma unroll
        for (int j = 0; j < 4; ++j) ss += (v[r][j].x * v[r][j].x + v[r][j].y * v[r][j].y) + (v[r][j].z * v[r][j].z + v[r][j].w * v[r][j].w);
        ss = wave_sum(ss);
        const float rstd = 1.0f / sqrtf(ss * (1.0f / D) + 1e-6f);
        if (live[r]) {
#pragma unroll
            for (int j = 0; j < 4; ++j) { const f32x4 o = v[r][j] * rstd * wv[j];
                if (hdst[r]) ((GAS f32x4*)hdst[r])[lane + 64 * j] = v[r][j];
                if (udst[r]) ((GAS v2u*)udst[r])[lane + 64 * j] = (v2u){pk2(o.x, o.y), pk2(o.z, o.w)};
                if (fdst[r]) ((GAS f32x4*)fdst[r])[lane + 64 * j] = o; } }
    }
}

__device__ __forceinline__ void ssd_unit(LAS unsigned char* lds, int tid, const GAS bf16* XC, const GAS float* DT, const GAS float* DA, size_t m0, int L, int h, int p0,
                                         const GAS float* hin, GAS float* hout, GAS float* YS, float dskip) {
    LAS float* Bl = (LAS float*)lds;
    LAS float* Cl = Bl + 64 * 128;
    LAS float* Xl = Cl + 64 * 128;
    LAS float* Yl = Xl + 64 * 32;
    LAS float* dtl = Yl + 64 * 32;
    LAS float* dal = dtl + 64;
    const int pl = tid >> 4, nq = tid & 15, n0 = nq * 8, g = h >> 3;
    float s[8];
    if (hin) { const f32x4 a = *(const GAS f32x4*)(hin + (size_t)(p0 + pl) * NST + n0), b = *(const GAS f32x4*)(hin + (size_t)(p0 + pl) * NST + n0 + 4);
        s[0] = a.x; s[1] = a.y; s[2] = a.z; s[3] = a.w; s[4] = b.x; s[5] = b.y; s[6] = b.z; s[7] = b.w; }
    else {
#pragma unroll
        for (int i = 0; i < 8; ++i) s[i] = 0.f; }
    for (int tb = 0; tb < L; tb += 64) {
        const int nb = (L - tb) < 64 ? (L - tb) : 64;
        { const int tk = tid >> 3, part = tid & 7;
            if (tk < nb) { const GAS bf16* xr = XC + (m0 + tb + tk) * CONVD;
                float f[8];
                unpack8(*(const GAS v4u*)(xr + DIN + g * NST + part * 16), f);
                *(LAS f32x4*)(Bl + tk * 128 + part * 16) = (f32x4){f[0], f[1], f[2], f[3]}; *(LAS f32x4*)(Bl + tk * 128 + part * 16 + 4) = (f32x4){f[4], f[5], f[6], f[7]};
                unpack8(*(const GAS v4u*)(xr + DIN + g * NST + part * 16 + 8), f);
                *(LAS f32x4*)(Bl + tk * 128 + part * 16 + 8) = (f32x4){f[0], f[1], f[2], f[3]}; *(LAS f32x4*)(Bl + tk * 128 + part * 16 + 12) = (f32x4){f[4], f[5], f[6], f[7]};
                unpack8(*(const GAS v4u*)(xr + DIN + NG * NST + g * NST + part * 16), f);
                *(LAS f32x4*)(Cl + tk * 128 + part * 16) = (f32x4){f[0], f[1], f[2], f[3]}; *(LAS f32x4*)(Cl + tk * 128 + part * 16 + 4) = (f32x4){f[4], f[5], f[6], f[7]};
                unpack8(*(const GAS v4u*)(xr + DIN + NG * NST + g * NST + part * 16 + 8), f);
                *(LAS f32x4*)(Cl + tk * 128 + part * 16 + 8) = (f32x4){f[0], f[1], f[2], f[3]}; *(LAS f32x4*)(Cl + tk * 128 + part * 16 + 12) = (f32x4){f[4], f[5], f[6], f[7]};
                const v2u xw = *(const GAS v2u*)(xr + h * HP + p0 + part * 4);
                *(LAS f32x4*)(Xl + tk * 32 + part * 4) = (f32x4){__uint_as_float(xw.x << 16), __uint_as_float(xw.x & 0xffff0000u), __uint_as_float(xw.y << 16), __uint_as_float(xw.y & 0xffff0000u)};
            }
            if (tid < nb) { dtl[tid] = DT[(m0 + tb + tid) * 32 + h]; dal[tid] = DA[(m0 + tb + tid) * 32 + h]; }
        }
        __syncthreads();
        for (int t = 0; t < nb; ++t) {
            const float da = dal[t], dtv = dtl[t], xv = Xl[t * 32 + pl], xdt = xv * dtv;
            const f32x4 b0 = *(const LAS f32x4*)(Bl + t * 128 + n0), b1 = *(const LAS f32x4*)(Bl + t * 128 + n0 + 4);
            const f32x4 c0 = *(const LAS f32x4*)(Cl + t * 128 + n0), c1 = *(const LAS f32x4*)(Cl + t * 128 + n0 + 4);
            s[0] = s[0] * da + xdt * b0.x; s[1] = s[1] * da + xdt * b0.y; s[2] = s[2] * da + xdt * b0.z; s[3] = s[3] * da + xdt * b0.w;
            s[4] = s[4] * da + xdt * b1.x; s[5] = s[5] * da + xdt * b1.y; s[6] = s[6] * da + xdt * b1.z; s[7] = s[7] * da + xdt * b1.w;
            float y = (s[0] * c0.x + s[1] * c0.y) + (s[2] * c0.z + s[3] * c0.w) + (s[4] * c1.x + s[5] * c1.y) + (s[6] * c1.z + s[7] * c1.w);
            y += __shfl_xor(y, 1); y += __shfl_xor(y, 2); y += __shfl_xor(y, 4); y += __shfl_xor(y, 8);
            if (nq == 0) Yl[t * 32 + pl] = y + xv * dskip;
        }
        __syncthreads();
        { const int tk = tid >> 3, part = tid & 7;
            if (tk < nb) *(GAS f32x4*)(YS + (m0 + tb + tk) * DIN + h * HP + p0 + part * 4) = *(const LAS f32x4*)(Yl + tk * 32 + part * 4); }
    }
    *(GAS f32x4*)(hout + (size_t)(p0 + pl) * NST + n0) = (f32x4){s[0], s[1], s[2], s[3]};
    *(GAS f32x4*)(hout + (size_t)(p0 + pl) * NST + n0 + 4) = (f32x4){s[4], s[5], s[6], s[7]};
}

__device__ __forceinline__ void idx_load_q(const GAS bf16* P1, const GAS float* MISC, size_t mq0, int lane, bf16x8 (&afr)[2][4], float (&wq)[2][2][8]) {
    const int r = lane & 31, hh = lane >> 5, qs = ((r >> 2) & 1) * 2 + (r >> 4), head = (r & 3) + 4 * ((r >> 3) & 1);
#pragma unroll
    for (int rt = 0; rt < 2; ++rt)
#pragma unroll
        for (int ks = 0; ks < 4; ++ks) afr[rt][ks] = *(const GAS bf16x8*)(P1 + (mq0 + qs + 4 * rt) * LDP1 + C_QI + head * 64 + 16 * ks + 8 * hh);
#pragma unroll
    for (int rt = 0; rt < 2; ++rt)
#pragma unroll
        for (int jq = 0; jq < 2; ++jq) { const GAS float* wp = MISC + (mq0 + 4 * rt + 2 * hh + jq) * 128 + MC_WI; const f32x4 a = *(const GAS f32x4*)wp, b = *(const GAS f32x4*)(wp + 4);
            const float sc = 0.125f * 0.35355339059327373f;
            wq[rt][jq][0] = a.x * sc; wq[rt][jq][1] = a.y * sc; wq[rt][jq][2] = a.z * sc; wq[rt][jq][3] = a.w * sc; wq[rt][jq][4] = b.x * sc; wq[rt][jq][5] = b.y * sc; wq[rt][jq][6] = b.z * sc; wq[rt][jq][7] = b.w * sc; }
}
typedef float f32x2 __attribute__((ext_vector_type(2)));
__device__ __forceinline__ float relu_bits(float x) { return __int_as_float(max(__float_as_int(x), 0)); }
__device__ __forceinline__ float idx_reduce(const f32x16& acc, const int o, const float (&w)[8]) {
    f32x2 s2 = (f32x2){w[0], w[1]} * (f32x2){relu_bits(acc[o]), relu_bits(acc[o + 1])};
#pragma unroll
    for (int i = 2; i < 8; i += 2) s2 = __builtin_elementwise_fma((f32x2){w[i], w[i + 1]}, (f32x2){relu_bits(acc[o + i]), relu_bits(acc[o + i + 1])}, s2);
    return s2.x + s2.y;
}
__device__ __forceinline__ void idx_scores(const bf16x8 (&afr)[2][4], const bf16x8 (&bfr)[4], const float (&wq)[2][2][8], float (&sc)[2][2]) {
#pragma unroll
    for (int rt = 0; rt < 2; ++rt) {
        f32x16 acc = {};
#pragma unroll
        for (int ks = 0; ks < 4; ++ks) acc = __builtin_amdgcn_mfma_f32_32x32x16_bf16(afr[rt][ks], bfr[ks], acc, 0, 0, 0);
#pragma unroll
        for (int jq = 0; jq < 2; ++jq) sc[rt][jq] = idx_reduce(acc, 8 * jq, wq[rt][jq]);
    }
}
__device__ __forceinline__ unsigned f2key(float f) { const unsigned u = __float_as_uint(f); return u ^ ((u >> 31) ? 0xffffffffu : 0x80000000u); }
__device__ __forceinline__ unsigned wave_incl_scan(unsigned v, int lane) {
#pragma unroll
    for (int o = 1; o < 64; o <<= 1) { const unsigned t = __shfl_up(v, o); if (lane >= o) v += t; }
    return v;
}
#ifndef REP_TK_OPEN
#define REP_TK_OPEN 1
#endif
#ifndef REP_TK_PASS
#define REP_TK_PASS 1
#endif
#ifndef REP_TK_COMP
#define REP_TK_COMP 1
#endif
__device__ __forceinline__ int wave_sum_i(int v) {
    v += __builtin_amdgcn_update_dpp(0, v, 0xB1, 0xf, 0xf, true);
    v += __builtin_amdgcn_update_dpp(0, v, 0x4E, 0xf, 0xf, true);
    v += __builtin_amdgcn_update_dpp(0, v, 0x141, 0xf, 0xf, true);
    v += __builtin_amdgcn_update_dpp(0, v, 0x140, 0xf, 0xf, true);
    v += __builtin_amdgcn_update_dpp(0, v, 0x142, 0xa, 0xf, false);
    v += __builtin_amdgcn_update_dpp(0, v, 0x143, 0xc, 0xf, false);
    return __builtin_amdgcn_readlane(v, 63);
}
__device__ __forceinline__ int cnt_ge(const LAS unsigned* s, int nit, unsigned mid, int lane) {
    int cl = 0; int it = 0;
    const LAS v4u* p = (const LAS v4u*)s + lane;
    for (; it + 4 <= nit; it += 4) {
        const v4u k0 = p[64 * it], k1 = p[64 * it + 64], k2 = p[64 * it + 128], k3 = p[64 * it + 192];
        cl += (k0.x >= mid) + (k0.y >= mid) + (k0.z >= mid) + (k0.w >= mid);
        cl += (k1.x >= mid) + (k1.y >= mid) + (k1.z >= mid) + (k1.w >= mid);
        cl += (k2.x >= mid) + (k2.y >= mid) + (k2.z >= mid) + (k2.w >= mid);
        cl += (k3.x >= mid) + (k3.y >= mid) + (k3.z >= mid) + (k3.w >= mid); }
    for (; it < nit; ++it) { const v4u kv = p[64 * it]; cl += (kv.x >= mid) + (kv.y >= mid) + (kv.z >= mid) + (kv.w >= mid); }
    return wave_sum_i(cl);
}
constexpr int HB = 512;
__device__ __forceinline__ unsigned hist_bound_key(int b) {
    return b <= 0 ? 1u : (b >= HB ? 0xff800001u : (b == 256 ? 0x7fffffffu : f2key((float)(b - 256) * (1.0f / 64.0f))));
}
__device__ __forceinline__ unsigned mbcnt64(unsigned long long m, unsigned add) { return __builtin_amdgcn_mbcnt_hi((unsigned)(m >> 32), __builtin_amdgcn_mbcnt_lo((unsigned)m, add)); }
template <class OT>
__device__ __forceinline__ void topk_select(LAS unsigned* s, int n, int lane, OT* out, const LAS unsigned* hist = nullptr) {
    const int nit = (n + 255) >> 8;
    for (int i = n + lane; i < nit * 256; i += 64) s[i] = 0u;
    LDS_WAIT(); asm volatile("" ::: "memory");
    unsigned T = 0u, need = 0u;
    {
    unsigned hi, lo; int c_hi, c_lo;
    if (hist) {
        unsigned c[8], tot = 0u;
#pragma unroll
        for (int j = 0; j < 8; ++j) { c[j] = hist[HB - 1 - 8 * lane - j]; tot += c[j]; }
        const unsigned incl = wave_incl_scan(tot, lane), excl = incl - tot;
        const bool here = (excl < 256u) && (256u <= incl);
        int bin = 0; unsigned above = 0u, inb = 0u;
        if (here) { unsigned run = excl;
#pragma unroll
            for (int j = 0; j < 8; ++j) { if (run < 256u && 256u <= run + c[j]) { bin = HB - 1 - 8 * lane - j; above = run; inb = c[j]; } run += c[j]; } }
        const unsigned long long mk = __ballot(here); const int src = mk ? (__ffsll((long long)mk) - 1) : 0;
        bin = __builtin_amdgcn_readlane(bin, src); above = (unsigned)__builtin_amdgcn_readlane((int)above, src); inb = (unsigned)__builtin_amdgcn_readlane((int)inb, src);
        lo = hist_bound_key(bin); hi = hist_bound_key(bin + 1); c_hi = (int)above; c_lo = (int)(above + inb);
        if (inb <= 64u) {
            LAS unsigned short* stg = (LAS unsigned short*)hist;
            LAS unsigned* cnd = (LAS unsigned*)hist + 128;
            const unsigned wdt = hi - lo;
            unsigned running = 0u, ncand = 0u;
#pragma unroll 2
            for (int it = 0; it < nit; ++it) {
                const int i0 = 4 * (lane + 64 * it); const v4u kv = *(const LAS v4u*)(s + i0);
                bool sel[4], cd[4]; bool any = false; unsigned lower = running, all = 0u;
#pragma unroll
                for (int e = 0; e < 4; ++e) { sel[e] = kv[e] >= hi; const unsigned long long sm = __ballot(sel[e]); lower = mbcnt64(sm, lower); all += (unsigned)__popcll(sm);
                                              cd[e] = (kv[e] - lo) < wdt; any = any || cd[e]; }
                unsigned pos = lower;
#pragma unroll
                for (int e = 0; e < 4; ++e) { if (sel[e]) { stg[pos] = (unsigned short)(i0 + e); ++pos; } }
                running += all;
                if (__ballot(any)) {
#pragma unroll
                    for (int e = 0; e < 4; ++e) { const unsigned long long cm = __ballot(cd[e]);
                        if (cd[e]) { const unsigned p = mbcnt64(cm, ncand); cnd[2 * p] = kv[e]; cnd[2 * p + 1] = (unsigned)(i0 + e); }
                        ncand += (unsigned)__popcll(cm); }
                }
            }
            LDS_WAIT(); asm volatile("" ::: "memory");
            const unsigned r = 256u - above;
            unsigned ck = 0u, ci = 0xffffffffu;
            if ((unsigned)lane < inb) { ck = cnd[2 * lane]; ci = cnd[2 * lane + 1]; }
            unsigned rank = 0u;
            for (unsigned j = 0; j < inb; ++j) { const unsigned kj = (unsigned)__builtin_amdgcn_readlane((int)ck, (int)j), ij = (unsigned)__builtin_amdgcn_readlane((int)ci, (int)j);
                rank += (kj > ck || (kj == ck && ij < ci)) ? 1u : 0u; }
            if ((unsigned)lane < inb && rank < r) stg[above + rank] = (unsigned short)ci;
            LDS_WAIT(); asm volatile("" ::: "memory");
            const v2u w = *(const LAS v2u*)(stg + 4 * lane);
            if constexpr (sizeof(OT) == 2) *(GAS v2u*)(out + 4 * lane) = w;
            else *(GAS v4u*)(out + 4 * lane) = (v4u){w.x & 0xffffu, w.x >> 16, w.y & 0xffffu, w.y >> 16};
            return;
        }
    } else {
    unsigned kmx = 0u;
    for (int it = 0; it < nit; ++it) { const v4u kv = *(const LAS v4u*)(s + 4 * (lane + 64 * it));
        const unsigned a = kv.x > kv.y ? kv.x : kv.y, c = kv.z > kv.w ? kv.z : kv.w, d = a > c ? a : c; kmx = d > kmx ? d : kmx; }
#pragma unroll
    for (int o = 1; o < 64; o <<= 1) { const unsigned a = __shfl_xor(kmx, o); kmx = a > kmx ? a : kmx; }
    kmx = (unsigned)__builtin_amdgcn_readfirstlane((int)kmx);
    hi = kmx + 1u; lo = 1u; c_hi = 0; c_lo = n;
    { unsigned step = 1u << 25;
      for (int tr = 0; tr < 7; ++tr) { if (hi <= step + 1u) break; const unsigned cand = hi - step;
          const int c = cnt_ge(s, nit, cand, lane);
          if (c >= 256) { lo = cand; c_lo = c; break; } hi = cand; c_hi = c; step <<= 1; } }
    }
    bool bis = false; unsigned pw = hi - lo;
    for (int pass = 0; pass < 96; ++pass) {
        if (c_lo == 256) { T = lo - 1u; need = 0u; break; }
        if (hi - lo <= 1u) { T = lo; need = (unsigned)(256 - c_hi); break; }
        const unsigned width = hi - lo; unsigned mid;
        if (bis) mid = lo + (width >> 1);
        else { const float f = ((float)(c_lo - 256) + 0.5f) * __builtin_amdgcn_rcpf((float)(c_lo - c_hi)); const float off = (float)width * f;
               mid = lo + (off >= (float)width ? width - 1u : (unsigned)off); }
        if (mid <= lo) mid = lo + 1u; if (mid >= hi) mid = hi - 1u;
        const int c = cnt_ge(s, nit, mid, lane);
        if (c >= 256) { lo = mid; c_lo = c; } else { hi = mid; c_hi = c; }
        const unsigned nw = hi - lo; bis = !bis && (nw > (pw >> 2)); pw = nw;
    }
    }
    const unsigned long long lt = (1ull << lane) - 1ull;
    unsigned running = 0u, eq_taken = 0u;
    {
#pragma unroll 2
    for (int it = 0; it < nit; ++it) {
        const int i0 = 4 * (lane + 64 * it); const v4u kv = *(const LAS v4u*)(s + i0);
        bool sel[4], eq[4]; bool anyeq = false;
#pragma unroll
        for (int e = 0; e < 4; ++e) { sel[e] = kv[e] > T; eq[e] = need != 0u && kv[e] == T && (i0 + e < n); anyeq = anyeq || eq[e]; }
        if (need != 0u && __ballot(anyeq)) {
            unsigned lower = 0u, all = 0u;
#pragma unroll
            for (int e = 0; e < 4; ++e) { const unsigned long long bm = __ballot(eq[e]); lower += (unsigned)__popcll(bm & lt); all += (unsigned)__popcll(bm); }
            unsigned er = eq_taken + lower;
#pragma unroll
            for (int e = 0; e < 4; ++e) { if (eq[e]) { sel[e] = er < need; ++er; } }
            eq_taken += all;
        }
        unsigned lower = 0u, all = 0u;
#pragma unroll
        for (int e = 0; e < 4; ++e) { const unsigned long long sm = __ballot(sel[e]); lower += (unsigned)__popcll(sm & lt); all += (unsigned)__popcll(sm); }
        unsigned pos = running + lower;
#pragma unroll
        for (int e = 0; e < 4; ++e) { if (sel[e]) { if (pos < 256u) out[pos] = (OT)(i0 + e); ++pos; } }
        running += all;
    } }
}

constexpr int NCH = 33;
typedef short s16x4 __attribute__((ext_vector_type(4)));
typedef short v4i16_t __attribute__((ext_vector_type(4)));
__device__ __forceinline__ float wave_incl_scan_f(float v, int lane) {
#pragma unroll
    for (int o = 1; o < 64; o <<= 1) { const float t = __shfl_up(v, o); if (lane >= o) v += t; }
    return v;
}
__device__ __forceinline__ s16x4 ldtr(const LAS unsigned char* p) { return __builtin_bit_cast(s16x4, __builtin_amdgcn_ds_read_tr16_b64_v4i16((LAS v4i16_t*)p)); }
__device__ __forceinline__ bf16x8 frag_tr(const LAS unsigned char* img, int RS, int k0, int c0, int lane) {
    const int hh = lane >> 5, blk = (lane >> 4) & 1, q = (lane & 15) >> 2, pp = lane & 3;
    const LAS unsigned char* a = img + (k0 + 8 * hh + q) * RS + (c0 + 16 * blk + 4 * pp) * 2;
    const s16x4 lo = ldtr(a), hi = ldtr(a + 4 * RS);
    return (bf16x8){lo[0], lo[1], lo[2], lo[3], hi[0], hi[1], hi[2], hi[3]};
}
__device__ __forceinline__ bf16x8 frag_row(const LAS unsigned char* img, int RS, int r0, int k0, int lane) {
    return *(const LAS bf16x8*)(img + (r0 + (lane & 31)) * RS + (k0 + 8 * (lane >> 5)) * 2);
}
constexpr int RS_BC = 272, RS_X = 144, IMG_BC = 128 * RS_BC, IMG_X = 128 * RS_X;
__device__ __forceinline__ void ssd_stage_acum(LAS float* acl, LAS float* dtl, const GAS float* DT, const GAS float* a_log_l, size_t m0, int Lc, int g, int wave, int lane) {
    const int h = 8 * g + wave; const float A = -__expf(a_log_l[h]);
    const float d0 = lane < Lc ? DT[(m0 + lane) * 32 + h] : 0.f, d1 = (64 + lane) < Lc ? DT[(m0 + 64 + lane) * 32 + h] : 0.f;
    const float s0 = wave_incl_scan_f(d0 * A, lane), tot0 = __shfl(s0, 63), s1 = wave_incl_scan_f(d1 * A, lane) + tot0;
    acl[wave * 128 + lane] = s0; acl[wave * 128 + 64 + lane] = s1; dtl[wave * 128 + lane] = d0; dtl[wave * 128 + 64 + lane] = d1;
}
__device__ __forceinline__ void ssd_stage_bc(LAS unsigned char* img, const GAS bf16* src  , int Lc, int tid) {
    const int ch = tid & 15;
#pragma unroll
    for (int q4 = 0; q4 < 4; ++q4) { const int row = (tid >> 4) + 32 * q4; v4u v = (v4u){0u, 0u, 0u, 0u}; if (row < Lc) v = *(const GAS v4u*)(src + (size_t)row * CONVD + ch * 8);
        *(LAS v4u*)(img + row * RS_BC + ch * 16) = v; }
}
__device__ __forceinline__ void ssd_stage_x(LAS unsigned char* img, const GAS bf16* src  , int Lc, int tid, const LAS float* dth, const LAS float* ach, float al, bool decay) {
    const int ch = tid & 7;
#pragma unroll
    for (int q2 = 0; q2 < 2; ++q2) { const int row = (tid >> 3) + 64 * q2; v4u o = (v4u){0u, 0u, 0u, 0u};
        if (row < Lc) { float f[8]; unpack8(*(const GAS v4u*)(src + (size_t)row * CONVD + ch * 8), f);
            const float sc = decay ? dth[row] * __expf(al - ach[row]) : dth[row];
            o = (v4u){pk2(f[0] * sc, f[1] * sc), pk2(f[2] * sc, f[3] * sc), pk2(f[4] * sc, f[5] * sc), pk2(f[6] * sc, f[7] * sc)}; }
        *(LAS v4u*)(img + row * RS_X + ch * 16) = o; }
}
__device__ __forceinline__ void ssd1_unit(LAS unsigned char* lds, int tid, const GAS bf16* XC, const GAS float* DT, const GAS float* a_log_l, GAS bf16* SB, GAS float* DEC, int b, int c, int g) {
    const int lane = tid & 63, wave = __builtin_amdgcn_readfirstlane(tid >> 6), hh = lane >> 5, col = lane & 31;
    const int t0 = c == 0 ? 0 : NMETA + 128 * (c - 1), Lc = c == 0 ? NMETA : 128; const size_t m0 = (size_t)b * LP + t0;
    LAS unsigned char* Bimg = lds; LAS unsigned char* Xw0 = lds + IMG_BC;
    LAS float* acl = (LAS float*)(lds + IMG_BC + 2 * IMG_X); LAS float* dtl = acl + 1024;
    ssd_stage_acum(acl, dtl, DT, a_log_l, m0, Lc, g, wave, lane);
    ssd_stage_bc(Bimg, XC + m0 * CONVD + DIN + g * NST, Lc, tid);
    __syncthreads();
    const int pb = wave >> 2, nb = wave & 3;
    for (int hl = 0; hl < 8; ++hl) {
        const int h = 8 * g + hl; LAS unsigned char* Xw = Xw0 + (hl & 1) * IMG_X;
        const float al = acl[hl * 128 + 127];
        ssd_stage_x(Xw, XC + m0 * CONVD + h * HP, Lc, tid, dtl + hl * 128, acl + hl * 128, al, true);
        __syncthreads();
        f32x16 acc = {};
        if (Lc == 128) {
#pragma unroll
            for (int ks = 0; ks < 8; ++ks) acc = __builtin_amdgcn_mfma_f32_32x32x16_bf16(frag_tr(Xw, RS_X, 16 * ks, 32 * pb, lane), frag_tr(Bimg, RS_BC, 16 * ks, 32 * nb, lane), acc, 0, 0, 0);
        } else acc = __builtin_amdgcn_mfma_f32_32x32x16_bf16(frag_tr(Xw, RS_X, 0, 32 * pb, lane), frag_tr(Bimg, RS_BC, 0, 32 * nb, lane), acc, 0, 0, 0);
        GAS bf16* Sp = SB + ((size_t)(b * NCH + c) * NH + h) * (HP * NST) + 32 * nb + col;
#pragma unroll
        for (int r = 0; r < 16; ++r) Sp[(32 * pb + (r & 3) + 8 * (r >> 2) + 4 * hh) * NST] = (bf16)f2bf(acc[r]);
        if (tid == 0) DEC[(b * NCH + c) * NH + h] = __expf(al);
    }
    __syncthreads();
}
#ifndef REP_SSD3_WR
#define REP_SSD3_WR 1
#endif
#ifndef REP_SSD3_MM
#define REP_SSD3_MM 1
#endif
#ifndef REP_SSD3_HEADS
#define REP_SSD3_HEADS 1
#endif
__device__ __forceinline__ void ssd3_unit(LAS unsigned char* lds, int tid, const GAS bf16* XC, const GAS bf16* P1, const GAS float* DT, const GAS float* a_log_l, const GAS float* dskip_l, const GAS float* normw_l,
                                          const GAS bf16* HC, GAS bf16* YSN, int b, int c, int g) {
    const int lane = tid & 63, wave = __builtin_amdgcn_readfirstlane(tid >> 6), hh = lane >> 5, col = lane & 31;
    const int t0 = c == 0 ? 0 : NMETA + 128 * (c - 1), Lc = c == 0 ? NMETA : 128; const size_t m0 = (size_t)b * LP + t0;
    LAS unsigned char* Bimg = lds; LAS unsigned char* Cimg = lds + IMG_BC; LAS unsigned char* Mimg0 = lds + 2 * IMG_BC; LAS unsigned char* Ximg0 = lds + 3 * IMG_BC;
    LAS float* acl = (LAS float*)(lds + 3 * IMG_BC + 2 * IMG_X); LAS float* dtl = acl + 1024;
    LAS unsigned char* Mimg1 = Bimg; LAS unsigned char* Ximg1 = Ximg0 + IMG_X;
    ssd_stage_acum(acl, dtl, DT, a_log_l, m0, Lc, g, wave, lane);
    ssd_stage_bc(Bimg, XC + m0 * CONVD + DIN + g * NST, Lc, tid);
    ssd_stage_bc(Cimg, XC + m0 * CONVD + DIN + NG * NST + g * NST, Lc, tid);
    __syncthreads();
    const int ib = wave >> 1, pb = wave & 1;
    f32x16 cb[2];
    const bool live = 32 * ib < Lc;
#pragma unroll
    for (int jj = 0; jj < 2; ++jj) { const int jb = 2 * (wave & 1) + jj; cb[jj] = (f32x16){};
        if (jb <= ib && live) {
#pragma unroll
            for (int ks = 0; ks < 8; ++ks) cb[jj] = __builtin_amdgcn_mfma_f32_32x32x16_bf16(frag_row(Bimg, RS_BC, 32 * jb, 16 * ks, lane), frag_row(Cimg, RS_BC, 32 * ib, 16 * ks, lane), cb[jj], 0, 0, 0); } }
    const int irow = 32 * ib + col;
    bf16x8 cf[8];
#pragma unroll
    for (int ks = 0; ks < 8; ++ks) cf[ks] = frag_row(Cimg, RS_BC, 32 * ib, 16 * ks, lane);
    __syncthreads();
    const int xrow = tid >> 3, xch = tid & 7;
    const GAS bf16* xsrc = XC + (m0 + xrow) * CONVD + (8 * g) * HP + xch * 8;
    v4u xq0 = (v4u){0u, 0u, 0u, 0u}, xq1 = xq0;
    for (int rh_ = 0; rh_ < REP_SSD3_HEADS; ++rh_) {
    if (rh_ > 0) __syncthreads();
    if (xrow < Lc) xq0 = *(const GAS v4u*)xsrc;
    if (xrow + 64 < Lc) xq1 = *(const GAS v4u*)(xsrc + (size_t)64 * CONVD);
    const GAS bf16* Hp0 = HC + ((size_t)(b * NCH + c) * NH + 8 * g) * (HP * NST) + pb * 4096 + lane * 8;
    bf16x8 hq[8];
#pragma unroll
    for (int ks = 0; ks < 8; ++ks) hq[ks] = *(const GAS bf16x8*)(Hp0 + 512 * ks);
    for (int hl = 0; hl < 8; ++hl) {
        const int h = 8 * g + hl;
        LAS unsigned char* Mimg = (hl & 1) ? Mimg1 : Mimg0; LAS unsigned char* Ximg = (hl & 1) ? Ximg1 : Ximg0;
        bf16x8 hf[8], hn[8];
#pragma unroll
        for (int ks = 0; ks < 8; ++ks) { hf[ks] = hq[ks]; hn[ks] = hq[ks]; }
        if (hl < 7) {
#pragma unroll
            for (int ks = 0; ks < 8; ++ks) hn[ks] = *(const GAS bf16x8*)(Hp0 + (size_t)(hl + 1) * (HP * NST) + 512 * ks); }
        v4u xn0 = xq0, xn1 = xq1;
        if (hl < 7 && xrow < Lc) xn0 = *(const GAS v4u*)(xsrc + (hl + 1) * HP);
        if (hl < 7 && xrow + 64 < Lc) xn1 = *(const GAS v4u*)(xsrc + (size_t)64 * CONVD + (hl + 1) * HP);
        const float ai = acl[hl * 128 + irow];
        for (int rw_ = 0; rw_ < REP_SSD3_WR; ++rw_) {
#pragma unroll
        for (int jj = 0; jj < 2; ++jj) { const int jb = 2 * (wave & 1) + jj;
            if (jb <= ib && live) {
                LAS unsigned char* mp = Mimg + irow * RS_BC + (32 * jb + 4 * hh) * 2;
#pragma unroll
                for (int q = 0; q < 4; ++q) { const int j0 = 32 * jb + 8 * q + 4 * hh; const f32x4 aj = *(const LAS f32x4*)(acl + hl * 128 + j0);
                    float v[4];
#pragma unroll
                    for (int e = 0; e < 4; ++e) v[e] = (j0 + e <= irow) ? cb[jj][4 * q + e] * __expf(ai - aj[e]) : 0.f;
                    *(LAS v2u*)(mp + 16 * q) = (v2u){pk2(v[0], v[1]), pk2(v[2], v[3])}; } } }
        { const float s0 = dtl[hl * 128 + xrow], s1 = dtl[hl * 128 + 64 + xrow]; float f[8]; v4u o0, o1;
          unpack8(xq0, f); o0 = (v4u){pk2(f[0] * s0, f[1] * s0), pk2(f[2] * s0, f[3] * s0), pk2(f[4] * s0, f[5] * s0), pk2(f[6] * s0, f[7] * s0)};
          unpack8(xq1, f); o1 = (v4u){pk2(f[0] * s1, f[1] * s1), pk2(f[2] * s1, f[3] * s1), pk2(f[4] * s1, f[5] * s1), pk2(f[6] * s1, f[7] * s1)};
          *(LAS v4u*)(Ximg + xrow * RS_X + xch * 16) = o0; *(LAS v4u*)(Ximg + (xrow + 64) * RS_X + xch * 16) = o1; }
        }
        __syncthreads();
        f32x16 a1 = {}, a2 = {};
        if (live) {
        const int nks = Lc == 128 ? 2 * (ib + 1) : 1;
        for (int rm_ = 0; rm_ < REP_SSD3_MM; ++rm_) { a1 = (f32x16){}; a2 = (f32x16){};
        for (int ks = 0; ks < nks; ++ks) a1 = __builtin_amdgcn_mfma_f32_32x32x16_bf16(frag_tr(Ximg, RS_X, 16 * ks, 32 * pb, lane), frag_row(Mimg, RS_BC, 32 * ib, 16 * ks, lane), a1, 0, 0, 0);
#pragma unroll
        for (int ks = 0; ks < 8; ++ks) a2 = __builtin_amdgcn_mfma_f32_32x32x16_bf16(hf[ks], cf[ks], a2, 0, 0, 0);
        }
        const float ei = __expf(ai);
        v2u wq[4];
#pragma unroll
        for (int q = 0; q < 4; ++q) wq[q] = (v2u){pk2(a1[4 * q] + ei * a2[4 * q], a1[4 * q + 1] + ei * a2[4 * q + 1]), pk2(a1[4 * q + 2] + ei * a2[4 * q + 2], a1[4 * q + 3] + ei * a2[4 * q + 3])};
        GAS bf16* yo = YSN + (m0 + irow) * DIN + h * HP + 32 * pb + 8 * hh;
#pragma unroll
        for (int k = 0; k < 4; k += 2) {
            const auto rx = __builtin_amdgcn_permlane32_swap(wq[k].x, wq[k + 1].x, false, false), ry = __builtin_amdgcn_permlane32_swap(wq[k].y, wq[k + 1].y, false, false);
            if (irow < Lc) *(GAS v4u*)(yo + 8 * k) = (v4u){rx[0], ry[0], rx[1], ry[1]}; }
        }
#pragma unroll
        for (int ks = 0; ks < 8; ++ks) hq[ks] = hn[ks];
        xq0 = xn0; xq1 = xn1;
    }
    }
    __syncthreads();
    for (int i0 = wave; i0 < Lc; i0 += 4 * NWAVES) { const int c0 = g * 512 + lane * 8;
        v4u yv[4], xv[4], zv[4];
#pragma unroll
        for (int q = 0; q < 4; ++q) { const int i = i0 + NWAVES * q; const size_t m = m0 + (i < Lc ? i : i0);
            yv[q] = *(const GAS v4u*)(YSN + m * DIN + c0); xv[q] = *(const GAS v4u*)(XC + m * CONVD + c0); zv[q] = *(const GAS v4u*)(P1 + m * LDP1 + C_Z + c0); }
        const float Dh = dskip_l[c0 >> 6];
        const GAS float* wp = normw_l + c0; const f32x4 wa = *(const GAS f32x4*)wp, wb = *(const GAS f32x4*)(wp + 4);
#pragma unroll
        for (int q = 0; q < 4; ++q) { const int i = i0 + NWAVES * q;
            float v[8], x[8], z[8]; unpack8(yv[q], v); unpack8(xv[q], x); unpack8(zv[q], z); float ss = 0.f;
#pragma unroll
            for (int j = 0; j < 8; ++j) { v[j] = (v[j] + Dh * x[j]) * (z[j] * sigm(z[j])); ss += v[j] * v[j]; }
            ss = wave_sum(ss);
            const float rstd = 1.0f / sqrtf(ss * (1.0f / 512.0f) + 1e-6f);
            if (i < Lc) *(GAS v4u*)(YSN + (m0 + i) * DIN + c0) = (v4u){pk2(v[0] * rstd * wa.x, v[1] * rstd * wa.y), pk2(v[2] * rstd * wa.z, v[3] * rstd * wa.w), pk2(v[4] * rstd * wb.x, v[5] * rstd * wb.y), pk2(v[6] * rstd * wb.z, v[7] * rstd * wb.w)}; }
    }
    __syncthreads();
}

constexpr int RS_V = 528;
#define KLOAD(dst, tile) do { _Pragma("unroll") for (int it = 0; it < 8; ++it) dst[it] = *(const GAS v4u*)(kvb + ((unsigned)idl[16 * (tile) + 2 * it + (lane >> 5)] * 1024u + 16u * (lane & 31))); } while (0)
template <int JT> struct AttnKTile {
    static __device__ __forceinline__ void run(LAS unsigned char* Vst, const LAS unsigned short* idl, const GAS char* kvb, const int lane, const int n, const int kg, const int k4, const int cnt, const int ntile,
                                               const bf16x8 (&bq)[8], v4u (&kst)[3][8], f32x4 (&S)[16], float& mx) {
        if (JT < ntile) {
            LAS unsigned char* half = Vst + 16 * (JT & 1) * RS_V;
#pragma unroll
            for (int it = 0; it < 8; ++it) *(LAS v4u*)(half + (2 * it + (lane >> 5)) * RS_V + 16 * (lane & 31)) = kst[JT % 3][it];
            LDS_WAIT(); asm volatile("" ::: "memory");
            if (JT + 3 < 16) KLOAD(kst[JT % 3], JT + 3);
            f32x4 acc = {0.f, 0.f, 0.f, 0.f};
#pragma unroll
            for (int s8 = 0; s8 < 8; ++s8) acc = __builtin_amdgcn_mfma_f32_16x16x32_bf16(*(const LAS bf16x8*)(half + n * RS_V + (32 * s8 + 8 * kg) * 2), bq[s8], acc, 0, 0, 0);
            f32x4 sv;
#pragma unroll
            for (int i = 0; i < 4; ++i) { const float v = (k4 + i < cnt - 16 * JT) ? acc[i] * 0.125f : -INFINITY; sv[i] = v; mx = fmaxf(mx, v); }
            S[JT] = sv;
            LDS_WAIT(); asm volatile("" ::: "memory");
            AttnKTile<JT + 1>::run(Vst, idl, kvb, lane, n, kg, k4, cnt, ntile, bq, kst, S, mx);
        }
    }
};
template <> struct AttnKTile<16> {
    static __device__ __forceinline__ void run(LAS unsigned char*, const LAS unsigned short*, const GAS char*, int, int, int, int, int, int, const bf16x8 (&)[8], v4u (&)[3][8], f32x4 (&)[16], float&) {}
};
__device__ __forceinline__ void attn_prompt_query(LAS unsigned char* wl, const GAS bf16* P1, const GAS bf16* KVB, const GAS unsigned short* IDXP, GAS bf16* YA, int m, int lane_in) {
    int lane = lane_in; asm volatile("" : "+v"(lane));
    const int b = m / LP, t = m - b * LP, cnt = (t + 1) < 256 ? (t + 1) : 256, ntile = (cnt + 15) >> 4, nstep = (ntile + 1) >> 1;
    LAS unsigned char* Vst = wl; LAS unsigned short* idl = (LAS unsigned short*)(wl + 32 * RS_V);
    { const v2u w = *(const GAS v2u*)(IDXP + (size_t)m * 256 + 4 * lane); const int s0 = 4 * lane;
      const unsigned i0 = (s0 + 0 < cnt) ? (w.x & 0xffffu) : 0u, i1 = (s0 + 1 < cnt) ? (w.x >> 16) : 0u, i2 = (s0 + 2 < cnt) ? (w.y & 0xffffu) : 0u, i3 = (s0 + 3 < cnt) ? (w.y >> 16) : 0u;
      *(LAS v2u*)(idl + s0) = (v2u){i0 | (i1 << 16), i2 | (i3 << 16)}; }
    const int n = lane & 15, kg = lane >> 4;
    int k4 = 4 * kg; asm volatile("" : "+v"(k4));
    bf16x8 bq[8];
#pragma unroll
    for (int s = 0; s < 8; ++s) { bq[s] = (bf16x8){0, 0, 0, 0, 0, 0, 0, 0};
        if ((n >> 2) == (s >> 1)) bq[s] = *(const GAS bf16x8*)(P1 + (size_t)m * LDP1 + C_Q + n * 64 + 32 * (s & 1) + 8 * kg); }
    LDS_WAIT(); asm volatile("" ::: "memory");
    const GAS char* kvb = (const GAS char*)(KVB + (size_t)b * LP * 512);
    const unsigned voff = 512u + 16u * (lane & 31);
    f32x4 S[16];
#pragma unroll
    for (int jt = 0; jt < 16; ++jt) S[jt] = (f32x4){-INFINITY, -INFINITY, -INFINITY, -INFINITY};
    float mx = -INFINITY;
    {
        v4u kst[3][8];
        KLOAD(kst[0], 0); KLOAD(kst[1], 1); KLOAD(kst[2], 2);
        AttnKTile<0>::run(Vst, idl, kvb, lane, n, kg, k4, cnt, ntile, bq, kst, S, mx);
#undef KLOAD
    }
    mx = fmaxf(mx, __shfl_xor(mx, 16)); mx = fmaxf(mx, __shfl_xor(mx, 32));
    float sum = 0.f;
    v4u pa[8];
#pragma unroll
    for (int s = 0; s < 8; ++s) { float p[8];
#pragma unroll
        for (int i = 0; i < 4; ++i) { p[i] = __expf(S[2 * s][i] - mx); p[4 + i] = __expf(S[2 * s + 1][i] - mx); }
#pragma unroll
        for (int i = 0; i < 8; ++i) sum += p[i];
        pa[s] = (v4u){pk2(p[0], p[1]), pk2(p[2], p[3]), pk2(p[4], p[5]), pk2(p[6], p[7])};
        __builtin_amdgcn_sched_barrier(0); }
    sum += __shfl_xor(sum, 16); sum += __shfl_xor(sum, 32);
    const float linv = 1.0f / sum;
    asm volatile("" ::: "memory");
    v4u vst[3][8];
#define VLOAD(dst, tile) do { _Pragma("unroll") for (int it = 0; it < 8; ++it) dst[it] = *(const GAS v4u*)(kvb + ((unsigned)idl[16 * (tile) + 2 * it + (lane >> 5)] * 1024u + voff)); } while (0)
#define VSTORE(src, tt) do { _Pragma("unroll") for (int it = 0; it < 8; ++it) { const int u = 2 * it + (lane >> 5); *(LAS v4u*)(Vst + (8 * (u >> 2) + 4 * (tt) + (u & 3)) * RS_V + 16 * (lane & 31)) = src[it]; } } while (0)
    VLOAD(vst[0], 0); VLOAD(vst[1], 1); VLOAD(vst[2], 2);
    f32x4 o[4];
#pragma unroll
    for (int c = 0; c < 4; ++c) o[c] = (f32x4){0.f, 0.f, 0.f, 0.f};
    const int g16 = lane >> 4, q4 = (lane & 15) >> 2, p4 = lane & 3;
    const LAS unsigned char* trb = Vst + (8 * g16 + q4) * RS_V + 8 * p4;
#pragma unroll
    for (int s = 0; s < 8; ++s) {
        if (s >= nstep) break;
        {
            VSTORE(vst[(2 * s) % 3], 0);
            VSTORE(vst[(2 * s + 1) % 3], 1);
            LDS_WAIT(); asm volatile("" ::: "memory");
            if (2 * s + 3 < 16) VLOAD(vst[(2 * s) % 3], 2 * s + 3);
            if (2 * s + 4 < 16) VLOAD(vst[(2 * s + 1) % 3], 2 * s + 4);
#pragma unroll
            for (int g = 0; g < 4; ++g) {
                const v4u pm = ((n >> 2) == g) ? pa[s] : (v4u){0u, 0u, 0u, 0u};
                const bf16x8 pf = __builtin_bit_cast(bf16x8, pm);
#pragma unroll
                for (int c = 0; c < 4; ++c) { const int ct = 4 * g + c;
                    const s16x4 lo = ldtr(trb + 32 * ct), hi = ldtr(trb + 4 * RS_V + 32 * ct);
                    const bf16x8 bv = (bf16x8){lo[0], lo[1], lo[2], lo[3], hi[0], hi[1], hi[2], hi[3]};
                    o[c] = __builtin_amdgcn_mfma_f32_16x16x32_bf16(pf, bv, o[c], 0, 0, 0); }
            }
            LDS_WAIT(); asm volatile("" ::: "memory");
        }
    }
#undef VLOAD
#undef VSTORE
#pragma unroll
    for (int i = 0; i < 4; ++i) { const float li = __shfl(linv, 4 * kg + i);
#pragma unroll
        for (int c = 0; c < 4; ++c) YA[(size_t)m * D + (4 * kg + i) * 64 + 16 * c + n] = (bf16)f2bf(o[c][i] * li); }
}

__device__ __forceinline__ void attn_sample_query(LAS unsigned char* lds, int tid, const GAS bf16* P1, const GAS bf16* KVB, const GAS float* ck, const GAS float* cv, const GAS int* ptab, const GAS int* IDXS, GAS bf16* YA, int qi) {
    const int lane = tid & 63, wave = tid >> 6, bd = qi >> 3; const size_t m = (size_t)MP + qi;
    LAS float* Sl = (LAS float*)lds;
    LAS float* Ol = Sl + 16 * 256;
    LAS float* ql = Ol + 8 * 1024;
    LAS float* linv = ql + 1024;
    LAS int* rowsel = (LAS int*)(linv + 16);
    { const unsigned w = *(const GAS unsigned*)(P1 + m * LDP1 + C_Q + 2 * tid); ql[2 * tid] = __uint_as_float(w << 16); ql[2 * tid + 1] = __uint_as_float(w & 0xffff0000u); }
    if (tid < 256) rowsel[tid] = IDXS[qi * 256 + tid];
    __syncthreads();
    const int g = lane >> 4, c = lane & 15;
    float qr[4][4];
#pragma unroll
    for (int a = 0; a < 4; ++a) { const f32x4 t = *(const LAS f32x4*)(ql + (4 * g + a) * 64 + 4 * c); qr[a][0] = t.x; qr[a][1] = t.y; qr[a][2] = t.z; qr[a][3] = t.w; }
#pragma unroll 4
    for (int kk = 0; kk < 32; ++kk) {
        const int key = 32 * wave + kk, idx = rowsel[key];
        f32x4 kv;
        if (idx < PAST) { const int page = ptab[bd * NPAGES + (idx >> 7)]; kv = *(const GAS f32x4*)(ck + ((size_t)page * PAGE + (idx & 127)) * 256 + 4 * lane); }
        else { const v2u w = *(const GAS v2u*)(KVB + (size_t)(MP + bd * DS + (idx - PAST)) * 512 + 4 * lane);
            kv = (f32x4){__uint_as_float(w.x << 16), __uint_as_float(w.x & 0xffff0000u), __uint_as_float(w.y << 16), __uint_as_float(w.y & 0xffff0000u)}; }
        float part[4];
#pragma unroll
        for (int a = 0; a < 4; ++a) { float s = (qr[a][0] * kv.x + qr[a][1] * kv.y) + (qr[a][2] * kv.z + qr[a][3] * kv.w);
            part[a] = row16_sum(s); }
        if (c == 0) {
#pragma unroll
            for (int a = 0; a < 4; ++a) Sl[(4 * g + a) * 256 + key] = part[a] * 0.125f; }
    }
    __syncthreads();
#pragma unroll
    for (int hs = 0; hs < 2; ++hs) { const int head = 2 * wave + hs; float v[4]; float mx = -INFINITY;
#pragma unroll
        for (int j = 0; j < 4; ++j) { v[j] = Sl[head * 256 + lane + 64 * j]; mx = fmaxf(mx, v[j]); }
        mx = wave_max(mx); float sum = 0.f;
#pragma unroll
        for (int j = 0; j < 4; ++j) { v[j] = __expf(v[j] - mx); sum += v[j]; Sl[head * 256 + lane + 64 * j] = v[j]; }
        sum = wave_sum(sum);
        if (lane == 0) linv[head] = 1.0f / sum; }
    __syncthreads();
    float o[4][4];
#pragma unroll
    for (int a = 0; a < 4; ++a)
#pragma unroll
        for (int cc = 0; cc < 4; ++cc) o[a][cc] = 0.f;
#pragma unroll 4
    for (int kk = 0; kk < 32; ++kk) {
        const int key = 32 * wave + kk, idx = rowsel[key];
        f32x4 vv;
        if (idx < PAST) { const int page = ptab[bd * NPAGES + (idx >> 7)]; vv = *(const GAS f32x4*)(cv + ((size_t)page * PAGE + (idx & 127)) * 256 + 4 * lane); }
        else { const v2u w = *(const GAS v2u*)(KVB + (size_t)(MP + bd * DS + (idx - PAST)) * 512 + 256 + 4 * lane);
            vv = (f32x4){__uint_as_float(w.x << 16), __uint_as_float(w.x & 0xffff0000u), __uint_as_float(w.y << 16), __uint_as_float(w.y & 0xffff0000u)}; }
#pragma unroll
        for (int a = 0; a < 4; ++a) { const float p = Sl[(4 * g + a) * 256 + key]; o[a][0] += p * vv.x; o[a][1] += p * vv.y; o[a][2] += p * vv.z; o[a][3] += p * vv.w; }
    }
#pragma unroll
    for (int a = 0; a < 4; ++a) *(LAS f32x4*)(Ol + wave * 1024 + (4 * g + a) * 64 + 4 * c) = (f32x4){o[a][0], o[a][1], o[a][2], o[a][3]};
    __syncthreads();
    { float s0 = 0.f, s1 = 0.f;
#pragma unroll
      for (int w = 0; w < 8; ++w) { s0 += Ol[w * 1024 + 2 * tid]; s1 += Ol[w * 1024 + 2 * tid + 1]; }
      const float li = linv[(2 * tid) >> 6];
      *(GAS unsigned*)(YA + m * D + 2 * tid) = pk2(s0 * li, s1 * li); }
    __syncthreads();
}

constexpr int TAIL_R0 = 16384, TAIL_NRT = (MR - TAIL_R0) / 64;
static_assert(TAIL_R0 + 64 * TAIL_NRT == MR, "tail rows");
template <int MODE>
__device__ __forceinline__ void tail_gemm(LAS unsigned char* lds, const GAS bf16* A, int K, const GAS bf16* Bt, int N, const GAS bf16* P1, GAS bf16* T1, GAS bf16* MG, GAS float* H, GAS bf16* A2, int bx, int G, int tid) {
    constexpr int KB = 256, RS = (KB + 8) * 2;
    const int lane = tid & 63, wave = __builtin_amdgcn_readfirstlane(tid >> 6), col = lane & 31, hh = lane >> 5;
    const int nunits = TAIL_NRT * (N / 64), lr = tid >> 3, lc = tid & 7, ti = wave & 3, kh = wave >> 2;
    LAS unsigned char* As = lds; LAS unsigned char* Bs = lds + 64 * RS; LAS float* red = (LAS float*)(lds + 2 * 64 * RS);
    for (int u = bx; u < nunits; u += G) {
        const int rt = u % TAIL_NRT, ct = u / TAIL_NRT;
        const GAS bf16* ap = A + (size_t)(TAIL_R0 + 64 * rt + lr) * K + 8 * lc;
        const GAS bf16* bp = Bt + (size_t)(64 * ct + lr) * K + 8 * lc;
        v4u ra[4], rb[4];
#pragma unroll
        for (int j = 0; j < 4; ++j) { ra[j] = *(const GAS v4u*)(ap + 64 * j); rb[j] = *(const GAS v4u*)(bp + 64 * j); }
        f32x16 acc = {};
        for (int k0 = 0; k0 < K; k0 += KB) {
            __syncthreads();
#pragma unroll
            for (int j = 0; j < 4; ++j) { *(LAS v4u*)(As + lr * RS + (lc * 8 + 64 * j) * 2) = ra[j]; *(LAS v4u*)(Bs + lr * RS + (lc * 8 + 64 * j) * 2) = rb[j]; }
            if (k0 + KB < K) {
#pragma unroll
                for (int j = 0; j < 4; ++j) { ra[j] = *(const GAS v4u*)(ap + k0 + KB + 64 * j); rb[j] = *(const GAS v4u*)(bp + k0 + KB + 64 * j); } }
            __syncthreads();
#pragma unroll
            for (int j = 0; j < 8; ++j) { const int ks = 8 * kh + j;
                const bf16x8 av = *(const LAS bf16x8*)(As + (32 * (ti >> 1) + col) * RS + (16 * ks + 8 * hh) * 2), bv = *(const LAS bf16x8*)(Bs + (32 * (ti & 1) + col) * RS + (16 * ks + 8 * hh) * 2);
                acc = __builtin_amdgcn_mfma_f32_32x32x16_bf16(av, bv, acc, 0, 0, 0); }
        }
        __syncthreads();
        if (kh == 1) {
#pragma unroll
            for (int r = 0; r < 16; ++r) red[(ti * 16 + r) * 64 + lane] = acc[r]; }
        __syncthreads();
        if (kh == 0) {
            const int c = 64 * ct + 32 * (ti & 1) + col;
#pragma unroll
            for (int r = 0; r < 16; ++r) { const size_t row = TAIL_R0 + 64 * rt + 32 * (ti >> 1) + (r & 3) + 8 * (r >> 2) + 4 * hh; const float v = acc[r] + red[(ti * 16 + r) * 64 + lane];
                if (MODE == 1) { const float g = __uint_as_float((unsigned)P1[row * LDP1 + C_GS + c] << 16); T1[row * D + c] = (bf16)f2bf(v * sigm(g)); }
                if (MODE == 2) { const float g = __uint_as_float((unsigned)P1[row * LDP1 + C_GA + c] << 16); MG[row * D + c] = (bf16)f2bf(__uint_as_float((unsigned)T1[row * D + c] << 16) + v * sigm(g)); }
                if (MODE == 3) H[row * D + c] += v;
                if (MODE == 4) { const float w = fmaxf(v, 0.f); A2[row * DFF + c] = (bf16)f2bf(w * w); } }
        }
    }
    __syncthreads();
}

#ifndef REP_SCORE
#define REP_SCORE 1
#endif
#ifndef REP_SCORE_AT
#define REP_SCORE_AT 1
#endif
#ifndef REP_SEL
#define REP_SEL 1
#endif
#ifndef REP_CONV
#define REP_CONV 1
#endif
#ifndef REP_TOPK
#define REP_TOPK 1
#endif
#ifndef REP_SSC
#define REP_SSC 1
#endif
#ifndef REP_SSEL
#define REP_SSEL 1
#endif
#ifndef REP_SSD1
#define REP_SSD1 1
#endif
#ifndef REP_SREC
#define REP_SREC 1
#endif
#ifndef REP_SCAN
#define REP_SCAN 1
#endif
#ifndef REP_ATTS
#define REP_ATTS 1
#endif
#ifndef REP_ATTP
#define REP_ATTP 1
#endif
#ifndef REP_SSD3
#define REP_SSD3 1
#endif
__device__ __forceinline__ void xcd_barrier_ni(unsigned* bar, unsigned x, volatile LAS unsigned* st, int tid, unsigned G) { XcdBarrier b; b.bar = bar; b.x = x; b.st = st; xcd_barrier(b, tid, G); }
__device__ __forceinline__ void assume_global(const void* p) {
#if defined(__HIP_DEVICE_COMPILE__)
    __builtin_assume(!__builtin_amdgcn_is_shared((const __attribute__((address_space(0))) void*)p));
    __builtin_assume(!__builtin_amdgcn_is_private((const __attribute__((address_space(0))) void*)p));
#else
    (void)p;
#endif
}
__device__ __forceinline__ int tid_now(int wave0) { unsigned ones = ~0u; asm volatile("" : "+s"(ones)); return (wave0 << 6) | (int)__builtin_amdgcn_mbcnt_hi(ones, __builtin_amdgcn_mbcnt_lo(ones, 0u)); }
constexpr int NPH = 12, NPHASES = 1 + 2 * NPH;
struct Args { const void* in[24]; float* out; unsigned char* ws; int l_lo, l_hi; };
static_assert(sizeof(Args) == 24 * 8 + 8 + 8 + 8, "Args has no padding");

template <int KLO, int KHI>
__global__ void __launch_bounds__(NT, 2) fwd_t(Args args) {
    extern __shared__ __attribute__((aligned(16))) unsigned char lds_raw[];
    LAS unsigned char* lds0 = (LAS unsigned char*)lds_raw;
    volatile LAS unsigned* MISCW = (volatile LAS unsigned*)(lds0 + MISC_OFF);
    const int G = gridDim.x, bx = blockIdx.x, NGW = G * NWAVES;
    const int wave0 = __builtin_amdgcn_readfirstlane((int)threadIdx.x >> 6);
#define TID_NOW() tid_now(wave0)
    { const int tid0 = threadIdx.x;
      for (int u = tid0; u < (LDS_BYTES - LDSCTL_OFF) / 4; u += NT) ((LAS unsigned*)(lds0 + LDSCTL_OFF))[u] = 0u; }
    __syncthreads();
    XcdBarrier bar = xcd_barrier_post((unsigned*)(args.ws + WS_CTL) + CW_BAR, MISCW + 8);
#define IN(k) (KLO <= (k) && (k) < KHI)
#define SEAM(k) do { if (IN(k) && IN((k) + 1)) xcd_barrier_ni(bar.bar, bar.x, bar.st, TID_NOW(), (unsigned)G); } while (0)
#define PHASE_REGS \
    int tid = TID_NOW(); asm volatile("" : "+v"(tid)); \
    int bxl = bx, Gl = G; asm volatile("" : "+s"(bxl), "+s"(Gl)); (void)bxl; (void)Gl;     \
    const int lane = tid & 63, wave = __builtin_amdgcn_readfirstlane(tid >> 6), gw = bx * NWAVES + wave; \
    unsigned char* ws_ = args.ws; asm volatile("" : "+s"(ws_)); GAS unsigned char* ws = (GAS unsigned char*)ws_;     \
    float* out_ = args.out; asm volatile("" : "+s"(out_)); GAS float* out = (GAS float*)out_; \
    (void)lane; (void)gw; (void)out; \
    GAS float* H = (GAS float*)(ws + WS_H); GAS bf16* U = (GAS bf16*)(ws + WS_U); GAS bf16* P1 = (GAS bf16*)(ws + WS_P1); GAS float* MISCB = (GAS float*)(ws + WS_MISC); GAS bf16* KIB = (GAS bf16*)(ws + WS_KIB); \
    GAS bf16* XC = (GAS bf16*)(ws + WS_XC); GAS float* DT = (GAS float*)(ws + WS_DT); GAS float* DA = (GAS float*)(ws + WS_DA); GAS float* YS = (GAS float*)(ws + WS_YS); GAS bf16* YSN = (GAS bf16*)(ws + WS_YSN); \
    GAS bf16* YA = (GAS bf16*)(ws + WS_YA); GAS bf16* T1 = (GAS bf16*)(ws + WS_T1); GAS bf16* MG = (GAS bf16*)(ws + WS_MG); GAS bf16* A2 = (GAS bf16*)(ws + WS_A2); \
    GAS unsigned short* IDXP = (GAS unsigned short*)(ws + WS_IDXP); GAS int* IDXS = (GAS int*)(ws + WS_IDXS); GAS float* SCS = (GAS float*)(ws + WS_SCS); \
    GAS bf16* SB = (GAS bf16*)(ws + WS_SB); GAS float* DEC = (GAS float*)(ws + WS_DEC); GAS bf16* HC = (GAS bf16*)(ws + WS_HC); GAS bf16* KVB = (GAS bf16*)(ws + WS_KVB); GAS bf16* KIB2 = (GAS bf16*)(ws + WS_KIB2); (void)KIB2; (void)SB; (void)DEC; (void)HC; (void)KVB; \
    GAS unsigned char* wl = ws + WS_W + (size_t)l * WL_SIZE; \
    (void)H; (void)U; (void)P1; (void)MISCB; (void)KIB; (void)XC; (void)DT; (void)DA; (void)YS; (void)YSN; (void)YA; (void)T1; (void)MG; (void)A2; (void)IDXP; (void)IDXS; (void)SCS; (void)wl;
#define LDS_LOCAL LAS unsigned char* lds = lds0; asm volatile("" : "+s"(lds));
#define INP(T, name, i) const GAS T* name; { const void* p_; asm volatile("s_load_dwordx2 %0, %1, %2\n\ts_waitcnt lgkmcnt(0)" : "=s"(p_) : "s"(__builtin_amdgcn_kernarg_segment_ptr()), "i"((i) * 8)); name = (const GAS T*)p_; }

    if (IN(0) && args.l_lo == 0) {
        const int l = 0; PHASE_REGS
        LDS_LOCAL
        INP(float, w_in, 10) INP(float, w_ssm, 17) INP(float, w_att, 18) INP(float, w_out, 19) INP(float, w_up, 21) INP(float, w_down, 22) INP(float, meta, 8) INP(float, x_prompt, 0) INP(float, x_sample, 1) INP(float, norm1_w, 9)
        LAS float* scr = (LAS float*)(lds + wave * 17408);
        constexpr int I_IN = (D / 64) * (NIN / 64), I_SSM = (DIN / 64) * (D / 64), I_ATT = (D / 64) * (D / 64), I_OUT = I_ATT, I_UP = (D / 64) * (DFF / 64), I_DN = (DFF / 64) * (D / 64);
        constexpr int I_L = I_IN + I_SSM + I_ATT + I_OUT + I_UP + I_DN;
        for (int it = gw; it < 2 * I_L; it += NGW) {
            const int l = it / I_L; int r = it % I_L; GAS unsigned char* wl = ws + WS_W + (size_t)l * WL_SIZE;
            if (r < I_IN) { tr_item(w_in + (size_t)l * D * IN_DIM, D, IN_DIM, (GAS bf16*)(wl + WL_WIN), NIN / 64, true, scr, r, lane); continue; } r -= I_IN;
            if (r < I_SSM) { tr_item(w_ssm + (size_t)l * DIN * D, DIN, D, (GAS bf16*)(wl + WL_WSSM), D / 64, false, scr, r, lane); continue; } r -= I_SSM;
            if (r < I_ATT) { tr_item(w_att + (size_t)l * D * D, D, D, (GAS bf16*)(wl + WL_WATT), D / 64, false, scr, r, lane); continue; } r -= I_ATT;
            if (r < I_OUT) { tr_item(w_out + (size_t)l * D * D, D, D, (GAS bf16*)(wl + WL_WOUT), D / 64, false, scr, r, lane); continue; } r -= I_OUT;
            if (r < I_UP) { tr_item(w_up + (size_t)l * D * DFF, D, DFF, (GAS bf16*)(wl + WL_WUP), DFF / 64, false, scr, r, lane); continue; } r -= I_UP;
            tr_item(w_down + (size_t)l * DFF * D, DFF, D, (GAS bf16*)(wl + WL_WDN), D / 64, false, scr, r, lane);
        }
        for (int m0 = gw; m0 < MPAD; m0 += 4 * NGW) {
            const GAS float* src[4]; GAS float* hd[4]; GAS bf16* ud[4]; GAS float* fd[4]; bool live[4];
#pragma unroll
            for (int r = 0; r < 4; ++r) { const int m = m0 + r * NGW; live[r] = m < MPAD; src[r] = nullptr; fd[r] = nullptr; hd[r] = H + (size_t)m * D; ud[r] = U + (size_t)m * D;
                if (m < MP) { const int b = m / LP, t = m - b * LP; src[r] = t < NMETA ? meta + (size_t)t * D : x_prompt + ((size_t)b * SEQ + (t - NMETA)) * D; }
                else if (m < MR) src[r] = x_sample + (size_t)(m - MP) * D; }
            rms_rows4g(src, norm1_w, hd, ud, fd, live, lane);
        }
    }
    SEAM(0);

    for (int l = args.l_lo; l < args.l_hi; ++l) {
        constexpr int pb = 1;

        if (IN(pb + 0)) {
            PHASE_REGS
            LAS unsigned char* lds = lds0;
            pg8::Gemm gm{U, (const GAS bf16*)(wl + WL_WIN), MPAD, NIN, D}; pg8::StaticOrder S; S.init(MPAD, NIN, Gl, bxl);
            pg8::EpiIn E{P1, KVB, MISCB, KIB, KIB2, out + O_PK + (size_t)l * MP * 256, out + O_PV + (size_t)l * MP * 256, out + O_PKI + (size_t)l * MP * 64,
                         out + O_SK + (size_t)l * MS * 256, out + O_SV + (size_t)l * MS * 256, out + O_SKI + (size_t)l * MS * 64};
            pg8::gemm_phase<pg8::EpiIn, pg8::StaticOrder, true, true>(lds, gm, S, E, tid);
        }
        SEAM(pb + 0);

        if (IN(pb + 1)) {
            PHASE_REGS
            LDS_LOCAL
            INP(float, state_conv, 6) INP(float, conv_b, 12) INP(float, conv_w, 11) INP(float, dt_bias, 13) INP(float, a_log, 14) INP(float, cache_ki, 4) INP(int, page_table, 7)
            for (int rp_ = 0; rp_ < REP_CONV; ++rp_) for (int it = bx * NT + tid; it < (MR / 8) * 384; it += G * NT) {
                const int rg = it / 384, c8 = (it % 384) * 8, m0 = 8 * rg;
                const bool isS = m0 >= MP; int tpos, sq;
                if (!isS) { sq = m0 / LP; tpos = m0 - sq * LP; } else { sq = (m0 - MP) >> 3; tpos = (m0 - MP) & 7; }
                float xv[11][8];
#pragma unroll
                for (int k = 0; k < 11; ++k) { const int dtp = tpos - 3 + k;
                    if (dtp >= 0) unpack8(*(const GAS v4u*)(P1 + (size_t)(m0 - 3 + k) * LDP1 + C_XBC + c8), xv[k]);
                    else if (isS) { const GAS float* pp = state_conv + ((size_t)(l * DB + sq) * 3 + (3 + dtp)) * CONVD + c8; const f32x4 a = *(const GAS f32x4*)pp, b = *(const GAS f32x4*)(pp + 4);
                        xv[k][0] = a.x; xv[k][1] = a.y; xv[k][2] = a.z; xv[k][3] = a.w; xv[k][4] = b.x; xv[k][5] = b.y; xv[k][6] = b.z; xv[k][7] = b.w; }
                    else {
#pragma unroll
                        for (int j = 0; j < 8; ++j) xv[k][j] = 0.f; } }
                float wv[4][8], bv[8];
                { const GAS float* bp = conv_b + (size_t)l * CONVD + c8; const f32x4 a = *(const GAS f32x4*)bp, b = *(const GAS f32x4*)(bp + 4);
                  bv[0] = a.x; bv[1] = a.y; bv[2] = a.z; bv[3] = a.w; bv[4] = b.x; bv[5] = b.y; bv[6] = b.z; bv[7] = b.w; }
#pragma unroll
                for (int k = 0; k < 4; ++k) { const GAS float* wp = conv_w + ((size_t)l * 4 + k) * CONVD + c8; const f32x4 a = *(const GAS f32x4*)wp, b = *(const GAS f32x4*)(wp + 4);
                    wv[k][0] = a.x; wv[k][1] = a.y; wv[k][2] = a.z; wv[k][3] = a.w; wv[k][4] = b.x; wv[k][5] = b.y; wv[k][6] = b.z; wv[k][7] = b.w; }
#pragma unroll
                for (int r = 0; r < 8; ++r) {
                    float y[8];
#pragma unroll
                    for (int j = 0; j < 8; ++j) { float s = bv[j];
#pragma unroll
                        for (int k = 0; k < 4; ++k) s += xv[r + k][j] * wv[k][j];
                        y[j] = s * sigm(s); }
                    *(GAS v4u*)(XC + (size_t)(m0 + r) * CONVD + c8) = (v4u){pk2(y[0], y[1]), pk2(y[2], y[3]), pk2(y[4], y[5]), pk2(y[6], y[7])};
                    const int tp = tpos + r; GAS float* cs = nullptr;
                    if (!isS && tp >= LP - 3) cs = out + O_PCONV + ((size_t)(l * NB + sq) * 3 + (tp - (LP - 3))) * CONVD + c8;
                    if (isS && tp >= DS - 3) cs = out + O_SCONV + ((size_t)(l * DB + sq) * 3 + (tp - (DS - 3))) * CONVD + c8;
                    if (cs) { *(GAS f32x4*)cs = (f32x4){xv[r + 3][0], xv[r + 3][1], xv[r + 3][2], xv[r + 3][3]}; *(GAS f32x4*)(cs + 4) = (f32x4){xv[r + 3][4], xv[r + 3][5], xv[r + 3][6], xv[r + 3][7]}; }
                }
            }
            for (int it = bx * NT + tid; it < MR * NH; it += G * NT) {
                const int m = it >> 5, h = it & 31;
                const float raw = MISCB[(size_t)m * 128 + MC_DT + h] + dt_bias[l * NH + h];
                const float sp = fmaxf(raw, 0.f) + log1pf(__expf(-fabsf(raw)));
                const float A = -__expf(a_log[l * NH + h]);
                DT[it] = sp; DA[it] = __expf(sp * A);
            }
            for (int rp_ = 0; rp_ < REP_TOPK; ++rp_) {
                constexpr int SLD = 4352;
                LAS unsigned* scl = (LAS unsigned*)lds; LAS unsigned* histq = (LAS unsigned*)(lds + 8 * SLD * 4);
                for (int j = 0; ; ++j) {
                    const int unit = j * G + ((j & 1) ? (G - 1 - bx) : bx); if (unit >= NB * (LP / 8)) break;
                    const int b = unit & (NB - 1), qb = (LP / 8 - 1) - (unit >> 2);
                    const size_t mq0 = (size_t)b * LP + 8 * qb; const int nkeys = 8 * qb + 8, ntl = (nkeys + 31) >> 5;
                    bf16x8 afr[2][4]; float wq[2][2][8];
                    idx_load_q(P1, MISCB, mq0, lane, afr, wq);
                    const int kcol = lane & 31, hh = lane >> 5;
                    for (int rs_ = 0; rs_ < REP_SCORE; ++rs_) {
                    if (rs_) __syncthreads();
                    for (int i = tid; i < 8 * HB; i += NT) histq[i] = 0u;
                    __syncthreads();
                    const GAS bf16* kp0 = KIB2 + (size_t)b * KT_PER_B * 2048 + lane * 8;
                    bf16x8 ks0[4], ks1[4], ks2[4];
#pragma unroll
                    for (int ks = 0; ks < 4; ++ks) { ks0[ks] = (bf16x8){0, 0, 0, 0, 0, 0, 0, 0}; ks1[ks] = ks0[ks]; ks2[ks] = ks0[ks]; }
#define SC_LOAD(S, T) { _Pragma("unroll") for (int ks = 0; ks < 4; ++ks) S[ks] = *(const GAS bf16x8*)(kp0 + (size_t)(T) * 2048 + 512 * ks); }
#define SC_TILE(S, KT, LOADC) { \
                        f32x16 a0 = {}, a1 = {}; \
                        _Pragma("unroll") for (int ks = 0; ks < 4; ++ks) { a0 = __builtin_amdgcn_mfma_f32_32x32x16_bf16(afr[0][ks], S[ks], a0, 0, 0, 0); a1 = __builtin_amdgcn_mfma_f32_32x32x16_bf16(afr[1][ks], S[ks], a1, 0, 0, 0); } \
                        asm volatile("" : "+v"(a0), "+v"(a1) :: "memory");        \
                        if (LOADC) SC_LOAD(S, (KT) + 3 * NWAVES) \
                        const int key = 32 * (KT) + kcol; \
                        _Pragma("unroll") for (int rt = 0; rt < 2; ++rt) \
                        _Pragma("unroll") for (int jq = 0; jq < 2; ++jq) { const int q = 4 * rt + 2 * hh + jq; const float sv = idx_reduce(rt ? a1 : a0, 8 * jq, wq[rt][jq]); \
                            scl[q * SLD + key] = f2key(sv); \
                            int bn; asm("v_cvt_flr_i32_f32 %0, %1" : "=v"(bn) : "v"(sv * 64.0f)); bn = min(max(bn + 256, 0), HB - 1); \
                            if (SC_ATOM) __hip_atomic_fetch_add(histq + q * HB + bn, key <= 8 * qb + q ? 1u : 0u, __ATOMIC_RELAXED, __HIP_MEMORY_SCOPE_WORKGROUP); } }
                    const bool SC_ATOM = REP_SCORE_AT || rs_ == REP_SCORE - 1;
                    int kt = wave;
                    if (kt + 5 * NWAVES < ntl) {
                        SC_LOAD(ks0, wave) SC_LOAD(ks1, wave + NWAVES) SC_LOAD(ks2, wave + 2 * NWAVES)
                        do { SC_TILE(ks0, kt, true) SC_TILE(ks1, kt + NWAVES, true) SC_TILE(ks2, kt + 2 * NWAVES, true) kt += 3 * NWAVES; } while (kt + 5 * NWAVES < ntl);
                    } else {
                        if (wave < ntl) SC_LOAD(ks0, wave)
                        if (wave + NWAVES < ntl) SC_LOAD(ks1, wave + NWAVES)
                        if (wave + 2 * NWAVES < ntl) SC_LOAD(ks2, wave + 2 * NWAVES)
                    }
                    for (; kt < ntl; kt += 3 * NWAVES) {
                        SC_TILE(ks0, kt, kt + 3 * NWAVES < ntl)
                        if (kt + NWAVES < ntl) SC_TILE(ks1, kt + NWAVES, kt + 4 * NWAVES < ntl)
                        if (kt + 2 * NWAVES < ntl) SC_TILE(ks2, kt + 2 * NWAVES, kt + 5 * NWAVES < ntl)
                    }
#undef SC_TILE
#undef SC_LOAD
                    }
                    __syncthreads();
                    for (int r2_ = 0; r2_ < REP_SEL; ++r2_) { const int t = 8 * qb + wave, n = t + 1; GAS unsigned short* op = IDXP + ((size_t)b * LP + t) * 256;
                      if (n <= 256) { for (int i = lane; i < n; i += 64) op[i] = (unsigned short)i; }
                      else topk_select(scl + wave * SLD, n, lane, op, histq + wave * HB); }
                    __syncthreads();
                }
            }
            const GAS float* cki = cache_ki + (size_t)l * NPOOL * PAGE * 64;
            for (int rp_ = 0; rp_ < REP_SSC; ++rp_) for (int unit = bx; unit < DB * 8; unit += G) {
                const int bd = unit >> 3, ch = unit & 7; const size_t mq0 = (size_t)MP + bd * DS;
                bf16x8 afr[2][4]; float wq[2][2][8];
                idx_load_q(P1, MISCB, mq0, lane, afr, wq);
                const int kcol = lane & 31, hh = lane >> 5;
                const int pg = 8 * ch + wave, phys = page_table[bd * NPAGES + pg];
                const GAS float* kbase = cki + (size_t)phys * PAGE * 64;
#pragma unroll 1
                for (int kt = 0; kt < 4; ++kt) {
                    const int kin = 32 * kt + kcol; const GAS float* kp = kbase + (size_t)kin * 64 + 8 * hh;
                    bf16x8 bfr[4];
#pragma unroll
                    for (int ks = 0; ks < 4; ++ks) { const f32x4 a = *(const GAS f32x4*)(kp + 16 * ks), bq = *(const GAS f32x4*)(kp + 16 * ks + 4);
                        const v4u w = (v4u){pk2(a.x, a.y), pk2(a.z, a.w), pk2(bq.x, bq.y), pk2(bq.z, bq.w)}; bfr[ks] = __builtin_bit_cast(bf16x8, w); }
                    float sc[2][2];
                    idx_scores(afr, bfr, wq, sc);
#pragma unroll
                    for (int rt = 0; rt < 2; ++rt)
#pragma unroll
                        for (int jq = 0; jq < 2; ++jq) SCS[(size_t)(bd * DS + 4 * rt + 2 * hh + jq) * SCS_LD + 128 * pg + kin] = sc[rt][jq];
                }
                if (ch == 7 && wave == 0) {
                    const int j = kcol < DS ? kcol : DS - 1; const GAS bf16* kp = KIB + (mq0 + j) * 64 + 8 * hh;
                    bf16x8 bfr[4];
#pragma unroll
                    for (int ks = 0; ks < 4; ++ks) bfr[ks] = *(const GAS bf16x8*)(kp + 16 * ks);
                    float sc[2][2];
                    idx_scores(afr, bfr, wq, sc);
                    if (kcol < DS) {
#pragma unroll
                        for (int rt = 0; rt < 2; ++rt)
#pragma unroll
                            for (int jq = 0; jq < 2; ++jq) { const int q = 4 * rt + 2 * hh + jq; SCS[(size_t)(bd * DS + q) * SCS_LD + PAST + kcol] = (kcol <= q) ? sc[rt][jq] : -INFINITY; }
                    }
                }
            }
        }
        SEAM(pb + 1);

        if (IN(pb + 2)) {
            PHASE_REGS
            LDS_LOCAL
            INP(float, a_log, 14) INP(float, state_ssm, 5) INP(float, d_skip, 15)
            for (int rp_ = 0; rp_ < REP_SSEL; ++rp_) for (int qi = bx; qi < MS; qi += G) {
                LAS unsigned* scl = (LAS unsigned*)lds; LAS unsigned* hs = (LAS unsigned*)(lds + 8448 * 4);
                hs[tid] = 0u;
                __syncthreads();
                for (int i = tid; i < PAST + DS; i += NT) { const float sc = SCS[(size_t)qi * SCS_LD + i]; scl[i] = f2key(sc);
                    int bn = __float2int_rd(fmaxf(sc, -8.0f) * 64.0f) + 256; bn = bn < 0 ? 0 : (bn > HB - 1 ? HB - 1 : bn);
                    __hip_atomic_fetch_add(hs + bn, 1u, __ATOMIC_RELAXED, __HIP_MEMORY_SCOPE_WORKGROUP); }
                __syncthreads();
                if (wave == 0) { int ns = PAST + DS; asm volatile("" : "+s"(ns)); topk_select(scl, ns, lane, IDXS + qi * 256, hs); }
                __syncthreads();
            }
            for (int rp_ = 0; rp_ < REP_SSD1; ++rp_) for (int unit = bx; unit < NB * NCH * NG; unit += G) {
                int b, c, g; if (unit < NB * 32 * NG) { b = unit >> 7; c = 1 + ((unit & 127) >> 2); g = unit & 3; } else { const int r = unit - NB * 32 * NG; b = r >> 2; c = 0; g = r & 3; }
                ssd1_unit(lds, tid, XC, DT, a_log + l * NH, SB, DEC, b, c, g);
            }
            for (int rp_ = 0; rp_ < REP_SREC; ++rp_) for (int unit = bx; unit < DB * NH * 2; unit += G) {
                const int bd = unit >> 6, h = (unit >> 1) & 31, p0 = (unit & 1) * 32;
                ssd_unit(lds, tid, XC, DT, DA, (size_t)MP + bd * DS, DS, h, p0, state_ssm + ((size_t)(l * DB + bd) * NH + h) * HP * NST,
                         out + O_SSSM + ((size_t)(l * DB + bd) * NH + h) * HP * NST, YS, d_skip[l * NH + h]);
                __syncthreads();
            }
        }
        SEAM(pb + 2);

        if (IN(pb + 3)) {
            PHASE_REGS
            LDS_LOCAL
            INP(float, cache_k, 2) INP(float, cache_v, 3) INP(int, page_table, 7)
            for (int rp_ = 0; rp_ < REP_SCAN; ++rp_) for (int e = bx * NT + tid; e < NB * NH * 2048; e += G * NT) {
                const int b = e / (NH * 2048), h = (e >> 11) & 31, q = e & 2047;
                f32x4 Hr = {0.f, 0.f, 0.f, 0.f};
#pragma unroll 3
                for (int c = 0; c < NCH; ++c) { const size_t idx = (size_t)(b * NCH + c) * NH + h;
                    { const int p = q >> 5, n = (q & 31) * 4;
                      *(GAS v2u*)(HC + idx * (HP * NST) + ((((p >> 5) * 8 + (n >> 4)) * 2 + ((n >> 3) & 1)) * 32 + (p & 31)) * 8 + (n & 7)) = (v2u){pk2(Hr.x, Hr.y), pk2(Hr.z, Hr.w)}; }
                    const float d = DEC[idx]; const v2u sw = *(const GAS v2u*)(SB + idx * (HP * NST) + q * 4);
                    const f32x4 sv = (f32x4){__uint_as_float(sw.x << 16), __uint_as_float(sw.x & 0xffff0000u), __uint_as_float(sw.y << 16), __uint_as_float(sw.y & 0xffff0000u)};
                    Hr = Hr * d + sv; }
                *(GAS f32x4*)(out + O_PSSM + ((size_t)(l * NB + b) * NH + h) * (HP * NST) + q * 4) = Hr;
            }
            const GAS float* ck = cache_k + (size_t)l * NPOOL * PAGE * 256; const GAS float* cv = cache_v + (size_t)l * NPOOL * PAGE * 256;
            for (int rp_ = 0; rp_ < REP_ATTS; ++rp_) for (int qi = bx; qi < MS; qi += G) attn_sample_query(lds, tid, P1, KVB, ck, cv, page_table, IDXS, YA, qi);
            for (int rp_ = 0; rp_ < REP_ATTP; ++rp_) {
                if (Gl == 256) {
                    const int bsel = (bxl & 7) >> 1, widx = ((((bxl >> 3) * NWAVES) + wave) << 1) | (bxl & 1);
                    for (int tr = widx; tr < LP; tr += 512) attn_prompt_query(lds + wave * 17408, P1, KVB, IDXP, YA, bsel * LP + (LP - 1 - tr), lane);
                } else for (int m = gw; m < MP; m += NGW) attn_prompt_query(lds + wave * 17408, P1, KVB, IDXP, YA, m, lane);
            }
        }
        SEAM(pb + 3);

        if (IN(pb + 4)) {
            PHASE_REGS
            LDS_LOCAL
            INP(float, a_log, 14) INP(float, d_skip, 15) INP(float, ssm_norm_w, 16)
            for (int rp_ = 0; rp_ < REP_SSD3; ++rp_) for (int unit = bx; unit < NB * NCH * NG; unit += G) {
                int b, c, g; if (unit < NB * 32 * NG) { b = unit >> 7; c = 1 + ((unit & 127) >> 2); g = unit & 3; } else { const int r = unit - NB * 32 * NG; b = r >> 2; c = 0; g = r & 3; }
                ssd3_unit(lds, tid, XC, P1, DT, a_log + l * NH, d_skip + l * NH, ssm_norm_w + (size_t)l * DIN, HC, YSN, b, c, g);
            }
            for (int it = gw; it < MS * NG; it += NGW) {
                const int m = MP + (it >> 2), g = it & 3, c0 = g * 512 + lane * 8;
                const GAS float* yp = YS + (size_t)m * DIN + c0; const f32x4 a = *(const GAS f32x4*)yp, b = *(const GAS f32x4*)(yp + 4);
                float z[8]; unpack8(*(const GAS v4u*)(P1 + (size_t)m * LDP1 + C_Z + c0), z);
                float v[8] = {a.x, a.y, a.z, a.w, b.x, b.y, b.z, b.w}; float ss = 0.f;
#pragma unroll
                for (int j = 0; j < 8; ++j) { v[j] = v[j] * (z[j] * sigm(z[j])); ss += v[j] * v[j]; }
                ss = wave_sum(ss);
                const float rstd = 1.0f / sqrtf(ss * (1.0f / 512.0f) + 1e-6f);
                const GAS float* wp = ssm_norm_w + (size_t)l * DIN + c0; const f32x4 wa = *(const GAS f32x4*)wp, wb = *(const GAS f32x4*)(wp + 4);
                *(GAS v4u*)(YSN + (size_t)m * DIN + c0) = (v4u){pk2(v[0] * rstd * wa.x, v[1] * rstd * wa.y), pk2(v[2] * rstd * wa.z, v[3] * rstd * wa.w), pk2(v[4] * rstd * wb.x, v[5] * rstd * wb.y), pk2(v[6] * rstd * wb.z, v[7] * rstd * wb.w)};
            }
        }
        SEAM(pb + 4);

        if (IN(pb + 5)) {
            PHASE_REGS
            LAS unsigned char* lds = lds0;
            pg8::Gemm gm{YSN, (const GAS bf16*)(wl + WL_WSSM), TAIL_R0, D, DIN}; pg8::StaticOrder S; S.init(TAIL_R0, D, Gl, bxl);
            pg8::EpiGate1 E{P1, T1};
            pg8::gemm_phase<pg8::EpiGate1, pg8::StaticOrder, true, true>(lds, gm, S, E, tid);
            tail_gemm<1>(lds, YSN, DIN, (const GAS bf16*)(wl + WL_WSSM), D, P1, T1, MG, H, A2, bxl, Gl, tid);
        }
        if (IN(pb + 6)) {
            PHASE_REGS
            LAS unsigned char* lds = lds0;
            pg8::Gemm gm{YA, (const GAS bf16*)(wl + WL_WATT), TAIL_R0, D, D}; pg8::StaticOrder S; S.init(TAIL_R0, D, Gl, bxl);
            pg8::EpiGate2 E{P1, T1, MG};
            pg8::gemm_phase<pg8::EpiGate2, pg8::StaticOrder, true, true>(lds, gm, S, E, tid);
            tail_gemm<2>(lds, YA, D, (const GAS bf16*)(wl + WL_WATT), D, P1, T1, MG, H, A2, bxl, Gl, tid);
        }
        SEAM(pb + 6);
        if (IN(pb + 7)) {
            PHASE_REGS
            LAS unsigned char* lds = lds0;
            pg8::Gemm gm{MG, (const GAS bf16*)(wl + WL_WOUT), TAIL_R0, D, D}; pg8::StaticOrder S; S.init(TAIL_R0, D, Gl, bxl);
            pg8::EpiResid E{H};
            pg8::gemm_phase<pg8::EpiResid, pg8::StaticOrder, true, true>(lds, gm, S, E, tid);
            tail_gemm<3>(lds, MG, D, (const GAS bf16*)(wl + WL_WOUT), D, P1, T1, MG, H, A2, bxl, Gl, tid);
        }
        SEAM(pb + 7);
        if (IN(pb + 8)) {
            PHASE_REGS
            INP(float, norm2_w, 20)
            for (int m = gw; m < MPAD; m += 4 * NGW) rms_rows4(H, norm2_w + (size_t)l * D, U, m, NGW, MPAD, lane);
        }
        SEAM(pb + 8);
        if (IN(pb + 9)) {
            PHASE_REGS
            LAS unsigned char* lds = lds0;
            pg8::Gemm gm{U, (const GAS bf16*)(wl + WL_WUP), TAIL_R0, DFF, D}; pg8::StaticOrder S; S.init(TAIL_R0, DFF, Gl, bxl);
            pg8::EpiUp E{A2};
            pg8::gemm_phase<pg8::EpiUp, pg8::StaticOrder, true, true>(lds, gm, S, E, tid);
            tail_gemm<4>(lds, U, D, (const GAS bf16*)(wl + WL_WUP), DFF, P1, T1, MG, H, A2, bxl, Gl, tid);
        }
        SEAM(pb + 9);
        if (IN(pb + 10)) {
            PHASE_REGS
            LAS unsigned char* lds = lds0;
            pg8::Gemm gm{A2, (const GAS bf16*)(wl + WL_WDN), TAIL_R0, D, DFF}; pg8::StaticOrder S; S.init(TAIL_R0, D, Gl, bxl);
            pg8::EpiResid E{H};
            pg8::gemm_phase<pg8::EpiResid, pg8::StaticOrder, true, true>(lds, gm, S, E, tid);
            tail_gemm<3>(lds, A2, DFF, (const GAS bf16*)(wl + WL_WDN), D, P1, T1, MG, H, A2, bxl, Gl, tid);
        }
        SEAM(pb + 10);
        if (IN(pb + 11)) {
            PHASE_REGS
            INP(float, norm1_w, 9) INP(float, final_w, 23)
            if (l == 0) { for (int m = gw; m < MPAD; m += 4 * NGW) rms_rows4(H, norm1_w + D, U, m, NGW, MPAD, lane); }
            else {
                for (int m0 = gw; m0 < MR; m0 += 4 * NGW) {
                    const GAS float* src[4]; GAS float* hd[4]; GAS bf16* ud[4]; GAS float* fd[4]; bool live[4];
#pragma unroll
                    for (int r = 0; r < 4; ++r) { const int m = m0 + r * NGW; hd[r] = nullptr; ud[r] = nullptr; fd[r] = nullptr; src[r] = H + (size_t)(m < MR ? m : m0) * D;
                        if (m < MP) { const int b = m / LP, t = m - b * LP; if (t >= NMETA) fd[r] = out + O_YP + ((size_t)b * SEQ + (t - NMETA)) * D; }
                        else if (m < MR) fd[r] = out + O_YS + (size_t)(m - MP) * D;
                        live[r] = fd[r] != nullptr; }
                    rms_rows4g(src, final_w, hd, ud, fd, live, lane);
                }
            }
        }
        if (IN(pb + 11) && IN(1) && l + 1 < args.l_hi) xcd_barrier_ni(bar.bar, bar.x, bar.st, TID_NOW(), (unsigned)G);
    }
#undef IN
#undef SEAM
}

#ifndef MK_PER_PHASE
#define MK_PER_PHASE 0
#endif
extern "C" void kernel_launch(void* const* d_in, const int* in_sizes, int n_in, void* d_out, int out_size, void* d_ws, size_t ws_size, hipStream_t stream) {
    static int grid = 0;
    if (grid == 0) {
        if (n_in != 24 || (size_t)out_size != O_END || ws_size < WS_END) { fprintf(stderr, "kernel_launch: unexpected shapes: n_in %d out %d (want %zu) ws %zu (want %zu)\n", n_in, out_size, (size_t)O_END, ws_size, (size_t)WS_END); grid = -1; return; }
        int dev = 0, cus = 0, per_cu = 0;
        if (hipGetDevice(&dev) != hipSuccess || hipDeviceGetAttribute(&cus, hipDeviceAttributeMultiprocessorCount, dev) != hipSuccess) { grid = -1; return; }
        bool ok = true;
#if MK_PER_PHASE
#define SETA(K) ok = ok && hipFuncSetAttribute((const void*)fwd_t<K, K + 1>, hipFuncAttributeMaxDynamicSharedMemorySize, LDS_BYTES) == hipSuccess
        SETA(0); SETA(1); SETA(2); SETA(3); SETA(4); SETA(5); SETA(6); SETA(7); SETA(8); SETA(9); SETA(10); SETA(11); SETA(12);
#else
        ok = hipFuncSetAttribute((const void*)fwd_t<0, NPH + 1>, hipFuncAttributeMaxDynamicSharedMemorySize, LDS_BYTES) == hipSuccess;
        ok = ok && hipOccupancyMaxActiveBlocksPerMultiprocessor(&per_cu, (const void*)fwd_t<0, NPH + 1>, NT, LDS_BYTES) == hipSuccess && per_cu >= 1;
#endif
        if (!ok) { fprintf(stderr, "kernel_launch: hipFuncSetAttribute / occupancy query failed (per_cu %d)\n", per_cu); (void)hipGetLastError(); grid = -1; return; }
        grid = cus;
    }
    if (grid < 0) return;
    (void)hipMemsetAsync((char*)d_ws + WS_CTL, 0, CTL_ZERO_BYTES, stream);
    Args a{};
    for (int i = 0; i < 24; ++i) a.in[i] = d_in[i];
    a.out = (float*)d_out; a.ws = (unsigned char*)d_ws;
#if MK_PER_PHASE
#define LAUNCH_PH(K) hipLaunchKernelGGL((fwd_t<K, K + 1>), dim3(grid), dim3(NT), LDS_BYTES, stream, a)
    a.l_lo = 0; a.l_hi = 1; LAUNCH_PH(0);
    for (int l = 0; l < 2; ++l) { a.l_lo = l; a.l_hi = l + 1;
        LAUNCH_PH(1); LAUNCH_PH(2); LAUNCH_PH(3); LAUNCH_PH(4); LAUNCH_PH(5); LAUNCH_PH(6); LAUNCH_PH(7); LAUNCH_PH(8); LAUNCH_PH(9); LAUNCH_PH(10); LAUNCH_PH(11); LAUNCH_PH(12); }
#else
    a.l_lo = 0; a.l_hi = 2; hipLaunchKernelGGL((fwd_t<0, NPH + 1>), dim3(grid), dim3(NT), LDS_BYTES, stream, a);
#endif
}
```

```cpp
#include <hip/hip_runtime.h>
#include <cstdio>
#include <cstdint>
#define GAS __attribute__((address_space(1)))
#define LAS __attribute__((address_space(3)))

constexpr int D = 1024, NB = 4, SEQ = 4096, NMETA = 16, LP = SEQ + NMETA, MP = NB * LP, DB = 32, DS = 8, MS = DB * DS, MR = MP + MS, MPAD = 16896;
constexpr int DIN = 2048, CONVD = 3072, NH = 32, HP = 64, NG = 4, NST = 128;
constexpr int DFF = 4096, IN_DIM = 9320;
constexpr int PAST = 8192, PAGE = 128, NPAGES = 64, NPOOL = 2560;
constexpr int NIN = 9472, LDP1 = 9216;
constexpr int C_Z = 0, C_XBC = 2048, C_Q = 5120, C_K = 6144, C_V = 6400, C_QI = 6656, C_GS = 7168, C_GA = 8192;
constexpr int MC_KI = 0, MC_DT = 64, MC_WI = 96;
constexpr int KT_PER_B = (LP + 31) / 32;
static_assert(MP == 16448 && MR == 16704 && MPAD % 256 == 0 && MPAD >= MR, "rows");
namespace pg8 {
#define PG8_LAS __attribute__((address_space(3)))
typedef unsigned short bf16_t;
typedef short bf16x8 __attribute__((ext_vector_type(8)));
typedef float f32x4 __attribute__((ext_vector_type(4)));
typedef unsigned u32x4 __attribute__((ext_vector_type(4)));
constexpr int BM = 256, BK = 64, HALF = 128, HTB = HALF * BK * 2  , STAGE_BYTES = 8 * HTB, NXCD = 8, WGM = 8;

__host__ __device__ __forceinline__ int lds_byte(int r, int c) { const int st = (r >> 4) * 2 + (c >> 5), rr = r & 15, cc = c & 31, ob = rr * 64 + cc * 2; return st * 1024 + (ob ^ (((ob >> 9) & 1) << 5)); }
__host__ __device__ __forceinline__ void stage_rc(int b, int& R, int& C) { const int st = b / 1024, sb = b % 1024, swz = sb ^ (((sb >> 9) & 1) << 5); R = (st >> 1) * 16 + swz / 64; C = (st & 1) * 32 + (swz % 64) / 2; }
__host__ __device__ __forceinline__ int perm32(int rho) { const int n = rho >> 4, i = rho & 15; return 8 * (i >> 2) + 4 * n + (i & 3); }

struct Unit { int pm, pn; };
struct Gemm { const GAS bf16_t* A; const GAS bf16_t* Bt; int M, N, K; };

struct StaticOrder {
    int nM, nN, nwg, G, c;
    __host__ __device__ void init(int M, int N, int G_, int c_) { nM = M / BM; nN = N / BM; nwg = nM * nN; G = G_; c = c_; }
    __host__ __device__ bool next(int i, Unit& u) const {
        const long L = (long)i * G + c; if (L >= nwg) return false;
        int wgid = (int)L; { const int q = nwg / NXCD, r = nwg % NXCD, xcd = wgid % NXCD, off = wgid / NXCD; wgid = (xcd < r ? xcd * (q + 1) : r * (q + 1) + (xcd - r) * q) + off; }
        const int nig = WGM * nN, gid = wgid / nig, fm = gid * WGM, gsz = (nM - fm) < WGM ? (nM - fm) : WGM;
        u.pm = fm + ((wgid % nig) % gsz); u.pn = (wgid % nig) / gsz; return true;
    }
    __device__ __forceinline__ void a_ready(const Unit&) const {}
    __device__ __forceinline__ void done(const Unit&) const {}
};

__device__ __forceinline__ unsigned cvt_pk_bf16(float lo, float hi) { unsigned r; asm volatile("v_cvt_pk_bf16_f32 %0, %1, %2" : "=v"(r) : "v"(lo), "v"(hi)); return r; }

__device__ __forceinline__ void unpack8(const u32x4 w, float (&f)[8]) {
    f[0] = __uint_as_float(w.x << 16); f[1] = __uint_as_float(w.x & 0xffff0000u); f[2] = __uint_as_float(w.y << 16); f[3] = __uint_as_float(w.y & 0xffff0000u);
    f[4] = __uint_as_float(w.z << 16); f[5] = __uint_as_float(w.z & 0xffff0000u); f[6] = __uint_as_float(w.w << 16); f[7] = __uint_as_float(w.w & 0xffff0000u);
}
__device__ __forceinline__ u32x4 pack8(const f32x4 v0, const f32x4 v1) { u32x4 w; w.x = cvt_pk_bf16(v0[0], v0[1]); w.y = cvt_pk_bf16(v0[2], v0[3]); w.z = cvt_pk_bf16(v1[0], v1[1]); w.w = cvt_pk_bf16(v1[2], v1[3]); return w; }
__device__ __forceinline__ float sigm(float x) { return __builtin_amdgcn_rcpf(1.0f + __expf(-x)); }

struct EpiIn {
    static constexpr bool PERM = true, AFTER_DRAIN = false;
    GAS bf16_t* P1; GAS bf16_t* kvb; GAS float* misc; GAS bf16_t* kib; GAS bf16_t* kib2; GAS float *pk, *pv, *pki, *sk, *sv, *ski;
    __device__ __forceinline__ void operator()(const f32x4 (&acc)[2][2][4][2], const Unit& u, int wr, int wc, int fr, int fq) const {
        const int row0 = u.pm * BM + wr * 64 + fr, lc0 = wc * 32 + 8 * fq;
#pragma unroll
        for (int ai = 0; ai < 2; ++ai)
#pragma unroll
            for (int m = 0; m < 4; ++m) {
                const int row = row0 + ai * HALF + m * 16;
#pragma unroll
                for (int bj = 0; bj < 2; ++bj) {
                    const f32x4 v0 = acc[ai][bj][m][0], v1 = acc[ai][bj][m][1];
                    const int lc = lc0 + bj * HALF;
                    if (u.pn < 36) {
                        if (u.pn == 24 || u.pn == 25) *(GAS u32x4*)(kvb + (size_t)row * 512 + (u.pn - 24) * BM + lc) = pack8(v0, v1);
                        else *(GAS u32x4*)(P1 + (size_t)row * LDP1 + u.pn * BM + lc) = pack8(v0, v1);
                        if (u.pn == 24) {
                            if (row < MP) { GAS float* dst = pk + (size_t)row * 256 + lc; *(GAS f32x4*)dst = v0; *(GAS f32x4*)(dst + 4) = v1; }
                            else if (row < MR) { GAS float* dst = sk + (size_t)(row - MP) * 256 + lc; *(GAS f32x4*)dst = v0; *(GAS f32x4*)(dst + 4) = v1; }
                        } else if (u.pn == 25) {
                            if (row < MP) { GAS float* dst = pv + (size_t)row * 256 + lc; *(GAS f32x4*)dst = v0; *(GAS f32x4*)(dst + 4) = v1; }
                            else if (row < MR) { GAS float* dst = sv + (size_t)(row - MP) * 256 + lc; *(GAS f32x4*)dst = v0; *(GAS f32x4*)(dst + 4) = v1; }
                        }
                    } else {
                        if (lc < 128) { GAS float* d = misc + (size_t)row * 128 + lc; *(GAS f32x4*)d = v0; *(GAS f32x4*)(d + 4) = v1; }
                        if (lc < 64) {
                            *(GAS u32x4*)(kib + (size_t)row * 64 + lc) = pack8(v0, v1);
                            if (row < MP) { const int b = row / LP, t = row - b * LP;
                                *(GAS u32x4*)(kib2 + ((size_t)(b * KT_PER_B + (t >> 5)) * 2048 + (lc >> 4) * 512 + ((lc >> 3) & 1) * 256 + (t & 31) * 8)) = pack8(v0, v1); }
                            if (row < MP) { GAS float* dst = pki + (size_t)row * 64 + lc; *(GAS f32x4*)dst = v0; *(GAS f32x4*)(dst + 4) = v1; }
                            else if (row < MR) { GAS float* dst = ski + (size_t)(row - MP) * 64 + lc; *(GAS f32x4*)dst = v0; *(GAS f32x4*)(dst + 4) = v1; }
                        }
                    }
                }
            }
    }
};
struct EpiGate1 {
    static constexpr bool PERM = true, AFTER_DRAIN = false;
    const GAS bf16_t* P1; GAS bf16_t* T1;
    __device__ __forceinline__ void operator()(const f32x4 (&acc)[2][2][4][2], const Unit& u, int wr, int wc, int fr, int fq) const {
        const int row0 = u.pm * BM + wr * 64 + fr, col0 = u.pn * BM + wc * 32 + 8 * fq;
#pragma unroll
        for (int ai = 0; ai < 2; ++ai)
#pragma unroll
            for (int m = 0; m < 4; ++m) {
                const int row = row0 + ai * HALF + m * 16;
#pragma unroll
                for (int bj = 0; bj < 2; ++bj) {
                    const int col = col0 + bj * HALF;
                    float g[8]; unpack8(*(const GAS u32x4*)(P1 + (size_t)row * LDP1 + C_GS + col), g);
                    f32x4 v0 = acc[ai][bj][m][0], v1 = acc[ai][bj][m][1];
#pragma unroll
                    for (int e = 0; e < 4; ++e) { v0[e] *= sigm(g[e]); v1[e] *= sigm(g[4 + e]); }
                    *(GAS u32x4*)(T1 + (size_t)row * 1024 + col) = pack8(v0, v1);
                }
            }
    }
};
struct EpiGate2 {
    static constexpr bool PERM = true, AFTER_DRAIN = false;
    const GAS bf16_t* P1; const GAS bf16_t* T1; GAS bf16_t* MG;
    __device__ __forceinline__ void operator()(const f32x4 (&acc)[2][2][4][2], const Unit& u, int wr, int wc, int fr, int fq) const {
        const int row0 = u.pm * BM + wr * 64 + fr, col0 = u.pn * BM + wc * 32 + 8 * fq;
#pragma unroll
        for (int ai = 0; ai < 2; ++ai)
#pragma unroll
            for (int m = 0; m < 4; ++m) {
                const int row = row0 + ai * HALF + m * 16;
#pragma unroll
                for (int bj = 0; bj < 2; ++bj) {
                    const int col = col0 + bj * HALF;
                    float g[8]; unpack8(*(const GAS u32x4*)(P1 + (size_t)row * LDP1 + C_GA + col), g);
                    float tt[8]; unpack8(*(const GAS u32x4*)(T1 + (size_t)row * 1024 + col), tt); const f32x4 t0 = (f32x4){tt[0], tt[1], tt[2], tt[3]}, t1 = (f32x4){tt[4], tt[5], tt[6], tt[7]};
                    f32x4 v0 = acc[ai][bj][m][0], v1 = acc[ai][bj][m][1];
#pragma unroll
                    for (int e = 0; e < 4; ++e) { v0[e] = t0[e] + v0[e] * sigm(g[e]); v1[e] = t1[e] + v1[e] * sigm(g[4 + e]); }
                    *(GAS u32x4*)(MG + (size_t)row * 1024 + col) = pack8(v0, v1);
                }
            }
    }
};
struct EpiResid {
    static constexpr bool PERM = true, AFTER_DRAIN = false;
    GAS float* H;
    __device__ __forceinline__ void operator()(const f32x4 (&acc)[2][2][4][2], const Unit& u, int wr, int wc, int fr, int fq) const {
        const int row0 = u.pm * BM + wr * 64 + fr, col0 = u.pn * BM + wc * 32 + 8 * fq;
#pragma unroll
        for (int ai = 0; ai < 2; ++ai)
#pragma unroll
            for (int m = 0; m < 4; ++m) {
                const int row = row0 + ai * HALF + m * 16;
#pragma unroll
                for (int bj = 0; bj < 2; ++bj) {
                    GAS float* d = H + (size_t)row * 1024 + col0 + bj * HALF;
                    const f32x4 h0 = *(const GAS f32x4*)d, h1 = *(const GAS f32x4*)(d + 4);
                    *(GAS f32x4*)d = h0 + acc[ai][bj][m][0]; *(GAS f32x4*)(d + 4) = h1 + acc[ai][bj][m][1];
                }
            }
    }
};
struct EpiUp {
    static constexpr bool PERM = true, AFTER_DRAIN = false;
    GAS bf16_t* A2;
    __device__ __forceinline__ void operator()(const f32x4 (&acc)[2][2][4][2], const Unit& u, int wr, int wc, int fr, int fq) const {
        const int row0 = u.pm * BM + wr * 64 + fr, col0 = u.pn * BM + wc * 32 + 8 * fq;
#pragma unroll
        for (int ai = 0; ai < 2; ++ai)
#pragma unroll
            for (int m = 0; m < 4; ++m) {
                const int row = row0 + ai * HALF + m * 16;
#pragma unroll
                for (int bj = 0; bj < 2; ++bj) {
                    f32x4 v0 = acc[ai][bj][m][0], v1 = acc[ai][bj][m][1];
#pragma unroll
                    for (int e = 0; e < 4; ++e) { const float a = fmaxf(v0[e], 0.f), b = fmaxf(v1[e], 0.f); v0[e] = a * a; v1[e] = b * b; }
                    *(GAS u32x4*)(A2 + (size_t)row * DFF + col0 + bj * HALF) = pack8(v0, v1);
                }
            }
    }
};
template <class Epi, class Sched, bool ALIGN_EPI = false, bool SP2 = false>
__device__ __forceinline__ void gemm_phase(PG8_LAS unsigned char* lds, const Gemm g, const Sched& S, const Epi& E, const int tid) {
    const int wid = __builtin_amdgcn_readfirstlane(tid >> 6), lane = tid & 63, wr = wid >> 2, wc = wid & 3, fr = lane & 15, fq = lane >> 4;
    const int K = g.K, nt = K / BK;
    unsigned voffA[2], voffB[2];
#pragma unroll
    for (int i = 0; i < 2; ++i) { int R, C; stage_rc(tid * 16 + i * 8192, R, C); const int Rb = Epi::PERM ? ((R & ~31) + perm32(R & 31)) : R;
        voffA[i] = (unsigned)(R * K + C) * 2u; voffB[i] = (unsigned)(Rb * K + C) * 2u; }
    const size_t kstep = (size_t)(BK * 2);
    const size_t hstep = (size_t)HALF * K * 2;
    const size_t tstep = 2 * hstep;
    const unsigned ldsw = (unsigned)wid * 1024u;
    const int aoff = lds_byte(wr * 64 + fr, fq * 8), boff = lds_byte(wc * 32 + fr, fq * 8);
#define PG8_SA(b, h) (((b) * 2 + (h)) * HTB)
#define PG8_SB(b, h) ((4 + (b) * 2 + (h)) * HTB)
#define PG8_STAGE(bufoff, gbase, voff) do { _Pragma("unroll") for (int _i = 0; _i < 2; ++_i) \
        __builtin_amdgcn_global_load_lds((const GAS unsigned*)((const GAS char*)(gbase) + (voff)[_i]), (PG8_LAS unsigned*)(lds + (bufoff) + ldsw + _i * 8192), 16, 0, 0); } while (0)
#define PG8_LDA(dst, b, h) do { _Pragma("unroll") for (int m = 0; m < 4; ++m) _Pragma("unroll") for (int k = 0; k < 2; ++k) dst[m][k] = *(const PG8_LAS bf16x8*)(lds + PG8_SA(b, h) + aoff + m * 2048 + k * 1024); } while (0)
#define PG8_LDB(dst, b, h) do { _Pragma("unroll") for (int n = 0; n < 2; ++n) _Pragma("unroll") for (int k = 0; k < 2; ++k) dst[n][k] = *(const PG8_LAS bf16x8*)(lds + PG8_SB(b, h) + boff + n * 2048 + k * 1024); } while (0)
#define PG8_MMA(ai, bj, At, Bt) do { __builtin_amdgcn_s_setprio(1); _Pragma("unroll") for (int m = 0; m < 4; ++m) _Pragma("unroll") for (int n = 0; n < 2; ++n) _Pragma("unroll") for (int k = 0; k < 2; ++k) \
        acc[ai][bj][m][n] = __builtin_amdgcn_mfma_f32_16x16x32_bf16(Bt[n][k], At[m][k], acc[ai][bj][m][n], 0, 0, 0); __builtin_amdgcn_s_setprio(0); } while (0)
#define PG8_WAIT_V(n) asm volatile("s_waitcnt vmcnt(" #n ")" ::: "memory")
#define PG8_WAIT_L(n) asm volatile("s_waitcnt lgkmcnt(" #n ")" ::: "memory")
#define PG8_BAR __builtin_amdgcn_s_barrier()
#define PG8_SCHED __builtin_amdgcn_sched_barrier(0)
    Unit cur, nxt; int ui = 0;
    if (!S.next(0, cur)) return;
    f32x4 acc[2][2][4][2];
#pragma unroll
    for (int a = 0; a < 2; ++a)
#pragma unroll
        for (int b = 0; b < 2; ++b)
#pragma unroll
            for (int m = 0; m < 4; ++m)
#pragma unroll
                for (int n = 0; n < 2; ++n) acc[a][b][m][n] = (f32x4){0.f, 0.f, 0.f, 0.f};
    bf16x8 At[4][2], B0[2][2], B1[2][2];
    const GAS char* cA = (const GAS char*)g.A + (size_t)cur.pm * tstep; const GAS char* cB = (const GAS char*)g.Bt + (size_t)cur.pn * tstep;
    S.a_ready(cur);
    if constexpr (SP2) {
        PG8_STAGE(PG8_SB(0, 0), cB, voffB); PG8_STAGE(PG8_SB(0, 1), cB + hstep, voffB); PG8_STAGE(PG8_SA(0, 0), cA, voffA); PG8_STAGE(PG8_SA(0, 1), cA + hstep, voffA);
        if (wr == 1) PG8_BAR;
        PG8_WAIT_V(2); PG8_BAR;
        PG8_STAGE(PG8_SB(1, 0), cB + kstep, voffB); PG8_STAGE(PG8_SA(1, 0), cA + kstep, voffA); PG8_STAGE(PG8_SB(1, 1), cB + hstep + kstep, voffB);
        PG8_WAIT_V(6); PG8_BAR;
    } else {
        PG8_STAGE(PG8_SB(0, 0), cB, voffB); PG8_STAGE(PG8_SA(0, 0), cA, voffA); PG8_STAGE(PG8_SB(0, 1), cB + hstep, voffB); PG8_STAGE(PG8_SA(0, 1), cA + hstep, voffA);
        if (wr == 1) PG8_BAR;
        PG8_WAIT_V(4); PG8_BAR;
        PG8_STAGE(PG8_SB(1, 0), cB + kstep, voffB); PG8_STAGE(PG8_SA(1, 0), cA + kstep, voffA); PG8_STAGE(PG8_SB(1, 1), cB + hstep + kstep, voffB);
        PG8_WAIT_V(6); PG8_BAR;
    }
    for (;;) {
        const bool has_next = S.next(ui + 1, nxt);
        const GAS char* nA = has_next ? (const GAS char*)g.A + (size_t)nxt.pm * tstep : cA; const GAS char* nB = has_next ? (const GAS char*)g.Bt + (size_t)nxt.pn * tstep : cB;
        for (int t = 0; t < nt; t += 2) {
            const bool last = (t == nt - 2);
            const GAS char* a1 = cA + (size_t)(t + 1) * kstep;
            const GAS char* a2 = last ? nA : cA + (size_t)(t + 2) * kstep; const GAS char* b2 = last ? nB : cB + (size_t)(t + 2) * kstep;
            const GAS char* a3 = a2 + kstep; const GAS char* b3 = b2 + kstep;
            if (last && has_next) S.a_ready(nxt);
            if constexpr (SP2) {
            PG8_LDB(B0, 0, 0); PG8_LDB(B1, 0, 1); PG8_SCHED; PG8_LDA(At, 0, 0); PG8_STAGE(PG8_SA(1, 1), a1 + hstep, voffA);
            PG8_WAIT_V(8); PG8_WAIT_L(0); PG8_BAR; PG8_MMA(0, 0, At, B0); PG8_MMA(0, 1, At, B1); PG8_BAR; PG8_SCHED;
            PG8_LDA(At, 0, 1); PG8_STAGE(PG8_SB(0, 0), b2, voffB); PG8_STAGE(PG8_SB(0, 1), b2 + hstep, voffB); PG8_STAGE(PG8_SA(0, 0), a2, voffA);
            PG8_WAIT_V(8); PG8_WAIT_L(0); PG8_BAR; PG8_MMA(1, 0, At, B0); PG8_MMA(1, 1, At, B1); PG8_BAR; PG8_SCHED;
            PG8_LDB(B0, 1, 0); PG8_LDB(B1, 1, 1); PG8_SCHED; PG8_LDA(At, 1, 0); PG8_STAGE(PG8_SA(0, 1), a2 + hstep, voffA);
            PG8_WAIT_V(8); PG8_WAIT_L(0); PG8_BAR; PG8_MMA(0, 0, At, B0); PG8_MMA(0, 1, At, B1); PG8_BAR; PG8_SCHED;
            PG8_LDA(At, 1, 1); PG8_STAGE(PG8_SB(1, 0), b3, voffB); PG8_STAGE(PG8_SB(1, 1), b3 + hstep, voffB); PG8_STAGE(PG8_SA(1, 0), a3, voffA);
            PG8_WAIT_V(8); PG8_WAIT_L(0); PG8_BAR; PG8_MMA(1, 0, At, B0); PG8_MMA(1, 1, At, B1); PG8_BAR; PG8_SCHED;
            } else {
            PG8_LDB(B0, 0, 0); PG8_SCHED; PG8_LDA(At, 0, 0); PG8_STAGE(PG8_SA(1, 1), a1 + hstep, voffA);
            PG8_WAIT_L(8); PG8_BAR; PG8_WAIT_L(0); PG8_MMA(0, 0, At, B0); PG8_BAR; PG8_SCHED;
            PG8_LDB(B1, 0, 1); PG8_STAGE(PG8_SB(0, 0), b2, voffB);
            PG8_BAR; PG8_WAIT_L(0); PG8_MMA(0, 1, At, B1); PG8_BAR;
            PG8_LDA(At, 0, 1); PG8_STAGE(PG8_SA(0, 0), a2, voffA);
            PG8_BAR; PG8_WAIT_L(0); PG8_MMA(1, 0, At, B0); PG8_BAR; PG8_SCHED;
            PG8_STAGE(PG8_SB(0, 1), b2 + hstep, voffB);
            PG8_WAIT_V(6); PG8_BAR; PG8_MMA(1, 1, At, B1); PG8_BAR;
            PG8_LDB(B0, 1, 0); PG8_SCHED; PG8_LDA(At, 1, 0); PG8_STAGE(PG8_SA(0, 1), a2 + hstep, voffA);
            PG8_WAIT_L(8); PG8_BAR; PG8_WAIT_L(0); PG8_MMA(0, 0, At, B0); PG8_BAR; PG8_SCHED;
            PG8_LDB(B1, 1, 1); PG8_STAGE(PG8_SB(1, 0), b3, voffB);
            PG8_BAR; PG8_WAIT_L(0); PG8_MMA(0, 1, At, B1); PG8_BAR;
            PG8_LDA(At, 1, 1); PG8_STAGE(PG8_SA(1, 0), a3, voffA);
            PG8_BAR; PG8_WAIT_L(0); PG8_MMA(1, 0, At, B0); PG8_BAR; PG8_SCHED;
            PG8_STAGE(PG8_SB(1, 1), b3 + hstep, voffB);
            PG8_WAIT_V(6); PG8_BAR; PG8_MMA(1, 1, At, B1); PG8_BAR;
            }
        }
        if constexpr (ALIGN_EPI) { if (wr == 0) PG8_BAR; }
        if constexpr (!Epi::AFTER_DRAIN) { E(acc, cur, wr, wc, fr, fq); S.done(cur); }
        if (!has_next) break;
#pragma unroll
        for (int a = 0; a < 2; ++a)
#pragma unroll
            for (int b = 0; b < 2; ++b)
#pragma unroll
                for (int m = 0; m < 4; ++m)
#pragma unroll
                    for (int n = 0; n < 2; ++n) acc[a][b][m][n] = (f32x4){0.f, 0.f, 0.f, 0.f};
        cur = nxt; cA = nA; cB = nB; ++ui;
        if constexpr (ALIGN_EPI) { if (wr == 1) PG8_BAR; }
    }
    PG8_WAIT_V(0);
    if constexpr (!ALIGN_EPI) { if (wr == 0) PG8_BAR; }
    PG8_BAR;
    if constexpr (Epi::AFTER_DRAIN) { E.fused(acc, cur, wr, wc, fr, fq, lds, wid, lane); S.done(cur); }
#undef PG8_SA
#undef PG8_SB
#undef PG8_STAGE
#undef PG8_LDA
#undef PG8_LDB
#undef PG8_MMA
#undef PG8_WAIT_V
#undef PG8_WAIT_L
#undef PG8_BAR
#undef PG8_SCHED
}
}

typedef unsigned short bf16;
typedef unsigned v4u __attribute__((ext_vector_type(4)));
typedef float f32x4 __attribute__((ext_vector_type(4)));
typedef short bf16x8 __attribute__((ext_vector_type(8)));
typedef GAS unsigned gu32;
typedef GAS unsigned long long gu64;
#define RLX_AGENT __ATOMIC_RELAXED, __HIP_MEMORY_SCOPE_AGENT
#define LDS_WAIT() asm volatile("s_waitcnt lgkmcnt(0)" ::: "memory")
#define VM_WAIT() asm volatile("s_waitcnt vmcnt(0)" ::: "memory")
__device__ __forceinline__ unsigned long long rt() { return __builtin_amdgcn_s_memrealtime(); }
typedef float f32x2_cv __attribute__((ext_vector_type(2))); typedef __bf16 bf16x2_cv __attribute__((ext_vector_type(2)));
__device__ __forceinline__ unsigned pk2(float lo, float hi) { const f32x2_cv v = {lo, hi}; const bf16x2_cv c = __builtin_convertvector(v, bf16x2_cv); return __builtin_bit_cast(unsigned, c); }
__device__ __forceinline__ unsigned f2bf(float f) { return pk2(f, 0.f) & 0xffffu; }

#define XB_TMO      128
#define XB_XCNT(j)  (256  + 64 * (j))
#define XB_XSUB(j)  (1280 + 64 * (j))
#define XB_XGEN(j)  (2304 + 64 * (j))
#define XB_TOP      3328
#define XB_TOPGEN   3392
#define XCD_BAR_WORDS 3456
#define XB_SPIN_CAP (1u << 18)

__device__ __forceinline__ unsigned xb_ld(unsigned* p)              { return __hip_atomic_load(p, __ATOMIC_RELAXED, __HIP_MEMORY_SCOPE_AGENT); }
__device__ __forceinline__ unsigned xb_add(unsigned* p, unsigned v) { return __hip_atomic_fetch_add(p, v, __ATOMIC_RELAXED, __HIP_MEMORY_SCOPE_AGENT); }
__device__ __forceinline__ unsigned xb_xcc_id() { return (unsigned)__builtin_amdgcn_s_getreg((3 << 11) | 20) & 0xFu; }
#define XB_SPIN(cond, bar) do { unsigned _sp = 0; while (cond) { __builtin_amdgcn_s_sleep(1); \
    if ((++_sp & 255u) == 0u) { if (xb_ld(&(bar)[XB_TMO])) break; if (_sp > XB_SPIN_CAP) { atomicAdd(&(bar)[XB_TMO], 1u); break; } } } } while (0)

struct XcdBarrier {
    unsigned* bar; unsigned x;
    volatile LAS unsigned* st;
};

__device__ __forceinline__ XcdBarrier xcd_barrier_post(unsigned* bar, volatile LAS unsigned* st) {
    XcdBarrier b; b.bar = bar; b.x = xb_xcc_id(); b.st = st;
    if (threadIdx.x == 0) (void)xb_add(&bar[XB_XCNT(b.x)], 1u);
    return b;
}
__device__ __forceinline__ void xcd_barrier_complete(unsigned* bar, unsigned x, unsigned& nloc, unsigned& nx, const unsigned G) {
    unsigned sum, cnt, mine, sp = 0u;
    for (;;) {
        sum = 0u; cnt = 0u; mine = 0u;
#pragma unroll 1
        for (unsigned j = 0; j < 16; ++j) { const unsigned c = xb_ld(&bar[XB_XCNT(j)]); sum += c; cnt += (c > 0u) ? 1u : 0u; mine = (j == x) ? c : mine; }
        if (sum == G) break;
        __builtin_amdgcn_s_sleep(1);
        if ((++sp & 255u) == 0u) { if (xb_ld(&bar[XB_TMO])) break; if (sp > XB_SPIN_CAP) { atomicAdd(&bar[XB_TMO], 1u); break; } }
    }
    nloc = mine > 0u ? mine : 1u; nx = cnt > 0u ? cnt : 1u;
}

__device__ __forceinline__ void xcd_barrier(const XcdBarrier& b, const int tid_, const unsigned G_) {
    asm volatile("s_waitcnt vmcnt(0)" ::: "memory");
    __syncthreads();
    if (tid_ == 0) {
        unsigned* bar = b.bar;
        __builtin_amdgcn_s_waitcnt(0);
        unsigned nloc = b.st[0], nx = b.st[1];
        if (nloc == 0u) { xcd_barrier_complete(bar, b.x, nloc, nx, G_); b.st[0] = nloc; b.st[1] = nx; }
        const unsigned old = xb_add(&bar[XB_XSUB(b.x)], 1u);
        const unsigned gen = old / nloc;
        if (old + 1u == (gen + 1u) * nloc) {
            __builtin_amdgcn_fence(__ATOMIC_RELEASE, "agent");
            asm volatile("s_waitcnt vmcnt(0)" ::: "memory");
            const unsigned og = xb_add(&bar[XB_TOP], 1u);
            const unsigned tg = og / nx;
            if (og + 1u == (tg + 1u) * nx) xb_add(&bar[XB_TOPGEN], 1u);
            else XB_SPIN(xb_ld(&bar[XB_TOPGEN]) == tg, bar);
            __builtin_amdgcn_fence(__ATOMIC_ACQUIRE, "agent");
            xb_add(&bar[XB_XGEN(b.x)], 1u);
            asm volatile("s_waitcnt vmcnt(0)" ::: "memory");
        } else {
            XB_SPIN(xb_ld(&bar[XB_XGEN(b.x)]) == gen, bar);
            __builtin_amdgcn_fence(__ATOMIC_ACQUIRE, "agent");
            asm volatile("s_waitcnt vmcnt(0)" ::: "memory");
        }
    }
    __syncthreads();
}

constexpr size_t O_YP = 0, O_YS = O_YP + (size_t)NB * SEQ * D, O_PK = O_YS + (size_t)MS * D, O_PV = O_PK + 2ull * MP * 256, O_PKI = O_PV + 2ull * MP * 256,
                 O_PSSM = O_PKI + 2ull * MP * 64, O_PCONV = O_PSSM + 2ull * NB * NH * HP * NST, O_SK = O_PCONV + 2ull * NB * 3 * CONVD, O_SV = O_SK + 2ull * MS * 256,
                 O_SKI = O_SV + 2ull * MS * 256, O_SSSM = O_SKI + 2ull * MS * 64, O_SCONV = O_SSSM + 2ull * DB * NH * HP * NST, O_END = O_SCONV + 2ull * DB * 3 * CONVD;

constexpr size_t MiB = 1u << 20;
constexpr size_t al(size_t x) { return (x + MiB - 1) / MiB * MiB; }
constexpr size_t WS_CTL = 0, CTL_ZERO_BYTES = 1 * MiB;
constexpr size_t SZ_WIN = (size_t)NIN * D * 2, SZ_WSSM = (size_t)D * DIN * 2, SZ_WATT = (size_t)D * D * 2, SZ_WOUT = (size_t)D * D * 2, SZ_WUP = (size_t)DFF * D * 2, SZ_WDN = (size_t)D * DFF * 2;
constexpr size_t WL_WIN = 0, WL_WSSM = al(WL_WIN + SZ_WIN), WL_WATT = al(WL_WSSM + SZ_WSSM), WL_WOUT = al(WL_WATT + SZ_WATT), WL_WUP = al(WL_WOUT + SZ_WOUT), WL_WDN = al(WL_WUP + SZ_WUP), WL_SIZE = al(WL_WDN + SZ_WDN);
constexpr size_t WS_W = 1 * MiB;
constexpr size_t WS_H = al(WS_W + 2 * WL_SIZE);
constexpr size_t WS_U = al(WS_H + (size_t)MPAD * D * 4);
constexpr size_t WS_P1 = al(WS_U + (size_t)MPAD * D * 2);
constexpr size_t WS_MISC = al(WS_P1 + (size_t)MPAD * LDP1 * 2);
constexpr size_t WS_KIB = al(WS_MISC + (size_t)MPAD * 128 * 4);
constexpr size_t WS_XC = al(WS_KIB + (size_t)MPAD * 64 * 2);
constexpr size_t WS_DT = al(WS_XC + (size_t)MPAD * CONVD * 2);
constexpr size_t WS_DA = al(WS_DT + (size_t)MPAD * 32 * 4);
constexpr size_t WS_YS = al(WS_DA + (size_t)MPAD * 32 * 4);
constexpr size_t WS_YSN = al(WS_YS + (size_t)MPAD * DIN * 4);
constexpr size_t WS_YA = al(WS_YSN + (size_t)MPAD * DIN * 2);
constexpr size_t WS_T1 = al(WS_YA + (size_t)MPAD * D * 2);
constexpr size_t WS_MG = al(WS_T1 + (size_t)MPAD * D * 4);
constexpr size_t WS_A2 = al(WS_MG + (size_t)MPAD * D * 2);
constexpr size_t WS_IDXP = al(WS_A2 + (size_t)MPAD * DFF * 2);
constexpr size_t WS_IDXS = al(WS_IDXP + (size_t)MP * 256 * 2);
constexpr int SCS_LD = 8256;
constexpr size_t WS_SCS = al(WS_IDXS + (size_t)MS * 256 * 4);
constexpr size_t WS_SB = al(WS_SCS + (size_t)MS * SCS_LD * 4);
constexpr size_t WS_DEC = al(WS_SB + (size_t)NB * 33 * NH * HP * NST * 4);
constexpr size_t WS_HC = al(WS_DEC + (size_t)NB * 33 * NH * 4);
constexpr size_t WS_KVB = al(WS_HC + (size_t)NB * 33 * NH * HP * NST * 2);
constexpr size_t WS_KIB2 = al(WS_KVB + (size_t)MPAD * 512 * 2);
constexpr size_t WS_END = al(WS_KIB2 + (size_t)NB * KT_PER_B * 2048 * 2);
constexpr int CW_BAR = 4096;

constexpr int LDS_BYTES = 159744, LDSCTL_OFF = 155648, MISC_OFF = LDSCTL_OFF + 320;
constexpr int NWAVES = 8, NT = 512;
typedef float f32x16 __attribute__((ext_vector_type(16)));
typedef unsigned v2u __attribute__((ext_vector_type(2)));

__device__ __forceinline__ float dpp_f(float v, const int ctrl_unused) { return v; }
#define DPPF(v, ctrl, rmask, bc) __uint_as_float((unsigned)__builtin_amdgcn_update_dpp(0, (int)__float_as_uint(v), ctrl, rmask, 0xf, bc))
__device__ __forceinline__ float row16_sum(float v) {
    v += DPPF(v, 0xB1, 0xf, true); v += DPPF(v, 0x4E, 0xf, true); v += DPPF(v, 0x141, 0xf, true); v += DPPF(v, 0x140, 0xf, true); return v;
}
__device__ __forceinline__ float wave_sum(float v) {
    v = row16_sum(v);
    v += DPPF(v, 0x142, 0xa, false); v += DPPF(v, 0x143, 0xc, false);
    return __uint_as_float((unsigned)__builtin_amdgcn_readlane((int)__float_as_uint(v), 63));
}
__device__ __forceinline__ float wave_max(float v) {
    v = fmaxf(v, __uint_as_float((unsigned)__builtin_amdgcn_update_dpp((int)__float_as_uint(v), (int)__float_as_uint(v), 0xB1, 0xf, 0xf, false)));
    v = fmaxf(v, __uint_as_float((unsigned)__builtin_amdgcn_update_dpp((int)__float_as_uint(v), (int)__float_as_uint(v), 0x4E, 0xf, 0xf, false)));
    v = fmaxf(v, __uint_as_float((unsigned)__builtin_amdgcn_update_dpp((int)__float_as_uint(v), (int)__float_as_uint(v), 0x141, 0xf, 0xf, false)));
    v = fmaxf(v, __uint_as_float((unsigned)__builtin_amdgcn_update_dpp((int)__float_as_uint(v), (int)__float_as_uint(v), 0x140, 0xf, 0xf, false)));
    v = fmaxf(v, __uint_as_float((unsigned)__builtin_amdgcn_update_dpp((int)__float_as_uint(v), (int)__float_as_uint(v), 0x142, 0xa, 0xf, false)));
    v = fmaxf(v, __uint_as_float((unsigned)__builtin_amdgcn_update_dpp((int)__float_as_uint(v), (int)__float_as_uint(v), 0x143, 0xc, 0xf, false)));
    return __uint_as_float((unsigned)__builtin_amdgcn_readlane((int)__float_as_uint(v), 63));
}
__device__ __forceinline__ void unpack8(const v4u w, float (&f)[8]) {
    f[0] = __uint_as_float(w.x << 16); f[1] = __uint_as_float(w.x & 0xffff0000u); f[2] = __uint_as_float(w.y << 16); f[3] = __uint_as_float(w.y & 0xffff0000u);
    f[4] = __uint_as_float(w.z << 16); f[5] = __uint_as_float(w.z & 0xffff0000u); f[6] = __uint_as_float(w.w << 16); f[7] = __uint_as_float(w.w & 0xffff0000u);
}
__device__ __forceinline__ float sigm(float x) { return __builtin_amdgcn_rcpf(1.0f + __expf(-x)); }

__device__ __forceinline__ int win_src_col(int n) {
    if (n < 5120) return n;
    if (n < 6144) return n - 5120 + 5152;
    if (n < 6400) return n - 6144 + 6176;
    if (n < 6656) return n - 6400 + 6432;
    if (n < 7168) return n - 6656 + 6688;
    if (n < 8192) return n - 7168 + 7272;
    if (n < 9216) return n - 8192 + 8296;
    if (n < 9280) return n - 9216 + 7200;
    if (n < 9312) return n - 9280 + 5120;
    if (n < 9320) return n - 9312 + 7264;
    return -1;
}
__device__ __forceinline__ void tr_item(const GAS float* W, int K, int Nsrc, GAS bf16* WT, int nblk, bool remap, LAS float* scr, int item, int lane) {
    const int kb = item / nblk, nb = item % nblk, k0 = 64 * kb, n0 = 64 * nb;
    const int s0 = remap ? win_src_col(n0) : n0, s63 = remap ? win_src_col(n0 + 63) : n0 + 63;
    if (s0 >= 0 && s63 == s0 + 63 && (s0 & 3) == 0 && (Nsrc & 3) == 0) {
        const int r4 = lane >> 4, c4 = (lane & 15) * 4;
#pragma unroll 4
        for (int i = 0; i < 16; ++i) { const int kk = 4 * i + r4; const f32x4 v = *(const GAS f32x4*)(W + (size_t)(k0 + kk) * Nsrc + s0 + c4);
            scr[kk * 65 + c4] = v.x; scr[kk * 65 + c4 + 1] = v.y; scr[kk * 65 + c4 + 2] = v.z; scr[kk * 65 + c4 + 3] = v.w; }
    } else {
        const int sc = remap ? win_src_col(n0 + lane) : n0 + lane;
#pragma unroll 8
        for (int kk = 0; kk < 64; ++kk) scr[kk * 65 + lane] = sc >= 0 ? W[(size_t)(k0 + kk) * Nsrc + sc] : 0.f;
    }
    LDS_WAIT(); asm volatile("" ::: "memory");
    const int c = lane & 7;
#pragma unroll
    for (int j = 0; j < 8; ++j) { const int n = (lane >> 3) + 8 * j; const LAS float* s = scr + (8 * c) * 65 + n;
        v4u o; o.x = pk2(s[0 * 65], s[1 * 65]); o.y = pk2(s[2 * 65], s[3 * 65]); o.z = pk2(s[4 * 65], s[5 * 65]); o.w = pk2(s[6 * 65], s[7 * 65]);
        *(GAS v4u*)(WT + (size_t)(n0 + n) * K + k0 + 8 * c) = o; }
    LDS_WAIT(); asm volatile("" ::: "memory");
}
__device__ __forceinline__ void rms_row(const GAS float* src, const GAS float* w, GAS float* hdst, GAS bf16* udst, GAS float* fdst, int lane) {
    f32x4 v[4]; float ss = 0.f;
#pragma unroll
    for (int j = 0; j < 4; ++j) { v[j] = src ? ((const GAS f32x4*)src)[lane + 64 * j] : (f32x4){0.f, 0.f, 0.f, 0.f}; ss += (v[j].x * v[j].x + v[j].y * v[j].y) + (v[j].z * v[j].z + v[j].w * v[j].w); }
    ss = wave_sum(ss);
    const float rstd = 1.0f / sqrtf(ss * (1.0f / D) + 1e-6f);
#pragma unroll
    for (int j = 0; j < 4; ++j) {
        if (hdst) ((GAS f32x4*)hdst)[lane + 64 * j] = v[j];
        const f32x4 wv = ((const GAS f32x4*)w)[lane + 64 * j]; const f32x4 o = v[j] * rstd * wv;
        if (udst) ((GAS v2u*)udst)[lane + 64 * j] = (v2u){pk2(o.x, o.y), pk2(o.z, o.w)};
        if (fdst) ((GAS f32x4*)fdst)[lane + 64 * j] = o;
    }
}

__device__ __forceinline__ void rms_rows4(const GAS float* H, const GAS float* w, GAS bf16* U, int m0, int stride, int mend, int lane) {
    f32x4 v[4][4]; float ss[4];
#pragma unroll
    for (int r = 0; r < 4; ++r) { const int m = m0 + r * stride; const GAS f32x4* src = (const GAS f32x4*)(H + (size_t)(m < mend ? m : m0) * D); ss[r] = 0.f;
#pragma unroll
        for (int j = 0; j < 4; ++j) v[r][j] = src[lane + 64 * j]; }
    f32x4 wv[4];
#pragma unroll
    for (int j = 0; j < 4; ++j) wv[j] = ((const GAS f32x4*)w)[lane + 64 * j];
#pragma unroll
    for (int r = 0; r < 4; ++r) {
#pragma unroll
        for (int j = 0; j < 4; ++j) ss[r] += (v[r][j].x * v[r][j].x + v[r][j].y * v[r][j].y) + (v[r][j].z * v[r][j].z + v[r][j].w * v[r][j].w);
        ss[r] = wave_sum(ss[r]);
        const float rstd = 1.0f / sqrtf(ss[r] * (1.0f / D) + 1e-6f); const int m = m0 + r * stride;
        if (m < mend) {
#pragma unroll
            for (int j = 0; j < 4; ++j) { const f32x4 o = v[r][j] * rstd * wv[j]; ((GAS v2u*)(U + (size_t)m * D))[lane + 64 * j] = (v2u){pk2(o.x, o.y), pk2(o.z, o.w)}; } }
    }
}

__device__ __forceinline__ void rms_rows4g(const GAS float* const (&src)[4], const GAS float* w, GAS float* const (&hdst)[4], GAS bf16* const (&udst)[4], GAS float* const (&fdst)[4], const bool (&live)[4], int lane) {
    f32x4 v[4][4];
#pragma unroll
    for (int r = 0; r < 4; ++r)
#pragma unroll
        for (int j = 0; j < 4; ++j) v[r][j] = (live[r] && src[r]) ? ((const GAS f32x4*)src[r])[lane + 64 * j] : (f32x4){0.f, 0.f, 0.f, 0.f};
    f32x4 wv[4];
#pragma unroll
    for (int j = 0; j < 4; ++j) wv[j] = ((const GAS f32x4*)w)[lane + 64 * j];
#pragma unroll
    for (int r = 0; r < 4; ++r) { float ss = 0.f;
#pragma unroll
        for (int j = 0; j < 4; ++j) ss += (v[r][j].x * v[r][j].x + v[r][j].y * v[r][j].y) + (v[r][j].z * v[r][j].z + v[r][j].w * v[r][j].w);
        ss = wave_sum(ss);
        const float rstd = 1.0f / sqrtf(ss * (1.0f / D) + 1e-6f);
        if (live[r]) {
#pragma unroll
            for (int j = 0; j < 4; ++j) { const f32x4 o = v[r][j] * rstd * wv[j];
                if (hdst[r]) ((GAS f32x4*)hdst[r])[lane + 64 * j] = v[r][j];
                if (udst[r]) ((GAS v2u*)udst[r])[lane + 64 * j] = (v2u){pk2(o.x, o.y), pk2(o.z, o.w)};
                if (fdst[r]) ((GAS f32x4*)fdst[r])[lane + 64 * j] = o; } }
    }
}

__device__ __forceinline__ void ssd_unit(LAS unsigned char* lds, int tid, const GAS bf16* XC, const GAS float* DT, const GAS float* DA, size_t m0, int L, int h, int p0,
                                         const GAS float* hin, GAS float* hout, GAS float* YS, float dskip) {
    LAS float* Bl = (LAS float*)lds;
    LAS float* Cl = Bl + 64 * 128;
    LAS float* Xl = Cl + 64 * 128;
    LAS float* Yl = Xl + 64 * 32;
    LAS float* dtl = Yl + 64 * 32;
    LAS float* dal = dtl + 64;
    const int pl = tid >> 4, nq = tid & 15, n0 = nq * 8, g = h >> 3;
    float s[8];
    if (hin) { const f32x4 a = *(const GAS f32x4*)(hin + (size_t)(p0 + pl) * NST + n0), b = *(const GAS f32x4*)(hin + (size_t)(p0 + pl) * NST + n0 + 4);
        s[0] = a.x; s[1] = a.y; s[2] = a.z; s[3] = a.w; s[4] = b.x; s[5] = b.y; s[6] = b.z; s[7] = b.w; }
    else {
#pragma unroll
        for (int i = 0; i < 8; ++i) s[i] = 0.f; }
    for (int tb = 0; tb < L; tb += 64) {
        const int nb = (L - tb) < 64 ? (L - tb) : 64;
        { const int tk = tid >> 3, part = tid & 7;
            if (tk < nb) { const GAS bf16* xr = XC + (m0 + tb + tk) * CONVD;
                float f[8];
                unpack8(*(const GAS v4u*)(xr + DIN + g * NST + part * 16), f);
                *(LAS f32x4*)(Bl + tk * 128 + part * 16) = (f32x4){f[0], f[1], f[2], f[3]}; *(LAS f32x4*)(Bl + tk * 128 + part * 16 + 4) = (f32x4){f[4], f[5], f[6], f[7]};
                unpack8(*(const GAS v4u*)(xr + DIN + g * NST + part * 16 + 8), f);
                *(LAS f32x4*)(Bl + tk * 128 + part * 16 + 8) = (f32x4){f[0], f[1], f[2], f[3]}; *(LAS f32x4*)(Bl + tk * 128 + part * 16 + 12) = (f32x4){f[4], f[5], f[6], f[7]};
                unpack8(*(const GAS v4u*)(xr + DIN + NG * NST + g * NST + part * 16), f);
                *(LAS f32x4*)(Cl + tk * 128 + part * 16) = (f32x4){f[0], f[1], f[2], f[3]}; *(LAS f32x4*)(Cl + tk * 128 + part * 16 + 4) = (f32x4){f[4], f[5], f[6], f[7]};
                unpack8(*(const GAS v4u*)(xr + DIN + NG * NST + g * NST + part * 16 + 8), f);
                *(LAS f32x4*)(Cl + tk * 128 + part * 16 + 8) = (f32x4){f[0], f[1], f[2], f[3]}; *(LAS f32x4*)(Cl + tk * 128 + part * 16 + 12) = (f32x4){f[4], f[5], f[6], f[7]};
                const v2u xw = *(const GAS v2u*)(xr + h * HP + p0 + part * 4);
                *(LAS f32x4*)(Xl + tk * 32 + part * 4) = (f32x4){__uint_as_float(xw.x << 16), __uint_as_float(xw.x & 0xffff0000u), __uint_as_float(xw.y << 16), __uint_as_float(xw.y & 0xffff0000u)};
            }
            if (tid < nb) { dtl[tid] = DT[(m0 + tb + tid) * 32 + h]; dal[tid] = DA[(m0 + tb + tid) * 32 + h]; }
        }
        __syncthreads();
        for (int t = 0; t < nb; ++t) {
            const float da = dal[t], dtv = dtl[t], xv = Xl[t * 32 + pl], xdt = xv * dtv;
            const f32x4 b0 = *(const LAS f32x4*)(Bl + t * 128 + n0), b1 = *(const LAS f32x4*)(Bl + t * 128 + n0 + 4);
            const f32x4 c0 = *(const LAS f32x4*)(Cl + t * 128 + n0), c1 = *(const LAS f32x4*)(Cl + t * 128 + n0 + 4);
            s[0] = s[0] * da + xdt * b0.x; s[1] = s[1] * da + xdt * b0.y; s[2] = s[2] * da + xdt * b0.z; s[3] = s[3] * da + xdt * b0.w;
            s[4] = s[4] * da + xdt * b1.x; s[5] = s[5] * da + xdt * b1.y; s[6] = s[6] * da + xdt * b1.z; s[7] = s[7] * da + xdt * b1.w;
            float y = (s[0] * c0.x + s[1] * c0.y) + (s[2] * c0.z + s[3] * c0.w) + (s[4] * c1.x + s[5] * c1.y) + (s[6] * c1.z + s[7] * c1.w);
            y += __shfl_xor(y, 1); y += __shfl_xor(y, 2); y += __shfl_xor(y, 4); y += __shfl_xor(y, 8);
            if (nq == 0) Yl[t * 32 + pl] = y + xv * dskip;
        }
        __syncthreads();
        { const int tk = tid >> 3, part = tid & 7;
            if (tk < nb) *(GAS f32x4*)(YS + (m0 + tb + tk) * DIN + h * HP + p0 + part * 4) = *(const LAS f32x4*)(Yl + tk * 32 + part * 4); }
    }
    *(GAS f32x4*)(hout + (size_t)(p0 + pl) * NST + n0) = (f32x4){s[0], s[1], s[2], s[3]};
    *(GAS f32x4*)(hout + (size_t)(p0 + pl) * NST + n0 + 4) = (f32x4){s[4], s[5], s[6], s[7]};
}

__device__ __forceinline__ void idx_load_q(const GAS bf16* P1, const GAS float* MISC, size_t mq0, int lane, bf16x8 (&afr)[2][4], float (&wq)[2][2][8]) {
    const int r = lane & 31, hh = lane >> 5, qs = ((r >> 2) & 1) * 2 + (r >> 4), head = (r & 3) + 4 * ((r >> 3) & 1);
#pragma unroll
    for (int rt = 0; rt < 2; ++rt)
#pragma unroll
        for (int ks = 0; ks < 4; ++ks) afr[rt][ks] = *(const GAS bf16x8*)(P1 + (mq0 + qs + 4 * rt) * LDP1 + C_QI + head * 64 + 16 * ks + 8 * hh);
#pragma unroll
    for (int rt = 0; rt < 2; ++rt)
#pragma unroll
        for (int jq = 0; jq < 2; ++jq) { const GAS float* wp = MISC + (mq0 + 4 * rt + 2 * hh + jq) * 128 + MC_WI; const f32x4 a = *(const GAS f32x4*)wp, b = *(const GAS f32x4*)(wp + 4);
            const float sc = 8.0f * 0.35355339059327373f;
            wq[rt][jq][0] = a.x * sc; wq[rt][jq][1] = a.y * sc; wq[rt][jq][2] = a.z * sc; wq[rt][jq][3] = a.w * sc; wq[rt][jq][4] = b.x * sc; wq[rt][jq][5] = b.y * sc; wq[rt][jq][6] = b.z * sc; wq[rt][jq][7] = b.w * sc; }
}
typedef float f32x2 __attribute__((ext_vector_type(2)));
__device__ __forceinline__ float relu_bits(float x) { return __int_as_float(max(__float_as_int(x), 0)); }
__device__ __forceinline__ float idx_reduce(const f32x16& acc, const int o, const float (&w)[8]) {
    f32x2 s2 = (f32x2){w[0], w[1]} * (f32x2){relu_bits(acc[o]), relu_bits(acc[o + 1])};
#pragma unroll
    for (int i = 2; i < 8; i += 2) s2 = __builtin_elementwise_fma((f32x2){w[i], w[i + 1]}, (f32x2){relu_bits(acc[o + i]), relu_bits(acc[o + i + 1])}, s2);
    float r; asm("v_add_f32 %0, %1, %2" : "=v"(r) : "v"(s2.x), "v"(s2.y));
    return r;
}
__device__ __forceinline__ void idx_scores(const bf16x8 (&afr)[2][4], const bf16x8 (&bfr)[4], const float (&wq)[2][2][8], float (&sc)[2][2]) {
#pragma unroll
    for (int rt = 0; rt < 2; ++rt) {
        f32x16 acc = {};
#pragma unroll
        for (int ks = 0; ks < 4; ++ks) acc = __builtin_amdgcn_mfma_f32_32x32x16_bf16(afr[rt][ks], bfr[ks], acc, 0, 0, 0);
#pragma unroll
        for (int jq = 0; jq < 2; ++jq) sc[rt][jq] = idx_reduce(acc, 8 * jq, wq[rt][jq]);
    }
}
__device__ __forceinline__ unsigned f2key(float f) { const unsigned u = __float_as_uint(f); return u ^ ((u >> 31) ? 0xffffffffu : 0x80000000u); }
__device__ __forceinline__ unsigned wave_incl_scan(unsigned v, int lane) {
#pragma unroll
    for (int o = 1; o < 64; o <<= 1) { const unsigned t = __shfl_up(v, o); if (lane >= o) v += t; }
    return v;
}
#ifndef REP_TK_PASS1
#define REP_TK_PASS1 1
#endif
#ifndef REP_TK_PICK
#define REP_TK_PICK 1
#endif
#ifndef REP_TK_OPEN
#define REP_TK_OPEN 1
#endif
#ifndef REP_TK_PASS
#define REP_TK_PASS 1
#endif
#ifndef REP_TK_COMP
#define REP_TK_COMP 1
#endif
__device__ __forceinline__ int wave_sum_i(int v) {
    v += __builtin_amdgcn_update_dpp(0, v, 0xB1, 0xf, 0xf, true);
    v += __builtin_amdgcn_update_dpp(0, v, 0x4E, 0xf, 0xf, true);
    v += __builtin_amdgcn_update_dpp(0, v, 0x141, 0xf, 0xf, true);
    v += __builtin_amdgcn_update_dpp(0, v, 0x140, 0xf, 0xf, true);
    v += __builtin_amdgcn_update_dpp(0, v, 0x142, 0xa, 0xf, false);
    v += __builtin_amdgcn_update_dpp(0, v, 0x143, 0xc, 0xf, false);
    return __builtin_amdgcn_readlane(v, 63);
}
__device__ __forceinline__ int cnt_ge(const LAS unsigned* s, int nit, unsigned mid, int lane) {
    int cl = 0; int it = 0;
    const LAS v4u* p = (const LAS v4u*)s + lane;
    for (; it + 4 <= nit; it += 4) {
        const v4u k0 = p[64 * it], k1 = p[64 * it + 64], k2 = p[64 * it + 128], k3 = p[64 * it + 192];
        cl += (k0.x >= mid) + (k0.y >= mid) + (k0.z >= mid) + (k0.w >= mid);
        cl += (k1.x >= mid) + (k1.y >= mid) + (k1.z >= mid) + (k1.w >= mid);
        cl += (k2.x >= mid) + (k2.y >= mid) + (k2.z >= mid) + (k2.w >= mid);
        cl += (k3.x >= mid) + (k3.y >= mid) + (k3.z >= mid) + (k3.w >= mid); }
    for (; it < nit; ++it) { const v4u kv = p[64 * it]; cl += (kv.x >= mid) + (kv.y >= mid) + (kv.z >= mid) + (kv.w >= mid); }
    return wave_sum_i(cl);
}
constexpr int HB = 512;
__device__ __forceinline__ unsigned hist_bound_key(int b) {
    return b <= 0 ? 1u : (b >= HB ? 0xff800001u : (b == 256 ? 0x7fffffffu : f2key((float)(b - 256))));
}
__device__ __forceinline__ unsigned mbcnt64(unsigned long long m, unsigned add) { return __builtin_amdgcn_mbcnt_hi((unsigned)(m >> 32), __builtin_amdgcn_mbcnt_lo((unsigned)m, add)); }
template <class OT>
__device__ __forceinline__ void topk_select(LAS unsigned* s, int n, int lane, OT* out, const LAS unsigned* hist = nullptr) {
    const int nit = (n + 255) >> 8;
    for (int i = n + lane; i < nit * 256; i += 64) s[i] = 0u;
    LDS_WAIT(); asm volatile("" ::: "memory");
    unsigned T = 0u, need = 0u;
    {
    unsigned hi, lo; int c_hi, c_lo;
    if (hist) {
        unsigned c[8], tot = 0u;
#pragma unroll
        for (int j = 0; j < 8; ++j) { c[j] = hist[HB - 1 - 8 * lane - j]; tot += c[j]; }
        const unsigned incl = wave_incl_scan(tot, lane), excl = incl - tot;
        const bool here = (excl < 256u) && (256u <= incl);
        int bin = 0; unsigned above = 0u, inb = 0u;
        if (here) { unsigned run = excl;
#pragma unroll
            for (int j = 0; j < 8; ++j) { if (run < 256u && 256u <= run + c[j]) { bin = HB - 1 - 8 * lane - j; above = run; inb = c[j]; } run += c[j]; } }
        const unsigned long long mk = __ballot(here); const int src = mk ? (__ffsll((long long)mk) - 1) : 0;
        bin = __builtin_amdgcn_readlane(bin, src); above = (unsigned)__builtin_amdgcn_readlane((int)above, src); inb = (unsigned)__builtin_amdgcn_readlane((int)inb, src);
        lo = hist_bound_key(bin); hi = hist_bound_key(bin + 1);
        while (inb > 192u && hi - lo > 1u) {
            const unsigned mid = lo + ((hi - lo) >> 1); const unsigned up = (unsigned)cnt_ge(s, nit, mid, lane) - above;
            if (above + up >= 256u) { lo = mid; inb = up; } else { above += up; hi = mid; inb -= up; } }
        if (inb <= 192u) {
            LAS unsigned short* stg = (LAS unsigned short*)hist;
            LAS unsigned* cnd = (LAS unsigned*)hist + 128;
            const unsigned wdt = hi - lo;
            unsigned running = 0u, ncand = 0u;
            for (int rq_ = 0; rq_ < REP_TK_PASS1; ++rq_) { running = 0u; ncand = 0u;
#pragma unroll 2
            for (int it = 0; it < nit; ++it) {
                const int i0 = 4 * (lane + 64 * it); const v4u kv = *(const LAS v4u*)(s + i0);
                bool sel[4], cd[4]; bool any = false; unsigned lower = running, all = 0u;
#pragma unroll
                for (int e = 0; e < 4; ++e) { sel[e] = kv[e] >= hi; const unsigned long long sm = __ballot(sel[e]); lower = mbcnt64(sm, lower); all += (unsigned)__popcll(sm);
                                              cd[e] = (kv[e] - lo) < wdt; any = any || cd[e]; }
                unsigned pos = lower;
#pragma unroll
                for (int e = 0; e < 4; ++e) { if (sel[e]) { stg[pos] = (unsigned short)(i0 + e); ++pos; } }
                running += all;
                if (__ballot(any)) {
#pragma unroll
                    for (int e = 0; e < 4; ++e) { const unsigned long long cm = __ballot(cd[e]);
                        if (cd[e]) { const unsigned p = mbcnt64(cm, ncand); *(LAS v2u*)(cnd + 2 * p) = (v2u){kv[e], (unsigned)(i0 + e)}; }
                        ncand += (unsigned)__popcll(cm); }
                }
            } }
            LDS_WAIT(); asm volatile("" ::: "memory");
            const unsigned r = 256u - above;
            for (int rk_ = 0; rk_ < REP_TK_PICK; ++rk_) { asm volatile("" ::: "memory");
#define TK_PICK(KC) { unsigned v[KC], ci[KC]; \
                _Pragma("unroll") for (int q = 0; q < KC; ++q) { const unsigned id = (unsigned)lane + 64u * q; v[q] = 0u; ci[q] = 0xffffffffu; \
                    if (id < inb) { const v2u t = *(const LAS v2u*)(cnd + 2 * id); v[q] = t.x - lo + 1u; ci[q] = t.y; } }              \
                unsigned Tv = 0u; \
                for (int bb = 31 - __builtin_clz(wdt | 1u); bb >= 0; --bb) { const unsigned trial = Tv | (1u << bb); unsigned c = 0u; \
                    _Pragma("unroll") for (int q = 0; q < KC; ++q) c += (unsigned)__popcll(__ballot(v[q] >= trial)); \
                    if (c >= r) Tv = trial; } \
                unsigned ngt = 0u, neq = 0u; bool eq[KC]; \
                _Pragma("unroll") for (int q = 0; q < KC; ++q) { ngt += (unsigned)__popcll(__ballot(v[q] > Tv)); eq[q] = v[q] == Tv; neq += (unsigned)__popcll(__ballot(eq[q])); } \
                unsigned needq = r - ngt;                                \
                if (neq != needq) {                                       \
                    bool keep[KC]; _Pragma("unroll") for (int q = 0; q < KC; ++q) keep[q] = false; \
                    for (unsigned t = 0; t < needq; ++t) { unsigned mi = 0xffffffffu; \
                        _Pragma("unroll") for (int q = 0; q < KC; ++q) if (eq[q] && !keep[q] && ci[q] < mi) mi = ci[q]; \
                        _Pragma("unroll") for (int o = 1; o < 64; o <<= 1) { const unsigned x = (unsigned)__shfl_xor((int)mi, o); mi = x < mi ? x : mi; } \
                        _Pragma("unroll") for (int q = 0; q < KC; ++q) if (eq[q] && ci[q] == mi) keep[q] = true; } \
                    _Pragma("unroll") for (int q = 0; q < KC; ++q) eq[q] = keep[q]; } \
                unsigned base = above; \
                _Pragma("unroll") for (int q = 0; q < KC; ++q) { const bool sq = v[q] > Tv || eq[q]; const unsigned long long m = __ballot(sq); \
                    if (sq) stg[mbcnt64(m, base)] = (unsigned short)ci[q]; base += (unsigned)__popcll(m); } }
            if (inb <= 64u) TK_PICK(1) else if (inb <= 128u) TK_PICK(2) else TK_PICK(3)
            }
#undef TK_PICK
            LDS_WAIT(); asm volatile("" ::: "memory");
            const v2u w = *(const LAS v2u*)(stg + 4 * lane);
            if constexpr (sizeof(OT) == 2) *(GAS v2u*)(out + 4 * lane) = w;
            else *(GAS v4u*)(out + 4 * lane) = (v4u){w.x & 0xffffu, w.x >> 16, w.y & 0xffffu, w.y >> 16};
            return;
        }
        T = lo; need = 256u - above;
    }
    }
    const unsigned long long lt = (1ull << lane) - 1ull;
    unsigned running = 0u, eq_taken = 0u;
    {
#pragma unroll 2
    for (int it = 0; it < nit; ++it) {
        const int i0 = 4 * (lane + 64 * it); const v4u kv = *(const LAS v4u*)(s + i0);
        bool sel[4], eq[4]; bool anyeq = false;
#pragma unroll
        for (int e = 0; e < 4; ++e) { sel[e] = kv[e] > T; eq[e] = need != 0u && kv[e] == T && (i0 + e < n); anyeq = anyeq || eq[e]; }
        if (need != 0u && __ballot(anyeq)) {
            unsigned lower = 0u, all = 0u;
#pragma unroll
            for (int e = 0; e < 4; ++e) { const unsigned long long bm = __ballot(eq[e]); lower += (unsigned)__popcll(bm & lt); all += (unsigned)__popcll(bm); }
            unsigned er = eq_taken + lower;
#pragma unroll
            for (int e = 0; e < 4; ++e) { if (eq[e]) { sel[e] = er < need; ++er; } }
            eq_taken += all;
        }
        unsigned lower = 0u, all = 0u;
#pragma unroll
        for (int e = 0; e < 4; ++e) { const unsigned long long sm = __ballot(sel[e]); lower += (unsigned)__popcll(sm & lt); all += (unsigned)__popcll(sm); }
        unsigned pos = running + lower;
#pragma unroll
        for (int e = 0; e < 4; ++e) { if (sel[e]) { if (pos < 256u) out[pos] = (OT)(i0 + e); ++pos; } }
        running += all;
    } }
}

constexpr int NCH = 33;
typedef short s16x4 __attribute__((ext_vector_type(4)));
typedef short v4i16_t __attribute__((ext_vector_type(4)));
__device__ __forceinline__ float wave_incl_scan_f(float v, int lane) {
#pragma unroll
    for (int o = 1; o < 64; o <<= 1) { const float t = __shfl_up(v, o); if (lane >= o) v += t; }
    return v;
}
__device__ __forceinline__ s16x4 ldtr(const LAS unsigned char* p) { return __builtin_bit_cast(s16x4, __builtin_amdgcn_ds_read_tr16_b64_v4i16((LAS v4i16_t*)p)); }
__device__ __forceinline__ bf16x8 frag_tr(const LAS unsigned char* img, int RS, int k0, int c0, int lane) {
    const int hh = lane >> 5, blk = (lane >> 4) & 1, q = (lane & 15) >> 2, pp = lane & 3;
    const LAS unsigned char* a = img + (k0 + 8 * hh + q) * RS + (c0 + 16 * blk + 4 * pp) * 2;
    const s16x4 lo = ldtr(a), hi = ldtr(a + 4 * RS);
    return (bf16x8){lo[0], lo[1], lo[2], lo[3], hi[0], hi[1], hi[2], hi[3]};
}
__device__ __forceinline__ bf16x8 frag_row(const LAS unsigned char* img, int RS, int r0, int k0, int lane) {
    return *(const LAS bf16x8*)(img + (r0 + (lane & 31)) * RS + (k0 + 8 * (lane >> 5)) * 2);
}
constexpr int RS_BC = 272, RS_X = 144, IMG_BC = 128 * RS_BC, IMG_X = 128 * RS_X;
__device__ __forceinline__ void ssd_stage_acum(LAS float* acl, LAS float* dtl, const GAS float* DT, const GAS float* a_log_l, size_t m0, int Lc, int g, int wave, int lane) {
    const int h = 8 * g + wave; const float A = -__expf(a_log_l[h]);
    const float d0 = lane < Lc ? DT[(m0 + lane) * 32 + h] : 0.f, d1 = (64 + lane) < Lc ? DT[(m0 + 64 + lane) * 32 + h] : 0.f;
    const float s0 = wave_incl_scan_f(d0 * A, lane), tot0 = __shfl(s0, 63), s1 = wave_incl_scan_f(d1 * A, lane) + tot0;
    acl[wave * 128 + lane] = s0; acl[wave * 128 + 64 + lane] = s1; dtl[wave * 128 + lane] = d0; dtl[wave * 128 + 64 + lane] = d1;
}
__device__ __forceinline__ void ssd_stage_bc(LAS unsigned char* img, const GAS bf16* src  , int Lc, int tid) {
    const int ch = tid & 15;
#pragma unroll
    for (int q4 = 0; q4 < 4; ++q4) { const int row = (tid >> 4) + 32 * q4; v4u v = (v4u){0u, 0u, 0u, 0u}; if (row < Lc) v = *(const GAS v4u*)(src + (size_t)row * CONVD + ch * 8);
        *(LAS v4u*)(img + row * RS_BC + ch * 16) = v; }
}
__device__ __forceinline__ void ssd_stage_x(LAS unsigned char* img, const GAS bf16* src  , int Lc, int tid, const LAS float* dth, const LAS float* ach, float al, bool decay) {
    const int ch = tid & 7;
#pragma unroll
    for (int q2 = 0; q2 < 2; ++q2) { const int row = (tid >> 3) + 64 * q2; v4u o = (v4u){0u, 0u, 0u, 0u};
        if (row < Lc) { float f[8]; unpack8(*(const GAS v4u*)(src + (size_t)row * CONVD + ch * 8), f);
            const float sc = decay ? dth[row] * __expf(al - ach[row]) : dth[row];
            o = (v4u){pk2(f[0] * sc, f[1] * sc), pk2(f[2] * sc, f[3] * sc), pk2(f[4] * sc, f[5] * sc), pk2(f[6] * sc, f[7] * sc)}; }
        *(LAS v4u*)(img + row * RS_X + ch * 16) = o; }
}
__device__ __forceinline__ void ssd1_unit(LAS unsigned char* lds, int tid, const GAS bf16* XC, const GAS float* DT, const GAS float* a_log_l, GAS bf16* SB, GAS float* DEC, int b, int c, int g) {
    const int lane = tid & 63, wave = __builtin_amdgcn_readfirstlane(tid >> 6), hh = lane >> 5, col = lane & 31;
    const int t0 = c == 0 ? 0 : NMETA + 128 * (c - 1), Lc = c == 0 ? NMETA : 128; const size_t m0 = (size_t)b * LP + t0;
    LAS unsigned char* Bimg = lds; LAS unsigned char* Xw0 = lds + IMG_BC;
    LAS float* acl = (LAS float*)(lds + IMG_BC + 2 * IMG_X); LAS float* dtl = acl + 1024;
    ssd_stage_acum(acl, dtl, DT, a_log_l, m0, Lc, g, wave, lane);
    ssd_stage_bc(Bimg, XC + m0 * CONVD + DIN + g * NST, Lc, tid);
    __syncthreads();
    const int pb = wave >> 2, nb = wave & 3;
    for (int hl = 0; hl < 8; ++hl) {
        const int h = 8 * g + hl; LAS unsigned char* Xw = Xw0 + (hl & 1) * IMG_X;
        const float al = acl[hl * 128 + 127];
        ssd_stage_x(Xw, XC + m0 * CONVD + h * HP, Lc, tid, dtl + hl * 128, acl + hl * 128, al, true);
        __syncthreads();
        f32x16 acc = {};
        if (Lc == 128) {
#pragma unroll
            for (int ks = 0; ks < 8; ++ks) acc = __builtin_amdgcn_mfma_f32_32x32x16_bf16(frag_tr(Xw, RS_X, 16 * ks, 32 * pb, lane), frag_tr(Bimg, RS_BC, 16 * ks, 32 * nb, lane), acc, 0, 0, 0);
        } else acc = __builtin_amdgcn_mfma_f32_32x32x16_bf16(frag_tr(Xw, RS_X, 0, 32 * pb, lane), frag_tr(Bimg, RS_BC, 0, 32 * nb, lane), acc, 0, 0, 0);
        GAS bf16* Sp = SB + ((size_t)(b * NCH + c) * NH + h) * (HP * NST) + 32 * nb + col;
#pragma unroll
        for (int r = 0; r < 16; ++r) Sp[(32 * pb + (r & 3) + 8 * (r >> 2) + 4 * hh) * NST] = (bf16)f2bf(acc[r]);
        if (tid == 0) DEC[(b * NCH + c) * NH + h] = __expf(al);
    }
    __syncthreads();
}
#ifndef REP_SSD3_WR
#define REP_SSD3_WR 1
#endif
#ifndef REP_SSD3_MM
#define REP_SSD3_MM 1
#endif
#ifndef REP_SSD3_HEADS
#define REP_SSD3_HEADS 1
#endif
__device__ __forceinline__ void ssd3_unit(LAS unsigned char* lds, int tid, const GAS bf16* XC, const GAS bf16* P1, const GAS float* DT, const GAS float* a_log_l, const GAS float* dskip_l, const GAS float* normw_l,
                                          const GAS bf16* HC, GAS bf16* YSN, int b, int c, int g) {
    const int lane = tid & 63, wave = __builtin_amdgcn_readfirstlane(tid >> 6), hh = lane >> 5, col = lane & 31;
    const int t0 = c == 0 ? 0 : NMETA + 128 * (c - 1), Lc = c == 0 ? NMETA : 128; const size_t m0 = (size_t)b * LP + t0;
    LAS unsigned char* Bimg = lds; LAS unsigned char* Cimg = lds + IMG_BC; LAS unsigned char* Mimg0 = lds + 2 * IMG_BC; LAS unsigned char* Ximg0 = lds + 3 * IMG_BC;
    LAS float* acl = (LAS float*)(lds + 3 * IMG_BC + 2 * IMG_X); LAS float* dtl = acl + 1024;
    LAS unsigned char* Mimg1 = Bimg; LAS unsigned char* Ximg1 = Ximg0 + IMG_X;
    ssd_stage_acum(acl, dtl, DT, a_log_l, m0, Lc, g, wave, lane);
    ssd_stage_bc(Bimg, XC + m0 * CONVD + DIN + g * NST, Lc, tid);
    ssd_stage_bc(Cimg, XC + m0 * CONVD + DIN + NG * NST + g * NST, Lc, tid);
    __syncthreads();
    const int ib = wave >> 1, pb = wave & 1;
    f32x16 cb[2];
    const bool live = 32 * ib < Lc;
#pragma unroll
    for (int jj = 0; jj < 2; ++jj) { const int jb = 2 * (wave & 1) + jj; cb[jj] = (f32x16){};
        if (jb <= ib && live) {
#pragma unroll
            for (int ks = 0; ks < 8; ++ks) cb[jj] = __builtin_amdgcn_mfma_f32_32x32x16_bf16(frag_row(Bimg, RS_BC, 32 * jb, 16 * ks, lane), frag_row(Cimg, RS_BC, 32 * ib, 16 * ks, lane), cb[jj], 0, 0, 0); } }
    const int irow = 32 * ib + col;
    bf16x8 cf[8];
#pragma unroll
    for (int ks = 0; ks < 8; ++ks) cf[ks] = frag_row(Cimg, RS_BC, 32 * ib, 16 * ks, lane);
    __syncthreads();
    const int xrow = tid >> 3, xch = tid & 7;
    const GAS bf16* xsrc = XC + (m0 + xrow) * CONVD + (8 * g) * HP + xch * 8;
    v4u xq0 = (v4u){0u, 0u, 0u, 0u}, xq1 = xq0;
    for (int rh_ = 0; rh_ < REP_SSD3_HEADS; ++rh_) {
    if (rh_ > 0) __syncthreads();
    if (xrow < Lc) xq0 = *(const GAS v4u*)xsrc;
    if (xrow + 64 < Lc) xq1 = *(const GAS v4u*)(xsrc + (size_t)64 * CONVD);
    const GAS bf16* Hp0 = HC + ((size_t)(b * NCH + c) * NH + 8 * g) * (HP * NST) + pb * 4096 + lane * 8;
    bf16x8 hq[8];
#pragma unroll
    for (int ks = 0; ks < 8; ++ks) hq[ks] = *(const GAS bf16x8*)(Hp0 + 512 * ks);
    for (int hl = 0; hl < 8; ++hl) {
        const int h = 8 * g + hl;
        LAS unsigned char* Mimg = (hl & 1) ? Mimg1 : Mimg0; LAS unsigned char* Ximg = (hl & 1) ? Ximg1 : Ximg0;
        bf16x8 hf[8], hn[8];
#pragma unroll
        for (int ks = 0; ks < 8; ++ks) { hf[ks] = hq[ks]; hn[ks] = hq[ks]; }
        if (hl < 7) {
#pragma unroll
            for (int ks = 0; ks < 8; ++ks) hn[ks] = *(const GAS bf16x8*)(Hp0 + (size_t)(hl + 1) * (HP * NST) + 512 * ks); }
        v4u xn0 = xq0, xn1 = xq1;
        if (hl < 7 && xrow < Lc) xn0 = *(const GAS v4u*)(xsrc + (hl + 1) * HP);
        if (hl < 7 && xrow + 64 < Lc) xn1 = *(const GAS v4u*)(xsrc + (size_t)64 * CONVD + (hl + 1) * HP);
        const float ai = acl[hl * 128 + irow];
        for (int rw_ = 0; rw_ < REP_SSD3_WR; ++rw_) {
#pragma unroll
        for (int jj = 0; jj < 2; ++jj) { const int jb = 2 * (wave & 1) + jj;
            if (jb <= ib && live) {
                LAS unsigned char* mp = Mimg + irow * RS_BC + (32 * jb + 4 * hh) * 2;
#pragma unroll
                for (int q = 0; q < 4; ++q) { const int j0 = 32 * jb + 8 * q + 4 * hh; const f32x4 aj = *(const LAS f32x4*)(acl + hl * 128 + j0);
                    float v[4];
#pragma unroll
                    for (int e = 0; e < 4; ++e) v[e] = (j0 + e <= irow) ? cb[jj][4 * q + e] * __expf(ai - aj[e]) : 0.f;
                    *(LAS v2u*)(mp + 16 * q) = (v2u){pk2(v[0], v[1]), pk2(v[2], v[3])}; } } }
        { const float s0 = dtl[hl * 128 + xrow], s1 = dtl[hl * 128 + 64 + xrow]; float f[8]; v4u o0, o1;
          unpack8(xq0, f); o0 = (v4u){pk2(f[0] * s0, f[1] * s0), pk2(f[2] * s0, f[3] * s0), pk2(f[4] * s0, f[5] * s0), pk2(f[6] * s0, f[7] * s0)};
          unpack8(xq1, f); o1 = (v4u){pk2(f[0] * s1, f[1] * s1), pk2(f[2] * s1, f[3] * s1), pk2(f[4] * s1, f[5] * s1), pk2(f[6] * s1, f[7] * s1)};
          *(LAS v4u*)(Ximg + xrow * RS_X + xch * 16) = o0; *(LAS v4u*)(Ximg + (xrow + 64) * RS_X + xch * 16) = o1; }
        }
        __syncthreads();
        f32x16 a1 = {}, a2 = {};
        if (live) {
        const int nks = Lc == 128 ? 2 * (ib + 1) : 1;
        for (int rm_ = 0; rm_ < REP_SSD3_MM; ++rm_) { a1 = (f32x16){}; a2 = (f32x16){};
        for (int ks = 0; ks < nks; ++ks) a1 = __builtin_amdgcn_mfma_f32_32x32x16_bf16(frag_tr(Ximg, RS_X, 16 * ks, 32 * pb, lane), frag_row(Mimg, RS_BC, 32 * ib, 16 * ks, lane), a1, 0, 0, 0);
#pragma unroll
        for (int ks = 0; ks < 8; ++ks) a2 = __builtin_amdgcn_mfma_f32_32x32x16_bf16(hf[ks], cf[ks], a2, 0, 0, 0);
        }
        const float ei = __expf(ai);
        v2u wq[4];
#pragma unroll
        for (int q = 0; q < 4; ++q) wq[q] = (v2u){pk2(a1[4 * q] + ei * a2[4 * q], a1[4 * q + 1] + ei * a2[4 * q + 1]), pk2(a1[4 * q + 2] + ei * a2[4 * q + 2], a1[4 * q + 3] + ei * a2[4 * q + 3])};
        GAS bf16* yo = YSN + (m0 + irow) * DIN + h * HP + 32 * pb + 8 * hh;
#pragma unroll
        for (int k = 0; k < 4; k += 2) {
            const auto rx = __builtin_amdgcn_permlane32_swap(wq[k].x, wq[k + 1].x, false, false), ry = __builtin_amdgcn_permlane32_swap(wq[k].y, wq[k + 1].y, false, false);
            if (irow < Lc) *(GAS v4u*)(yo + 8 * k) = (v4u){rx[0], ry[0], rx[1], ry[1]}; }
        }
#pragma unroll
        for (int ks = 0; ks < 8; ++ks) hq[ks] = hn[ks];
        xq0 = xn0; xq1 = xn1;
    }
    }
    __syncthreads();
    for (int i0 = wave; i0 < Lc; i0 += 4 * NWAVES) { const int c0 = g * 512 + lane * 8;
        v4u yv[4], xv[4], zv[4];
#pragma unroll
        for (int q = 0; q < 4; ++q) { const int i = i0 + NWAVES * q; const size_t m = m0 + (i < Lc ? i : i0);
            yv[q] = *(const GAS v4u*)(YSN + m * DIN + c0); xv[q] = *(const GAS v4u*)(XC + m * CONVD + c0); zv[q] = *(const GAS v4u*)(P1 + m * LDP1 + C_Z + c0); }
        const float Dh = dskip_l[c0 >> 6];
        const GAS float* wp = normw_l + c0; const f32x4 wa = *(const GAS f32x4*)wp, wb = *(const GAS f32x4*)(wp + 4);
#pragma unroll
        for (int q = 0; q < 4; ++q) { const int i = i0 + NWAVES * q;
            float v[8], x[8], z[8]; unpack8(yv[q], v); unpack8(xv[q], x); unpack8(zv[q], z); float ss = 0.f;
#pragma unroll
            for (int j = 0; j < 8; ++j) { v[j] = (v[j] + Dh * x[j]) * (z[j] * sigm(z[j])); ss += v[j] * v[j]; }
            ss = wave_sum(ss);
            const float rstd = 1.0f / sqrtf(ss * (1.0f / 512.0f) + 1e-6f);
            if (i < Lc) *(GAS v4u*)(YSN + (m0 + i) * DIN + c0) = (v4u){pk2(v[0] * rstd * wa.x, v[1] * rstd * wa.y), pk2(v[2] * rstd * wa.z, v[3] * rstd * wa.w), pk2(v[4] * rstd * wb.x, v[5] * rstd * wb.y), pk2(v[6] * rstd * wb.z, v[7] * rstd * wb.w)}; }
    }
    __syncthreads();
}

constexpr int RS_V = 528;
#define KLOAD(dst, tile) do { _Pragma("unroll") for (int it = 0; it < 8; ++it) dst[it] = *(const GAS v4u*)(kvb + ((unsigned)idl[16 * (tile) + 2 * it + (lane >> 5)] * 1024u + 16u * (lane & 31))); } while (0)
template <int JT> struct AttnKTile {
    static __device__ __forceinline__ void run(LAS unsigned char* Vst, const LAS unsigned short* idl, const GAS char* kvb, const int lane, const int n, const int kg, const int k4, const int cnt, const int ntile,
                                               const bf16x8 (&bq)[8], v4u (&kst)[3][8], f32x4 (&S)[16], float& mx) {
        if (JT < ntile) {
            LAS unsigned char* half = Vst + 16 * (JT & 1) * RS_V;
#pragma unroll
            for (int it = 0; it < 8; ++it) *(LAS v4u*)(half + (2 * it + (lane >> 5)) * RS_V + 16 * (lane & 31)) = kst[JT % 3][it];
            LDS_WAIT(); asm volatile("" ::: "memory");
            if (JT + 3 < 16) KLOAD(kst[JT % 3], JT + 3);
            f32x4 acc = {0.f, 0.f, 0.f, 0.f};
#pragma unroll
            for (int s8 = 0; s8 < 8; ++s8) acc = __builtin_amdgcn_mfma_f32_16x16x32_bf16(*(const LAS bf16x8*)(half + n * RS_V + (32 * s8 + 8 * kg) * 2), bq[s8], acc, 0, 0, 0);
            f32x4 sv;
#pragma unroll
            for (int i = 0; i < 4; ++i) { const float v = (k4 + i < cnt - 16 * JT) ? acc[i] * 0.125f : -INFINITY; sv[i] = v; mx = fmaxf(mx, v); }
            S[JT] = sv;
            LDS_WAIT(); asm volatile("" ::: "memory");
            AttnKTile<JT + 1>::run(Vst, idl, kvb, lane, n, kg, k4, cnt, ntile, bq, kst, S, mx);
        }
    }
};
template <> struct AttnKTile<16> {
    static __device__ __forceinline__ void run(LAS unsigned char*, const LAS unsigned short*, const GAS char*, int, int, int, int, int, int, const bf16x8 (&)[8], v4u (&)[3][8], f32x4 (&)[16], float&) {}
};
__device__ __forceinline__ void attn_prompt_query(LAS unsigned char* wl, const GAS bf16* P1, const GAS bf16* KVB, const GAS unsigned short* IDXP, GAS bf16* YA, int m, int lane_in) {
    int lane = lane_in; asm volatile("" : "+v"(lane));
    const int b = m / LP, t = m - b * LP, cnt = (t + 1) < 256 ? (t + 1) : 256, ntile = (cnt + 15) >> 4, nstep = (ntile + 1) >> 1;
    LAS unsigned char* Vst = wl; LAS unsigned short* idl = (LAS unsigned short*)(wl + 32 * RS_V);
    { const v2u w = *(const GAS v2u*)(IDXP + (size_t)m * 256 + 4 * lane); const int s0 = 4 * lane;
      const unsigned i0 = (s0 + 0 < cnt) ? (w.x & 0xffffu) : 0u, i1 = (s0 + 1 < cnt) ? (w.x >> 16) : 0u, i2 = (s0 + 2 < cnt) ? (w.y & 0xffffu) : 0u, i3 = (s0 + 3 < cnt) ? (w.y >> 16) : 0u;
      *(LAS v2u*)(idl + s0) = (v2u){i0 | (i1 << 16), i2 | (i3 << 16)}; }
    const int n = lane & 15, kg = lane >> 4;
    int k4 = 4 * kg; asm volatile("" : "+v"(k4));
    bf16x8 bq[8];
#pragma unroll
    for (int s = 0; s < 8; ++s) { bq[s] = (bf16x8){0, 0, 0, 0, 0, 0, 0, 0};
        if ((n >> 2) == (s >> 1)) bq[s] = *(const GAS bf16x8*)(P1 + (size_t)m * LDP1 + C_Q + n * 64 + 32 * (s & 1) + 8 * kg); }
    LDS_WAIT(); asm volatile("" ::: "memory");
    const GAS char* kvb = (const GAS char*)(KVB + (size_t)b * LP * 512);
    const unsigned voff = 512u + 16u * (lane & 31);
    f32x4 S[16];
#pragma unroll
    for (int jt = 0; jt < 16; ++jt) S[jt] = (f32x4){-INFINITY, -INFINITY, -INFINITY, -INFINITY};
    float mx = -INFINITY;
    {
        v4u kst[3][8];
        KLOAD(kst[0], 0); KLOAD(kst[1], 1); KLOAD(kst[2], 2);
        AttnKTile<0>::run(Vst, idl, kvb, lane, n, kg, k4, cnt, ntile, bq, kst, S, mx);
#undef KLOAD
    }
    mx = fmaxf(mx, __shfl_xor(mx, 16)); mx = fmaxf(mx, __shfl_xor(mx, 32));
    float sum = 0.f;
    v4u pa[8];
#pragma unroll
    for (int s = 0; s < 8; ++s) { float p[8];
#pragma unroll
        for (int i = 0; i < 4; ++i) { p[i] = __expf(S[2 * s][i] - mx); p[4 + i] = __expf(S[2 * s + 1][i] - mx); }
#pragma unroll
        for (int i = 0; i < 8; ++i) sum += p[i];
        pa[s] = (v4u){pk2(p[0], p[1]), pk2(p[2], p[3]), pk2(p[4], p[5]), pk2(p[6], p[7])};
        __builtin_amdgcn_sched_barrier(0); }
    sum += __shfl_xor(sum, 16); sum += __shfl_xor(sum, 32);
    const float linv = 1.0f / sum;
    asm volatile("" ::: "memory");
    v4u vst[3][8];
#define VLOAD(dst, tile) do { _Pragma("unroll") for (int it = 0; it < 8; ++it) dst[it] = *(const GAS v4u*)(kvb + ((unsigned)idl[16 * (tile) + 2 * it + (lane >> 5)] * 1024u + voff)); } while (0)
#define VSTORE(src, tt) do { _Pragma("unroll") for (int it = 0; it < 8; ++it) { const int u = 2 * it + (lane >> 5); *(LAS v4u*)(Vst + (8 * (u >> 2) + 4 * (tt) + (u & 3)) * RS_V + 16 * (lane & 31)) = src[it]; } } while (0)
    VLOAD(vst[0], 0); VLOAD(vst[1], 1); VLOAD(vst[2], 2);
    f32x4 o[4];
#pragma unroll
    for (int c = 0; c < 4; ++c) o[c] = (f32x4){0.f, 0.f, 0.f, 0.f};
    const int g16 = lane >> 4, q4 = (lane & 15) >> 2, p4 = lane & 3;
    const LAS unsigned char* trb = Vst + (8 * g16 + q4) * RS_V + 8 * p4;
#pragma unroll
    for (int s = 0; s < 8; ++s) {
        if (s >= nstep) break;
        {
            VSTORE(vst[(2 * s) % 3], 0);
            VSTORE(vst[(2 * s + 1) % 3], 1);
            LDS_WAIT(); asm volatile("" ::: "memory");
            if (2 * s + 3 < 16) VLOAD(vst[(2 * s) % 3], 2 * s + 3);
            if (2 * s + 4 < 16) VLOAD(vst[(2 * s + 1) % 3], 2 * s + 4);
#pragma unroll
            for (int g = 0; g < 4; ++g) {
                const v4u pm = ((n >> 2) == g) ? pa[s] : (v4u){0u, 0u, 0u, 0u};
                const bf16x8 pf = __builtin_bit_cast(bf16x8, pm);
#pragma unroll
                for (int c = 0; c < 4; ++c) { const int ct = 4 * g + c;
                    const s16x4 lo = ldtr(trb + 32 * ct), hi = ldtr(trb + 4 * RS_V + 32 * ct);
                    const bf16x8 bv = (bf16x8){lo[0], lo[1], lo[2], lo[3], hi[0], hi[1], hi[2], hi[3]};
                    o[c] = __builtin_amdgcn_mfma_f32_16x16x32_bf16(pf, bv, o[c], 0, 0, 0); }
            }
            LDS_WAIT(); asm volatile("" ::: "memory");
        }
    }
#undef VLOAD
#undef VSTORE
#pragma unroll
    for (int i = 0; i < 4; ++i) { const float li = __shfl(linv, 4 * kg + i);
#pragma unroll
        for (int c = 0; c < 4; ++c) YA[(size_t)m * D + (4 * kg + i) * 64 + 16 * c + n] = (bf16)f2bf(o[c][i] * li); }
}

__device__ __forceinline__ void attn_sample_query(LAS unsigned char* lds, int tid, const GAS bf16* P1, const GAS bf16* KVB, const GAS float* ck, const GAS float* cv, const GAS int* ptab, const GAS int* IDXS, GAS bf16* YA, int qi) {
    const int lane = tid & 63, wave = tid >> 6, bd = qi >> 3; const size_t m = (size_t)MP + qi;
    LAS float* Sl = (LAS float*)lds;
    LAS float* Ol = Sl + 16 * 256;
    LAS float* ql = Ol + 8 * 1024;
    LAS float* linv = ql + 1024;
    LAS int* rowsel = (LAS int*)(linv + 16);
    { const unsigned w = *(const GAS unsigned*)(P1 + m * LDP1 + C_Q + 2 * tid); ql[2 * tid] = __uint_as_float(w << 16); ql[2 * tid + 1] = __uint_as_float(w & 0xffff0000u); }
    if (tid < 256) rowsel[tid] = IDXS[qi * 256 + tid];
    __syncthreads();
    const int g = lane >> 4, c = lane & 15;
    float qr[4][4];
#pragma unroll
    for (int a = 0; a < 4; ++a) { const f32x4 t = *(const LAS f32x4*)(ql + (4 * g + a) * 64 + 4 * c); qr[a][0] = t.x; qr[a][1] = t.y; qr[a][2] = t.z; qr[a][3] = t.w; }
#pragma unroll 4
    for (int kk = 0; kk < 32; ++kk) {
        const int key = 32 * wave + kk, idx = rowsel[key];
        f32x4 kv;
        if (idx < PAST) { const int page = ptab[bd * NPAGES + (idx >> 7)]; kv = *(const GAS f32x4*)(ck + ((size_t)page * PAGE + (idx & 127)) * 256 + 4 * lane); }
        else { const v2u w = *(const GAS v2u*)(KVB + (size_t)(MP + bd * DS + (idx - PAST)) * 512 + 4 * lane);
            kv = (f32x4){__uint_as_float(w.x << 16), __uint_as_float(w.x & 0xffff0000u), __uint_as_float(w.y << 16), __uint_as_float(w.y & 0xffff0000u)}; }
        float part[4];
#pragma unroll
        for (int a = 0; a < 4; ++a) { float s = (qr[a][0] * kv.x + qr[a][1] * kv.y) + (qr[a][2] * kv.z + qr[a][3] * kv.w);
            part[a] = row16_sum(s); }
        if (c == 0) {
#pragma unroll
            for (int a = 0; a < 4; ++a) Sl[(4 * g + a) * 256 + key] = part[a] * 0.125f; }
    }
    __syncthreads();
#pragma unroll
    for (int hs = 0; hs < 2; ++hs) { const int head = 2 * wave + hs; float v[4]; float mx = -INFINITY;
#pragma unroll
        for (int j = 0; j < 4; ++j) { v[j] = Sl[head * 256 + lane + 64 * j]; mx = fmaxf(mx, v[j]); }
        mx = wave_max(mx); float sum = 0.f;
#pragma unroll
        for (int j = 0; j < 4; ++j) { v[j] = __expf(v[j] - mx); sum += v[j]; Sl[head * 256 + lane + 64 * j] = v[j]; }
        sum = wave_sum(sum);
        if (lane == 0) linv[head] = 1.0f / sum; }
    __syncthreads();
    float o[4][4];
#pragma unroll
    for (int a = 0; a < 4; ++a)
#pragma unroll
        for (int cc = 0; cc < 4; ++cc) o[a][cc] = 0.f;
#pragma unroll 4
    for (int kk = 0; kk < 32; ++kk) {
        const int key = 32 * wave + kk, idx = rowsel[key];
        f32x4 vv;
        if (idx < PAST) { const int page = ptab[bd * NPAGES + (idx >> 7)]; vv = *(const GAS f32x4*)(cv + ((size_t)page * PAGE + (idx & 127)) * 256 + 4 * lane); }
        else { const v2u w = *(const GAS v2u*)(KVB + (size_t)(MP + bd * DS + (idx - PAST)) * 512 + 256 + 4 * lane);
            vv = (f32x4){__uint_as_float(w.x << 16), __uint_as_float(w.x & 0xffff0000u), __uint_as_float(w.y << 16), __uint_as_float(w.y & 0xffff0000u)}; }
#pragma unroll
        for (int a = 0; a < 4; ++a) { const float p = Sl[(4 * g + a) * 256 + key]; o[a][0] += p * vv.x; o[a][1] += p * vv.y; o[a][2] += p * vv.z; o[a][3] += p * vv.w; }
    }
#pragma unroll
    for (int a = 0; a < 4; ++a) *(LAS f32x4*)(Ol + wave * 1024 + (4 * g + a) * 64 + 4 * c) = (f32x4){o[a][0], o[a][1], o[a][2], o[a][3]};
    __syncthreads();
    { float s0 = 0.f, s1 = 0.f;
#pragma unroll
      for (int w = 0; w < 8; ++w) { s0 += Ol[w * 1024 + 2 * tid]; s1 += Ol[w * 1024 + 2 * tid + 1]; }
      const float li = linv[(2 * tid) >> 6];
      *(GAS unsigned*)(YA + m * D + 2 * tid) = pk2(s0 * li, s1 * li); }
    __syncthreads();
}

constexpr int TAIL_R0 = 16384, TAIL_NRT = (MR - TAIL_R0) / 64;
static_assert(TAIL_R0 + 64 * TAIL_NRT == MR, "tail rows");
template <int MODE>
__device__ __forceinline__ void tail_gemm(LAS unsigned char* lds, const GAS bf16* A, int K, const GAS bf16* Bt, int N, const GAS bf16* P1, GAS bf16* T1, GAS bf16* MG, GAS float* H, GAS bf16* A2, int bx, int G, int tid) {
    constexpr int KB = 256, RS = (KB + 8) * 2;
    const int lane = tid & 63, wave = __builtin_amdgcn_readfirstlane(tid >> 6), col = lane & 31, hh = lane >> 5;
    const int nunits = TAIL_NRT * (N / 64), lr = tid >> 3, lc = tid & 7, ti = wave & 3, kh = wave >> 2;
    LAS unsigned char* As = lds; LAS unsigned char* Bs = lds + 64 * RS; LAS float* red = (LAS float*)(lds + 2 * 64 * RS);
    for (int u = bx; u < nunits; u += G) {
        const int rt = u % TAIL_NRT, ct = u / TAIL_NRT;
        const GAS bf16* ap = A + (size_t)(TAIL_R0 + 64 * rt + lr) * K + 8 * lc;
        const GAS bf16* bp = Bt + (size_t)(64 * ct + lr) * K + 8 * lc;
        v4u ra[4], rb[4];
#pragma unroll
        for (int j = 0; j < 4; ++j) { ra[j] = *(const GAS v4u*)(ap + 64 * j); rb[j] = *(const GAS v4u*)(bp + 64 * j); }
        f32x16 acc = {};
        for (int k0 = 0; k0 < K; k0 += KB) {
            __syncthreads();
#pragma unroll
            for (int j = 0; j < 4; ++j) { *(LAS v4u*)(As + lr * RS + (lc * 8 + 64 * j) * 2) = ra[j]; *(LAS v4u*)(Bs + lr * RS + (lc * 8 + 64 * j) * 2) = rb[j]; }
            if (k0 + KB < K) {
#pragma unroll
                for (int j = 0; j < 4; ++j) { ra[j] = *(const GAS v4u*)(ap + k0 + KB + 64 * j); rb[j] = *(const GAS v4u*)(bp + k0 + KB + 64 * j); } }
            __syncthreads();
#pragma unroll
            for (int j = 0; j < 8; ++j) { const int ks = 8 * kh + j;
                const bf16x8 av = *(const LAS bf16x8*)(As + (32 * (ti >> 1) + col) * RS + (16 * ks + 8 * hh) * 2), bv = *(const LAS bf16x8*)(Bs + (32 * (ti & 1) + col) * RS + (16 * ks + 8 * hh) * 2);
                acc = __builtin_amdgcn_mfma_f32_32x32x16_bf16(av, bv, acc, 0, 0, 0); }
        }
        __syncthreads();
        if (kh == 1) {
#pragma unroll
            for (int r = 0; r < 16; ++r) red[(ti * 16 + r) * 64 + lane] = acc[r]; }
        __syncthreads();
        if (kh == 0) {
            const int c = 64 * ct + 32 * (ti & 1) + col;
#pragma unroll
            for (int r = 0; r < 16; ++r) { const size_t row = TAIL_R0 + 64 * rt + 32 * (ti >> 1) + (r & 3) + 8 * (r >> 2) + 4 * hh; const float v = acc[r] + red[(ti * 16 + r) * 64 + lane];
                if (MODE == 1) { const float g = __uint_as_float((unsigned)P1[row * LDP1 + C_GS + c] << 16); T1[row * D + c] = (bf16)f2bf(v * sigm(g)); }
                if (MODE == 2) { const float g = __uint_as_float((unsigned)P1[row * LDP1 + C_GA + c] << 16); MG[row * D + c] = (bf16)f2bf(__uint_as_float((unsigned)T1[row * D + c] << 16) + v * sigm(g)); }
                if (MODE == 3) H[row * D + c] += v;
                if (MODE == 4) { const float w = fmaxf(v, 0.f); A2[row * DFF + c] = (bf16)f2bf(w * w); } }
        }
    }
    __syncthreads();
}

#ifndef REP_SCORE
#define REP_SCORE 1
#endif
#ifndef REP_SCORE_AT
#define REP_SCORE_AT 1
#endif
#ifndef REP_SEL
#define REP_SEL 1
#endif
#ifndef REP_CONV
#define REP_CONV 1
#endif
#ifndef REP_TOPK
#define REP_TOPK 1
#endif
#ifndef REP_SSC
#define REP_SSC 1
#endif
#ifndef REP_SSEL
#define REP_SSEL 1
#endif
#ifndef REP_SSD1
#define REP_SSD1 1
#endif
#ifndef REP_SREC
#define REP_SREC 1
#endif
#ifndef REP_SCAN
#define REP_SCAN 1
#endif
#ifndef REP_ATTS
#define REP_ATTS 1
#endif
#ifndef REP_ATTP
#define REP_ATTP 1
#endif
#ifndef REP_SSD3
#define REP_SSD3 1
#endif
__device__ __forceinline__ void xcd_barrier_ni(unsigned* bar, unsigned x, volatile LAS unsigned* st, int tid, unsigned G) { XcdBarrier b; b.bar = bar; b.x = x; b.st = st; xcd_barrier(b, tid, G); }
__device__ __forceinline__ void assume_global(const void* p) {
#if defined(__HIP_DEVICE_COMPILE__)
    __builtin_assume(!__builtin_amdgcn_is_shared((const __attribute__((address_space(0))) void*)p));
    __builtin_assume(!__builtin_amdgcn_is_private((const __attribute__((address_space(0))) void*)p));
#else
    (void)p;
#endif
}
__device__ __forceinline__ int tid_now(int wave0) { unsigned ones = ~0u; asm volatile("" : "+s"(ones)); return (wave0 << 6) | (int)__builtin_amdgcn_mbcnt_hi(ones, __builtin_amdgcn_mbcnt_lo(ones, 0u)); }
constexpr int NPH = 12, NPHASES = 1 + 2 * NPH;
struct Args { const void* in[24]; float* out; unsigned char* ws; int l_lo, l_hi; };
static_assert(sizeof(Args) == 24 * 8 + 8 + 8 + 8, "Args has no padding");

template <int KLO, int KHI>
__global__ void __launch_bounds__(NT, 2) fwd_t(Args args) {
    extern __shared__ __attribute__((aligned(16))) unsigned char lds_raw[];
    LAS unsigned char* lds0 = (LAS unsigned char*)lds_raw;
    volatile LAS unsigned* MISCW = (volatile LAS unsigned*)(lds0 + MISC_OFF);
    const int G = gridDim.x, bx = blockIdx.x, NGW = G * NWAVES;
    const int wave0 = __builtin_amdgcn_readfirstlane((int)threadIdx.x >> 6);
#define TID_NOW() tid_now(wave0)
    { const int tid0 = threadIdx.x;
      for (int u = tid0; u < (LDS_BYTES - LDSCTL_OFF) / 4; u += NT) ((LAS unsigned*)(lds0 + LDSCTL_OFF))[u] = 0u; }
    __syncthreads();
    XcdBarrier bar = xcd_barrier_post((unsigned*)(args.ws + WS_CTL) + CW_BAR, MISCW + 8);
#define IN(k) (KLO <= (k) && (k) < KHI)
#define SEAM(k) do { if (IN(k) && IN((k) + 1)) xcd_barrier_ni(bar.bar, bar.x, bar.st, TID_NOW(), (unsigned)G); } while (0)
#define PHASE_REGS \
    int tid = TID_NOW(); asm volatile("" : "+v"(tid)); \
    int bxl = bx, Gl = G; asm volatile("" : "+s"(bxl), "+s"(Gl)); (void)bxl; (void)Gl;     \
    const int lane = tid & 63, wave = __builtin_amdgcn_readfirstlane(tid >> 6), gw = bx * NWAVES + wave; \
    unsigned char* ws_ = args.ws; asm volatile("" : "+s"(ws_)); GAS unsigned char* ws = (GAS unsigned char*)ws_;     \
    float* out_ = args.out; asm volatile("" : "+s"(out_)); GAS float* out = (GAS float*)out_; \
    (void)lane; (void)gw; (void)out; \
    GAS float* H = (GAS float*)(ws + WS_H); GAS bf16* U = (GAS bf16*)(ws + WS_U); GAS bf16* P1 = (GAS bf16*)(ws + WS_P1); GAS float* MISCB = (GAS float*)(ws + WS_MISC); GAS bf16* KIB = (GAS bf16*)(ws + WS_KIB); \
    GAS bf16* XC = (GAS bf16*)(ws + WS_XC); GAS float* DT = (GAS float*)(ws + WS_DT); GAS float* DA = (GAS float*)(ws + WS_DA); GAS float* YS = (GAS float*)(ws + WS_YS); GAS bf16* YSN = (GAS bf16*)(ws + WS_YSN); \
    GAS bf16* YA = (GAS bf16*)(ws + WS_YA); GAS bf16* T1 = (GAS bf16*)(ws + WS_T1); GAS bf16* MG = (GAS bf16*)(ws + WS_MG); GAS bf16* A2 = (GAS bf16*)(ws + WS_A2); \
    GAS unsigned short* IDXP = (GAS unsigned short*)(ws + WS_IDXP); GAS int* IDXS = (GAS int*)(ws + WS_IDXS); GAS float* SCS = (GAS float*)(ws + WS_SCS); \
    GAS bf16* SB = (GAS bf16*)(ws + WS_SB); GAS float* DEC = (GAS float*)(ws + WS_DEC); GAS bf16* HC = (GAS bf16*)(ws + WS_HC); GAS bf16* KVB = (GAS bf16*)(ws + WS_KVB); GAS bf16* KIB2 = (GAS bf16*)(ws + WS_KIB2); (void)KIB2; (void)SB; (void)DEC; (void)HC; (void)KVB; \
    GAS unsigned char* wl = ws + WS_W + (size_t)l * WL_SIZE; \
    (void)H; (void)U; (void)P1; (void)MISCB; (void)KIB; (void)XC; (void)DT; (void)DA; (void)YS; (void)YSN; (void)YA; (void)T1; (void)MG; (void)A2; (void)IDXP; (void)IDXS; (void)SCS; (void)wl;
#define LDS_LOCAL LAS unsigned char* lds = lds0; asm volatile("" : "+s"(lds));
#define INP(T, name, i) const GAS T* name; { const void* p_; asm volatile("s_load_dwordx2 %0, %1, %2\n\ts_waitcnt lgkmcnt(0)" : "=s"(p_) : "s"(__builtin_amdgcn_kernarg_segment_ptr()), "i"((i) * 8)); name = (const GAS T*)p_; }

    if (IN(0) && args.l_lo == 0) {
        const int l = 0; PHASE_REGS
        LDS_LOCAL
        INP(float, w_in, 10) INP(float, w_ssm, 17) INP(float, w_att, 18) INP(float, w_out, 19) INP(float, w_up, 21) INP(float, w_down, 22) INP(float, meta, 8) INP(float, x_prompt, 0) INP(float, x_sample, 1) INP(float, norm1_w, 9)
        LAS float* scr = (LAS float*)(lds + wave * 17408);
        constexpr int I_IN = (D / 64) * (NIN / 64), I_SSM = (DIN / 64) * (D / 64), I_ATT = (D / 64) * (D / 64), I_OUT = I_ATT, I_UP = (D / 64) * (DFF / 64), I_DN = (DFF / 64) * (D / 64);
        constexpr int I_L = I_IN + I_SSM + I_ATT + I_OUT + I_UP + I_DN;
        for (int it = gw; it < 2 * I_L; it += NGW) {
            const int l = it / I_L; int r = it % I_L; GAS unsigned char* wl = ws + WS_W + (size_t)l * WL_SIZE;
            if (r < I_IN) { tr_item(w_in + (size_t)l * D * IN_DIM, D, IN_DIM, (GAS bf16*)(wl + WL_WIN), NIN / 64, true, scr, r, lane); continue; } r -= I_IN;
            if (r < I_SSM) { tr_item(w_ssm + (size_t)l * DIN * D, DIN, D, (GAS bf16*)(wl + WL_WSSM), D / 64, false, scr, r, lane); continue; } r -= I_SSM;
            if (r < I_ATT) { tr_item(w_att + (size_t)l * D * D, D, D, (GAS bf16*)(wl + WL_WATT), D / 64, false, scr, r, lane); continue; } r -= I_ATT;
            if (r < I_OUT) { tr_item(w_out + (size_t)l * D * D, D, D, (GAS bf16*)(wl + WL_WOUT), D / 64, false, scr, r, lane); continue; } r -= I_OUT;
            if (r < I_UP) { tr_item(w_up + (size_t)l * D * DFF, D, DFF, (GAS bf16*)(wl + WL_WUP), DFF / 64, false, scr, r, lane); continue; } r -= I_UP;
            tr_item(w_down + (size_t)l * DFF * D, DFF, D, (GAS bf16*)(wl + WL_WDN), D / 64, false, scr, r, lane);
        }
        for (int m0 = gw; m0 < MPAD; m0 += 4 * NGW) {
            const GAS float* src[4]; GAS float* hd[4]; GAS bf16* ud[4]; GAS float* fd[4]; bool live[4];
#pragma unroll
            for (int r = 0; r < 4; ++r) { const int m = m0 + r * NGW; live[r] = m < MPAD; src[r] = nullptr; fd[r] = nullptr; hd[r] = H + (size_t)m * D; ud[r] = U + (size_t)m * D;
                if (m < MP) { const int b = m / LP, t = m - b * LP; src[r] = t < NMETA ? meta + (size_t)t * D : x_prompt + ((size_t)b * SEQ + (t - NMETA)) * D; }
                else if (m < MR) src[r] = x_sample + (size_t)(m - MP) * D; }
            rms_rows4g(src, norm1_w, hd, ud, fd, live, lane);
        }
    }
    SEAM(0);

    for (int l = args.l_lo; l < args.l_hi; ++l) {
        constexpr int pb = 1;

        if (IN(pb + 0)) {
            PHASE_REGS
            LAS unsigned char* lds = lds0;
            pg8::Gemm gm{U, (const GAS bf16*)(wl + WL_WIN), MPAD, NIN, D}; pg8::StaticOrder S; S.init(MPAD, NIN, Gl, bxl);
            pg8::EpiIn E{P1, KVB, MISCB, KIB, KIB2, out + O_PK + (size_t)l * MP * 256, out + O_PV + (size_t)l * MP * 256, out + O_PKI + (size_t)l * MP * 64,
                         out + O_SK + (size_t)l * MS * 256, out + O_SV + (size_t)l * MS * 256, out + O_SKI + (size_t)l * MS * 64};
            pg8::gemm_phase<pg8::EpiIn, pg8::StaticOrder, true, true>(lds, gm, S, E, tid);
        }
        SEAM(pb + 0);

        if (IN(pb + 1)) {
            PHASE_REGS
            LDS_LOCAL
            INP(float, state_conv, 6) INP(float, conv_b, 12) INP(float, conv_w, 11) INP(float, dt_bias, 13) INP(float, a_log, 14) INP(float, cache_ki, 4) INP(int, page_table, 7)
            for (int rp_ = 0; rp_ < REP_CONV; ++rp_) for (int it = bx * NT + tid; it < (MR / 8) * 384; it += G * NT) {
                const int rg = it / 384, c8 = (it % 384) * 8, m0 = 8 * rg;
                const bool isS = m0 >= MP; int tpos, sq;
                if (!isS) { sq = m0 / LP; tpos = m0 - sq * LP; } else { sq = (m0 - MP) >> 3; tpos = (m0 - MP) & 7; }
                float xv[11][8];
#pragma unroll
                for (int k = 0; k < 11; ++k) { const int dtp = tpos - 3 + k;
                    if (dtp >= 0) unpack8(*(const GAS v4u*)(P1 + (size_t)(m0 - 3 + k) * LDP1 + C_XBC + c8), xv[k]);
                    else if (isS) { const GAS float* pp = state_conv + ((size_t)(l * DB + sq) * 3 + (3 + dtp)) * CONVD + c8; const f32x4 a = *(const GAS f32x4*)pp, b = *(const GAS f32x4*)(pp + 4);
                        xv[k][0] = a.x; xv[k][1] = a.y; xv[k][2] = a.z; xv[k][3] = a.w; xv[k][4] = b.x; xv[k][5] = b.y; xv[k][6] = b.z; xv[k][7] = b.w; }
                    else {
#pragma unroll
                        for (int j = 0; j < 8; ++j) xv[k][j] = 0.f; } }
                float wv[4][8], bv[8];
                { const GAS float* bp = conv_b + (size_t)l * CONVD + c8; const f32x4 a = *(const GAS f32x4*)bp, b = *(const GAS f32x4*)(bp + 4);
                  bv[0] = a.x; bv[1] = a.y; bv[2] = a.z; bv[3] = a.w; bv[4] = b.x; bv[5] = b.y; bv[6] = b.z; bv[7] = b.w; }
#pragma unroll
                for (int k = 0; k < 4; ++k) { const GAS float* wp = conv_w + ((size_t)l * 4 + k) * CONVD + c8; const f32x4 a = *(const GAS f32x4*)wp, b = *(const GAS f32x4*)(wp + 4);
                    wv[k][0] = a.x; wv[k][1] = a.y; wv[k][2] = a.z; wv[k][3] = a.w; wv[k][4] = b.x; wv[k][5] = b.y; wv[k][6] = b.z; wv[k][7] = b.w; }
#pragma unroll
                for (int r = 0; r < 8; ++r) {
                    float y[8];
#pragma unroll
                    for (int j = 0; j < 8; ++j) { float s = bv[j];
#pragma unroll
                        for (int k = 0; k < 4; ++k) s += xv[r + k][j] * wv[k][j];
                        y[j] = s * sigm(s); }
                    *(GAS v4u*)(XC + (size_t)(m0 + r) * CONVD + c8) = (v4u){pk2(y[0], y[1]), pk2(y[2], y[3]), pk2(y[4], y[5]), pk2(y[6], y[7])};
                    const int tp = tpos + r; GAS float* cs = nullptr;
                    if (!isS && tp >= LP - 3) cs = out + O_PCONV + ((size_t)(l * NB + sq) * 3 + (tp - (LP - 3))) * CONVD + c8;
                    if (isS && tp >= DS - 3) cs = out + O_SCONV + ((size_t)(l * DB + sq) * 3 + (tp - (DS - 3))) * CONVD + c8;
                    if (cs) { *(GAS f32x4*)cs = (f32x4){xv[r + 3][0], xv[r + 3][1], xv[r + 3][2], xv[r + 3][3]}; *(GAS f32x4*)(cs + 4) = (f32x4){xv[r + 3][4], xv[r + 3][5], xv[r + 3][6], xv[r + 3][7]}; }
                }
            }
            for (int it = bx * NT + tid; it < MR * NH; it += G * NT) {
                const int m = it >> 5, h = it & 31;
                const float raw = MISCB[(size_t)m * 128 + MC_DT + h] + dt_bias[l * NH + h];
                const float sp = fmaxf(raw, 0.f) + log1pf(__expf(-fabsf(raw)));
                const float A = -__expf(a_log[l * NH + h]);
                DT[it] = sp; DA[it] = __expf(sp * A);
            }
            for (int rp_ = 0; rp_ < REP_TOPK; ++rp_) {
                constexpr int SLD = 4352;
                LAS unsigned* scl = (LAS unsigned*)lds; LAS unsigned* histq = (LAS unsigned*)(lds + 8 * SLD * 4);
                for (int j = 0; ; ++j) {
                    const int unit = j * G + ((j & 1) ? (G - 1 - bx) : bx); if (unit >= NB * (LP / 8)) break;
                    const int b = unit & (NB - 1), qb = (LP / 8 - 1) - (unit >> 2);
                    const size_t mq0 = (size_t)b * LP + 8 * qb; const int nkeys = 8 * qb + 8, ntl = (nkeys + 31) >> 5;
                    bf16x8 afr[2][4]; float wq[2][2][8];
                    idx_load_q(P1, MISCB, mq0, lane, afr, wq);
                    const int kcol = lane & 31, hh = lane >> 5;
                    for (int rs_ = 0; rs_ < REP_SCORE; ++rs_) {
                    if (rs_) __syncthreads();
                    for (int i = tid; i < 8 * HB; i += NT) histq[i] = 0u;
                    __syncthreads();
                    const GAS bf16* kp0 = KIB2 + (size_t)b * KT_PER_B * 2048 + lane * 8;
                    bf16x8 ks0[4], ks1[4], ks2[4];
#pragma unroll
                    for (int ks = 0; ks < 4; ++ks) { ks0[ks] = (bf16x8){0, 0, 0, 0, 0, 0, 0, 0}; ks1[ks] = ks0[ks]; ks2[ks] = ks0[ks]; }
#define SC_LOAD(S, T) { _Pragma("unroll") for (int ks = 0; ks < 4; ++ks) S[ks] = *(const GAS bf16x8*)(kp0 + (size_t)(T) * 2048 + 512 * ks); }
#define SC_TILE(S, KT, LOADC, ADM) { \
                        f32x16 a0 = {}, a1 = {}; \
                        _Pragma("unroll") for (int ks = 0; ks < 4; ++ks) { a0 = __builtin_amdgcn_mfma_f32_32x32x16_bf16(afr[0][ks], S[ks], a0, 0, 0, 0); a1 = __builtin_amdgcn_mfma_f32_32x32x16_bf16(afr[1][ks], S[ks], a1, 0, 0, 0); } \
                        asm volatile("" : "+v"(a0), "+v"(a1) :: "memory");        \
                        if (LOADC) SC_LOAD(S, (KT) + 3 * NWAVES) \
                        const int key = 32 * (KT) + kcol; \
                        _Pragma("unroll") for (int rt = 0; rt < 2; ++rt) \
                        _Pragma("unroll") for (int jq = 0; jq < 2; ++jq) { const int q = 4 * rt + 2 * hh + jq; const float sv = idx_reduce(rt ? a1 : a0, 8 * jq, wq[rt][jq]); \
                            scl[q * SLD + key] = f2key(sv); \
                            int bn; asm("v_cvt_flr_i32_f32 %0, %1" : "=v"(bn) : "v"(sv)); bn = min(max(bn, -256), HB - 257); \
                            if (SC_ATOM) __hip_atomic_fetch_add(histq + q * HB + 256 + bn, (ADM) || key <= 8 * qb + q ? 1u : 0u, __ATOMIC_RELAXED, __HIP_MEMORY_SCOPE_WORKGROUP); } }
                    const bool SC_ATOM = REP_SCORE_AT || rs_ == REP_SCORE - 1;
                    int kt = wave;
                    if (kt + 5 * NWAVES < ntl) {
                        SC_LOAD(ks0, wave) SC_LOAD(ks1, wave + NWAVES) SC_LOAD(ks2, wave + 2 * NWAVES)
                        do { SC_TILE(ks0, kt, true, true) SC_TILE(ks1, kt + NWAVES, true, true) SC_TILE(ks2, kt + 2 * NWAVES, true, true) kt += 3 * NWAVES; } while (kt + 5 * NWAVES < ntl);
                    } else {
                        if (wave < ntl) SC_LOAD(ks0, wave)
                        if (wave + NWAVES < ntl) SC_LOAD(ks1, wave + NWAVES)
                        if (wave + 2 * NWAVES < ntl) SC_LOAD(ks2, wave + 2 * NWAVES)
                    }
                    for (; kt < ntl; kt += 3 * NWAVES) {
                        SC_TILE(ks0, kt, kt + 3 * NWAVES < ntl, false)
                        if (kt + NWAVES < ntl) SC_TILE(ks1, kt + NWAVES, kt + 4 * NWAVES < ntl, false)
                        if (kt + 2 * NWAVES < ntl) SC_TILE(ks2, kt + 2 * NWAVES, kt + 5 * NWAVES < ntl, false)
                    }
#undef SC_TILE
#undef SC_LOAD
                    }
                    __syncthreads();
                    for (int r2_ = 0; r2_ < REP_SEL; ++r2_) { const int t = 8 * qb + wave, n = t + 1; GAS unsigned short* op = IDXP + ((size_t)b * LP + t) * 256;
                      if (n <= 256) { for (int i = lane; i < n; i += 64) op[i] = (unsigned short)i; }
                      else topk_select(scl + wave * SLD, n, lane, op, histq + wave * HB); }
                    __syncthreads();
                }
            }
            const GAS float* cki = cache_ki + (size_t)l * NPOOL * PAGE * 64;
            for (int rp_ = 0; rp_ < REP_SSC; ++rp_) for (int unit = bx; unit < DB * 8; unit += G) {
                const int bd = unit >> 3, ch = unit & 7; const size_t mq0 = (size_t)MP + bd * DS;
                bf16x8 afr[2][4]; float wq[2][2][8];
                idx_load_q(P1, MISCB, mq0, lane, afr, wq);
                const int kcol = lane & 31, hh = lane >> 5;
                const int pg = 8 * ch + wave, phys = page_table[bd * NPAGES + pg];
                const GAS float* kbase = cki + (size_t)phys * PAGE * 64;
#pragma unroll 1
                for (int kt = 0; kt < 4; ++kt) {
                    const int kin = 32 * kt + kcol; const GAS float* kp = kbase + (size_t)kin * 64 + 8 * hh;
                    bf16x8 bfr[4];
#pragma unroll
                    for (int ks = 0; ks < 4; ++ks) { const f32x4 a = *(const GAS f32x4*)(kp + 16 * ks), bq = *(const GAS f32x4*)(kp + 16 * ks + 4);
                        const v4u w = (v4u){pk2(a.x, a.y), pk2(a.z, a.w), pk2(bq.x, bq.y), pk2(bq.z, bq.w)}; bfr[ks] = __builtin_bit_cast(bf16x8, w); }
                    float sc[2][2];
                    idx_scores(afr, bfr, wq, sc);
#pragma unroll
                    for (int rt = 0; rt < 2; ++rt)
#pragma unroll
                        for (int jq = 0; jq < 2; ++jq) SCS[(size_t)(bd * DS + 4 * rt + 2 * hh + jq) * SCS_LD + 128 * pg + kin] = sc[rt][jq];
                }
                if (ch == 7 && wave == 0) {
                    const int j = kcol < DS ? kcol : DS - 1; const GAS bf16* kp = KIB + (mq0 + j) * 64 + 8 * hh;
                    bf16x8 bfr[4];
#pragma unroll
                    for (int ks = 0; ks < 4; ++ks) bfr[ks] = *(const GAS bf16x8*)(kp + 16 * ks);
                    float sc[2][2];
                    idx_scores(afr, bfr, wq, sc);
                    if (kcol < DS) {
#pragma unroll
                        for (int rt = 0; rt < 2; ++rt)
#pragma unroll
                            for (int jq = 0; jq < 2; ++jq) { const int q = 4 * rt + 2 * hh + jq; SCS[(size_t)(bd * DS + q) * SCS_LD + PAST + kcol] = (kcol <= q) ? sc[rt][jq] : -INFINITY; }
                    }
                }
            }
        }
        SEAM(pb + 1);

        if (IN(pb + 2)) {
            PHASE_REGS
            LDS_LOCAL
            INP(float, a_log, 14) INP(float, state_ssm, 5) INP(float, d_skip, 15)
            for (int rp_ = 0; rp_ < REP_SSEL; ++rp_) for (int qi = bx; qi < MS; qi += G) {
                LAS unsigned* scl = (LAS unsigned*)lds; LAS unsigned* hs = (LAS unsigned*)(lds + 8448 * 4);
                hs[tid] = 0u;
                __syncthreads();
                for (int i = tid; i < PAST + DS; i += NT) { const float sc = SCS[(size_t)qi * SCS_LD + i]; scl[i] = f2key(sc);
                    int bn = __float2int_rd(fmaxf(sc, -512.0f)) + 256; bn = bn < 0 ? 0 : (bn > HB - 1 ? HB - 1 : bn);
                    __hip_atomic_fetch_add(hs + bn, 1u, __ATOMIC_RELAXED, __HIP_MEMORY_SCOPE_WORKGROUP); }
                __syncthreads();
                if (wave == 0) { int ns = PAST + DS; asm volatile("" : "+s"(ns)); topk_select(scl, ns, lane, IDXS + qi * 256, hs); }
                __syncthreads();
            }
            for (int rp_ = 0; rp_ < REP_SSD1; ++rp_) for (int unit = bx; unit < NB * NCH * NG; unit += G) {
                int b, c, g; if (unit < NB * 32 * NG) { b = unit >> 7; c = 1 + ((unit & 127) >> 2); g = unit & 3; } else { const int r = unit - NB * 32 * NG; b = r >> 2; c = 0; g = r & 3; }
                ssd1_unit(lds, tid, XC, DT, a_log + l * NH, SB, DEC, b, c, g);
            }
            for (int rp_ = 0; rp_ < REP_SREC; ++rp_) for (int unit = bx; unit < DB * NH * 2; unit += G) {
                const int bd = unit >> 6, h = (unit >> 1) & 31, p0 = (unit & 1) * 32;
                ssd_unit(lds, tid, XC, DT, DA, (size_t)MP + bd * DS, DS, h, p0, state_ssm + ((size_t)(l * DB + bd) * NH + h) * HP * NST,
                         out + O_SSSM + ((size_t)(l * DB + bd) * NH + h) * HP * NST, YS, d_skip[l * NH + h]);
                __syncthreads();
            }
        }
        SEAM(pb + 2);

        if (IN(pb + 3)) {
            PHASE_REGS
            LDS_LOCAL
            INP(float, cache_k, 2) INP(float, cache_v, 3) INP(int, page_table, 7)
            for (int rp_ = 0; rp_ < REP_SCAN; ++rp_) for (int e = bx * NT + tid; e < NB * NH * 2048; e += G * NT) {
                const int b = e / (NH * 2048), h = (e >> 11) & 31, q = e & 2047;
                f32x4 Hr = {0.f, 0.f, 0.f, 0.f};
#pragma unroll 3
                for (int c = 0; c < NCH; ++c) { const size_t idx = (size_t)(b * NCH + c) * NH + h;
                    { const int p = q >> 5, n = (q & 31) * 4;
                      *(GAS v2u*)(HC + idx * (HP * NST) + ((((p >> 5) * 8 + (n >> 4)) * 2 + ((n >> 3) & 1)) * 32 + (p & 31)) * 8 + (n & 7)) = (v2u){pk2(Hr.x, Hr.y), pk2(Hr.z, Hr.w)}; }
                    const float d = DEC[idx]; const v2u sw = *(const GAS v2u*)(SB + idx * (HP * NST) + q * 4);
                    const f32x4 sv = (f32x4){__uint_as_float(sw.x << 16), __uint_as_float(sw.x & 0xffff0000u), __uint_as_float(sw.y << 16), __uint_as_float(sw.y & 0xffff0000u)};
                    Hr = Hr * d + sv; }
                *(GAS f32x4*)(out + O_PSSM + ((size_t)(l * NB + b) * NH + h) * (HP * NST) + q * 4) = Hr;
            }
            const GAS float* ck = cache_k + (size_t)l * NPOOL * PAGE * 256; const GAS float* cv = cache_v + (size_t)l * NPOOL * PAGE * 256;
            for (int rp_ = 0; rp_ < REP_ATTS; ++rp_) for (int qi = bx; qi < MS; qi += G) attn_sample_query(lds, tid, P1, KVB, ck, cv, page_table, IDXS, YA, qi);
            for (int rp_ = 0; rp_ < REP_ATTP; ++rp_) {
                if (Gl == 256) {
                    const int bsel = (bxl & 7) >> 1, widx = ((((bxl >> 3) * NWAVES) + wave) << 1) | (bxl & 1);
                    for (int tr = widx; tr < LP; tr += 512) attn_prompt_query(lds + wave * 17408, P1, KVB, IDXP, YA, bsel * LP + (LP - 1 - tr), lane);
                } else for (int m = gw; m < MP; m += NGW) attn_prompt_query(lds + wave * 17408, P1, KVB, IDXP, YA, m, lane);
            }
        }
        SEAM(pb + 3);

        if (IN(pb + 4)) {
            PHASE_REGS
            LDS_LOCAL
            INP(float, a_log, 14) INP(float, d_skip, 15) INP(float, ssm_norm_w, 16)
            for (int rp_ = 0; rp_ < REP_SSD3; ++rp_) for (int unit = bx; unit < NB * NCH * NG; unit += G) {
                int b, c, g; if (unit < NB * 32 * NG) { b = unit >> 7; c = 1 + ((unit & 127) >> 2); g = unit & 3; } else { const int r = unit - NB * 32 * NG; b = r >> 2; c = 0; g = r & 3; }
                ssd3_unit(lds, tid, XC, P1, DT, a_log + l * NH, d_skip + l * NH, ssm_norm_w + (size_t)l * DIN, HC, YSN, b, c, g);
            }
            for (int it = gw; it < MS * NG; it += NGW) {
                const int m = MP + (it >> 2), g = it & 3, c0 = g * 512 + lane * 8;
                const GAS float* yp = YS + (size_t)m * DIN + c0; const f32x4 a = *(const GAS f32x4*)yp, b = *(const GAS f32x4*)(yp + 4);
                float z[8]; unpack8(*(const GAS v4u*)(P1 + (size_t)m * LDP1 + C_Z + c0), z);
                float v[8] = {a.x, a.y, a.z, a.w, b.x, b.y, b.z, b.w}; float ss = 0.f;
#pragma unroll
                for (int j = 0; j < 8; ++j) { v[j] = v[j] * (z[j] * sigm(z[j])); ss += v[j] * v[j]; }
                ss = wave_sum(ss);
                const float rstd = 1.0f / sqrtf(ss * (1.0f / 512.0f) + 1e-6f);
                const GAS float* wp = ssm_norm_w + (size_t)l * DIN + c0; const f32x4 wa = *(const GAS f32x4*)wp, wb = *(const GAS f32x4*)(wp + 4);
                *(GAS v4u*)(YSN + (size_t)m * DIN + c0) = (v4u){pk2(v[0] * rstd * wa.x, v[1] * rstd * wa.y), pk2(v[2] * rstd * wa.z, v[3] * rstd * wa.w), pk2(v[4] * rstd * wb.x, v[5] * rstd * wb.y), pk2(v[6] * rstd * wb.z, v[7] * rstd * wb.w)};
            }
        }
        SEAM(pb + 4);

        if (IN(pb + 5)) {
            PHASE_REGS
            LAS unsigned char* lds = lds0;
            pg8::Gemm gm{YSN, (const GAS bf16*)(wl + WL_WSSM), TAIL_R0, D, DIN}; pg8::StaticOrder S; S.init(TAIL_R0, D, Gl, bxl);
            pg8::EpiGate1 E{P1, T1};
            pg8::gemm_phase<pg8::EpiGate1, pg8::StaticOrder, true, true>(lds, gm, S, E, tid);
            tail_gemm<1>(lds, YSN, DIN, (const GAS bf16*)(wl + WL_WSSM), D, P1, T1, MG, H, A2, bxl, Gl, tid);
        }
        if (IN(pb + 6)) {
            PHASE_REGS
            LAS unsigned char* lds = lds0;
            pg8::Gemm gm{YA, (const GAS bf16*)(wl + WL_WATT), TAIL_R0, D, D}; pg8::StaticOrder S; S.init(TAIL_R0, D, Gl, bxl);
            pg8::EpiGate2 E{P1, T1, MG};
            pg8::gemm_phase<pg8::EpiGate2, pg8::StaticOrder, true, true>(lds, gm, S, E, tid);
            tail_gemm<2>(lds, YA, D, (const GAS bf16*)(wl + WL_WATT), D, P1, T1, MG, H, A2, bxl, Gl, tid);
        }
        SEAM(pb + 6);
        if (IN(pb + 7)) {
            PHASE_REGS
            LAS unsigned char* lds = lds0;
            pg8::Gemm gm{MG, (const GAS bf16*)(wl + WL_WOUT), TAIL_R0, D, D}; pg8::StaticOrder S; S.init(TAIL_R0, D, Gl, bxl);
            pg8::EpiResid E{H};
            pg8::gemm_phase<pg8::EpiResid, pg8::StaticOrder, true, true>(lds, gm, S, E, tid);
            tail_gemm<3>(lds, MG, D, (const GAS bf16*)(wl + WL_WOUT), D, P1, T1, MG, H, A2, bxl, Gl, tid);
        }
        SEAM(pb + 7);
        if (IN(pb + 8)) {
            PHASE_REGS
            INP(float, norm2_w, 20)
            for (int m = gw; m < MPAD; m += 4 * NGW) rms_rows4(H, norm2_w + (size_t)l * D, U, m, NGW, MPAD, lane);
        }
        SEAM(pb + 8);
        if (IN(pb + 9)) {
            PHASE_REGS
            LAS unsigned char* lds = lds0;
            pg8::Gemm gm{U, (const GAS bf16*)(wl + WL_WUP), TAIL_R0, DFF, D}; pg8::StaticOrder S; S.init(TAIL_R0, DFF, Gl, bxl);
            pg8::EpiUp E{A2};
            pg8::gemm_phase<pg8::EpiUp, pg8::StaticOrder, true, true>(lds, gm, S, E, tid);
            tail_gemm<4>(lds, U, D, (const GAS bf16*)(wl + WL_WUP), DFF, P1, T1, MG, H, A2, bxl, Gl, tid);
        }
        SEAM(pb + 9);
        if (IN(pb + 10)) {
            PHASE_REGS
            LAS unsigned char* lds = lds0;
            pg8::Gemm gm{A2, (const GAS bf16*)(wl + WL_WDN), TAIL_R0, D, DFF}; pg8::StaticOrder S; S.init(TAIL_R0, D, Gl, bxl);
            pg8::EpiResid E{H};
            pg8::gemm_phase<pg8::EpiResid, pg8::StaticOrder, true, true>(lds, gm, S, E, tid);
            tail_gemm<3>(lds, A2, DFF, (const GAS bf16*)(wl + WL_WDN), D, P1, T1, MG, H, A2, bxl, Gl, tid);
        }
        SEAM(pb + 10);
        if (IN(pb + 11)) {
            PHASE_REGS
            INP(float, norm1_w, 9) INP(float, final_w, 23)
            if (l == 0) { for (int m = gw; m < MPAD; m += 4 * NGW) rms_rows4(H, norm1_w + D, U, m, NGW, MPAD, lane); }
            else {
                for (int m0 = gw; m0 < MR; m0 += 4 * NGW) {
                    const GAS float* src[4]; GAS float* hd[4]; GAS bf16* ud[4]; GAS float* fd[4]; bool live[4];
#pragma unroll
                    for (int r = 0; r < 4; ++r) { const int m = m0 + r * NGW; hd[r] = nullptr; ud[r] = nullptr; fd[r] = nullptr; src[r] = H + (size_t)(m < MR ? m : m0) * D;
                        if (m < MP) { const int b = m / LP, t = m - b * LP; if (t >= NMETA) fd[r] = out + O_YP + ((size_t)b * SEQ + (t - NMETA)) * D; }
                        else if (m < MR) fd[r] = out + O_YS + (size_t)(m - MP) * D;
                        live[r] = fd[r] != nullptr; }
                    rms_rows4g(src, final_w, hd, ud, fd, live, lane);
                }
            }
        }
        if (IN(pb + 11) && IN(1) && l + 1 < args.l_hi) xcd_barrier_ni(bar.bar, bar.x, bar.st, TID_NOW(), (unsigned)G);
    }
#undef IN
#undef SEAM
}

#ifndef MK_PER_PHASE
#define MK_PER_PHASE 0
#endif
extern "C" void kernel_launch(void* const* d_in, const int* in_sizes, int n_in, void* d_out, int out_size, void* d_ws, size_t ws_size, hipStream_t stream) {
    static int grid = 0;
    if (grid == 0) {
        if (n_in != 24 || (size_t)out_size != O_END || ws_size < WS_END) { fprintf(stderr, "kernel_launch: unexpected shapes: n_in %d out %d (want %zu) ws %zu (want %zu)\n", n_in, out_size, (size_t)O_END, ws_size, (size_t)WS_END); grid = -1; return; }
        int dev = 0, cus = 0, per_cu = 0;
        if (hipGetDevice(&dev) != hipSuccess || hipDeviceGetAttribute(&cus, hipDeviceAttributeMultiprocessorCount, dev) != hipSuccess) { grid = -1; return; }
        bool ok = true;
#if MK_PER_PHASE
#define SETA(K) ok = ok && hipFuncSetAttribute((const void*)fwd_t<K, K + 1>, hipFuncAttributeMaxDynamicSharedMemorySize, LDS_BYTES) == hipSuccess
        SETA(0); SETA(1); SETA(2); SETA(3); SETA(4); SETA(5); SETA(6); SETA(7); SETA(8); SETA(9); SETA(10); SETA(11); SETA(12);
#else
        ok = hipFuncSetAttribute((const void*)fwd_t<0, NPH + 1>, hipFuncAttributeMaxDynamicSharedMemorySize, LDS_BYTES) == hipSuccess;
        ok = ok && hipOccupancyMaxActiveBlocksPerMultiprocessor(&per_cu, (const void*)fwd_t<0, NPH + 1>, NT, LDS_BYTES) == hipSuccess && per_cu >= 1;
#endif
        if (!ok) { fprintf(stderr, "kernel_launch: hipFuncSetAttribute / occupancy query failed (per_cu %d)\n", per_cu); (void)hipGetLastError(); grid = -1; return; }
        grid = cus;
    }
    if (grid < 0) return;
    (void)hipMemsetAsync((char*)d_ws + WS_CTL, 0, CTL_ZERO_BYTES, stream);
    Args a{};
    for (int i = 0; i < 24; ++i) a.in[i] = d_in[i];
    a.out = (float*)d_out; a.ws = (unsigned char*)d_ws;
#if MK_PER_PHASE
#define LAUNCH_PH(K) hipLaunchKernelGGL((fwd_t<K, K + 1>), dim3(grid), dim3(NT), LDS_BYTES, stream, a)
    a.l_lo = 0; a.l_hi = 1; LAUNCH_PH(0);
    for (int l = 0; l < 2; ++l) { a.l_lo = l; a.l_hi = l + 1;
        LAUNCH_PH(1); LAUNCH_PH(2); LAUNCH_PH(3); LAUNCH_PH(4); LAUNCH_PH(5); LAUNCH_PH(6); LAUNCH_PH(7); LAUNCH_PH(8); LAUNCH_PH(9); LAUNCH_PH(10); LAUNCH_PH(11); LAUNCH_PH(12); }
#else
    a.l_lo = 0; a.l_hi = 2; hipLaunchKernelGGL((fwd_t<0, NPH + 1>), dim3(grid), dim3(NT), LDS_BYTES, stream, a);
#endif
}
```

```cpp
#include <hip/hip_runtime.h>
#include <cstdio>
#include <cstdint>
#define GAS __attribute__((address_space(1)))
#define LAS __attribute__((address_space(3)))

constexpr int D = 1024, NB = 4, SEQ = 4096, NMETA = 16, LP = SEQ + NMETA, MP = NB * LP, DB = 32, DS = 8, MS = DB * DS, MR = MP + MS, MPAD = 16896;
constexpr int DIN = 2048, CONVD = 3072, NH = 32, HP = 64, NG = 4, NST = 128;
constexpr int DFF = 4096, IN_DIM = 9320;
constexpr int PAST = 8192, PAGE = 128, NPAGES = 64, NPOOL = 2560;
constexpr int NIN = 9472, LDP1 = 9216;
constexpr int C_Z = 0, C_XBC = 2048, C_Q = 5120, C_K = 6144, C_V = 6400, C_QI = 6656, C_GS = 7168, C_GA = 8192;
constexpr int MC_KI = 0, MC_DT = 64, MC_WI = 96;
constexpr int KT_PER_B = (LP + 31) / 32;
static_assert(MP == 16448 && MR == 16704 && MPAD % 256 == 0 && MPAD >= MR, "rows");
namespace pg8 {
#define PG8_LAS __attribute__((address_space(3)))
typedef unsigned short bf16_t;
typedef short bf16x8 __attribute__((ext_vector_type(8)));
typedef float f32x4 __attribute__((ext_vector_type(4)));
typedef unsigned u32x4 __attribute__((ext_vector_type(4)));
constexpr int BM = 256, BK = 64, HALF = 128, HTB = HALF * BK * 2  , STAGE_BYTES = 8 * HTB, NXCD = 8, WGM = 8;

__host__ __device__ __forceinline__ int lds_byte(int r, int c) { const int st = (r >> 4) * 2 + (c >> 5), rr = r & 15, cc = c & 31, ob = rr * 64 + cc * 2; return st * 1024 + (ob ^ (((ob >> 9) & 1) << 5)); }
__host__ __device__ __forceinline__ void stage_rc(int b, int& R, int& C) { const int st = b / 1024, sb = b % 1024, swz = sb ^ (((sb >> 9) & 1) << 5); R = (st >> 1) * 16 + swz / 64; C = (st & 1) * 32 + (swz % 64) / 2; }
__host__ __device__ __forceinline__ int perm32(int rho) { const int n = rho >> 4, i = rho & 15; return 8 * (i >> 2) + 4 * n + (i & 3); }

struct Unit { int pm, pn; };
struct Gemm { const GAS bf16_t* A; const GAS bf16_t* Bt; int M, N, K; };

struct StaticOrder {
    int nM, nN, nwg, G, c;
    __host__ __device__ void init(int M, int N, int G_, int c_) { nM = M / BM; nN = N / BM; nwg = nM * nN; G = G_; c = c_; }
    __host__ __device__ bool next(int i, Unit& u) const {
        const long L = (long)i * G + c; if (L >= nwg) return false;
        int wgid = (int)L; { const int q = nwg / NXCD, r = nwg % NXCD, xcd = wgid % NXCD, off = wgid / NXCD; wgid = (xcd < r ? xcd * (q + 1) : r * (q + 1) + (xcd - r) * q) + off; }
        const int nig = WGM * nN, gid = wgid / nig, fm = gid * WGM, gsz = (nM - fm) < WGM ? (nM - fm) : WGM;
        u.pm = fm + ((wgid % nig) % gsz); u.pn = (wgid % nig) / gsz; return true;
    }
    __device__ __forceinline__ void a_ready(const Unit&) const {}
    __device__ __forceinline__ void done(const Unit&) const {}
};

__device__ __forceinline__ unsigned cvt_pk_bf16(float lo, float hi) { unsigned r; asm volatile("v_cvt_pk_bf16_f32 %0, %1, %2" : "=v"(r) : "v"(lo), "v"(hi)); return r; }

__device__ __forceinline__ void unpack8(const u32x4 w, float (&f)[8]) {
    f[0] = __uint_as_float(w.x << 16); f[1] = __uint_as_float(w.x & 0xffff0000u); f[2] = __uint_as_float(w.y << 16); f[3] = __uint_as_float(w.y & 0xffff0000u);
    f[4] = __uint_as_float(w.z << 16); f[5] = __uint_as_float(w.z & 0xffff0000u); f[6] = __uint_as_float(w.w << 16); f[7] = __uint_as_float(w.w & 0xffff0000u);
}
__device__ __forceinline__ u32x4 pack8(const f32x4 v0, const f32x4 v1) { u32x4 w; w.x = cvt_pk_bf16(v0[0], v0[1]); w.y = cvt_pk_bf16(v0[2], v0[3]); w.z = cvt_pk_bf16(v1[0], v1[1]); w.w = cvt_pk_bf16(v1[2], v1[3]); return w; }
__device__ __forceinline__ float sigm(float x) { return __builtin_amdgcn_rcpf(1.0f + __expf(-x)); }

struct EpiIn {
    static constexpr bool PERM = true, AFTER_DRAIN = false;
    GAS bf16_t* P1; GAS bf16_t* kvb; GAS float* misc; GAS bf16_t* kib; GAS bf16_t* kib2; GAS float *pk, *pv, *pki, *sk, *sv, *ski;
    __device__ __forceinline__ void operator()(const f32x4 (&acc)[2][2][4][2], const Unit& u, int wr, int wc, int fr, int fq) const {
        const int row0 = u.pm * BM + wr * 64 + fr, lc0 = wc * 32 + 8 * fq;
#pragma unroll
        for (int ai = 0; ai < 2; ++ai)
#pragma unroll
            for (int m = 0; m < 4; ++m) {
                const int row = row0 + ai * HALF + m * 16;
#pragma unroll
                for (int bj = 0; bj < 2; ++bj) {
                    const f32x4 v0 = acc[ai][bj][m][0], v1 = acc[ai][bj][m][1];
                    const int lc = lc0 + bj * HALF;
                    if (u.pn < 36) {
                        if (u.pn == 24 || u.pn == 25) *(GAS u32x4*)(kvb + (size_t)row * 512 + (u.pn - 24) * BM + lc) = pack8(v0, v1);
                        else *(GAS u32x4*)(P1 + (size_t)row * LDP1 + u.pn * BM + lc) = pack8(v0, v1);
                        if (u.pn == 24) {
                            if (row < MP) { GAS float* dst = pk + (size_t)row * 256 + lc; *(GAS f32x4*)dst = v0; *(GAS f32x4*)(dst + 4) = v1; }
                            else if (row < MR) { GAS float* dst = sk + (size_t)(row - MP) * 256 + lc; *(GAS f32x4*)dst = v0; *(GAS f32x4*)(dst + 4) = v1; }
                        } else if (u.pn == 25) {
                            if (row < MP) { GAS float* dst = pv + (size_t)row * 256 + lc; *(GAS f32x4*)dst = v0; *(GAS f32x4*)(dst + 4) = v1; }
                            else if (row < MR) { GAS float* dst = sv + (size_t)(row - MP) * 256 + lc; *(GAS f32x4*)dst = v0; *(GAS f32x4*)(dst + 4) = v1; }
                        }
                    } else {
                        if (lc < 128) { GAS float* d = misc + (size_t)row * 128 + lc; *(GAS f32x4*)d = v0; *(GAS f32x4*)(d + 4) = v1; }
                        if (lc < 64) {
                            *(GAS u32x4*)(kib + (size_t)row * 64 + lc) = pack8(v0, v1);
                            if (row < MP) { const int b = row / LP, t = row - b * LP;
                                *(GAS u32x4*)(kib2 + ((size_t)(b * KT_PER_B + (t >> 5)) * 2048 + (lc >> 4) * 512 + ((lc >> 3) & 1) * 256 + (t & 31) * 8)) = pack8(v0, v1); }
                            if (row < MP) { GAS float* dst = pki + (size_t)row * 64 + lc; *(GAS f32x4*)dst = v0; *(GAS f32x4*)(dst + 4) = v1; }
                            else if (row < MR) { GAS float* dst = ski + (size_t)(row - MP) * 64 + lc; *(GAS f32x4*)dst = v0; *(GAS f32x4*)(dst + 4) = v1; }
                        }
                    }
                }
            }
    }
};
struct EpiGate1 {
    static constexpr bool PERM = true, AFTER_DRAIN = false;
    const GAS bf16_t* P1; GAS bf16_t* T1;
    __device__ __forceinline__ void operator()(const f32x4 (&acc)[2][2][4][2], const Unit& u, int wr, int wc, int fr, int fq) const {
        const int row0 = u.pm * BM + wr * 64 + fr, col0 = u.pn * BM + wc * 32 + 8 * fq;
#pragma unroll
        for (int ai = 0; ai < 2; ++ai)
#pragma unroll
            for (int m = 0; m < 4; ++m) {
                const int row = row0 + ai * HALF + m * 16;
#pragma unroll
                for (int bj = 0; bj < 2; ++bj) {
                    const int col = col0 + bj * HALF;
                    float g[8]; unpack8(*(const GAS u32x4*)(P1 + (size_t)row * LDP1 + C_GS + col), g);
                    f32x4 v0 = acc[ai][bj][m][0], v1 = acc[ai][bj][m][1];
#pragma unroll
                    for (int e = 0; e < 4; ++e) { v0[e] *= sigm(g[e]); v1[e] *= sigm(g[4 + e]); }
                    *(GAS u32x4*)(T1 + (size_t)row * 1024 + col) = pack8(v0, v1);
                }
            }
    }
};
struct EpiGate2 {
    static constexpr bool PERM = true, AFTER_DRAIN = false;
    const GAS bf16_t* P1; const GAS bf16_t* T1; GAS bf16_t* MG;
    __device__ __forceinline__ void operator()(const f32x4 (&acc)[2][2][4][2], const Unit& u, int wr, int wc, int fr, int fq) const {
        const int row0 = u.pm * BM + wr * 64 + fr, col0 = u.pn * BM + wc * 32 + 8 * fq;
#pragma unroll
        for (int ai = 0; ai < 2; ++ai)
#pragma unroll
            for (int m = 0; m < 4; ++m) {
                const int row = row0 + ai * HALF + m * 16;
#pragma unroll
                for (int bj = 0; bj < 2; ++bj) {
                    const int col = col0 + bj * HALF;
                    float g[8]; unpack8(*(const GAS u32x4*)(P1 + (size_t)row * LDP1 + C_GA + col), g);
                    float tt[8]; unpack8(*(const GAS u32x4*)(T1 + (size_t)row * 1024 + col), tt); const f32x4 t0 = (f32x4){tt[0], tt[1], tt[2], tt[3]}, t1 = (f32x4){tt[4], tt[5], tt[6], tt[7]};
                    f32x4 v0 = acc[ai][bj][m][0], v1 = acc[ai][bj][m][1];
#pragma unroll
                    for (int e = 0; e < 4; ++e) { v0[e] = t0[e] + v0[e] * sigm(g[e]); v1[e] = t1[e] + v1[e] * sigm(g[4 + e]); }
                    *(GAS u32x4*)(MG + (size_t)row * 1024 + col) = pack8(v0, v1);
                }
            }
    }
};
struct EpiResid {
    static constexpr bool PERM = true, AFTER_DRAIN = false;
    GAS float* H;
    __device__ __forceinline__ void operator()(const f32x4 (&acc)[2][2][4][2], const Unit& u, int wr, int wc, int fr, int fq) const {
        const int row0 = u.pm * BM + wr * 64 + fr, col0 = u.pn * BM + wc * 32 + 8 * fq;
#pragma unroll
        for (int ai = 0; ai < 2; ++ai)
#pragma unroll
            for (int m = 0; m < 4; ++m) {
                const int row = row0 + ai * HALF + m * 16;
#pragma unroll
                for (int bj = 0; bj < 2; ++bj) {
                    GAS float* d = H + (size_t)row * 1024 + col0 + bj * HALF;
                    const f32x4 h0 = *(const GAS f32x4*)d, h1 = *(const GAS f32x4*)(d + 4);
                    *(GAS f32x4*)d = h0 + acc[ai][bj][m][0]; *(GAS f32x4*)(d + 4) = h1 + acc[ai][bj][m][1];
                }
            }
    }
};
struct EpiUp {
    static constexpr bool PERM = true, AFTER_DRAIN = false;
    GAS bf16_t* A2;
    __device__ __forceinline__ void operator()(const f32x4 (&acc)[2][2][4][2], const Unit& u, int wr, int wc, int fr, int fq) const {
        const int row0 = u.pm * BM + wr * 64 + fr, col0 = u.pn * BM + wc * 32 + 8 * fq;
#pragma unroll
        for (int ai = 0; ai < 2; ++ai)
#pragma unroll
            for (int m = 0; m < 4; ++m) {
                const int row = row0 + ai * HALF + m * 16;
#pragma unroll
                for (int bj = 0; bj < 2; ++bj) {
                    f32x4 v0 = acc[ai][bj][m][0], v1 = acc[ai][bj][m][1];
#pragma unroll
                    for (int e = 0; e < 4; ++e) { const float a = fmaxf(v0[e], 0.f), b = fmaxf(v1[e], 0.f); v0[e] = a * a; v1[e] = b * b; }
                    *(GAS u32x4*)(A2 + (size_t)row * DFF + col0 + bj * HALF) = pack8(v0, v1);
                }
            }
    }
};
template <class Epi, class Sched, bool ALIGN_EPI = false, bool SP2 = false>
__device__ __forceinline__ void gemm_phase(PG8_LAS unsigned char* lds, const Gemm g, const Sched& S, const Epi& E, const int tid) {
    const int wid = __builtin_amdgcn_readfirstlane(tid >> 6), lane = tid & 63, wr = wid >> 2, wc = wid & 3, fr = lane & 15, fq = lane >> 4;
    const int K = g.K, nt = K / BK;
    unsigned voffA[2], voffB[2];
#pragma unroll
    for (int i = 0; i < 2; ++i) { int R, C; stage_rc(tid * 16 + i * 8192, R, C); const int Rb = Epi::PERM ? ((R & ~31) + perm32(R & 31)) : R;
        voffA[i] = (unsigned)(R * K + C) * 2u; voffB[i] = (unsigned)(Rb * K + C) * 2u; }
    const size_t kstep = (size_t)(BK * 2);
    const size_t hstep = (size_t)HALF * K * 2;
    const size_t tstep = 2 * hstep;
    const unsigned ldsw = (unsigned)wid * 1024u;
    const int aoff = lds_byte(wr * 64 + fr, fq * 8), boff = lds_byte(wc * 32 + fr, fq * 8);
#define PG8_SA(b, h) (((b) * 2 + (h)) * HTB)
#define PG8_SB(b, h) ((4 + (b) * 2 + (h)) * HTB)
#define PG8_STAGE(bufoff, gbase, voff) do { _Pragma("unroll") for (int _i = 0; _i < 2; ++_i) \
        __builtin_amdgcn_global_load_lds((const GAS unsigned*)((const GAS char*)(gbase) + (voff)[_i]), (PG8_LAS unsigned*)(lds + (bufoff) + ldsw + _i * 8192), 16, 0, 0); } while (0)
#define PG8_LDA(dst, b, h) do { _Pragma("unroll") for (int m = 0; m < 4; ++m) _Pragma("unroll") for (int k = 0; k < 2; ++k) dst[m][k] = *(const PG8_LAS bf16x8*)(lds + PG8_SA(b, h) + aoff + m * 2048 + k * 1024); } while (0)
#define PG8_LDB(dst, b, h) do { _Pragma("unroll") for (int n = 0; n < 2; ++n) _Pragma("unroll") for (int k = 0; k < 2; ++k) dst[n][k] = *(const PG8_LAS bf16x8*)(lds + PG8_SB(b, h) + boff + n * 2048 + k * 1024); } while (0)
#define PG8_MMA(ai, bj, At, Bt) do { __builtin_amdgcn_s_setprio(1); _Pragma("unroll") for (int m = 0; m < 4; ++m) _Pragma("unroll") for (int n = 0; n < 2; ++n) _Pragma("unroll") for (int k = 0; k < 2; ++k) \
        acc[ai][bj][m][n] = __builtin_amdgcn_mfma_f32_16x16x32_bf16(Bt[n][k], At[m][k], acc[ai][bj][m][n], 0, 0, 0); __builtin_amdgcn_s_setprio(0); } while (0)
#define PG8_WAIT_V(n) asm volatile("s_waitcnt vmcnt(" #n ")" ::: "memory")
#define PG8_WAIT_L(n) asm volatile("s_waitcnt lgkmcnt(" #n ")" ::: "memory")
#define PG8_BAR __builtin_amdgcn_s_barrier()
#define PG8_SCHED __builtin_amdgcn_sched_barrier(0)
    Unit cur, nxt; int ui = 0;
    if (!S.next(0, cur)) return;
    f32x4 acc[2][2][4][2];
#pragma unroll
    for (int a = 0; a < 2; ++a)
#pragma unroll
        for (int b = 0; b < 2; ++b)
#pragma unroll
            for (int m = 0; m < 4; ++m)
#pragma unroll
                for (int n = 0; n < 2; ++n) acc[a][b][m][n] = (f32x4){0.f, 0.f, 0.f, 0.f};
    bf16x8 At[4][2], B0[2][2], B1[2][2];
    const GAS char* cA = (const GAS char*)g.A + (size_t)cur.pm * tstep; const GAS char* cB = (const GAS char*)g.Bt + (size_t)cur.pn * tstep;
    S.a_ready(cur);
    if constexpr (SP2) {
        PG8_STAGE(PG8_SB(0, 0), cB, voffB); PG8_STAGE(PG8_SB(0, 1), cB + hstep, voffB); PG8_STAGE(PG8_SA(0, 0), cA, voffA); PG8_STAGE(PG8_SA(0, 1), cA + hstep, voffA);
        if (wr == 1) PG8_BAR;
        PG8_WAIT_V(2); PG8_BAR;
        PG8_STAGE(PG8_SB(1, 0), cB + kstep, voffB); PG8_STAGE(PG8_SA(1, 0), cA + kstep, voffA); PG8_STAGE(PG8_SB(1, 1), cB + hstep + kstep, voffB);
        PG8_WAIT_V(6); PG8_BAR;
    } else {
        PG8_STAGE(PG8_SB(0, 0), cB, voffB); PG8_STAGE(PG8_SA(0, 0), cA, voffA); PG8_STAGE(PG8_SB(0, 1), cB + hstep, voffB); PG8_STAGE(PG8_SA(0, 1), cA + hstep, voffA);
        if (wr == 1) PG8_BAR;
        PG8_WAIT_V(4); PG8_BAR;
        PG8_STAGE(PG8_SB(1, 0), cB + kstep, voffB); PG8_STAGE(PG8_SA(1, 0), cA + kstep, voffA); PG8_STAGE(PG8_SB(1, 1), cB + hstep + kstep, voffB);
        PG8_WAIT_V(6); PG8_BAR;
    }
    for (;;) {
        const bool has_next = S.next(ui + 1, nxt);
        const GAS char* nA = has_next ? (const GAS char*)g.A + (size_t)nxt.pm * tstep : cA; const GAS char* nB = has_next ? (const GAS char*)g.Bt + (size_t)nxt.pn * tstep : cB;
        for (int t = 0; t < nt; t += 2) {
            const bool last = (t == nt - 2);
            const GAS char* a1 = cA + (size_t)(t + 1) * kstep;
            const GAS char* a2 = last ? nA : cA + (size_t)(t + 2) * kstep; const GAS char* b2 = last ? nB : cB + (size_t)(t + 2) * kstep;
            const GAS char* a3 = a2 + kstep; const GAS char* b3 = b2 + kstep;
            if (last && has_next) S.a_ready(nxt);
            if constexpr (SP2) {
            PG8_LDB(B0, 0, 0); PG8_LDB(B1, 0, 1); PG8_SCHED; PG8_LDA(At, 0, 0); PG8_STAGE(PG8_SA(1, 1), a1 + hstep, voffA);
            PG8_WAIT_V(8); PG8_WAIT_L(0); PG8_BAR; PG8_MMA(0, 0, At, B0); PG8_MMA(0, 1, At, B1); PG8_BAR; PG8_SCHED;
            PG8_LDA(At, 0, 1); PG8_STAGE(PG8_SB(0, 0), b2, voffB); PG8_STAGE(PG8_SB(0, 1), b2 + hstep, voffB); PG8_STAGE(PG8_SA(0, 0), a2, voffA);
            PG8_WAIT_V(8); PG8_WAIT_L(0); PG8_BAR; PG8_MMA(1, 0, At, B0); PG8_MMA(1, 1, At, B1); PG8_BAR; PG8_SCHED;
            PG8_LDB(B0, 1, 0); PG8_LDB(B1, 1, 1); PG8_SCHED; PG8_LDA(At, 1, 0); PG8_STAGE(PG8_SA(0, 1), a2 + hstep, voffA);
            PG8_WAIT_V(8); PG8_WAIT_L(0); PG8_BAR; PG8_MMA(0, 0, At, B0); PG8_MMA(0, 1, At, B1); PG8_BAR; PG8_SCHED;
            PG8_LDA(At, 1, 1); PG8_STAGE(PG8_SB(1, 0), b3, voffB); PG8_STAGE(PG8_SB(1, 1), b3 + hstep, voffB); PG8_STAGE(PG8_SA(1, 0), a3, voffA);
            PG8_WAIT_V(8); PG8_WAIT_L(0); PG8_BAR; PG8_MMA(1, 0, At, B0); PG8_MMA(1, 1, At, B1); PG8_BAR; PG8_SCHED;
            } else {
            PG8_LDB(B0, 0, 0); PG8_SCHED; PG8_LDA(At, 0, 0); PG8_STAGE(PG8_SA(1, 1), a1 + hstep, voffA);
            PG8_WAIT_L(8); PG8_BAR; PG8_WAIT_L(0); PG8_MMA(0, 0, At, B0); PG8_BAR; PG8_SCHED;
            PG8_LDB(B1, 0, 1); PG8_STAGE(PG8_SB(0, 0), b2, voffB);
            PG8_BAR; PG8_WAIT_L(0); PG8_MMA(0, 1, At, B1); PG8_BAR;
            PG8_LDA(At, 0, 1); PG8_STAGE(PG8_SA(0, 0), a2, voffA);
            PG8_BAR; PG8_WAIT_L(0); PG8_MMA(1, 0, At, B0); PG8_BAR; PG8_SCHED;
            PG8_STAGE(PG8_SB(0, 1), b2 + hstep, voffB);
            PG8_WAIT_V(6); PG8_BAR; PG8_MMA(1, 1, At, B1); PG8_BAR;
            PG8_LDB(B0, 1, 0); PG8_SCHED; PG8_LDA(At, 1, 0); PG8_STAGE(PG8_SA(0, 1), a2 + hstep, voffA);
            PG8_WAIT_L(8); PG8_BAR; PG8_WAIT_L(0); PG8_MMA(0, 0, At, B0); PG8_BAR; PG8_SCHED;
            PG8_LDB(B1, 1, 1); PG8_STAGE(PG8_SB(1, 0), b3, voffB);
            PG8_BAR; PG8_WAIT_L(0); PG8_MMA(0, 1, At, B1); PG8_BAR;
            PG8_LDA(At, 1, 1); PG8_STAGE(PG8_SA(1, 0), a3, voffA);
            PG8_BAR; PG8_WAIT_L(0); PG8_MMA(1, 0, At, B0); PG8_BAR; PG8_SCHED;
            PG8_STAGE(PG8_SB(1, 1), b3 + hstep, voffB);
            PG8_WAIT_V(6); PG8_BAR; PG8_MMA(1, 1, At, B1); PG8_BAR;
            }
        }
        if constexpr (ALIGN_EPI) { if (wr == 0) PG8_BAR; }
        if constexpr (!Epi::AFTER_DRAIN) { E(acc, cur, wr, wc, fr, fq); S.done(cur); }
        if (!has_next) break;
#pragma unroll
        for (int a = 0; a < 2; ++a)
#pragma unroll
            for (int b = 0; b < 2; ++b)
#pragma unroll
                for (int m = 0; m < 4; ++m)
#pragma unroll
                    for (int n = 0; n < 2; ++n) acc[a][b][m][n] = (f32x4){0.f, 0.f, 0.f, 0.f};
        cur = nxt; cA = nA; cB = nB; ++ui;
        if constexpr (ALIGN_EPI) { if (wr == 1) PG8_BAR; }
    }
    PG8_WAIT_V(0);
    if constexpr (!ALIGN_EPI) { if (wr == 0) PG8_BAR; }
    PG8_BAR;
    if constexpr (Epi::AFTER_DRAIN) { E.fused(acc, cur, wr, wc, fr, fq, lds, wid, lane); S.done(cur); }
#undef PG8_SA
#undef PG8_SB
#undef PG8_STAGE
#undef PG8_LDA
#undef PG8_LDB
#undef PG8_MMA
#undef PG8_WAIT_V
#undef PG8_WAIT_L
#undef PG8_BAR
#undef PG8_SCHED
}
}

typedef unsigned short bf16;
typedef unsigned v4u __attribute__((ext_vector_type(4)));
typedef float f32x4 __attribute__((ext_vector_type(4)));
typedef short bf16x8 __attribute__((ext_vector_type(8)));
typedef GAS unsigned gu32;
typedef GAS unsigned long long gu64;
#define RLX_AGENT __ATOMIC_RELAXED, __HIP_MEMORY_SCOPE_AGENT
#define LDS_WAIT() asm volatile("s_waitcnt lgkmcnt(0)" ::: "memory")
#define VM_WAIT() asm volatile("s_waitcnt vmcnt(0)" ::: "memory")
__device__ __forceinline__ unsigned long long rt() { return __builtin_amdgcn_s_memrealtime(); }
typedef float f32x2_cv __attribute__((ext_vector_type(2))); typedef __bf16 bf16x2_cv __attribute__((ext_vector_type(2)));
__device__ __forceinline__ unsigned pk2(float lo, float hi) { const f32x2_cv v = {lo, hi}; const bf16x2_cv c = __builtin_convertvector(v, bf16x2_cv); return __builtin_bit_cast(unsigned, c); }
__device__ __forceinline__ unsigned f2bf(float f) { return pk2(f, 0.f) & 0xffffu; }

#define XB_TMO      128
#define XB_XCNT(j)  (256  + 64 * (j))
#define XB_XSUB(j)  (1280 + 64 * (j))
#define XB_XGEN(j)  (2304 + 64 * (j))
#define XB_TOP      3328
#define XB_TOPGEN   3392
#define XCD_BAR_WORDS 3456
#define XB_SPIN_CAP (1u << 18)

__device__ __forceinline__ unsigned xb_ld(unsigned* p)              { return __hip_atomic_load(p, __ATOMIC_RELAXED, __HIP_MEMORY_SCOPE_AGENT); }
__device__ __forceinline__ unsigned xb_add(unsigned* p, unsigned v) { return __hip_atomic_fetch_add(p, v, __ATOMIC_RELAXED, __HIP_MEMORY_SCOPE_AGENT); }
__device__ __forceinline__ unsigned xb_xcc_id() { return (unsigned)__builtin_amdgcn_s_getreg((3 << 11) | 20) & 0xFu; }
#define XB_SPIN(cond, bar) do { unsigned _sp = 0; while (cond) { __builtin_amdgcn_s_sleep(1); \
    if ((++_sp & 255u) == 0u) { if (xb_ld(&(bar)[XB_TMO])) break; if (_sp > XB_SPIN_CAP) { atomicAdd(&(bar)[XB_TMO], 1u); break; } } } } while (0)

struct XcdBarrier {
    unsigned* bar; unsigned x;
    volatile LAS unsigned* st;
};

__device__ __forceinline__ XcdBarrier xcd_barrier_post(unsigned* bar, volatile LAS unsigned* st) {
    XcdBarrier b; b.bar = bar; b.x = xb_xcc_id(); b.st = st;
    if (threadIdx.x == 0) (void)xb_add(&bar[XB_XCNT(b.x)], 1u);
    return b;
}
__device__ __forceinline__ void xcd_barrier_complete(unsigned* bar, unsigned x, unsigned& nloc, unsigned& nx, const unsigned G) {
    unsigned sum, cnt, mine, sp = 0u;
    for (;;) {
        sum = 0u; cnt = 0u; mine = 0u;
#pragma unroll 1
        for (unsigned j = 0; j < 16; ++j) { const unsigned c = xb_ld(&bar[XB_XCNT(j)]); sum += c; cnt += (c > 0u) ? 1u : 0u; mine = (j == x) ? c : mine; }
        if (sum == G) break;
        __builtin_amdgcn_s_sleep(1);
        if ((++sp & 255u) == 0u) { if (xb_ld(&bar[XB_TMO])) break; if (sp > XB_SPIN_CAP) { atomicAdd(&bar[XB_TMO], 1u); break; } }
    }
    nloc = mine > 0u ? mine : 1u; nx = cnt > 0u ? cnt : 1u;
}

__device__ __forceinline__ void xcd_barrier(const XcdBarrier& b, const int tid_, const unsigned G_) {
    asm volatile("s_waitcnt vmcnt(0)" ::: "memory");
    __syncthreads();
    if (tid_ == 0) {
        unsigned* bar = b.bar;
        __builtin_amdgcn_s_waitcnt(0);
        unsigned nloc = b.st[0], nx = b.st[1];
        if (nloc == 0u) { xcd_barrier_complete(bar, b.x, nloc, nx, G_); b.st[0] = nloc; b.st[1] = nx; }
        const unsigned old = xb_add(&bar[XB_XSUB(b.x)], 1u);
        const unsigned gen = old / nloc;
        if (old + 1u == (gen + 1u) * nloc) {
            __builtin_amdgcn_fence(__ATOMIC_RELEASE, "agent");
            asm volatile("s_waitcnt vmcnt(0)" ::: "memory");
            const unsigned og = xb_add(&bar[XB_TOP], 1u);
            const unsigned tg = og / nx;
            if (og + 1u == (tg + 1u) * nx) xb_add(&bar[XB_TOPGEN], 1u);
            else XB_SPIN(xb_ld(&bar[XB_TOPGEN]) == tg, bar);
            __builtin_amdgcn_fence(__ATOMIC_ACQUIRE, "agent");
            xb_add(&bar[XB_XGEN(b.x)], 1u);
            asm volatile("s_waitcnt vmcnt(0)" ::: "memory");
        } else {
            XB_SPIN(xb_ld(&bar[XB_XGEN(b.x)]) == gen, bar);
            __builtin_amdgcn_fence(__ATOMIC_ACQUIRE, "agent");
            asm volatile("s_waitcnt vmcnt(0)" ::: "memory");
        }
    }
    __syncthreads();
}

constexpr size_t O_YP = 0, O_YS = O_YP + (size_t)NB * SEQ * D, O_PK = O_YS + (size_t)MS * D, O_PV = O_PK + 2ull * MP * 256, O_PKI = O_PV + 2ull * MP * 256,
                 O_PSSM = O_PKI + 2ull * MP * 64, O_PCONV = O_PSSM + 2ull * NB * NH * HP * NST, O_SK = O_PCONV + 2ull * NB * 3 * CONVD, O_SV = O_SK + 2ull * MS * 256,
                 O_SKI = O_SV + 2ull * MS * 256, O_SSSM = O_SKI + 2ull * MS * 64, O_SCONV = O_SSSM + 2ull * DB * NH * HP * NST, O_END = O_SCONV + 2ull * DB * 3 * CONVD;

constexpr size_t MiB = 1u << 20;
constexpr size_t al(size_t x) { return (x + MiB - 1) / MiB * MiB; }
constexpr size_t WS_CTL = 0, CTL_ZERO_BYTES = 1 * MiB;
constexpr size_t SZ_WIN = (size_t)NIN * D * 2, SZ_WSSM = (size_t)D * DIN * 2, SZ_WATT = (size_t)D * D * 2, SZ_WOUT = (size_t)D * D * 2, SZ_WUP = (size_t)DFF * D * 2, SZ_WDN = (size_t)D * DFF * 2;
constexpr size_t WL_WIN = 0, WL_WSSM = al(WL_WIN + SZ_WIN), WL_WATT = al(WL_WSSM + SZ_WSSM), WL_WOUT = al(WL_WATT + SZ_WATT), WL_WUP = al(WL_WOUT + SZ_WOUT), WL_WDN = al(WL_WUP + SZ_WUP), WL_SIZE = al(WL_WDN + SZ_WDN);
constexpr size_t WS_W = 1 * MiB;
constexpr size_t WS_H = al(WS_W + 2 * WL_SIZE);
constexpr size_t WS_U = al(WS_H + (size_t)MPAD * D * 4);
constexpr size_t WS_P1 = al(WS_U + (size_t)MPAD * D * 2);
constexpr size_t WS_MISC = al(WS_P1 + (size_t)MPAD * LDP1 * 2);
constexpr size_t WS_KIB = al(WS_MISC + (size_t)MPAD * 128 * 4);
constexpr size_t WS_XC = al(WS_KIB + (size_t)MPAD * 64 * 2);
constexpr size_t WS_DT = al(WS_XC + (size_t)MPAD * CONVD * 2);
constexpr size_t WS_DA = al(WS_DT + (size_t)MPAD * 32 * 4);
constexpr size_t WS_YS = al(WS_DA + (size_t)MPAD * 32 * 4);
constexpr size_t WS_YSN = al(WS_YS + (size_t)MPAD * DIN * 4);
constexpr size_t WS_YA = al(WS_YSN + (size_t)MPAD * DIN * 2);
constexpr size_t WS_T1 = al(WS_YA + (size_t)MPAD * D * 2);
constexpr size_t WS_MG = al(WS_T1 + (size_t)MPAD * D * 4);
constexpr size_t WS_A2 = al(WS_MG + (size_t)MPAD * D * 2);
constexpr size_t WS_IDXP = al(WS_A2 + (size_t)MPAD * DFF * 2);
constexpr size_t WS_IDXS = al(WS_IDXP + (size_t)MP * 256 * 2);
constexpr int SCS_LD = 8256;
constexpr size_t WS_SCS = al(WS_IDXS + (size_t)MS * 256 * 4);
constexpr size_t WS_SB = al(WS_SCS + (size_t)MS * SCS_LD * 4);
constexpr size_t WS_DEC = al(WS_SB + (size_t)NB * 33 * NH * HP * NST * 4);
constexpr size_t WS_HC = al(WS_DEC + (size_t)NB * 33 * NH * 4);
constexpr size_t WS_KVB = al(WS_HC + (size_t)NB * 33 * NH * HP * NST * 2);
constexpr size_t WS_KIB2 = al(WS_KVB + (size_t)MPAD * 512 * 2);
constexpr size_t WS_END = al(WS_KIB2 + (size_t)NB * KT_PER_B * 2048 * 2);
constexpr int CW_BAR = 4096;

constexpr int LDS_BYTES = 159744, LDSCTL_OFF = 155648, MISC_OFF = LDSCTL_OFF + 320;
constexpr int NWAVES = 8, NT = 512;
typedef float f32x16 __attribute__((ext_vector_type(16)));
typedef unsigned v2u __attribute__((ext_vector_type(2)));

__device__ __forceinline__ float dpp_f(float v, const int ctrl_unused) { return v; }
#define DPPF(v, ctrl, rmask, bc) __uint_as_float((unsigned)__builtin_amdgcn_update_dpp(0, (int)__float_as_uint(v), ctrl, rmask, 0xf, bc))
__device__ __forceinline__ float row16_sum(float v) {
    v += DPPF(v, 0xB1, 0xf, true); v += DPPF(v, 0x4E, 0xf, true); v += DPPF(v, 0x141, 0xf, true); v += DPPF(v, 0x140, 0xf, true); return v;
}
__device__ __forceinline__ float wave_sum(float v) {
    v = row16_sum(v);
    v += DPPF(v, 0x142, 0xa, false); v += DPPF(v, 0x143, 0xc, false);
    return __uint_as_float((unsigned)__builtin_amdgcn_readlane((int)__float_as_uint(v), 63));
}
__device__ __forceinline__ float wave_max(float v) {
    v = fmaxf(v, __uint_as_float((unsigned)__builtin_amdgcn_update_dpp((int)__float_as_uint(v), (int)__float_as_uint(v), 0xB1, 0xf, 0xf, false)));
    v = fmaxf(v, __uint_as_float((unsigned)__builtin_amdgcn_update_dpp((int)__float_as_uint(v), (int)__float_as_uint(v), 0x4E, 0xf, 0xf, false)));
    v = fmaxf(v, __uint_as_float((unsigned)__builtin_amdgcn_update_dpp((int)__float_as_uint(v), (int)__float_as_uint(v), 0x141, 0xf, 0xf, false)));
    v = fmaxf(v, __uint_as_float((unsigned)__builtin_amdgcn_update_dpp((int)__float_as_uint(v), (int)__float_as_uint(v), 0x140, 0xf, 0xf, false)));
    v = fmaxf(v, __uint_as_float((unsigned)__builtin_amdgcn_update_dpp((int)__float_as_uint(v), (int)__float_as_uint(v), 0x142, 0xa, 0xf, false)));
    v = fmaxf(v, __uint_as_float((unsigned)__builtin_amdgcn_update_dpp((int)__float_as_uint(v), (int)__float_as_uint(v), 0x143, 0xc, 0xf, false)));
    return __uint_as_float((unsigned)__builtin_amdgcn_readlane((int)__float_as_uint(v), 63));
}
__device__ __forceinline__ void unpack8(const v4u w, float (&f)[8]) {
    f[0] = __uint_as_float(w.x << 16); f[1] = __uint_as_float(w.x & 0xffff0000u); f[2] = __uint_as_float(w.y << 16); f[3] = __uint_as_float(w.y & 0xffff0000u);
    f[4] = __uint_as_float(w.z << 16); f[5] = __uint_as_float(w.z & 0xffff0000u); f[6] = __uint_as_float(w.w << 16); f[7] = __uint_as_float(w.w & 0xffff0000u);
}
__device__ __forceinline__ float sigm(float x) { return __builtin_amdgcn_rcpf(1.0f + __expf(-x)); }

__device__ __forceinline__ int win_src_col(int n) {
    if (n < 5120) return n;
    if (n < 6144) return n - 5120 + 5152;
    if (n < 6400) return n - 6144 + 6176;
    if (n < 6656) return n - 6400 + 6432;
    if (n < 7168) return n - 6656 + 6688;
    if (n < 8192) return n - 7168 + 7272;
    if (n < 9216) return n - 8192 + 8296;
    if (n < 9280) return n - 9216 + 7200;
    if (n < 9312) return n - 9280 + 5120;
    if (n < 9320) return n - 9312 + 7264;
    return -1;
}
__device__ __forceinline__ void tr_item(const GAS float* W, int K, int Nsrc, GAS bf16* WT, int nblk, bool remap, LAS float* scr, int item, int lane) {
    const int kb = item / nblk, nb = item % nblk, k0 = 64 * kb, n0 = 64 * nb;
    const int s0 = remap ? win_src_col(n0) : n0, s63 = remap ? win_src_col(n0 + 63) : n0 + 63;
    if (s0 >= 0 && s63 == s0 + 63 && (s0 & 3) == 0 && (Nsrc & 3) == 0) {
        const int r4 = lane >> 4, c4 = (lane & 15) * 4;
#pragma unroll 4
        for (int i = 0; i < 16; ++i) { const int kk = 4 * i + r4; const f32x4 v = *(const GAS f32x4*)(W + (size_t)(k0 + kk) * Nsrc + s0 + c4);
            scr[kk * 65 + c4] = v.x; scr[kk * 65 + c4 + 1] = v.y; scr[kk * 65 + c4 + 2] = v.z; scr[kk * 65 + c4 + 3] = v.w; }
    } else {
        const int sc = remap ? win_src_col(n0 + lane) : n0 + lane;
#pragma unroll 8
        for (int kk = 0; kk < 64; ++kk) scr[kk * 65 + lane] = sc >= 0 ? W[(size_t)(k0 + kk) * Nsrc + sc] : 0.f;
    }
    LDS_WAIT(); asm volatile("" ::: "memory");
    const int c = lane & 7;
#pragma unroll
    for (int j = 0; j < 8; ++j) { const int n = (lane >> 3) + 8 * j; const LAS float* s = scr + (8 * c) * 65 + n;
        v4u o; o.x = pk2(s[0 * 65], s[1 * 65]); o.y = pk2(s[2 * 65], s[3 * 65]); o.z = pk2(s[4 * 65], s[5 * 65]); o.w = pk2(s[6 * 65], s[7 * 65]);
        *(GAS v4u*)(WT + (size_t)(n0 + n) * K + k0 + 8 * c) = o; }
    LDS_WAIT(); asm volatile("" ::: "memory");
}
__device__ __forceinline__ void rms_row(const GAS float* src, const GAS float* w, GAS float* hdst, GAS bf16* udst, GAS float* fdst, int lane) {
    f32x4 v[4]; float ss = 0.f;
#pragma unroll
    for (int j = 0; j < 4; ++j) { v[j] = src ? ((const GAS f32x4*)src)[lane + 64 * j] : (f32x4){0.f, 0.f, 0.f, 0.f}; ss += (v[j].x * v[j].x + v[j].y * v[j].y) + (v[j].z * v[j].z + v[j].w * v[j].w); }
    ss = wave_sum(ss);
    const float rstd = 1.0f / sqrtf(ss * (1.0f / D) + 1e-6f);
#pragma unroll
    for (int j = 0; j < 4; ++j) {
        if (hdst) ((GAS f32x4*)hdst)[lane + 64 * j] = v[j];
        const f32x4 wv = ((const GAS f32x4*)w)[lane + 64 * j]; const f32x4 o = v[j] * rstd * wv;
        if (udst) ((GAS v2u*)udst)[lane + 64 * j] = (v2u){pk2(o.x, o.y), pk2(o.z, o.w)};
        if (fdst) ((GAS f32x4*)fdst)[lane + 64 * j] = o;
    }
}

__device__ __forceinline__ void rms_rows4(const GAS float* H, const GAS float* w, GAS bf16* U, int m0, int stride, int mend, int lane) {
    f32x4 v[4][4]; float ss[4];
#pragma unroll
    for (int r = 0; r < 4; ++r) { const int m = m0 + r * stride; const GAS f32x4* src = (const GAS f32x4*)(H + (size_t)(m < mend ? m : m0) * D); ss[r] = 0.f;
#pragma unroll
        for (int j = 0; j < 4; ++j) v[r][j] = src[lane + 64 * j]; }
    f32x4 wv[4];
#pragma unroll
    for (int j = 0; j < 4; ++j) wv[j] = ((const GAS f32x4*)w)[lane + 64 * j];
#pragma unroll
    for (int r = 0; r < 4; ++r) {
#pragma unroll
        for (int j = 0; j < 4; ++j) ss[r] += (v[r][j].x * v[r][j].x + v[r][j].y * v[r][j].y) + (v[r][j].z * v[r][j].z + v[r][j].w * v[r][j].w);
        ss[r] = wave_sum(ss[r]);
        const float rstd = 1.0f / sqrtf(ss[r] * (1.0f / D) + 1e-6f); const int m = m0 + r * stride;
        if (m < mend) {
#pragma unroll
            for (int j = 0; j < 4; ++j) { const f32x4 o = v[r][j] * rstd * wv[j]; ((GAS v2u*)(U + (size_t)m * D))[lane + 64 * j] = (v2u){pk2(o.x, o.y), pk2(o.z, o.w)}; } }
    }
}

__device__ __forceinline__ void rms_rows4g(const GAS float* const (&src)[4], const GAS float* w, GAS float* const (&hdst)[4], GAS bf16* const (&udst)[4], GAS float* const (&fdst)[4], const bool (&live)[4], int lane) {
    f32x4 v[4][4];
#pragma unroll
    for (int r = 0; r < 4; ++r)
#pragma unroll
        for (int j = 0; j < 4; ++j) v[r][j] = (live[r] && src[r]) ? ((const GAS f32x4*)src[r])[lane + 64 * j] : (f32x4){0.f, 0.f, 0.f, 0.f};
    f32x4 wv[4];
#pragma unroll
    for (int j = 0; j < 4; ++j) wv[j] = ((const GAS f32x4*)w)[lane + 64 * j];
#pragma unroll
    for (int r = 0; r < 4; ++r) { float ss = 0.f;
#pragma unroll
        for (int j = 0; j < 4; ++j) ss += (v[r][j].x * v[r][j].x + v[r][j].y * v[r][j].y) + (v[r][j].z * v[r][j].z + v[r][j].w * v[r][j].w);
        ss = wave_sum(ss);
        const float rstd = 1.0f / sqrtf(ss * (1.0f / D) + 1e-6f);
        if (live[r]) {
#pragma unroll
            for (int j = 0; j < 4; ++j) { const f32x4 o = v[r][j] * rstd * wv[j];
                if (hdst[r]) ((GAS f32x4*)hdst[r])[lane + 64 * j] = v[r][j];
                if (udst[r]) ((GAS v2u*)udst[r])[lane + 64 * j] = (v2u){pk2(o.x, o.y), pk2(o.z, o.w)};
                if (fdst[r]) ((GAS f32x4*)fdst[r])[lane + 64 * j] = o; } }
    }
}

__device__ __forceinline__ void ssd_unit(LAS unsigned char* lds, int tid, const GAS bf16* XC, const GAS float* DT, const GAS float* DA, size_t m0, int L, int h, int p0,
                                         const GAS float* hin, GAS float* hout, GAS float* YS, float dskip) {
    LAS float* Bl = (LAS float*)lds;
    LAS float* Cl = Bl + 64 * 128;
    LAS float* Xl = Cl + 64 * 128;
    LAS float* Yl = Xl + 64 * 32;
    LAS float* dtl = Yl + 64 * 32;
    LAS float* dal = dtl + 64;
    const int pl = tid >> 4, nq = tid & 15, n0 = nq * 8, g = h >> 3;
    float s[8];
    if (hin) { const f32x4 a = *(const GAS f32x4*)(hin + (size_t)(p0 + pl) * NST + n0), b = *(const GAS f32x4*)(hin + (size_t)(p0 + pl) * NST + n0 + 4);
        s[0] = a.x; s[1] = a.y; s[2] = a.z; s[3] = a.w; s[4] = b.x; s[5] = b.y; s[6] = b.z; s[7] = b.w; }
    else {
#pragma unroll
        for (int i = 0; i < 8; ++i) s[i] = 0.f; }
    for (int tb = 0; tb < L; tb += 64) {
        const int nb = (L - tb) < 64 ? (L - tb) : 64;
        { const int tk = tid >> 3, part = tid & 7;
            if (tk < nb) { const GAS bf16* xr = XC + (m0 + tb + tk) * CONVD;
                float f[8];
                unpack8(*(const GAS v4u*)(xr + DIN + g * NST + part * 16), f);
                *(LAS f32x4*)(Bl + tk * 128 + part * 16) = (f32x4){f[0], f[1], f[2], f[3]}; *(LAS f32x4*)(Bl + tk * 128 + part * 16 + 4) = (f32x4){f[4], f[5], f[6], f[7]};
                unpack8(*(const GAS v4u*)(xr + DIN + g * NST + part * 16 + 8), f);
                *(LAS f32x4*)(Bl + tk * 128 + part * 16 + 8) = (f32x4){f[0], f[1], f[2], f[3]}; *(LAS f32x4*)(Bl + tk * 128 + part * 16 + 12) = (f32x4){f[4], f[5], f[6], f[7]};
                unpack8(*(const GAS v4u*)(xr + DIN + NG * NST + g * NST + part * 16), f);
                *(LAS f32x4*)(Cl + tk * 128 + part * 16) = (f32x4){f[0], f[1], f[2], f[3]}; *(LAS f32x4*)(Cl + tk * 128 + part * 16 + 4) = (f32x4){f[4], f[5], f[6], f[7]};
                unpack8(*(const GAS v4u*)(xr + DIN + NG * NST + g * NST + part * 16 + 8), f);
                *(LAS f32x4*)(Cl + tk * 128 + part * 16 + 8) = (f32x4){f[0], f[1], f[2], f[3]}; *(LAS f32x4*)(Cl + tk * 128 + part * 16 + 12) = (f32x4){f[4], f[5], f[6], f[7]};
                const v2u xw = *(const GAS v2u*)(xr + h * HP + p0 + part * 4);
                *(LAS f32x4*)(Xl + tk * 32 + part * 4) = (f32x4){__uint_as_float(xw.x << 16), __uint_as_float(xw.x & 0xffff0000u), __uint_as_float(xw.y << 16), __uint_as_float(xw.y & 0xffff0000u)};
            }
            if (tid < nb) { dtl[tid] = DT[(m0 + tb + tid) * 32 + h]; dal[tid] = DA[(m0 + tb + tid) * 32 + h]; }
        }
        __syncthreads();
        for (int t = 0; t < nb; ++t) {
            const float da = dal[t], dtv = dtl[t], xv = Xl[t * 32 + pl], xdt = xv * dtv;
            const f32x4 b0 = *(const LAS f32x4*)(Bl + t * 128 + n0), b1 = *(const LAS f32x4*)(Bl + t * 128 + n0 + 4);
            const f32x4 c0 = *(const LAS f32x4*)(Cl + t * 128 + n0), c1 = *(const LAS f32x4*)(Cl + t * 128 + n0 + 4);
            s[0] = s[0] * da + xdt * b0.x; s[1] = s[1] * da + xdt * b0.y; s[2] = s[2] * da + xdt * b0.z; s[3] = s[3] * da + xdt * b0.w;
            s[4] = s[4] * da + xdt * b1.x; s[5] = s[5] * da + xdt * b1.y; s[6] = s[6] * da + xdt * b1.z; s[7] = s[7] * da + xdt * b1.w;
            float y = (s[0] * c0.x + s[1] * c0.y) + (s[2] * c0.z + s[3] * c0.w) + (s[4] * c1.x + s[5] * c1.y) + (s[6] * c1.z + s[7] * c1.w);
            y += __shfl_xor(y, 1); y += __shfl_xor(y, 2); y += __shfl_xor(y, 4); y += __shfl_xor(y, 8);
            if (nq == 0) Yl[t * 32 + pl] = y + xv * dskip;
        }
        __syncthreads();
        { const int tk = tid >> 3, part = tid & 7;
            if (tk < nb) *(GAS f32x4*)(YS + (m0 + tb + tk) * DIN + h * HP + p0 + part * 4) = *(const LAS f32x4*)(Yl + tk * 32 + part * 4); }
    }
    *(GAS f32x4*)(hout + (size_t)(p0 + pl) * NST + n0) = (f32x4){s[0], s[1], s[2], s[3]};
    *(GAS f32x4*)(hout + (size_t)(p0 + pl) * NST + n0 + 4) = (f32x4){s[4], s[5], s[6], s[7]};
}

__device__ __forceinline__ void idx_load_q(const GAS bf16* P1, const GAS float* MISC, size_t mq0, int lane, bf16x8 (&afr)[2][4], float (&wq)[2][2][8]) {
    const int r = lane & 31, hh = lane >> 5, qs = ((r >> 2) & 1) * 2 + (r >> 4), head = (r & 3) + 4 * ((r >> 3) & 1);
#pragma unroll
    for (int rt = 0; rt < 2; ++rt)
#pragma unroll
        for (int ks = 0; ks < 4; ++ks) afr[rt][ks] = *(const GAS bf16x8*)(P1 + (mq0 + qs + 4 * rt) * LDP1 + C_QI + head * 64 + 16 * ks + 8 * hh);
#pragma unroll
    for (int rt = 0; rt < 2; ++rt)
#pragma unroll
        for (int jq = 0; jq < 2; ++jq) { const GAS float* wp = MISC + (mq0 + 4 * rt + 2 * hh + jq) * 128 + MC_WI; const f32x4 a = *(const GAS f32x4*)wp, b = *(const GAS f32x4*)(wp + 4);
            const float sc = 8.0f * 0.35355339059327373f;
            wq[rt][jq][0] = a.x * sc; wq[rt][jq][1] = a.y * sc; wq[rt][jq][2] = a.z * sc; wq[rt][jq][3] = a.w * sc; wq[rt][jq][4] = b.x * sc; wq[rt][jq][5] = b.y * sc; wq[rt][jq][6] = b.z * sc; wq[rt][jq][7] = b.w * sc; }
}
typedef float f32x2 __attribute__((ext_vector_type(2)));
__device__ __forceinline__ float relu_bits(float x) { return __int_as_float(max(__float_as_int(x), 0)); }
__device__ __forceinline__ float idx_reduce(const f32x16& acc, const int o, const float (&w)[8]) {
    f32x2 s2 = (f32x2){w[0], w[1]} * (f32x2){relu_bits(acc[o]), relu_bits(acc[o + 1])};
#pragma unroll
    for (int i = 2; i < 8; i += 2) s2 = __builtin_elementwise_fma((f32x2){w[i], w[i + 1]}, (f32x2){relu_bits(acc[o + i]), relu_bits(acc[o + i + 1])}, s2);
    float r; asm("v_add_f32 %0, %1, %2" : "=v"(r) : "v"(s2.x), "v"(s2.y));
    return r;
}
__device__ __forceinline__ void idx_scores(const bf16x8 (&afr)[2][4], const bf16x8 (&bfr)[4], const float (&wq)[2][2][8], float (&sc)[2][2]) {
#pragma unroll
    for (int rt = 0; rt < 2; ++rt) {
        f32x16 acc = {};
#pragma unroll
        for (int ks = 0; ks < 4; ++ks) acc = __builtin_amdgcn_mfma_f32_32x32x16_bf16(afr[rt][ks], bfr[ks], acc, 0, 0, 0);
#pragma unroll
        for (int jq = 0; jq < 2; ++jq) sc[rt][jq] = idx_reduce(acc, 8 * jq, wq[rt][jq]);
    }
}
__device__ __forceinline__ unsigned f2key(float f) { const unsigned u = __float_as_uint(f); return u ^ ((u >> 31) ? 0xffffffffu : 0x80000000u); }
__device__ __forceinline__ unsigned wave_incl_scan(unsigned v, int lane) {
    int x = (int)v;
    x += __builtin_amdgcn_update_dpp(0, x, 0x111, 0xf, 0xf, false);
    x += __builtin_amdgcn_update_dpp(0, x, 0x112, 0xf, 0xf, false);
    x += __builtin_amdgcn_update_dpp(0, x, 0x114, 0xf, 0xf, false);
    x += __builtin_amdgcn_update_dpp(0, x, 0x118, 0xf, 0xf, false);
    x += __builtin_amdgcn_update_dpp(0, x, 0x142, 0xa, 0xf, false);
    x += __builtin_amdgcn_update_dpp(0, x, 0x143, 0xc, 0xf, false);
    return (unsigned)x;
}
#ifndef REP_TK_PASS1
#define REP_TK_PASS1 1
#endif
#ifndef REP_TK_PICK
#define REP_TK_PICK 1
#endif
#ifndef REP_TK_OPEN
#define REP_TK_OPEN 1
#endif
#ifndef REP_TK_PASS
#define REP_TK_PASS 1
#endif
#ifndef REP_TK_COMP
#define REP_TK_COMP 1
#endif
__device__ __forceinline__ int wave_sum_i(int v) {
    v += __builtin_amdgcn_update_dpp(0, v, 0xB1, 0xf, 0xf, true);
    v += __builtin_amdgcn_update_dpp(0, v, 0x4E, 0xf, 0xf, true);
    v += __builtin_amdgcn_update_dpp(0, v, 0x141, 0xf, 0xf, true);
    v += __builtin_amdgcn_update_dpp(0, v, 0x140, 0xf, 0xf, true);
    v += __builtin_amdgcn_update_dpp(0, v, 0x142, 0xa, 0xf, false);
    v += __builtin_amdgcn_update_dpp(0, v, 0x143, 0xc, 0xf, false);
    return __builtin_amdgcn_readlane(v, 63);
}
__device__ __forceinline__ int cnt_ge(const LAS unsigned* s, int nit, unsigned mid, int lane) {
    int cl = 0; int it = 0;
    const LAS v4u* p = (const LAS v4u*)s + lane;
    for (; it + 4 <= nit; it += 4) {
        const v4u k0 = p[64 * it], k1 = p[64 * it + 64], k2 = p[64 * it + 128], k3 = p[64 * it + 192];
        cl += (k0.x >= mid) + (k0.y >= mid) + (k0.z >= mid) + (k0.w >= mid);
        cl += (k1.x >= mid) + (k1.y >= mid) + (k1.z >= mid) + (k1.w >= mid);
        cl += (k2.x >= mid) + (k2.y >= mid) + (k2.z >= mid) + (k2.w >= mid);
        cl += (k3.x >= mid) + (k3.y >= mid) + (k3.z >= mid) + (k3.w >= mid); }
    for (; it < nit; ++it) { const v4u kv = p[64 * it]; cl += (kv.x >= mid) + (kv.y >= mid) + (kv.z >= mid) + (kv.w >= mid); }
    return wave_sum_i(cl);
}
constexpr int HB = 512;
__device__ __forceinline__ unsigned hist_bound_key(int b) {
    return b <= 0 ? 1u : (b >= HB ? 0xff800001u : (b == 256 ? 0x7fffffffu : f2key((float)(b - 256))));
}
__device__ __forceinline__ unsigned mbcnt64(unsigned long long m, unsigned add) { return __builtin_amdgcn_mbcnt_hi((unsigned)(m >> 32), __builtin_amdgcn_mbcnt_lo((unsigned)m, add)); }
template <class OT>
__device__ __forceinline__ void topk_select(LAS unsigned* s, int n, int lane, OT* out, const LAS unsigned* hist = nullptr) {
    const int nit = (n + 255) >> 8;
    for (int i = n + lane; i < nit * 256; i += 64) s[i] = 0u;
    LDS_WAIT(); asm volatile("" ::: "memory");
    unsigned T = 0u, need = 0u;
    {
    unsigned hi, lo; int c_hi, c_lo;
    if (hist) {
        unsigned c[8], tot = 0u;
        { const v4u h0 = *(const LAS v4u*)(hist + HB - 8 - 8 * lane), h1 = *(const LAS v4u*)(hist + HB - 4 - 8 * lane);
          c[0] = h1.w; c[1] = h1.z; c[2] = h1.y; c[3] = h1.x; c[4] = h0.w; c[5] = h0.z; c[6] = h0.y; c[7] = h0.x; }
#pragma unroll
        for (int j = 0; j < 8; ++j) tot += c[j];
        const unsigned incl = wave_incl_scan(tot, lane), excl = incl - tot;
        const bool here = (excl < 256u) && (256u <= incl);
        int bin = 0; unsigned above = 0u, inb = 0u;
        if (here) { unsigned run = excl;
#pragma unroll
            for (int j = 0; j < 8; ++j) { if (run < 256u && 256u <= run + c[j]) { bin = HB - 1 - 8 * lane - j; above = run; inb = c[j]; } run += c[j]; } }
        const unsigned long long mk = __ballot(here); const int src = mk ? (__ffsll((long long)mk) - 1) : 0;
        bin = __builtin_amdgcn_readlane(bin, src); above = (unsigned)__builtin_amdgcn_readlane((int)above, src); inb = (unsigned)__builtin_amdgcn_readlane((int)inb, src);
        lo = hist_bound_key(bin); hi = hist_bound_key(bin + 1);
        while (inb > 192u && hi - lo > 1u) {
            const unsigned mid = lo + ((hi - lo) >> 1); const unsigned up = (unsigned)cnt_ge(s, nit, mid, lane) - above;
            if (above + up >= 256u) { lo = mid; inb = up; } else { above += up; hi = mid; inb -= up; } }
        if (inb <= 192u) {
            LAS unsigned short* stg = (LAS unsigned short*)hist;
            LAS unsigned* cnd = (LAS unsigned*)hist + 128;
            const unsigned wdt = hi - lo;
            unsigned running = 0u, ncand = 0u;
            for (int rq_ = 0; rq_ < REP_TK_PASS1; ++rq_) { running = 0u; ncand = 0u;
            v4u kn = *(const LAS v4u*)(s + 4 * lane);
            for (int it = 0; it < nit; ++it) {
                const int i0 = 4 * (lane + 64 * it); const v4u kv = kn;
                if (it + 1 < nit) kn = *(const LAS v4u*)(s + i0 + 256);
                bool sel[4]; unsigned long long cm[4]; unsigned lower = running, all = 0u;
#pragma unroll
                for (int e = 0; e < 4; ++e) { sel[e] = kv[e] >= hi; const unsigned long long sm = __ballot(sel[e]); lower = mbcnt64(sm, lower); all += (unsigned)__popcll(sm);
                                              cm[e] = __ballot(kv[e] >= lo) & ~sm; }
                unsigned pos = lower;
#pragma unroll
                for (int e = 0; e < 4; ++e) { if (sel[e]) { stg[pos] = (unsigned short)(i0 + e); ++pos; } }
                running += all;
                if (cm[0] | cm[1] | cm[2] | cm[3]) {
#pragma unroll
                    for (int e = 0; e < 4; ++e) {
                        if ((cm[e] >> lane) & 1ull) { const unsigned p = mbcnt64(cm[e], ncand); *(LAS v2u*)(cnd + 2 * p) = (v2u){kv[e], (unsigned)(i0 + e)}; }
                        ncand += (unsigned)__popcll(cm[e]); }
                }
            } }
            LDS_WAIT(); asm volatile("" ::: "memory");
            const unsigned r = 256u - above;
            for (int rk_ = 0; rk_ < REP_TK_PICK; ++rk_) { asm volatile("" ::: "memory");
#define TK_PICK(KC) { unsigned v[KC], ci[KC]; \
                _Pragma("unroll") for (int q = 0; q < KC; ++q) { const unsigned id = (unsigned)lane + 64u * q; v[q] = 0u; ci[q] = 0xffffffffu; \
                    if (id < inb) { const v2u t = *(const LAS v2u*)(cnd + 2 * id); v[q] = t.x - lo + 1u; ci[q] = t.y; } }              \
                unsigned Tv = 0u; \
                for (int bb = 31 - __builtin_clz(wdt | 1u); bb >= 0; --bb) { const unsigned trial = Tv | (1u << bb); unsigned c = 0u; \
                    _Pragma("unroll") for (int q = 0; q < KC; ++q) c += (unsigned)__popcll(__ballot(v[q] >= trial)); \
                    if (c >= r) Tv = trial; } \
                unsigned ngt = 0u, neq = 0u; bool eq[KC]; \
                _Pragma("unroll") for (int q = 0; q < KC; ++q) { ngt += (unsigned)__popcll(__ballot(v[q] > Tv)); eq[q] = v[q] == Tv; neq += (unsigned)__popcll(__ballot(eq[q])); } \
                unsigned needq = r - ngt;                                \
                if (neq != needq) {                                       \
                    bool keep[KC]; _Pragma("unroll") for (int q = 0; q < KC; ++q) keep[q] = false; \
                    for (unsigned t = 0; t < needq; ++t) { unsigned mi = 0xffffffffu; \
                        _Pragma("unroll") for (int q = 0; q < KC; ++q) if (eq[q] && !keep[q] && ci[q] < mi) mi = ci[q]; \
                        _Pragma("unroll") for (int o = 1; o < 64; o <<= 1) { const unsigned x = (unsigned)__shfl_xor((int)mi, o); mi = x < mi ? x : mi; } \
                        _Pragma("unroll") for (int q = 0; q < KC; ++q) if (eq[q] && ci[q] == mi) keep[q] = true; } \
                    _Pragma("unroll") for (int q = 0; q < KC; ++q) eq[q] = keep[q]; } \
                unsigned base = above; \
                _Pragma("unroll") for (int q = 0; q < KC; ++q) { const bool sq = v[q] > Tv || eq[q]; const unsigned long long m = __ballot(sq); \
                    if (sq) stg[mbcnt64(m, base)] = (unsigned short)ci[q]; base += (unsigned)__popcll(m); } }
            if (inb <= 64u) TK_PICK(1) else if (inb <= 128u) TK_PICK(2) else TK_PICK(3)
            }
#undef TK_PICK
            LDS_WAIT(); asm volatile("" ::: "memory");
            const v2u w = *(const LAS v2u*)(stg + 4 * lane);
            if constexpr (sizeof(OT) == 2) *(GAS v2u*)(out + 4 * lane) = w;
            else *(GAS v4u*)(out + 4 * lane) = (v4u){w.x & 0xffffu, w.x >> 16, w.y & 0xffffu, w.y >> 16};
            return;
        }
        T = lo; need = 256u - above;
    }
    }
    const unsigned long long lt = (1ull << lane) - 1ull;
    unsigned running = 0u, eq_taken = 0u;
    {
#pragma unroll 2
    for (int it = 0; it < nit; ++it) {
        const int i0 = 4 * (lane + 64 * it); const v4u kv = *(const LAS v4u*)(s + i0);
        bool sel[4], eq[4]; bool anyeq = false;
#pragma unroll
        for (int e = 0; e < 4; ++e) { sel[e] = kv[e] > T; eq[e] = need != 0u && kv[e] == T && (i0 + e < n); anyeq = anyeq || eq[e]; }
        if (need != 0u && __ballot(anyeq)) {
            unsigned lower = 0u, all = 0u;
#pragma unroll
            for (int e = 0; e < 4; ++e) { const unsigned long long bm = __ballot(eq[e]); lower += (unsigned)__popcll(bm & lt); all += (unsigned)__popcll(bm); }
            unsigned er = eq_taken + lower;
#pragma unroll
            for (int e = 0; e < 4; ++e) { if (eq[e]) { sel[e] = er < need; ++er; } }
            eq_taken += all;
        }
        unsigned lower = 0u, all = 0u;
#pragma unroll
        for (int e = 0; e < 4; ++e) { const unsigned long long sm = __ballot(sel[e]); lower += (unsigned)__popcll(sm & lt); all += (unsigned)__popcll(sm); }
        unsigned pos = running + lower;
#pragma unroll
        for (int e = 0; e < 4; ++e) { if (sel[e]) { if (pos < 256u) out[pos] = (OT)(i0 + e); ++pos; } }
        running += all;
    } }
}

constexpr int NCH = 33;
typedef short s16x4 __attribute__((ext_vector_type(4)));
typedef short v4i16_t __attribute__((ext_vector_type(4)));
__device__ __forceinline__ float wave_incl_scan_f(float v, int lane) {
#pragma unroll
    for (int o = 1; o < 64; o <<= 1) { const float t = __shfl_up(v, o); if (lane >= o) v += t; }
    return v;
}
__device__ __forceinline__ s16x4 ldtr(const LAS unsigned char* p) { return __builtin_bit_cast(s16x4, __builtin_amdgcn_ds_read_tr16_b64_v4i16((LAS v4i16_t*)p)); }
__device__ __forceinline__ bf16x8 frag_tr(const LAS unsigned char* img, int RS, int k0, int c0, int lane) {
    const int hh = lane >> 5, blk = (lane >> 4) & 1, q = (lane & 15) >> 2, pp = lane & 3;
    const LAS unsigned char* a = img + (k0 + 8 * hh + q) * RS + (c0 + 16 * blk + 4 * pp) * 2;
    const s16x4 lo = ldtr(a), hi = ldtr(a + 4 * RS);
    return (bf16x8){lo[0], lo[1], lo[2], lo[3], hi[0], hi[1], hi[2], hi[3]};
}
__device__ __forceinline__ bf16x8 frag_row(const LAS unsigned char* img, int RS, int r0, int k0, int lane) {
    return *(const LAS bf16x8*)(img + (r0 + (lane & 31)) * RS + (k0 + 8 * (lane >> 5)) * 2);
}
constexpr int RS_BC = 272, RS_X = 144, IMG_BC = 128 * RS_BC, IMG_X = 128 * RS_X;
__device__ __forceinline__ void ssd_stage_acum(LAS float* acl, LAS float* dtl, const GAS float* DT, const GAS float* a_log_l, size_t m0, int Lc, int g, int wave, int lane) {
    const int h = 8 * g + wave; const float A = -__expf(a_log_l[h]);
    const float d0 = lane < Lc ? DT[(m0 + lane) * 32 + h] : 0.f, d1 = (64 + lane) < Lc ? DT[(m0 + 64 + lane) * 32 + h] : 0.f;
    const float s0 = wave_incl_scan_f(d0 * A, lane), tot0 = __shfl(s0, 63), s1 = wave_incl_scan_f(d1 * A, lane) + tot0;
    acl[wave * 128 + lane] = s0; acl[wave * 128 + 64 + lane] = s1; dtl[wave * 128 + lane] = d0; dtl[wave * 128 + 64 + lane] = d1;
}
__device__ __forceinline__ void ssd_stage_bc(LAS unsigned char* img, const GAS bf16* src  , int Lc, int tid) {
    const int ch = tid & 15;
#pragma unroll
    for (int q4 = 0; q4 < 4; ++q4) { const int row = (tid >> 4) + 32 * q4; v4u v = (v4u){0u, 0u, 0u, 0u}; if (row < Lc) v = *(const GAS v4u*)(src + (size_t)row * CONVD + ch * 8);
        *(LAS v4u*)(img + row * RS_BC + ch * 16) = v; }
}
__device__ __forceinline__ void ssd_stage_x(LAS unsigned char* img, const GAS bf16* src  , int Lc, int tid, const LAS float* dth, const LAS float* ach, float al, bool decay) {
    const int ch = tid & 7;
#pragma unroll
    for (int q2 = 0; q2 < 2; ++q2) { const int row = (tid >> 3) + 64 * q2; v4u o = (v4u){0u, 0u, 0u, 0u};
        if (row < Lc) { float f[8]; unpack8(*(const GAS v4u*)(src + (size_t)row * CONVD + ch * 8), f);
            const float sc = decay ? dth[row] * __expf(al - ach[row]) : dth[row];
            o = (v4u){pk2(f[0] * sc, f[1] * sc), pk2(f[2] * sc, f[3] * sc), pk2(f[4] * sc, f[5] * sc), pk2(f[6] * sc, f[7] * sc)}; }
        *(LAS v4u*)(img + row * RS_X + ch * 16) = o; }
}
__device__ __forceinline__ void ssd1_unit(LAS unsigned char* lds, int tid, const GAS bf16* XC, const GAS float* DT, const GAS float* a_log_l, GAS bf16* SB, GAS float* DEC, int b, int c, int g) {
    const int lane = tid & 63, wave = __builtin_amdgcn_readfirstlane(tid >> 6), hh = lane >> 5, col = lane & 31;
    const int t0 = c == 0 ? 0 : NMETA + 128 * (c - 1), Lc = c == 0 ? NMETA : 128; const size_t m0 = (size_t)b * LP + t0;
    LAS unsigned char* Bimg = lds; LAS unsigned char* Xw0 = lds + IMG_BC;
    LAS float* acl = (LAS float*)(lds + IMG_BC + 2 * IMG_X); LAS float* dtl = acl + 1024;
    ssd_stage_acum(acl, dtl, DT, a_log_l, m0, Lc, g, wave, lane);
    ssd_stage_bc(Bimg, XC + m0 * CONVD + DIN + g * NST, Lc, tid);
    __syncthreads();
    const int pb = wave >> 2, nb = wave & 3;
    for (int hl = 0; hl < 8; ++hl) {
        const int h = 8 * g + hl; LAS unsigned char* Xw = Xw0 + (hl & 1) * IMG_X;
        const float al = acl[hl * 128 + 127];
        ssd_stage_x(Xw, XC + m0 * CONVD + h * HP, Lc, tid, dtl + hl * 128, acl + hl * 128, al, true);
        __syncthreads();
        f32x16 acc = {};
        if (Lc == 128) {
#pragma unroll
            for (int ks = 0; ks < 8; ++ks) acc = __builtin_amdgcn_mfma_f32_32x32x16_bf16(frag_tr(Xw, RS_X, 16 * ks, 32 * pb, lane), frag_tr(Bimg, RS_BC, 16 * ks, 32 * nb, lane), acc, 0, 0, 0);
        } else acc = __builtin_amdgcn_mfma_f32_32x32x16_bf16(frag_tr(Xw, RS_X, 0, 32 * pb, lane), frag_tr(Bimg, RS_BC, 0, 32 * nb, lane), acc, 0, 0, 0);
        GAS bf16* Sp = SB + ((size_t)(b * NCH + c) * NH + h) * (HP * NST) + 32 * nb + col;
#pragma unroll
        for (int r = 0; r < 16; ++r) Sp[(32 * pb + (r & 3) + 8 * (r >> 2) + 4 * hh) * NST] = (bf16)f2bf(acc[r]);
        if (tid == 0) DEC[(b * NCH + c) * NH + h] = __expf(al);
    }
    __syncthreads();
}
#ifndef REP_SSD3_WR
#define REP_SSD3_WR 1
#endif
#ifndef REP_SSD3_MM
#define REP_SSD3_MM 1
#endif
#ifndef REP_SSD3_HEADS
#define REP_SSD3_HEADS 1
#endif
__device__ __forceinline__ void ssd3_unit(LAS unsigned char* lds, int tid, const GAS bf16* XC, const GAS bf16* P1, const GAS float* DT, const GAS float* a_log_l, const GAS float* dskip_l, const GAS float* normw_l,
                                          const GAS bf16* HC, GAS bf16* YSN, int b, int c, int g) {
    const int lane = tid & 63, wave = __builtin_amdgcn_readfirstlane(tid >> 6), hh = lane >> 5, col = lane & 31;
    const int t0 = c == 0 ? 0 : NMETA + 128 * (c - 1), Lc = c == 0 ? NMETA : 128; const size_t m0 = (size_t)b * LP + t0;
    LAS unsigned char* Bimg = lds; LAS unsigned char* Cimg = lds + IMG_BC; LAS unsigned char* Mimg0 = lds + 2 * IMG_BC; LAS unsigned char* Ximg0 = lds + 3 * IMG_BC;
    LAS float* acl = (LAS float*)(lds + 3 * IMG_BC + 2 * IMG_X); LAS float* dtl = acl + 1024;
    LAS unsigned char* Mimg1 = Bimg; LAS unsigned char* Ximg1 = Ximg0 + IMG_X;
    ssd_stage_acum(acl, dtl, DT, a_log_l, m0, Lc, g, wave, lane);
    ssd_stage_bc(Bimg, XC + m0 * CONVD + DIN + g * NST, Lc, tid);
    ssd_stage_bc(Cimg, XC + m0 * CONVD + DIN + NG * NST + g * NST, Lc, tid);
    __syncthreads();
    const int ib = wave >> 1, pb = wave & 1;
    f32x16 cb[2];
    const bool live = 32 * ib < Lc;
#pragma unroll
    for (int jj = 0; jj < 2; ++jj) { const int jb = 2 * (wave & 1) + jj; cb[jj] = (f32x16){};
        if (jb <= ib && live) {
#pragma unroll
            for (int ks = 0; ks < 8; ++ks) cb[jj] = __builtin_amdgcn_mfma_f32_32x32x16_bf16(frag_row(Bimg, RS_BC, 32 * jb, 16 * ks, lane), frag_row(Cimg, RS_BC, 32 * ib, 16 * ks, lane), cb[jj], 0, 0, 0); } }
    const int irow = 32 * ib + col;
    bf16x8 cf[8];
#pragma unroll
    for (int ks = 0; ks < 8; ++ks) cf[ks] = frag_row(Cimg, RS_BC, 32 * ib, 16 * ks, lane);
    __syncthreads();
    const int xrow = tid >> 3, xch = tid & 7;
    const GAS bf16* xsrc = XC + (m0 + xrow) * CONVD + (8 * g) * HP + xch * 8;
    v4u xq0 = (v4u){0u, 0u, 0u, 0u}, xq1 = xq0;
    for (int rh_ = 0; rh_ < REP_SSD3_HEADS; ++rh_) {
    if (rh_ > 0) __syncthreads();
    if (xrow < Lc) xq0 = *(const GAS v4u*)xsrc;
    if (xrow + 64 < Lc) xq1 = *(const GAS v4u*)(xsrc + (size_t)64 * CONVD);
    const GAS bf16* Hp0 = HC + ((size_t)(b * NCH + c) * NH + 8 * g) * (HP * NST) + pb * 4096 + lane * 8;
    bf16x8 hq[8];
#pragma unroll
    for (int ks = 0; ks < 8; ++ks) hq[ks] = *(const GAS bf16x8*)(Hp0 + 512 * ks);
    for (int hl = 0; hl < 8; ++hl) {
        const int h = 8 * g + hl;
        LAS unsigned char* Mimg = (hl & 1) ? Mimg1 : Mimg0; LAS unsigned char* Ximg = (hl & 1) ? Ximg1 : Ximg0;
        bf16x8 hf[8], hn[8];
#pragma unroll
        for (int ks = 0; ks < 8; ++ks) { hf[ks] = hq[ks]; hn[ks] = hq[ks]; }
        if (hl < 7) {
#pragma unroll
            for (int ks = 0; ks < 8; ++ks) hn[ks] = *(const GAS bf16x8*)(Hp0 + (size_t)(hl + 1) * (HP * NST) + 512 * ks); }
        v4u xn0 = xq0, xn1 = xq1;
        if (hl < 7 && xrow < Lc) xn0 = *(const GAS v4u*)(xsrc + (hl + 1) * HP);
        if (hl < 7 && xrow + 64 < Lc) xn1 = *(const GAS v4u*)(xsrc + (size_t)64 * CONVD + (hl + 1) * HP);
        const float ai = acl[hl * 128 + irow];
        for (int rw_ = 0; rw_ < REP_SSD3_WR; ++rw_) {
#pragma unroll
        for (int jj = 0; jj < 2; ++jj) { const int jb = 2 * (wave & 1) + jj;
            if (jb <= ib && live) {
                LAS unsigned char* mp = Mimg + irow * RS_BC + (32 * jb + 4 * hh) * 2;
#pragma unroll
                for (int q = 0; q < 4; ++q) { const int j0 = 32 * jb + 8 * q + 4 * hh; const f32x4 aj = *(const LAS f32x4*)(acl + hl * 128 + j0);
                    float v[4];
#pragma unroll
                    for (int e = 0; e < 4; ++e) v[e] = (j0 + e <= irow) ? cb[jj][4 * q + e] * __expf(ai - aj[e]) : 0.f;
                    *(LAS v2u*)(mp + 16 * q) = (v2u){pk2(v[0], v[1]), pk2(v[2], v[3])}; } } }
        { const float s0 = dtl[hl * 128 + xrow], s1 = dtl[hl * 128 + 64 + xrow]; float f[8]; v4u o0, o1;
          unpack8(xq0, f); o0 = (v4u){pk2(f[0] * s0, f[1] * s0), pk2(f[2] * s0, f[3] * s0), pk2(f[4] * s0, f[5] * s0), pk2(f[6] * s0, f[7] * s0)};
          unpack8(xq1, f); o1 = (v4u){pk2(f[0] * s1, f[1] * s1), pk2(f[2] * s1, f[3] * s1), pk2(f[4] * s1, f[5] * s1), pk2(f[6] * s1, f[7] * s1)};
          *(LAS v4u*)(Ximg + xrow * RS_X + xch * 16) = o0; *(LAS v4u*)(Ximg + (xrow + 64) * RS_X + xch * 16) = o1; }
        }
        __syncthreads();
        f32x16 a1 = {}, a2 = {};
        if (live) {
        const int nks = Lc == 128 ? 2 * (ib + 1) : 1;
        for (int rm_ = 0; rm_ < REP_SSD3_MM; ++rm_) { a1 = (f32x16){}; a2 = (f32x16){};
        for (int ks = 0; ks < nks; ++ks) a1 = __builtin_amdgcn_mfma_f32_32x32x16_bf16(frag_tr(Ximg, RS_X, 16 * ks, 32 * pb, lane), frag_row(Mimg, RS_BC, 32 * ib, 16 * ks, lane), a1, 0, 0, 0);
#pragma unroll
        for (int ks = 0; ks < 8; ++ks) a2 = __builtin_amdgcn_mfma_f32_32x32x16_bf16(hf[ks], cf[ks], a2, 0, 0, 0);
        }
        const float ei = __expf(ai);
        v2u wq[4];
#pragma unroll
        for (int q = 0; q < 4; ++q) wq[q] = (v2u){pk2(a1[4 * q] + ei * a2[4 * q], a1[4 * q + 1] + ei * a2[4 * q + 1]), pk2(a1[4 * q + 2] + ei * a2[4 * q + 2], a1[4 * q + 3] + ei * a2[4 * q + 3])};
        GAS bf16* yo = YSN + (m0 + irow) * DIN + h * HP + 32 * pb + 8 * hh;
#pragma unroll
        for (int k = 0; k < 4; k += 2) {
            const auto rx = __builtin_amdgcn_permlane32_swap(wq[k].x, wq[k + 1].x, false, false), ry = __builtin_amdgcn_permlane32_swap(wq[k].y, wq[k + 1].y, false, false);
            if (irow < Lc) *(GAS v4u*)(yo + 8 * k) = (v4u){rx[0], ry[0], rx[1], ry[1]}; }
        }
#pragma unroll
        for (int ks = 0; ks < 8; ++ks) hq[ks] = hn[ks];
        xq0 = xn0; xq1 = xn1;
    }
    }
    __syncthreads();
    for (int i0 = wave; i0 < Lc; i0 += 4 * NWAVES) { const int c0 = g * 512 + lane * 8;
        v4u yv[4], xv[4], zv[4];
#pragma unroll
        for (int q = 0; q < 4; ++q) { const int i = i0 + NWAVES * q; const size_t m = m0 + (i < Lc ? i : i0);
            yv[q] = *(const GAS v4u*)(YSN + m * DIN + c0); xv[q] = *(const GAS v4u*)(XC + m * CONVD + c0); zv[q] = *(const GAS v4u*)(P1 + m * LDP1 + C_Z + c0); }
        const float Dh = dskip_l[c0 >> 6];
        const GAS float* wp = normw_l + c0; const f32x4 wa = *(const GAS f32x4*)wp, wb = *(const GAS f32x4*)(wp + 4);
#pragma unroll
        for (int q = 0; q < 4; ++q) { const int i = i0 + NWAVES * q;
            float v[8], x[8], z[8]; unpack8(yv[q], v); unpack8(xv[q], x); unpack8(zv[q], z); float ss = 0.f;
#pragma unroll
            for (int j = 0; j < 8; ++j) { v[j] = (v[j] + Dh * x[j]) * (z[j] * sigm(z[j])); ss += v[j] * v[j]; }
            ss = wave_sum(ss);
            const float rstd = 1.0f / sqrtf(ss * (1.0f / 512.0f) + 1e-6f);
            if (i < Lc) *(GAS v4u*)(YSN + (m0 + i) * DIN + c0) = (v4u){pk2(v[0] * rstd * wa.x, v[1] * rstd * wa.y), pk2(v[2] * rstd * wa.z, v[3] * rstd * wa.w), pk2(v[4] * rstd * wb.x, v[5] * rstd * wb.y), pk2(v[6] * rstd * wb.z, v[7] * rstd * wb.w)}; }
    }
    __syncthreads();
}

constexpr int RS_V = 528;
#define KLOAD(dst, tile) do { _Pragma("unroll") for (int it = 0; it < 8; ++it) dst[it] = *(const GAS v4u*)(kvb + ((unsigned)idl[16 * (tile) + 2 * it + (lane >> 5)] * 1024u + 16u * (lane & 31))); } while (0)
template <int JT> struct AttnKTile {
    static __device__ __forceinline__ void run(LAS unsigned char* Vst, const LAS unsigned short* idl, const GAS char* kvb, const int lane, const int n, const int kg, const int k4, const int cnt, const int ntile,
                                               const bf16x8 (&bq)[8], v4u (&kst)[3][8], f32x4 (&S)[16], float& mx) {
        if (JT < ntile) {
            LAS unsigned char* half = Vst + 16 * (JT & 1) * RS_V;
#pragma unroll
            for (int it = 0; it < 8; ++it) *(LAS v4u*)(half + (2 * it + (lane >> 5)) * RS_V + 16 * (lane & 31)) = kst[JT % 3][it];
            LDS_WAIT(); asm volatile("" ::: "memory");
            if (JT + 3 < 16) KLOAD(kst[JT % 3], JT + 3);
            f32x4 acc = {0.f, 0.f, 0.f, 0.f};
#pragma unroll
            for (int s8 = 0; s8 < 8; ++s8) acc = __builtin_amdgcn_mfma_f32_16x16x32_bf16(*(const LAS bf16x8*)(half + n * RS_V + (32 * s8 + 8 * kg) * 2), bq[s8], acc, 0, 0, 0);
            f32x4 sv;
#pragma unroll
            for (int i = 0; i < 4; ++i) { const float v = (k4 + i < cnt - 16 * JT) ? acc[i] * 0.125f : -INFINITY; sv[i] = v; mx = fmaxf(mx, v); }
            S[JT] = sv;
            LDS_WAIT(); asm volatile("" ::: "memory");
            AttnKTile<JT + 1>::run(Vst, idl, kvb, lane, n, kg, k4, cnt, ntile, bq, kst, S, mx);
        }
    }
};
template <> struct AttnKTile<16> {
    static __device__ __forceinline__ void run(LAS unsigned char*, const LAS unsigned short*, const GAS char*, int, int, int, int, int, int, const bf16x8 (&)[8], v4u (&)[3][8], f32x4 (&)[16], float&) {}
};
__device__ __forceinline__ void attn_prompt_query(LAS unsigned char* wl, const GAS bf16* P1, const GAS bf16* KVB, const GAS unsigned short* IDXP, GAS bf16* YA, int m, int lane_in) {
    int lane = lane_in; asm volatile("" : "+v"(lane));
    const int b = m / LP, t = m - b * LP, cnt = (t + 1) < 256 ? (t + 1) : 256, ntile = (cnt + 15) >> 4, nstep = (ntile + 1) >> 1;
    LAS unsigned char* Vst = wl; LAS unsigned short* idl = (LAS unsigned short*)(wl + 32 * RS_V);
    { const v2u w = *(const GAS v2u*)(IDXP + (size_t)m * 256 + 4 * lane); const int s0 = 4 * lane;
      const unsigned i0 = (s0 + 0 < cnt) ? (w.x & 0xffffu) : 0u, i1 = (s0 + 1 < cnt) ? (w.x >> 16) : 0u, i2 = (s0 + 2 < cnt) ? (w.y & 0xffffu) : 0u, i3 = (s0 + 3 < cnt) ? (w.y >> 16) : 0u;
      *(LAS v2u*)(idl + s0) = (v2u){i0 | (i1 << 16), i2 | (i3 << 16)}; }
    const int n = lane & 15, kg = lane >> 4;
    int k4 = 4 * kg; asm volatile("" : "+v"(k4));
    bf16x8 bq[8];
#pragma unroll
    for (int s = 0; s < 8; ++s) { bq[s] = (bf16x8){0, 0, 0, 0, 0, 0, 0, 0};
        if ((n >> 2) == (s >> 1)) bq[s] = *(const GAS bf16x8*)(P1 + (size_t)m * LDP1 + C_Q + n * 64 + 32 * (s & 1) + 8 * kg); }
    LDS_WAIT(); asm volatile("" ::: "memory");
    const GAS char* kvb = (const GAS char*)(KVB + (size_t)b * LP * 512);
    const unsigned voff = 512u + 16u * (lane & 31);
    f32x4 S[16];
#pragma unroll
    for (int jt = 0; jt < 16; ++jt) S[jt] = (f32x4){-INFINITY, -INFINITY, -INFINITY, -INFINITY};
    float mx = -INFINITY;
    {
        v4u kst[3][8];
        KLOAD(kst[0], 0); KLOAD(kst[1], 1); KLOAD(kst[2], 2);
        AttnKTile<0>::run(Vst, idl, kvb, lane, n, kg, k4, cnt, ntile, bq, kst, S, mx);
#undef KLOAD
    }
    mx = fmaxf(mx, __shfl_xor(mx, 16)); mx = fmaxf(mx, __shfl_xor(mx, 32));
    float sum = 0.f;
    v4u pa[8];
#pragma unroll
    for (int s = 0; s < 8; ++s) { float p[8];
#pragma unroll
        for (int i = 0; i < 4; ++i) { p[i] = __expf(S[2 * s][i] - mx); p[4 + i] = __expf(S[2 * s + 1][i] - mx); }
#pragma unroll
        for (int i = 0; i < 8; ++i) sum += p[i];
        pa[s] = (v4u){pk2(p[0], p[1]), pk2(p[2], p[3]), pk2(p[4], p[5]), pk2(p[6], p[7])};
        __builtin_amdgcn_sched_barrier(0); }
    sum += __shfl_xor(sum, 16); sum += __shfl_xor(sum, 32);
    const float linv = 1.0f / sum;
    asm volatile("" ::: "memory");
    v4u vst[3][8];
#define VLOAD(dst, tile) do { _Pragma("unroll") for (int it = 0; it < 8; ++it) dst[it] = *(const GAS v4u*)(kvb + ((unsigned)idl[16 * (tile) + 2 * it + (lane >> 5)] * 1024u + voff)); } while (0)
#define VSTORE(src, tt) do { _Pragma("unroll") for (int it = 0; it < 8; ++it) { const int u = 2 * it + (lane >> 5); *(LAS v4u*)(Vst + (8 * (u >> 2) + 4 * (tt) + (u & 3)) * RS_V + 16 * (lane & 31)) = src[it]; } } while (0)
    VLOAD(vst[0], 0); VLOAD(vst[1], 1); VLOAD(vst[2], 2);
    f32x4 o[4];
#pragma unroll
    for (int c = 0; c < 4; ++c) o[c] = (f32x4){0.f, 0.f, 0.f, 0.f};
    const int g16 = lane >> 4, q4 = (lane & 15) >> 2, p4 = lane & 3;
    const LAS unsigned char* trb = Vst + (8 * g16 + q4) * RS_V + 8 * p4;
#pragma unroll
    for (int s = 0; s < 8; ++s) {
        if (s >= nstep) break;
        {
            VSTORE(vst[(2 * s) % 3], 0);
            VSTORE(vst[(2 * s + 1) % 3], 1);
            LDS_WAIT(); asm volatile("" ::: "memory");
            if (2 * s + 3 < 16) VLOAD(vst[(2 * s) % 3], 2 * s + 3);
            if (2 * s + 4 < 16) VLOAD(vst[(2 * s + 1) % 3], 2 * s + 4);
#pragma unroll
            for (int g = 0; g < 4; ++g) {
                const v4u pm = ((n >> 2) == g) ? pa[s] : (v4u){0u, 0u, 0u, 0u};
                const bf16x8 pf = __builtin_bit_cast(bf16x8, pm);
#pragma unroll
                for (int c = 0; c < 4; ++c) { const int ct = 4 * g + c;
                    const s16x4 lo = ldtr(trb + 32 * ct), hi = ldtr(trb + 4 * RS_V + 32 * ct);
                    const bf16x8 bv = (bf16x8){lo[0], lo[1], lo[2], lo[3], hi[0], hi[1], hi[2], hi[3]};
                    o[c] = __builtin_amdgcn_mfma_f32_16x16x32_bf16(pf, bv, o[c], 0, 0, 0); }
            }
            LDS_WAIT(); asm volatile("" ::: "memory");
        }
    }
#undef VLOAD
#undef VSTORE
#pragma unroll
    for (int i = 0; i < 4; ++i) { const float li = __shfl(linv, 4 * kg + i);
#pragma unroll
        for (int c = 0; c < 4; ++c) YA[(size_t)m * D + (4 * kg + i) * 64 + 16 * c + n] = (bf16)f2bf(o[c][i] * li); }
}

__device__ __forceinline__ void attn_sample_query(LAS unsigned char* lds, int tid, const GAS bf16* P1, const GAS bf16* KVB, const GAS float* ck, const GAS float* cv, const GAS int* ptab, const GAS int* IDXS, GAS bf16* YA, int qi) {
    const int lane = tid & 63, wave = tid >> 6, bd = qi >> 3; const size_t m = (size_t)MP + qi;
    LAS float* Sl = (LAS float*)lds;
    LAS float* Ol = Sl + 16 * 256;
    LAS float* ql = Ol + 8 * 1024;
    LAS float* linv = ql + 1024;
    LAS int* rowsel = (LAS int*)(linv + 16);
    { const unsigned w = *(const GAS unsigned*)(P1 + m * LDP1 + C_Q + 2 * tid); ql[2 * tid] = __uint_as_float(w << 16); ql[2 * tid + 1] = __uint_as_float(w & 0xffff0000u); }
    if (tid < 256) rowsel[tid] = IDXS[qi * 256 + tid];
    __syncthreads();
    const int g = lane >> 4, c = lane & 15;
    float qr[4][4];
#pragma unroll
    for (int a = 0; a < 4; ++a) { const f32x4 t = *(const LAS f32x4*)(ql + (4 * g + a) * 64 + 4 * c); qr[a][0] = t.x; qr[a][1] = t.y; qr[a][2] = t.z; qr[a][3] = t.w; }
#pragma unroll 4
    for (int kk = 0; kk < 32; ++kk) {
        const int key = 32 * wave + kk, idx = rowsel[key];
        f32x4 kv;
        if (idx < PAST) { const int page = ptab[bd * NPAGES + (idx >> 7)]; kv = *(const GAS f32x4*)(ck + ((size_t)page * PAGE + (idx & 127)) * 256 + 4 * lane); }
        else { const v2u w = *(const GAS v2u*)(KVB + (size_t)(MP + bd * DS + (idx - PAST)) * 512 + 4 * lane);
            kv = (f32x4){__uint_as_float(w.x << 16), __uint_as_float(w.x & 0xffff0000u), __uint_as_float(w.y << 16), __uint_as_float(w.y & 0xffff0000u)}; }
        float part[4];
#pragma unroll
        for (int a = 0; a < 4; ++a) { float s = (qr[a][0] * kv.x + qr[a][1] * kv.y) + (qr[a][2] * kv.z + qr[a][3] * kv.w);
            part[a] = row16_sum(s); }
        if (c == 0) {
#pragma unroll
            for (int a = 0; a < 4; ++a) Sl[(4 * g + a) * 256 + key] = part[a] * 0.125f; }
    }
    __syncthreads();
#pragma unroll
    for (int hs = 0; hs < 2; ++hs) { const int head = 2 * wave + hs; float v[4]; float mx = -INFINITY;
#pragma unroll
        for (int j = 0; j < 4; ++j) { v[j] = Sl[head * 256 + lane + 64 * j]; mx = fmaxf(mx, v[j]); }
        mx = wave_max(mx); float sum = 0.f;
#pragma unroll
        for (int j = 0; j < 4; ++j) { v[j] = __expf(v[j] - mx); sum += v[j]; Sl[head * 256 + lane + 64 * j] = v[j]; }
        sum = wave_sum(sum);
        if (lane == 0) linv[head] = 1.0f / sum; }
    __syncthreads();
    float o[4][4];
#pragma unroll
    for (int a = 0; a < 4; ++a)
#pragma unroll
        for (int cc = 0; cc < 4; ++cc) o[a][cc] = 0.f;
#pragma unroll 4
    for (int kk = 0; kk < 32; ++kk) {
        const int key = 32 * wave + kk, idx = rowsel[key];
        f32x4 vv;
        if (idx < PAST) { const int page = ptab[bd * NPAGES + (idx >> 7)]; vv = *(const GAS f32x4*)(cv + ((size_t)page * PAGE + (idx & 127)) * 256 + 4 * lane); }
        else { const v2u w = *(const GAS v2u*)(KVB + (size_t)(MP + bd * DS + (idx - PAST)) * 512 + 256 + 4 * lane);
            vv = (f32x4){__uint_as_float(w.x << 16), __uint_as_float(w.x & 0xffff0000u), __uint_as_float(w.y << 16), __uint_as_float(w.y & 0xffff0000u)}; }
#pragma unroll
        for (int a = 0; a < 4; ++a) { const float p = Sl[(4 * g + a) * 256 + key]; o[a][0] += p * vv.x; o[a][1] += p * vv.y; o[a][2] += p * vv.z; o[a][3] += p * vv.w; }
    }
#pragma unroll
    for (int a = 0; a < 4; ++a) *(LAS f32x4*)(Ol + wave * 1024 + (4 * g + a) * 64 + 4 * c) = (f32x4){o[a][0], o[a][1], o[a][2], o[a][3]};
    __syncthreads();
    { float s0 = 0.f, s1 = 0.f;
#pragma unroll
      for (int w = 0; w < 8; ++w) { s0 += Ol[w * 1024 + 2 * tid]; s1 += Ol[w * 1024 + 2 * tid + 1]; }
      const float li = linv[(2 * tid) >> 6];
      *(GAS unsigned*)(YA + m * D + 2 * tid) = pk2(s0 * li, s1 * li); }
    __syncthreads();
}

constexpr int TAIL_R0 = 16384, TAIL_NRT = (MR - TAIL_R0) / 64;
static_assert(TAIL_R0 + 64 * TAIL_NRT == MR, "tail rows");
template <int MODE>
__device__ __forceinline__ void tail_gemm(LAS unsigned char* lds, const GAS bf16* A, int K, const GAS bf16* Bt, int N, const GAS bf16* P1, GAS bf16* T1, GAS bf16* MG, GAS float* H, GAS bf16* A2, int bx, int G, int tid) {
    constexpr int KB = 256, RS = (KB + 8) * 2;
    const int lane = tid & 63, wave = __builtin_amdgcn_readfirstlane(tid >> 6), col = lane & 31, hh = lane >> 5;
    const int nunits = TAIL_NRT * (N / 64), lr = tid >> 3, lc = tid & 7, ti = wave & 3, kh = wave >> 2;
    LAS unsigned char* As = lds; LAS unsigned char* Bs = lds + 64 * RS; LAS float* red = (LAS float*)(lds + 2 * 64 * RS);
    for (int u = bx; u < nunits; u += G) {
        const int rt = u % TAIL_NRT, ct = u / TAIL_NRT;
        const GAS bf16* ap = A + (size_t)(TAIL_R0 + 64 * rt + lr) * K + 8 * lc;
        const GAS bf16* bp = Bt + (size_t)(64 * ct + lr) * K + 8 * lc;
        v4u ra[4], rb[4];
#pragma unroll
        for (int j = 0; j < 4; ++j) { ra[j] = *(const GAS v4u*)(ap + 64 * j); rb[j] = *(const GAS v4u*)(bp + 64 * j); }
        f32x16 acc = {};
        for (int k0 = 0; k0 < K; k0 += KB) {
            __syncthreads();
#pragma unroll
            for (int j = 0; j < 4; ++j) { *(LAS v4u*)(As + lr * RS + (lc * 8 + 64 * j) * 2) = ra[j]; *(LAS v4u*)(Bs + lr * RS + (lc * 8 + 64 * j) * 2) = rb[j]; }
            if (k0 + KB < K) {
#pragma unroll
                for (int j = 0; j < 4; ++j) { ra[j] = *(const GAS v4u*)(ap + k0 + KB + 64 * j); rb[j] = *(const GAS v4u*)(bp + k0 + KB + 64 * j); } }
            __syncthreads();
#pragma unroll
            for (int j = 0; j < 8; ++j) { const int ks = 8 * kh + j;
                const bf16x8 av = *(const LAS bf16x8*)(As + (32 * (ti >> 1) + col) * RS + (16 * ks + 8 * hh) * 2), bv = *(const LAS bf16x8*)(Bs + (32 * (ti & 1) + col) * RS + (16 * ks + 8 * hh) * 2);
                acc = __builtin_amdgcn_mfma_f32_32x32x16_bf16(av, bv, acc, 0, 0, 0); }
        }
        __syncthreads();
        if (kh == 1) {
#pragma unroll
            for (int r = 0; r < 16; ++r) red[(ti * 16 + r) * 64 + lane] = acc[r]; }
        __syncthreads();
        if (kh == 0) {
            const int c = 64 * ct + 32 * (ti & 1) + col;
#pragma unroll
            for (int r = 0; r < 16; ++r) { const size_t row = TAIL_R0 + 64 * rt + 32 * (ti >> 1) + (r & 3) + 8 * (r >> 2) + 4 * hh; const float v = acc[r] + red[(ti * 16 + r) * 64 + lane];
                if (MODE == 1) { const float g = __uint_as_float((unsigned)P1[row * LDP1 + C_GS + c] << 16); T1[row * D + c] = (bf16)f2bf(v * sigm(g)); }
                if (MODE == 2) { const float g = __uint_as_float((unsigned)P1[row * LDP1 + C_GA + c] << 16); MG[row * D + c] = (bf16)f2bf(__uint_as_float((unsigned)T1[row * D + c] << 16) + v * sigm(g)); }
                if (MODE == 3) H[row * D + c] += v;
                if (MODE == 4) { const float w = fmaxf(v, 0.f); A2[row * DFF + c] = (bf16)f2bf(w * w); } }
        }
    }
    __syncthreads();
}

#ifndef REP_SCORE
#define REP_SCORE 1
#endif
#ifndef REP_SCORE_AT
#define REP_SCORE_AT 1
#endif
#ifndef REP_SEL
#define REP_SEL 1
#endif
#ifndef REP_CONV
#define REP_CONV 1
#endif
#ifndef REP_TOPK
#define REP_TOPK 1
#endif
#ifndef REP_SSC
#define REP_SSC 1
#endif
#ifndef REP_SSEL
#define REP_SSEL 1
#endif
#ifndef REP_SSD1
#define REP_SSD1 1
#endif
#ifndef REP_SREC
#define REP_SREC 1
#endif
#ifndef REP_SCAN
#define REP_SCAN 1
#endif
#ifndef REP_ATTS
#define REP_ATTS 1
#endif
#ifndef REP_ATTP
#define REP_ATTP 1
#endif
#ifndef REP_SSD3
#define REP_SSD3 1
#endif
__device__ __forceinline__ void xcd_barrier_ni(unsigned* bar, unsigned x, volatile LAS unsigned* st, int tid, unsigned G) { XcdBarrier b; b.bar = bar; b.x = x; b.st = st; xcd_barrier(b, tid, G); }
__device__ __forceinline__ void assume_global(const void* p) {
#if defined(__HIP_DEVICE_COMPILE__)
    __builtin_assume(!__builtin_amdgcn_is_shared((const __attribute__((address_space(0))) void*)p));
    __builtin_assume(!__builtin_amdgcn_is_private((const __attribute__((address_space(0))) void*)p));
#else
    (void)p;
#endif
}
__device__ __forceinline__ int tid_now(int wave0) { unsigned ones = ~0u; asm volatile("" : "+s"(ones)); return (wave0 << 6) | (int)__builtin_amdgcn_mbcnt_hi(ones, __builtin_amdgcn_mbcnt_lo(ones, 0u)); }
constexpr int NPH = 12, NPHASES = 1 + 2 * NPH;
struct Args { const void* in[24]; float* out; unsigned char* ws; int l_lo, l_hi; };
static_assert(sizeof(Args) == 24 * 8 + 8 + 8 + 8, "Args has no padding");

template <int KLO, int KHI>
__global__ void __launch_bounds__(NT, 2) fwd_t(Args args) {
    extern __shared__ __attribute__((aligned(16))) unsigned char lds_raw[];
    LAS unsigned char* lds0 = (LAS unsigned char*)lds_raw;
    volatile LAS unsigned* MISCW = (volatile LAS unsigned*)(lds0 + MISC_OFF);
    const int G = gridDim.x, bx = blockIdx.x, NGW = G * NWAVES;
    const int wave0 = __builtin_amdgcn_readfirstlane((int)threadIdx.x >> 6);
#define TID_NOW() tid_now(wave0)
    { const int tid0 = threadIdx.x;
      for (int u = tid0; u < (LDS_BYTES - LDSCTL_OFF) / 4; u += NT) ((LAS unsigned*)(lds0 + LDSCTL_OFF))[u] = 0u; }
    __syncthreads();
    XcdBarrier bar = xcd_barrier_post((unsigned*)(args.ws + WS_CTL) + CW_BAR, MISCW + 8);
#define IN(k) (KLO <= (k) && (k) < KHI)
#define SEAM(k) do { if (IN(k) && IN((k) + 1)) xcd_barrier_ni(bar.bar, bar.x, bar.st, TID_NOW(), (unsigned)G); } while (0)
#define PHASE_REGS \
    int tid = TID_NOW(); asm volatile("" : "+v"(tid)); \
    int bxl = bx, Gl = G; asm volatile("" : "+s"(bxl), "+s"(Gl)); (void)bxl; (void)Gl;     \
    const int lane = tid & 63, wave = __builtin_amdgcn_readfirstlane(tid >> 6), gw = bx * NWAVES + wave; \
    unsigned char* ws_ = args.ws; asm volatile("" : "+s"(ws_)); GAS unsigned char* ws = (GAS unsigned char*)ws_;     \
    float* out_ = args.out; asm volatile("" : "+s"(out_)); GAS float* out = (GAS float*)out_; \
    (void)lane; (void)gw; (void)out; \
    GAS float* H = (GAS float*)(ws + WS_H); GAS bf16* U = (GAS bf16*)(ws + WS_U); GAS bf16* P1 = (GAS bf16*)(ws + WS_P1); GAS float* MISCB = (GAS float*)(ws + WS_MISC); GAS bf16* KIB = (GAS bf16*)(ws + WS_KIB); \
    GAS bf16* XC = (GAS bf16*)(ws + WS_XC); GAS float* DT = (GAS float*)(ws + WS_DT); GAS float* DA = (GAS float*)(ws + WS_DA); GAS float* YS = (GAS float*)(ws + WS_YS); GAS bf16* YSN = (GAS bf16*)(ws + WS_YSN); \
    GAS bf16* YA = (GAS bf16*)(ws + WS_YA); GAS bf16* T1 = (GAS bf16*)(ws + WS_T1); GAS bf16* MG = (GAS bf16*)(ws + WS_MG); GAS bf16* A2 = (GAS bf16*)(ws + WS_A2); \
    GAS unsigned short* IDXP = (GAS unsigned short*)(ws + WS_IDXP); GAS int* IDXS = (GAS int*)(ws + WS_IDXS); GAS float* SCS = (GAS float*)(ws + WS_SCS); \
    GAS bf16* SB = (GAS bf16*)(ws + WS_SB); GAS float* DEC = (GAS float*)(ws + WS_DEC); GAS bf16* HC = (GAS bf16*)(ws + WS_HC); GAS bf16* KVB = (GAS bf16*)(ws + WS_KVB); GAS bf16* KIB2 = (GAS bf16*)(ws + WS_KIB2); (void)KIB2; (void)SB; (void)DEC; (void)HC; (void)KVB; \
    GAS unsigned char* wl = ws + WS_W + (size_t)l * WL_SIZE; \
    (void)H; (void)U; (void)P1; (void)MISCB; (void)KIB; (void)XC; (void)DT; (void)DA; (void)YS; (void)YSN; (void)YA; (void)T1; (void)MG; (void)A2; (void)IDXP; (void)IDXS; (void)SCS; (void)wl;
#define LDS_LOCAL LAS unsigned char* lds = lds0; asm volatile("" : "+s"(lds));
#define INP(T, name, i) const GAS T* name; { const void* p_; asm volatile("s_load_dwordx2 %0, %1, %2\n\ts_waitcnt lgkmcnt(0)" : "=s"(p_) : "s"(__builtin_amdgcn_kernarg_segment_ptr()), "i"((i) * 8)); name = (const GAS T*)p_; }

    if (IN(0) && args.l_lo == 0) {
        const int l = 0; PHASE_REGS
        LDS_LOCAL
        INP(float, w_in, 10) INP(float, w_ssm, 17) INP(float, w_att, 18) INP(float, w_out, 19) INP(float, w_up, 21) INP(float, w_down, 22) INP(float, meta, 8) INP(float, x_prompt, 0) INP(float, x_sample, 1) INP(float, norm1_w, 9)
        LAS float* scr = (LAS float*)(lds + wave * 17408);
        constexpr int I_IN = (D / 64) * (NIN / 64), I_SSM = (DIN / 64) * (D / 64), I_ATT = (D / 64) * (D / 64), I_OUT = I_ATT, I_UP = (D / 64) * (DFF / 64), I_DN = (DFF / 64) * (D / 64);
        constexpr int I_L = I_IN + I_SSM + I_ATT + I_OUT + I_UP + I_DN;
        for (int it = gw; it < 2 * I_L; it += NGW) {
            const int l = it / I_L; int r = it % I_L; GAS unsigned char* wl = ws + WS_W + (size_t)l * WL_SIZE;
            if (r < I_IN) { tr_item(w_in + (size_t)l * D * IN_DIM, D, IN_DIM, (GAS bf16*)(wl + WL_WIN), NIN / 64, true, scr, r, lane); continue; } r -= I_IN;
            if (r < I_SSM) { tr_item(w_ssm + (size_t)l * DIN * D, DIN, D, (GAS bf16*)(wl + WL_WSSM), D / 64, false, scr, r, lane); continue; } r -= I_SSM;
            if (r < I_ATT) { tr_item(w_att + (size_t)l * D * D, D, D, (GAS bf16*)(wl + WL_WATT), D / 64, false, scr, r, lane); continue; } r -= I_ATT;
            if (r < I_OUT) { tr_item(w_out + (size_t)l * D * D, D, D, (GAS bf16*)(wl + WL_WOUT), D / 64, false, scr, r, lane); continue; } r -= I_OUT;
            if (r < I_UP) { tr_item(w_up + (size_t)l * D * DFF, D, DFF, (GAS bf16*)(wl + WL_WUP), DFF / 64, false, scr, r, lane); continue; } r -= I_UP;
            tr_item(w_down + (size_t)l * DFF * D, DFF, D, (GAS bf16*)(wl + WL_WDN), D / 64, false, scr, r, lane);
        }
        for (int m0 = gw; m0 < MPAD; m0 += 4 * NGW) {
            const GAS float* src[4]; GAS float* hd[4]; GAS bf16* ud[4]; GAS float* fd[4]; bool live[4];
#pragma unroll
            for (int r = 0; r < 4; ++r) { const int m = m0 + r * NGW; live[r] = m < MPAD; src[r] = nullptr; fd[r] = nullptr; hd[r] = H + (size_t)m * D; ud[r] = U + (size_t)m * D;
                if (m < MP) { const int b = m / LP, t = m - b * LP; src[r] = t < NMETA ? meta + (size_t)t * D : x_prompt + ((size_t)b * SEQ + (t - NMETA)) * D; }
                else if (m < MR) src[r] = x_sample + (size_t)(m - MP) * D; }
            rms_rows4g(src, norm1_w, hd, ud, fd, live, lane);
        }
    }
    SEAM(0);

    for (int l = args.l_lo; l < args.l_hi; ++l) {
        constexpr int pb = 1;

        if (IN(pb + 0)) {
            PHASE_REGS
            LAS unsigned char* lds = lds0;
            pg8::Gemm gm{U, (const GAS bf16*)(wl + WL_WIN), MPAD, NIN, D}; pg8::StaticOrder S; S.init(MPAD, NIN, Gl, bxl);
            pg8::EpiIn E{P1, KVB, MISCB, KIB, KIB2, out + O_PK + (size_t)l * MP * 256, out + O_PV + (size_t)l * MP * 256, out + O_PKI + (size_t)l * MP * 64,
                         out + O_SK + (size_t)l * MS * 256, out + O_SV + (size_t)l * MS * 256, out + O_SKI + (size_t)l * MS * 64};
            pg8::gemm_phase<pg8::EpiIn, pg8::StaticOrder, true, true>(lds, gm, S, E, tid);
        }
        SEAM(pb + 0);

        if (IN(pb + 1)) {
            PHASE_REGS
            LDS_LOCAL
            INP(float, state_conv, 6) INP(float, conv_b, 12) INP(float, conv_w, 11) INP(float, dt_bias, 13) INP(float, a_log, 14) INP(float, cache_ki, 4) INP(int, page_table, 7)
            for (int rp_ = 0; rp_ < REP_CONV; ++rp_) for (int it = bx * NT + tid; it < (MR / 8) * 384; it += G * NT) {
                const int rg = it / 384, c8 = (it % 384) * 8, m0 = 8 * rg;
                const bool isS = m0 >= MP; int tpos, sq;
                if (!isS) { sq = m0 / LP; tpos = m0 - sq * LP; } else { sq = (m0 - MP) >> 3; tpos = (m0 - MP) & 7; }
                float xv[11][8];
#pragma unroll
                for (int k = 0; k < 11; ++k) { const int dtp = tpos - 3 + k;
                    if (dtp >= 0) unpack8(*(const GAS v4u*)(P1 + (size_t)(m0 - 3 + k) * LDP1 + C_XBC + c8), xv[k]);
                    else if (isS) { const GAS float* pp = state_conv + ((size_t)(l * DB + sq) * 3 + (3 + dtp)) * CONVD + c8; const f32x4 a = *(const GAS f32x4*)pp, b = *(const GAS f32x4*)(pp + 4);
                        xv[k][0] = a.x; xv[k][1] = a.y; xv[k][2] = a.z; xv[k][3] = a.w; xv[k][4] = b.x; xv[k][5] = b.y; xv[k][6] = b.z; xv[k][7] = b.w; }
                    else {
#pragma unroll
                        for (int j = 0; j < 8; ++j) xv[k][j] = 0.f; } }
                float wv[4][8], bv[8];
                { const GAS float* bp = conv_b + (size_t)l * CONVD + c8; const f32x4 a = *(const GAS f32x4*)bp, b = *(const GAS f32x4*)(bp + 4);
                  bv[0] = a.x; bv[1] = a.y; bv[2] = a.z; bv[3] = a.w; bv[4] = b.x; bv[5] = b.y; bv[6] = b.z; bv[7] = b.w; }
#pragma unroll
                for (int k = 0; k < 4; ++k) { const GAS float* wp = conv_w + ((size_t)l * 4 + k) * CONVD + c8; const f32x4 a = *(const GAS f32x4*)wp, b = *(const GAS f32x4*)(wp + 4);
                    wv[k][0] = a.x; wv[k][1] = a.y; wv[k][2] = a.z; wv[k][3] = a.w; wv[k][4] = b.x; wv[k][5] = b.y; wv[k][6] = b.z; wv[k][7] = b.w; }
#pragma unroll
                for (int r = 0; r < 8; ++r) {
                    float y[8];
#pragma unroll
                    for (int j = 0; j < 8; ++j) { float s = bv[j];
#pragma unroll
                        for (int k = 0; k < 4; ++k) s += xv[r + k][j] * wv[k][j];
                        y[j] = s * sigm(s); }
                    *(GAS v4u*)(XC + (size_t)(m0 + r) * CONVD + c8) = (v4u){pk2(y[0], y[1]), pk2(y[2], y[3]), pk2(y[4], y[5]), pk2(y[6], y[7])};
                    const int tp = tpos + r; GAS float* cs = nullptr;
                    if (!isS && tp >= LP - 3) cs = out + O_PCONV + ((size_t)(l * NB + sq) * 3 + (tp - (LP - 3))) * CONVD + c8;
                    if (isS && tp >= DS - 3) cs = out + O_SCONV + ((size_t)(l * DB + sq) * 3 + (tp - (DS - 3))) * CONVD + c8;
                    if (cs) { *(GAS f32x4*)cs = (f32x4){xv[r + 3][0], xv[r + 3][1], xv[r + 3][2], xv[r + 3][3]}; *(GAS f32x4*)(cs + 4) = (f32x4){xv[r + 3][4], xv[r + 3][5], xv[r + 3][6], xv[r + 3][7]}; }
                }
            }
            for (int it = bx * NT + tid; it < MR * NH; it += G * NT) {
                const int m = it >> 5, h = it & 31;
                const float raw = MISCB[(size_t)m * 128 + MC_DT + h] + dt_bias[l * NH + h];
                const float sp = fmaxf(raw, 0.f) + log1pf(__expf(-fabsf(raw)));
                const float A = -__expf(a_log[l * NH + h]);
                DT[it] = sp; DA[it] = __expf(sp * A);
            }
            for (int rp_ = 0; rp_ < REP_TOPK; ++rp_) {
                constexpr int SLD = 4352;
                LAS unsigned* scl = (LAS unsigned*)lds; LAS unsigned* histq = (LAS unsigned*)(lds + 8 * SLD * 4);
                for (int j = 0; ; ++j) {
                    const int unit = j * G + ((j & 1) ? (G - 1 - bx) : bx); if (unit >= NB * (LP / 8)) break;
                    const int b = unit & (NB - 1), qb = (LP / 8 - 1) - (unit >> 2);
                    const size_t mq0 = (size_t)b * LP + 8 * qb; const int nkeys = 8 * qb + 8, ntl = (nkeys + 31) >> 5;
                    bf16x8 afr[2][4]; float wq[2][2][8];
                    idx_load_q(P1, MISCB, mq0, lane, afr, wq);
                    const int kcol = lane & 31, hh = lane >> 5;
                    for (int rs_ = 0; rs_ < REP_SCORE; ++rs_) {
                    if (rs_) __syncthreads();
                    for (int i = tid; i < 8 * HB; i += NT) histq[i] = 0u;
                    __syncthreads();
                    const GAS bf16* kp0 = KIB2 + (size_t)b * KT_PER_B * 2048 + lane * 8;
                    bf16x8 ks0[4], ks1[4], ks2[4];
#pragma unroll
                    for (int ks = 0; ks < 4; ++ks) { ks0[ks] = (bf16x8){0, 0, 0, 0, 0, 0, 0, 0}; ks1[ks] = ks0[ks]; ks2[ks] = ks0[ks]; }
#define SC_LOAD(S, T) { _Pragma("unroll") for (int ks = 0; ks < 4; ++ks) S[ks] = *(const GAS bf16x8*)(kp0 + (size_t)(T) * 2048 + 512 * ks); }
#define SC_TILE(S, KT, LOADC, ADM) { \
                        f32x16 a0 = {}, a1 = {}; \
                        _Pragma("unroll") for (int ks = 0; ks < 4; ++ks) { a0 = __builtin_amdgcn_mfma_f32_32x32x16_bf16(afr[0][ks], S[ks], a0, 0, 0, 0); a1 = __builtin_amdgcn_mfma_f32_32x32x16_bf16(afr[1][ks], S[ks], a1, 0, 0, 0); } \
                        asm volatile("" : "+v"(a0), "+v"(a1) :: "memory");        \
                        if (LOADC) SC_LOAD(S, (KT) + 3 * NWAVES) \
                        const int key = 32 * (KT) + kcol; \
                        _Pragma("unroll") for (int rt = 0; rt < 2; ++rt) \
                        _Pragma("unroll") for (int jq = 0; jq < 2; ++jq) { const int q = 4 * rt + 2 * hh + jq; const float sv = idx_reduce(rt ? a1 : a0, 8 * jq, wq[rt][jq]); \
                            scl[q * SLD + key] = f2key(sv); \
                            int bn; asm("v_cvt_flr_i32_f32 %0, %1" : "=v"(bn) : "v"(sv)); bn = min(max(bn, -256), HB - 257); \
                            if (SC_ATOM) __hip_atomic_fetch_add(histq + q * HB + 256 + bn, (ADM) || key <= 8 * qb + q ? 1u : 0u, __ATOMIC_RELAXED, __HIP_MEMORY_SCOPE_WORKGROUP); } }
                    const bool SC_ATOM = REP_SCORE_AT || rs_ == REP_SCORE - 1;
                    int kt = wave;
                    if (kt + 5 * NWAVES < ntl) {
                        SC_LOAD(ks0, wave) SC_LOAD(ks1, wave + NWAVES) SC_LOAD(ks2, wave + 2 * NWAVES)
                        do { SC_TILE(ks0, kt, true, true) SC_TILE(ks1, kt + NWAVES, true, true) SC_TILE(ks2, kt + 2 * NWAVES, true, true) kt += 3 * NWAVES; } while (kt + 5 * NWAVES < ntl);
                    } else {
                        if (wave < ntl) SC_LOAD(ks0, wave)
                        if (wave + NWAVES < ntl) SC_LOAD(ks1, wave + NWAVES)
                        if (wave + 2 * NWAVES < ntl) SC_LOAD(ks2, wave + 2 * NWAVES)
                    }
                    for (; kt < ntl; kt += 3 * NWAVES) {
                        SC_TILE(ks0, kt, kt + 3 * NWAVES < ntl, false)
                        if (kt + NWAVES < ntl) SC_TILE(ks1, kt + NWAVES, kt + 4 * NWAVES < ntl, false)
                        if (kt + 2 * NWAVES < ntl) SC_TILE(ks2, kt + 2 * NWAVES, kt + 5 * NWAVES < ntl, false)
                    }
#undef SC_TILE
#undef SC_LOAD
                    }
                    __syncthreads();
                    for (int r2_ = 0; r2_ < REP_SEL; ++r2_) { const int t = 8 * qb + wave, n = t + 1; GAS unsigned short* op = IDXP + ((size_t)b * LP + t) * 256;
                      if (n <= 256) { for (int i = lane; i < n; i += 64) op[i] = (unsigned short)i; }
                      else topk_select(scl + wave * SLD, n, lane, op, histq + wave * HB); }
                    __syncthreads();
                }
            }
            const GAS float* cki = cache_ki + (size_t)l * NPOOL * PAGE * 64;
            for (int rp_ = 0; rp_ < REP_SSC; ++rp_) for (int unit = bx; unit < DB * 8; unit += G) {
                const int bd = unit >> 3, ch = unit & 7; const size_t mq0 = (size_t)MP + bd * DS;
                bf16x8 afr[2][4]; float wq[2][2][8];
                idx_load_q(P1, MISCB, mq0, lane, afr, wq);
                const int kcol = lane & 31, hh = lane >> 5;
                const int pg = 8 * ch + wave, phys = page_table[bd * NPAGES + pg];
                const GAS float* kbase = cki + (size_t)phys * PAGE * 64;
#pragma unroll 1
                for (int kt = 0; kt < 4; ++kt) {
                    const int kin = 32 * kt + kcol; const GAS float* kp = kbase + (size_t)kin * 64 + 8 * hh;
                    bf16x8 bfr[4];
#pragma unroll
                    for (int ks = 0; ks < 4; ++ks) { const f32x4 a = *(const GAS f32x4*)(kp + 16 * ks), bq = *(const GAS f32x4*)(kp + 16 * ks + 4);
                        const v4u w = (v4u){pk2(a.x, a.y), pk2(a.z, a.w), pk2(bq.x, bq.y), pk2(bq.z, bq.w)}; bfr[ks] = __builtin_bit_cast(bf16x8, w); }
                    float sc[2][2];
                    idx_scores(afr, bfr, wq, sc);
#pragma unroll
                    for (int rt = 0; rt < 2; ++rt)
#pragma unroll
                        for (int jq = 0; jq < 2; ++jq) SCS[(size_t)(bd * DS + 4 * rt + 2 * hh + jq) * SCS_LD + 128 * pg + kin] = sc[rt][jq];
                }
                if (ch == 7 && wave == 0) {
                    const int j = kcol < DS ? kcol : DS - 1; const GAS bf16* kp = KIB + (mq0 + j) * 64 + 8 * hh;
                    bf16x8 bfr[4];
#pragma unroll
                    for (int ks = 0; ks < 4; ++ks) bfr[ks] = *(const GAS bf16x8*)(kp + 16 * ks);
                    float sc[2][2];
                    idx_scores(afr, bfr, wq, sc);
                    if (kcol < DS) {
#pragma unroll
                        for (int rt = 0; rt < 2; ++rt)
#pragma unroll
                            for (int jq = 0; jq < 2; ++jq) { const int q = 4 * rt + 2 * hh + jq; SCS[(size_t)(bd * DS + q) * SCS_LD + PAST + kcol] = (kcol <= q) ? sc[rt][jq] : -INFINITY; }
                    }
                }
            }
        }
        SEAM(pb + 1);

        if (IN(pb + 2)) {
            PHASE_REGS
            LDS_LOCAL
            INP(float, a_log, 14) INP(float, state_ssm, 5) INP(float, d_skip, 15)
            for (int rp_ = 0; rp_ < REP_SSEL; ++rp_) for (int qi = bx; qi < MS; qi += G) {
                LAS unsigned* scl = (LAS unsigned*)lds; LAS unsigned* hs = (LAS unsigned*)(lds + 8448 * 4);
                hs[tid] = 0u;
                __syncthreads();
                for (int i = tid; i < PAST + DS; i += NT) { const float sc = SCS[(size_t)qi * SCS_LD + i]; scl[i] = f2key(sc);
                    int bn = __float2int_rd(fmaxf(sc, -512.0f)) + 256; bn = bn < 0 ? 0 : (bn > HB - 1 ? HB - 1 : bn);
                    __hip_atomic_fetch_add(hs + bn, 1u, __ATOMIC_RELAXED, __HIP_MEMORY_SCOPE_WORKGROUP); }
                __syncthreads();
                if (wave == 0) { int ns = PAST + DS; asm volatile("" : "+s"(ns)); topk_select(scl, ns, lane, IDXS + qi * 256, hs); }
                __syncthreads();
            }
            for (int rp_ = 0; rp_ < REP_SSD1; ++rp_) for (int unit = bx; unit < NB * NCH * NG; unit += G) {
                int b, c, g; if (unit < NB * 32 * NG) { b = unit >> 7; c = 1 + ((unit & 127) >> 2); g = unit & 3; } else { const int r = unit - NB * 32 * NG; b = r >> 2; c = 0; g = r & 3; }
                ssd1_unit(lds, tid, XC, DT, a_log + l * NH, SB, DEC, b, c, g);
            }
            for (int rp_ = 0; rp_ < REP_SREC; ++rp_) for (int unit = bx; unit < DB * NH * 2; unit += G) {
                const int bd = unit >> 6, h = (unit >> 1) & 31, p0 = (unit & 1) * 32;
                ssd_unit(lds, tid, XC, DT, DA, (size_t)MP + bd * DS, DS, h, p0, state_ssm + ((size_t)(l * DB + bd) * NH + h) * HP * NST,
                         out + O_SSSM + ((size_t)(l * DB + bd) * NH + h) * HP * NST, YS, d_skip[l * NH + h]);
                __syncthreads();
            }
        }
        SEAM(pb + 2);

        if (IN(pb + 3)) {
            PHASE_REGS
            LDS_LOCAL
            INP(float, cache_k, 2) INP(float, cache_v, 3) INP(int, page_table, 7)
            for (int rp_ = 0; rp_ < REP_SCAN; ++rp_) for (int e = bx * NT + tid; e < NB * NH * 2048; e += G * NT) {
                const int b = e / (NH * 2048), h = (e >> 11) & 31, q = e & 2047;
                f32x4 Hr = {0.f, 0.f, 0.f, 0.f};
#pragma unroll 3
                for (int c = 0; c < NCH; ++c) { const size_t idx = (size_t)(b * NCH + c) * NH + h;
                    { const int p = q >> 5, n = (q & 31) * 4;
                      *(GAS v2u*)(HC + idx * (HP * NST) + ((((p >> 5) * 8 + (n >> 4)) * 2 + ((n >> 3) & 1)) * 32 + (p & 31)) * 8 + (n & 7)) = (v2u){pk2(Hr.x, Hr.y), pk2(Hr.z, Hr.w)}; }
                    const float d = DEC[idx]; const v2u sw = *(const GAS v2u*)(SB + idx * (HP * NST) + q * 4);
                    const f32x4 sv = (f32x4){__uint_as_float(sw.x << 16), __uint_as_float(sw.x & 0xffff0000u), __uint_as_float(sw.y << 16), __uint_as_float(sw.y & 0xffff0000u)};
                    Hr = Hr * d + sv; }
                *(GAS f32x4*)(out + O_PSSM + ((size_t)(l * NB + b) * NH + h) * (HP * NST) + q * 4) = Hr;
            }
            const GAS float* ck = cache_k + (size_t)l * NPOOL * PAGE * 256; const GAS float* cv = cache_v + (size_t)l * NPOOL * PAGE * 256;
            for (int rp_ = 0; rp_ < REP_ATTS; ++rp_) for (int qi = bx; qi < MS; qi += G) attn_sample_query(lds, tid, P1, KVB, ck, cv, page_table, IDXS, YA, qi);
            for (int rp_ = 0; rp_ < REP_ATTP; ++rp_) {
                if (Gl == 256) {
                    const int bsel = (bxl & 7) >> 1, widx = ((((bxl >> 3) * NWAVES) + wave) << 1) | (bxl & 1);
                    for (int tr = widx; tr < LP; tr += 512) attn_prompt_query(lds + wave * 17408, P1, KVB, IDXP, YA, bsel * LP + (LP - 1 - tr), lane);
                } else for (int m = gw; m < MP; m += NGW) attn_prompt_query(lds + wave * 17408, P1, KVB, IDXP, YA, m, lane);
            }
        }
        SEAM(pb + 3);

        if (IN(pb + 4)) {
            PHASE_REGS
            LDS_LOCAL
            INP(float, a_log, 14) INP(float, d_skip, 15) INP(float, ssm_norm_w, 16)
            for (int rp_ = 0; rp_ < REP_SSD3; ++rp_) for (int unit = bx; unit < NB * NCH * NG; unit += G) {
                int b, c, g; if (unit < NB * 32 * NG) { b = unit >> 7; c = 1 + ((unit & 127) >> 2); g = unit & 3; } else { const int r = unit - NB * 32 * NG; b = r >> 2; c = 0; g = r & 3; }
                ssd3_unit(lds, tid, XC, P1, DT, a_log + l * NH, d_skip + l * NH, ssm_norm_w + (size_t)l * DIN, HC, YSN, b, c, g);
            }
            for (int it = gw; it < MS * NG; it += NGW) {
                const int m = MP + (it >> 2), g = it & 3, c0 = g * 512 + lane * 8;
                const GAS float* yp = YS + (size_t)m * DIN + c0; const f32x4 a = *(const GAS f32x4*)yp, b = *(const GAS f32x4*)(yp + 4);
                float z[8]; unpack8(*(const GAS v4u*)(P1 + (size_t)m * LDP1 + C_Z + c0), z);
                float v[8] = {a.x, a.y, a.z, a.w, b.x, b.y, b.z, b.w}; float ss = 0.f;
#pragma unroll
                for (int j = 0; j < 8; ++j) { v[j] = v[j] * (z[j] * sigm(z[j])); ss += v[j] * v[j]; }
                ss = wave_sum(ss);
                const float rstd = 1.0f / sqrtf(ss * (1.0f / 512.0f) + 1e-6f);
                const GAS float* wp = ssm_norm_w + (size_t)l * DIN + c0; const f32x4 wa = *(const GAS f32x4*)wp, wb = *(const GAS f32x4*)(wp + 4);
                *(GAS v4u*)(YSN + (size_t)m * DIN + c0) = (v4u){pk2(v[0] * rstd * wa.x, v[1] * rstd * wa.y), pk2(v[2] * rstd * wa.z, v[3] * rstd * wa.w), pk2(v[4] * rstd * wb.x, v[5] * rstd * wb.y), pk2(v[6] * rstd * wb.z, v[7] * rstd * wb.w)};
            }
        }
        SEAM(pb + 4);

        if (IN(pb + 5)) {
            PHASE_REGS
            LAS unsigned char* lds = lds0;
            pg8::Gemm gm{YSN, (const GAS bf16*)(wl + WL_WSSM), TAIL_R0, D, DIN}; pg8::StaticOrder S; S.init(TAIL_R0, D, Gl, bxl);
            pg8::EpiGate1 E{P1, T1};
            pg8::gemm_phase<pg8::EpiGate1, pg8::StaticOrder, true, true>(lds, gm, S, E, tid);
            tail_gemm<1>(lds, YSN, DIN, (const GAS bf16*)(wl + WL_WSSM), D, P1, T1, MG, H, A2, bxl, Gl, tid);
        }
        if (IN(pb + 6)) {
            PHASE_REGS
            LAS unsigned char* lds = lds0;
            pg8::Gemm gm{YA, (const GAS bf16*)(wl + WL_WATT), TAIL_R0, D, D}; pg8::StaticOrder S; S.init(TAIL_R0, D, Gl, bxl);
            pg8::EpiGate2 E{P1, T1, MG};
            pg8::gemm_phase<pg8::EpiGate2, pg8::StaticOrder, true, true>(lds, gm, S, E, tid);
            tail_gemm<2>(lds, YA, D, (const GAS bf16*)(wl + WL_WATT), D, P1, T1, MG, H, A2, bxl, Gl, tid);
        }
        SEAM(pb + 6);
        if (IN(pb + 7)) {
            PHASE_REGS
            LAS unsigned char* lds = lds0;
            pg8::Gemm gm{MG, (const GAS bf16*)(wl + WL_WOUT), TAIL_R0, D, D}; pg8::StaticOrder S; S.init(TAIL_R0, D, Gl, bxl);
            pg8::EpiResid E{H};
            pg8::gemm_phase<pg8::EpiResid, pg8::StaticOrder, true, true>(lds, gm, S, E, tid);
            tail_gemm<3>(lds, MG, D, (const GAS bf16*)(wl + WL_WOUT), D, P1, T1, MG, H, A2, bxl, Gl, tid);
        }
        SEAM(pb + 7);
        if (IN(pb + 8)) {
            PHASE_REGS
            INP(float, norm2_w, 20)
            for (int m = gw; m < MPAD; m += 4 * NGW) rms_rows4(H, norm2_w + (size_t)l * D, U, m, NGW, MPAD, lane);
        }
        SEAM(pb + 8);
        if (IN(pb + 9)) {
            PHASE_REGS
            LAS unsigned char* lds = lds0;
            pg8::Gemm gm{U, (const GAS bf16*)(wl + WL_WUP), TAIL_R0, DFF, D}; pg8::StaticOrder S; S.init(TAIL_R0, DFF, Gl, bxl);
            pg8::EpiUp E{A2};
            pg8::gemm_phase<pg8::EpiUp, pg8::StaticOrder, true, true>(lds, gm, S, E, tid);
            tail_gemm<4>(lds, U, D, (const GAS bf16*)(wl + WL_WUP), DFF, P1, T1, MG, H, A2, bxl, Gl, tid);
        }
        SEAM(pb + 9);
        if (IN(pb + 10)) {
            PHASE_REGS
            LAS unsigned char* lds = lds0;
            pg8::Gemm gm{A2, (const GAS bf16*)(wl + WL_WDN), TAIL_R0, D, DFF}; pg8::StaticOrder S; S.init(TAIL_R0, D, Gl, bxl);
            pg8::EpiResid E{H};
            pg8::gemm_phase<pg8::EpiResid, pg8::StaticOrder, true, true>(lds, gm, S, E, tid);
            tail_gemm<3>(lds, A2, DFF, (const GAS bf16*)(wl + WL_WDN), D, P1, T1, MG, H, A2, bxl, Gl, tid);
        }
        SEAM(pb + 10);
        if (IN(pb + 11)) {
            PHASE_REGS
            INP(float, norm1_w, 9) INP(float, final_w, 23)
            if (l == 0) { for (int m = gw; m < MPAD; m += 4 * NGW) rms_rows4(H, norm1_w + D, U, m, NGW, MPAD, lane); }
            else {
                for (int m0 = gw; m0 < MR; m0 += 4 * NGW) {
                    const GAS float* src[4]; GAS float* hd[4]; GAS bf16* ud[4]; GAS float* fd[4]; bool live[4];
#pragma unroll
                    for (int r = 0; r < 4; ++r) { const int m = m0 + r * NGW; hd[r] = nullptr; ud[r] = nullptr; fd[r] = nullptr; src[r] = H + (size_t)(m < MR ? m : m0) * D;
                        if (m < MP) { const int b = m / LP, t = m - b * LP; if (t >= NMETA) fd[r] = out + O_YP + ((size_t)b * SEQ + (t - NMETA)) * D; }
                        else if (m < MR) fd[r] = out + O_YS + (size_t)(m - MP) * D;
                        live[r] = fd[r] != nullptr; }
                    rms_rows4g(src, final_w, hd, ud, fd, live, lane);
                }
            }
        }
        if (IN(pb + 11) && IN(1) && l + 1 < args.l_hi) xcd_barrier_ni(bar.bar, bar.x, bar.st, TID_NOW(), (unsigned)G);
    }
#undef IN
#undef SEAM
}

#ifndef MK_PER_PHASE
#define MK_PER_PHASE 0
#endif
extern "C" void kernel_launch(void* const* d_in, const int* in_sizes, int n_in, void* d_out, int out_size, void* d_ws, size_t ws_size, hipStream_t stream) {
    static int grid = 0;
    if (grid == 0) {
        if (n_in != 24 || (size_t)out_size != O_END || ws_size < WS_END) { fprintf(stderr, "kernel_launch: unexpected shapes: n_in %d out %d (want %zu) ws %zu (want %zu)\n", n_in, out_size, (size_t)O_END, ws_size, (size_t)WS_END); grid = -1; return; }
        int dev = 0, cus = 0, per_cu = 0;
        if (hipGetDevice(&dev) != hipSuccess || hipDeviceGetAttribute(&cus, hipDeviceAttributeMultiprocessorCount, dev) != hipSuccess) { grid = -1; return; }
        bool ok = true;
#if MK_PER_PHASE
#define SETA(K) ok = ok && hipFuncSetAttribute((const void*)fwd_t<K, K + 1>, hipFuncAttributeMaxDynamicSharedMemorySize, LDS_BYTES) == hipSuccess
        SETA(0); SETA(1); SETA(2); SETA(3); SETA(4); SETA(5); SETA(6); SETA(7); SETA(8); SETA(9); SETA(10); SETA(11); SETA(12);
#else
        ok = hipFuncSetAttribute((const void*)fwd_t<0, NPH + 1>, hipFuncAttributeMaxDynamicSharedMemorySize, LDS_BYTES) == hipSuccess;
        ok = ok && hipOccupancyMaxActiveBlocksPerMultiprocessor(&per_cu, (const void*)fwd_t<0, NPH + 1>, NT, LDS_BYTES) == hipSuccess && per_cu >= 1;
#endif
        if (!ok) { fprintf(stderr, "kernel_launch: hipFuncSetAttribute / occupancy query failed (per_cu %d)\n", per_cu); (void)hipGetLastError(); grid = -1; return; }
        grid = cus;
    }
    if (grid < 0) return;
    (void)hipMemsetAsync((char*)d_ws + WS_CTL, 0, CTL_ZERO_BYTES, stream);
    Args a{};
    for (int i = 0; i < 24; ++i) a.in[i] = d_in[i];
    a.out = (float*)d_out; a.ws = (unsigned char*)d_ws;
#if MK_PER_PHASE
#define LAUNCH_PH(K) hipLaunchKernelGGL((fwd_t<K, K + 1>), dim3(grid), dim3(NT), LDS_BYTES, stream, a)
    a.l_lo = 0; a.l_hi = 1; LAUNCH_PH(0);
    for (int l = 0; l < 2; ++l) { a.l_lo = l; a.l_hi = l + 1;
        LAUNCH_PH(1); LAUNCH_PH(2); LAUNCH_PH(3); LAUNCH_PH(4); LAUNCH_PH(5); LAUNCH_PH(6); LAUNCH_PH(7); LAUNCH_PH(8); LAUNCH_PH(9); LAUNCH_PH(10); LAUNCH_PH(11); LAUNCH_PH(12); }
#else
    a.l_lo = 0; a.l_hi = 2; hipLaunchKernelGGL((fwd_t<0, NPH + 1>), dim3(grid), dim3(NT), LDS_BYTES, stream, a);
#endif
}
```

```cpp
#include <hip/hip_runtime.h>
#include <cstdio>
#include <cstdint>
#define GAS __attribute__((address_space(1)))
#define LAS __attribute__((address_space(3)))

constexpr int D = 1024, NB = 4, SEQ = 4096, NMETA = 16, LP = SEQ + NMETA, MP = NB * LP, DB = 32, DS = 8, MS = DB * DS, MR = MP + MS, MPAD = 16896;
constexpr int DIN = 2048, CONVD = 3072, NH = 32, HP = 64, NG = 4, NST = 128;
constexpr int DFF = 4096, IN_DIM = 9320;
constexpr int PAST = 8192, PAGE = 128, NPAGES = 64, NPOOL = 2560;
constexpr int NIN = 9472, LDP1 = 9216;
constexpr int C_Z = 0, C_XBC = 2048, C_Q = 5120, C_K = 6144, C_V = 6400, C_QI = 6656, C_GS = 7168, C_GA = 8192;
constexpr int MC_KI = 0, MC_DT = 64, MC_WI = 96;
constexpr int KT_PER_B = (LP + 31) / 32;
static_assert(MP == 16448 && MR == 16704 && MPAD % 256 == 0 && MPAD >= MR, "rows");
namespace pg8 {
#define PG8_LAS __attribute__((address_space(3)))
typedef unsigned short bf16_t;
typedef short bf16x8 __attribute__((ext_vector_type(8)));
typedef float f32x4 __attribute__((ext_vector_type(4)));
typedef unsigned u32x4 __attribute__((ext_vector_type(4)));
constexpr int BM = 256, BK = 64, HALF = 128, HTB = HALF * BK * 2  , STAGE_BYTES = 8 * HTB, NXCD = 8, WGM = 8;

__host__ __device__ __forceinline__ int lds_byte(int r, int c) { const int st = (r >> 4) * 2 + (c >> 5), rr = r & 15, cc = c & 31, ob = rr * 64 + cc * 2; return st * 1024 + (ob ^ (((ob >> 9) & 1) << 5)); }
__host__ __device__ __forceinline__ void stage_rc(int b, int& R, int& C) { const int st = b / 1024, sb = b % 1024, swz = sb ^ (((sb >> 9) & 1) << 5); R = (st >> 1) * 16 + swz / 64; C = (st & 1) * 32 + (swz % 64) / 2; }
__host__ __device__ __forceinline__ int perm32(int rho) { const int n = rho >> 4, i = rho & 15; return 8 * (i >> 2) + 4 * n + (i & 3); }

struct Unit { int pm, pn; };
struct Gemm { const GAS bf16_t* A; const GAS bf16_t* Bt; int M, N, K; };

struct StaticOrder {
    int nM, nN, nwg, G, c;
    __host__ __device__ void init(int M, int N, int G_, int c_) { nM = M / BM; nN = N / BM; nwg = nM * nN; G = G_; c = c_; }
    __host__ __device__ bool next(int i, Unit& u) const {
        const long L = (long)i * G + c; if (L >= nwg) return false;
        int wgid = (int)L; { const int q = nwg / NXCD, r = nwg % NXCD, xcd = wgid % NXCD, off = wgid / NXCD; wgid = (xcd < r ? xcd * (q + 1) : r * (q + 1) + (xcd - r) * q) + off; }
        const int nig = WGM * nN, gid = wgid / nig, fm = gid * WGM, gsz = (nM - fm) < WGM ? (nM - fm) : WGM;
        u.pm = fm + ((wgid % nig) % gsz); u.pn = (wgid % nig) / gsz; return true;
    }
    __device__ __forceinline__ void a_ready(const Unit&) const {}
    __device__ __forceinline__ void done(const Unit&) const {}
};

__device__ __forceinline__ unsigned cvt_pk_bf16(float lo, float hi) { unsigned r; asm volatile("v_cvt_pk_bf16_f32 %0, %1, %2" : "=v"(r) : "v"(lo), "v"(hi)); return r; }

__device__ __forceinline__ void unpack8(const u32x4 w, float (&f)[8]) {
    f[0] = __uint_as_float(w.x << 16); f[1] = __uint_as_float(w.x & 0xffff0000u); f[2] = __uint_as_float(w.y << 16); f[3] = __uint_as_float(w.y & 0xffff0000u);
    f[4] = __uint_as_float(w.z << 16); f[5] = __uint_as_float(w.z & 0xffff0000u); f[6] = __uint_as_float(w.w << 16); f[7] = __uint_as_float(w.w & 0xffff0000u);
}
__device__ __forceinline__ u32x4 pack8(const f32x4 v0, const f32x4 v1) { u32x4 w; w.x = cvt_pk_bf16(v0[0], v0[1]); w.y = cvt_pk_bf16(v0[2], v0[3]); w.z = cvt_pk_bf16(v1[0], v1[1]); w.w = cvt_pk_bf16(v1[2], v1[3]); return w; }
__device__ __forceinline__ float sigm(float x) { return __builtin_amdgcn_rcpf(1.0f + __expf(-x)); }

struct EpiIn {
    static constexpr bool PERM = true, AFTER_DRAIN = false;
    GAS bf16_t* P1; GAS bf16_t* kvb; GAS float* misc; GAS bf16_t* kib; GAS bf16_t* kib2; GAS float *pk, *pv, *pki, *sk, *sv, *ski;
    __device__ __forceinline__ void operator()(const f32x4 (&acc)[2][2][4][2], const Unit& u, int wr, int wc, int fr, int fq) const {
        const int row0 = u.pm * BM + wr * 64 + fr, lc0 = wc * 32 + 8 * fq;
#pragma unroll
        for (int ai = 0; ai < 2; ++ai)
#pragma unroll
            for (int m = 0; m < 4; ++m) {
                const int row = row0 + ai * HALF + m * 16;
#pragma unroll
                for (int bj = 0; bj < 2; ++bj) {
                    const f32x4 v0 = acc[ai][bj][m][0], v1 = acc[ai][bj][m][1];
                    const int lc = lc0 + bj * HALF;
                    if (u.pn < 36) {
                        if (u.pn == 24 || u.pn == 25) *(GAS u32x4*)(kvb + (size_t)row * 512 + (u.pn - 24) * BM + lc) = pack8(v0, v1);
                        else *(GAS u32x4*)(P1 + (size_t)row * LDP1 + u.pn * BM + lc) = pack8(v0, v1);
                        if (u.pn == 24) {
                            if (row < MP) { GAS float* dst = pk + (size_t)row * 256 + lc; *(GAS f32x4*)dst = v0; *(GAS f32x4*)(dst + 4) = v1; }
                            else if (row < MR) { GAS float* dst = sk + (size_t)(row - MP) * 256 + lc; *(GAS f32x4*)dst = v0; *(GAS f32x4*)(dst + 4) = v1; }
                        } else if (u.pn == 25) {
                            if (row < MP) { GAS float* dst = pv + (size_t)row * 256 + lc; *(GAS f32x4*)dst = v0; *(GAS f32x4*)(dst + 4) = v1; }
                            else if (row < MR) { GAS float* dst = sv + (size_t)(row - MP) * 256 + lc; *(GAS f32x4*)dst = v0; *(GAS f32x4*)(dst + 4) = v1; }
                        }
                    } else {
                        if (lc < 128) { GAS float* d = misc + (size_t)row * 128 + lc; *(GAS f32x4*)d = v0; *(GAS f32x4*)(d + 4) = v1; }
                        if (lc < 64) {
                            *(GAS u32x4*)(kib + (size_t)row * 64 + lc) = pack8(v0, v1);
                            if (row < MP) { const int b = row / LP, t = row - b * LP;
                                *(GAS u32x4*)(kib2 + ((size_t)(b * KT_PER_B + (t >> 5)) * 2048 + (lc >> 4) * 512 + ((lc >> 3) & 1) * 256 + (t & 31) * 8)) = pack8(v0, v1); }
                            if (row < MP) { GAS float* dst = pki + (size_t)row * 64 + lc; *(GAS f32x4*)dst = v0; *(GAS f32x4*)(dst + 4) = v1; }
                            else if (row < MR) { GAS float* dst = ski + (size_t)(row - MP) * 64 + lc; *(GAS f32x4*)dst = v0; *(GAS f32x4*)(dst + 4) = v1; }
                        }
                    }
                }
            }
    }
};
struct EpiGate1 {
    static constexpr bool PERM = true, AFTER_DRAIN = false;
    const GAS bf16_t* P1; GAS bf16_t* T1;
    __device__ __forceinline__ void operator()(const f32x4 (&acc)[2][2][4][2], const Unit& u, int wr, int wc, int fr, int fq) const {
        const int row0 = u.pm * BM + wr * 64 + fr, col0 = u.pn * BM + wc * 32 + 8 * fq;
#pragma unroll
        for (int ai = 0; ai < 2; ++ai)
#pragma unroll
            for (int m = 0; m < 4; ++m) {
                const int row = row0 + ai * HALF + m * 16;
#pragma unroll
                for (int bj = 0; bj < 2; ++bj) {
                    const int col = col0 + bj * HALF;
                    float g[8]; unpack8(*(const GAS u32x4*)(P1 + (size_t)row * LDP1 + C_GS + col), g);
                    f32x4 v0 = acc[ai][bj][m][0], v1 = acc[ai][bj][m][1];
#pragma unroll
                    for (int e = 0; e < 4; ++e) { v0[e] *= sigm(g[e]); v1[e] *= sigm(g[4 + e]); }
                    *(GAS u32x4*)(T1 + (size_t)row * 1024 + col) = pack8(v0, v1);
                }
            }
    }
};
struct EpiGate2 {
    static constexpr bool PERM = true, AFTER_DRAIN = false;
    const GAS bf16_t* P1; const GAS bf16_t* T1; GAS bf16_t* MG;
    __device__ __forceinline__ void operator()(const f32x4 (&acc)[2][2][4][2], const Unit& u, int wr, int wc, int fr, int fq) const {
        const int row0 = u.pm * BM + wr * 64 + fr, col0 = u.pn * BM + wc * 32 + 8 * fq;
#pragma unroll
        for (int ai = 0; ai < 2; ++ai)
#pragma unroll
            for (int m = 0; m < 4; ++m) {
                const int row = row0 + ai * HALF + m * 16;
#pragma unroll
                for (int bj = 0; bj < 2; ++bj) {
                    const int col = col0 + bj * HALF;
                    float g[8]; unpack8(*(const GAS u32x4*)(P1 + (size_t)row * LDP1 + C_GA + col), g);
                    float tt[8]; unpack8(*(const GAS u32x4*)(T1 + (size_t)row * 1024 + col), tt); const f32x4 t0 = (f32x4){tt[0], tt[1], tt[2], tt[3]}, t1 = (f32x4){tt[4], tt[5], tt[6], tt[7]};
                    f32x4 v0 = acc[ai][bj][m][0], v1 = acc[ai][bj][m][1];
#pragma unroll
                    for (int e = 0; e < 4; ++e) { v0[e] = t0[e] + v0[e] * sigm(g[e]); v1[e] = t1[e] + v1[e] * sigm(g[4 + e]); }
                    *(GAS u32x4*)(MG + (size_t)row * 1024 + col) = pack8(v0, v1);
                }
            }
    }
};
struct EpiResid {
    static constexpr bool PERM = true, AFTER_DRAIN = false;
    GAS float* H;
    __device__ __forceinline__ void operator()(const f32x4 (&acc)[2][2][4][2], const Unit& u, int wr, int wc, int fr, int fq) const {
        const int row0 = u.pm * BM + wr * 64 + fr, col0 = u.pn * BM + wc * 32 + 8 * fq;
#pragma unroll
        for (int ai = 0; ai < 2; ++ai)
#pragma unroll
            for (int m = 0; m < 4; ++m) {
                const int row = row0 + ai * HALF + m * 16;
#pragma unroll
                for (int bj = 0; bj < 2; ++bj) {
                    GAS float* d = H + (size_t)row * 1024 + col0 + bj * HALF;
                    const f32x4 h0 = *(const GAS f32x4*)d, h1 = *(const GAS f32x4*)(d + 4);
                    *(GAS f32x4*)d = h0 + acc[ai][bj][m][0]; *(GAS f32x4*)(d + 4) = h1 + acc[ai][bj][m][1];
                }
            }
    }
};
struct EpiUp {
    static constexpr bool PERM = true, AFTER_DRAIN = false;
    GAS bf16_t* A2;
    __device__ __forceinline__ void operator()(const f32x4 (&acc)[2][2][4][2], const Unit& u, int wr, int wc, int fr, int fq) const {
        const int row0 = u.pm * BM + wr * 64 + fr, col0 = u.pn * BM + wc * 32 + 8 * fq;
#pragma unroll
        for (int ai = 0; ai < 2; ++ai)
#pragma unroll
            for (int m = 0; m < 4; ++m) {
                const int row = row0 + ai * HALF + m * 16;
#pragma unroll
                for (int bj = 0; bj < 2; ++bj) {
                    f32x4 v0 = acc[ai][bj][m][0], v1 = acc[ai][bj][m][1];
#pragma unroll
                    for (int e = 0; e < 4; ++e) { const float a = fmaxf(v0[e], 0.f), b = fmaxf(v1[e], 0.f); v0[e] = a * a; v1[e] = b * b; }
                    *(GAS u32x4*)(A2 + (size_t)row * DFF + col0 + bj * HALF) = pack8(v0, v1);
                }
            }
    }
};
template <class Epi, class Sched, bool ALIGN_EPI = false, bool SP2 = false>
__device__ __forceinline__ void gemm_phase(PG8_LAS unsigned char* lds, const Gemm g, const Sched& S, const Epi& E, const int tid) {
    const int wid = __builtin_amdgcn_readfirstlane(tid >> 6), lane = tid & 63, wr = wid >> 2, wc = wid & 3, fr = lane & 15, fq = lane >> 4;
    const int K = g.K, nt = K / BK;
    unsigned voffA[2], voffB[2];
#pragma unroll
    for (int i = 0; i < 2; ++i) { int R, C; stage_rc(tid * 16 + i * 8192, R, C); const int Rb = Epi::PERM ? ((R & ~31) + perm32(R & 31)) : R;
        voffA[i] = (unsigned)(R * K + C) * 2u; voffB[i] = (unsigned)(Rb * K + C) * 2u; }
    const size_t kstep = (size_t)(BK * 2);
    const size_t hstep = (size_t)HALF * K * 2;
    const size_t tstep = 2 * hstep;
    const unsigned ldsw = (unsigned)wid * 1024u;
    const int aoff = lds_byte(wr * 64 + fr, fq * 8), boff = lds_byte(wc * 32 + fr, fq * 8);
#define PG8_SA(b, h) (((b) * 2 + (h)) * HTB)
#define PG8_SB(b, h) ((4 + (b) * 2 + (h)) * HTB)
#define PG8_STAGE(bufoff, gbase, voff) do { _Pragma("unroll") for (int _i = 0; _i < 2; ++_i) \
        __builtin_amdgcn_global_load_lds((const GAS unsigned*)((const GAS char*)(gbase) + (voff)[_i]), (PG8_LAS unsigned*)(lds + (bufoff) + ldsw + _i * 8192), 16, 0, 0); } while (0)
#define PG8_LDA(dst, b, h) do { _Pragma("unroll") for (int m = 0; m < 4; ++m) _Pragma("unroll") for (int k = 0; k < 2; ++k) dst[m][k] = *(const PG8_LAS bf16x8*)(lds + PG8_SA(b, h) + aoff + m * 2048 + k * 1024); } while (0)
#define PG8_LDB(dst, b, h) do { _Pragma("unroll") for (int n = 0; n < 2; ++n) _Pragma("unroll") for (int k = 0; k < 2; ++k) dst[n][k] = *(const PG8_LAS bf16x8*)(lds + PG8_SB(b, h) + boff + n * 2048 + k * 1024); } while (0)
#define PG8_MMA(ai, bj, At, Bt) do { __builtin_amdgcn_s_setprio(1); _Pragma("unroll") for (int m = 0; m < 4; ++m) _Pragma("unroll") for (int n = 0; n < 2; ++n) _Pragma("unroll") for (int k = 0; k < 2; ++k) \
        acc[ai][bj][m][n] = __builtin_amdgcn_mfma_f32_16x16x32_bf16(Bt[n][k], At[m][k], acc[ai][bj][m][n], 0, 0, 0); __builtin_amdgcn_s_setprio(0); } while (0)
#define PG8_WAIT_V(n) asm volatile("s_waitcnt vmcnt(" #n ")" ::: "memory")
#define PG8_WAIT_L(n) asm volatile("s_waitcnt lgkmcnt(" #n ")" ::: "memory")
#define PG8_BAR __builtin_amdgcn_s_barrier()
#define PG8_SCHED __builtin_amdgcn_sched_barrier(0)
    Unit cur, nxt; int ui = 0;
    if (!S.next(0, cur)) return;
    f32x4 acc[2][2][4][2];
#pragma unroll
    for (int a = 0; a < 2; ++a)
#pragma unroll
        for (int b = 0; b < 2; ++b)
#pragma unroll
            for (int m = 0; m < 4; ++m)
#pragma unroll
                for (int n = 0; n < 2; ++n) acc[a][b][m][n] = (f32x4){0.f, 0.f, 0.f, 0.f};
    bf16x8 At[4][2], B0[2][2], B1[2][2];
    const GAS char* cA = (const GAS char*)g.A + (size_t)cur.pm * tstep; const GAS char* cB = (const GAS char*)g.Bt + (size_t)cur.pn * tstep;
    S.a_ready(cur);
    if constexpr (SP2) {
        PG8_STAGE(PG8_SB(0, 0), cB, voffB); PG8_STAGE(PG8_SB(0, 1), cB + hstep, voffB); PG8_STAGE(PG8_SA(0, 0), cA, voffA); PG8_STAGE(PG8_SA(0, 1), cA + hstep, voffA);
        if (wr == 1) PG8_BAR;
        PG8_WAIT_V(2); PG8_BAR;
        PG8_STAGE(PG8_SB(1, 0), cB + kstep, voffB); PG8_STAGE(PG8_SA(1, 0), cA + kstep, voffA); PG8_STAGE(PG8_SB(1, 1), cB + hstep + kstep, voffB);
        PG8_WAIT_V(6); PG8_BAR;
    } else {
        PG8_STAGE(PG8_SB(0, 0), cB, voffB); PG8_STAGE(PG8_SA(0, 0), cA, voffA); PG8_STAGE(PG8_SB(0, 1), cB + hstep, voffB); PG8_STAGE(PG8_SA(0, 1), cA + hstep, voffA);
        if (wr == 1) PG8_BAR;
        PG8_WAIT_V(4); PG8_BAR;
        PG8_STAGE(PG8_SB(1, 0), cB + kstep, voffB); PG8_STAGE(PG8_SA(1, 0), cA + kstep, voffA); PG8_STAGE(PG8_SB(1, 1), cB + hstep + kstep, voffB);
        PG8_WAIT_V(6); PG8_BAR;
    }
    for (;;) {
        const bool has_next = S.next(ui + 1, nxt);
        const GAS char* nA = has_next ? (const GAS char*)g.A + (size_t)nxt.pm * tstep : cA; const GAS char* nB = has_next ? (const GAS char*)g.Bt + (size_t)nxt.pn * tstep : cB;
        for (int t = 0; t < nt; t += 2) {
            const bool last = (t == nt - 2);
            const GAS char* a1 = cA + (size_t)(t + 1) * kstep;
            const GAS char* a2 = last ? nA : cA + (size_t)(t + 2) * kstep; const GAS char* b2 = last ? nB : cB + (size_t)(t + 2) * kstep;
            const GAS char* a3 = a2 + kstep; const GAS char* b3 = b2 + kstep;
            if (last && has_next) S.a_ready(nxt);
            if constexpr (SP2) {
            PG8_LDB(B0, 0, 0); PG8_LDB(B1, 0, 1); PG8_SCHED; PG8_LDA(At, 0, 0); PG8_STAGE(PG8_SA(1, 1), a1 + hstep, voffA);
            PG8_WAIT_V(8); PG8_WAIT_L(0); PG8_BAR; PG8_MMA(0, 0, At, B0); PG8_MMA(0, 1, At, B1); PG8_BAR; PG8_SCHED;
            PG8_LDA(At, 0, 1); PG8_STAGE(PG8_SB(0, 0), b2, voffB); PG8_STAGE(PG8_SB(0, 1), b2 + hstep, voffB); PG8_STAGE(PG8_SA(0, 0), a2, voffA);
            PG8_WAIT_V(8); PG8_WAIT_L(0); PG8_BAR; PG8_MMA(1, 0, At, B0); PG8_MMA(1, 1, At, B1); PG8_BAR; PG8_SCHED;
            PG8_LDB(B0, 1, 0); PG8_LDB(B1, 1, 1); PG8_SCHED; PG8_LDA(At, 1, 0); PG8_STAGE(PG8_SA(0, 1), a2 + hstep, voffA);
            PG8_WAIT_V(8); PG8_WAIT_L(0); PG8_BAR; PG8_MMA(0, 0, At, B0); PG8_MMA(0, 1, At, B1); PG8_BAR; PG8_SCHED;
            PG8_LDA(At, 1, 1); PG8_STAGE(PG8_SB(1, 0), b3, voffB); PG8_STAGE(PG8_SB(1, 1), b3 + hstep, voffB); PG8_STAGE(PG8_SA(1, 0), a3, voffA);
            PG8_WAIT_V(8); PG8_WAIT_L(0); PG8_BAR; PG8_MMA(1, 0, At, B0); PG8_MMA(1, 1, At, B1); PG8_BAR; PG8_SCHED;
            } else {
            PG8_LDB(B0, 0, 0); PG8_SCHED; PG8_LDA(At, 0, 0); PG8_STAGE(PG8_SA(1, 1), a1 + hstep, voffA);
            PG8_WAIT_L(8); PG8_BAR; PG8_WAIT_L(0); PG8_MMA(0, 0, At, B0); PG8_BAR; PG8_SCHED;
            PG8_LDB(B1, 0, 1); PG8_STAGE(PG8_SB(0, 0), b2, voffB);
            PG8_BAR; PG8_WAIT_L(0); PG8_MMA(0, 1, At, B1); PG8_BAR;
            PG8_LDA(At, 0, 1); PG8_STAGE(PG8_SA(0, 0), a2, voffA);
            PG8_BAR; PG8_WAIT_L(0); PG8_MMA(1, 0, At, B0); PG8_BAR; PG8_SCHED;
            PG8_STAGE(PG8_SB(0, 1), b2 + hstep, voffB);
            PG8_WAIT_V(6); PG8_BAR; PG8_MMA(1, 1, At, B1); PG8_BAR;
            PG8_LDB(B0, 1, 0); PG8_SCHED; PG8_LDA(At, 1, 0); PG8_STAGE(PG8_SA(0, 1), a2 + hstep, voffA);
            PG8_WAIT_L(8); PG8_BAR; PG8_WAIT_L(0); PG8_MMA(0, 0, At, B0); PG8_BAR; PG8_SCHED;
            PG8_LDB(B1, 1, 1); PG8_STAGE(PG8_SB(1, 0), b3, voffB);
            PG8_BAR; PG8_WAIT_L(0); PG8_MMA(0, 1, At, B1); PG8_BAR;
            PG8_LDA(At, 1, 1); PG8_STAGE(PG8_SA(1, 0), a3, voffA);
            PG8_BAR; PG8_WAIT_L(0); PG8_MMA(1, 0, At, B0); PG8_BAR; PG8_SCHED;
            PG8_STAGE(PG8_SB(1, 1), b3 + hstep, voffB);
            PG8_WAIT_V(6); PG8_BAR; PG8_MMA(1, 1, At, B1); PG8_BAR;
            }
        }
        if constexpr (ALIGN_EPI) { if (wr == 0) PG8_BAR; }
        if constexpr (!Epi::AFTER_DRAIN) { E(acc, cur, wr, wc, fr, fq); S.done(cur); }
        if (!has_next) break;
#pragma unroll
        for (int a = 0; a < 2; ++a)
#pragma unroll
            for (int b = 0; b < 2; ++b)
#pragma unroll
                for (int m = 0; m < 4; ++m)
#pragma unroll
                    for (int n = 0; n < 2; ++n) acc[a][b][m][n] = (f32x4){0.f, 0.f, 0.f, 0.f};
        cur = nxt; cA = nA; cB = nB; ++ui;
        if constexpr (ALIGN_EPI) { if (wr == 1) PG8_BAR; }
    }
    PG8_WAIT_V(0);
    if constexpr (!ALIGN_EPI) { if (wr == 0) PG8_BAR; }
    PG8_BAR;
    if constexpr (Epi::AFTER_DRAIN) { E.fused(acc, cur, wr, wc, fr, fq, lds, wid, lane); S.done(cur); }
#undef PG8_SA
#undef PG8_SB
#undef PG8_STAGE
#undef PG8_LDA
#undef PG8_LDB
#undef PG8_MMA
#undef PG8_WAIT_V
#undef PG8_WAIT_L
#undef PG8_BAR
#undef PG8_SCHED
}
}

typedef unsigned short bf16;
typedef unsigned v4u __attribute__((ext_vector_type(4)));
typedef float f32x4 __attribute__((ext_vector_type(4)));
typedef short bf16x8 __attribute__((ext_vector_type(8)));
typedef GAS unsigned gu32;
typedef GAS unsigned long long gu64;
#define RLX_AGENT __ATOMIC_RELAXED, __HIP_MEMORY_SCOPE_AGENT
#define LDS_WAIT() asm volatile("s_waitcnt lgkmcnt(0)" ::: "memory")
#define VM_WAIT() asm volatile("s_waitcnt vmcnt(0)" ::: "memory")
__device__ __forceinline__ unsigned long long rt() { return __builtin_amdgcn_s_memrealtime(); }
typedef float f32x2_cv __attribute__((ext_vector_type(2))); typedef __bf16 bf16x2_cv __attribute__((ext_vector_type(2)));
__device__ __forceinline__ unsigned pk2(float lo, float hi) { const f32x2_cv v = {lo, hi}; const bf16x2_cv c = __builtin_convertvector(v, bf16x2_cv); return __builtin_bit_cast(unsigned, c); }
__device__ __forceinline__ unsigned f2bf(float f) { return pk2(f, 0.f) & 0xffffu; }

#define XB_TMO      128
#define XB_XCNT(j)  (256  + 64 * (j))
#define XB_XSUB(j)  (1280 + 64 * (j))
#define XB_XGEN(j)  (2304 + 64 * (j))
#define XB_TOP      3328
#define XB_TOPGEN   3392
#define XCD_BAR_WORDS 3456
#define XB_SPIN_CAP (1u << 18)

__device__ __forceinline__ unsigned xb_ld(unsigned* p)              { return __hip_atomic_load(p, __ATOMIC_RELAXED, __HIP_MEMORY_SCOPE_AGENT); }
__device__ __forceinline__ unsigned xb_add(unsigned* p, unsigned v) { return __hip_atomic_fetch_add(p, v, __ATOMIC_RELAXED, __HIP_MEMORY_SCOPE_AGENT); }
__device__ __forceinline__ unsigned xb_xcc_id() { return (unsigned)__builtin_amdgcn_s_getreg((3 << 11) | 20) & 0xFu; }
#define XB_SPIN(cond, bar) do { unsigned _sp = 0; while (cond) { __builtin_amdgcn_s_sleep(1); \
    if ((++_sp & 255u) == 0u) { if (xb_ld(&(bar)[XB_TMO])) break; if (_sp > XB_SPIN_CAP) { atomicAdd(&(bar)[XB_TMO], 1u); break; } } } } while (0)

struct XcdBarrier {
    unsigned* bar; unsigned x;
    volatile LAS unsigned* st;
};

__device__ __forceinline__ XcdBarrier xcd_barrier_post(unsigned* bar, volatile LAS unsigned* st) {
    XcdBarrier b; b.bar = bar; b.x = xb_xcc_id(); b.st = st;
    if (threadIdx.x == 0) (void)xb_add(&bar[XB_XCNT(b.x)], 1u);
    return b;
}
__device__ __forceinline__ void xcd_barrier_complete(unsigned* bar, unsigned x, unsigned& nloc, unsigned& nx, const unsigned G) {
    unsigned sum, cnt, mine, sp = 0u;
    for (;;) {
        sum = 0u; cnt = 0u; mine = 0u;
#pragma unroll 1
        for (unsigned j = 0; j < 16; ++j) { const unsigned c = xb_ld(&bar[XB_XCNT(j)]); sum += c; cnt += (c > 0u) ? 1u : 0u; mine = (j == x) ? c : mine; }
        if (sum == G) break;
        __builtin_amdgcn_s_sleep(1);
        if ((++sp & 255u) == 0u) { if (xb_ld(&bar[XB_TMO])) break; if (sp > XB_SPIN_CAP) { atomicAdd(&bar[XB_TMO], 1u); break; } }
    }
    nloc = mine > 0u ? mine : 1u; nx = cnt > 0u ? cnt : 1u;
}

__device__ __forceinline__ void xcd_barrier(const XcdBarrier& b, const int tid_, const unsigned G_) {
    asm volatile("s_waitcnt vmcnt(0)" ::: "memory");
    __syncthreads();
    if (tid_ == 0) {
        unsigned* bar = b.bar;
        __builtin_amdgcn_s_waitcnt(0);
        unsigned nloc = b.st[0], nx = b.st[1];
        if (nloc == 0u) { xcd_barrier_complete(bar, b.x, nloc, nx, G_); b.st[0] = nloc; b.st[1] = nx; }
        const unsigned old = xb_add(&bar[XB_XSUB(b.x)], 1u);
        const unsigned gen = old / nloc;
        if (old + 1u == (gen + 1u) * nloc) {
            __builtin_amdgcn_fence(__ATOMIC_RELEASE, "agent");
            asm volatile("s_waitcnt vmcnt(0)" ::: "memory");
            const unsigned og = xb_add(&bar[XB_TOP], 1u);
            const unsigned tg = og / nx;
            if (og + 1u == (tg + 1u) * nx) xb_add(&bar[XB_TOPGEN], 1u);
            else XB_SPIN(xb_ld(&bar[XB_TOPGEN]) == tg, bar);
            __builtin_amdgcn_fence(__ATOMIC_ACQUIRE, "agent");
            xb_add(&bar[XB_XGEN(b.x)], 1u);
            asm volatile("s_waitcnt vmcnt(0)" ::: "memory");
        } else {
            XB_SPIN(xb_ld(&bar[XB_XGEN(b.x)]) == gen, bar);
            __builtin_amdgcn_fence(__ATOMIC_ACQUIRE, "agent");
            asm volatile("s_waitcnt vmcnt(0)" ::: "memory");
        }
    }
    __syncthreads();
}

constexpr size_t O_YP = 0, O_YS = O_YP + (size_t)NB * SEQ * D, O_PK = O_YS + (size_t)MS * D, O_PV = O_PK + 2ull * MP * 256, O_PKI = O_PV + 2ull * MP * 256,
                 O_PSSM = O_PKI + 2ull * MP * 64, O_PCONV = O_PSSM + 2ull * NB * NH * HP * NST, O_SK = O_PCONV + 2ull * NB * 3 * CONVD, O_SV = O_SK + 2ull * MS * 256,
                 O_SKI = O_SV + 2ull * MS * 256, O_SSSM = O_SKI + 2ull * MS * 64, O_SCONV = O_SSSM + 2ull * DB * NH * HP * NST, O_END = O_SCONV + 2ull * DB * 3 * CONVD;

constexpr size_t MiB = 1u << 20;
constexpr size_t al(size_t x) { return (x + MiB - 1) / MiB * MiB; }
constexpr size_t WS_CTL = 0, CTL_ZERO_BYTES = 1 * MiB;
constexpr size_t SZ_WIN = (size_t)NIN * D * 2, SZ_WSSM = (size_t)D * DIN * 2, SZ_WATT = (size_t)D * D * 2, SZ_WOUT = (size_t)D * D * 2, SZ_WUP = (size_t)DFF * D * 2, SZ_WDN = (size_t)D * DFF * 2;
constexpr size_t WL_WIN = 0, WL_WSSM = al(WL_WIN + SZ_WIN), WL_WATT = al(WL_WSSM + SZ_WSSM), WL_WOUT = al(WL_WATT + SZ_WATT), WL_WUP = al(WL_WOUT + SZ_WOUT), WL_WDN = al(WL_WUP + SZ_WUP), WL_SIZE = al(WL_WDN + SZ_WDN);
constexpr size_t WS_W = 1 * MiB;
constexpr size_t WS_H = al(WS_W + 2 * WL_SIZE);
constexpr size_t WS_U = al(WS_H + (size_t)MPAD * D * 4);
constexpr size_t WS_P1 = al(WS_U + (size_t)MPAD * D * 2);
constexpr size_t WS_MISC = al(WS_P1 + (size_t)MPAD * LDP1 * 2);
constexpr size_t WS_KIB = al(WS_MISC + (size_t)MPAD * 128 * 4);
constexpr size_t WS_XC = al(WS_KIB + (size_t)MPAD * 64 * 2);
constexpr size_t WS_DT = al(WS_XC + (size_t)MPAD * CONVD * 2);
constexpr size_t WS_DA = al(WS_DT + (size_t)MPAD * 32 * 4);
constexpr size_t WS_YS = al(WS_DA + (size_t)MPAD * 32 * 4);
constexpr size_t WS_YSN = al(WS_YS + (size_t)MPAD * DIN * 4);
constexpr size_t WS_YA = al(WS_YSN + (size_t)MPAD * DIN * 2);
constexpr size_t WS_T1 = al(WS_YA + (size_t)MPAD * D * 2);
constexpr size_t WS_MG = al(WS_T1 + (size_t)MPAD * D * 4);
constexpr size_t WS_A2 = al(WS_MG + (size_t)MPAD * D * 2);
constexpr size_t WS_IDXP = al(WS_A2 + (size_t)MPAD * DFF * 2);
constexpr size_t WS_IDXS = al(WS_IDXP + (size_t)MP * 256 * 2);
constexpr int SCS_LD = 8256;
constexpr size_t WS_SCS = al(WS_IDXS + (size_t)MS * 256 * 4);
constexpr size_t WS_SB = al(WS_SCS + (size_t)MS * SCS_LD * 4);
constexpr size_t WS_DEC = al(WS_SB + (size_t)NB * 33 * NH * HP * NST * 4);
constexpr size_t WS_HC = al(WS_DEC + (size_t)NB * 33 * NH * 4);
constexpr size_t WS_KVB = al(WS_HC + (size_t)NB * 33 * NH * HP * NST * 2);
constexpr size_t WS_KIB2 = al(WS_KVB + (size_t)MPAD * 512 * 2);
constexpr size_t WS_END = al(WS_KIB2 + (size_t)NB * KT_PER_B * 2048 * 2);
constexpr int CW_BAR = 4096;

constexpr int LDS_BYTES = 159744, LDSCTL_OFF = 155648, MISC_OFF = LDSCTL_OFF + 320;
constexpr int NWAVES = 8, NT = 512;
typedef float f32x16 __attribute__((ext_vector_type(16)));
typedef unsigned v2u __attribute__((ext_vector_type(2)));

__device__ __forceinline__ float dpp_f(float v, const int ctrl_unused) { return v; }
#define DPPF(v, ctrl, rmask, bc) __uint_as_float((unsigned)__builtin_amdgcn_update_dpp(0, (int)__float_as_uint(v), ctrl, rmask, 0xf, bc))
__device__ __forceinline__ float row16_sum(float v) {
    v += DPPF(v, 0xB1, 0xf, true); v += DPPF(v, 0x4E, 0xf, true); v += DPPF(v, 0x141, 0xf, true); v += DPPF(v, 0x140, 0xf, true); return v;
}
__device__ __forceinline__ float wave_sum(float v) {
    v = row16_sum(v);
    v += DPPF(v, 0x142, 0xa, false); v += DPPF(v, 0x143, 0xc, false);
    return __uint_as_float((unsigned)__builtin_amdgcn_readlane((int)__float_as_uint(v), 63));
}
__device__ __forceinline__ float wave_max(float v) {
    v = fmaxf(v, __uint_as_float((unsigned)__builtin_amdgcn_update_dpp((int)__float_as_uint(v), (int)__float_as_uint(v), 0xB1, 0xf, 0xf, false)));
    v = fmaxf(v, __uint_as_float((unsigned)__builtin_amdgcn_update_dpp((int)__float_as_uint(v), (int)__float_as_uint(v), 0x4E, 0xf, 0xf, false)));
    v = fmaxf(v, __uint_as_float((unsigned)__builtin_amdgcn_update_dpp((int)__float_as_uint(v), (int)__float_as_uint(v), 0x141, 0xf, 0xf, false)));
    v = fmaxf(v, __uint_as_float((unsigned)__builtin_amdgcn_update_dpp((int)__float_as_uint(v), (int)__float_as_uint(v), 0x140, 0xf, 0xf, false)));
    v = fmaxf(v, __uint_as_float((unsigned)__builtin_amdgcn_update_dpp((int)__float_as_uint(v), (int)__float_as_uint(v), 0x142, 0xa, 0xf, false)));
    v = fmaxf(v, __uint_as_float((unsigned)__builtin_amdgcn_update_dpp((int)__float_as_uint(v), (int)__float_as_uint(v), 0x143, 0xc, 0xf, false)));
    return __uint_as_float((unsigned)__builtin_amdgcn_readlane((int)__float_as_uint(v), 63));
}
__device__ __forceinline__ void unpack8(const v4u w, float (&f)[8]) {
    f[0] = __uint_as_float(w.x << 16); f[1] = __uint_as_float(w.x & 0xffff0000u); f[2] = __uint_as_float(w.y << 16); f[3] = __uint_as_float(w.y & 0xffff0000u);
    f[4] = __uint_as_float(w.z << 16); f[5] = __uint_as_float(w.z & 0xffff0000u); f[6] = __uint_as_float(w.w << 16); f[7] = __uint_as_float(w.w & 0xffff0000u);
}
__device__ __forceinline__ float sigm(float x) { return __builtin_amdgcn_rcpf(1.0f + __expf(-x)); }

__device__ __forceinline__ int win_src_col(int n) {
    if (n < 5120) return n;
    if (n < 6144) return n - 5120 + 5152;
    if (n < 6400) return n - 6144 + 6176;
    if (n < 6656) return n - 6400 + 6432;
    if (n < 7168) return n - 6656 + 6688;
    if (n < 8192) return n - 7168 + 7272;
    if (n < 9216) return n - 8192 + 8296;
    if (n < 9280) return n - 9216 + 7200;
    if (n < 9312) return n - 9280 + 5120;
    if (n < 9320) return n - 9312 + 7264;
    return -1;
}
__device__ __forceinline__ void tr_item(const GAS float* W, int K, int Nsrc, GAS bf16* WT, int nblk, bool remap, LAS float* scr, int item, int lane) {
    const int kb = item / nblk, nb = item % nblk, k0 = 64 * kb, n0 = 64 * nb;
    const int s0 = remap ? win_src_col(n0) : n0, s63 = remap ? win_src_col(n0 + 63) : n0 + 63;
    if (s0 >= 0 && s63 == s0 + 63 && (s0 & 3) == 0 && (Nsrc & 3) == 0) {
        const int r4 = lane >> 4, c4 = (lane & 15) * 4;
#pragma unroll 4
        for (int i = 0; i < 16; ++i) { const int kk = 4 * i + r4; const f32x4 v = *(const GAS f32x4*)(W + (size_t)(k0 + kk) * Nsrc + s0 + c4);
            scr[kk * 65 + c4] = v.x; scr[kk * 65 + c4 + 1] = v.y; scr[kk * 65 + c4 + 2] = v.z; scr[kk * 65 + c4 + 3] = v.w; }
    } else {
        const int sc = remap ? win_src_col(n0 + lane) : n0 + lane;
#pragma unroll 8
        for (int kk = 0; kk < 64; ++kk) scr[kk * 65 + lane] = sc >= 0 ? W[(size_t)(k0 + kk) * Nsrc + sc] : 0.f;
    }
    LDS_WAIT(); asm volatile("" ::: "memory");
    const int c = lane & 7;
#pragma unroll
    for (int j = 0; j < 8; ++j) { const int n = (lane >> 3) + 8 * j; const LAS float* s = scr + (8 * c) * 65 + n;
        v4u o; o.x = pk2(s[0 * 65], s[1 * 65]); o.y = pk2(s[2 * 65], s[3 * 65]); o.z = pk2(s[4 * 65], s[5 * 65]); o.w = pk2(s[6 * 65], s[7 * 65]);
        *(GAS v4u*)(WT + (size_t)(n0 + n) * K + k0 + 8 * c) = o; }
    LDS_WAIT(); asm volatile("" ::: "memory");
}
__device__ __forceinline__ void rms_row(const GAS float* src, const GAS float* w, GAS float* hdst, GAS bf16* udst, GAS float* fdst, int lane) {
    f32x4 v[4]; float ss = 0.f;
#pragma unroll
    for (int j = 0; j < 4; ++j) { v[j] = src ? ((const GAS f32x4*)src)[lane + 64 * j] : (f32x4){0.f, 0.f, 0.f, 0.f}; ss += (v[j].x * v[j].x + v[j].y * v[j].y) + (v[j].z * v[j].z + v[j].w * v[j].w); }
    ss = wave_sum(ss);
    const float rstd = 1.0f / sqrtf(ss * (1.0f / D) + 1e-6f);
#pragma unroll
    for (int j = 0; j < 4; ++j) {
        if (hdst) ((GAS f32x4*)hdst)[lane + 64 * j] = v[j];
        const f32x4 wv = ((const GAS f32x4*)w)[lane + 64 * j]; const f32x4 o = v[j] * rstd * wv;
        if (udst) ((GAS v2u*)udst)[lane + 64 * j] = (v2u){pk2(o.x, o.y), pk2(o.z, o.w)};
        if (fdst) ((GAS f32x4*)fdst)[lane + 64 * j] = o;
    }
}

__device__ __forceinline__ void rms_row_fold(GAS float* hrow, const GAS float* p, size_t pstride, const GAS float* w, GAS bf16* udst, GAS float* fdst, int lane) {
    f32x4 v[4], q[4][4]; float ss = 0.f;
#pragma unroll
    for (int j = 0; j < 4; ++j) { v[j] = ((const GAS f32x4*)hrow)[lane + 64 * j];
#pragma unroll
        for (int sp = 0; sp < 4; ++sp) q[sp][j] = ((const GAS f32x4*)(p + sp * pstride))[lane + 64 * j]; }
#pragma unroll
    for (int j = 0; j < 4; ++j) {
#pragma unroll
        for (int sp = 0; sp < 4; ++sp) v[j] += q[sp][j];
        ((GAS f32x4*)hrow)[lane + 64 * j] = v[j];
        ss += (v[j].x * v[j].x + v[j].y * v[j].y) + (v[j].z * v[j].z + v[j].w * v[j].w); }
    ss = wave_sum(ss);
    const float rstd = 1.0f / sqrtf(ss * (1.0f / D) + 1e-6f);
#pragma unroll
    for (int j = 0; j < 4; ++j) {
        const f32x4 wv = ((const GAS f32x4*)w)[lane + 64 * j]; const f32x4 o = v[j] * rstd * wv;
        if (udst) ((GAS v2u*)udst)[lane + 64 * j] = (v2u){pk2(o.x, o.y), pk2(o.z, o.w)};
        if (fdst) ((GAS f32x4*)fdst)[lane + 64 * j] = o;
    }
}

__device__ __forceinline__ void rms_rows4(const GAS float* H, const GAS float* w, GAS bf16* U, int m0, int stride, int mend, int lane) {
    f32x4 v[4][4]; float ss[4];
#pragma unroll
    for (int r = 0; r < 4; ++r) { const int m = m0 + r * stride; const GAS f32x4* src = (const GAS f32x4*)(H + (size_t)(m < mend ? m : m0) * D); ss[r] = 0.f;
#pragma unroll
        for (int j = 0; j < 4; ++j) v[r][j] = src[lane + 64 * j]; }
    f32x4 wv[4];
#pragma unroll
    for (int j = 0; j < 4; ++j) wv[j] = ((const GAS f32x4*)w)[lane + 64 * j];
#pragma unroll
    for (int r = 0; r < 4; ++r) {
#pragma unroll
        for (int j = 0; j < 4; ++j) ss[r] += (v[r][j].x * v[r][j].x + v[r][j].y * v[r][j].y) + (v[r][j].z * v[r][j].z + v[r][j].w * v[r][j].w);
        ss[r] = wave_sum(ss[r]);
        const float rstd = 1.0f / sqrtf(ss[r] * (1.0f / D) + 1e-6f); const int m = m0 + r * stride;
        if (m < mend) {
#pragma unroll
            for (int j = 0; j < 4; ++j) { const f32x4 o = v[r][j] * rstd * wv[j]; ((GAS v2u*)(U + (size_t)m * D))[lane + 64 * j] = (v2u){pk2(o.x, o.y), pk2(o.z, o.w)}; } }
    }
}

__device__ __forceinline__ void rms_rows4g(const GAS float* const (&src)[4], const GAS float* w, GAS float* const (&hdst)[4], GAS bf16* const (&udst)[4], GAS float* const (&fdst)[4], const bool (&live)[4], int lane) {
    f32x4 v[4][4];
#pragma unroll
    for (int r = 0; r < 4; ++r)
#pragma unroll
        for (int j = 0; j < 4; ++j) v[r][j] = (live[r] && src[r]) ? ((const GAS f32x4*)src[r])[lane + 64 * j] : (f32x4){0.f, 0.f, 0.f, 0.f};
    f32x4 wv[4];
#pragma unroll
    for (int j = 0; j < 4; ++j) wv[j] = ((const GAS f32x4*)w)[lane + 64 * j];
#pragma unroll
    for (int r = 0; r < 4; ++r) { float ss = 0.f;
#pragma unroll
        for (int j = 0; j < 4; ++j) ss += (v[r][j].x * v[r][j].x + v[r][j].y * v[r][j].y) + (v[r][j].z * v[r][j].z + v[r][j].w * v[r][j].w);
        ss = wave_sum(ss);
        const float rstd = 1.0f / sqrtf(ss * (1.0f / D) + 1e-6f);
        if (live[r]) {
#pragma unroll
            for (int j = 0; j < 4; ++j) { const f32x4 o = v[r][j] * rstd * wv[j];
                if (hdst[r]) ((GAS f32x4*)hdst[r])[lane + 64 * j] = v[r][j];
                if (udst[r]) ((GAS v2u*)udst[r])[lane + 64 * j] = (v2u){pk2(o.x, o.y), pk2(o.z, o.w)};
                if (fdst[r]) ((GAS f32x4*)fdst[r])[lane + 64 * j] = o; } }
    }
}

__device__ __forceinline__ void ssd_unit(LAS unsigned char* lds, int tid, const GAS bf16* XC, const GAS float* DT, const GAS float* DA, size_t m0, int L, int h, int p0,
                                         const GAS float* hin, GAS float* hout, GAS float* YS, float dskip) {
    LAS float* Bl = (LAS float*)lds;
    LAS float* Cl = Bl + 64 * 128;
    LAS float* Xl = Cl + 64 * 128;
    LAS float* Yl = Xl + 64 * 32;
    LAS float* dtl = Yl + 64 * 32;
    LAS float* dal = dtl + 64;
    const int pl = tid >> 4, nq = tid & 15, n0 = nq * 8, g = h >> 3;
    float s[8];
    if (hin) { const f32x4 a = *(const GAS f32x4*)(hin + (size_t)(p0 + pl) * NST + n0), b = *(const GAS f32x4*)(hin + (size_t)(p0 + pl) * NST + n0 + 4);
        s[0] = a.x; s[1] = a.y; s[2] = a.z; s[3] = a.w; s[4] = b.x; s[5] = b.y; s[6] = b.z; s[7] = b.w; }
    else {
#pragma unroll
        for (int i = 0; i < 8; ++i) s[i] = 0.f; }
    for (int tb = 0; tb < L; tb += 64) {
        const int nb = (L - tb) < 64 ? (L - tb) : 64;
        { const int tk = tid >> 3, part = tid & 7;
            if (tk < nb) { const GAS bf16* xr = XC + (m0 + tb + tk) * CONVD;
                float f[8];
                unpack8(*(const GAS v4u*)(xr + DIN + g * NST + part * 16), f);
                *(LAS f32x4*)(Bl + tk * 128 + part * 16) = (f32x4){f[0], f[1], f[2], f[3]}; *(LAS f32x4*)(Bl + tk * 128 + part * 16 + 4) = (f32x4){f[4], f[5], f[6], f[7]};
                unpack8(*(const GAS v4u*)(xr + DIN + g * NST + part * 16 + 8), f);
                *(LAS f32x4*)(Bl + tk * 128 + part * 16 + 8) = (f32x4){f[0], f[1], f[2], f[3]}; *(LAS f32x4*)(Bl + tk * 128 + part * 16 + 12) = (f32x4){f[4], f[5], f[6], f[7]};
                unpack8(*(const GAS v4u*)(xr + DIN + NG * NST + g * NST + part * 16), f);
                *(LAS f32x4*)(Cl + tk * 128 + part * 16) = (f32x4){f[0], f[1], f[2], f[3]}; *(LAS f32x4*)(Cl + tk * 128 + part * 16 + 4) = (f32x4){f[4], f[5], f[6], f[7]};
                unpack8(*(const GAS v4u*)(xr + DIN + NG * NST + g * NST + part * 16 + 8), f);
                *(LAS f32x4*)(Cl + tk * 128 + part * 16 + 8) = (f32x4){f[0], f[1], f[2], f[3]}; *(LAS f32x4*)(Cl + tk * 128 + part * 16 + 12) = (f32x4){f[4], f[5], f[6], f[7]};
                const v2u xw = *(const GAS v2u*)(xr + h * HP + p0 + part * 4);
                *(LAS f32x4*)(Xl + tk * 32 + part * 4) = (f32x4){__uint_as_float(xw.x << 16), __uint_as_float(xw.x & 0xffff0000u), __uint_as_float(xw.y << 16), __uint_as_float(xw.y & 0xffff0000u)};
            }
            if (tid < nb) { dtl[tid] = DT[(m0 + tb + tid) * 32 + h]; dal[tid] = DA[(m0 + tb + tid) * 32 + h]; }
        }
        __syncthreads();
        for (int t = 0; t < nb; ++t) {
            const float da = dal[t], dtv = dtl[t], xv = Xl[t * 32 + pl], xdt = xv * dtv;
            const f32x4 b0 = *(const LAS f32x4*)(Bl + t * 128 + n0), b1 = *(const LAS f32x4*)(Bl + t * 128 + n0 + 4);
            const f32x4 c0 = *(const LAS f32x4*)(Cl + t * 128 + n0), c1 = *(const LAS f32x4*)(Cl + t * 128 + n0 + 4);
            s[0] = s[0] * da + xdt * b0.x; s[1] = s[1] * da + xdt * b0.y; s[2] = s[2] * da + xdt * b0.z; s[3] = s[3] * da + xdt * b0.w;
            s[4] = s[4] * da + xdt * b1.x; s[5] = s[5] * da + xdt * b1.y; s[6] = s[6] * da + xdt * b1.z; s[7] = s[7] * da + xdt * b1.w;
            float y = (s[0] * c0.x + s[1] * c0.y) + (s[2] * c0.z + s[3] * c0.w) + (s[4] * c1.x + s[5] * c1.y) + (s[6] * c1.z + s[7] * c1.w);
            y += __shfl_xor(y, 1); y += __shfl_xor(y, 2); y += __shfl_xor(y, 4); y += __shfl_xor(y, 8);
            if (nq == 0) Yl[t * 32 + pl] = y + xv * dskip;
        }
        __syncthreads();
        { const int tk = tid >> 3, part = tid & 7;
            if (tk < nb) *(GAS f32x4*)(YS + (m0 + tb + tk) * DIN + h * HP + p0 + part * 4) = *(const LAS f32x4*)(Yl + tk * 32 + part * 4); }
    }
    *(GAS f32x4*)(hout + (size_t)(p0 + pl) * NST + n0) = (f32x4){s[0], s[1], s[2], s[3]};
    *(GAS f32x4*)(hout + (size_t)(p0 + pl) * NST + n0 + 4) = (f32x4){s[4], s[5], s[6], s[7]};
}

__device__ __forceinline__ void idx_load_q(const GAS bf16* P1, const GAS float* MISC, size_t mq0, int lane, bf16x8 (&afr)[2][4], float (&wq)[2][2][8]) {
    const int r = lane & 31, hh = lane >> 5, qs = ((r >> 2) & 1) * 2 + (r >> 4), head = (r & 3) + 4 * ((r >> 3) & 1);
#pragma unroll
    for (int rt = 0; rt < 2; ++rt)
#pragma unroll
        for (int ks = 0; ks < 4; ++ks) afr[rt][ks] = *(const GAS bf16x8*)(P1 + (mq0 + qs + 4 * rt) * LDP1 + C_QI + head * 64 + 16 * ks + 8 * hh);
#pragma unroll
    for (int rt = 0; rt < 2; ++rt)
#pragma unroll
        for (int jq = 0; jq < 2; ++jq) { const GAS float* wp = MISC + (mq0 + 4 * rt + 2 * hh + jq) * 128 + MC_WI; const f32x4 a = *(const GAS f32x4*)wp, b = *(const GAS f32x4*)(wp + 4);
            const float sc = 8.0f * 0.35355339059327373f;
            wq[rt][jq][0] = a.x * sc; wq[rt][jq][1] = a.y * sc; wq[rt][jq][2] = a.z * sc; wq[rt][jq][3] = a.w * sc; wq[rt][jq][4] = b.x * sc; wq[rt][jq][5] = b.y * sc; wq[rt][jq][6] = b.z * sc; wq[rt][jq][7] = b.w * sc; }
}
typedef float f32x2 __attribute__((ext_vector_type(2)));
__device__ __forceinline__ float relu_bits(float x) { return __int_as_float(max(__float_as_int(x), 0)); }
__device__ __forceinline__ float idx_reduce(const f32x16& acc, const int o, const float (&w)[8]) {
    f32x2 s2 = (f32x2){w[0], w[1]} * (f32x2){relu_bits(acc[o]), relu_bits(acc[o + 1])};
#pragma unroll
    for (int i = 2; i < 8; i += 2) s2 = __builtin_elementwise_fma((f32x2){w[i], w[i + 1]}, (f32x2){relu_bits(acc[o + i]), relu_bits(acc[o + i + 1])}, s2);
    float r; asm("v_add_f32 %0, %1, %2" : "=v"(r) : "v"(s2.x), "v"(s2.y));
    return r;
}
__device__ __forceinline__ void idx_scores(const bf16x8 (&afr)[2][4], const bf16x8 (&bfr)[4], const float (&wq)[2][2][8], float (&sc)[2][2]) {
#pragma unroll
    for (int rt = 0; rt < 2; ++rt) {
        f32x16 acc = {};
#pragma unroll
        for (int ks = 0; ks < 4; ++ks) acc = __builtin_amdgcn_mfma_f32_32x32x16_bf16(afr[rt][ks], bfr[ks], acc, 0, 0, 0);
#pragma unroll
        for (int jq = 0; jq < 2; ++jq) sc[rt][jq] = idx_reduce(acc, 8 * jq, wq[rt][jq]);
    }
}
__device__ __forceinline__ unsigned f2key(float f) { const unsigned u = __float_as_uint(f); return u ^ ((u >> 31) ? 0xffffffffu : 0x80000000u); }
__device__ __forceinline__ unsigned wave_incl_scan(unsigned v, int lane) {
    int x = (int)v;
    x += __builtin_amdgcn_update_dpp(0, x, 0x111, 0xf, 0xf, false);
    x += __builtin_amdgcn_update_dpp(0, x, 0x112, 0xf, 0xf, false);
    x += __builtin_amdgcn_update_dpp(0, x, 0x114, 0xf, 0xf, false);
    x += __builtin_amdgcn_update_dpp(0, x, 0x118, 0xf, 0xf, false);
    x += __builtin_amdgcn_update_dpp(0, x, 0x142, 0xa, 0xf, false);
    x += __builtin_amdgcn_update_dpp(0, x, 0x143, 0xc, 0xf, false);
    return (unsigned)x;
}
#ifndef REP_TK_PASS1
#define REP_TK_PASS1 1
#endif
#ifndef REP_TK_PICK
#define REP_TK_PICK 1
#endif
#ifndef REP_TK_OPEN
#define REP_TK_OPEN 1
#endif
#ifndef REP_TK_PASS
#define REP_TK_PASS 1
#endif
#ifndef REP_TK_COMP
#define REP_TK_COMP 1
#endif
__device__ __forceinline__ int wave_sum_i(int v) {
    v += __builtin_amdgcn_update_dpp(0, v, 0xB1, 0xf, 0xf, true);
    v += __builtin_amdgcn_update_dpp(0, v, 0x4E, 0xf, 0xf, true);
    v += __builtin_amdgcn_update_dpp(0, v, 0x141, 0xf, 0xf, true);
    v += __builtin_amdgcn_update_dpp(0, v, 0x140, 0xf, 0xf, true);
    v += __builtin_amdgcn_update_dpp(0, v, 0x142, 0xa, 0xf, false);
    v += __builtin_amdgcn_update_dpp(0, v, 0x143, 0xc, 0xf, false);
    return __builtin_amdgcn_readlane(v, 63);
}
__device__ __forceinline__ int cnt_ge(const LAS unsigned* s, int nit, unsigned mid, int lane) {
    int cl = 0; int it = 0;
    const LAS v4u* p = (const LAS v4u*)s + lane;
    for (; it + 4 <= nit; it += 4) {
        const v4u k0 = p[64 * it], k1 = p[64 * it + 64], k2 = p[64 * it + 128], k3 = p[64 * it + 192];
        cl += (k0.x >= mid) + (k0.y >= mid) + (k0.z >= mid) + (k0.w >= mid);
        cl += (k1.x >= mid) + (k1.y >= mid) + (k1.z >= mid) + (k1.w >= mid);
        cl += (k2.x >= mid) + (k2.y >= mid) + (k2.z >= mid) + (k2.w >= mid);
        cl += (k3.x >= mid) + (k3.y >= mid) + (k3.z >= mid) + (k3.w >= mid); }
    for (; it < nit; ++it) { const v4u kv = p[64 * it]; cl += (kv.x >= mid) + (kv.y >= mid) + (kv.z >= mid) + (kv.w >= mid); }
    return wave_sum_i(cl);
}
constexpr int HB = 512;
__device__ __forceinline__ unsigned hist_bound_key(int b) {
    return b <= 0 ? 1u : (b >= HB ? 0xff800001u : (b == 256 ? 0x7fffffffu : f2key((float)(b - 256))));
}
__device__ __forceinline__ unsigned mbcnt64(unsigned long long m, unsigned add) { return __builtin_amdgcn_mbcnt_hi((unsigned)(m >> 32), __builtin_amdgcn_mbcnt_lo((unsigned)m, add)); }
template <class OT>
__device__ __forceinline__ void topk_select(LAS unsigned* s, int n, int lane, OT* out, const LAS unsigned* hist = nullptr) {
    const int nit = (n + 255) >> 8;
    for (int i = n + lane; i < nit * 256; i += 64) s[i] = 0u;
    LDS_WAIT(); asm volatile("" ::: "memory");
    unsigned T = 0u, need = 0u;
    {
    unsigned hi, lo; int c_hi, c_lo;
    if (hist) {
        unsigned c[8], tot = 0u;
        { const v4u h0 = *(const LAS v4u*)(hist + HB - 8 - 8 * lane), h1 = *(const LAS v4u*)(hist + HB - 4 - 8 * lane);
          c[0] = h1.w; c[1] = h1.z; c[2] = h1.y; c[3] = h1.x; c[4] = h0.w; c[5] = h0.z; c[6] = h0.y; c[7] = h0.x; }
#pragma unroll
        for (int j = 0; j < 8; ++j) tot += c[j];
        const unsigned incl = wave_incl_scan(tot, lane), excl = incl - tot;
        const bool here = (excl < 256u) && (256u <= incl);
        int bin = 0; unsigned above = 0u, inb = 0u;
        if (here) { unsigned run = excl;
#pragma unroll
            for (int j = 0; j < 8; ++j) { if (run < 256u && 256u <= run + c[j]) { bin = HB - 1 - 8 * lane - j; above = run; inb = c[j]; } run += c[j]; } }
        const unsigned long long mk = __ballot(here); const int src = mk ? (__ffsll((long long)mk) - 1) : 0;
        bin = __builtin_amdgcn_readlane(bin, src); above = (unsigned)__builtin_amdgcn_readlane((int)above, src); inb = (unsigned)__builtin_amdgcn_readlane((int)inb, src);
        lo = hist_bound_key(bin); hi = hist_bound_key(bin + 1);
        while (inb > 192u && hi - lo > 1u) {
            const unsigned mid = lo + ((hi - lo) >> 1); const unsigned up = (unsigned)cnt_ge(s, nit, mid, lane) - above;
            if (above + up >= 256u) { lo = mid; inb = up; } else { above += up; hi = mid; inb -= up; } }
        if (inb <= 192u) {
            LAS unsigned short* stg = (LAS unsigned short*)hist;
            LAS unsigned* cnd = (LAS unsigned*)hist + 128;
            const unsigned wdt = hi - lo;
            unsigned running = 0u, ncand = 0u;
            for (int rq_ = 0; rq_ < REP_TK_PASS1; ++rq_) { running = 0u; ncand = 0u;
            v4u kn = *(const LAS v4u*)(s + 4 * lane);
            for (int it = 0; it < nit; ++it) {
                const int i0 = 4 * (lane + 64 * it); const v4u kv = kn;
                if (it + 1 < nit) kn = *(const LAS v4u*)(s + i0 + 256);
                bool sel[4]; unsigned long long cm[4]; unsigned lower = running, all = 0u;
#pragma unroll
                for (int e = 0; e < 4; ++e) { sel[e] = kv[e] >= hi; const unsigned long long sm = __ballot(sel[e]); lower = mbcnt64(sm, lower); all += (unsigned)__popcll(sm);
                                              cm[e] = __ballot(kv[e] >= lo) & ~sm; }
                unsigned pos = lower;
#pragma unroll
                for (int e = 0; e < 4; ++e) { if (sel[e]) { stg[pos] = (unsigned short)(i0 + e); ++pos; } }
                running += all;
                if (cm[0] | cm[1] | cm[2] | cm[3]) {
#pragma unroll
                    for (int e = 0; e < 4; ++e) {
                        if ((cm[e] >> lane) & 1ull) { const unsigned p = mbcnt64(cm[e], ncand); *(LAS v2u*)(cnd + 2 * p) = (v2u){kv[e], (unsigned)(i0 + e)}; }
                        ncand += (unsigned)__popcll(cm[e]); }
                }
            } }
            LDS_WAIT(); asm volatile("" ::: "memory");
            const unsigned r = 256u - above;
            for (int rk_ = 0; rk_ < REP_TK_PICK; ++rk_) { asm volatile("" ::: "memory");
#define TK_PICK(KC) { unsigned v[KC], ci[KC]; \
                _Pragma("unroll") for (int q = 0; q < KC; ++q) { const unsigned id = (unsigned)lane + 64u * q; v[q] = 0u; ci[q] = 0xffffffffu; \
                    if (id < inb) { const v2u t = *(const LAS v2u*)(cnd + 2 * id); v[q] = t.x - lo + 1u; ci[q] = t.y; } }              \
                unsigned Tv = 0u; \
                for (int bb = 31 - __builtin_clz(wdt | 1u); bb >= 0; --bb) { const unsigned trial = Tv | (1u << bb); unsigned c = 0u; \
                    _Pragma("unroll") for (int q = 0; q < KC; ++q) c += (unsigned)__popcll(__ballot(v[q] >= trial)); \
                    if (c >= r) Tv = trial; } \
                unsigned ngt = 0u, neq = 0u; bool eq[KC]; \
                _Pragma("unroll") for (int q = 0; q < KC; ++q) { ngt += (unsigned)__popcll(__ballot(v[q] > Tv)); eq[q] = v[q] == Tv; neq += (unsigned)__popcll(__ballot(eq[q])); } \
                unsigned needq = r - ngt;                                \
                if (neq != needq) {                                       \
                    bool keep[KC]; _Pragma("unroll") for (int q = 0; q < KC; ++q) keep[q] = false; \
                    for (unsigned t = 0; t < needq; ++t) { unsigned mi = 0xffffffffu; \
                        _Pragma("unroll") for (int q = 0; q < KC; ++q) if (eq[q] && !keep[q] && ci[q] < mi) mi = ci[q]; \
                        _Pragma("unroll") for (int o = 1; o < 64; o <<= 1) { const unsigned x = (unsigned)__shfl_xor((int)mi, o); mi = x < mi ? x : mi; } \
                        _Pragma("unroll") for (int q = 0; q < KC; ++q) if (eq[q] && ci[q] == mi) keep[q] = true; } \
                    _Pragma("unroll") for (int q = 0; q < KC; ++q) eq[q] = keep[q]; } \
                unsigned base = above; \
                _Pragma("unroll") for (int q = 0; q < KC; ++q) { const bool sq = v[q] > Tv || eq[q]; const unsigned long long m = __ballot(sq); \
                    if (sq) stg[mbcnt64(m, base)] = (unsigned short)ci[q]; base += (unsigned)__popcll(m); } }
            if (inb <= 64u) TK_PICK(1) else if (inb <= 128u) TK_PICK(2) else TK_PICK(3)
            }
#undef TK_PICK
            LDS_WAIT(); asm volatile("" ::: "memory");
            const v2u w = *(const LAS v2u*)(stg + 4 * lane);
            if constexpr (sizeof(OT) == 2) *(GAS v2u*)(out + 4 * lane) = w;
            else *(GAS v4u*)(out + 4 * lane) = (v4u){w.x & 0xffffu, w.x >> 16, w.y & 0xffffu, w.y >> 16};
            return;
        }
        T = lo; need = 256u - above;
    }
    }
    const unsigned long long lt = (1ull << lane) - 1ull;
    unsigned running = 0u, eq_taken = 0u;
    {
#pragma unroll 2
    for (int it = 0; it < nit; ++it) {
        const int i0 = 4 * (lane + 64 * it); const v4u kv = *(const LAS v4u*)(s + i0);
        bool sel[4], eq[4]; bool anyeq = false;
#pragma unroll
        for (int e = 0; e < 4; ++e) { sel[e] = kv[e] > T; eq[e] = need != 0u && kv[e] == T && (i0 + e < n); anyeq = anyeq || eq[e]; }
        if (need != 0u && __ballot(anyeq)) {
            unsigned lower = 0u, all = 0u;
#pragma unroll
            for (int e = 0; e < 4; ++e) { const unsigned long long bm = __ballot(eq[e]); lower += (unsigned)__popcll(bm & lt); all += (unsigned)__popcll(bm); }
            unsigned er = eq_taken + lower;
#pragma unroll
            for (int e = 0; e < 4; ++e) { if (eq[e]) { sel[e] = er < need; ++er; } }
            eq_taken += all;
        }
        unsigned lower = 0u, all = 0u;
#pragma unroll
        for (int e = 0; e < 4; ++e) { const unsigned long long sm = __ballot(sel[e]); lower += (unsigned)__popcll(sm & lt); all += (unsigned)__popcll(sm); }
        unsigned pos = running + lower;
#pragma unroll
        for (int e = 0; e < 4; ++e) { if (sel[e]) { if (pos < 256u) out[pos] = (OT)(i0 + e); ++pos; } }
        running += all;
    } }
}

constexpr int NCH = 33;
typedef short s16x4 __attribute__((ext_vector_type(4)));
typedef short v4i16_t __attribute__((ext_vector_type(4)));
__device__ __forceinline__ float wave_incl_scan_f(float v, int lane) {
#pragma unroll
    for (int o = 1; o < 64; o <<= 1) { const float t = __shfl_up(v, o); if (lane >= o) v += t; }
    return v;
}
__device__ __forceinline__ s16x4 ldtr(const LAS unsigned char* p) { return __builtin_bit_cast(s16x4, __builtin_amdgcn_ds_read_tr16_b64_v4i16((LAS v4i16_t*)p)); }
__device__ __forceinline__ bf16x8 frag_tr(const LAS unsigned char* img, int RS, int k0, int c0, int lane) {
    const int hh = lane >> 5, blk = (lane >> 4) & 1, q = (lane & 15) >> 2, pp = lane & 3;
    const LAS unsigned char* a = img + (k0 + 8 * hh + q) * RS + (c0 + 16 * blk + 4 * pp) * 2;
    const s16x4 lo = ldtr(a), hi = ldtr(a + 4 * RS);
    return (bf16x8){lo[0], lo[1], lo[2], lo[3], hi[0], hi[1], hi[2], hi[3]};
}
__device__ __forceinline__ bf16x8 frag_row(const LAS unsigned char* img, int RS, int r0, int k0, int lane) {
    return *(const LAS bf16x8*)(img + (r0 + (lane & 31)) * RS + (k0 + 8 * (lane >> 5)) * 2);
}
constexpr int RS_BC = 272, RS_X = 144, IMG_BC = 128 * RS_BC, IMG_X = 128 * RS_X;
__device__ __forceinline__ void ssd_stage_acum(LAS float* acl, LAS float* dtl, const GAS float* DT, const GAS float* a_log_l, size_t m0, int Lc, int g, int wave, int lane) {
    const int h = 8 * g + wave; const float A = -__expf(a_log_l[h]);
    const float d0 = lane < Lc ? DT[(m0 + lane) * 32 + h] : 0.f, d1 = (64 + lane) < Lc ? DT[(m0 + 64 + lane) * 32 + h] : 0.f;
    const float s0 = wave_incl_scan_f(d0 * A, lane), tot0 = __shfl(s0, 63), s1 = wave_incl_scan_f(d1 * A, lane) + tot0;
    acl[wave * 128 + lane] = s0; acl[wave * 128 + 64 + lane] = s1; dtl[wave * 128 + lane] = d0; dtl[wave * 128 + 64 + lane] = d1;
}
__device__ __forceinline__ void ssd_stage_bc(LAS unsigned char* img, const GAS bf16* src  , int Lc, int tid) {
    const int ch = tid & 15;
#pragma unroll
    for (int q4 = 0; q4 < 4; ++q4) { const int row = (tid >> 4) + 32 * q4; v4u v = (v4u){0u, 0u, 0u, 0u}; if (row < Lc) v = *(const GAS v4u*)(src + (size_t)row * CONVD + ch * 8);
        *(LAS v4u*)(img + row * RS_BC + ch * 16) = v; }
}
__device__ __forceinline__ void ssd_stage_x(LAS unsigned char* img, const GAS bf16* src  , int Lc, int tid, const LAS float* dth, const LAS float* ach, float al, bool decay) {
    const int ch = tid & 7;
#pragma unroll
    for (int q2 = 0; q2 < 2; ++q2) { const int row = (tid >> 3) + 64 * q2; v4u o = (v4u){0u, 0u, 0u, 0u};
        if (row < Lc) { float f[8]; unpack8(*(const GAS v4u*)(src + (size_t)row * CONVD + ch * 8), f);
            const float sc = decay ? dth[row] * __expf(al - ach[row]) : dth[row];
            o = (v4u){pk2(f[0] * sc, f[1] * sc), pk2(f[2] * sc, f[3] * sc), pk2(f[4] * sc, f[5] * sc), pk2(f[6] * sc, f[7] * sc)}; }
        *(LAS v4u*)(img + row * RS_X + ch * 16) = o; }
}
__device__ __forceinline__ void ssd1_unit(LAS unsigned char* lds, int tid, const GAS bf16* XC, const GAS float* DT, const GAS float* a_log_l, GAS bf16* SB, GAS float* DEC, int b, int c, int g) {
    const int lane = tid & 63, wave = __builtin_amdgcn_readfirstlane(tid >> 6), hh = lane >> 5, col = lane & 31;
    const int t0 = c == 0 ? 0 : NMETA + 128 * (c - 1), Lc = c == 0 ? NMETA : 128; const size_t m0 = (size_t)b * LP + t0;
    LAS unsigned char* Bimg = lds; LAS unsigned char* Xw0 = lds + IMG_BC;
    LAS float* acl = (LAS float*)(lds + IMG_BC + 2 * IMG_X); LAS float* dtl = acl + 1024;
    ssd_stage_acum(acl, dtl, DT, a_log_l, m0, Lc, g, wave, lane);
    ssd_stage_bc(Bimg, XC + m0 * CONVD + DIN + g * NST, Lc, tid);
    __syncthreads();
    const int pb = wave >> 2, nb = wave & 3;
    for (int hl = 0; hl < 8; ++hl) {
        const int h = 8 * g + hl; LAS unsigned char* Xw = Xw0 + (hl & 1) * IMG_X;
        const float al = acl[hl * 128 + 127];
        ssd_stage_x(Xw, XC + m0 * CONVD + h * HP, Lc, tid, dtl + hl * 128, acl + hl * 128, al, true);
        __syncthreads();
        f32x16 acc = {};
        if (Lc == 128) {
#pragma unroll
            for (int ks = 0; ks < 8; ++ks) acc = __builtin_amdgcn_mfma_f32_32x32x16_bf16(frag_tr(Xw, RS_X, 16 * ks, 32 * pb, lane), frag_tr(Bimg, RS_BC, 16 * ks, 32 * nb, lane), acc, 0, 0, 0);
        } else acc = __builtin_amdgcn_mfma_f32_32x32x16_bf16(frag_tr(Xw, RS_X, 0, 32 * pb, lane), frag_tr(Bimg, RS_BC, 0, 32 * nb, lane), acc, 0, 0, 0);
        GAS bf16* Sp = SB + ((size_t)(b * NCH + c) * NH + h) * (HP * NST) + 32 * nb + col;
#pragma unroll
        for (int r = 0; r < 16; ++r) Sp[(32 * pb + (r & 3) + 8 * (r >> 2) + 4 * hh) * NST] = (bf16)f2bf(acc[r]);
        if (tid == 0) DEC[(b * NCH + c) * NH + h] = __expf(al);
    }
    __syncthreads();
}
#ifndef REP_SSD3_WR
#define REP_SSD3_WR 1
#endif
#ifndef REP_SSD3_MM
#define REP_SSD3_MM 1
#endif
#ifndef REP_SSD3_HEADS
#define REP_SSD3_HEADS 1
#endif
__device__ __forceinline__ void ssd3_unit(LAS unsigned char* lds, int tid, const GAS bf16* XC, const GAS bf16* P1, const GAS float* DT, const GAS float* a_log_l, const GAS float* dskip_l, const GAS float* normw_l,
                                          const GAS bf16* HC, GAS bf16* YSN, int b, int c, int g) {
    const int lane = tid & 63, wave = __builtin_amdgcn_readfirstlane(tid >> 6), hh = lane >> 5, col = lane & 31;
    const int t0 = c == 0 ? 0 : NMETA + 128 * (c - 1), Lc = c == 0 ? NMETA : 128; const size_t m0 = (size_t)b * LP + t0;
    LAS unsigned char* Bimg = lds; LAS unsigned char* Cimg = lds + IMG_BC; LAS unsigned char* Mimg0 = lds + 2 * IMG_BC; LAS unsigned char* Ximg0 = lds + 3 * IMG_BC;
    LAS float* acl = (LAS float*)(lds + 3 * IMG_BC + 2 * IMG_X); LAS float* dtl = acl + 1024;
    LAS unsigned char* Mimg1 = Bimg; LAS unsigned char* Ximg1 = Ximg0 + IMG_X;
    ssd_stage_acum(acl, dtl, DT, a_log_l, m0, Lc, g, wave, lane);
    ssd_stage_bc(Bimg, XC + m0 * CONVD + DIN + g * NST, Lc, tid);
    ssd_stage_bc(Cimg, XC + m0 * CONVD + DIN + NG * NST + g * NST, Lc, tid);
    __syncthreads();
    const int ib = wave >> 1, pb = wave & 1;
    f32x16 cb[2];
    const bool live = 32 * ib < Lc;
#pragma unroll
    for (int jj = 0; jj < 2; ++jj) { const int jb = 2 * (wave & 1) + jj; cb[jj] = (f32x16){};
        if (jb <= ib && live) {
#pragma unroll
            for (int ks = 0; ks < 8; ++ks) cb[jj] = __builtin_amdgcn_mfma_f32_32x32x16_bf16(frag_row(Bimg, RS_BC, 32 * jb, 16 * ks, lane), frag_row(Cimg, RS_BC, 32 * ib, 16 * ks, lane), cb[jj], 0, 0, 0); } }
    const int irow = 32 * ib + col;
    bf16x8 cf[8];
#pragma unroll
    for (int ks = 0; ks < 8; ++ks) cf[ks] = frag_row(Cimg, RS_BC, 32 * ib, 16 * ks, lane);
    __syncthreads();
    const int xrow = tid >> 3, xch = tid & 7;
    const GAS bf16* xsrc = XC + (m0 + xrow) * CONVD + (8 * g) * HP + xch * 8;
    v4u xq0 = (v4u){0u, 0u, 0u, 0u}, xq1 = xq0;
    for (int rh_ = 0; rh_ < REP_SSD3_HEADS; ++rh_) {
    if (rh_ > 0) __syncthreads();
    if (xrow < Lc) xq0 = *(const GAS v4u*)xsrc;
    if (xrow + 64 < Lc) xq1 = *(const GAS v4u*)(xsrc + (size_t)64 * CONVD);
    const GAS bf16* Hp0 = HC + ((size_t)(b * NCH + c) * NH + 8 * g) * (HP * NST) + pb * 4096 + lane * 8;
    bf16x8 hq[8];
#pragma unroll
    for (int ks = 0; ks < 8; ++ks) hq[ks] = *(const GAS bf16x8*)(Hp0 + 512 * ks);
    for (int hl = 0; hl < 8; ++hl) {
        const int h = 8 * g + hl;
        LAS unsigned char* Mimg = (hl & 1) ? Mimg1 : Mimg0; LAS unsigned char* Ximg = (hl & 1) ? Ximg1 : Ximg0;
        bf16x8 hf[8], hn[8];
#pragma unroll
        for (int ks = 0; ks < 8; ++ks) { hf[ks] = hq[ks]; hn[ks] = hq[ks]; }
        if (hl < 7) {
#pragma unroll
            for (int ks = 0; ks < 8; ++ks) hn[ks] = *(const GAS bf16x8*)(Hp0 + (size_t)(hl + 1) * (HP * NST) + 512 * ks); }
        v4u xn0 = xq0, xn1 = xq1;
        if (hl < 7 && xrow < Lc) xn0 = *(const GAS v4u*)(xsrc + (hl + 1) * HP);
        if (hl < 7 && xrow + 64 < Lc) xn1 = *(const GAS v4u*)(xsrc + (size_t)64 * CONVD + (hl + 1) * HP);
        const float ai = acl[hl * 128 + irow];
        for (int rw_ = 0; rw_ < REP_SSD3_WR; ++rw_) {
#pragma unroll
        for (int jj = 0; jj < 2; ++jj) { const int jb = 2 * (wave & 1) + jj;
            if (jb <= ib && live) {
                LAS unsigned char* mp = Mimg + irow * RS_BC + (32 * jb + 4 * hh) * 2;
#pragma unroll
                for (int q = 0; q < 4; ++q) { const int j0 = 32 * jb + 8 * q + 4 * hh; const f32x4 aj = *(const LAS f32x4*)(acl + hl * 128 + j0);
                    float v[4];
#pragma unroll
                    for (int e = 0; e < 4; ++e) v[e] = (j0 + e <= irow) ? cb[jj][4 * q + e] * __expf(ai - aj[e]) : 0.f;
                    *(LAS v2u*)(mp + 16 * q) = (v2u){pk2(v[0], v[1]), pk2(v[2], v[3])}; } } }
        { const float s0 = dtl[hl * 128 + xrow], s1 = dtl[hl * 128 + 64 + xrow]; float f[8]; v4u o0, o1;
          unpack8(xq0, f); o0 = (v4u){pk2(f[0] * s0, f[1] * s0), pk2(f[2] * s0, f[3] * s0), pk2(f[4] * s0, f[5] * s0), pk2(f[6] * s0, f[7] * s0)};
          unpack8(xq1, f); o1 = (v4u){pk2(f[0] * s1, f[1] * s1), pk2(f[2] * s1, f[3] * s1), pk2(f[4] * s1, f[5] * s1), pk2(f[6] * s1, f[7] * s1)};
          *(LAS v4u*)(Ximg + xrow * RS_X + xch * 16) = o0; *(LAS v4u*)(Ximg + (xrow + 64) * RS_X + xch * 16) = o1; }
        }
        __syncthreads();
        f32x16 a1 = {}, a2 = {};
        if (live) {
        const int nks = Lc == 128 ? 2 * (ib + 1) : 1;
        for (int rm_ = 0; rm_ < REP_SSD3_MM; ++rm_) { a1 = (f32x16){}; a2 = (f32x16){};
        for (int ks = 0; ks < nks; ++ks) a1 = __builtin_amdgcn_mfma_f32_32x32x16_bf16(frag_tr(Ximg, RS_X, 16 * ks, 32 * pb, lane), frag_row(Mimg, RS_BC, 32 * ib, 16 * ks, lane), a1, 0, 0, 0);
#pragma unroll
        for (int ks = 0; ks < 8; ++ks) a2 = __builtin_amdgcn_mfma_f32_32x32x16_bf16(hf[ks], cf[ks], a2, 0, 0, 0);
        }
        const float ei = __expf(ai);
        v2u wq[4];
#pragma unroll
        for (int q = 0; q < 4; ++q) wq[q] = (v2u){pk2(a1[4 * q] + ei * a2[4 * q], a1[4 * q + 1] + ei * a2[4 * q + 1]), pk2(a1[4 * q + 2] + ei * a2[4 * q + 2], a1[4 * q + 3] + ei * a2[4 * q + 3])};
        GAS bf16* yo = YSN + (m0 + irow) * DIN + h * HP + 32 * pb + 8 * hh;
#pragma unroll
        for (int k = 0; k < 4; k += 2) {
            const auto rx = __builtin_amdgcn_permlane32_swap(wq[k].x, wq[k + 1].x, false, false), ry = __builtin_amdgcn_permlane32_swap(wq[k].y, wq[k + 1].y, false, false);
            if (irow < Lc) *(GAS v4u*)(yo + 8 * k) = (v4u){rx[0], ry[0], rx[1], ry[1]}; }
        }
#pragma unroll
        for (int ks = 0; ks < 8; ++ks) hq[ks] = hn[ks];
        xq0 = xn0; xq1 = xn1;
    }
    }
    __syncthreads();
    for (int i0 = wave; i0 < Lc; i0 += 4 * NWAVES) { const int c0 = g * 512 + lane * 8;
        v4u yv[4], xv[4], zv[4];
#pragma unroll
        for (int q = 0; q < 4; ++q) { const int i = i0 + NWAVES * q; const size_t m = m0 + (i < Lc ? i : i0);
            yv[q] = *(const GAS v4u*)(YSN + m * DIN + c0); xv[q] = *(const GAS v4u*)(XC + m * CONVD + c0); zv[q] = *(const GAS v4u*)(P1 + m * LDP1 + C_Z + c0); }
        const float Dh = dskip_l[c0 >> 6];
        const GAS float* wp = normw_l + c0; const f32x4 wa = *(const GAS f32x4*)wp, wb = *(const GAS f32x4*)(wp + 4);
#pragma unroll
        for (int q = 0; q < 4; ++q) { const int i = i0 + NWAVES * q;
            float v[8], x[8], z[8]; unpack8(yv[q], v); unpack8(xv[q], x); unpack8(zv[q], z); float ss = 0.f;
#pragma unroll
            for (int j = 0; j < 8; ++j) { v[j] = (v[j] + Dh * x[j]) * (z[j] * sigm(z[j])); ss += v[j] * v[j]; }
            ss = wave_sum(ss);
            const float rstd = 1.0f / sqrtf(ss * (1.0f / 512.0f) + 1e-6f);
            if (i < Lc) *(GAS v4u*)(YSN + (m0 + i) * DIN + c0) = (v4u){pk2(v[0] * rstd * wa.x, v[1] * rstd * wa.y), pk2(v[2] * rstd * wa.z, v[3] * rstd * wa.w), pk2(v[4] * rstd * wb.x, v[5] * rstd * wb.y), pk2(v[6] * rstd * wb.z, v[7] * rstd * wb.w)}; }
    }
    __syncthreads();
}

constexpr int RS_V = 528;
#define KLOAD(dst, tile) do { _Pragma("unroll") for (int it = 0; it < 8; ++it) dst[it] = *(const GAS v4u*)(kvb + ((unsigned)idl[16 * (tile) + 2 * it + (lane >> 5)] * 1024u + 16u * (lane & 31))); } while (0)
template <int JT> struct AttnKTile {
    static __device__ __forceinline__ void run(LAS unsigned char* Vst, const LAS unsigned short* idl, const GAS char* kvb, const int lane, const int n, const int kg, const int k4, const int cnt, const int ntile,
                                               const bf16x8 (&bq)[8], v4u (&kst)[3][8], f32x4 (&S)[16], float& mx) {
        if (JT < ntile) {
            LAS unsigned char* half = Vst + 16 * (JT & 1) * RS_V;
#pragma unroll
            for (int it = 0; it < 8; ++it) *(LAS v4u*)(half + (2 * it + (lane >> 5)) * RS_V + 16 * (lane & 31)) = kst[JT % 3][it];
            LDS_WAIT(); asm volatile("" ::: "memory");
            if (JT + 3 < 16) KLOAD(kst[JT % 3], JT + 3);
            f32x4 acc = {0.f, 0.f, 0.f, 0.f};
#pragma unroll
            for (int s8 = 0; s8 < 8; ++s8) acc = __builtin_amdgcn_mfma_f32_16x16x32_bf16(*(const LAS bf16x8*)(half + n * RS_V + (32 * s8 + 8 * kg) * 2), bq[s8], acc, 0, 0, 0);
            f32x4 sv;
#pragma unroll
            for (int i = 0; i < 4; ++i) { const float v = (k4 + i < cnt - 16 * JT) ? acc[i] * 0.125f : -INFINITY; sv[i] = v; mx = fmaxf(mx, v); }
            S[JT] = sv;
            LDS_WAIT(); asm volatile("" ::: "memory");
            AttnKTile<JT + 1>::run(Vst, idl, kvb, lane, n, kg, k4, cnt, ntile, bq, kst, S, mx);
        }
    }
};
template <> struct AttnKTile<16> {
    static __device__ __forceinline__ void run(LAS unsigned char*, const LAS unsigned short*, const GAS char*, int, int, int, int, int, int, const bf16x8 (&)[8], v4u (&)[3][8], f32x4 (&)[16], float&) {}
};
__device__ __forceinline__ void attn_prompt_query(LAS unsigned char* wl, const GAS bf16* P1, const GAS bf16* KVB, const GAS unsigned short* IDXP, GAS bf16* YA, int m, int lane_in) {
    int lane = lane_in; asm volatile("" : "+v"(lane));
    const int b = m / LP, t = m - b * LP, cnt = (t + 1) < 256 ? (t + 1) : 256, ntile = (cnt + 15) >> 4, nstep = (ntile + 1) >> 1;
    LAS unsigned char* Vst = wl; LAS unsigned short* idl = (LAS unsigned short*)(wl + 32 * RS_V);
    { const v2u w = *(const GAS v2u*)(IDXP + (size_t)m * 256 + 4 * lane); const int s0 = 4 * lane;
      const unsigned i0 = (s0 + 0 < cnt) ? (w.x & 0xffffu) : 0u, i1 = (s0 + 1 < cnt) ? (w.x >> 16) : 0u, i2 = (s0 + 2 < cnt) ? (w.y & 0xffffu) : 0u, i3 = (s0 + 3 < cnt) ? (w.y >> 16) : 0u;
      *(LAS v2u*)(idl + s0) = (v2u){i0 | (i1 << 16), i2 | (i3 << 16)}; }
    const int n = lane & 15, kg = lane >> 4;
    int k4 = 4 * kg; asm volatile("" : "+v"(k4));
    bf16x8 bq[8];
#pragma unroll
    for (int s = 0; s < 8; ++s) { bq[s] = (bf16x8){0, 0, 0, 0, 0, 0, 0, 0};
        if ((n >> 2) == (s >> 1)) bq[s] = *(const GAS bf16x8*)(P1 + (size_t)m * LDP1 + C_Q + n * 64 + 32 * (s & 1) + 8 * kg); }
    LDS_WAIT(); asm volatile("" ::: "memory");
    const GAS char* kvb = (const GAS char*)(KVB + (size_t)b * LP * 512);
    const unsigned voff = 512u + 16u * (lane & 31);
    f32x4 S[16];
#pragma unroll
    for (int jt = 0; jt < 16; ++jt) S[jt] = (f32x4){-INFINITY, -INFINITY, -INFINITY, -INFINITY};
    float mx = -INFINITY;
    {
        v4u kst[3][8];
        KLOAD(kst[0], 0); KLOAD(kst[1], 1); KLOAD(kst[2], 2);
        AttnKTile<0>::run(Vst, idl, kvb, lane, n, kg, k4, cnt, ntile, bq, kst, S, mx);
#undef KLOAD
    }
    mx = fmaxf(mx, __shfl_xor(mx, 16)); mx = fmaxf(mx, __shfl_xor(mx, 32));
    float sum = 0.f;
    v4u pa[8];
#pragma unroll
    for (int s = 0; s < 8; ++s) { float p[8];
#pragma unroll
        for (int i = 0; i < 4; ++i) { p[i] = __expf(S[2 * s][i] - mx); p[4 + i] = __expf(S[2 * s + 1][i] - mx); }
#pragma unroll
        for (int i = 0; i < 8; ++i) sum += p[i];
        pa[s] = (v4u){pk2(p[0], p[1]), pk2(p[2], p[3]), pk2(p[4], p[5]), pk2(p[6], p[7])};
        __builtin_amdgcn_sched_barrier(0); }
    sum += __shfl_xor(sum, 16); sum += __shfl_xor(sum, 32);
    const float linv = 1.0f / sum;
    asm volatile("" ::: "memory");
    v4u vst[3][8];
#define VLOAD(dst, tile) do { _Pragma("unroll") for (int it = 0; it < 8; ++it) dst[it] = *(const GAS v4u*)(kvb + ((unsigned)idl[16 * (tile) + 2 * it + (lane >> 5)] * 1024u + voff)); } while (0)
#define VSTORE(src, tt) do { _Pragma("unroll") for (int it = 0; it < 8; ++it) { const int u = 2 * it + (lane >> 5); *(LAS v4u*)(Vst + (8 * (u >> 2) + 4 * (tt) + (u & 3)) * RS_V + 16 * (lane & 31)) = src[it]; } } while (0)
    VLOAD(vst[0], 0); VLOAD(vst[1], 1); VLOAD(vst[2], 2);
    f32x4 o[4];
#pragma unroll
    for (int c = 0; c < 4; ++c) o[c] = (f32x4){0.f, 0.f, 0.f, 0.f};
    const int g16 = lane >> 4, q4 = (lane & 15) >> 2, p4 = lane & 3;
    const LAS unsigned char* trb = Vst + (8 * g16 + q4) * RS_V + 8 * p4;
#pragma unroll
    for (int s = 0; s < 8; ++s) {
        if (s >= nstep) break;
        {
            VSTORE(vst[(2 * s) % 3], 0);
            VSTORE(vst[(2 * s + 1) % 3], 1);
            LDS_WAIT(); asm volatile("" ::: "memory");
            if (2 * s + 3 < 16) VLOAD(vst[(2 * s) % 3], 2 * s + 3);
            if (2 * s + 4 < 16) VLOAD(vst[(2 * s + 1) % 3], 2 * s + 4);
#pragma unroll
            for (int g = 0; g < 4; ++g) {
                const v4u pm = ((n >> 2) == g) ? pa[s] : (v4u){0u, 0u, 0u, 0u};
                const bf16x8 pf = __builtin_bit_cast(bf16x8, pm);
#pragma unroll
                for (int c = 0; c < 4; ++c) { const int ct = 4 * g + c;
                    const s16x4 lo = ldtr(trb + 32 * ct), hi = ldtr(trb + 4 * RS_V + 32 * ct);
                    const bf16x8 bv = (bf16x8){lo[0], lo[1], lo[2], lo[3], hi[0], hi[1], hi[2], hi[3]};
                    o[c] = __builtin_amdgcn_mfma_f32_16x16x32_bf16(pf, bv, o[c], 0, 0, 0); }
            }
            LDS_WAIT(); asm volatile("" ::: "memory");
        }
    }
#undef VLOAD
#undef VSTORE
#pragma unroll
    for (int i = 0; i < 4; ++i) { const float li = __shfl(linv, 4 * kg + i);
#pragma unroll
        for (int c = 0; c < 4; ++c) YA[(size_t)m * D + (4 * kg + i) * 64 + 16 * c + n] = (bf16)f2bf(o[c][i] * li); }
}

__device__ __forceinline__ void attn_sample_query(LAS unsigned char* lds, int tid, const GAS bf16* P1, const GAS bf16* KVB, const GAS float* ck, const GAS float* cv, const GAS int* ptab, const GAS int* IDXS, GAS bf16* YA, int qi) {
    const int lane = tid & 63, wave = tid >> 6, bd = qi >> 3; const size_t m = (size_t)MP + qi;
    LAS float* Sl = (LAS float*)lds;
    LAS float* Ol = Sl + 16 * 256;
    LAS float* ql = Ol + 8 * 1024;
    LAS float* linv = ql + 1024;
    LAS int* rowsel = (LAS int*)(linv + 16);
    { const unsigned w = *(const GAS unsigned*)(P1 + m * LDP1 + C_Q + 2 * tid); ql[2 * tid] = __uint_as_float(w << 16); ql[2 * tid + 1] = __uint_as_float(w & 0xffff0000u); }
    if (tid < 256) rowsel[tid] = IDXS[qi * 256 + tid];
    __syncthreads();
    const int g = lane >> 4, c = lane & 15;
    float qr[4][4];
#pragma unroll
    for (int a = 0; a < 4; ++a) { const f32x4 t = *(const LAS f32x4*)(ql + (4 * g + a) * 64 + 4 * c); qr[a][0] = t.x; qr[a][1] = t.y; qr[a][2] = t.z; qr[a][3] = t.w; }
#pragma unroll 4
    for (int kk = 0; kk < 32; ++kk) {
        const int key = 32 * wave + kk, idx = rowsel[key];
        f32x4 kv;
        if (idx < PAST) { const int page = ptab[bd * NPAGES + (idx >> 7)]; kv = *(const GAS f32x4*)(ck + ((size_t)page * PAGE + (idx & 127)) * 256 + 4 * lane); }
        else { const v2u w = *(const GAS v2u*)(KVB + (size_t)(MP + bd * DS + (idx - PAST)) * 512 + 4 * lane);
            kv = (f32x4){__uint_as_float(w.x << 16), __uint_as_float(w.x & 0xffff0000u), __uint_as_float(w.y << 16), __uint_as_float(w.y & 0xffff0000u)}; }
        float part[4];
#pragma unroll
        for (int a = 0; a < 4; ++a) { float s = (qr[a][0] * kv.x + qr[a][1] * kv.y) + (qr[a][2] * kv.z + qr[a][3] * kv.w);
            part[a] = row16_sum(s); }
        if (c == 0) {
#pragma unroll
            for (int a = 0; a < 4; ++a) Sl[(4 * g + a) * 256 + key] = part[a] * 0.125f; }
    }
    __syncthreads();
#pragma unroll
    for (int hs = 0; hs < 2; ++hs) { const int head = 2 * wave + hs; float v[4]; float mx = -INFINITY;
#pragma unroll
        for (int j = 0; j < 4; ++j) { v[j] = Sl[head * 256 + lane + 64 * j]; mx = fmaxf(mx, v[j]); }
        mx = wave_max(mx); float sum = 0.f;
#pragma unroll
        for (int j = 0; j < 4; ++j) { v[j] = __expf(v[j] - mx); sum += v[j]; Sl[head * 256 + lane + 64 * j] = v[j]; }
        sum = wave_sum(sum);
        if (lane == 0) linv[head] = 1.0f / sum; }
    __syncthreads();
    float o[4][4];
#pragma unroll
    for (int a = 0; a < 4; ++a)
#pragma unroll
        for (int cc = 0; cc < 4; ++cc) o[a][cc] = 0.f;
#pragma unroll 4
    for (int kk = 0; kk < 32; ++kk) {
        const int key = 32 * wave + kk, idx = rowsel[key];
        f32x4 vv;
        if (idx < PAST) { const int page = ptab[bd * NPAGES + (idx >> 7)]; vv = *(const GAS f32x4*)(cv + ((size_t)page * PAGE + (idx & 127)) * 256 + 4 * lane); }
        else { const v2u w = *(const GAS v2u*)(KVB + (size_t)(MP + bd * DS + (idx - PAST)) * 512 + 256 + 4 * lane);
            vv = (f32x4){__uint_as_float(w.x << 16), __uint_as_float(w.x & 0xffff0000u), __uint_as_float(w.y << 16), __uint_as_float(w.y & 0xffff0000u)}; }
#pragma unroll
        for (int a = 0; a < 4; ++a) { const float p = Sl[(4 * g + a) * 256 + key]; o[a][0] += p * vv.x; o[a][1] += p * vv.y; o[a][2] += p * vv.z; o[a][3] += p * vv.w; }
    }
#pragma unroll
    for (int a = 0; a < 4; ++a) *(LAS f32x4*)(Ol + wave * 1024 + (4 * g + a) * 64 + 4 * c) = (f32x4){o[a][0], o[a][1], o[a][2], o[a][3]};
    __syncthreads();
    { float s0 = 0.f, s1 = 0.f;
#pragma unroll
      for (int w = 0; w < 8; ++w) { s0 += Ol[w * 1024 + 2 * tid]; s1 += Ol[w * 1024 + 2 * tid + 1]; }
      const float li = linv[(2 * tid) >> 6];
      *(GAS unsigned*)(YA + m * D + 2 * tid) = pk2(s0 * li, s1 * li); }
    __syncthreads();
}

constexpr int TAIL_R0 = 16384, TAIL_NRT = (MR - TAIL_R0) / 64;
static_assert(TAIL_R0 + 64 * TAIL_NRT == MR, "tail rows");
template <int MODE>
__device__ __forceinline__ void tail_gemm(LAS unsigned char* lds, const GAS bf16* A, int K, const GAS bf16* Bt, int N, const GAS bf16* P1, GAS bf16* T1, GAS bf16* MG, GAS float* H, GAS bf16* A2, int bx, int G, int tid) {
    constexpr int KB = 256, RS = (KB + 8) * 2;
    const int lane = tid & 63, wave = __builtin_amdgcn_readfirstlane(tid >> 6), col = lane & 31, hh = lane >> 5;
    constexpr int NSPLIT = MODE == 5 ? 4 : 1;
    const int nunits = TAIL_NRT * (N / 64) * NSPLIT, lr = tid >> 3, lc = tid & 7, ti = wave & 3, kh = wave >> 2, Ks = K / NSPLIT;
    LAS unsigned char* As = lds; LAS unsigned char* Bs = lds + 64 * RS; LAS float* red = (LAS float*)(lds + 2 * 64 * RS);
    for (int u = bx; u < nunits; u += G) {
        const int sp = u % NSPLIT, uu = u / NSPLIT, rt = uu % TAIL_NRT, ct = uu / TAIL_NRT;
        const GAS bf16* ap = A + (size_t)(TAIL_R0 + 64 * rt + lr) * K + sp * Ks + 8 * lc;
        const GAS bf16* bp = Bt + (size_t)(64 * ct + lr) * K + sp * Ks + 8 * lc;
        v4u ra[4], rb[4];
#pragma unroll
        for (int j = 0; j < 4; ++j) { ra[j] = *(const GAS v4u*)(ap + 64 * j); rb[j] = *(const GAS v4u*)(bp + 64 * j); }
        f32x16 acc = {};
        for (int k0 = 0; k0 < Ks; k0 += KB) {
            __syncthreads();
#pragma unroll
            for (int j = 0; j < 4; ++j) { *(LAS v4u*)(As + lr * RS + (lc * 8 + 64 * j) * 2) = ra[j]; *(LAS v4u*)(Bs + lr * RS + (lc * 8 + 64 * j) * 2) = rb[j]; }
            if (k0 + KB < Ks) {
#pragma unroll
                for (int j = 0; j < 4; ++j) { ra[j] = *(const GAS v4u*)(ap + k0 + KB + 64 * j); rb[j] = *(const GAS v4u*)(bp + k0 + KB + 64 * j); } }
            __syncthreads();
#pragma unroll
            for (int j = 0; j < 8; ++j) { const int ks = 8 * kh + j;
                const bf16x8 av = *(const LAS bf16x8*)(As + (32 * (ti >> 1) + col) * RS + (16 * ks + 8 * hh) * 2), bv = *(const LAS bf16x8*)(Bs + (32 * (ti & 1) + col) * RS + (16 * ks + 8 * hh) * 2);
                acc = __builtin_amdgcn_mfma_f32_32x32x16_bf16(av, bv, acc, 0, 0, 0); }
        }
        __syncthreads();
        if (kh == 1) {
#pragma unroll
            for (int r = 0; r < 16; ++r) red[(ti * 16 + r) * 64 + lane] = acc[r]; }
        __syncthreads();
        if (kh == 0) {
            const int c = 64 * ct + 32 * (ti & 1) + col;
#pragma unroll
            for (int r = 0; r < 16; ++r) { const size_t row = TAIL_R0 + 64 * rt + 32 * (ti >> 1) + (r & 3) + 8 * (r >> 2) + 4 * hh; const float v = acc[r] + red[(ti * 16 + r) * 64 + lane];
                if (MODE == 1) { const float g = __uint_as_float((unsigned)P1[row * LDP1 + C_GS + c] << 16); T1[row * D + c] = (bf16)f2bf(v * sigm(g)); }
                if (MODE == 2) { const float g = __uint_as_float((unsigned)P1[row * LDP1 + C_GA + c] << 16); MG[row * D + c] = (bf16)f2bf(__uint_as_float((unsigned)T1[row * D + c] << 16) + v * sigm(g)); }
                if (MODE == 3) H[row * D + c] += v;
                if (MODE == 5) H[((size_t)sp * (MR - TAIL_R0) + (row - TAIL_R0)) * D + c] = v;
                if (MODE == 4) { const float w = fmaxf(v, 0.f); A2[row * DFF + c] = (bf16)f2bf(w * w); } }
        }
    }
    __syncthreads();
}

#ifndef REP_SCORE
#define REP_SCORE 1
#endif
#ifndef REP_SCORE_AT
#define REP_SCORE_AT 1
#endif
#ifndef REP_SEL
#define REP_SEL 1
#endif
#ifndef REP_CONV
#define REP_CONV 1
#endif
#ifndef REP_TOPK
#define REP_TOPK 1
#endif
#ifndef REP_SSC
#define REP_SSC 1
#endif
#ifndef REP_SSEL
#define REP_SSEL 1
#endif
#ifndef REP_SSD1
#define REP_SSD1 1
#endif
#ifndef REP_SREC
#define REP_SREC 1
#endif
#ifndef REP_SCAN
#define REP_SCAN 1
#endif
#ifndef REP_ATTS
#define REP_ATTS 1
#endif
#ifndef REP_ATTP
#define REP_ATTP 1
#endif
#ifndef REP_SSD3
#define REP_SSD3 1
#endif
__device__ __forceinline__ void xcd_barrier_ni(unsigned* bar, unsigned x, volatile LAS unsigned* st, int tid, unsigned G) { XcdBarrier b; b.bar = bar; b.x = x; b.st = st; xcd_barrier(b, tid, G); }
__device__ __forceinline__ void assume_global(const void* p) {
#if defined(__HIP_DEVICE_COMPILE__)
    __builtin_assume(!__builtin_amdgcn_is_shared((const __attribute__((address_space(0))) void*)p));
    __builtin_assume(!__builtin_amdgcn_is_private((const __attribute__((address_space(0))) void*)p));
#else
    (void)p;
#endif
}
__device__ __forceinline__ int tid_now(int wave0) { unsigned ones = ~0u; asm volatile("" : "+s"(ones)); return (wave0 << 6) | (int)__builtin_amdgcn_mbcnt_hi(ones, __builtin_amdgcn_mbcnt_lo(ones, 0u)); }
constexpr int NPH = 12, NPHASES = 1 + 2 * NPH;
struct Args { const void* in[24]; float* out; unsigned char* ws; int l_lo, l_hi; };
static_assert(sizeof(Args) == 24 * 8 + 8 + 8 + 8, "Args has no padding");

template <int KLO, int KHI>
__global__ void __launch_bounds__(NT, 2) fwd_t(Args args) {
    extern __shared__ __attribute__((aligned(16))) unsigned char lds_raw[];
    LAS unsigned char* lds0 = (LAS unsigned char*)lds_raw;
    volatile LAS unsigned* MISCW = (volatile LAS unsigned*)(lds0 + MISC_OFF);
    const int G = gridDim.x, bx = blockIdx.x, NGW = G * NWAVES;
    const int wave0 = __builtin_amdgcn_readfirstlane((int)threadIdx.x >> 6);
#define TID_NOW() tid_now(wave0)
    { const int tid0 = threadIdx.x;
      for (int u = tid0; u < (LDS_BYTES - LDSCTL_OFF) / 4; u += NT) ((LAS unsigned*)(lds0 + LDSCTL_OFF))[u] = 0u; }
    __syncthreads();
    XcdBarrier bar = xcd_barrier_post((unsigned*)(args.ws + WS_CTL) + CW_BAR, MISCW + 8);
#define IN(k) (KLO <= (k) && (k) < KHI)
#define SEAM(k) do { if (IN(k) && IN((k) + 1)) xcd_barrier_ni(bar.bar, bar.x, bar.st, TID_NOW(), (unsigned)G); } while (0)
#define PHASE_REGS \
    int tid = TID_NOW(); asm volatile("" : "+v"(tid)); \
    int bxl = bx, Gl = G; asm volatile("" : "+s"(bxl), "+s"(Gl)); (void)bxl; (void)Gl;     \
    const int lane = tid & 63, wave = __builtin_amdgcn_readfirstlane(tid >> 6), gw = bx * NWAVES + wave; \
    unsigned char* ws_ = args.ws; asm volatile("" : "+s"(ws_)); GAS unsigned char* ws = (GAS unsigned char*)ws_;     \
    float* out_ = args.out; asm volatile("" : "+s"(out_)); GAS float* out = (GAS float*)out_; \
    (void)lane; (void)gw; (void)out; \
    GAS float* H = (GAS float*)(ws + WS_H); GAS bf16* U = (GAS bf16*)(ws + WS_U); GAS bf16* P1 = (GAS bf16*)(ws + WS_P1); GAS float* MISCB = (GAS float*)(ws + WS_MISC); GAS bf16* KIB = (GAS bf16*)(ws + WS_KIB); \
    GAS bf16* XC = (GAS bf16*)(ws + WS_XC); GAS float* DT = (GAS float*)(ws + WS_DT); GAS float* DA = (GAS float*)(ws + WS_DA); GAS float* YS = (GAS float*)(ws + WS_YS); GAS bf16* YSN = (GAS bf16*)(ws + WS_YSN); \
    GAS bf16* YA = (GAS bf16*)(ws + WS_YA); GAS bf16* T1 = (GAS bf16*)(ws + WS_T1); GAS bf16* MG = (GAS bf16*)(ws + WS_MG); GAS bf16* A2 = (GAS bf16*)(ws + WS_A2); \
    GAS unsigned short* IDXP = (GAS unsigned short*)(ws + WS_IDXP); GAS int* IDXS = (GAS int*)(ws + WS_IDXS); GAS float* SCS = (GAS float*)(ws + WS_SCS); \
    GAS bf16* SB = (GAS bf16*)(ws + WS_SB); GAS float* DEC = (GAS float*)(ws + WS_DEC); GAS bf16* HC = (GAS bf16*)(ws + WS_HC); GAS bf16* KVB = (GAS bf16*)(ws + WS_KVB); GAS bf16* KIB2 = (GAS bf16*)(ws + WS_KIB2); (void)KIB2; (void)SB; (void)DEC; (void)HC; (void)KVB; \
    GAS unsigned char* wl = ws + WS_W + (size_t)l * WL_SIZE; \
    (void)H; (void)U; (void)P1; (void)MISCB; (void)KIB; (void)XC; (void)DT; (void)DA; (void)YS; (void)YSN; (void)YA; (void)T1; (void)MG; (void)A2; (void)IDXP; (void)IDXS; (void)SCS; (void)wl;
#define LDS_LOCAL LAS unsigned char* lds = lds0; asm volatile("" : "+s"(lds));
#define INP(T, name, i) const GAS T* name; { const void* p_; asm volatile("s_load_dwordx2 %0, %1, %2\n\ts_waitcnt lgkmcnt(0)" : "=s"(p_) : "s"(__builtin_amdgcn_kernarg_segment_ptr()), "i"((i) * 8)); name = (const GAS T*)p_; }

    if (IN(0) && args.l_lo == 0) {
        const int l = 0; PHASE_REGS
        LDS_LOCAL
        INP(float, w_in, 10) INP(float, w_ssm, 17) INP(float, w_att, 18) INP(float, w_out, 19) INP(float, w_up, 21) INP(float, w_down, 22) INP(float, meta, 8) INP(float, x_prompt, 0) INP(float, x_sample, 1) INP(float, norm1_w, 9)
        LAS float* scr = (LAS float*)(lds + wave * 17408);
        constexpr int I_IN = (D / 64) * (NIN / 64), I_SSM = (DIN / 64) * (D / 64), I_ATT = (D / 64) * (D / 64), I_OUT = I_ATT, I_UP = (D / 64) * (DFF / 64), I_DN = (DFF / 64) * (D / 64);
        constexpr int I_L = I_IN + I_SSM + I_ATT + I_OUT + I_UP + I_DN;
        for (int it = gw; it < 2 * I_L; it += NGW) {
            const int l = it / I_L; int r = it % I_L; GAS unsigned char* wl = ws + WS_W + (size_t)l * WL_SIZE;
            if (r < I_IN) { tr_item(w_in + (size_t)l * D * IN_DIM, D, IN_DIM, (GAS bf16*)(wl + WL_WIN), NIN / 64, true, scr, r, lane); continue; } r -= I_IN;
            if (r < I_SSM) { tr_item(w_ssm + (size_t)l * DIN * D, DIN, D, (GAS bf16*)(wl + WL_WSSM), D / 64, false, scr, r, lane); continue; } r -= I_SSM;
            if (r < I_ATT) { tr_item(w_att + (size_t)l * D * D, D, D, (GAS bf16*)(wl + WL_WATT), D / 64, false, scr, r, lane); continue; } r -= I_ATT;
            if (r < I_OUT) { tr_item(w_out + (size_t)l * D * D, D, D, (GAS bf16*)(wl + WL_WOUT), D / 64, false, scr, r, lane); continue; } r -= I_OUT;
            if (r < I_UP) { tr_item(w_up + (size_t)l * D * DFF, D, DFF, (GAS bf16*)(wl + WL_WUP), DFF / 64, false, scr, r, lane); continue; } r -= I_UP;
            tr_item(w_down + (size_t)l * DFF * D, DFF, D, (GAS bf16*)(wl + WL_WDN), D / 64, false, scr, r, lane);
        }
        for (int m0 = gw; m0 < MPAD; m0 += 4 * NGW) {
            const GAS float* src[4]; GAS float* hd[4]; GAS bf16* ud[4]; GAS float* fd[4]; bool live[4];
#pragma unroll
            for (int r = 0; r < 4; ++r) { const int m = m0 + r * NGW; live[r] = m < MPAD; src[r] = nullptr; fd[r] = nullptr; hd[r] = H + (size_t)m * D; ud[r] = U + (size_t)m * D;
                if (m < MP) { const int b = m / LP, t = m - b * LP; src[r] = t < NMETA ? meta + (size_t)t * D : x_prompt + ((size_t)b * SEQ + (t - NMETA)) * D; }
                else if (m < MR) src[r] = x_sample + (size_t)(m - MP) * D; }
            rms_rows4g(src, norm1_w, hd, ud, fd, live, lane);
        }
    }
    SEAM(0);

    for (int l = args.l_lo; l < args.l_hi; ++l) {
        constexpr int pb = 1;

        if (IN(pb + 0)) {
            PHASE_REGS
            LAS unsigned char* lds = lds0;
            pg8::Gemm gm{U, (const GAS bf16*)(wl + WL_WIN), MPAD, NIN, D}; pg8::StaticOrder S; S.init(MPAD, NIN, Gl, bxl);
            pg8::EpiIn E{P1, KVB, MISCB, KIB, KIB2, out + O_PK + (size_t)l * MP * 256, out + O_PV + (size_t)l * MP * 256, out + O_PKI + (size_t)l * MP * 64,
                         out + O_SK + (size_t)l * MS * 256, out + O_SV + (size_t)l * MS * 256, out + O_SKI + (size_t)l * MS * 64};
            pg8::gemm_phase<pg8::EpiIn, pg8::StaticOrder, true, true>(lds, gm, S, E, tid);
        }
        SEAM(pb + 0);

        if (IN(pb + 1)) {
            PHASE_REGS
            LDS_LOCAL
            INP(float, state_conv, 6) INP(float, conv_b, 12) INP(float, conv_w, 11) INP(float, dt_bias, 13) INP(float, a_log, 14) INP(float, cache_ki, 4) INP(int, page_table, 7)
            for (int rp_ = 0; rp_ < REP_CONV; ++rp_) for (int it = bx * NT + tid; it < (MR / 8) * 384; it += G * NT) {
                const int rg = it / 384, c8 = (it % 384) * 8, m0 = 8 * rg;
                const bool isS = m0 >= MP; int tpos, sq;
                if (!isS) { sq = m0 / LP; tpos = m0 - sq * LP; } else { sq = (m0 - MP) >> 3; tpos = (m0 - MP) & 7; }
                float xv[11][8];
#pragma unroll
                for (int k = 0; k < 11; ++k) { const int dtp = tpos - 3 + k;
                    if (dtp >= 0) unpack8(*(const GAS v4u*)(P1 + (size_t)(m0 - 3 + k) * LDP1 + C_XBC + c8), xv[k]);
                    else if (isS) { const GAS float* pp = state_conv + ((size_t)(l * DB + sq) * 3 + (3 + dtp)) * CONVD + c8; const f32x4 a = *(const GAS f32x4*)pp, b = *(const GAS f32x4*)(pp + 4);
                        xv[k][0] = a.x; xv[k][1] = a.y; xv[k][2] = a.z; xv[k][3] = a.w; xv[k][4] = b.x; xv[k][5] = b.y; xv[k][6] = b.z; xv[k][7] = b.w; }
                    else {
#pragma unroll
                        for (int j = 0; j < 8; ++j) xv[k][j] = 0.f; } }
                float wv[4][8], bv[8];
                { const GAS float* bp = conv_b + (size_t)l * CONVD + c8; const f32x4 a = *(const GAS f32x4*)bp, b = *(const GAS f32x4*)(bp + 4);
                  bv[0] = a.x; bv[1] = a.y; bv[2] = a.z; bv[3] = a.w; bv[4] = b.x; bv[5] = b.y; bv[6] = b.z; bv[7] = b.w; }
#pragma unroll
                for (int k = 0; k < 4; ++k) { const GAS float* wp = conv_w + ((size_t)l * 4 + k) * CONVD + c8; const f32x4 a = *(const GAS f32x4*)wp, b = *(const GAS f32x4*)(wp + 4);
                    wv[k][0] = a.x; wv[k][1] = a.y; wv[k][2] = a.z; wv[k][3] = a.w; wv[k][4] = b.x; wv[k][5] = b.y; wv[k][6] = b.z; wv[k][7] = b.w; }
#pragma unroll
                for (int r = 0; r < 8; ++r) {
                    float y[8];
#pragma unroll
                    for (int j = 0; j < 8; ++j) { float s = bv[j];
#pragma unroll
                        for (int k = 0; k < 4; ++k) s += xv[r + k][j] * wv[k][j];
                        y[j] = s * sigm(s); }
                    *(GAS v4u*)(XC + (size_t)(m0 + r) * CONVD + c8) = (v4u){pk2(y[0], y[1]), pk2(y[2], y[3]), pk2(y[4], y[5]), pk2(y[6], y[7])};
                    const int tp = tpos + r; GAS float* cs = nullptr;
                    if (!isS && tp >= LP - 3) cs = out + O_PCONV + ((size_t)(l * NB + sq) * 3 + (tp - (LP - 3))) * CONVD + c8;
                    if (isS && tp >= DS - 3) cs = out + O_SCONV + ((size_t)(l * DB + sq) * 3 + (tp - (DS - 3))) * CONVD + c8;
                    if (cs) { *(GAS f32x4*)cs = (f32x4){xv[r + 3][0], xv[r + 3][1], xv[r + 3][2], xv[r + 3][3]}; *(GAS f32x4*)(cs + 4) = (f32x4){xv[r + 3][4], xv[r + 3][5], xv[r + 3][6], xv[r + 3][7]}; }
                }
            }
            for (int it = bx * NT + tid; it < MR * NH; it += G * NT) {
                const int m = it >> 5, h = it & 31;
                const float raw = MISCB[(size_t)m * 128 + MC_DT + h] + dt_bias[l * NH + h];
                const float sp = fmaxf(raw, 0.f) + log1pf(__expf(-fabsf(raw)));
                const float A = -__expf(a_log[l * NH + h]);
                DT[it] = sp; DA[it] = __expf(sp * A);
            }
            for (int rp_ = 0; rp_ < REP_TOPK; ++rp_) {
                constexpr int SLD = 4352;
                LAS unsigned* scl = (LAS unsigned*)lds; LAS unsigned* histq = (LAS unsigned*)(lds + 8 * SLD * 4);
                for (int j = 0; ; ++j) {
                    const int unit = j * G + ((j & 1) ? (G - 1 - bx) : bx); if (unit >= NB * (LP / 8)) break;
                    const int b = unit & (NB - 1), qb = (LP / 8 - 1) - (unit >> 2);
                    const size_t mq0 = (size_t)b * LP + 8 * qb; const int nkeys = 8 * qb + 8, ntl = (nkeys + 31) >> 5;
                    bf16x8 afr[2][4]; float wq[2][2][8];
                    idx_load_q(P1, MISCB, mq0, lane, afr, wq);
                    const int kcol = lane & 31, hh = lane >> 5;
                    for (int rs_ = 0; rs_ < REP_SCORE; ++rs_) {
                    if (rs_) __syncthreads();
                    for (int i = tid; i < 8 * HB; i += NT) histq[i] = 0u;
                    __syncthreads();
                    const GAS bf16* kp0 = KIB2 + (size_t)b * KT_PER_B * 2048 + lane * 8;
                    bf16x8 ks0[4], ks1[4], ks2[4];
#pragma unroll
                    for (int ks = 0; ks < 4; ++ks) { ks0[ks] = (bf16x8){0, 0, 0, 0, 0, 0, 0, 0}; ks1[ks] = ks0[ks]; ks2[ks] = ks0[ks]; }
#define SC_LOAD(S, T) { _Pragma("unroll") for (int ks = 0; ks < 4; ++ks) S[ks] = *(const GAS bf16x8*)(kp0 + (size_t)(T) * 2048 + 512 * ks); }
#define SC_TILE(S, KT, LOADC, ADM) { \
                        f32x16 a0 = {}, a1 = {}; \
                        _Pragma("unroll") for (int ks = 0; ks < 4; ++ks) { a0 = __builtin_amdgcn_mfma_f32_32x32x16_bf16(afr[0][ks], S[ks], a0, 0, 0, 0); a1 = __builtin_amdgcn_mfma_f32_32x32x16_bf16(afr[1][ks], S[ks], a1, 0, 0, 0); } \
                        asm volatile("" : "+v"(a0), "+v"(a1) :: "memory");        \
                        if (LOADC) SC_LOAD(S, (KT) + 3 * NWAVES) \
                        const int key = 32 * (KT) + kcol; \
                        _Pragma("unroll") for (int rt = 0; rt < 2; ++rt) \
                        _Pragma("unroll") for (int jq = 0; jq < 2; ++jq) { const int q = 4 * rt + 2 * hh + jq; const float sv = idx_reduce(rt ? a1 : a0, 8 * jq, wq[rt][jq]); \
                            scl[q * SLD + key] = f2key(sv); \
                            int bn; asm("v_cvt_flr_i32_f32 %0, %1" : "=v"(bn) : "v"(sv)); bn = min(max(bn, -256), HB - 257); \
                            if (SC_ATOM) __hip_atomic_fetch_add(histq + q * HB + 256 + bn, (ADM) || key <= 8 * qb + q ? 1u : 0u, __ATOMIC_RELAXED, __HIP_MEMORY_SCOPE_WORKGROUP); } }
                    const bool SC_ATOM = REP_SCORE_AT || rs_ == REP_SCORE - 1;
                    int kt = wave;
                    if (kt + 5 * NWAVES < ntl) {
                        SC_LOAD(ks0, wave) SC_LOAD(ks1, wave + NWAVES) SC_LOAD(ks2, wave + 2 * NWAVES)
                        do { SC_TILE(ks0, kt, true, true) SC_TILE(ks1, kt + NWAVES, true, true) SC_TILE(ks2, kt + 2 * NWAVES, true, true) kt += 3 * NWAVES; } while (kt + 5 * NWAVES < ntl);
                    } else {
                        if (wave < ntl) SC_LOAD(ks0, wave)
                        if (wave + NWAVES < ntl) SC_LOAD(ks1, wave + NWAVES)
                        if (wave + 2 * NWAVES < ntl) SC_LOAD(ks2, wave + 2 * NWAVES)
                    }
                    for (; kt < ntl; kt += 3 * NWAVES) {
                        SC_TILE(ks0, kt, kt + 3 * NWAVES < ntl, false)
                        if (kt + NWAVES < ntl) SC_TILE(ks1, kt + NWAVES, kt + 4 * NWAVES < ntl, false)
                        if (kt + 2 * NWAVES < ntl) SC_TILE(ks2, kt + 2 * NWAVES, kt + 5 * NWAVES < ntl, false)
                    }
#undef SC_TILE
#undef SC_LOAD
                    }
                    __syncthreads();
                    for (int r2_ = 0; r2_ < REP_SEL; ++r2_) { const int t = 8 * qb + wave, n = t + 1; GAS unsigned short* op = IDXP + ((size_t)b * LP + t) * 256;
                      if (n <= 256) { for (int i = lane; i < n; i += 64) op[i] = (unsigned short)i; }
                      else topk_select(scl + wave * SLD, n, lane, op, histq + wave * HB); }
                    __syncthreads();
                }
            }
            const GAS float* cki = cache_ki + (size_t)l * NPOOL * PAGE * 64;
            for (int rp_ = 0; rp_ < REP_SSC; ++rp_) for (int unit = bx; unit < DB * 8; unit += G) {
                const int bd = unit >> 3, ch = unit & 7; const size_t mq0 = (size_t)MP + bd * DS;
                bf16x8 afr[2][4]; float wq[2][2][8];
                idx_load_q(P1, MISCB, mq0, lane, afr, wq);
                const int kcol = lane & 31, hh = lane >> 5;
                const int pg = 8 * ch + wave, phys = page_table[bd * NPAGES + pg];
                const GAS float* kbase = cki + (size_t)phys * PAGE * 64;
#pragma unroll 1
                for (int kt = 0; kt < 4; ++kt) {
                    const int kin = 32 * kt + kcol; const GAS float* kp = kbase + (size_t)kin * 64 + 8 * hh;
                    bf16x8 bfr[4];
#pragma unroll
                    for (int ks = 0; ks < 4; ++ks) { const f32x4 a = *(const GAS f32x4*)(kp + 16 * ks), bq = *(const GAS f32x4*)(kp + 16 * ks + 4);
                        const v4u w = (v4u){pk2(a.x, a.y), pk2(a.z, a.w), pk2(bq.x, bq.y), pk2(bq.z, bq.w)}; bfr[ks] = __builtin_bit_cast(bf16x8, w); }
                    float sc[2][2];
                    idx_scores(afr, bfr, wq, sc);
#pragma unroll
                    for (int rt = 0; rt < 2; ++rt)
#pragma unroll
                        for (int jq = 0; jq < 2; ++jq) SCS[(size_t)(bd * DS + 4 * rt + 2 * hh + jq) * SCS_LD + 128 * pg + kin] = sc[rt][jq];
                }
                if (ch == 7 && wave == 0) {
                    const int j = kcol < DS ? kcol : DS - 1; const GAS bf16* kp = KIB + (mq0 + j) * 64 + 8 * hh;
                    bf16x8 bfr[4];
#pragma unroll
                    for (int ks = 0; ks < 4; ++ks) bfr[ks] = *(const GAS bf16x8*)(kp + 16 * ks);
                    float sc[2][2];
                    idx_scores(afr, bfr, wq, sc);
                    if (kcol < DS) {
#pragma unroll
                        for (int rt = 0; rt < 2; ++rt)
#pragma unroll
                            for (int jq = 0; jq < 2; ++jq) { const int q = 4 * rt + 2 * hh + jq; SCS[(size_t)(bd * DS + q) * SCS_LD + PAST + kcol] = (kcol <= q) ? sc[rt][jq] : -INFINITY; }
                    }
                }
            }
        }
        SEAM(pb + 1);

        if (IN(pb + 2)) {
            PHASE_REGS
            LDS_LOCAL
            INP(float, a_log, 14) INP(float, state_ssm, 5) INP(float, d_skip, 15)
            for (int rp_ = 0; rp_ < REP_SSEL; ++rp_) for (int qi = bx; qi < MS; qi += G) {
                LAS unsigned* scl = (LAS unsigned*)lds; LAS unsigned* hs = (LAS unsigned*)(lds + 8448 * 4);
                hs[tid] = 0u;
                __syncthreads();
                for (int i = tid; i < PAST + DS; i += NT) { const float sc = SCS[(size_t)qi * SCS_LD + i]; scl[i] = f2key(sc);
                    int bn = __float2int_rd(fmaxf(sc, -512.0f)) + 256; bn = bn < 0 ? 0 : (bn > HB - 1 ? HB - 1 : bn);
                    __hip_atomic_fetch_add(hs + bn, 1u, __ATOMIC_RELAXED, __HIP_MEMORY_SCOPE_WORKGROUP); }
                __syncthreads();
                if (wave == 0) { int ns = PAST + DS; asm volatile("" : "+s"(ns)); topk_select(scl, ns, lane, IDXS + qi * 256, hs); }
                __syncthreads();
            }
            for (int rp_ = 0; rp_ < REP_SSD1; ++rp_) for (int unit = bx; unit < NB * NCH * NG; unit += G) {
                int b, c, g; if (unit < NB * 32 * NG) { b = unit >> 7; c = 1 + ((unit & 127) >> 2); g = unit & 3; } else { const int r = unit - NB * 32 * NG; b = r >> 2; c = 0; g = r & 3; }
                ssd1_unit(lds, tid, XC, DT, a_log + l * NH, SB, DEC, b, c, g);
            }
            for (int rp_ = 0; rp_ < REP_SREC; ++rp_) for (int unit = bx; unit < DB * NH * 2; unit += G) {
                const int bd = unit >> 6, h = (unit >> 1) & 31, p0 = (unit & 1) * 32;
                ssd_unit(lds, tid, XC, DT, DA, (size_t)MP + bd * DS, DS, h, p0, state_ssm + ((size_t)(l * DB + bd) * NH + h) * HP * NST,
                         out + O_SSSM + ((size_t)(l * DB + bd) * NH + h) * HP * NST, YS, d_skip[l * NH + h]);
                __syncthreads();
            }
        }
        SEAM(pb + 2);

        if (IN(pb + 3)) {
            PHASE_REGS
            LDS_LOCAL
            INP(float, cache_k, 2) INP(float, cache_v, 3) INP(int, page_table, 7)
            for (int rp_ = 0; rp_ < REP_SCAN; ++rp_) for (int e = bx * NT + tid; e < NB * NH * 2048; e += G * NT) {
                const int b = e / (NH * 2048), h = (e >> 11) & 31, q = e & 2047;
                f32x4 Hr = {0.f, 0.f, 0.f, 0.f};
#pragma unroll 3
                for (int c = 0; c < NCH; ++c) { const size_t idx = (size_t)(b * NCH + c) * NH + h;
                    { const int p = q >> 5, n = (q & 31) * 4;
                      *(GAS v2u*)(HC + idx * (HP * NST) + ((((p >> 5) * 8 + (n >> 4)) * 2 + ((n >> 3) & 1)) * 32 + (p & 31)) * 8 + (n & 7)) = (v2u){pk2(Hr.x, Hr.y), pk2(Hr.z, Hr.w)}; }
                    const float d = DEC[idx]; const v2u sw = *(const GAS v2u*)(SB + idx * (HP * NST) + q * 4);
                    const f32x4 sv = (f32x4){__uint_as_float(sw.x << 16), __uint_as_float(sw.x & 0xffff0000u), __uint_as_float(sw.y << 16), __uint_as_float(sw.y & 0xffff0000u)};
                    Hr = Hr * d + sv; }
                *(GAS f32x4*)(out + O_PSSM + ((size_t)(l * NB + b) * NH + h) * (HP * NST) + q * 4) = Hr;
            }
            const GAS float* ck = cache_k + (size_t)l * NPOOL * PAGE * 256; const GAS float* cv = cache_v + (size_t)l * NPOOL * PAGE * 256;
            for (int rp_ = 0; rp_ < REP_ATTS; ++rp_) for (int qi = bx; qi < MS; qi += G) attn_sample_query(lds, tid, P1, KVB, ck, cv, page_table, IDXS, YA, qi);
            for (int rp_ = 0; rp_ < REP_ATTP; ++rp_) {
                if (Gl == 256) {
                    const int bsel = (bxl & 7) >> 1, widx = ((((bxl >> 3) * NWAVES) + wave) << 1) | (bxl & 1);
                    for (int tr = widx; tr < LP; tr += 512) attn_prompt_query(lds + wave * 17408, P1, KVB, IDXP, YA, bsel * LP + (LP - 1 - tr), lane);
                } else for (int m = gw; m < MP; m += NGW) attn_prompt_query(lds + wave * 17408, P1, KVB, IDXP, YA, m, lane);
            }
        }
        SEAM(pb + 3);

        if (IN(pb + 4)) {
            PHASE_REGS
            LDS_LOCAL
            INP(float, a_log, 14) INP(float, d_skip, 15) INP(float, ssm_norm_w, 16)
            for (int rp_ = 0; rp_ < REP_SSD3; ++rp_) for (int unit = bx; unit < NB * NCH * NG; unit += G) {
                int b, c, g; if (unit < NB * 32 * NG) { b = unit >> 7; c = 1 + ((unit & 127) >> 2); g = unit & 3; } else { const int r = unit - NB * 32 * NG; b = r >> 2; c = 0; g = r & 3; }
                ssd3_unit(lds, tid, XC, P1, DT, a_log + l * NH, d_skip + l * NH, ssm_norm_w + (size_t)l * DIN, HC, YSN, b, c, g);
            }
            for (int it = gw; it < MS * NG; it += NGW) {
                const int m = MP + (it >> 2), g = it & 3, c0 = g * 512 + lane * 8;
                const GAS float* yp = YS + (size_t)m * DIN + c0; const f32x4 a = *(const GAS f32x4*)yp, b = *(const GAS f32x4*)(yp + 4);
                float z[8]; unpack8(*(const GAS v4u*)(P1 + (size_t)m * LDP1 + C_Z + c0), z);
                float v[8] = {a.x, a.y, a.z, a.w, b.x, b.y, b.z, b.w}; float ss = 0.f;
#pragma unroll
                for (int j = 0; j < 8; ++j) { v[j] = v[j] * (z[j] * sigm(z[j])); ss += v[j] * v[j]; }
                ss = wave_sum(ss);
                const float rstd = 1.0f / sqrtf(ss * (1.0f / 512.0f) + 1e-6f);
                const GAS float* wp = ssm_norm_w + (size_t)l * DIN + c0; const f32x4 wa = *(const GAS f32x4*)wp, wb = *(const GAS f32x4*)(wp + 4);
                *(GAS v4u*)(YSN + (size_t)m * DIN + c0) = (v4u){pk2(v[0] * rstd * wa.x, v[1] * rstd * wa.y), pk2(v[2] * rstd * wa.z, v[3] * rstd * wa.w), pk2(v[4] * rstd * wb.x, v[5] * rstd * wb.y), pk2(v[6] * rstd * wb.z, v[7] * rstd * wb.w)};
            }
        }
        SEAM(pb + 4);

        if (IN(pb + 5)) {
            PHASE_REGS
            LAS unsigned char* lds = lds0;
            pg8::Gemm gm{YSN, (const GAS bf16*)(wl + WL_WSSM), TAIL_R0, D, DIN}; pg8::StaticOrder S; S.init(TAIL_R0, D, Gl, bxl);
            pg8::EpiGate1 E{P1, T1};
            pg8::gemm_phase<pg8::EpiGate1, pg8::StaticOrder, true, true>(lds, gm, S, E, tid);
            tail_gemm<1>(lds, YSN, DIN, (const GAS bf16*)(wl + WL_WSSM), D, P1, T1, MG, H, A2, bxl, Gl, tid);
        }
        if (IN(pb + 6)) {
            PHASE_REGS
            LAS unsigned char* lds = lds0;
            pg8::Gemm gm{YA, (const GAS bf16*)(wl + WL_WATT), TAIL_R0, D, D}; pg8::StaticOrder S; S.init(TAIL_R0, D, Gl, bxl);
            pg8::EpiGate2 E{P1, T1, MG};
            pg8::gemm_phase<pg8::EpiGate2, pg8::StaticOrder, true, true>(lds, gm, S, E, tid);
            tail_gemm<2>(lds, YA, D, (const GAS bf16*)(wl + WL_WATT), D, P1, T1, MG, H, A2, bxl, Gl, tid);
        }
        SEAM(pb + 6);
        if (IN(pb + 7)) {
            PHASE_REGS
            LAS unsigned char* lds = lds0;
            pg8::Gemm gm{MG, (const GAS bf16*)(wl + WL_WOUT), TAIL_R0, D, D}; pg8::StaticOrder S; S.init(TAIL_R0, D, Gl, bxl);
            pg8::EpiResid E{H};
            pg8::gemm_phase<pg8::EpiResid, pg8::StaticOrder, true, true>(lds, gm, S, E, tid);
            tail_gemm<3>(lds, MG, D, (const GAS bf16*)(wl + WL_WOUT), D, P1, T1, MG, H, A2, bxl, Gl, tid);
        }
        SEAM(pb + 7);
        if (IN(pb + 8)) {
            PHASE_REGS
            INP(float, norm2_w, 20)
            for (int m = gw; m < MPAD; m += 4 * NGW) rms_rows4(H, norm2_w + (size_t)l * D, U, m, NGW, MPAD, lane);
        }
        SEAM(pb + 8);
        if (IN(pb + 9)) {
            PHASE_REGS
            LAS unsigned char* lds = lds0;
            pg8::Gemm gm{U, (const GAS bf16*)(wl + WL_WUP), TAIL_R0, DFF, D}; pg8::StaticOrder S; S.init(TAIL_R0, DFF, Gl, bxl);
            pg8::EpiUp E{A2};
            pg8::gemm_phase<pg8::EpiUp, pg8::StaticOrder, true, true>(lds, gm, S, E, tid);
            tail_gemm<4>(lds, U, D, (const GAS bf16*)(wl + WL_WUP), DFF, P1, T1, MG, H, A2, bxl, Gl, tid);
        }
        SEAM(pb + 9);
        if (IN(pb + 10)) {
            PHASE_REGS
            LAS unsigned char* lds = lds0;
            pg8::Gemm gm{A2, (const GAS bf16*)(wl + WL_WDN), TAIL_R0, D, DFF}; pg8::StaticOrder S; S.init(TAIL_R0, D, Gl, bxl);
            pg8::EpiResid E{H};
            pg8::gemm_phase<pg8::EpiResid, pg8::StaticOrder, true, true>(lds, gm, S, E, tid);
            tail_gemm<5>(lds, A2, DFF, (const GAS bf16*)(wl + WL_WDN), D, P1, T1, MG, (GAS float*)(ws + WS_YA), A2, bxl, Gl, tid);
        }
        SEAM(pb + 10);
        if (IN(pb + 11)) {
            PHASE_REGS
            INP(float, norm1_w, 9) INP(float, final_w, 23)
            { const GAS float* TP = (const GAS float*)(ws + WS_YA);
              for (int m = TAIL_R0 + gw; m < MR; m += NGW) {
                  GAS float* fd = nullptr;
                  if (l != 0) { if (m < MP) { const int b = m / LP, t = m - b * LP; if (t >= NMETA) fd = out + O_YP + ((size_t)b * SEQ + (t - NMETA)) * D; } else fd = out + O_YS + (size_t)(m - MP) * D; }
                  rms_row_fold(H + (size_t)m * D, TP + (size_t)(m - TAIL_R0) * D, (size_t)(MR - TAIL_R0) * D, l == 0 ? norm1_w + D : final_w, l == 0 ? U + (size_t)m * D : nullptr, fd, lane); } }
            if (l == 0) { for (int m = gw; m < TAIL_R0; m += 4 * NGW) rms_rows4(H, norm1_w + D, U, m, NGW, TAIL_R0, lane);
                          for (int m = MR + gw; m < MPAD; m += 4 * NGW) rms_rows4(H, norm1_w + D, U, m, NGW, MPAD, lane); }
            else {
                for (int m0 = gw; m0 < TAIL_R0; m0 += 4 * NGW) {
                    const GAS float* src[4]; GAS float* hd[4]; GAS bf16* ud[4]; GAS float* fd[4]; bool live[4];
#pragma unroll
                    for (int r = 0; r < 4; ++r) { const int m = m0 + r * NGW; hd[r] = nullptr; ud[r] = nullptr; fd[r] = nullptr; src[r] = H + (size_t)(m < TAIL_R0 ? m : m0) * D;
                        if (m < TAIL_R0) { const int b = m / LP, t = m - b * LP; if (t >= NMETA) fd[r] = out + O_YP + ((size_t)b * SEQ + (t - NMETA)) * D; }
                        live[r] = fd[r] != nullptr; }
                    rms_rows4g(src, final_w, hd, ud, fd, live, lane);
                }
            }
        }
        if (IN(pb + 11) && IN(1) && l + 1 < args.l_hi) xcd_barrier_ni(bar.bar, bar.x, bar.st, TID_NOW(), (unsigned)G);
    }
#undef IN
#undef SEAM
}

#ifndef MK_PER_PHASE
#define MK_PER_PHASE 0
#endif
extern "C" void kernel_launch(void* const* d_in, const int* in_sizes, int n_in, void* d_out, int out_size, void* d_ws, size_t ws_size, hipStream_t stream) {
    static int grid = 0;
    if (grid == 0) {
        if (n_in != 24 || (size_t)out_size != O_END || ws_size < WS_END) { fprintf(stderr, "kernel_launch: unexpected shapes: n_in %d out %d (want %zu) ws %zu (want %zu)\n", n_in, out_size, (size_t)O_END, ws_size, (size_t)WS_END); grid = -1; return; }
        int dev = 0, cus = 0, per_cu = 0;
        if (hipGetDevice(&dev) != hipSuccess || hipDeviceGetAttribute(&cus, hipDeviceAttributeMultiprocessorCount, dev) != hipSuccess) { grid = -1; return; }
        bool ok = true;
#if MK_PER_PHASE
#define SETA(K) ok = ok && hipFuncSetAttribute((const void*)fwd_t<K, K + 1>, hipFuncAttributeMaxDynamicSharedMemorySize, LDS_BYTES) == hipSuccess
        SETA(0); SETA(1); SETA(2); SETA(3); SETA(4); SETA(5); SETA(6); SETA(7); SETA(8); SETA(9); SETA(10); SETA(11); SETA(12);
#else
        ok = hipFuncSetAttribute((const void*)fwd_t<0, NPH + 1>, hipFuncAttributeMaxDynamicSharedMemorySize, LDS_BYTES) == hipSuccess;
        ok = ok && hipOccupancyMaxActiveBlocksPerMultiprocessor(&per_cu, (const void*)fwd_t<0, NPH + 1>, NT, LDS_BYTES) == hipSuccess && per_cu >= 1;
#endif
        if (!ok) { fprintf(stderr, "kernel_launch: hipFuncSetAttribute / occupancy query failed (per_cu %d)\n", per_cu); (void)hipGetLastError(); grid = -1; return; }
        grid = cus;
    }
    if (grid < 0) return;
    (void)hipMemsetAsync((char*)d_ws + WS_CTL, 0, CTL_ZERO_BYTES, stream);
    Args a{};
    for (int i = 0; i < 24; ++i) a.in[i] = d_in[i];
    a.out = (float*)d_out; a.ws = (unsigned char*)d_ws;
#if MK_PER_PHASE
#define LAUNCH_PH(K) hipLaunchKernelGGL((fwd_t<K, K + 1>), dim3(grid), dim3(NT), LDS_BYTES, stream, a)
    a.l_lo = 0; a.l_hi = 1; LAUNCH_PH(0);
    for (int l = 0; l < 2; ++l) { a.l_lo = l; a.l_hi = l + 1;
        LAUNCH_PH(1); LAUNCH_PH(2); LAUNCH_PH(3); LAUNCH_PH(4); LAUNCH_PH(5); LAUNCH_PH(6); LAUNCH_PH(7); LAUNCH_PH(8); LAUNCH_PH(9); LAUNCH_PH(10); LAUNCH_PH(11); LAUNCH_PH(12); }
#else
    a.l_lo = 0; a.l_hi = 2; hipLaunchKernelGGL((fwd_t<0, NPH + 1>), dim3(grid), dim3(NT), LDS_BYTES, stream, a);
#endif
}
```
